# Optimizing an MI355X kernel written in HIP

```python
import math
import jax
import jax.numpy as jnp
from jax import lax
import numpy as np

D_MODEL = 2048
BATCH = 16
SEQ = 256
DEPTH = 4
DEC_BATCH = 8
DEC_SEQ = 1024
PAST_LEN = 512

GRID_W = 64
N_MIXERS = 3
N_ATTN = (DEPTH + 2) // 3
N_HYENA = (DEPTH + 1) // 3
N_RWKV = DEPTH // 3

ATTN_HEADS = 16
ATTN_KV_HEADS = 4
ATTN_HEAD_DIM = 128
ATTN_GROUP = ATTN_HEADS // ATTN_KV_HEADS
WINDOW = 128
ATTN_BLOCK = 128
ROPE_BASE = 10000.0
NEG_INF = -1e30

HYENA_EMB = 33
HYENA_FILTER_WIDTH = 64
HYENA_TARGET = 1e-2
HYENA_FAST_DECAY = 0.3
HYENA_SLOW_DECAY = 1.5

RWKV_HEAD_DIM = 64
RWKV_HEADS = D_MODEL // RWKV_HEAD_DIM
RWKV_DECAY_LORA = 96
RWKV_A_LORA = 96
RWKV_GATE_LORA = 256
RWKV_GN_EPS = 64e-5

D_FF = 4 * D_MODEL
NORM_EPS = 1e-6

kernel_name = "hybrid_diffusion_attn_hyena_rwkv7_step"


def _rmsnorm(x, g):
    xf = x.astype(jnp.float32)
    y = xf * lax.rsqrt(jnp.mean(xf * xf, axis=-1, keepdims=True) + NORM_EPS)
    return (y * g.astype(jnp.float32)).astype(x.dtype)


def _ada(cond, w, b):
    m = jax.nn.silu(cond) @ w + b
    return jnp.split(m[:, None, :], 6, axis=-1)


def _modulate(h, shift, scale):
    return h * (1 + scale) + shift


def _mlp(h, w1, w2):
    return jnp.square(jax.nn.relu(h @ w1)) @ w2


def _axial_angles(L):
    rows = L // GRID_W
    t = jnp.arange(rows * GRID_W)
    row = (t // GRID_W).astype(jnp.float32)
    col = (t % GRID_W).astype(jnp.float32)
    half = ATTN_HEAD_DIM // 2
    inv = ROPE_BASE ** (-jnp.arange(0, half, 2, dtype=jnp.float32) / half)
    return row[:, None] * inv, col[:, None] * inv


def _rotate(x, ang):
    x1, x2 = jnp.split(x, 2, axis=-1)
    c, s = jnp.cos(ang), jnp.sin(ang)
    return jnp.concatenate([x1 * c - x2 * s, x1 * s + x2 * c], axis=-1)


def _apply_axial_rope(x, ang_row, ang_col):
    L = x.shape[1]
    shp = (L,) + (1,) * (x.ndim - 3) + (ang_row.shape[-1],)
    xr, xc = jnp.split(x.astype(jnp.float32), 2, axis=-1)
    out = jnp.concatenate([_rotate(xr, ang_row.reshape(shp)), _rotate(xc, ang_col.reshape(shp))], axis=-1)
    return out.astype(x.dtype)


def _attn_qkv(h, wqkv):
    B, L, _ = h.shape
    qkv = h @ wqkv
    qd = ATTN_HEADS * ATTN_HEAD_DIM
    kd = ATTN_KV_HEADS * ATTN_HEAD_DIM
    q = qkv[..., :qd].reshape(B, L, ATTN_KV_HEADS, ATTN_GROUP, ATTN_HEAD_DIM)
    k = qkv[..., qd:qd + kd].reshape(B, L, ATTN_KV_HEADS, ATTN_HEAD_DIM)
    v = qkv[..., qd + kd:].reshape(B, L, ATTN_KV_HEADS, ATTN_HEAD_DIM)
    return q, k, v


def _softmax_with_sink(s, sink):
    sk = jnp.broadcast_to(sink.astype(jnp.float32).reshape(ATTN_KV_HEADS, ATTN_GROUP, 1, 1), s.shape[:-1] + (1,))
    p = jax.nn.softmax(jnp.concatenate([s, sk], axis=-1), axis=-1)
    return p[..., :-1]


def _attn_context(h, wqkv, wo, sink):
    B, L, _ = h.shape
    q, k, v = _attn_qkv(h, wqkv)
    nq = L // ATTN_BLOCK
    qb = jnp.moveaxis(q.reshape(B, nq, ATTN_BLOCK, ATTN_KV_HEADS, ATTN_GROUP, ATTN_HEAD_DIM), 1, 0)
    scale = ATTN_HEAD_DIM ** -0.5

    def block(qblk):
        s = jnp.einsum("bqhgd,bshd->bhgqs", qblk, k).astype(jnp.float32) * scale
        p = _softmax_with_sink(s, sink)
        return jnp.einsum("bhgqs,bshd->bqhgd", p.astype(v.dtype), v)

    o = lax.map(block, qb)
    o = jnp.moveaxis(o, 0, 1).reshape(B, L, ATTN_HEADS * ATTN_HEAD_DIM)
    return o @ wo, k, v


def _attn_latent(h, k_ctx, v_ctx, wqkv, wo, sink):
    B, L, _ = h.shape
    q, k, v = _attn_qkv(h, wqkv)
    ang_r, ang_c = _axial_angles(L)
    q = _apply_axial_rope(q, ang_r, ang_c)
    k = _apply_axial_rope(k, ang_r, ang_c)
    nb = L // ATTN_BLOCK
    nl = 3 * ATTN_BLOCK

    def band(t):
        tp = jnp.pad(t, ((0, 0), (ATTN_BLOCK, ATTN_BLOCK), (0, 0), (0, 0)))
        tp = tp.reshape(B, nb + 2, ATTN_BLOCK, ATTN_KV_HEADS, ATTN_HEAD_DIM)
        tb = jnp.concatenate([tp[:, :-2], tp[:, 1:-1], tp[:, 2:]], axis=2)
        return jnp.moveaxis(tb, 1, 0)

    k_band, v_band = band(k), band(v)
    qb = jnp.moveaxis(q.reshape(B, nb, ATTN_BLOCK, ATTN_KV_HEADS, ATTN_GROUP, ATTN_HEAD_DIM), 1, 0)
    qi = jnp.arange(ATTN_BLOCK)
    ki = jnp.arange(nl)
    rel = ki[None, :] - ATTN_BLOCK - qi[:, None]
    scale = ATTN_HEAD_DIM ** -0.5

    def block(args):
        j, qblk, kblk, vblk = args
        kpos = (j - 1) * ATTN_BLOCK + ki
        valid = (jnp.abs(rel) <= WINDOW) & ((kpos >= 0) & (kpos < L))[None, :]
        s_loc = jnp.einsum("bqhgd,bshd->bhgqs", qblk, kblk).astype(jnp.float32) * scale
        s_loc = jnp.where(valid, s_loc, NEG_INF)
        s_ctx = jnp.einsum("bqhgd,bshd->bhgqs", qblk, k_ctx).astype(jnp.float32) * scale
        p = _softmax_with_sink(jnp.concatenate([s_loc, s_ctx], axis=-1), sink).astype(v.dtype)
        return (jnp.einsum("bhgqs,bshd->bqhgd", p[..., :nl], vblk)
                + jnp.einsum("bhgqs,bshd->bqhgd", p[..., nl:], v_ctx))

    o = lax.map(block, (jnp.arange(nb), qb, k_band, v_band))
    o = jnp.moveaxis(o, 0, 1).reshape(B, L, ATTN_HEADS * ATTN_HEAD_DIM)
    return o @ wo


def _centred_conv3(u, w, b):
    up = jnp.pad(u, ((0, 0), (1, 1), (0, 0)))
    return up[:, :-2] * w[0] + up[:, 1:-1] * w[1] + up[:, 2:] * w[2] + b


def _hyena_filter(L, f_w1, f_b1, f_w2, f_b2, f_w3, f_b3, freq, f_wout):
    f32 = jnp.float32
    t = jnp.linspace(0.0, 1.0, L, dtype=f32)[:, None]
    bands = (HYENA_EMB - 1) // 2
    w = 2 * math.pi * jnp.arange(L, dtype=f32)[:, None] / L
    fr = jnp.linspace(1e-4, bands - 1, bands, dtype=f32)[None, :]
    z = jnp.concatenate([t, jnp.cos(fr * w), -jnp.sin(fr * w)], axis=-1)
    fq = freq.astype(f32)
    hdn = jnp.sin(fq * (z @ f_w1.astype(f32) + f_b1.astype(f32)))
    hdn = jnp.sin(fq * (hdn @ f_w2.astype(f32) + f_b2.astype(f32)))
    hdn = jnp.sin(fq * (hdn @ f_w3.astype(f32) + f_b3.astype(f32)))
    filt = (hdn @ f_wout.astype(f32)).reshape(L, 2, D_MODEL)
    deltas = jnp.linspace(math.log(HYENA_TARGET) / HYENA_SLOW_DECAY,
                          math.log(HYENA_TARGET) / HYENA_FAST_DECAY, D_MODEL, dtype=f32)
    filt = filt * jnp.exp(-t * jnp.abs(deltas))[:, None, :]
    h_fwd, h_bwd = filt[:, 0], filt[:, 1]
    return jnp.concatenate([h_fwd, jnp.zeros((1, D_MODEL), f32), h_bwd[:0:-1]], axis=0)


def _hyena(h, w_in, conv_w, conv_b, f_w1, f_b1, f_w2, f_b2, f_w3, f_b3, freq, f_wout, fbias, w_out):
    B, L, _ = h.shape
    u = _centred_conv3(h @ w_in, conv_w, conv_b)
    x0, x1, v = jnp.split(u, 3, axis=-1)
    z = (v * x1).astype(jnp.float32)
    h_circ = _hyena_filter(L, f_w1, f_b1, f_w2, f_b2, f_w3, f_b3, freq, f_wout)
    zf = jnp.fft.rfft(z, n=2 * L, axis=1)
    hf = jnp.fft.rfft(h_circ, axis=0)
    y = jnp.fft.irfft(zf * hf[None], n=2 * L, axis=1)[:, :L] + z * fbias.astype(jnp.float32)
    return (y.astype(h.dtype) * x0) @ w_out


def _rwkv_step(S, inp):
    r, w, kk, b, k, v = inp
    sa = jnp.einsum("bhvk,bhk->bhv", S, -kk)
    S = S * w[:, :, None, :] + sa[..., None] * b[:, :, None, :] + v[..., None] * k[:, :, None, :]
    return S, jnp.einsum("bhvk,bhk->bhv", S, r)


def _rwkv_scan(S0, r, w, kk, b, k, v, reverse):
    xs = tuple(jnp.moveaxis(t, 1, 0) for t in (r, w, kk, b, k, v))
    S, ys = lax.scan(_rwkv_step, S0.astype(jnp.float32), xs, reverse=reverse)
    return S, jnp.moveaxis(ys, 0, 1)


def _rwkv(h, s0_fwd, s0_bwd, mu, wr, wk, wv, wo, w0, w1, w2, a0, a1, a2, g1, g2, k_k, k_a, r_k, ln_w, ln_b):
    f32 = jnp.float32
    B, L, D = h.shape
    hp = jnp.pad(h, ((0, 0), (1, 1), (0, 0)))
    xx = 0.5 * (hp[:, :-2] + hp[:, 2:]) - h
    xr, xw, xk, xv, xa, xg = [h + xx * mu[i] for i in range(6)]

    def heads(t):
        return t.astype(f32).reshape(B, L, RWKV_HEADS, RWKV_HEAD_DIM)

    r = heads(xr @ wr)
    k = heads(xk @ wk)
    v = heads(xv @ wv)
    g = jax.nn.sigmoid(xg @ g1) @ g2
    kk = k * k_k.astype(f32).reshape(RWKV_HEADS, RWKV_HEAD_DIM)
    kk = kk * lax.rsqrt(jnp.sum(kk * kk, axis=-1, keepdims=True) + 1e-12)
    k_a_h = k_a.astype(f32).reshape(RWKV_HEADS, RWKV_HEAD_DIM)
    r_k_h = r_k.astype(f32)
    ys, bonuses, finals = [], [], []
    for d, (s0, rev) in enumerate(((s0_fwd, False), (s0_bwd, True))):
        wlog = -jax.nn.softplus(-(w0[d] + jnp.tanh(xw @ w1[d]) @ w2[d])) - 0.5
        decay = heads(jnp.exp(-jnp.exp(wlog.astype(f32))))
        a = heads(jax.nn.sigmoid(a0[d] + (xa @ a1[d]) @ a2[d]))
        kd = k * (1 + (a - 1) * k_a_h)
        s_fin, y_d = _rwkv_scan(s0, r, decay, kk, kk * a, kd, v, rev)
        ys.append(y_d)
        bonuses.append(jnp.sum(r * kd * r_k_h, axis=-1, keepdims=True) * v)
        finals.append(s_fin)
    y = ys[0] + ys[1]
    mean = jnp.mean(y, axis=-1, keepdims=True)
    var = jnp.mean(jnp.square(y - mean), axis=-1, keepdims=True)
    yn = ((y - mean) * lax.rsqrt(var + RWKV_GN_EPS)).reshape(B, L, D) * ln_w.astype(f32) + ln_b.astype(f32)
    out = (yn + (bonuses[0] + bonuses[1]).reshape(B, L, D)).astype(h.dtype) * g
    return out @ wo, jnp.stack(finals, axis=1).astype(h.dtype)


def setup_inputs(seed: int = 0) -> dict:
    key = jax.random.key(seed)
    keys = jax.random.split(key, 64)
    counter = iter(range(64))
    f32 = jnp.float32

    def nrm(shape, scale=1.0):
        return scale * jax.random.normal(keys[next(counter)], shape, f32)

    D = D_MODEL
    QD = ATTN_HEADS * ATTN_HEAD_DIM
    QKV = (ATTN_HEADS + 2 * ATTN_KV_HEADS) * ATTN_HEAD_DIM
    HF = HYENA_FILTER_WIDTH
    w0_base = jnp.linspace(-6.0, -0.5, D, dtype=f32)
    return {
        "x_prompt": nrm((BATCH, SEQ, D)),
        "x_sample": nrm((DEC_BATCH, DEC_SEQ, D)),
        "cache_attn_k": nrm((DEC_BATCH, N_ATTN, PAST_LEN, ATTN_KV_HEADS, ATTN_HEAD_DIM)),
        "cache_attn_v": nrm((DEC_BATCH, N_ATTN, PAST_LEN, ATTN_KV_HEADS, ATTN_HEAD_DIM)),
        "state_rwkv": nrm((DEC_BATCH, N_RWKV, 2, RWKV_HEADS, RWKV_HEAD_DIM, RWKV_HEAD_DIM), 0.3),
        "c": nrm((DEC_BATCH, D)),
        "c_ctx": nrm((D,)),
        "ada_w": nrm((DEPTH, D, 6 * D), 0.5 * D ** -0.5),
        "ada_b": nrm((DEPTH, 6 * D), 0.01),
        "norm1_g": 1.0 + nrm((DEPTH, D), 0.05),
        "norm2_g": 1.0 + nrm((DEPTH, D), 0.05),
        "mlp_w1": nrm((DEPTH, D, D_FF), D ** -0.5),
        "mlp_w2": nrm((DEPTH, D_FF, D), D_FF ** -0.5),
        "attn_wqkv": nrm((N_ATTN, D, QKV), D ** -0.5),
        "attn_wo": nrm((N_ATTN, QD, D), QD ** -0.5),
        "attn_sink": nrm((N_ATTN, ATTN_HEADS), 0.5),
        "hy_w_in": nrm((N_HYENA, D, 3 * D), D ** -0.5),
        "hy_conv_w": nrm((N_HYENA, 3, 3 * D), 3 ** -0.5),
        "hy_conv_b": nrm((N_HYENA, 3 * D), 0.01),
        "hy_f_w1": nrm((N_HYENA, HYENA_EMB, HF), 1.0),
        "hy_f_b1": nrm((N_HYENA, HF), 0.1),
        "hy_f_w2": nrm((N_HYENA, HF, HF), HF ** -0.5),
        "hy_f_b2": nrm((N_HYENA, HF), 0.1),
        "hy_f_w3": nrm((N_HYENA, HF, HF), HF ** -0.5),
        "hy_f_b3": nrm((N_HYENA, HF), 0.1),
        "hy_f_freq": 1.0 + nrm((N_HYENA, HF), 0.05),
        "hy_f_wout": nrm((N_HYENA, HF, 2 * D), 0.02 * HF ** -0.5),
        "hy_bias": nrm((N_HYENA, D), 0.1),
        "hy_w_out": nrm((N_HYENA, D, D), D ** -0.5),
        "rw_mu": 0.5 + nrm((N_RWKV, 6, D), 0.1),
        "rw_wr": nrm((N_RWKV, D, D), D ** -0.5),
        "rw_wk": nrm((N_RWKV, D, D), D ** -0.5),
        "rw_wv": nrm((N_RWKV, D, D), D ** -0.5),
        "rw_wo": nrm((N_RWKV, D, D), D ** -0.5),
        "rw_w0": w0_base + nrm((N_RWKV, 2, D), 0.1),
        "rw_w1": nrm((N_RWKV, 2, D, RWKV_DECAY_LORA), D ** -0.5),
        "rw_w2": nrm((N_RWKV, 2, RWKV_DECAY_LORA, D), 0.1 * RWKV_DECAY_LORA ** -0.5),
        "rw_a0": nrm((N_RWKV, 2, D), 0.1),
        "rw_a1": nrm((N_RWKV, 2, D, RWKV_A_LORA), D ** -0.5),
        "rw_a2": nrm((N_RWKV, 2, RWKV_A_LORA, D), 0.5 * RWKV_A_LORA ** -0.5),
        "rw_g1": nrm((N_RWKV, D, RWKV_GATE_LORA), D ** -0.5),
        "rw_g2": nrm((N_RWKV, RWKV_GATE_LORA, D), RWKV_GATE_LORA ** -0.5),
        "rw_k_k": 0.85 + nrm((N_RWKV, D), 0.02),
        "rw_k_a": 1.0 + nrm((N_RWKV, D), 0.02),
        "rw_r_k": nrm((N_RWKV, RWKV_HEADS, RWKV_HEAD_DIM), 0.1),
        "rw_ln_w": 1.0 + nrm((N_RWKV, D), 0.05),
        "rw_ln_b": nrm((N_RWKV, D), 0.01),
        "final_norm_g": 1.0 + nrm((D,), 0.05),
    }


def reference(x_prompt, x_sample, cache_attn_k, cache_attn_v, state_rwkv, c, c_ctx,
              ada_w, ada_b, norm1_g, norm2_g, mlp_w1, mlp_w2,
              attn_wqkv, attn_wo, attn_sink,
              hy_w_in, hy_conv_w, hy_conv_b, hy_f_w1, hy_f_b1, hy_f_w2, hy_f_b2, hy_f_w3, hy_f_b3,
              hy_f_freq, hy_f_wout, hy_bias, hy_w_out,
              rw_mu, rw_wr, rw_wk, rw_wv, rw_wo, rw_w0, rw_w1, rw_w2, rw_a0, rw_a1, rw_a2,
              rw_g1, rw_g2, rw_k_k, rw_k_a, rw_r_k, rw_ln_w, rw_ln_b,
              final_norm_g):
    xp = x_prompt
    xs = x_sample
    new_k, new_v, new_s = [], [], []
    cond_ctx = c_ctx[None, :]
    for i in range(DEPTH):
        kind = i % N_MIXERS
        j = i // N_MIXERS
        sh1p, sc1p, gt1p, sh2p, sc2p, gt2p = _ada(cond_ctx, ada_w[i], ada_b[i])
        sh1s, sc1s, gt1s, sh2s, sc2s, gt2s = _ada(c, ada_w[i], ada_b[i])
        hp = _modulate(_rmsnorm(xp, norm1_g[i]), sh1p, sc1p)
        hs = _modulate(_rmsnorm(xs, norm1_g[i]), sh1s, sc1s)
        if kind == 0:
            op, kc, vc = _attn_context(hp, attn_wqkv[j], attn_wo[j], attn_sink[j])
            os_ = _attn_latent(hs, cache_attn_k[:, j], cache_attn_v[:, j], attn_wqkv[j], attn_wo[j], attn_sink[j])
            new_k.append(kc)
            new_v.append(vc)
        elif kind == 1:
            hy = (hy_w_in[j], hy_conv_w[j], hy_conv_b[j], hy_f_w1[j], hy_f_b1[j], hy_f_w2[j], hy_f_b2[j],
                  hy_f_w3[j], hy_f_b3[j], hy_f_freq[j], hy_f_wout[j], hy_bias[j], hy_w_out[j])
            op = _hyena(hp, *hy)
            os_ = _hyena(hs, *hy)
        else:
            rw = (rw_mu[j], rw_wr[j], rw_wk[j], rw_wv[j], rw_wo[j], rw_w0[j], rw_w1[j], rw_w2[j],
                  rw_a0[j], rw_a1[j], rw_a2[j], rw_g1[j], rw_g2[j], rw_k_k[j], rw_k_a[j], rw_r_k[j],
                  rw_ln_w[j], rw_ln_b[j])
            zeros = jnp.zeros((xp.shape[0], RWKV_HEADS, RWKV_HEAD_DIM, RWKV_HEAD_DIM), jnp.float32)
            op, st = _rwkv(hp, zeros, zeros, *rw)
            os_, _ = _rwkv(hs, state_rwkv[:, j, 0], state_rwkv[:, j, 1], *rw)
            new_s.append(st)
        xp = xp + gt1p * op
        xs = xs + gt1s * os_
        hp = _modulate(_rmsnorm(xp, norm2_g[i]), sh2p, sc2p)
        hs = _modulate(_rmsnorm(xs, norm2_g[i]), sh2s, sc2s)
        xp = xp + gt2p * _mlp(hp, mlp_w1[i], mlp_w2[i])
        xs = xs + gt2s * _mlp(hs, mlp_w1[i], mlp_w2[i])
    y_prompt = _rmsnorm(xp, final_norm_g)
    y_sample = _rmsnorm(xs, final_norm_g)
    new_attn_k = jnp.stack(new_k, axis=1)
    new_attn_v = jnp.stack(new_v, axis=1)
    new_rwkv_state = jnp.stack(new_s, axis=1)
    return (y_prompt, y_sample, new_attn_k, new_attn_v, new_rwkv_state)
```

```cpp
#include <hip/hip_runtime.h>
#include <cstdio>
#include <cstdint>
namespace pg8 {
#define PG8_LAS __attribute__((address_space(3)))
typedef unsigned short bf16_t;
typedef short bf16x8 __attribute__((ext_vector_type(8)));
typedef float f32x4 __attribute__((ext_vector_type(4)));
typedef unsigned u32x4 __attribute__((ext_vector_type(4)));
constexpr int BM = 256, BK = 64, HALF = 128, HTB = HALF * BK * 2  , STAGE_BYTES = 8 * HTB, NXCD = 8, WGM = 8;

__host__ __device__ __forceinline__ int lds_byte(int r, int c) { const int st = (r >> 4) * 2 + (c >> 5), rr = r & 15, cc = c & 31, ob = rr * 64 + cc * 2; return st * 1024 + (ob ^ (((ob >> 9) & 1) << 5)); }
__host__ __device__ __forceinline__ void stage_rc(int b, int& R, int& C) { const int st = b / 1024, sb = b % 1024, swz = sb ^ (((sb >> 9) & 1) << 5); R = (st >> 1) * 16 + swz / 64; C = (st & 1) * 32 + (swz % 64) / 2; }
__host__ __device__ __forceinline__ int perm32(int rho) { const int n = rho >> 4, i = rho & 15; return 8 * (i >> 2) + 4 * n + (i & 3); }

struct Unit { int pm, pn; };
struct Gemm { const bf16_t* A; const bf16_t* Bt; int M, N, K; };

struct StaticOrder {
    int nM, nN, nwg, G, c;
    __host__ __device__ void init(int M, int N, int G_, int c_) { nM = M / BM; nN = N / BM; nwg = nM * nN; G = G_; c = c_; }
    __host__ __device__ bool next(int i, Unit& u) const {
        const long L = (long)i * G + c; if (L >= nwg) return false;
        int wgid = (int)L; { const int q = nwg / NXCD, r = nwg % NXCD, xcd = wgid % NXCD, off = wgid / NXCD; wgid = (xcd < r ? xcd * (q + 1) : r * (q + 1) + (xcd - r) * q) + off; }
        const int nig = WGM * nN, gid = wgid / nig, fm = gid * WGM, gsz = (nM - fm) < WGM ? (nM - fm) : WGM;
        u.pm = fm + ((wgid % nig) % gsz); u.pn = (wgid % nig) / gsz; return true;
    }
    __device__ __forceinline__ void a_ready(const Unit&) const {}
    __device__ __forceinline__ void done(const Unit&) const {}
};

template <class Epi, class Sched, bool STAMP = false>
__device__ __forceinline__ void gemm_phase(PG8_LAS unsigned char* lds, const Gemm g, const Sched& S, const Epi& E, unsigned long long* stamps) {
    const int tid = threadIdx.x, wid = __builtin_amdgcn_readfirstlane(tid >> 6), lane = tid & 63, wr = wid >> 2, wc = wid & 3, fr = lane & 15, fq = lane >> 4;
    const int K = g.K, nt = K / BK;
    int ts_lo = 0, ts_hi = 0, nts = 0; const unsigned long long rt_entry = STAMP ? (unsigned long long)wall_clock64() : 0ull;
#define PG8_STAMP() do { if (STAMP && wid == 0 && nts < 64) { const unsigned long long _c = (unsigned long long)clock64(); \
        ts_lo = (lane == nts) ? (int)(unsigned)_c : ts_lo; ts_hi = (lane == nts) ? (int)(unsigned)(_c >> 32) : ts_hi; ++nts; } } while (0)
    PG8_STAMP();
    unsigned voffA[2], voffB[2];
#pragma unroll
    for (int i = 0; i < 2; ++i) { int R, C; stage_rc(tid * 16 + i * 8192, R, C); const int Rb = Epi::PERM ? ((R & ~31) + perm32(R & 31)) : R;
        voffA[i] = (unsigned)(R * K + C) * 2u; voffB[i] = (unsigned)(Rb * K + C) * 2u; }
    const size_t kstep = (size_t)(BK * 2);
    const size_t hstep = (size_t)HALF * K * 2;
    const size_t tstep = 2 * hstep;
    const unsigned ldsw = (unsigned)wid * 1024u;
    const int aoff = lds_byte(wr * 64 + fr, fq * 8), boff = lds_byte(wc * 32 + fr, fq * 8);
#define PG8_SA(b, h) (((b) * 2 + (h)) * HTB)
#define PG8_SB(b, h) ((4 + (b) * 2 + (h)) * HTB)
#define PG8_STAGE(bufoff, gbase, voff) do { _Pragma("unroll") for (int _i = 0; _i < 2; ++_i) \
        __builtin_amdgcn_global_load_lds((const unsigned*)((const char*)(gbase) + (voff)[_i]), (PG8_LAS unsigned*)(lds + (bufoff) + ldsw + _i * 8192), 16, 0, 0); } while (0)
#define PG8_LDA(dst, b, h) do { _Pragma("unroll") for (int m = 0; m < 4; ++m) _Pragma("unroll") for (int k = 0; k < 2; ++k) dst[m][k] = *(const PG8_LAS bf16x8*)(lds + PG8_SA(b, h) + aoff + m * 2048 + k * 1024); } while (0)
#define PG8_LDB(dst, b, h) do { _Pragma("unroll") for (int n = 0; n < 2; ++n) _Pragma("unroll") for (int k = 0; k < 2; ++k) dst[n][k] = *(const PG8_LAS bf16x8*)(lds + PG8_SB(b, h) + boff + n * 2048 + k * 1024); } while (0)
#define PG8_MMA(ai, bj, At, Bt) do { __builtin_amdgcn_s_setprio(1); _Pragma("unroll") for (int k = 0; k < 2; ++k) _Pragma("unroll") for (int m = 0; m < 4; ++m) _Pragma("unroll") for (int n = 0; n < 2; ++n) \
        asm volatile("v_mfma_f32_16x16x32_bf16 %0, %1, %2, %0" : "+v"(acc[ai][bj][m][n]) : "v"(Bt[n][k]), "v"(At[m][k])); __builtin_amdgcn_s_setprio(0); } while (0)
#define PG8_ACC_FENCE1(ai, bj) asm volatile("s_nop 15\n\ts_nop 15" : "+v"(acc[ai][bj][0][0]), "+v"(acc[ai][bj][0][1]), "+v"(acc[ai][bj][1][0]), "+v"(acc[ai][bj][1][1]), "+v"(acc[ai][bj][2][0]), "+v"(acc[ai][bj][2][1]), "+v"(acc[ai][bj][3][0]), "+v"(acc[ai][bj][3][1]))
#define PG8_ACC_FENCE() do { PG8_ACC_FENCE1(0, 0); PG8_ACC_FENCE1(0, 1); PG8_ACC_FENCE1(1, 0); PG8_ACC_FENCE1(1, 1); } while (0)
#define PG8_WAIT_V(n) asm volatile("s_waitcnt vmcnt(" #n ")" ::: "memory")
#define PG8_WAIT_L(n) asm volatile("s_waitcnt lgkmcnt(" #n ")" ::: "memory")
#define PG8_BAR __builtin_amdgcn_s_barrier()
#define PG8_SCHED __builtin_amdgcn_sched_barrier(0)
    Unit cur, nxt; int ui = 0;
    if (!S.next(0, cur)) return;
    f32x4 acc[2][2][4][2];
#pragma unroll
    for (int a = 0; a < 2; ++a)
#pragma unroll
        for (int b = 0; b < 2; ++b)
#pragma unroll
            for (int m = 0; m < 4; ++m)
#pragma unroll
                for (int n = 0; n < 2; ++n) acc[a][b][m][n] = (f32x4){0.f, 0.f, 0.f, 0.f};
    bf16x8 At[4][2], B0[2][2], B1[2][2];
    const char* cA = (const char*)g.A + (size_t)cur.pm * tstep; const char* cB = (const char*)g.Bt + (size_t)cur.pn * tstep;
    S.a_ready(cur);
    PG8_STAGE(PG8_SB(0, 0), cB, voffB); PG8_STAGE(PG8_SA(0, 0), cA, voffA); PG8_STAGE(PG8_SB(0, 1), cB + hstep, voffB); PG8_STAGE(PG8_SA(0, 1), cA + hstep, voffA);
    if (wr == 1) PG8_BAR;
    PG8_WAIT_V(4); PG8_BAR;
    PG8_STAGE(PG8_SB(1, 0), cB + kstep, voffB); PG8_STAGE(PG8_SA(1, 0), cA + kstep, voffA); PG8_STAGE(PG8_SB(1, 1), cB + hstep + kstep, voffB);
    PG8_WAIT_V(6); PG8_BAR;
    PG8_STAMP();
    for (;;) {
        const bool has_next = S.next(ui + 1, nxt);
        const char* nA = has_next ? (const char*)g.A + (size_t)nxt.pm * tstep : cA; const char* nB = has_next ? (const char*)g.Bt + (size_t)nxt.pn * tstep : cB;
        for (int t = 0; t < nt; t += 2) {
            const bool last = (t == nt - 2);
            const char* a1 = cA + (size_t)(t + 1) * kstep;
            const char* a2 = last ? nA : cA + (size_t)(t + 2) * kstep; const char* b2 = last ? nB : cB + (size_t)(t + 2) * kstep;
            const char* a3 = a2 + kstep; const char* b3 = b2 + kstep;
            if (last && has_next) S.a_ready(nxt);
            PG8_LDB(B0, 0, 0); PG8_SCHED; PG8_LDA(At, 0, 0); PG8_STAGE(PG8_SA(1, 1), a1 + hstep, voffA);
            PG8_WAIT_L(8); PG8_BAR; PG8_WAIT_L(0); PG8_MMA(0, 0, At, B0); PG8_BAR; PG8_SCHED;
            PG8_LDB(B1, 0, 1); PG8_STAGE(PG8_SB(0, 0), b2, voffB);
            PG8_BAR; PG8_WAIT_L(0); PG8_MMA(0, 1, At, B1); PG8_BAR;
            PG8_LDA(At, 0, 1); PG8_STAGE(PG8_SA(0, 0), a2, voffA);
            PG8_BAR; PG8_WAIT_L(0); PG8_MMA(1, 0, At, B0); PG8_BAR; PG8_SCHED;
            PG8_STAGE(PG8_SB(0, 1), b2 + hstep, voffB);
            PG8_WAIT_V(6); PG8_BAR; PG8_MMA(1, 1, At, B1); PG8_BAR;
            PG8_LDB(B0, 1, 0); PG8_SCHED; PG8_LDA(At, 1, 0); PG8_STAGE(PG8_SA(0, 1), a2 + hstep, voffA);
            PG8_WAIT_L(8); PG8_BAR; PG8_WAIT_L(0); PG8_MMA(0, 0, At, B0); PG8_BAR; PG8_SCHED;
            PG8_LDB(B1, 1, 1); PG8_STAGE(PG8_SB(1, 0), b3, voffB);
            PG8_BAR; PG8_WAIT_L(0); PG8_MMA(0, 1, At, B1); PG8_BAR;
            PG8_LDA(At, 1, 1); PG8_STAGE(PG8_SA(1, 0), a3, voffA);
            PG8_BAR; PG8_WAIT_L(0); PG8_MMA(1, 0, At, B0); PG8_BAR; PG8_SCHED;
            PG8_STAGE(PG8_SB(1, 1), b3 + hstep, voffB);
            PG8_WAIT_V(6); PG8_BAR; PG8_MMA(1, 1, At, B1); PG8_BAR;
        }
        PG8_STAMP();
        PG8_ACC_FENCE();
        if constexpr (!Epi::AFTER_DRAIN) { E(acc, cur, wr, wc, fr, fq); S.done(cur); }
        PG8_STAMP();
        if (!has_next) break;
#pragma unroll
        for (int a = 0; a < 2; ++a)
#pragma unroll
            for (int b = 0; b < 2; ++b)
#pragma unroll
                for (int m = 0; m < 4; ++m)
#pragma unroll
                    for (int n = 0; n < 2; ++n) acc[a][b][m][n] = (f32x4){0.f, 0.f, 0.f, 0.f};
        cur = nxt; cA = nA; cB = nB; ++ui;
    }
    PG8_WAIT_V(0);
    if (wr == 0) PG8_BAR;
    PG8_BAR;
    if constexpr (Epi::AFTER_DRAIN) { E.fused(acc, cur, wr, wc, fr, fq, lds, wid, lane); S.done(cur); }
    PG8_STAMP();
    if (STAMP && wid == 0) { stamps[lane] = lane < nts ? (((unsigned long long)(unsigned)ts_hi << 32) | (unsigned)ts_lo) : 0ull;
        if (lane == 62) stamps[62] = rt_entry; if (lane == 63) stamps[63] = (unsigned long long)wall_clock64(); }
#undef PG8_STAMP
#undef PG8_SA
#undef PG8_SB
#undef PG8_STAGE
#undef PG8_LDA
#undef PG8_LDB
#undef PG8_MMA
#undef PG8_ACC_FENCE
#undef PG8_ACC_FENCE1
#undef PG8_WAIT_V
#undef PG8_WAIT_L
#undef PG8_BAR
#undef PG8_SCHED
}
}

#define XB_TMO      128
#define XB_XCNT(j)  (256  + 64 * (j))
#define XB_XSUB(j)  (1280 + 64 * (j))
#define XB_XGEN(j)  (2304 + 64 * (j))
#define XB_TOP      3328
#define XB_TOPGEN   3392
#define XCD_BAR_WORDS 3456
#define XB_SPIN_CAP (1u << 20)
#define LAS __attribute__((address_space(3)))

__device__ __forceinline__ unsigned xb_ld(unsigned* p)              { return __hip_atomic_load(p, __ATOMIC_RELAXED, __HIP_MEMORY_SCOPE_AGENT); }
__device__ __forceinline__ unsigned xb_add(unsigned* p, unsigned v) { return __hip_atomic_fetch_add(p, v, __ATOMIC_RELAXED, __HIP_MEMORY_SCOPE_AGENT); }
__device__ __forceinline__ unsigned xb_xcc_id() { return (unsigned)__builtin_amdgcn_s_getreg((3 << 11) | 20) & 0xFu; }
#define XB_SPIN(cond, bar) do { unsigned _sp = 0; while (cond) { __builtin_amdgcn_s_sleep(1); \
    if ((++_sp & 255u) == 0u) { if (xb_ld(&(bar)[XB_TMO])) break; if (_sp > XB_SPIN_CAP) { atomicAdd(&(bar)[XB_TMO], 1u); break; } } } } while (0)

struct XcdBarrier {
    unsigned* bar; unsigned x;
    volatile LAS unsigned* st;
};

__device__ __forceinline__ XcdBarrier xcd_barrier_post(unsigned* bar, volatile LAS unsigned* st) {
    XcdBarrier b; b.bar = bar; b.x = xb_xcc_id(); b.st = st;
    if (threadIdx.x == 0) (void)xb_add(&bar[XB_XCNT(b.x)], 1u);
    return b;
}
__device__ __forceinline__ void xcd_barrier_complete(unsigned* bar, unsigned x, unsigned& nloc, unsigned& nx) {
    const unsigned G = gridDim.x * gridDim.y * gridDim.z;
    unsigned sum, cnt, mine, sp = 0u;
    for (;;) {
        sum = 0u; cnt = 0u; mine = 0u;
#pragma unroll
        for (unsigned j = 0; j < 16; ++j) { const unsigned c = xb_ld(&bar[XB_XCNT(j)]); sum += c; cnt += (c > 0u) ? 1u : 0u; mine = (j == x) ? c : mine; }
        if (sum == G) break;
        __builtin_amdgcn_s_sleep(1);
        if ((++sp & 255u) == 0u) { if (xb_ld(&bar[XB_TMO])) break; if (sp > XB_SPIN_CAP) { atomicAdd(&bar[XB_TMO], 1u); break; } }
    }
    nloc = mine > 0u ? mine : 1u; nx = cnt > 0u ? cnt : 1u;
}

__device__ __forceinline__ void xcd_barrier(const XcdBarrier& b) {
    asm volatile("s_waitcnt vmcnt(0)" ::: "memory");
    __syncthreads();
    if (threadIdx.x == 0) {
        unsigned* bar = b.bar;
        __builtin_amdgcn_s_waitcnt(0);
        unsigned nloc = b.st[0], nx = b.st[1];
        if (nloc == 0u) { xcd_barrier_complete(bar, b.x, nloc, nx); b.st[0] = nloc; b.st[1] = nx; }
        const unsigned old = xb_add(&bar[XB_XSUB(b.x)], 1u);
        const unsigned gen = old / nloc;
        if (old + 1u == (gen + 1u) * nloc) {
            __builtin_amdgcn_fence(__ATOMIC_RELEASE, "agent");
            asm volatile("s_waitcnt vmcnt(0)" ::: "memory");
            const unsigned og = xb_add(&bar[XB_TOP], 1u);
            const unsigned tg = og / nx;
            if (og + 1u == (tg + 1u) * nx) xb_add(&bar[XB_TOPGEN], 1u);
            else XB_SPIN(xb_ld(&bar[XB_TOPGEN]) == tg, bar);
            __builtin_amdgcn_fence(__ATOMIC_ACQUIRE, "agent");
            xb_add(&bar[XB_XGEN(b.x)], 1u);
            asm volatile("s_waitcnt vmcnt(0)" ::: "memory");
        } else {
            XB_SPIN(xb_ld(&bar[XB_XGEN(b.x)]) == gen, bar);
            __builtin_amdgcn_fence(__ATOMIC_ACQUIRE, "agent");
            asm volatile("s_waitcnt vmcnt(0)" ::: "memory");
        }
    }
    __syncthreads();
}

typedef unsigned short bf16_t;
typedef short bf16x8 __attribute__((ext_vector_type(8)));
typedef short bf16x4 __attribute__((ext_vector_type(4)));
typedef float f32x2 __attribute__((ext_vector_type(2)));
typedef float f32x4 __attribute__((ext_vector_type(4)));
typedef float f32x16 __attribute__((ext_vector_type(16)));
typedef unsigned u32x4 __attribute__((ext_vector_type(4)));
typedef unsigned u32x2 __attribute__((ext_vector_type(2)));

constexpr int D = 2048, FF = 8192, MP = 4096, MS = 8192, MT = 12288;
constexpr int NPANEL = MT / 256;
constexpr size_t MiB = 1u << 20;
constexpr size_t WS_CTL = 0, WS_MOD = 1 * MiB, WS_ZERO_BYTES = 3 * MiB;
constexpr size_t WS_ROPE = 3 * MiB;
constexpr size_t WS_W1T = 4 * MiB, WS_W2T = 132 * MiB, WS_WQKVT = 260 * MiB, WS_WOT = 284 * MiB, WS_HYINT = 300 * MiB, WS_HYOUTT = 324 * MiB;
constexpr size_t WS_RWBT = 332 * MiB, WS_LORA2T = 359 * MiB, WS_RWOT = 364 * MiB, WS_KC = 372 * MiB, WS_VC = 380 * MiB, WS_FGS = 388 * MiB, WS_FGP = 397 * MiB;
constexpr size_t WS_X = 400 * MiB, WS_H = 496 * MiB, WS_ARENA = 544 * MiB, WS_END = 1186 * MiB;
constexpr size_t AR_U = 0;
constexpr size_t AR_Q = 0, AR_K = 48 * MiB, AR_V = 60 * MiB, AR_O = 72 * MiB;
constexpr size_t AR_P = 0, AR_X0 = 144 * MiB, AR_ZT = 192 * MiB, AR_YT = 240 * MiB, AR_HO = 288 * MiB;
constexpr size_t AR_XMIX = 0, AR_LD = 0, AR_LA = 96 * MiB, AR_G = 192 * MiB, AR_RO = 240 * MiB, AR_R = 288 * MiB, AR_KK = 336 * MiB, AR_VV = 384 * MiB, AR_A3 = 432 * MiB, AR_YB = 450 * MiB;
constexpr size_t OUT_Y = 0, OUT_NK = 25165824, OUT_NV = 29360128, OUT_ST = 33554432;
constexpr int FGS_ROW = 2112, FGP_ROW = 576;
constexpr size_t AR_FILT = 600 * MiB;
constexpr int LDS_BAR_OFF = 131072, LDS_BYTES = 131072 + 1024;

enum { I_XP = 0, I_XS, I_CK, I_CV, I_ST, I_C, I_CCTX, I_ADAW, I_ADAB, I_N1G, I_N2G, I_MW1, I_MW2, I_WQKV, I_WO, I_SINK, I_HYWIN, I_HYCW, I_HYCB, I_FW1, I_FB1, I_FW2, I_FB2, I_FW3, I_FB3,
       I_FREQ, I_FWOUT, I_HYBIAS, I_HYWOUT, I_MU, I_WR, I_WK, I_WV, I_RWO, I_W0, I_W1, I_W2, I_A0, I_A1, I_A2, I_G1, I_G2, I_KK, I_KA, I_RK, I_LNW, I_LNB, I_FNG, N_IN };

struct Params { const float* in[N_IN]; float* out; unsigned char* ws; int ph_lo, ph_hi; };

__device__ __forceinline__ unsigned cvt_pk(float lo, float hi) { unsigned r; asm("v_cvt_pk_bf16_f32 %0, %1, %2" : "=v"(r) : "v"(lo), "v"(hi)); return r; }
__device__ __forceinline__ float bflo(unsigned w) { return __uint_as_float(w << 16); }
__device__ __forceinline__ float bfhi(unsigned w) { return __uint_as_float(w & 0xffff0000u); }
__device__ __forceinline__ float bf2f(bf16_t b) { return __uint_as_float(((unsigned)b) << 16); }
__device__ __forceinline__ float wave_sum(float v) {
#pragma unroll
    for (int o = 1; o < 64; o <<= 1) v += __shfl_xor(v, o);
    return v;
}
__device__ __forceinline__ float opaque_zero() { float z; asm volatile("v_mov_b32 %0, 0" : "=v"(z)); return z; }
__device__ __forceinline__ float fexp2(float x) { return __builtin_amdgcn_exp2f(x); }
__device__ __forceinline__ float fexp(float x) { return __builtin_amdgcn_exp2f(x * 1.4426950408889634f); }
__device__ __forceinline__ float flog(float x) { return __builtin_amdgcn_logf(x) * 0.6931471805599453f; }
__device__ __forceinline__ float frcp(float x) { return __builtin_amdgcn_rcpf(x); }
__device__ __forceinline__ float fsigmoid(float x) { return frcp(1.0f + fexp(-x)); }
__device__ __forceinline__ float ftanh(float x) { const float e = fexp(2.0f * x); return 1.0f - 2.0f * frcp(e + 1.0f); }
__device__ __forceinline__ float fsoftplus(float x) { return fmaxf(x, 0.0f) + flog(1.0f + fexp(-fabsf(x))); }
__device__ __forceinline__ float fsin_rev(float rev) { return __builtin_amdgcn_sinf(rev - rintf(rev)); }
__device__ __forceinline__ float fcos_rev(float rev) { return __builtin_amdgcn_cosf(rev - rintf(rev)); }
__device__ __forceinline__ float fsin(float x) { return fsin_rev(x * 0.15915494309189535f); }
__device__ __forceinline__ int cond_of_row(int m) { return m < MP ? 0 : 1 + ((m - MP) >> 10); }
__device__ __forceinline__ int cond_of_panel(int pm) { return pm < 16 ? 0 : 1 + ((pm - 16) >> 2); }

struct Ctx {
    LAS unsigned char* lds;
    int tid, lane, wave, G, bid;
    float* out;
    unsigned char* ws;
};
template <int IDX> __device__ __forceinline__ const float* karg() {
    unsigned long long v;
    asm volatile("s_load_dwordx2 %0, %1, %2\n\ts_waitcnt lgkmcnt(0)" : "=s"(v) : "s"(__builtin_amdgcn_kernarg_segment_ptr()), "n"(IDX * 8));
    return (const float*)v;
}
#define WSP(T, off) ((T*)(C.ws + (off)))
#define MODP(l, cond, which) (WSP(float, WS_MOD) + ((size_t)((l) * 9 + (cond)) * 6 + (which)) * D)

__device__ __forceinline__ void p0_transpose_item(const float* W, int K, int N, bf16_t* WT, LAS float* scr, int item, int lane) {
    const int nblk = N / 32, kb = item / nblk, nb = item % nblk, k0 = 64 * kb, n0 = 32 * nb;
#pragma unroll 8
    for (int i = 0; i < 32; ++i) { const int kk = 2 * i + (lane >> 5); scr[kk * 33 + (lane & 31)] = W[(size_t)(k0 + kk) * N + n0 + (lane & 31)]; }
    asm volatile("s_waitcnt lgkmcnt(0)" ::: "memory");
    const int c = lane & 7;
#pragma unroll
    for (int j = 0; j < 4; ++j) { const int n = (lane >> 3) + 8 * j; const LAS float* s = scr + (8 * c) * 33 + n;
        u32x4 o; o.x = cvt_pk(s[0 * 33], s[1 * 33]); o.y = cvt_pk(s[2 * 33], s[3 * 33]); o.z = cvt_pk(s[4 * 33], s[5 * 33]); o.w = cvt_pk(s[6 * 33], s[7 * 33]);
        *(u32x4*)(WT + (size_t)(n0 + n) * K + k0 + 8 * c) = o; }
    asm volatile("s_waitcnt lgkmcnt(0)" ::: "memory");
}

#ifndef MK_PRO_MASK
#define MK_PRO_MASK 127
#endif
__device__ __forceinline__ void phase_prologue(const Ctx& C) {
    const int gw = C.bid * 8 + C.wave, NGW = C.G * 8, lane = C.lane;
    const size_t gt = (size_t)C.bid * 512 + C.tid, NGT = (size_t)C.G * 512;
    LAS float* scr = (LAS float*)(C.lds + C.wave * 16384);
    if (MK_PRO_MASK & 1)
    {
        constexpr int I_M1 = 8192, I_M2 = 8192, I_QKV = 3072, I_O = 2048, I_HI = 6144, I_SQ = 2048;
        constexpr int NIT = 4 * I_M1 + 4 * I_M2 + 2 * I_QKV + 2 * I_O + I_HI + I_SQ + 4 * I_SQ;
        for (int it = gw; it < NIT; it += NGW) {
            int r = it;
            if (r < 4 * I_M1) { const int l = r / I_M1; p0_transpose_item(karg<I_MW1>() + (size_t)l * D * FF, D, FF, WSP(bf16_t, WS_W1T) + (size_t)l * D * FF, scr, r % I_M1, lane); continue; } r -= 4 * I_M1;
            if (r < 4 * I_M2) { const int l = r / I_M2; p0_transpose_item(karg<I_MW2>() + (size_t)l * D * FF, FF, D, WSP(bf16_t, WS_W2T) + (size_t)l * D * FF, scr, r % I_M2, lane); continue; } r -= 4 * I_M2;
            if (r < 2 * I_QKV) { const int l = r / I_QKV; p0_transpose_item(karg<I_WQKV>() + (size_t)l * D * 3072, D, 3072, WSP(bf16_t, WS_WQKVT) + (size_t)l * D * 3072, scr, r % I_QKV, lane); continue; } r -= 2 * I_QKV;
            if (r < 2 * I_O) { const int l = r / I_O; p0_transpose_item(karg<I_WO>() + (size_t)l * D * D, D, D, WSP(bf16_t, WS_WOT) + (size_t)l * D * D, scr, r % I_O, lane); continue; } r -= 2 * I_O;
            if (r < I_HI) { p0_transpose_item(karg<I_HYWIN>(), D, 6144, WSP(bf16_t, WS_HYINT), scr, r, lane); continue; } r -= I_HI;
            if (r < I_SQ) { p0_transpose_item(karg<I_HYWOUT>(), D, D, WSP(bf16_t, WS_HYOUTT), scr, r, lane); continue; } r -= I_SQ;
            if (r < I_SQ) { p0_transpose_item(karg<I_WR>(), D, D, WSP(bf16_t, WS_RWBT), scr, r, lane); continue; } r -= I_SQ;
            if (r < I_SQ) { p0_transpose_item(karg<I_WK>(), D, D, WSP(bf16_t, WS_RWBT) + (size_t)D * D, scr, r, lane); continue; } r -= I_SQ;
            if (r < I_SQ) { p0_transpose_item(karg<I_WV>(), D, D, WSP(bf16_t, WS_RWBT) + (size_t)2 * D * D, scr, r, lane); continue; } r -= I_SQ;
            p0_transpose_item(karg<I_RWO>(), D, D, WSP(bf16_t, WS_RWOT), scr, r, lane);
        }
    }
    if (MK_PRO_MASK & 2)
    {
        bf16_t* L1 = WSP(bf16_t, WS_RWBT) + (size_t)3 * D * D;
#pragma unroll
        for (int part = 0; part < 7; ++part) {
            const int row0 = part == 0 ? 0 : part == 1 ? 96 : part == 2 ? 192 : part == 3 ? 256 : part == 4 ? 352 : part == 5 ? 448 : 512;
            const int nrow = (part == 2 || part == 5) ? 64 : (part == 6 ? 256 : 96);
            const int ld = part == 6 ? 256 : 96;
            const float* src = part == 0 ? karg<I_W1>() : part == 1 ? karg<I_W1>() + (size_t)D * 96 : part == 3 ? karg<I_A1>() : part == 4 ? karg<I_A1>() + (size_t)D * 96 : karg<I_G1>();
            const bool zero = (part == 2 || part == 5);
            for (size_t i = gt; i < (size_t)nrow * 256; i += NGT) {
                const int rr = (int)(i / 256), k8 = (int)(i % 256);
                float v[8];
#pragma unroll
                for (int j = 0; j < 8; ++j) v[j] = zero ? 0.0f : src[(size_t)(8 * k8 + j) * ld + rr];
                u32x4 o; o.x = cvt_pk(v[0], v[1]); o.y = cvt_pk(v[2], v[3]); o.z = cvt_pk(v[4], v[5]); o.w = cvt_pk(v[6], v[7]);
                *(u32x4*)(L1 + (size_t)(row0 + rr) * D + 8 * k8) = o;
            }
        }
        bf16_t* L2 = WSP(bf16_t, WS_LORA2T);
#pragma unroll
        for (int mat = 0; mat < 5; ++mat) {
            const float* src = mat == 0 ? karg<I_W2>() : mat == 1 ? karg<I_W2>() + (size_t)96 * D : mat == 2 ? karg<I_A2>() : mat == 3 ? karg<I_A2>() + (size_t)96 * D : karg<I_G2>();
            const int kofs = (mat == 1 || mat == 3) ? 96 : 0, klen = mat == 4 ? 256 : 96;
            for (size_t i = gt; i < (size_t)2048 * 32; i += NGT) {
                const int n = (int)(i / 32), k8 = (int)(i % 32);
                float v[8];
#pragma unroll
                for (int j = 0; j < 8; ++j) { const int k = 8 * k8 + j - kofs; const int kc = k < 0 ? 0 : (k >= klen ? klen - 1 : k); const float x = src[(size_t)kc * D + n]; v[j] = (k >= 0 && k < klen) ? x : 0.0f; }
                u32x4 o; o.x = cvt_pk(v[0], v[1]); o.y = cvt_pk(v[2], v[3]); o.z = cvt_pk(v[4], v[5]); o.w = cvt_pk(v[6], v[7]);
                *(u32x4*)(L2 + ((size_t)mat * 2048 + n) * 256 + 8 * k8) = o;
            }
        }
    }
    if (MK_PRO_MASK & 4)
    for (size_t i = gt; i < 2048; i += NGT) {
        const int pos = (int)(i >> 5), fi = (int)(i & 31);
        const float inv = fexp2(-(float)(2 * fi) * (13.287712379549449f / 64.0f));
        const float rev = (float)pos * inv * 0.15915494309189535f;
        WSP(f32x2, WS_ROPE)[i] = (f32x2){fcos_rev(rev), fsin_rev(rev)};
    }
    if (MK_PRO_MASK & 8)
    { const float *ckp = karg<I_CK>(), *cvp = karg<I_CV>();
    for (size_t i = gt; i < (size_t)2 * 524288; i += NGT) {
        const bool isv = i >= 524288; const size_t e = (isv ? i - 524288 : i) * 8;
        const float* src = (isv ? cvp : ckp) + e;
        const f32x4 a = *(const f32x4*)src, b = *(const f32x4*)(src + 4);
        u32x4 o; o.x = cvt_pk(a.x, a.y); o.y = cvt_pk(a.z, a.w); o.z = cvt_pk(b.x, b.y); o.w = cvt_pk(b.z, b.w);
        *(u32x4*)(WSP(bf16_t, isv ? WS_VC : WS_KC) + e) = o;
    } }
    if (MK_PRO_MASK & 16)
    { const float *xpp = karg<I_XP>(), *xsp = karg<I_XS>();
    for (size_t i = gt; i < (size_t)MT * D / 4; i += NGT) {
        const size_t e = i * 4;
        const float* src = e < (size_t)MP * D ? xpp + e : xsp + (e - (size_t)MP * D);
        *(f32x4*)(WSP(float, WS_X) + e) = *(const f32x4*)src;
    } }
    if (MK_PRO_MASK & 32)
    {
        __syncthreads();
        LAS float* tab = (LAS float*)C.lds;
        const float *cctx = karg<I_CCTX>(), *cc = karg<I_C>();
        for (int e = C.tid; e < 9 * D; e += 512) { const int j = e >> 11, k = e & (D - 1);
            const float cv = j == 0 ? cctx[k] : cc[(size_t)(j == 0 ? 0 : j - 1) * D + k]; tab[e] = cv * fsigmoid(cv); }
        __syncthreads();
        for (int it = gw; it < 4 * 192; it += NGW) {
            const int nb = it % 192, l = it / 192;
            float acc[9];
#pragma unroll
            for (int j = 0; j < 9; ++j) acc[j] = 0.f;
            const float* wp = karg<I_ADAW>() + (size_t)l * D * (6 * D) + nb * 64 + lane;
#pragma unroll 2
            for (int k4 = 0; k4 < D; k4 += 4) {
                const float w0 = wp[(size_t)(k4 + 0) * (6 * D)], w1 = wp[(size_t)(k4 + 1) * (6 * D)], w2 = wp[(size_t)(k4 + 2) * (6 * D)], w3 = wp[(size_t)(k4 + 3) * (6 * D)];
#pragma unroll
                for (int j = 0; j < 9; ++j) { const f32x4 sv = *(const LAS f32x4*)(tab + j * D + k4); acc[j] += (w0 * sv.x + w1 * sv.y) + (w2 * sv.z + w3 * sv.w); }
            }
            const float bv = karg<I_ADAB>()[(size_t)l * 6 * D + nb * 64 + lane];
            float* mo = WSP(float, WS_MOD) + (size_t)l * 9 * 6 * D + nb * 64 + lane;
#pragma unroll
            for (int j = 0; j < 9; ++j) mo[(size_t)j * 6 * D] = acc[j] + bv;
        }
        __syncthreads();
    }
    if (MK_PRO_MASK & 64)
    {
        for (int it = gw; it < 1280; it += NGW) {
            const bool smp = it >= 256; const int n = smp ? it - 256 : it; const int L = smp ? 1024 : 256; const int ROW = smp ? FGS_ROW : FGP_ROW;
            float* FILT = WSP(float, WS_ARENA + AR_FILT) + (smp ? 0 : (size_t)1024 * 4096);
            const float* hbias = karg<I_HYBIAS>();
            const float tn = (float)n / (float)(L - 1);
            if (lane < 33) {
                float z;
                if (lane == 0) z = tn;
                else { const int i = (lane - 1) & 15; const float fr = 1e-4f + (float)i * ((15.0f - 1e-4f) / 15.0f); const float rev = fr * (float)n / (float)L;
                       z = lane <= 16 ? fcos_rev(rev) : -fsin_rev(rev); }
                scr[lane] = z;
            }
            asm volatile("s_waitcnt lgkmcnt(0)" ::: "memory");
            const float fq = karg<I_FREQ>()[lane];
            const float *fw1 = karg<I_FW1>(), *fw2 = karg<I_FW2>(), *fw3 = karg<I_FW3>();
            float pre = karg<I_FB1>()[lane];
#pragma unroll 3
            for (int e = 0; e < 33; ++e) pre += scr[e] * fw1[e * 64 + lane];
            float hv = fsin(fq * pre);
            asm volatile("s_waitcnt lgkmcnt(0)" ::: "memory");
            scr[64 + lane] = hv;
            asm volatile("s_waitcnt lgkmcnt(0)" ::: "memory");
            pre = karg<I_FB2>()[lane];
#pragma unroll 4
            for (int e = 0; e < 64; ++e) pre += scr[64 + e] * fw2[e * 64 + lane];
            hv = fsin(fq * pre);
            asm volatile("s_waitcnt lgkmcnt(0)" ::: "memory");
            scr[128 + lane] = hv;
            asm volatile("s_waitcnt lgkmcnt(0)" ::: "memory");
            pre = karg<I_FB3>()[lane];
#pragma unroll 4
            for (int e = 0; e < 64; ++e) pre += scr[128 + e] * fw3[e * 64 + lane];
            hv = fsin(fq * pre);
            asm volatile("s_waitcnt lgkmcnt(0)" ::: "memory");
            scr[192 + lane] = hv;
            asm volatile("s_waitcnt lgkmcnt(0)" ::: "memory");
#pragma unroll 1
            for (int ob = 0; ob < 8; ++ob) {
                float acc[8];
#pragma unroll
                for (int i = 0; i < 8; ++i) acc[i] = 0.f;
                const float* wo = karg<I_FWOUT>() + ob * 512 + lane;
#pragma unroll 2
                for (int e = 0; e < 64; ++e) { const float hh = scr[192 + e];
#pragma unroll
                    for (int i = 0; i < 8; ++i) acc[i] += hh * wo[(size_t)e * 4096 + i * 64]; }
#pragma unroll
                for (int i = 0; i < 8; ++i) {
                    const int o = ob * 512 + i * 64 + lane, dir = o >> 11, c = o & 2047;
                    const float delta = -3.0701134573253944f + (float)c * ((-15.350567286626972f + 3.0701134573253944f) / 2047.0f);
                    float val = acc[i] * fexp(-tn * fabsf(delta));
                    if (dir == 0 && n == 0) val += hbias[c];
                    FILT[(size_t)n * 4096 + o] = val;
                }
            }
            asm volatile("s_waitcnt lgkmcnt(0)" ::: "memory");
        }
    }
}

__device__ __forceinline__ void phase_fg_transpose(const Ctx& C) {
    const int tid = C.tid;
    LAS float* tl = (LAS float*)C.lds;
    for (int it = C.bid; it < 1280; it += C.G) {
        const bool smp = it < 1024; const int q = smp ? it : it - 1024;
        const int L = smp ? 1024 : 256, ROW = smp ? FGS_ROW : FGP_ROW;
        const int cbk = q & 31, nb = smp ? (q >> 5) & 15 : (q >> 5) & 3, dir = smp ? q >> 9 : q >> 7;
        const float* FILT = WSP(float, WS_ARENA + AR_FILT) + (smp ? 0 : (size_t)1024 * 4096);
        bf16_t* FG = WSP(bf16_t, smp ? WS_FGS : WS_FGP);
        const int n0 = nb * 64 + dir;
        __syncthreads();
        { const int nl = tid >> 3, c8 = tid & 7; const int n = n0 + nl;
          f32x4 a = (f32x4){0.f, 0.f, 0.f, 0.f}, b = a;
          const int nc = n < L ? n : L - 1;
          const float* src = FILT + (size_t)nc * 4096 + dir * 2048 + cbk * 64 + 8 * c8;
          a = *(const f32x4*)src; b = *(const f32x4*)(src + 4);
          if (n >= L) { a = (f32x4){0.f, 0.f, 0.f, 0.f}; b = a; }
          LAS float* d = tl + nl * 65 + 8 * c8;
          d[0] = a.x; d[1] = a.y; d[2] = a.z; d[3] = a.w; d[4] = b.x; d[5] = b.y; d[6] = b.z; d[7] = b.w; }
        __syncthreads();
        { const int cl = tid >> 3, i8 = tid & 7;
          float v[8];
#pragma unroll
          for (int j = 0; j < 8; ++j) { const int il = 8 * i8 + j; const int nl = dir ? il : 63 - il; v[j] = tl[nl * 65 + cl]; }
          const int idx0 = dir ? (L + nb * 64) : (L - 64 - nb * 64);
          u32x4 o; o.x = cvt_pk(v[0], v[1]); o.y = cvt_pk(v[2], v[3]); o.z = cvt_pk(v[4], v[5]); o.w = cvt_pk(v[6], v[7]);
          bf16_t* dst = FG + (size_t)(cbk * 64 + cl) * ROW;
          *(u32x4*)(dst + idx0 + 8 * i8) = o;
          if (dir && nb * 64 + 64 == L) *(u32x4*)(dst + 2 * L + 8 * i8) = (u32x4){0u, 0u, 0u, 0u}; }
    }
    __syncthreads();
}

__device__ __forceinline__ void phase_norm_mod(const Ctx& C, const float* X, const float* g, int layer, int which_sh, bf16_t* H) {
    const int gw = C.bid * 8 + C.wave, NGW = C.G * 8, lane = C.lane;
    for (int m = gw; m < MT; m += NGW) {
        const int cond = cond_of_row(m);
        const float* sh = MODP(layer, cond, which_sh); const float* sc = MODP(layer, cond, which_sh + 1);
        const f32x4* xr = (const f32x4*)(X + (size_t)m * D) + lane;
        f32x4 v[8]; float ss = 0.f;
#pragma unroll
        for (int j = 0; j < 8; ++j) { v[j] = xr[64 * j]; ss += (v[j].x * v[j].x + v[j].y * v[j].y) + (v[j].z * v[j].z + v[j].w * v[j].w); }
        const float rstd = __builtin_amdgcn_rsqf(wave_sum(ss) * (1.0f / D) + 1e-6f);
        u32x2* o = (u32x2*)(H + (size_t)m * D) + lane;
#pragma unroll
        for (int j = 0; j < 8; ++j) {
            const f32x4 gv = ((const f32x4*)g)[lane + 64 * j], sv = ((const f32x4*)sh)[lane + 64 * j], cv = ((const f32x4*)sc)[lane + 64 * j];
            const f32x4 y = (v[j] * rstd * gv) * (cv + 1.0f) + sv;
            u32x2 w; w.x = cvt_pk(y.x, y.y); w.y = cvt_pk(y.z, y.w); o[64 * j] = w;
        }
    }
}
__device__ __forceinline__ void phase_norm_final(const Ctx& C, const float* X, const float* g, float* out) {
    const int gw = C.bid * 8 + C.wave, NGW = C.G * 8, lane = C.lane;
    for (int m = gw; m < MT; m += NGW) {
        const f32x4* xr = (const f32x4*)(X + (size_t)m * D) + lane;
        f32x4 v[8]; float ss = 0.f;
#pragma unroll
        for (int j = 0; j < 8; ++j) { v[j] = xr[64 * j]; ss += (v[j].x * v[j].x + v[j].y * v[j].y) + (v[j].z * v[j].z + v[j].w * v[j].w); }
        const float rstd = __builtin_amdgcn_rsqf(wave_sum(ss) * (1.0f / D) + 1e-6f);
        f32x4* o = (f32x4*)(out + (size_t)m * D) + lane;
#pragma unroll
        for (int j = 0; j < 8; ++j) o[64 * j] = v[j] * rstd * ((const f32x4*)g)[lane + 64 * j];
    }
}

using pg8::Unit;
constexpr int HALF = 128;

struct EpiResidual {
    static constexpr bool PERM = false, AFTER_DRAIN = false;
    float* X; const float* gate_base;
    __device__ __forceinline__ void operator()(const f32x4 (&acc)[2][2][4][2], const Unit& u, int wr, int wc, int fr, int fq) const {
        const int row0 = u.pm * 256 + wr * 64 + fr, col0 = u.pn * 256 + wc * 32 + 4 * fq;
        const float* gp = gate_base + (size_t)cond_of_panel(u.pm) * 6 * D + col0;
        f32x4 gv[2][2];
#pragma unroll
        for (int bj = 0; bj < 2; ++bj)
#pragma unroll
            for (int n = 0; n < 2; ++n) gv[bj][n] = *(const f32x4*)(gp + bj * HALF + n * 16);
#pragma unroll
        for (int ai = 0; ai < 2; ++ai)
#pragma unroll
            for (int m = 0; m < 4; ++m) { float* rowp = X + (size_t)(row0 + ai * HALF + m * 16) * D + col0;
#pragma unroll
                for (int bj = 0; bj < 2; ++bj)
#pragma unroll
                    for (int n = 0; n < 2; ++n) { f32x4* q = (f32x4*)(rowp + bj * HALF + n * 16); *q = *q + gv[bj][n] * acc[ai][bj][m][n]; } }
    }
};
template <int ACT> struct EpiBf16 {
    static constexpr bool PERM = true, AFTER_DRAIN = false;
    bf16_t* O; int ldc;
    __device__ __forceinline__ void operator()(const f32x4 (&acc)[2][2][4][2], const Unit& u, int wr, int wc, int fr, int fq) const {
        const int row0 = u.pm * 256 + wr * 64 + fr, col0 = u.pn * 256 + wc * 32 + 8 * fq;
#pragma unroll
        for (int ai = 0; ai < 2; ++ai)
#pragma unroll
            for (int m = 0; m < 4; ++m) { bf16_t* rowp = O + (size_t)(row0 + ai * HALF + m * 16) * ldc + col0;
#pragma unroll
                for (int bj = 0; bj < 2; ++bj) { f32x4 v0 = acc[ai][bj][m][0], v1 = acc[ai][bj][m][1];
                    if (ACT == 1) {
#pragma unroll
                        for (int j = 0; j < 4; ++j) { const float a = fmaxf(v0[j], 0.f), b = fmaxf(v1[j], 0.f); v0[j] = a * a; v1[j] = b * b; } }
                    u32x4 w; w.x = cvt_pk(v0[0], v0[1]); w.y = cvt_pk(v0[2], v0[3]); w.z = cvt_pk(v1[0], v1[1]); w.w = cvt_pk(v1[2], v1[3]);
                    *(u32x4*)(rowp + bj * HALF) = w; } }
    }
};
struct EpiQKV {
    static constexpr bool PERM = true, AFTER_DRAIN = false;
    bf16_t *Q, *K, *V; float *NK, *NV;
    __device__ __forceinline__ void operator()(const f32x4 (&acc)[2][2][4][2], const Unit& u, int wr, int wc, int fr, int fq) const {
        const int row0 = u.pm * 256 + wr * 64 + fr; const int cin = wc * 32 + 8 * fq;
        bf16_t* base; int ldc, colt; float* fo = nullptr;
        if (u.pn < 8) { base = Q; ldc = 2048; colt = u.pn * 256; }
        else if (u.pn < 10) { base = K; ldc = 512; colt = (u.pn - 8) * 256; if (u.pm < 16) fo = NK; }
        else { base = V; ldc = 512; colt = (u.pn - 10) * 256; if (u.pm < 16) fo = NV; }
#pragma unroll
        for (int ai = 0; ai < 2; ++ai)
#pragma unroll
            for (int m = 0; m < 4; ++m) { const int r = row0 + ai * HALF + m * 16; bf16_t* rowp = base + (size_t)r * ldc + colt + cin;
#pragma unroll
                for (int bj = 0; bj < 2; ++bj) { const f32x4 v0 = acc[ai][bj][m][0], v1 = acc[ai][bj][m][1];
                    u32x4 w; w.x = cvt_pk(v0[0], v0[1]); w.y = cvt_pk(v0[2], v0[3]); w.z = cvt_pk(v1[0], v1[1]); w.w = cvt_pk(v1[2], v1[3]);
                    *(u32x4*)(rowp + bj * HALF) = w;
                    if (fo) { float* fp = fo + ((size_t)(r >> 8) * 512 + (r & 255)) * 512 + colt + cin + bj * HALF; *(f32x4*)fp = v0; *(f32x4*)(fp + 4) = v1; } } }
    }
};
struct EpiRw1 {
    static constexpr bool PERM = true, AFTER_DRAIN = false;
    bf16_t *R, *A3;
    __device__ __forceinline__ void operator()(const f32x4 (&acc)[2][2][4][2], const Unit& u, int wr, int wc, int fr, int fq) const {
        const int ct = u.pn, panel = u.pm % NPANEL;
        const int row0 = panel * 256 + wr * 64 + fr; const int cin = wc * 32 + 8 * fq;
        bf16_t* base; int ldc, colt, act = 0;
        if (ct < 24) { base = R + (size_t)(ct >> 3) * MT * D; ldc = D; colt = (ct & 7) * 256; }
        else { base = A3 + (size_t)(ct - 24) * MT * 256; ldc = 256; colt = 0; act = ct - 23; }
#pragma unroll
        for (int ai = 0; ai < 2; ++ai)
#pragma unroll
            for (int m = 0; m < 4; ++m) { bf16_t* rowp = base + (size_t)(row0 + ai * HALF + m * 16) * ldc + colt + cin;
#pragma unroll
                for (int bj = 0; bj < 2; ++bj) { f32x4 v0 = acc[ai][bj][m][0], v1 = acc[ai][bj][m][1];
                    if (act == 1) {
#pragma unroll
                        for (int j = 0; j < 4; ++j) { v0[j] = ftanh(v0[j]); v1[j] = ftanh(v1[j]); } }
                    else if (act == 3) {
#pragma unroll
                        for (int j = 0; j < 4; ++j) { v0[j] = fsigmoid(v0[j]); v1[j] = fsigmoid(v1[j]); } }
                    u32x4 w; w.x = cvt_pk(v0[0], v0[1]); w.y = cvt_pk(v0[2], v0[3]); w.z = cvt_pk(v1[0], v1[1]); w.w = cvt_pk(v1[2], v1[3]);
                    *(u32x4*)(rowp + bj * HALF) = w; } }
    }
};
struct EpiRw2 {
    static constexpr bool PERM = true, AFTER_DRAIN = false;
    bf16_t *LD, *LA, *Gt; const float *w0, *a0;
    __device__ __forceinline__ void operator()(const f32x4 (&acc)[2][2][4][2], const Unit& u, int wr, int wc, int fr, int fq) const {
        const int ct = u.pn, panel = u.pm % NPANEL, grp = ct >> 3;
        const int row0 = panel * 256 + wr * 64 + fr; const int col0 = (ct & 7) * 256 + wc * 32 + 8 * fq;
        bf16_t* base; const float* bias = nullptr;
        if (grp < 2) { base = LD + (size_t)grp * MT * D; bias = w0 + grp * D; }
        else if (grp < 4) { base = LA + (size_t)(grp - 2) * MT * D; bias = a0 + (grp - 2) * D; }
        else base = Gt;
#pragma unroll
        for (int ai = 0; ai < 2; ++ai)
#pragma unroll
            for (int m = 0; m < 4; ++m) { bf16_t* rowp = base + (size_t)(row0 + ai * HALF + m * 16) * D + col0;
#pragma unroll
                for (int bj = 0; bj < 2; ++bj) {
                    f32x4 v0 = acc[ai][bj][m][0], v1 = acc[ai][bj][m][1];
                    if (bias) { v0 += *(const f32x4*)(bias + col0 + bj * HALF); v1 += *(const f32x4*)(bias + col0 + bj * HALF + 4); }
                    if (grp < 2) {
#pragma unroll
                        for (int j = 0; j < 4; ++j) { v0[j] = -fexp(-fsoftplus(-v0[j]) - 0.5f); v1[j] = -fexp(-fsoftplus(-v1[j]) - 0.5f); } }
                    u32x4 w; w.x = cvt_pk(v0[0], v0[1]); w.y = cvt_pk(v0[2], v0[3]); w.z = cvt_pk(v1[0], v1[1]); w.w = cvt_pk(v1[2], v1[3]);
                    *(u32x4*)(rowp + bj * HALF) = w;
                    asm volatile("" ::: "memory"); } }
    }
};
struct RwOrder1 {
    int G, c;
    __device__ __forceinline__ bool next(int i, Unit& u) const { const int L = i * G + c; if (L >= 27 * NPANEL) return false; const int panel = L / 27, ct = L % 27; const int ai = ct < 24 ? (ct >> 3) : ct - 21; u.pm = ai * NPANEL + panel; u.pn = ct; return true; }
    __device__ __forceinline__ void a_ready(const Unit&) const {}
    __device__ __forceinline__ void done(const Unit&) const {}
};
struct RwOrder2 {
    int G, c;
    __device__ __forceinline__ bool next(int i, Unit& u) const { const int L = i * G + c; if (L >= 40 * NPANEL) return false; const int panel = L / 40, ct = L % 40; const int ai = ct < 16 ? 0 : (ct < 32 ? 1 : 2); u.pm = ai * NPANEL + panel; u.pn = ct; return true; }
    __device__ __forceinline__ void a_ready(const Unit&) const {}
    __device__ __forceinline__ void done(const Unit&) const {}
};

constexpr int KS_STRIDE = 136;
constexpr int VT_STRIDE = 72;
constexpr int ATT_KS_OFF = 0, ATT_VT_OFF = 64 * KS_STRIDE * 2;

__device__ __forceinline__ void rope8(u32x4& a, u32x4& b, const f32x2* tab) {
    unsigned* pa = (unsigned*)&a; unsigned* pb = (unsigned*)&b;
#pragma unroll
    for (int w = 0; w < 4; ++w) {
        const f32x4 cs = *(const f32x4*)(tab + 2 * w);
        const float x1l = bflo(pa[w]), x1h = bfhi(pa[w]), x2l = bflo(pb[w]), x2h = bfhi(pb[w]);
        const float o1l = x1l * cs.x - x2l * cs.y, o2l = x1l * cs.y + x2l * cs.x;
        const float o1h = x1h * cs.z - x2h * cs.w, o2h = x1h * cs.w + x2h * cs.z;
        pa[w] = cvt_pk(o1l, o1h); pb[w] = cvt_pk(o2l, o2h);
    }
}

__device__ __forceinline__ void phase_attention(const Ctx& C, const bf16_t* Q, const bf16_t* Kb, const bf16_t* Vb, const bf16_t* KC, const bf16_t* VC, const float* sink, bf16_t* O) {
    const int tid = C.tid, lane = C.lane, w = C.wave, h = lane >> 5, lq = lane & 31;
    LAS bf16_t* Ks = (LAS bf16_t*)(C.lds + ATT_KS_OFF);
    LAS bf16_t* Vt = (LAS bf16_t*)(C.lds + ATT_VT_OFF);
    const f32x2* rope = WSP(f32x2, WS_ROPE);
    const float c2 = 0.08838834764831845f * 1.4426950408889634f;
    for (int it = C.bid; it < 768; it += C.G) {
        const bool smp = it < 512;
        int bb, kvh, qb, R0;
        if (smp) { bb = it >> 6; kvh = (it >> 4) & 3; qb = it & 15; R0 = MP + bb * 1024; }
        else { const int p = it - 512; bb = p >> 4; kvh = (p >> 2) & 3; qb = p & 3; R0 = bb * 256; }
        const int head = kvh * 4 + (w >> 1);
        const int t = qb * 64 + (w & 1) * 32 + lq;
        u32x4 qf[8];
        { const bf16_t* qp = Q + (size_t)(R0 + t) * D + head * 128 + 8 * h;
#pragma unroll
          for (int ks = 0; ks < 8; ++ks) qf[ks] = *(const u32x4*)(qp + 16 * ks); }
        if (smp) {
#pragma unroll
            for (int half = 0; half < 2; ++half) { const int pos = half ? (t & 63) : (t >> 6);
#pragma unroll
                for (int kk = 0; kk < 2; ++kk) rope8(qf[4 * half + kk], qf[4 * half + kk + 2], rope + pos * 32 + 16 * kk + 8 * h); }
        }
        f32x16 o[4];
#pragma unroll
        for (int db = 0; db < 4; ++db)
#pragma unroll
            for (int r = 0; r < 16; ++r) o[db][r] = 0.f;
        float mrun = -1e30f, lrun = 0.f;
        const int ntiles = smp ? 13 : 4;
        for (int ti = 0; ti < ntiles; ++ti) {
            const bf16_t *kp, *vp; int k0 = 0; bool local = false;
            if (smp) {
                if (ti < 8) { const size_t off = ((size_t)(bb * 2) * 512 + ti * 64) * 512 + kvh * 128; kp = KC + off; vp = VC + off; }
                else { k0 = qb * 64 - 128 + 64 * (ti - 8); if (k0 < 0 || k0 >= 1024) continue; local = true;
                       const size_t off = (size_t)(R0 + k0) * 512 + kvh * 128; kp = Kb + off; vp = Vb + off; }
            } else { k0 = ti * 64; const size_t off = (size_t)(R0 + k0) * 512 + kvh * 128; kp = Kb + off; vp = Vb + off; }
            __syncthreads();
            {
                const int key = tid >> 3, cc = tid & 7, c1 = (cc & 3) + (cc >> 2) * 8;
                u32x4 ka = *(const u32x4*)(kp + (size_t)key * 512 + 8 * c1), kb2 = *(const u32x4*)(kp + (size_t)key * 512 + 8 * c1 + 32);
                const u32x4 va = *(const u32x4*)(vp + (size_t)key * 512 + 8 * c1), vb2 = *(const u32x4*)(vp + (size_t)key * 512 + 8 * c1 + 32);
                if (local) { const int kpos = k0 + key; const int pos = (cc >> 2) ? (kpos & 63) : (kpos >> 6); rope8(ka, kb2, rope + pos * 32 + 8 * (cc & 3)); }
                *(LAS u32x4*)(Ks + key * KS_STRIDE + 8 * c1) = ka; *(LAS u32x4*)(Ks + key * KS_STRIDE + 8 * c1 + 32) = kb2;
                const unsigned* pva = (const unsigned*)&va; const unsigned* pvb = (const unsigned*)&vb2;
#pragma unroll
                for (int j = 0; j < 4; ++j) {
                    Vt[(8 * c1 + 2 * j) * VT_STRIDE + key] = (bf16_t)(pva[j] & 0xffffu); Vt[(8 * c1 + 2 * j + 1) * VT_STRIDE + key] = (bf16_t)(pva[j] >> 16);
                    Vt[(8 * c1 + 32 + 2 * j) * VT_STRIDE + key] = (bf16_t)(pvb[j] & 0xffffu); Vt[(8 * c1 + 32 + 2 * j + 1) * VT_STRIDE + key] = (bf16_t)(pvb[j] >> 16);
                }
            }
            __syncthreads();
            f32x16 s0, s1;
            { const float z0 = opaque_zero();
#pragma unroll
            for (int r = 0; r < 16; ++r) { s0[r] = z0; s1[r] = z0; } }
#pragma unroll
            for (int ks = 0; ks < 8; ++ks) {
                const bf16x8 a0 = *(const LAS bf16x8*)(Ks + lq * KS_STRIDE + 16 * ks + 8 * h);
                const bf16x8 a1 = *(const LAS bf16x8*)(Ks + (32 + lq) * KS_STRIDE + 16 * ks + 8 * h);
                const bf16x8 bq = __builtin_bit_cast(bf16x8, qf[ks]);
                s0 = __builtin_amdgcn_mfma_f32_32x32x16_bf16(a0, bq, s0, 0, 0, 0);
                s1 = __builtin_amdgcn_mfma_f32_32x32x16_bf16(a1, bq, s1, 0, 0, 0);
            }
            float mx = -1e30f;
#pragma unroll
            for (int r = 0; r < 16; ++r) {
                const int kl = (r & 3) + 8 * (r >> 2) + 4 * h;
                bool v0 = true, v1 = true;
                if (local) { const int d0 = k0 + kl - t, d1 = d0 + 32; v0 = (d0 <= 128) && (d0 >= -128); v1 = (d1 <= 128) && (d1 >= -128); }
                s0[r] = v0 ? s0[r] * c2 : -1e30f; s1[r] = v1 ? s1[r] * c2 : -1e30f;
                mx = fmaxf(mx, fmaxf(s0[r], s1[r]));
            }
            mx = fmaxf(mx, __shfl_xor(mx, 32));
            const float mnew = fmaxf(mrun, mx);
            const float alpha = fexp2(mrun - mnew);
            float ps = 0.f;
#pragma unroll
            for (int r = 0; r < 16; ++r) {
                const float p0 = s0[r] > -1e29f ? fexp2(s0[r] - mnew) : 0.f, p1 = s1[r] > -1e29f ? fexp2(s1[r] - mnew) : 0.f;
                s0[r] = p0; s1[r] = p1; ps += p0 + p1;
            }
            lrun = lrun * alpha + ps; mrun = mnew;
#pragma unroll
            for (int db = 0; db < 4; ++db)
#pragma unroll
                for (int r = 0; r < 16; ++r) o[db][r] *= alpha;
            u32x4 pf[4];
#pragma unroll
            for (int s = 0; s < 2; ++s) {
                pf[s].x = cvt_pk(s0[8 * s + 0], s0[8 * s + 1]); pf[s].y = cvt_pk(s0[8 * s + 2], s0[8 * s + 3]); pf[s].z = cvt_pk(s0[8 * s + 4], s0[8 * s + 5]); pf[s].w = cvt_pk(s0[8 * s + 6], s0[8 * s + 7]);
                pf[2 + s].x = cvt_pk(s1[8 * s + 0], s1[8 * s + 1]); pf[2 + s].y = cvt_pk(s1[8 * s + 2], s1[8 * s + 3]); pf[2 + s].z = cvt_pk(s1[8 * s + 4], s1[8 * s + 5]); pf[2 + s].w = cvt_pk(s1[8 * s + 6], s1[8 * s + 7]);
            }
#pragma unroll
            for (int db = 0; db < 4; ++db)
#pragma unroll
                for (int s2 = 0; s2 < 4; ++s2) {
                    const LAS bf16_t* vr = Vt + (32 * db + lq) * VT_STRIDE + 16 * s2 + 4 * h;
                    const u32x2 lo = *(const LAS u32x2*)vr, hi = *(const LAS u32x2*)(vr + 8);
                    u32x4 av; av.x = lo.x; av.y = lo.y; av.z = hi.x; av.w = hi.y;
                    o[db] = __builtin_amdgcn_mfma_f32_32x32x16_bf16(__builtin_bit_cast(bf16x8, av), __builtin_bit_cast(bf16x8, pf[s2]), o[db], 0, 0, 0);
                }
        }
        {
            const float sk = sink[head] * 1.4426950408889634f;
            const float mnew = fmaxf(mrun, sk), alpha = fexp2(mrun - mnew);
            float l = lrun * alpha; l += __shfl_xor(l, 32); l += fexp2(sk - mnew);
            const float sc = alpha * frcp(l);
            bf16_t* op = O + (size_t)(R0 + t) * D + head * 128 + 4 * h;
#pragma unroll
            for (int db = 0; db < 4; ++db)
#pragma unroll
                for (int g4 = 0; g4 < 4; ++g4) {
                    u32x2 wv; wv.x = cvt_pk(o[db][4 * g4 + 0] * sc, o[db][4 * g4 + 1] * sc); wv.y = cvt_pk(o[db][4 * g4 + 2] * sc, o[db][4 * g4 + 3] * sc);
                    *(u32x2*)(op + 32 * db + 8 * g4) = wv;
                }
        }
    }
    __syncthreads();
}

__device__ __forceinline__ void phase_hy_gate(const Ctx& C, const bf16_t* Pm, const float* cw, const float* cb, bf16_t* X0, bf16_t* ZTp, bf16_t* ZTs) {
    const int tid = C.tid;
    LAS bf16_t* zs = (LAS bf16_t*)C.lds;
    for (int it = C.bid; it < 6144; it += C.G) {
        const bool smp = it >= 2048; const int q = smp ? it - 2048 : it;
        const int cbk = q & 31, tb = smp ? (q >> 5) & 15 : (q >> 5) & 3, b = smp ? q >> 9 : q >> 7;
        const int L = smp ? 1024 : 256, R0 = smp ? MP + b * 1024 : b * 256, NB = smp ? 8 : 16;
        const int tl = tid >> 3, c8 = tid & 7, t = tb * 64 + tl, c0 = cbk * 64 + 8 * c8;
        float u[3][8];
#pragma unroll
        for (int g = 0; g < 3; ++g) {
            const int gc = g * D + c0;
            const bf16_t* pr = Pm + (size_t)(R0 + t) * 6144 + gc;
            u32x4 pm1 = *(const u32x4*)(pr - (t > 0 ? 6144 : 0)), pp1 = *(const u32x4*)(pr + (t < L - 1 ? 6144 : 0)); const u32x4 p0 = *(const u32x4*)pr;
            { const unsigned mk0 = t > 0 ? 0xffffffffu : 0u, mk1 = t < L - 1 ? 0xffffffffu : 0u; pm1.x &= mk0; pm1.y &= mk0; pm1.z &= mk0; pm1.w &= mk0; pp1.x &= mk1; pp1.y &= mk1; pp1.z &= mk1; pp1.w &= mk1; }
            const unsigned* a = (const unsigned*)&pm1; const unsigned* bq = (const unsigned*)&p0; const unsigned* cq = (const unsigned*)&pp1;
#pragma unroll
            for (int j = 0; j < 4; ++j) {
                const f32x2 w0 = *(const f32x2*)(cw + gc + 2 * j), w1 = *(const f32x2*)(cw + 6144 + gc + 2 * j), w2 = *(const f32x2*)(cw + 12288 + gc + 2 * j), bb = *(const f32x2*)(cb + gc + 2 * j);
#if defined(MK_GATE_VARIANT) && MK_GATE_VARIANT == 1
                u[g][2 * j] = bflo(bq[j]); u[g][2 * j + 1] = bfhi(bq[j]);
#elif defined(MK_GATE_VARIANT) && MK_GATE_VARIANT == 2
                u[g][2 * j] = bflo(bq[j]) * w1.x + bb.x; u[g][2 * j + 1] = bfhi(bq[j]) * w1.y + bb.y;
#elif defined(MK_GATE_VARIANT) && MK_GATE_VARIANT == 3
                u[g][2 * j] = bflo(a[j]) + bflo(bq[j]) + bflo(cq[j]); u[g][2 * j + 1] = bfhi(a[j]) + bfhi(bq[j]) + bfhi(cq[j]);
#else
                u[g][2 * j] = bflo(a[j]) * w0.x + bflo(bq[j]) * w1.x + bflo(cq[j]) * w2.x + bb.x;
                u[g][2 * j + 1] = bfhi(a[j]) * w0.y + bfhi(bq[j]) * w1.y + bfhi(cq[j]) * w2.y + bb.y;
#endif
            }
        }
        { u32x4 o; o.x = cvt_pk(u[0][0], u[0][1]); o.y = cvt_pk(u[0][2], u[0][3]); o.z = cvt_pk(u[0][4], u[0][5]); o.w = cvt_pk(u[0][6], u[0][7]);
          *(u32x4*)(X0 + (size_t)(R0 + t) * D + c0) = o; }
        __syncthreads();
#pragma unroll
        for (int j = 0; j < 8; ++j) zs[(8 * c8 + j) * 72 + tl] = (bf16_t)(cvt_pk(u[2][j] * u[1][j], 0.f) & 0xffffu);
        __syncthreads();
        { const int cl = tid >> 3, t8 = tid & 7;
          const u32x4 o = *(const LAS u32x4*)(zs + cl * 72 + 8 * t8);
          bf16_t* ZT = smp ? ZTs : ZTp;
          *(u32x4*)(ZT + ((size_t)(cbk * 64 + cl) * NB + b) * L + tb * 64 + 8 * t8) = o; }
    }
    __syncthreads();
}

template <int L, int NB>
__device__ __forceinline__ void phase_hy_conv(const Ctx& C, const bf16_t* FG, const bf16_t* ZT, bf16_t* YT) {
    constexpr int WPC = L / 256, CPB = 8 / WPC, NS = L / 32, ROW = 2 * L + 64, UNITS = L / 4, COPYB = UNITS * 16, CHB = 8 * COPYB;
    constexpr int NH = NS > 16 ? NS / 16 : 1, JH = NS / NH;
    const int lane = C.lane, w = C.wave, ch_local = w / WPC, w4 = w % WPC, r = lane & 15, q = lane >> 4;
    for (int it = C.bid; it < 2048 / CPB; it += C.G) {
        const int c = it * CPB + ch_local;
        __syncthreads();
        {
            const int tcid = w4 * 64 + lane;
            const bf16_t* frow = FG + (size_t)c * ROW;
            for (int x = tcid; x < UNITS; x += 64 * WPC) {
                const u32x4 d0 = *(const u32x4*)(frow + 8 * x), d1 = *(const u32x4*)(frow + 8 * x + 8);
                const unsigned dd[8] = {d0.x, d0.y, d0.z, d0.w, d1.x, d1.y, d1.z, d1.w};
#pragma unroll
                for (int k = 0; k < 8; ++k) {
                    u32x4 o;
                    if ((k & 1) == 0) { o.x = dd[k / 2]; o.y = dd[k / 2 + 1]; o.z = dd[k / 2 + 2]; o.w = dd[k / 2 + 3]; }
                    else { const int b0 = (k - 1) / 2;
                        o.x = (dd[b0] >> 16) | (dd[b0 + 1] << 16); o.y = (dd[b0 + 1] >> 16) | (dd[b0 + 2] << 16); o.z = (dd[b0 + 2] >> 16) | (dd[b0 + 3] << 16); o.w = (dd[b0 + 3] >> 16) | (dd[b0 + 4] << 16); }
                    *(LAS u32x4*)(C.lds + ch_local * CHB + k * COPYB + x * 16) = o;
                }
            }
        }
        __syncthreads();
        f32x4 acc[16];
        { const float z0 = opaque_zero();
#pragma unroll
        for (int i = 0; i < 16; ++i) acc[i] = (f32x4){z0, z0, z0, z0}; }
        const bf16_t* zrow = ZT + ((size_t)c * NB + (r % NB)) * L + 8 * q;
        const LAS unsigned char* abase = C.lds + ch_local * CHB + (7 - (r & 7)) * COPYB + ((L - 8) / 8 - (r >> 3) + q - 32 * w4) * 16;
#pragma unroll
        for (int hh = 0; hh < NH; ++hh) {
            bf16x8 bf[JH];
#pragma unroll
            for (int j = 0; j < JH; ++j) bf[j] = *(const bf16x8*)(zrow + 32 * (hh * JH + j));
#pragma unroll
            for (int e = -2 * (hh * JH + JH - 1); e <= 15 - 2 * (hh * JH); ++e) {
                const bf16x8 a = *(const LAS bf16x8*)(abase - 32 * e);
#pragma unroll
                for (int j = 0; j < JH; ++j) { const int il = e + 2 * (hh * JH + j);
                    if (il >= 0 && il < 16) asm volatile("v_mfma_f32_16x16x32_bf16 %0, %1, %2, %0" : "+v"(acc[il]) : "v"(a), "v"(bf[j])); }
                asm volatile("" :: "v"(a));
            }
#pragma unroll
            for (int j = 0; j < JH; ++j) asm volatile("" :: "v"(bf[j]));
        }
        asm volatile("s_nop 15\n\ts_nop 15" : "+v"(acc[0]), "+v"(acc[1]), "+v"(acc[2]), "+v"(acc[3]), "+v"(acc[4]), "+v"(acc[5]), "+v"(acc[6]), "+v"(acc[7]));
        asm volatile("" : "+v"(acc[8]), "+v"(acc[9]), "+v"(acc[10]), "+v"(acc[11]), "+v"(acc[12]), "+v"(acc[13]), "+v"(acc[14]), "+v"(acc[15]));
        if (r < NB) {
            bf16_t* yrow = YT + ((size_t)c * NB + r) * L + 256 * w4 + 4 * q;
#pragma unroll
            for (int i = 0; i < 16; ++i) { u32x2 o; o.x = cvt_pk(acc[i][0], acc[i][1]); o.y = cvt_pk(acc[i][2], acc[i][3]);
#if defined(MK_CONV_VARIANT) && MK_CONV_VARIANT == 1
                { const u32x4 zz = *(const u32x4*)(zrow + 32 * (i & 7)); o.x = zz.x; o.y = zz.y; }
#elif defined(MK_CONV_VARIANT) && MK_CONV_VARIANT == 2
                { const u32x4 aa = *(const LAS u32x4*)(abase - 32 * (i - 8)); o.x = aa.x; o.y = aa.w; }
#endif
                *(u32x2*)(yrow + 16 * i) = o; }
        }
    }
    __syncthreads();
}

__device__ __forceinline__ void phase_hy_out(const Ctx& C, const bf16_t* YTp, const bf16_t* YTs, const bf16_t* X0, bf16_t* Om) {
    const int tid = C.tid;
    LAS bf16_t* ys = (LAS bf16_t*)C.lds;
    for (int it = C.bid; it < 6144; it += C.G) {
        const bool smp = it >= 2048; const int q = smp ? it - 2048 : it;
        const int cbk = q & 31, tb = smp ? (q >> 5) & 15 : (q >> 5) & 3, b = smp ? q >> 9 : q >> 7;
        const int L = smp ? 1024 : 256, R0 = smp ? MP + b * 1024 : b * 256, NB = smp ? 8 : 16;
        __syncthreads();
        { const int cl = tid >> 3, t8 = tid & 7;
          const bf16_t* YT = smp ? YTs : YTp;
          const u32x4 v = *(const u32x4*)(YT + ((size_t)(cbk * 64 + cl) * NB + b) * L + tb * 64 + 8 * t8);
          const unsigned* pv = (const unsigned*)&v;
#pragma unroll
          for (int j = 0; j < 4; ++j) { ys[(8 * t8 + 2 * j) * 72 + cl] = (bf16_t)(pv[j] & 0xffffu); ys[(8 * t8 + 2 * j + 1) * 72 + cl] = (bf16_t)(pv[j] >> 16); } }
        __syncthreads();
        { const int tl = tid >> 3, c8 = tid & 7; const size_t off = (size_t)(R0 + tb * 64 + tl) * D + cbk * 64 + 8 * c8;
          const u32x4 yv = *(const LAS u32x4*)(ys + tl * 72 + 8 * c8), xv = *(const u32x4*)(X0 + off);
          const unsigned* py = (const unsigned*)&yv; const unsigned* px = (const unsigned*)&xv; u32x4 o; unsigned* po = (unsigned*)&o;
#pragma unroll
          for (int j = 0; j < 4; ++j) po[j] = cvt_pk(bflo(py[j]) * bflo(px[j]), bfhi(py[j]) * bfhi(px[j]));
          *(u32x4*)(Om + off) = o; }
    }
    __syncthreads();
}

__device__ __forceinline__ void phase_rw_mix(const Ctx& C, const bf16_t* H, const float* mu, bf16_t* XM) {
    const int gw = C.bid * 8 + C.wave, NGW = C.G * 8, lane = C.lane;
    for (int m = gw; m < MT; m += NGW) {
        const int t = m < MP ? (m & 255) : ((m - MP) & 1023), L = m < MP ? 256 : 1024;
        const bool hasp = t > 0, hasn = t < L - 1;
#pragma unroll
        for (int ch = 0; ch < 4; ++ch) {
            const int c0 = 8 * (lane + 64 * ch);
            const bf16_t* hp = H + (size_t)m * D + c0;
            u32x4 a = *(const u32x4*)(hp - (hasp ? D : 0)), c = *(const u32x4*)(hp + (hasn ? D : 0)); const u32x4 b = *(const u32x4*)hp;
            { const unsigned mk0 = hasp ? 0xffffffffu : 0u, mk1 = hasn ? 0xffffffffu : 0u; a.x &= mk0; a.y &= mk0; a.z &= mk0; a.w &= mk0; c.x &= mk1; c.y &= mk1; c.z &= mk1; c.w &= mk1; }
            const unsigned* pa = (const unsigned*)&a; const unsigned* pb = (const unsigned*)&b; const unsigned* pc = (const unsigned*)&c;
            float hv[8], xx[8];
#pragma unroll
            for (int j = 0; j < 4; ++j) { hv[2 * j] = bflo(pb[j]); hv[2 * j + 1] = bfhi(pb[j]);
                xx[2 * j] = 0.5f * (bflo(pa[j]) + bflo(pc[j])) - hv[2 * j]; xx[2 * j + 1] = 0.5f * (bfhi(pa[j]) + bfhi(pc[j])) - hv[2 * j + 1]; }
#pragma unroll
            for (int s = 0; s < 6; ++s) {
                const int mi = s == 0 ? 0 : s == 1 ? 2 : s == 2 ? 3 : s == 3 ? 1 : s;
                const f32x4 m0 = *(const f32x4*)(mu + mi * D + c0), m1 = *(const f32x4*)(mu + mi * D + c0 + 4);
                u32x4 o; o.x = cvt_pk(hv[0] + xx[0] * m0.x, hv[1] + xx[1] * m0.y); o.y = cvt_pk(hv[2] + xx[2] * m0.z, hv[3] + xx[3] * m0.w);
                o.z = cvt_pk(hv[4] + xx[4] * m1.x, hv[5] + xx[5] * m1.y); o.w = cvt_pk(hv[6] + xx[6] * m1.z, hv[7] + xx[7] * m1.w);
                *(u32x4*)(XM + ((size_t)s * MT + m) * D + c0) = o;
            }
        }
    }
}

__device__ __forceinline__ float dpp_xor1(float x) { return __int_as_float(__builtin_amdgcn_update_dpp(0, __float_as_int(x), 0xB1, 0xF, 0xF, true)); }
__device__ __forceinline__ float dpp_xor2(float x) { return __int_as_float(__builtin_amdgcn_update_dpp(0, __float_as_int(x), 0x4E, 0xF, 0xF, true)); }

constexpr int SC_TS = 4;
constexpr int SC_STEP = 6 * 64;
__device__ __forceinline__ void phase_rw_scan(const Ctx& C, const bf16_t* Rm, const bf16_t* Km, const bf16_t* Vm, const bf16_t* LD, const bf16_t* LA,
                                              const float* k_k, const float* k_a, const float* state_in, float* YB, float* state_out) {
    const int lane = C.lane, w = C.wave, rg = lane >> 2, kq = lane & 3;
    LAS float* buf = (LAS float*)(C.lds + w * (SC_TS * SC_STEP * 4));
    int task;
    if (C.G == 256) task = w < 2 ? C.bid * 2 + w : (w < 6 ? 512 + C.bid * 4 + (w - 2) : 1536);
    else task = C.bid * 8 + w;
    for (; task < 1536; task += C.G * 8) {
        const bool smp = task < 512; const int id = smp ? task : task - 512;
        const int b = id >> 6, head = (id >> 1) & 31, dir = id & 1;
        const int L = smp ? 1024 : 256, R0 = smp ? MP + b * 1024 : b * 256;
        float S[4][16];
        if (smp) {
            const float* sp = state_in + ((size_t)(b * 2 + dir) * 32 + head) * 4096 + (4 * rg) * 64 + 16 * kq;
#pragma unroll
            for (int rr = 0; rr < 4; ++rr)
#pragma unroll
                for (int j4 = 0; j4 < 4; ++j4) { const f32x4 v = *(const f32x4*)(sp + rr * 64 + 4 * j4); S[rr][4 * j4] = v.x; S[rr][4 * j4 + 1] = v.y; S[rr][4 * j4 + 2] = v.z; S[rr][4 * j4 + 3] = v.w; }
        } else {
#pragma unroll
            for (int rr = 0; rr < 4; ++rr)
#pragma unroll
                for (int j = 0; j < 16; ++j) S[rr][j] = 0.f;
        }
        const int ch = head * 64 + lane;
        const float kkc = k_k[ch], kac = k_a[ch];
        const bf16_t* ldp = LD + (size_t)dir * MT * D; const bf16_t* lap = LA + (size_t)dir * MT * D;
        float* yb = YB + (size_t)dir * MT * D;
        bf16_t pr[SC_TS], pk[SC_TS], pv[SC_TS], pl[SC_TS], pa[SC_TS];
        const int tstart = dir ? L - 1 : 0, tstep = dir ? -1 : 1;
#pragma unroll
        for (int s = 0; s < SC_TS; ++s) { const size_t o = (size_t)(R0 + tstart + tstep * s) * D + ch; pr[s] = Rm[o]; pk[s] = Km[o]; pv[s] = Vm[o]; pl[s] = ldp[o]; pa[s] = lap[o]; }
        for (int cix = 0; cix < L / SC_TS; ++cix) {
#pragma unroll
            for (int s = 0; s < SC_TS; ++s) {
                const float r = bf2f(pr[s]), k = bf2f(pk[s]), v = bf2f(pv[s]), ld = bf2f(pl[s]), a = fsigmoid(bf2f(pa[s]));
                const float kr = k * kkc; const float ss = wave_sum(kr * kr); const float kk = kr * __builtin_amdgcn_rsqf(ss + 1e-12f);
                LAS float* sb = buf + s * SC_STEP;
                sb[lane] = fexp(ld); sb[64 + lane] = kk * a; sb[128 + lane] = k * (1.0f + (a - 1.0f) * kac); sb[192 + lane] = -kk; sb[256 + lane] = r; sb[320 + lane] = v;
            }
            if (cix + 1 < L / SC_TS) {
#pragma unroll
                for (int s = 0; s < SC_TS; ++s) { const size_t o = (size_t)(R0 + tstart + tstep * ((cix + 1) * SC_TS + s)) * D + ch; pr[s] = Rm[o]; pk[s] = Km[o]; pv[s] = Vm[o]; pl[s] = ldp[o]; pa[s] = lap[o]; }
            }
            asm volatile("s_waitcnt lgkmcnt(0)" ::: "memory");
#pragma unroll
            for (int s = 0; s < SC_TS; ++s) {
                const LAS float* sb = buf + s * SC_STEP;
                f32x4 wv[4], bv[4], dv[4], nv[4], rv[4];
#pragma unroll
                for (int j4 = 0; j4 < 4; ++j4) { wv[j4] = *(const LAS f32x4*)(sb + 16 * kq + 4 * j4); bv[j4] = *(const LAS f32x4*)(sb + 64 + 16 * kq + 4 * j4); dv[j4] = *(const LAS f32x4*)(sb + 128 + 16 * kq + 4 * j4);
                    nv[j4] = *(const LAS f32x4*)(sb + 192 + 16 * kq + 4 * j4); rv[j4] = *(const LAS f32x4*)(sb + 256 + 16 * kq + 4 * j4); }
                const f32x4 vv = *(const LAS f32x4*)(sb + 320 + 4 * rg);
                float y[4];
#pragma unroll
                for (int rr = 0; rr < 4; ++rr) {
                    float sa0 = 0.f, sa1 = 0.f;
#pragma unroll
                    for (int j4 = 0; j4 < 4; ++j4) { sa0 += S[rr][4 * j4] * nv[j4].x + S[rr][4 * j4 + 2] * nv[j4].z; sa1 += S[rr][4 * j4 + 1] * nv[j4].y + S[rr][4 * j4 + 3] * nv[j4].w; }
                    float sa = sa0 + sa1; sa += dpp_xor1(sa); sa += dpp_xor2(sa);
                    const float vr = vv[rr];
                    float y0 = 0.f, y1 = 0.f;
#pragma unroll
                    for (int j4 = 0; j4 < 4; ++j4) {
                        S[rr][4 * j4] = S[rr][4 * j4] * wv[j4].x + (sa * bv[j4].x + vr * dv[j4].x);
                        S[rr][4 * j4 + 1] = S[rr][4 * j4 + 1] * wv[j4].y + (sa * bv[j4].y + vr * dv[j4].y);
                        S[rr][4 * j4 + 2] = S[rr][4 * j4 + 2] * wv[j4].z + (sa * bv[j4].z + vr * dv[j4].z);
                        S[rr][4 * j4 + 3] = S[rr][4 * j4 + 3] * wv[j4].w + (sa * bv[j4].w + vr * dv[j4].w);
                        y0 += S[rr][4 * j4] * rv[j4].x + S[rr][4 * j4 + 2] * rv[j4].z; y1 += S[rr][4 * j4 + 1] * rv[j4].y + S[rr][4 * j4 + 3] * rv[j4].w;
                    }
                    float yy = y0 + y1; yy += dpp_xor1(yy); yy += dpp_xor2(yy); y[rr] = yy;
                }
                if (kq == 0) { const int t = tstart + tstep * (cix * SC_TS + s); *(f32x4*)(yb + (size_t)(R0 + t) * D + head * 64 + 4 * rg) = (f32x4){y[0], y[1], y[2], y[3]}; }
            }
        }
        if (!smp) {
            float* sp = state_out + ((size_t)(b * 2 + dir) * 32 + head) * 4096 + (4 * rg) * 64 + 16 * kq;
#pragma unroll
            for (int rr = 0; rr < 4; ++rr)
#pragma unroll
                for (int j4 = 0; j4 < 4; ++j4) *(f32x4*)(sp + rr * 64 + 4 * j4) = (f32x4){S[rr][4 * j4], S[rr][4 * j4 + 1], S[rr][4 * j4 + 2], S[rr][4 * j4 + 3]};
        }
    }
    __syncthreads();
}

__device__ __forceinline__ void phase_rw_post(const Ctx& C, const float* YB, const bf16_t* Rm, const bf16_t* Km, const bf16_t* Vm, const bf16_t* LA, const bf16_t* Gt,
                                              const float* k_a, const float* r_k, const float* ln_w, const float* ln_b, bf16_t* Om) {
    const int gw = C.bid * 8 + C.wave, NGW = C.G * 8, lane = C.lane;
#pragma unroll 2
    for (int it = gw; it < MT * 32; it += NGW) {
        const size_t o = (size_t)it * 64 + lane; const int ch = (it & 31) * 64 + lane;
        const float y = YB[o] + YB[(size_t)MT * D + o];
        const float r = bf2f(Rm[o]), k = bf2f(Km[o]), v = bf2f(Vm[o]), g = bf2f(Gt[o]);
        const float a0 = fsigmoid(bf2f(LA[o])), a1 = fsigmoid(bf2f(LA[(size_t)MT * D + o]));
        const float kac = k_a[ch], rkc = r_k[ch];
        const float mean = wave_sum(y) * (1.0f / 64.0f); const float dy = y - mean; const float var = wave_sum(dy * dy) * (1.0f / 64.0f);
        const float yn = dy * __builtin_amdgcn_rsqf(var + 64e-5f) * ln_w[ch] + ln_b[ch];
        const float kd0 = k * (1.0f + (a0 - 1.0f) * kac), kd1 = k * (1.0f + (a1 - 1.0f) * kac);
        const float bon = wave_sum(r * (kd0 + kd1) * rkc);
        const float outv = (yn + bon * v) * g;
        Om[o] = (bf16_t)(cvt_pk(outv, 0.f) & 0xffffu);
    }
}

constexpr int NPH = 35;
#define IN(k) (lo <= (k) && (k) < hi)
#define SEAM(k) do { if (IN(k) && IN((k) + 1)) xcd_barrier(bar); } while (0)
#define LDSG ((PG8_LAS unsigned char*)C.lds)

template <class Epi>
__device__ __forceinline__ void run_gemm(const Ctx& C, const bf16_t* A, const bf16_t* Bt, int N, int K, const Epi& E) {
    pg8::Gemm g{A, Bt, MT, N, K}; pg8::StaticOrder S; S.init(MT, N, C.G, C.bid);
    pg8::gemm_phase<Epi, pg8::StaticOrder, false>(LDSG, g, S, E, nullptr);
}

template <int LAYER>
__device__ __forceinline__ void mlp_block(const Ctx& C, const XcdBarrier& bar, int lo, int hi, int b0) {
    float* X = WSP(float, WS_X); bf16_t* H = WSP(bf16_t, WS_H); bf16_t* U = WSP(bf16_t, WS_ARENA + AR_U);
    if (IN(b0)) phase_norm_mod(C, X, karg<I_N2G>() + LAYER * D, LAYER, 3, H);
    SEAM(b0);
    if (IN(b0 + 1)) { EpiBf16<1> E{U, FF}; run_gemm(C, H, WSP(bf16_t, WS_W1T) + (size_t)LAYER * D * FF, FF, D, E); }
    SEAM(b0 + 1);
    if (IN(b0 + 2)) { EpiResidual E{X, MODP(LAYER, 0, 5)}; run_gemm(C, U, WSP(bf16_t, WS_W2T) + (size_t)LAYER * D * FF, D, FF, E); }
    SEAM(b0 + 2);
}

template <int LAYER, int J>
__device__ __forceinline__ void attn_layer(const Ctx& C, const XcdBarrier& bar, int lo, int hi, int b0) {
    float* X = WSP(float, WS_X); bf16_t* H = WSP(bf16_t, WS_H);
    bf16_t *Q = WSP(bf16_t, WS_ARENA + AR_Q), *Kb = WSP(bf16_t, WS_ARENA + AR_K), *Vb = WSP(bf16_t, WS_ARENA + AR_V), *O = WSP(bf16_t, WS_ARENA + AR_O);
    if (IN(b0)) { if (LAYER == 0) phase_fg_transpose(C); phase_norm_mod(C, X, karg<I_N1G>() + LAYER * D, LAYER, 0, H); }
    SEAM(b0);
    if (IN(b0 + 1)) { EpiQKV E{Q, Kb, Vb, C.out + OUT_NK + (size_t)J * 256 * 512, C.out + OUT_NV + (size_t)J * 256 * 512};
                      run_gemm(C, H, WSP(bf16_t, WS_WQKVT) + (size_t)J * D * 3072, 3072, D, E); }
    SEAM(b0 + 1);
    if (IN(b0 + 2)) phase_attention(C, Q, Kb, Vb, WSP(bf16_t, WS_KC) + (size_t)J * 512 * 512, WSP(bf16_t, WS_VC) + (size_t)J * 512 * 512, karg<I_SINK>() + J * 16, O);
    SEAM(b0 + 2);
    if (IN(b0 + 3)) { EpiResidual E{X, MODP(LAYER, 0, 2)}; run_gemm(C, O, WSP(bf16_t, WS_WOT) + (size_t)J * D * D, D, D, E); }
    SEAM(b0 + 3);
    mlp_block<LAYER>(C, bar, lo, hi, b0 + 4);
}

template <int LAYER>
__device__ __forceinline__ void hyena_layer(const Ctx& C, const XcdBarrier& bar, int lo, int hi, int b0) {
    float* X = WSP(float, WS_X); bf16_t* H = WSP(bf16_t, WS_H);
    bf16_t *Pm = WSP(bf16_t, WS_ARENA + AR_P), *X0 = WSP(bf16_t, WS_ARENA + AR_X0), *ZT = WSP(bf16_t, WS_ARENA + AR_ZT), *YT = WSP(bf16_t, WS_ARENA + AR_YT), *HO = WSP(bf16_t, WS_ARENA + AR_HO);
    bf16_t *ZTp = ZT, *ZTs = ZT + (size_t)MP * D, *YTp = YT, *YTs = YT + (size_t)MP * D;
    if (IN(b0)) phase_norm_mod(C, X, karg<I_N1G>() + LAYER * D, LAYER, 0, H);
    SEAM(b0);
    if (IN(b0 + 1)) { EpiBf16<0> E{Pm, 6144}; run_gemm(C, H, WSP(bf16_t, WS_HYINT), 6144, D, E); }
    SEAM(b0 + 1);
    if (IN(b0 + 2)) phase_hy_gate(C, Pm, karg<I_HYCW>(), karg<I_HYCB>(), X0, ZTp, ZTs);
    SEAM(b0 + 2);
    if (IN(b0 + 3)) { phase_hy_conv<1024, 8>(C, WSP(bf16_t, WS_FGS), ZTs, YTs); phase_hy_conv<256, 16>(C, WSP(bf16_t, WS_FGP), ZTp, YTp); }
    SEAM(b0 + 3);
    if (IN(b0 + 4)) phase_hy_out(C, YTp, YTs, X0, HO);
    SEAM(b0 + 4);
    if (IN(b0 + 5)) { EpiResidual E{X, MODP(LAYER, 0, 2)}; run_gemm(C, HO, WSP(bf16_t, WS_HYOUTT), D, D, E); }
    SEAM(b0 + 5);
    mlp_block<LAYER>(C, bar, lo, hi, b0 + 6);
}

template <int LAYER>
__device__ __forceinline__ void rwkv_layer(const Ctx& C, const XcdBarrier& bar, int lo, int hi, int b0) {
    float* X = WSP(float, WS_X); bf16_t* H = WSP(bf16_t, WS_H);
    bf16_t *XM = WSP(bf16_t, WS_ARENA + AR_XMIX), *LD = WSP(bf16_t, WS_ARENA + AR_LD), *LA = WSP(bf16_t, WS_ARENA + AR_LA), *Gt = WSP(bf16_t, WS_ARENA + AR_G), *RO = WSP(bf16_t, WS_ARENA + AR_RO);
    bf16_t *Rm = WSP(bf16_t, WS_ARENA + AR_R), *Km = WSP(bf16_t, WS_ARENA + AR_KK), *Vm = WSP(bf16_t, WS_ARENA + AR_VV), *A3 = WSP(bf16_t, WS_ARENA + AR_A3);
    float* YB = WSP(float, WS_ARENA + AR_YB);
    if (IN(b0)) phase_norm_mod(C, X, karg<I_N1G>() + LAYER * D, LAYER, 0, H);
    SEAM(b0);
    if (IN(b0 + 1)) phase_rw_mix(C, H, karg<I_MU>(), XM);
    SEAM(b0 + 1);
    if (IN(b0 + 2)) { pg8::Gemm g{XM, WSP(bf16_t, WS_RWBT), 6 * MT, 27 * 256, D}; RwOrder1 S{C.G, C.bid}; EpiRw1 E{Rm, A3};
                      pg8::gemm_phase<EpiRw1, RwOrder1, false>(LDSG, g, S, E, nullptr); }
    SEAM(b0 + 2);
    if (IN(b0 + 3)) { pg8::Gemm g{A3, WSP(bf16_t, WS_LORA2T), 3 * MT, 40 * 256, 256}; RwOrder2 S{C.G, C.bid}; EpiRw2 E{LD, LA, Gt, karg<I_W0>(), karg<I_A0>()};
                      pg8::gemm_phase<EpiRw2, RwOrder2, false>(LDSG, g, S, E, nullptr); }
    SEAM(b0 + 3);
    if (IN(b0 + 4)) phase_rw_scan(C, Rm, Km, Vm, LD, LA, karg<I_KK>(), karg<I_KA>(), karg<I_ST>(), YB, C.out + OUT_ST);
    SEAM(b0 + 4);
    if (IN(b0 + 5)) phase_rw_post(C, YB, Rm, Km, Vm, LA, Gt, karg<I_KA>(), karg<I_RK>(), karg<I_LNW>(), karg<I_LNB>(), RO);
    SEAM(b0 + 5);
    if (IN(b0 + 6)) { EpiResidual E{X, MODP(LAYER, 0, 2)}; run_gemm(C, RO, WSP(bf16_t, WS_RWOT), D, D, E); }
    SEAM(b0 + 6);
    mlp_block<LAYER>(C, bar, lo, hi, b0 + 7);
}

__global__ void __launch_bounds__(512, 2) fwd_kernel(Params prm) {
    extern __shared__ __attribute__((aligned(16))) unsigned char lds_raw[];
    Ctx C;
    C.lds = (LAS unsigned char*)lds_raw;
    C.tid = threadIdx.x; C.lane = C.tid & 63; C.wave = __builtin_amdgcn_readfirstlane(C.tid >> 6); C.G = gridDim.x; C.bid = blockIdx.x;
    C.out = prm.out; C.ws = prm.ws;
    const int lo = prm.ph_lo, hi = prm.ph_hi;
    volatile LAS unsigned* xbw = (volatile LAS unsigned*)(C.lds + LDS_BAR_OFF);
    if (C.tid < 4) xbw[C.tid] = 0u;
    __syncthreads();
    XcdBarrier bar; bar.bar = (unsigned*)(C.ws + WS_CTL) + 1024; bar.x = 0; bar.st = xbw;
    if (hi - lo > 1) bar = xcd_barrier_post((unsigned*)(C.ws + WS_CTL) + 1024, xbw);

#ifdef MK_SKIP_FROM
    if (IN(0)) { for (size_t i = (size_t)C.bid * 512 + C.tid; i < (size_t)3 * 4194304; i += (size_t)C.G * 512) prm.out[OUT_NK + i] = 0.f; }
#endif
    if (IN(0)) phase_prologue(C);
    SEAM(0);
    attn_layer<0, 0>(C, bar, lo, hi, 1);
    hyena_layer<1>(C, bar, lo, hi, 8);
    rwkv_layer<2>(C, bar, lo, hi, 17);
    attn_layer<3, 1>(C, bar, lo, hi, 27);
#ifndef MK_DBG_N
#define MK_DBG_N ((size_t)MT * D)
#endif
#ifndef MK_DBG_SCALE
#define MK_DBG_SCALE 1.0f
#endif
#ifdef MK_DBG_OFF
    if (IN(34)) { for (size_t i = (size_t)C.bid * 512 + C.tid; i < (size_t)MT * D; i += (size_t)C.G * 512) prm.out[OUT_Y + i] = i < (size_t)(MK_DBG_N) ? MK_DBG_SCALE * (MK_DBG_BF16 ? bf2f(WSP(bf16_t, MK_DBG_OFF)[i]) : WSP(float, MK_DBG_OFF)[i]) : 0.f; }
#else
    if (IN(34)) phase_norm_final(C, WSP(float, WS_X), karg<I_FNG>(), prm.out + OUT_Y);
#endif
}

#ifdef MK_SEP_CONV
__global__ void __launch_bounds__(512, 2) k_hyconv(Params prm) {
    extern __shared__ __attribute__((aligned(16))) unsigned char lds_raw3[];
    Ctx C; C.lds = (LAS unsigned char*)lds_raw3; C.tid = threadIdx.x; C.lane = C.tid & 63; C.wave = __builtin_amdgcn_readfirstlane(C.tid >> 6); C.G = gridDim.x; C.bid = blockIdx.x; C.out = prm.out; C.ws = prm.ws;
    bf16_t *ZT = WSP(bf16_t, WS_ARENA + AR_ZT), *YT = WSP(bf16_t, WS_ARENA + AR_YT);
    phase_hy_conv<1024, 8>(C, WSP(bf16_t, WS_FGS), ZT + (size_t)MP * D, YT + (size_t)MP * D); phase_hy_conv<256, 16>(C, WSP(bf16_t, WS_FGP), ZT, YT);
}
#endif
#ifdef MK_SEP_GATE
__global__ void __launch_bounds__(512, 2) k_hygate(Params prm) {
    extern __shared__ __attribute__((aligned(16))) unsigned char lds_raw2[];
    Ctx C; C.lds = (LAS unsigned char*)lds_raw2; C.tid = threadIdx.x; C.lane = C.tid & 63; C.wave = __builtin_amdgcn_readfirstlane(C.tid >> 6); C.G = gridDim.x; C.bid = blockIdx.x; C.out = prm.out; C.ws = prm.ws;
    bf16_t* ZT = WSP(bf16_t, WS_ARENA + AR_ZT);
    phase_hy_gate(C, WSP(bf16_t, WS_ARENA + AR_P), karg<I_HYCW>(), karg<I_HYCB>(), WSP(bf16_t, WS_ARENA + AR_X0), ZT, ZT + (size_t)MP * D);
}
#endif
#ifndef MK_PER_PHASE
#define MK_PER_PHASE 1
#endif
extern "C" void kernel_launch(void* const* d_in, const int* in_sizes, int n_in, void* d_out, int out_size, void* d_ws, size_t ws_size, hipStream_t stream) {
    static int grid = 0;
    if (grid == 0) {
        if (n_in != N_IN || ws_size < WS_END || out_size != 37748736) { fprintf(stderr, "kernel_launch: unexpected shapes (n_in %d, ws %zu, out %d); nothing launched\n", n_in, ws_size, out_size); grid = -1; return; }
        int dev = 0, cus = 0, per_cu = 0;
        if (hipGetDevice(&dev) != hipSuccess || hipDeviceGetAttribute(&cus, hipDeviceAttributeMultiprocessorCount, dev) != hipSuccess) { grid = -1; return; }
        if (hipFuncSetAttribute((const void*)fwd_kernel, hipFuncAttributeMaxDynamicSharedMemorySize, LDS_BYTES) != hipSuccess) { fprintf(stderr, "kernel_launch: hipFuncSetAttribute failed\n"); grid = -1; return; }
        if (hipOccupancyMaxActiveBlocksPerMultiprocessor(&per_cu, (const void*)fwd_kernel, 512, LDS_BYTES) != hipSuccess || per_cu < 1) { fprintf(stderr, "kernel_launch: occupancy query says %d\n", per_cu); }
        (void)hipGetLastError();
        grid = cus;
    }
    if (grid < 0) return;
    (void)hipMemsetAsync((char*)d_ws, 0, WS_ZERO_BYTES, stream);
    Params p{};
    for (int i = 0; i < N_IN; ++i) p.in[i] = (const float*)d_in[i];
    p.out = (float*)d_out; p.ws = (unsigned char*)d_ws;
#ifndef MK_LASTP
#define MK_LASTP NPH
#endif
#ifndef MK_FIRSTP
#define MK_FIRSTP 0
#endif
#if MK_PER_PHASE
    for (int k = MK_FIRSTP; k < MK_LASTP; ++k) {
#ifdef MK_SKIP_FROM
        if (k >= MK_SKIP_FROM && k < NPH - 1) continue;
#endif
#ifdef MK_SEP_CONV
        if (k == 11) { static bool a3 = false; if (!a3) { (void)hipFuncSetAttribute((const void*)k_hyconv, hipFuncAttributeMaxDynamicSharedMemorySize, 70000); a3 = true; } hipLaunchKernelGGL(k_hyconv, dim3(grid), dim3(512), 70000, stream, p); continue; }
#endif
#ifdef MK_SEP_GATE
        if (k == 10) { hipLaunchKernelGGL(k_hygate, dim3(grid), dim3(512), 16384, stream, p); continue; }
#endif
#ifdef MK_REPEAT_PH
        if (k == MK_REPEAT_PH) { p.ph_lo = k; p.ph_hi = k + 1; hipLaunchKernelGGL(fwd_kernel, dim3(grid), dim3(512), LDS_BYTES, stream, p); }
#endif
 p.ph_lo = k; p.ph_hi = k + 1; hipLaunchKernelGGL(fwd_kernel, dim3(grid), dim3(512), LDS_BYTES, stream, p); }
#else
    p.ph_lo = 0; p.ph_hi = NPH; hipLaunchKernelGGL(fwd_kernel, dim3(grid), dim3(512), LDS_BYTES, stream, p);
#endif
}
```

```cpp
#include <hip/hip_runtime.h>
#include <cstdio>
#include <cstdint>
namespace pg8 {
#define PG8_LAS __attribute__((address_space(3)))
typedef unsigned short bf16_t;
typedef short bf16x8 __attribute__((ext_vector_type(8)));
typedef float f32x4 __attribute__((ext_vector_type(4)));
typedef unsigned u32x4 __attribute__((ext_vector_type(4)));
constexpr int BM = 256, BK = 64, HALF = 128, HTB = HALF * BK * 2  , STAGE_BYTES = 8 * HTB, NXCD = 8, WGM = 4;

__host__ __device__ __forceinline__ int lds_byte(int r, int c) { const int st = (r >> 4) * 2 + (c >> 5), rr = r & 15, cc = c & 31, ob = rr * 64 + cc * 2; return st * 1024 + (ob ^ (((ob >> 9) & 1) << 5)); }
__host__ __device__ __forceinline__ void stage_rc(int b, int& R, int& C) { const int st = b / 1024, sb = b % 1024, swz = sb ^ (((sb >> 9) & 1) << 5); R = (st >> 1) * 16 + swz / 64; C = (st & 1) * 32 + (swz % 64) / 2; }
__host__ __device__ __forceinline__ int perm32(int rho) { const int n = rho >> 4, i = rho & 15; return 8 * (i >> 2) + 4 * n + (i & 3); }

struct Unit { int pm, pn, kh, mask; int nt = 0; };
struct Gemm { const bf16_t* A; const bf16_t* Bt; int M, N, K, KU; };

__host__ __device__ __forceinline__ bool tail_deal(int nwg, int G, int i, int c, int& L, int& mask) {
    const int full = nwg / G, rem = nwg - full * G;
    if (i < full) { L = i * G + c; mask = 15; return true; }
    if (i > full || rem == 0) return false;
    const int parts = (4 * rem <= G) ? 4 : ((2 * rem <= G) ? 2 : 1);
    if (c >= parts * rem) return false;
    L = full * G + c / parts; const int sub = c % parts;
    mask = parts == 1 ? 15 : (parts == 2 ? (sub ? 0xA : 0x5) : (1 << sub));
    return true;
}
struct StaticOrder {
    int nM, nN, nwg, G, c;
    __host__ __device__ void init(int M, int N, int G_, int c_) { nM = M / BM; nN = N / BM; nwg = nM * nN; G = G_; c = c_; }
    __host__ __device__ bool next(int i, Unit& u) const { const long L = (long)i * G + c; if (L >= nwg) return false; map((int)L, u); u.kh = 0; u.mask = 15; return true; }
    __host__ __device__ bool map(int L, Unit& u) const {
        int wgid = (int)L; { const int q = nwg / NXCD, r = nwg % NXCD, xcd = wgid % NXCD, off = wgid / NXCD; wgid = (xcd < r ? xcd * (q + 1) : r * (q + 1) + (xcd - r) * q) + off; }
        const int nig = WGM * nN, gid = wgid / nig, fm = gid * WGM, gsz = (nM - fm) < WGM ? (nM - fm) : WGM;
        u.pm = fm + ((wgid % nig) % gsz); u.pn = (wgid % nig) / gsz; return true;
    }
    __device__ __forceinline__ void a_ready(const Unit&) const {}
    __device__ __forceinline__ void done(const Unit&) const {}
};

template <class Epi, class Sched, bool STAMP = false>
__device__ __forceinline__ void gemm_phase(PG8_LAS unsigned char* lds, const Gemm g, const Sched& S, const Epi& E, unsigned long long* stamps) {
    const int tid = threadIdx.x, wid = __builtin_amdgcn_readfirstlane(tid >> 6), lane = tid & 63, wr = wid >> 2, wc = wid & 3, fr = lane & 15, fq = lane >> 4;
    const int K = g.K, nt = g.KU / BK;
    int ts_lo = 0, ts_hi = 0, nts = 0; const unsigned long long rt_entry = STAMP ? (unsigned long long)wall_clock64() : 0ull;
#define PG8_STAMP() do { if (STAMP && wid == 0 && nts < 64) { const unsigned long long _c = (unsigned long long)clock64(); \
        ts_lo = (lane == nts) ? (int)(unsigned)_c : ts_lo; ts_hi = (lane == nts) ? (int)(unsigned)(_c >> 32) : ts_hi; ++nts; } } while (0)
    PG8_STAMP();
    unsigned voffA[2], voffB[2];
#pragma unroll
    for (int i = 0; i < 2; ++i) { int R, C; stage_rc(tid * 16 + i * 8192, R, C); const int Rb = Epi::PERM ? ((R & ~31) + perm32(R & 31)) : R;
        voffA[i] = (unsigned)(R * K + C) * 2u; voffB[i] = (unsigned)(Rb * K + C) * 2u; }
    const size_t kstep = (size_t)(BK * 2);
    const size_t hstep = (size_t)HALF * K * 2;
    const size_t tstep = 2 * hstep;
    const unsigned ldsw = (unsigned)wid * 1024u;
    const int aoff = lds_byte(wr * 64 + fr, fq * 8), boff = lds_byte(wc * 32 + fr, fq * 8);
#define PG8_SA(b, h) (((b) * 2 + (h)) * HTB)
#define PG8_SB(b, h) ((4 + (b) * 2 + (h)) * HTB)
#define PG8_STAGE(bufoff, gbase, voff) do { _Pragma("unroll") for (int _i = 0; _i < 2; ++_i) \
        __builtin_amdgcn_global_load_lds((const unsigned*)((const char*)(gbase) + (voff)[_i]), (PG8_LAS unsigned*)(lds + (bufoff) + ldsw + _i * 8192), 16, 0, 0); } while (0)
#define PG8_LDA(dst, b, h) do { _Pragma("unroll") for (int m = 0; m < 4; ++m) _Pragma("unroll") for (int k = 0; k < 2; ++k) dst[m][k] = *(const PG8_LAS bf16x8*)(lds + PG8_SA(b, h) + aoff + m * 2048 + k * 1024); } while (0)
#define PG8_LDB(dst, b, h) do { _Pragma("unroll") for (int n = 0; n < 2; ++n) _Pragma("unroll") for (int k = 0; k < 2; ++k) dst[n][k] = *(const PG8_LAS bf16x8*)(lds + PG8_SB(b, h) + boff + n * 2048 + k * 1024); } while (0)
#define PG8_MMA(ai, bj, At, Bt) do { __builtin_amdgcn_s_setprio(1); _Pragma("unroll") for (int k = 0; k < 2; ++k) _Pragma("unroll") for (int m = 0; m < 4; ++m) _Pragma("unroll") for (int n = 0; n < 2; ++n) \
        asm volatile("v_mfma_f32_16x16x32_bf16 %0, %1, %2, %0" : "+v"(acc[ai][bj][m][n]) : "v"(Bt[n][k]), "v"(At[m][k])); __builtin_amdgcn_s_setprio(0); } while (0)
#define PG8_ACC_FENCE1(ai, bj) asm volatile("s_nop 15\n\ts_nop 15" : "+v"(acc[ai][bj][0][0]), "+v"(acc[ai][bj][0][1]), "+v"(acc[ai][bj][1][0]), "+v"(acc[ai][bj][1][1]), "+v"(acc[ai][bj][2][0]), "+v"(acc[ai][bj][2][1]), "+v"(acc[ai][bj][3][0]), "+v"(acc[ai][bj][3][1]))
#define PG8_ACC_FENCE() do { PG8_ACC_FENCE1(0, 0); PG8_ACC_FENCE1(0, 1); PG8_ACC_FENCE1(1, 0); PG8_ACC_FENCE1(1, 1); } while (0)
#define PG8_WAIT_V(n) asm volatile("s_waitcnt vmcnt(" #n ")" ::: "memory")
#define PG8_WAIT_L(n) asm volatile("s_waitcnt lgkmcnt(" #n ")" ::: "memory")
#define PG8_BAR __builtin_amdgcn_s_barrier()
#define PG8_SCHED __builtin_amdgcn_sched_barrier(0)
    Unit cur, nxt; int ui = 0;
    if (!S.next(0, cur)) return;
    f32x4 acc[2][2][4][2];
#pragma unroll
    for (int a = 0; a < 2; ++a)
#pragma unroll
        for (int b = 0; b < 2; ++b)
#pragma unroll
            for (int m = 0; m < 4; ++m)
#pragma unroll
                for (int n = 0; n < 2; ++n) acc[a][b][m][n] = (f32x4){0.f, 0.f, 0.f, 0.f};
    bf16x8 At[4][2], B0[2][2], B1[2][2];
    const size_t kslice = (size_t)g.KU * 2;
    const char* cA = (const char*)g.A + (size_t)cur.pm * tstep + cur.kh * kslice; const char* cB = (const char*)g.Bt + (size_t)cur.pn * tstep + cur.kh * kslice;
    S.a_ready(cur);
    PG8_STAGE(PG8_SB(0, 0), cB, voffB); PG8_STAGE(PG8_SA(0, 0), cA, voffA); PG8_STAGE(PG8_SB(0, 1), cB + hstep, voffB); PG8_STAGE(PG8_SA(0, 1), cA + hstep, voffA);
    if (wr == 1) PG8_BAR;
    PG8_WAIT_V(4); PG8_BAR;
    PG8_STAGE(PG8_SB(1, 0), cB + kstep, voffB); PG8_STAGE(PG8_SA(1, 0), cA + kstep, voffA); PG8_STAGE(PG8_SB(1, 1), cB + hstep + kstep, voffB);
    PG8_WAIT_V(6); PG8_BAR;
    PG8_STAMP();
    for (;;) {
        const bool has_next = S.next(ui + 1, nxt);
        const char* nA = has_next ? (const char*)g.A + (size_t)nxt.pm * tstep + nxt.kh * kslice : cA; const char* nB = has_next ? (const char*)g.Bt + (size_t)nxt.pn * tstep + nxt.kh * kslice : cB;
        const int unt = cur.nt ? cur.nt : nt;
        for (int t = 0; t < unt; t += 2) {
            const bool last = (t == unt - 2);
            const char* a1 = cA + (size_t)(t + 1) * kstep;
            const char* a2 = last ? nA : cA + (size_t)(t + 2) * kstep; const char* b2 = last ? nB : cB + (size_t)(t + 2) * kstep;
            const char* a3 = a2 + kstep; const char* b3 = b2 + kstep;
            if (last && has_next) S.a_ready(nxt);
            PG8_LDB(B0, 0, 0); PG8_SCHED; PG8_LDA(At, 0, 0); PG8_STAGE(PG8_SA(1, 1), a1 + hstep, voffA);
            PG8_WAIT_L(8); PG8_BAR; PG8_WAIT_L(0); PG8_MMA(0, 0, At, B0); PG8_BAR; PG8_SCHED;
            PG8_LDB(B1, 0, 1); PG8_STAGE(PG8_SB(0, 0), b2, voffB);
            PG8_BAR; PG8_WAIT_L(0); PG8_MMA(0, 1, At, B1); PG8_BAR;
            PG8_LDA(At, 0, 1); PG8_STAGE(PG8_SA(0, 0), a2, voffA);
            PG8_BAR; PG8_WAIT_L(0); PG8_MMA(1, 0, At, B0); PG8_BAR; PG8_SCHED;
            PG8_STAGE(PG8_SB(0, 1), b2 + hstep, voffB);
            PG8_WAIT_V(6); PG8_BAR; PG8_MMA(1, 1, At, B1); PG8_BAR;
            PG8_LDB(B0, 1, 0); PG8_SCHED; PG8_LDA(At, 1, 0); PG8_STAGE(PG8_SA(0, 1), a2 + hstep, voffA);
            PG8_WAIT_L(8); PG8_BAR; PG8_WAIT_L(0); PG8_MMA(0, 0, At, B0); PG8_BAR; PG8_SCHED;
            PG8_LDB(B1, 1, 1); PG8_STAGE(PG8_SB(1, 0), b3, voffB);
            PG8_BAR; PG8_WAIT_L(0); PG8_MMA(0, 1, At, B1); PG8_BAR;
            PG8_LDA(At, 1, 1); PG8_STAGE(PG8_SA(1, 0), a3, voffA);
            PG8_BAR; PG8_WAIT_L(0); PG8_MMA(1, 0, At, B0); PG8_BAR; PG8_SCHED;
            PG8_STAGE(PG8_SB(1, 1), b3 + hstep, voffB);
            PG8_WAIT_V(6); PG8_BAR; PG8_MMA(1, 1, At, B1); PG8_BAR;
        }
        PG8_STAMP();
        PG8_ACC_FENCE();
        if constexpr (!Epi::AFTER_DRAIN) { E(acc, cur, wr, wc, fr, fq); S.done(cur); }
        PG8_STAMP();
        if (!has_next) break;
#pragma unroll
        for (int a = 0; a < 2; ++a)
#pragma unroll
            for (int b = 0; b < 2; ++b)
#pragma unroll
                for (int m = 0; m < 4; ++m)
#pragma unroll
                    for (int n = 0; n < 2; ++n) acc[a][b][m][n] = (f32x4){0.f, 0.f, 0.f, 0.f};
        cur = nxt; cA = nA; cB = nB; ++ui;
    }
    PG8_WAIT_V(0);
    if (wr == 0) PG8_BAR;
    PG8_BAR;
    if constexpr (Epi::AFTER_DRAIN) { E.fused(acc, cur, wr, wc, fr, fq, lds, wid, lane); S.done(cur); }
    PG8_STAMP();
    if (STAMP && wid == 0) { stamps[lane] = lane < nts ? (((unsigned long long)(unsigned)ts_hi << 32) | (unsigned)ts_lo) : 0ull;
        if (lane == 62) stamps[62] = rt_entry; if (lane == 63) stamps[63] = (unsigned long long)wall_clock64(); }
#undef PG8_STAMP
#undef PG8_SA
#undef PG8_SB
#undef PG8_STAGE
#undef PG8_LDA
#undef PG8_LDB
#undef PG8_MMA
#undef PG8_ACC_FENCE
#undef PG8_ACC_FENCE1
#undef PG8_WAIT_V
#undef PG8_WAIT_L
#undef PG8_BAR
#undef PG8_SCHED
}
}

#define XB_TMO      128
#define XB_XCNT(j)  (256  + 64 * (j))
#define XB_XSUB(j)  (1280 + 64 * (j))
#define XB_XGEN(j)  (2304 + 64 * (j))
#define XB_TOP      3328
#define XB_TOPGEN   3392
#define XCD_BAR_WORDS 3456
#define XB_SPIN_CAP (1u << 20)
#define LAS __attribute__((address_space(3)))

__device__ __forceinline__ unsigned xb_ld(unsigned* p)              { return __hip_atomic_load(p, __ATOMIC_RELAXED, __HIP_MEMORY_SCOPE_AGENT); }
__device__ __forceinline__ unsigned xb_add(unsigned* p, unsigned v) { return __hip_atomic_fetch_add(p, v, __ATOMIC_RELAXED, __HIP_MEMORY_SCOPE_AGENT); }
__device__ __forceinline__ unsigned xb_xcc_id() { return (unsigned)__builtin_amdgcn_s_getreg((3 << 11) | 20) & 0xFu; }
#define XB_SPIN(cond, bar) do { unsigned _sp = 0; while (cond) { __builtin_amdgcn_s_sleep(1); \
    if ((++_sp & 255u) == 0u) { if (xb_ld(&(bar)[XB_TMO])) break; if (_sp > XB_SPIN_CAP) { atomicAdd(&(bar)[XB_TMO], 1u); break; } } } } while (0)

struct XcdBarrier {
    unsigned* bar; unsigned x;
    volatile LAS unsigned* st;
};

__device__ __forceinline__ XcdBarrier xcd_barrier_post(unsigned* bar, volatile LAS unsigned* st) {
    XcdBarrier b; b.bar = bar; b.x = xb_xcc_id(); b.st = st;
    if (threadIdx.x == 0) (void)xb_add(&bar[XB_XCNT(b.x)], 1u);
    return b;
}
__device__ __forceinline__ void xcd_barrier_complete(unsigned* bar, unsigned x, unsigned& nloc, unsigned& nx) {
    const unsigned G = gridDim.x * gridDim.y * gridDim.z;
    unsigned sum, cnt, mine, sp = 0u;
    for (;;) {
        sum = 0u; cnt = 0u; mine = 0u;
#pragma unroll
        for (unsigned j = 0; j < 16; ++j) { const unsigned c = xb_ld(&bar[XB_XCNT(j)]); sum += c; cnt += (c > 0u) ? 1u : 0u; mine = (j == x) ? c : mine; }
        if (sum == G) break;
        __builtin_amdgcn_s_sleep(1);
        if ((++sp & 255u) == 0u) { if (xb_ld(&bar[XB_TMO])) break; if (sp > XB_SPIN_CAP) { atomicAdd(&bar[XB_TMO], 1u); break; } }
    }
    nloc = mine > 0u ? mine : 1u; nx = cnt > 0u ? cnt : 1u;
}

__device__ __forceinline__ void xcd_barrier(const XcdBarrier& b) {
    asm volatile("s_waitcnt vmcnt(0)" ::: "memory");
    __syncthreads();
    if (threadIdx.x == 0) {
        unsigned* bar = b.bar;
        __builtin_amdgcn_s_waitcnt(0);
        unsigned nloc = b.st[0], nx = b.st[1];
        if (nloc == 0u) { xcd_barrier_complete(bar, b.x, nloc, nx); b.st[0] = nloc; b.st[1] = nx; }
        const unsigned old = xb_add(&bar[XB_XSUB(b.x)], 1u);
        const unsigned gen = old / nloc;
        if (old + 1u == (gen + 1u) * nloc) {
            __builtin_amdgcn_fence(__ATOMIC_RELEASE, "agent");
            asm volatile("s_waitcnt vmcnt(0)" ::: "memory");
            const unsigned og = xb_add(&bar[XB_TOP], 1u);
            const unsigned tg = og / nx;
            if (og + 1u == (tg + 1u) * nx) xb_add(&bar[XB_TOPGEN], 1u);
            else XB_SPIN(xb_ld(&bar[XB_TOPGEN]) == tg, bar);
            __builtin_amdgcn_fence(__ATOMIC_ACQUIRE, "agent");
            xb_add(&bar[XB_XGEN(b.x)], 1u);
            asm volatile("s_waitcnt vmcnt(0)" ::: "memory");
        } else {
            XB_SPIN(xb_ld(&bar[XB_XGEN(b.x)]) == gen, bar);
            __builtin_amdgcn_fence(__ATOMIC_ACQUIRE, "agent");
            asm volatile("s_waitcnt vmcnt(0)" ::: "memory");
        }
    }
    __syncthreads();
}

typedef unsigned short bf16_t;
typedef short bf16x8 __attribute__((ext_vector_type(8)));
typedef short bf16x4 __attribute__((ext_vector_type(4)));
typedef float f32x2 __attribute__((ext_vector_type(2)));
typedef float f32x4 __attribute__((ext_vector_type(4)));
typedef float f32x16 __attribute__((ext_vector_type(16)));
typedef unsigned u32x4 __attribute__((ext_vector_type(4)));
typedef unsigned u32x2 __attribute__((ext_vector_type(2)));

constexpr int D = 2048, FF = 8192, MP = 4096, MS = 8192, MT = 12288;
constexpr int NPANEL = MT / 256;
constexpr size_t MiB = 1u << 20;
constexpr size_t WS_CTL = 0, WS_MOD = 1 * MiB, WS_ZERO_BYTES = 3 * MiB;
constexpr size_t WS_ROPE = 3 * MiB;
constexpr size_t WS_W1T = 4 * MiB, WS_W2T = 132 * MiB, WS_WQKVT = 260 * MiB, WS_WOT = 284 * MiB, WS_HYINT = 300 * MiB, WS_HYOUTT = 324 * MiB;
constexpr size_t WS_RWBT = 332 * MiB, WS_LORA2T = 359 * MiB, WS_RWOT = 364 * MiB, WS_KC = 372 * MiB, WS_VC = 380 * MiB, WS_FGS = 388 * MiB, WS_FGP = 397 * MiB;
constexpr size_t WS_X = 400 * MiB, WS_H = 496 * MiB, WS_ARENA = 544 * MiB, WS_INVSQ = 1186 * MiB, WS_END = 1188 * MiB;
constexpr size_t AR_U = 0;
constexpr size_t AR_Q = 0, AR_K = 48 * MiB, AR_V = 60 * MiB, AR_O = 72 * MiB;
constexpr size_t AR_P = 0, AR_X0 = 144 * MiB, AR_ZT = 192 * MiB, AR_YT = 240 * MiB, AR_HO = 288 * MiB;
constexpr size_t AR_XMIX = 0, AR_LD = 0, AR_LA = 96 * MiB, AR_G = 192 * MiB, AR_RO = 240 * MiB, AR_R = 288 * MiB, AR_KK = 336 * MiB, AR_VV = 384 * MiB, AR_A3 = 432 * MiB, AR_YB = 450 * MiB;
constexpr size_t OUT_Y = 0, OUT_NK = 25165824, OUT_NV = 29360128, OUT_ST = 33554432;
constexpr int FGS_ROW = 2112, FGP_ROW = 576;
constexpr size_t AR_FILT = 600 * MiB;
constexpr int LDS_BAR_OFF = 147456, LDS_BYTES = 147456 + 1024;

enum { I_XP = 0, I_XS, I_CK, I_CV, I_ST, I_C, I_CCTX, I_ADAW, I_ADAB, I_N1G, I_N2G, I_MW1, I_MW2, I_WQKV, I_WO, I_SINK, I_HYWIN, I_HYCW, I_HYCB, I_FW1, I_FB1, I_FW2, I_FB2, I_FW3, I_FB3,
       I_FREQ, I_FWOUT, I_HYBIAS, I_HYWOUT, I_MU, I_WR, I_WK, I_WV, I_RWO, I_W0, I_W1, I_W2, I_A0, I_A1, I_A2, I_G1, I_G2, I_KK, I_KA, I_RK, I_LNW, I_LNB, I_FNG, N_IN };

struct Params { const float* in[N_IN]; float* out; unsigned char* ws; int ph_lo, ph_hi; };

__device__ __forceinline__ unsigned cvt_pk(float lo, float hi) { unsigned r; asm("v_cvt_pk_bf16_f32 %0, %1, %2" : "=v"(r) : "v"(lo), "v"(hi)); return r; }
__device__ __forceinline__ float bflo(unsigned w) { return __uint_as_float(w << 16); }
__device__ __forceinline__ float bfhi(unsigned w) { return __uint_as_float(w & 0xffff0000u); }
__device__ __forceinline__ float bf2f(bf16_t b) { return __uint_as_float(((unsigned)b) << 16); }
__device__ __forceinline__ float dpp_f(float x, const int ctrl) { return x; }
#define DPP_ADD(x, ctrl) ((x) + __int_as_float(__builtin_amdgcn_update_dpp(0, __float_as_int(x), (ctrl), 0xF, 0xF, true)))
__device__ __forceinline__ float wave_sum(float v) {
    v = DPP_ADD(v, 0xB1); v = DPP_ADD(v, 0x4E); v = DPP_ADD(v, 0x141); v = DPP_ADD(v, 0x140);
    const int vi = __float_as_int(v);
    const float r0 = __int_as_float(__builtin_amdgcn_readlane(vi, 0)), r1 = __int_as_float(__builtin_amdgcn_readlane(vi, 16)),
                r2 = __int_as_float(__builtin_amdgcn_readlane(vi, 32)), r3 = __int_as_float(__builtin_amdgcn_readlane(vi, 48));
    return (r0 + r1) + (r2 + r3);
}
__device__ __forceinline__ float opaque_zero() { float z; asm volatile("v_mov_b32 %0, 0" : "=v"(z)); return z; }
__device__ __forceinline__ float fexp2(float x) { return __builtin_amdgcn_exp2f(x); }
__device__ __forceinline__ float fexp(float x) { return __builtin_amdgcn_exp2f(x * 1.4426950408889634f); }
__device__ __forceinline__ float flog(float x) { return __builtin_amdgcn_logf(x) * 0.6931471805599453f; }
__device__ __forceinline__ float frcp(float x) { return __builtin_amdgcn_rcpf(x); }
__device__ __forceinline__ float fsigmoid(float x) { return frcp(1.0f + fexp(-x)); }
__device__ __forceinline__ float ftanh(float x) { const float e = fexp(2.0f * x); return 1.0f - 2.0f * frcp(e + 1.0f); }
__device__ __forceinline__ float fsoftplus(float x) { return fmaxf(x, 0.0f) + flog(1.0f + fexp(-fabsf(x))); }
__device__ __forceinline__ float fsin_rev(float rev) { return __builtin_amdgcn_sinf(rev - rintf(rev)); }
__device__ __forceinline__ float fcos_rev(float rev) { return __builtin_amdgcn_cosf(rev - rintf(rev)); }
__device__ __forceinline__ float fsin(float x) { return fsin_rev(x * 0.15915494309189535f); }
__device__ __forceinline__ int cond_of_row(int m) { return m < MP ? 0 : 1 + ((m - MP) >> 10); }
__device__ __forceinline__ int cond_of_panel(int pm) { return pm < 16 ? 0 : 1 + ((pm - 16) >> 2); }

struct Ctx {
    LAS unsigned char* lds;
    int tid, lane, wave, G, bid;
    float* out;
    unsigned char* ws;
};
template <int IDX> __device__ __forceinline__ const float* karg() {
    unsigned long long v;
    asm volatile("s_load_dwordx2 %0, %1, %2\n\ts_waitcnt lgkmcnt(0)" : "=s"(v) : "s"(__builtin_amdgcn_kernarg_segment_ptr()), "n"(IDX * 8));
    return (const float*)v;
}
#define WSP(T, off) ((T*)(C.ws + (off)))
#define MODP(l, cond, which) (WSP(float, WS_MOD) + ((size_t)((l) * 9 + (cond)) * 6 + (which)) * D)

__device__ __forceinline__ void p0_transpose_item(const float* W, int K, int N, bf16_t* WT, LAS float* scr, int item, int lane) {
    const int nblk = N / 32, kb = item / nblk, nb = item % nblk, k0 = 64 * kb, n0 = 32 * nb;
    const int rsub = lane >> 3, c4 = (lane & 7) * 4;
    f32x4 v[8];
#pragma unroll
    for (int i = 0; i < 8; ++i) v[i] = *(const f32x4*)(W + (size_t)(k0 + 8 * i + rsub) * N + n0 + c4);
#pragma unroll
    for (int i = 0; i < 8; ++i) { LAS float* d = scr + (8 * i + rsub) * 33 + c4; d[0] = v[i].x; d[1] = v[i].y; d[2] = v[i].z; d[3] = v[i].w; }
    asm volatile("s_waitcnt lgkmcnt(0)" ::: "memory");
    const int c = lane & 7;
#pragma unroll
    for (int j = 0; j < 4; ++j) { const int n = (lane >> 3) + 8 * j; const LAS float* s = scr + (8 * c) * 33 + n;
        u32x4 o; o.x = cvt_pk(s[0 * 33], s[1 * 33]); o.y = cvt_pk(s[2 * 33], s[3 * 33]); o.z = cvt_pk(s[4 * 33], s[5 * 33]); o.w = cvt_pk(s[6 * 33], s[7 * 33]);
        *(u32x4*)(WT + (size_t)(n0 + n) * K + k0 + 8 * c) = o; }
    asm volatile("s_waitcnt lgkmcnt(0)" ::: "memory");
}

__device__ __forceinline__ void late_transposes(const Ctx& C, LAS float* scr, int wv, int nwv) {
    constexpr int I_M = 8192, I_QKV = 3072, I_O = 2048;
    constexpr int NIT = 4 * I_M + I_QKV + I_O;
    for (int it = wv; it < NIT; it += nwv) {
        int r = it;
        if (r < 2 * I_M) { const int l = 2 + r / I_M; p0_transpose_item(karg<I_MW1>() + (size_t)l * D * FF, D, FF, WSP(bf16_t, WS_W1T) + (size_t)l * D * FF, scr, r % I_M, C.lane); continue; } r -= 2 * I_M;
        if (r < 2 * I_M) { const int l = 2 + r / I_M; p0_transpose_item(karg<I_MW2>() + (size_t)l * D * FF, FF, D, WSP(bf16_t, WS_W2T) + (size_t)l * D * FF, scr, r % I_M, C.lane); continue; } r -= 2 * I_M;
        if (r < I_QKV) { p0_transpose_item(karg<I_WQKV>() + (size_t)D * 3072, D, 3072, WSP(bf16_t, WS_WQKVT) + (size_t)D * 3072, scr, r, C.lane); continue; } r -= I_QKV;
        p0_transpose_item(karg<I_WO>() + (size_t)D * D, D, D, WSP(bf16_t, WS_WOT) + (size_t)D * D, scr, r, C.lane);
    }
}
#ifndef MK_PRO_MASK
#define MK_PRO_MASK 127
#endif
__device__ __forceinline__ void phase_prologue(const Ctx& C) {
    const int gw = C.bid * 8 + C.wave, NGW = C.G * 8, lane = C.lane;
    const size_t gt = (size_t)C.bid * 512 + C.tid, NGT = (size_t)C.G * 512;
    LAS float* scr = (LAS float*)(C.lds + C.wave * 16384);
    if (MK_PRO_MASK & 1)
    {
        constexpr int I_M1 = 8192, I_M2 = 8192, I_QKV = 3072, I_O = 2048, I_HI = 6144, I_SQ = 2048;
        constexpr int NIT = 2 * I_M1 + 2 * I_M2 + I_QKV + I_O + I_HI + I_SQ + 4 * I_SQ;
        for (int it = gw; it < NIT; it += NGW) {
            int r = it;
            if (r < 2 * I_M1) { const int l = r / I_M1; p0_transpose_item(karg<I_MW1>() + (size_t)l * D * FF, D, FF, WSP(bf16_t, WS_W1T) + (size_t)l * D * FF, scr, r % I_M1, lane); continue; } r -= 2 * I_M1;
            if (r < 2 * I_M2) { const int l = r / I_M2; p0_transpose_item(karg<I_MW2>() + (size_t)l * D * FF, FF, D, WSP(bf16_t, WS_W2T) + (size_t)l * D * FF, scr, r % I_M2, lane); continue; } r -= 2 * I_M2;
            if (r < I_QKV) { p0_transpose_item(karg<I_WQKV>(), D, 3072, WSP(bf16_t, WS_WQKVT), scr, r, lane); continue; } r -= I_QKV;
            if (r < I_O) { p0_transpose_item(karg<I_WO>(), D, D, WSP(bf16_t, WS_WOT), scr, r, lane); continue; } r -= I_O;
            if (r < I_HI) { p0_transpose_item(karg<I_HYWIN>(), D, 6144, WSP(bf16_t, WS_HYINT), scr, r, lane); continue; } r -= I_HI;
            if (r < I_SQ) { p0_transpose_item(karg<I_HYWOUT>(), D, D, WSP(bf16_t, WS_HYOUTT), scr, r, lane); continue; } r -= I_SQ;
            if (r < I_SQ) { p0_transpose_item(karg<I_WR>(), D, D, WSP(bf16_t, WS_RWBT), scr, r, lane); continue; } r -= I_SQ;
            if (r < I_SQ) { p0_transpose_item(karg<I_WK>(), D, D, WSP(bf16_t, WS_RWBT) + (size_t)D * D, scr, r, lane); continue; } r -= I_SQ;
            if (r < I_SQ) { p0_transpose_item(karg<I_WV>(), D, D, WSP(bf16_t, WS_RWBT) + (size_t)2 * D * D, scr, r, lane); continue; } r -= I_SQ;
            p0_transpose_item(karg<I_RWO>(), D, D, WSP(bf16_t, WS_RWOT), scr, r, lane);
        }
    }
    if (MK_PRO_MASK & 2)
    {
        bf16_t* L1 = WSP(bf16_t, WS_RWBT) + (size_t)3 * D * D;
#pragma unroll
        for (int part = 0; part < 7; ++part) {
            const int row0 = part == 0 ? 0 : part == 1 ? 96 : part == 2 ? 192 : part == 3 ? 256 : part == 4 ? 352 : part == 5 ? 448 : 512;
            const int nrow = (part == 2 || part == 5) ? 64 : (part == 6 ? 256 : 96);
            const int ld = part == 6 ? 256 : 96;
            const float* src = part == 0 ? karg<I_W1>() : part == 1 ? karg<I_W1>() + (size_t)D * 96 : part == 3 ? karg<I_A1>() : part == 4 ? karg<I_A1>() + (size_t)D * 96 : karg<I_G1>();
            const bool zero = (part == 2 || part == 5);
            for (size_t i = gt; i < (size_t)nrow * 256; i += NGT) {
                const int rr = (int)(i / 256), k8 = (int)(i % 256);
                float v[8];
#pragma unroll
                for (int j = 0; j < 8; ++j) v[j] = zero ? 0.0f : src[(size_t)(8 * k8 + j) * ld + rr];
                u32x4 o; o.x = cvt_pk(v[0], v[1]); o.y = cvt_pk(v[2], v[3]); o.z = cvt_pk(v[4], v[5]); o.w = cvt_pk(v[6], v[7]);
                *(u32x4*)(L1 + (size_t)(row0 + rr) * D + 8 * k8) = o;
            }
        }
        bf16_t* L2 = WSP(bf16_t, WS_LORA2T);
#pragma unroll
        for (int mat = 0; mat < 5; ++mat) {
            const float* src = mat == 0 ? karg<I_W2>() : mat == 1 ? karg<I_W2>() + (size_t)96 * D : mat == 2 ? karg<I_A2>() : mat == 3 ? karg<I_A2>() + (size_t)96 * D : karg<I_G2>();
            const int kofs = (mat == 1 || mat == 3) ? 96 : 0, klen = mat == 4 ? 256 : 96;
            for (size_t i = gt; i < (size_t)2048 * 32; i += NGT) {
                const int n = (int)(i / 32), k8 = (int)(i % 32);
                float v[8];
#pragma unroll
                for (int j = 0; j < 8; ++j) { const int k = 8 * k8 + j - kofs; const int kc = k < 0 ? 0 : (k >= klen ? klen - 1 : k); const float x = src[(size_t)kc * D + n]; v[j] = (k >= 0 && k < klen) ? x : 0.0f; }
                u32x4 o; o.x = cvt_pk(v[0], v[1]); o.y = cvt_pk(v[2], v[3]); o.z = cvt_pk(v[4], v[5]); o.w = cvt_pk(v[6], v[7]);
                *(u32x4*)(L2 + ((size_t)mat * 2048 + n) * 256 + 8 * k8) = o;
            }
        }
    }
    if (MK_PRO_MASK & 4)
    for (size_t i = gt; i < 2048; i += NGT) {
        const int pos = (int)(i >> 5), fi = (int)(i & 31);
        const float inv = fexp2(-(float)(2 * fi) * (13.287712379549449f / 64.0f));
        const float rev = (float)pos * inv * 0.15915494309189535f;
        WSP(f32x2, WS_ROPE)[i] = (f32x2){fcos_rev(rev), fsin_rev(rev)};
    }
    for (size_t i = gt; i < (size_t)MT * 32 / 4; i += NGT) WSP(f32x4, WS_INVSQ)[i] = (f32x4){0.f, 0.f, 0.f, 0.f};
    if (MK_PRO_MASK & 8)
    { const float *ckp = karg<I_CK>(), *cvp = karg<I_CV>();
    for (size_t i = gt; i < (size_t)2 * 524288; i += NGT) {
        const bool isv = i >= 524288; const size_t e = (isv ? i - 524288 : i) * 8;
        const float* src = (isv ? cvp : ckp) + e;
        const f32x4 a = *(const f32x4*)src, b = *(const f32x4*)(src + 4);
        u32x4 o; o.x = cvt_pk(a.x, a.y); o.y = cvt_pk(a.z, a.w); o.z = cvt_pk(b.x, b.y); o.w = cvt_pk(b.z, b.w);
        *(u32x4*)(WSP(bf16_t, isv ? WS_VC : WS_KC) + e) = o;
    } }
    if (MK_PRO_MASK & 32)
    {
        __syncthreads();
        LAS float* tab = (LAS float*)C.lds;
        LAS float* red = (LAS float*)(C.lds + 73728);
        const float *cctx = karg<I_CCTX>(), *cc = karg<I_C>();
        for (int e = C.tid; e < 9 * D; e += 512) { const int j = e >> 11, k = e & (D - 1);
            const float cv = j == 0 ? cctx[k] : cc[(size_t)(j == 0 ? 0 : j - 1) * D + k]; tab[e] = cv * fsigmoid(cv); }
        __syncthreads();
        const float* adaw = karg<I_ADAW>(); const float* adab = karg<I_ADAB>();
        for (int it = C.bid; it < 4 * 192; it += C.G) {
            const int nb = it % 192, l = it / 192, w = C.wave;
            float acc[9];
#pragma unroll
            for (int j = 0; j < 9; ++j) acc[j] = 0.f;
            const float* wp = adaw + ((size_t)l * D + 256 * w) * (6 * D) + nb * 64 + lane;
#pragma unroll 4
            for (int k4 = 0; k4 < 256; k4 += 4) {
                const float w0 = wp[(size_t)(k4 + 0) * (6 * D)], w1 = wp[(size_t)(k4 + 1) * (6 * D)], w2 = wp[(size_t)(k4 + 2) * (6 * D)], w3 = wp[(size_t)(k4 + 3) * (6 * D)];
#pragma unroll
                for (int j = 0; j < 9; ++j) { const f32x4 sv = *(const LAS f32x4*)(tab + j * D + 256 * w + k4); acc[j] += (w0 * sv.x + w1 * sv.y) + (w2 * sv.z + w3 * sv.w); }
            }
#pragma unroll
            for (int j = 0; j < 9; ++j) red[(w * 9 + j) * 64 + lane] = acc[j];
            __syncthreads();
            for (int e = C.tid; e < 9 * 64; e += 512) { const int j = e >> 6, c = e & 63; float sum = adab[(size_t)l * 6 * D + nb * 64 + c];
#pragma unroll
                for (int ww = 0; ww < 8; ++ww) sum += red[(ww * 9 + j) * 64 + c];
                WSP(float, WS_MOD)[((size_t)l * 9 + j) * 6 * D + nb * 64 + c] = sum; }
            __syncthreads();
        }
    }
    if (MK_PRO_MASK & 64)
    {
        const float *fw1 = karg<I_FW1>(), *fw2 = karg<I_FW2>(), *fw3 = karg<I_FW3>(), *fwout = karg<I_FWOUT>(), *hbias = karg<I_HYBIAS>();
        const float fq = karg<I_FREQ>()[lane]; const float fb1 = karg<I_FB1>()[lane], fb2 = karg<I_FB2>()[lane], fb3 = karg<I_FB3>()[lane];
        for (int it = C.bid; it < 160; it += C.G) {
            const bool smp = it >= 32; const int nbase = (smp ? it - 32 : it) * 8; const int L = smp ? 1024 : 256; const int n = nbase + C.wave;
            float* FILT = WSP(float, WS_ARENA + AR_FILT) + (smp ? 0 : (size_t)1024 * 4096);
            __syncthreads();
            if (lane < 33) {
                float z;
                if (lane == 0) z = (float)n / (float)(L - 1);
                else { const int i = (lane - 1) & 15; const float fr = 1e-4f + (float)i * ((15.0f - 1e-4f) / 15.0f); const float rev = fr * (float)n / (float)L;
                       z = lane <= 16 ? fcos_rev(rev) : -fsin_rev(rev); }
                scr[lane] = z;
            }
            asm volatile("s_waitcnt lgkmcnt(0)" ::: "memory");
            float pre = fb1;
#pragma unroll 3
            for (int e = 0; e < 33; ++e) pre += scr[e] * fw1[e * 64 + lane];
            float hv = fsin(fq * pre);
            asm volatile("s_waitcnt lgkmcnt(0)" ::: "memory");
            scr[64 + lane] = hv;
            asm volatile("s_waitcnt lgkmcnt(0)" ::: "memory");
            pre = fb2;
#pragma unroll 4
            for (int e = 0; e < 64; ++e) pre += scr[64 + e] * fw2[e * 64 + lane];
            hv = fsin(fq * pre);
            asm volatile("s_waitcnt lgkmcnt(0)" ::: "memory");
            scr[128 + lane] = hv;
            asm volatile("s_waitcnt lgkmcnt(0)" ::: "memory");
            pre = fb3;
#pragma unroll 4
            for (int e = 0; e < 64; ++e) pre += scr[128 + e] * fw3[e * 64 + lane];
            hv = fsin(fq * pre);
            scr[1024 + lane] = hv;
            __syncthreads();
            float acc[8][8];
#pragma unroll
            for (int nn = 0; nn < 8; ++nn)
#pragma unroll
                for (int i = 0; i < 8; ++i) acc[nn][i] = 0.f;
            const float* wo = fwout + 512 * C.wave + lane;
#pragma unroll 2
            for (int e = 0; e < 64; ++e) {
                float wv[8];
#pragma unroll
                for (int i = 0; i < 8; ++i) wv[i] = wo[(size_t)e * 4096 + i * 64];
#pragma unroll
                for (int nn = 0; nn < 8; ++nn) { const float hh = ((const LAS float*)(C.lds + nn * 16384))[1024 + e];
#pragma unroll
                    for (int i = 0; i < 8; ++i) acc[nn][i] += hh * wv[i]; }
            }
#pragma unroll
            for (int nn = 0; nn < 8; ++nn) { const int n2 = nbase + nn; const float tn = (float)n2 / (float)(L - 1);
#pragma unroll
                for (int i = 0; i < 8; ++i) {
                    const int o = 512 * C.wave + i * 64 + lane, dir = o >> 11, c = o & 2047;
                    const float delta = -3.0701134573253944f + (float)c * ((-15.350567286626972f + 3.0701134573253944f) / 2047.0f);
                    float val = acc[nn][i] * fexp(-tn * fabsf(delta));
                    if (dir == 0 && n2 == 0) val += hbias[c];
                    FILT[(size_t)n2 * 4096 + o] = val;
                } }
        }
        __syncthreads();
    }
}

__device__ __forceinline__ void phase_fg_transpose(const Ctx& C) {
    const int tid = C.tid;
    LAS float* tl = (LAS float*)C.lds;
    for (int it = C.bid; it < 1280; it += C.G) {
        const bool smp = it < 1024; const int q = smp ? it : it - 1024;
        const int L = smp ? 1024 : 256, ROW = smp ? FGS_ROW : FGP_ROW;
        const int cbk = q & 31, nb = smp ? (q >> 5) & 15 : (q >> 5) & 3, dir = smp ? q >> 9 : q >> 7;
        const float* FILT = WSP(float, WS_ARENA + AR_FILT) + (smp ? 0 : (size_t)1024 * 4096);
        bf16_t* FG = WSP(bf16_t, smp ? WS_FGS : WS_FGP);
        const int n0 = nb * 64 + dir;
        __syncthreads();
        { const int nl = tid >> 3, c8 = tid & 7; const int n = n0 + nl;
          f32x4 a = (f32x4){0.f, 0.f, 0.f, 0.f}, b = a;
          const int nc = n < L ? n : L - 1;
          const float* src = FILT + (size_t)nc * 4096 + dir * 2048 + cbk * 64 + 8 * c8;
          a = *(const f32x4*)src; b = *(const f32x4*)(src + 4);
          if (n >= L) { a = (f32x4){0.f, 0.f, 0.f, 0.f}; b = a; }
          LAS float* d = tl + nl * 65 + 8 * c8;
          d[0] = a.x; d[1] = a.y; d[2] = a.z; d[3] = a.w; d[4] = b.x; d[5] = b.y; d[6] = b.z; d[7] = b.w; }
        __syncthreads();
        { const int cl = tid >> 3, i8 = tid & 7;
          float v[8];
#pragma unroll
          for (int j = 0; j < 8; ++j) { const int il = 8 * i8 + j; const int nl = dir ? il : 63 - il; v[j] = tl[nl * 65 + cl]; }
          const int idx0 = dir ? (L + nb * 64) : (L - 64 - nb * 64);
          u32x4 o; o.x = cvt_pk(v[0], v[1]); o.y = cvt_pk(v[2], v[3]); o.z = cvt_pk(v[4], v[5]); o.w = cvt_pk(v[6], v[7]);
          bf16_t* dst = FG + (size_t)(cbk * 64 + cl) * ROW;
          *(u32x4*)(dst + idx0 + 8 * i8) = o;
          if (dir && nb * 64 + 64 == L) *(u32x4*)(dst + 2 * L + 8 * i8) = (u32x4){0u, 0u, 0u, 0u}; }
    }
    __syncthreads();
}

__device__ __forceinline__ void phase_norm_mod(const Ctx& C, const float* Xp, const float* Xs, const float* g, int layer, int which_sh, bf16_t* H, const bf16_t* P1 = nullptr, float* Xw = nullptr) {
    const int gw = C.bid * 8 + C.wave, NGW = C.G * 8, lane = C.lane;
    for (int m = gw; m < MT; m += NGW) {
        const int cond = cond_of_row(m);
        const float* sh = MODP(layer, cond, which_sh); const float* sc = MODP(layer, cond, which_sh + 1);
        const f32x4* xr = (const f32x4*)(m < MP ? Xp + (size_t)m * D : Xs + (size_t)(m - MP) * D) + lane;
        f32x4 v[8]; float ss = 0.f;
#pragma unroll
        for (int j = 0; j < 8; ++j) { v[j] = xr[64 * j]; if (P1) { const u32x2 pw = ((const u32x2*)(P1 + (size_t)m * D) + lane)[64 * j]; v[j] += (f32x4){bflo(pw.x), bfhi(pw.x), bflo(pw.y), bfhi(pw.y)}; ((f32x4*)(Xw + (size_t)m * D) + lane)[64 * j] = v[j]; }
            ss += (v[j].x * v[j].x + v[j].y * v[j].y) + (v[j].z * v[j].z + v[j].w * v[j].w); }
        const float rstd = __builtin_amdgcn_rsqf(wave_sum(ss) * (1.0f / D) + 1e-6f);
        u32x2* o = (u32x2*)(H + (size_t)m * D) + lane;
#pragma unroll
        for (int j = 0; j < 8; ++j) {
            const f32x4 gv = ((const f32x4*)g)[lane + 64 * j], sv = ((const f32x4*)sh)[lane + 64 * j], cv = ((const f32x4*)sc)[lane + 64 * j];
            const f32x4 y = (v[j] * rstd * gv) * (cv + 1.0f) + sv;
            u32x2 w; w.x = cvt_pk(y.x, y.y); w.y = cvt_pk(y.z, y.w); o[64 * j] = w;
        }
    }
}
__device__ __forceinline__ void phase_norm_final(const Ctx& C, const float* X, const float* g, float* out, const bf16_t* P1 = nullptr) {
    const int gw = C.bid * 8 + C.wave, NGW = C.G * 8, lane = C.lane;
    for (int m = gw; m < MT; m += NGW) {
        const f32x4* xr = (const f32x4*)(X + (size_t)m * D) + lane;
        f32x4 v[8]; float ss = 0.f;
#pragma unroll
        for (int j = 0; j < 8; ++j) { v[j] = xr[64 * j]; if (P1) { const u32x2 pw = ((const u32x2*)(P1 + (size_t)m * D) + lane)[64 * j]; v[j] += (f32x4){bflo(pw.x), bfhi(pw.x), bflo(pw.y), bfhi(pw.y)}; } ss += (v[j].x * v[j].x + v[j].y * v[j].y) + (v[j].z * v[j].z + v[j].w * v[j].w); }
        const float rstd = __builtin_amdgcn_rsqf(wave_sum(ss) * (1.0f / D) + 1e-6f);
        f32x4* o = (f32x4*)(out + (size_t)m * D) + lane;
#pragma unroll
        for (int j = 0; j < 8; ++j) o[64 * j] = v[j] * rstd * ((const f32x4*)g)[lane + 64 * j];
    }
}

__device__ __forceinline__ void unpack8(const u32x4 w, float (&f)[8]) { f[0] = bflo(w.x); f[1] = bfhi(w.x); f[2] = bflo(w.y); f[3] = bfhi(w.y); f[4] = bflo(w.z); f[5] = bfhi(w.z); f[6] = bflo(w.w); f[7] = bfhi(w.w); }
__device__ __forceinline__ u32x4 pack8(const float (&f)[8]) { u32x4 o; o.x = cvt_pk(f[0], f[1]); o.y = cvt_pk(f[2], f[3]); o.z = cvt_pk(f[4], f[5]); o.w = cvt_pk(f[6], f[7]); return o; }
__device__ __forceinline__ void phase_norm_mod_b(const Ctx& C, const bf16_t* X, const float* g, int layer, int which_sh, bf16_t* H, const bf16_t* P1 = nullptr, bf16_t* Xw = nullptr, int p1_row0 = 0) {
    const int gw = C.bid * 8 + C.wave, NGW = C.G * 8, lane = C.lane;
    f32x4 gv[4][2];
#pragma unroll
    for (int j = 0; j < 4; ++j)
#pragma unroll
        for (int h = 0; h < 2; ++h) gv[j][h] = ((const f32x4*)g)[2 * (lane + 64 * j) + h];
    u32x4 xa[4], pa[4]; f32x4 sv[4][2], cv[4][2];
#define NM_LOAD(m_) do { const int cond_ = cond_of_row(m_); const f32x4* sh_ = (const f32x4*)MODP(layer, cond_, which_sh); const f32x4* sc_ = (const f32x4*)MODP(layer, cond_, which_sh + 1); \
        _Pragma("unroll") for (int j = 0; j < 4; ++j) { xa[j] = ((const u32x4*)(X + (size_t)(m_) * D) + lane)[64 * j]; if (P1 && (m_) >= p1_row0) pa[j] = ((const u32x4*)(P1 + (size_t)(m_) * D) + lane)[64 * j]; } \
        _Pragma("unroll") for (int j = 0; j < 4; ++j) { _Pragma("unroll") for (int h = 0; h < 2; ++h) { const int ci_ = 2 * (lane + 64 * j) + h; sv[j][h] = sh_[ci_]; cv[j][h] = sc_[ci_]; } } } while (0)
    int m = gw;
    if (m < MT) NM_LOAD(m);
    for (; m < MT; m += NGW) {
        const bool fold = P1 && m >= p1_row0;
        float v[4][8]; float ss = 0.f;
#pragma unroll
        for (int j = 0; j < 4; ++j) {
            unpack8(xa[j], v[j]);
            if (fold) { float p[8]; unpack8(pa[j], p);
#pragma unroll
                for (int e = 0; e < 8; ++e) v[j][e] += p[e]; }
#pragma unroll
            for (int e = 0; e < 8; ++e) ss += v[j][e] * v[j][e];
        }
        const float rstd = __builtin_amdgcn_rsqf(wave_sum(ss) * (1.0f / D) + 1e-6f);
        u32x4 xo[4], ho[4];
#pragma unroll
        for (int j = 0; j < 4; ++j) {
            if (fold) xo[j] = pack8(v[j]);
            float y[8];
#pragma unroll
            for (int h = 0; h < 2; ++h)
#pragma unroll
                for (int e = 0; e < 4; ++e) y[4 * h + e] = (v[j][4 * h + e] * rstd * gv[j][h][e]) * (cv[j][h][e] + 1.0f) + sv[j][h][e];
            ho[j] = pack8(y);
        }
        const int mn = m + NGW;
        if (mn < MT) NM_LOAD(mn);
        asm volatile("" ::: "memory");
#pragma unroll
        for (int j = 0; j < 4; ++j) { if (fold) ((u32x4*)(Xw + (size_t)m * D) + lane)[64 * j] = xo[j]; ((u32x4*)(H + (size_t)m * D) + lane)[64 * j] = ho[j]; }
    }
#undef NM_LOAD
}
__device__ __forceinline__ void phase_norm_final_b(const Ctx& C, const bf16_t* X, const float* g, float* out, const bf16_t* P1 = nullptr) {
    const int gw = C.bid * 8 + C.wave, NGW = C.G * 8, lane = C.lane;
    for (int m = gw; m < MT; m += NGW) {
        const u32x4* xr = (const u32x4*)(X + (size_t)m * D) + lane;
        float v[4][8]; float ss = 0.f;
#pragma unroll
        for (int j = 0; j < 4; ++j) {
            unpack8(xr[64 * j], v[j]);
            if (P1) { float p[8]; unpack8(((const u32x4*)(P1 + (size_t)m * D) + lane)[64 * j], p);
#pragma unroll
                for (int e = 0; e < 8; ++e) v[j][e] += p[e]; }
#pragma unroll
            for (int e = 0; e < 8; ++e) ss += v[j][e] * v[j][e];
        }
        const float rstd = __builtin_amdgcn_rsqf(wave_sum(ss) * (1.0f / D) + 1e-6f);
        f32x4* o = (f32x4*)(out + (size_t)m * D);
#pragma unroll
        for (int j = 0; j < 4; ++j)
#pragma unroll
            for (int h = 0; h < 2; ++h) {
                const int ci = 2 * (lane + 64 * j) + h;
                const f32x4 gv = ((const f32x4*)g)[ci];
                f32x4 y;
#pragma unroll
                for (int e = 0; e < 4; ++e) y[e] = v[j][4 * h + e] * rstd * gv[e];
                o[ci] = y;
            }
    }
}

using pg8::Unit;
constexpr int HALF = 128;

struct EpiResidual {
    static constexpr bool PERM = false, AFTER_DRAIN = false;
    float* X; const float* gate_base;
    const float *Bp, *Bs;
    __device__ __forceinline__ void operator()(const f32x4 (&acc)[2][2][4][2], const Unit& u, int wr, int wc, int fr, int fq) const {
        const int row0 = u.pm * 256 + wr * 64 + fr, col0 = u.pn * 256 + wc * 32 + 4 * fq;
        const float* gp = gate_base + (size_t)cond_of_panel(u.pm) * 6 * D + col0;
        f32x4 gv[2][2];
#pragma unroll
        for (int bj = 0; bj < 2; ++bj)
#pragma unroll
            for (int n = 0; n < 2; ++n) gv[bj][n] = *(const f32x4*)(gp + bj * HALF + n * 16);
        const float* sbase = (u.pm < 16 ? Bp + (size_t)row0 * D : Bs + (size_t)(row0 - MP) * D) + col0;
#pragma unroll
        for (int ai = 0; ai < 2; ++ai) {
            f32x4 q[4][2][2];
#pragma unroll
            for (int m = 0; m < 4; ++m)
#pragma unroll
                for (int bj = 0; bj < 2; ++bj)
#pragma unroll
                    for (int n = 0; n < 2; ++n) if ((u.mask >> (ai * 2 + bj)) & 1) q[m][bj][n] = *(const f32x4*)(sbase + (size_t)(ai * HALF + m * 16) * D + bj * HALF + n * 16);
#pragma unroll
            for (int m = 0; m < 4; ++m) { float* rowp = X + (size_t)(row0 + ai * HALF + m * 16) * D + col0;
#pragma unroll
                for (int bj = 0; bj < 2; ++bj)
#pragma unroll
                    for (int n = 0; n < 2; ++n) if ((u.mask >> (ai * 2 + bj)) & 1) *(f32x4*)(rowp + bj * HALF + n * 16) = q[m][bj][n] + gv[bj][n] * acc[ai][bj][m][n]; }
            asm volatile("" ::: "memory");
        }
    }
};
template <int ACT> struct EpiBf16 {
    static constexpr bool PERM = true, AFTER_DRAIN = false;
    bf16_t* O; int ldc;
    __device__ __forceinline__ void operator()(const f32x4 (&acc)[2][2][4][2], const Unit& u, int wr, int wc, int fr, int fq) const {
        const int row0 = u.pm * 256 + wr * 64 + fr, col0 = u.pn * 256 + wc * 32 + 8 * fq;
#pragma unroll
        for (int ai = 0; ai < 2; ++ai)
#pragma unroll
            for (int m = 0; m < 4; ++m) { bf16_t* rowp = O + (size_t)(row0 + ai * HALF + m * 16) * ldc + col0;
#pragma unroll
                for (int bj = 0; bj < 2; ++bj) { if (!((u.mask >> (ai * 2 + bj)) & 1)) continue; f32x4 v0 = acc[ai][bj][m][0], v1 = acc[ai][bj][m][1];
                    if (ACT == 1) {
#pragma unroll
                        for (int j = 0; j < 4; ++j) { const float a = fmaxf(v0[j], 0.f), b = fmaxf(v1[j], 0.f); v0[j] = a * a; v1[j] = b * b; } }
                    u32x4 w; w.x = cvt_pk(v0[0], v0[1]); w.y = cvt_pk(v0[2], v0[3]); w.z = cvt_pk(v1[0], v1[1]); w.w = cvt_pk(v1[2], v1[3]);
                    *(u32x4*)(rowp + bj * HALF) = w; } }
    }
};
struct EpiQKV {
    static constexpr bool PERM = true, AFTER_DRAIN = false;
    bf16_t *Q, *K, *V; float *NK, *NV;
    __device__ __forceinline__ void operator()(const f32x4 (&acc)[2][2][4][2], const Unit& u, int wr, int wc, int fr, int fq) const {
        const int row0 = u.pm * 256 + wr * 64 + fr; const int cin = wc * 32 + 8 * fq;
        bf16_t* base; int ldc, colt; float* fo = nullptr;
        if (u.pn < 8) { base = Q; ldc = 2048; colt = u.pn * 256; }
        else if (u.pn < 10) { base = K; ldc = 512; colt = (u.pn - 8) * 256; if (u.pm < 16) fo = NK; }
        else { base = V; ldc = 512; colt = (u.pn - 10) * 256; if (u.pm < 16) fo = NV; }
#pragma unroll
        for (int ai = 0; ai < 2; ++ai)
#pragma unroll
            for (int m = 0; m < 4; ++m) { const int r = row0 + ai * HALF + m * 16; bf16_t* rowp = base + (size_t)r * ldc + colt + cin;
#pragma unroll
                for (int bj = 0; bj < 2; ++bj) { if (!((u.mask >> (ai * 2 + bj)) & 1)) continue; const f32x4 v0 = acc[ai][bj][m][0], v1 = acc[ai][bj][m][1];
                    u32x4 w; w.x = cvt_pk(v0[0], v0[1]); w.y = cvt_pk(v0[2], v0[3]); w.z = cvt_pk(v1[0], v1[1]); w.w = cvt_pk(v1[2], v1[3]);
                    *(u32x4*)(rowp + bj * HALF) = w;
                    if (fo) { float* fp = fo + ((size_t)(r >> 8) * 512 + (r & 255)) * 512 + colt + cin + bj * HALF; *(f32x4*)fp = v0; *(f32x4*)(fp + 4) = v1; } } }
    }
};
__device__ __forceinline__ size_t hm_index(int m, int c) { return ((size_t)(c >> 6) * MT + m) * 64 + (c & 63); }
struct EpiRw1 {
    static constexpr bool PERM = true, AFTER_DRAIN = false;
    bf16_t *R, *A3;
    const float* k_k; float* invsq;
    __device__ __forceinline__ void operator()(const f32x4 (&acc)[2][2][4][2], const Unit& u, int wr, int wc, int fr, int fq) const {
        const int ct = u.pn, panel = u.pm % NPANEL;
        const int row0 = panel * 256 + wr * 64 + fr; const int cin = wc * 32 + 8 * fq;
        bf16_t* base; int ldc, colt, act = 0;
        if (ct < 24) { base = R + (size_t)(ct >> 3) * MT * D; ldc = D; colt = (ct & 7) * 256; }
        else { base = A3 + (size_t)(ct - 24) * MT * 256; ldc = 256; colt = 0; act = ct - 23; }
#pragma unroll
        for (int ai = 0; ai < 2; ++ai)
#pragma unroll
            for (int m = 0; m < 4; ++m) { const int rrow = row0 + ai * HALF + m * 16; bf16_t* rowp = base + (size_t)rrow * ldc + colt + cin;
#pragma unroll
                for (int bj = 0; bj < 2; ++bj) { if (!((u.mask >> (ai * 2 + bj)) & 1)) continue; f32x4 v0 = acc[ai][bj][m][0], v1 = acc[ai][bj][m][1];
                    if (act == 1) {
#pragma unroll
                        for (int j = 0; j < 4; ++j) { v0[j] = ftanh(v0[j]); v1[j] = ftanh(v1[j]); } }
                    else if (act == 3) {
#pragma unroll
                        for (int j = 0; j < 4; ++j) { v0[j] = fsigmoid(v0[j]); v1[j] = fsigmoid(v1[j]); } }
                    u32x4 w; w.x = cvt_pk(v0[0], v0[1]); w.y = cvt_pk(v0[2], v0[3]); w.z = cvt_pk(v1[0], v1[1]); w.w = cvt_pk(v1[2], v1[3]);
                    if (ct < 24) *(u32x4*)(base + hm_index(rrow, colt + cin + bj * HALF)) = w; else *(u32x4*)(rowp + bj * HALF) = w;
} }
    }
};
struct EpiRw2 {
    static constexpr bool PERM = true, AFTER_DRAIN = false;
    bf16_t *LD, *LA, *Gt; const float *w0, *a0;
    __device__ __forceinline__ void operator()(const f32x4 (&acc)[2][2][4][2], const Unit& u, int wr, int wc, int fr, int fq) const {
        const int ct = u.pn, panel = u.pm % NPANEL, grp = ct >> 3;
        const int row0 = panel * 256 + wr * 64 + fr; const int col0 = (ct & 7) * 256 + wc * 32 + 8 * fq;
        bf16_t* base; const float* bias = nullptr;
        if (grp < 2) { base = LD + (size_t)grp * MT * D; bias = w0 + grp * D; }
        else if (grp < 4) { base = LA + (size_t)(grp - 2) * MT * D; bias = a0 + (grp - 2) * D; }
        else base = Gt;
        f32x4 bv[2][2];
#pragma unroll
        for (int bj = 0; bj < 2; ++bj)
#pragma unroll
            for (int n = 0; n < 2; ++n) bv[bj][n] = bias ? *(const f32x4*)(bias + col0 + bj * HALF + 4 * n) : (f32x4){0.f, 0.f, 0.f, 0.f};
#pragma unroll
        for (int ai = 0; ai < 2; ++ai)
#pragma unroll
            for (int m = 0; m < 4; ++m) { const int rrow = row0 + ai * HALF + m * 16; bf16_t* rowp = base + (size_t)rrow * D + col0;
#pragma unroll
                for (int bj = 0; bj < 2; ++bj) {
                    f32x4 v0 = acc[ai][bj][m][0] + bv[bj][0], v1 = acc[ai][bj][m][1] + bv[bj][1];
                    if (grp < 2) {
#pragma unroll
                        for (int j = 0; j < 4; ++j) { v0[j] = -fexp(-fsoftplus(-v0[j]) - 0.5f); v1[j] = -fexp(-fsoftplus(-v1[j]) - 0.5f); } }
                    u32x4 w; w.x = cvt_pk(v0[0], v0[1]); w.y = cvt_pk(v0[2], v0[3]); w.z = cvt_pk(v1[0], v1[1]); w.w = cvt_pk(v1[2], v1[3]);
                    if (grp < 4) *(u32x4*)(base + hm_index(rrow, col0 + bj * HALF)) = w; else *(u32x4*)(rowp + bj * HALF) = w; }
                asm volatile("" : "+v"(bv[0][0]), "+v"(bv[0][1]), "+v"(bv[1][0]), "+v"(bv[1][1]));
            }
    }
};
struct RwOrder1 {
    int G, c;
    __device__ __forceinline__ bool next(int i, Unit& u) const { const int L = i * G + c; if (L >= 27 * NPANEL) return false; u.mask = 15; const int panel = L / 27, ct = L % 27; const int ai = ct < 24 ? (ct >> 3) : ct - 21; u.pm = ai * NPANEL + panel; u.pn = ct; u.kh = 0; return true; }
    __device__ __forceinline__ void a_ready(const Unit&) const {}
    __device__ __forceinline__ void done(const Unit&) const {}
};
struct RwOrder2 {
    int G, c;
    __device__ __forceinline__ bool next(int i, Unit& u) const { const int L = i * G + c; if (L >= 40 * NPANEL) return false; const int panel = L / 40, ct = L % 40; const int ai = ct < 16 ? 0 : (ct < 32 ? 1 : 2); u.pm = ai * NPANEL + panel; u.pn = ct; u.kh = 0; u.mask = 15; return true; }
    __device__ __forceinline__ void a_ready(const Unit&) const {}
    __device__ __forceinline__ void done(const Unit&) const {}
};

struct SplitOrder {
    pg8::StaticOrder so; int G, c, ntiles;
    __device__ __forceinline__ void init(int N, int G_, int c_) { so.init(MT, N, G_, c_); G = G_; c = c_; ntiles = so.nwg; }
    __device__ __forceinline__ bool next(int i, Unit& u) const { const int L = i * G + c; if (L >= 2 * ntiles) return false; const int kh = L >= ntiles; so.map(kh ? L - ntiles : L, u); u.kh = kh; u.mask = 15; return true; }
    __device__ __forceinline__ void a_ready(const Unit&) const {}
    __device__ __forceinline__ void done(const Unit&) const {}
};
struct EpiResidualSplit {
    static constexpr bool PERM = false, AFTER_DRAIN = false;
    float* X; const float* gate_base; bf16_t* P1;
    __device__ __forceinline__ void operator()(const f32x4 (&acc)[2][2][4][2], const Unit& u, int wr, int wc, int fr, int fq) const {
        const int row0 = u.pm * 256 + wr * 64 + fr, col0 = u.pn * 256 + wc * 32 + 4 * fq;
        const float* gp = gate_base + (size_t)cond_of_panel(u.pm) * 6 * D + col0;
        f32x4 gv[2][2];
#pragma unroll
        for (int bj = 0; bj < 2; ++bj)
#pragma unroll
            for (int n = 0; n < 2; ++n) gv[bj][n] = *(const f32x4*)(gp + bj * HALF + n * 16);
        if (u.kh == 0) {
#pragma unroll
            for (int ai = 0; ai < 2; ++ai) {
                f32x4 q[4][2][2];
#pragma unroll
                for (int m = 0; m < 4; ++m)
#pragma unroll
                    for (int bj = 0; bj < 2; ++bj)
#pragma unroll
                        for (int n = 0; n < 2; ++n) q[m][bj][n] = *(const f32x4*)(X + (size_t)(row0 + ai * HALF + m * 16) * D + col0 + bj * HALF + n * 16);
#pragma unroll
                for (int m = 0; m < 4; ++m) { float* rowp = X + (size_t)(row0 + ai * HALF + m * 16) * D + col0;
#pragma unroll
                    for (int bj = 0; bj < 2; ++bj)
#pragma unroll
                        for (int n = 0; n < 2; ++n) *(f32x4*)(rowp + bj * HALF + n * 16) = q[m][bj][n] + gv[bj][n] * acc[ai][bj][m][n]; }
                asm volatile("" ::: "memory");
            }
        } else {
#pragma unroll
            for (int ai = 0; ai < 2; ++ai)
#pragma unroll
                for (int m = 0; m < 4; ++m) { bf16_t* rowp = P1 + (size_t)(row0 + ai * HALF + m * 16) * D + col0;
#pragma unroll
                    for (int bj = 0; bj < 2; ++bj)
#pragma unroll
                        for (int n = 0; n < 2; ++n) { const f32x4 v = gv[bj][n] * acc[ai][bj][m][n]; u32x2 w; w.x = cvt_pk(v.x, v.y); w.y = cvt_pk(v.z, v.w); *(u32x2*)(rowp + bj * HALF + n * 16) = w; } }
        }
    }
};

template <bool SRCF32> struct EpiResidualB {
    static constexpr bool PERM = true, AFTER_DRAIN = false;
    bf16_t* X; const float* gate_base; const float *Bp, *Bs;
    __device__ __forceinline__ void operator()(const f32x4 (&acc)[2][2][4][2], const Unit& u, int wr, int wc, int fr, int fq) const {
        const int row0 = u.pm * 256 + wr * 64 + fr, col0 = u.pn * 256 + wc * 32 + 8 * fq;
        const float* gp = gate_base + (size_t)cond_of_panel(u.pm) * 6 * D + col0;
        f32x4 gv[2][2];
#pragma unroll
        for (int bj = 0; bj < 2; ++bj)
#pragma unroll
            for (int n = 0; n < 2; ++n) gv[bj][n] = *(const f32x4*)(gp + bj * HALF + 4 * n);
#pragma unroll
        for (int ai = 0; ai < 2; ++ai) {
            if constexpr (SRCF32) {
                const float* sbase = (u.pm < 16 ? Bp + (size_t)row0 * D : Bs + (size_t)(row0 - MP) * D) + col0;
                f32x4 q[4][2][2];
#pragma unroll
                for (int m = 0; m < 4; ++m)
#pragma unroll
                    for (int bj = 0; bj < 2; ++bj)
#pragma unroll
                        for (int n = 0; n < 2; ++n) q[m][bj][n] = *(const f32x4*)(sbase + (size_t)(ai * HALF + m * 16) * D + bj * HALF + 4 * n);
#pragma unroll
                for (int m = 0; m < 4; ++m) { bf16_t* rowp = X + (size_t)(row0 + ai * HALF + m * 16) * D + col0;
#pragma unroll
                    for (int bj = 0; bj < 2; ++bj) { const f32x4 v0 = q[m][bj][0] + gv[bj][0] * acc[ai][bj][m][0], v1 = q[m][bj][1] + gv[bj][1] * acc[ai][bj][m][1];
                        u32x4 w; w.x = cvt_pk(v0.x, v0.y); w.y = cvt_pk(v0.z, v0.w); w.z = cvt_pk(v1.x, v1.y); w.w = cvt_pk(v1.z, v1.w); *(u32x4*)(rowp + bj * HALF) = w; } }
            } else {
                u32x4 q[4][2];
#pragma unroll
                for (int m = 0; m < 4; ++m)
#pragma unroll
                    for (int bj = 0; bj < 2; ++bj) q[m][bj] = *(const u32x4*)(X + (size_t)(row0 + ai * HALF + m * 16) * D + col0 + bj * HALF);
#pragma unroll
                for (int m = 0; m < 4; ++m) { bf16_t* rowp = X + (size_t)(row0 + ai * HALF + m * 16) * D + col0;
#pragma unroll
                    for (int bj = 0; bj < 2; ++bj) { const u32x4 o = q[m][bj];
                        const f32x4 v0 = (f32x4){bflo(o.x), bfhi(o.x), bflo(o.y), bfhi(o.y)} + gv[bj][0] * acc[ai][bj][m][0], v1 = (f32x4){bflo(o.z), bfhi(o.z), bflo(o.w), bfhi(o.w)} + gv[bj][1] * acc[ai][bj][m][1];
                        u32x4 w; w.x = cvt_pk(v0.x, v0.y); w.y = cvt_pk(v0.z, v0.w); w.z = cvt_pk(v1.x, v1.y); w.w = cvt_pk(v1.z, v1.w); *(u32x4*)(rowp + bj * HALF) = w; } }
            }
            asm volatile("" ::: "memory");
        }
    }
};
struct EpiResidualSplitB {
    static constexpr bool PERM = true, AFTER_DRAIN = false;
    bf16_t* X; const float* gate_base; bf16_t* P1;
    __device__ __forceinline__ void operator()(const f32x4 (&acc)[2][2][4][2], const Unit& u, int wr, int wc, int fr, int fq) const {
        const int row0 = u.pm * 256 + wr * 64 + fr, col0 = u.pn * 256 + wc * 32 + 8 * fq;
        const float* gp = gate_base + (size_t)cond_of_panel(u.pm) * 6 * D + col0;
        f32x4 gv[2][2];
#pragma unroll
        for (int bj = 0; bj < 2; ++bj)
#pragma unroll
            for (int n = 0; n < 2; ++n) gv[bj][n] = *(const f32x4*)(gp + bj * HALF + 4 * n);
        if (u.kh == 0) {
#pragma unroll
            for (int ai = 0; ai < 2; ++ai) {
                u32x4 q[4][2];
#pragma unroll
                for (int m = 0; m < 4; ++m)
#pragma unroll
                    for (int bj = 0; bj < 2; ++bj) q[m][bj] = *(const u32x4*)(X + (size_t)(row0 + ai * HALF + m * 16) * D + col0 + bj * HALF);
#pragma unroll
                for (int m = 0; m < 4; ++m) { bf16_t* rowp = X + (size_t)(row0 + ai * HALF + m * 16) * D + col0;
#pragma unroll
                    for (int bj = 0; bj < 2; ++bj) { const u32x4 o = q[m][bj];
                        const f32x4 v0 = (f32x4){bflo(o.x), bfhi(o.x), bflo(o.y), bfhi(o.y)} + gv[bj][0] * acc[ai][bj][m][0], v1 = (f32x4){bflo(o.z), bfhi(o.z), bflo(o.w), bfhi(o.w)} + gv[bj][1] * acc[ai][bj][m][1];
                        u32x4 w; w.x = cvt_pk(v0.x, v0.y); w.y = cvt_pk(v0.z, v0.w); w.z = cvt_pk(v1.x, v1.y); w.w = cvt_pk(v1.z, v1.w); *(u32x4*)(rowp + bj * HALF) = w; } }
                asm volatile("" ::: "memory");
            }
        } else {
#pragma unroll
            for (int ai = 0; ai < 2; ++ai)
#pragma unroll
                for (int m = 0; m < 4; ++m) { bf16_t* rowp = P1 + (size_t)(row0 + ai * HALF + m * 16) * D + col0;
#pragma unroll
                    for (int bj = 0; bj < 2; ++bj) { const f32x4 v0 = gv[bj][0] * acc[ai][bj][m][0], v1 = gv[bj][1] * acc[ai][bj][m][1];
                        u32x4 w; w.x = cvt_pk(v0.x, v0.y); w.y = cvt_pk(v0.z, v0.w); w.z = cvt_pk(v1.x, v1.y); w.w = cvt_pk(v1.z, v1.w); *(u32x4*)(rowp + bj * HALF) = w; } }
        }
    }
};
struct TailSplitOrder {
    pg8::StaticOrder sf, st; int G, c;
    __device__ __forceinline__ void init(int G_, int c_) { sf.init(8192, D, G_, c_); st.init(4096, D, G_, c_); G = G_; c = c_; }
    __device__ __forceinline__ bool next(int i, Unit& u) const {
        const int L = i * G + c; if (L >= 512) return false;
        if (L < 256) { sf.map(L, u); u.kh = 0; u.nt = 32; }
        else { const int h = L - 256, kh = h >= 128; st.map(kh ? h - 128 : h, u); u.pm += 32; u.kh = kh; u.nt = 16; }
        u.mask = 15; return true; }
    __device__ __forceinline__ void a_ready(const Unit&) const {}
    __device__ __forceinline__ void done(const Unit&) const {}
};


typedef short s16x4 __attribute__((ext_vector_type(4)));
constexpr int KS_STRIDE = 136;
constexpr int VT_STRIDE = 72;
constexpr int ATT_KS_OFF = 0, ATT_VT_OFF = 64 * KS_STRIDE * 2, ATT_BUF_BYTES = 36864;

__device__ __forceinline__ void rope8(u32x4& a, u32x4& b, const f32x2* tab) {
    unsigned* pa = (unsigned*)&a; unsigned* pb = (unsigned*)&b;
#pragma unroll
    for (int w = 0; w < 4; ++w) {
        const f32x4 cs = *(const f32x4*)(tab + 2 * w);
        const float x1l = bflo(pa[w]), x1h = bfhi(pa[w]), x2l = bflo(pb[w]), x2h = bfhi(pb[w]);
        const float o1l = x1l * cs.x - x2l * cs.y, o2l = x1l * cs.y + x2l * cs.x;
        const float o1h = x1h * cs.z - x2h * cs.w, o2h = x1h * cs.w + x2h * cs.z;
        pa[w] = cvt_pk(o1l, o1h); pb[w] = cvt_pk(o2l, o2h);
    }
}

__device__ __forceinline__ void phase_attention(const Ctx& C, const bf16_t* Q, const bf16_t* Kb, const bf16_t* Vb, const bf16_t* KC, const bf16_t* VC, const float* sink, bf16_t* O) {
    const int tid = C.tid, lane = C.lane, w = C.wave, h = lane >> 5, lq = lane & 31;
    LAS bf16_t* Ks = (LAS bf16_t*)(C.lds + ATT_KS_OFF);
    LAS bf16_t* Vt = (LAS bf16_t*)(C.lds + ATT_VT_OFF);
    const f32x2* rope = WSP(f32x2, WS_ROPE);
    const float c2 = 0.08838834764831845f * 1.4426950408889634f;
    for (int it = C.bid; it < 768; it += C.G) {
        const bool smp = it < 512;
        int bb, kvh, qb, R0;
        if (smp) { bb = it >> 6; kvh = (it >> 4) & 3; qb = it & 15; R0 = MP + bb * 1024; }
        else { const int p = it - 512; bb = p >> 4; kvh = (p >> 2) & 3; qb = p & 3; R0 = bb * 256; }
        const int head = kvh * 4 + (w >> 1);
        const int t = qb * 64 + (w & 1) * 32 + lq;
        u32x4 qf[8];
        { const bf16_t* qp = Q + (size_t)(R0 + t) * D + head * 128 + 8 * h;
#pragma unroll
          for (int ks = 0; ks < 8; ++ks) qf[ks] = *(const u32x4*)(qp + 16 * ks); }
        if (smp) {
#pragma unroll
            for (int half = 0; half < 2; ++half) { const int pos = half ? (t & 63) : (t >> 6);
#pragma unroll
                for (int kk = 0; kk < 2; ++kk) rope8(qf[4 * half + kk], qf[4 * half + kk + 2], rope + pos * 32 + 16 * kk + 8 * h); }
        }
        f32x16 o[4];
#pragma unroll
        for (int db = 0; db < 4; ++db)
#pragma unroll
            for (int r = 0; r < 16; ++r) o[db][r] = 0.f;
        float mrun = -1e30f, lrun = 0.f;
        const int li0 = smp ? (qb >= 2 ? 0 : 2 - qb) : 0, li1 = smp ? (17 - qb < 4 ? 17 - qb : 4) : 0;
        const int ntot = smp ? 8 + (li1 - li0 + 1) : 4;
        const int key = tid >> 3, cc = tid & 7, c1 = (cc & 3) + (cc >> 2) * 8;
#define ATT_TILE(i, kp_, vp_, k0_, loc_) do { if (smp) { if ((i) < 8) { const size_t off_ = ((size_t)(bb * 2) * 512 + (i) * 64) * 512 + kvh * 128; kp_ = KC + off_; vp_ = VC + off_; k0_ = 0; loc_ = false; } \
            else { k0_ = qb * 64 - 128 + 64 * ((i) - 8 + li0); loc_ = true; const size_t off_ = (size_t)(R0 + k0_) * 512 + kvh * 128; kp_ = Kb + off_; vp_ = Vb + off_; } } \
          else { k0_ = (i) * 64; loc_ = false; const size_t off_ = (size_t)(R0 + k0_) * 512 + kvh * 128; kp_ = Kb + off_; vp_ = Vb + off_; } } while (0)
        u32x4 ka, kb2, va, vb2;
#define ATT_LOAD(i) do { const bf16_t *kp_, *vp_; int k0_; bool loc_; ATT_TILE(i, kp_, vp_, k0_, loc_); (void)k0_; (void)loc_; \
          ka = *(const u32x4*)(kp_ + (size_t)key * 512 + 8 * c1); kb2 = *(const u32x4*)(kp_ + (size_t)key * 512 + 8 * c1 + 32); \
          va = *(const u32x4*)(vp_ + (size_t)key * 512 + 8 * c1); vb2 = *(const u32x4*)(vp_ + (size_t)key * 512 + 8 * c1 + 32); } while (0)
#define ATT_STAGE(i, KsB, VtB) do { const bf16_t *kp_, *vp_; int k0_; bool loc_; ATT_TILE(i, kp_, vp_, k0_, loc_); (void)kp_; (void)vp_; \
          if (loc_) { const int kpos = k0_ + key; const int pos = (cc >> 2) ? (kpos & 63) : (kpos >> 6); rope8(ka, kb2, rope + pos * 32 + 8 * (cc & 3)); } \
          *(LAS u32x4*)((KsB) + key * KS_STRIDE + 8 * c1) = ka; *(LAS u32x4*)((KsB) + key * KS_STRIDE + 8 * c1 + 32) = kb2; \
          *(LAS u32x4*)((VtB) + key * KS_STRIDE + 8 * c1) = va; *(LAS u32x4*)((VtB) + key * KS_STRIDE + 8 * c1 + 32) = vb2; } while (0)
        ATT_LOAD(0); ATT_STAGE(0, Ks, Vt); if (ntot > 1) ATT_LOAD(1);
        __syncthreads();
        for (int ti = 0; ti < ntot; ++ti) {
            const bf16_t *kp, *vp; int k0; bool local; ATT_TILE(ti, kp, vp, k0, local); (void)kp; (void)vp;
            LAS bf16_t* Ks = (LAS bf16_t*)(C.lds + (ti & 1) * ATT_BUF_BYTES + ATT_KS_OFF);
            LAS bf16_t* Vt = (LAS bf16_t*)(C.lds + (ti & 1) * ATT_BUF_BYTES + ATT_VT_OFF);
            f32x16 s0, s1;
            { const float z0 = opaque_zero();
#pragma unroll
            for (int r = 0; r < 16; ++r) { s0[r] = z0; s1[r] = z0; } }
#pragma unroll
            for (int ks = 0; ks < 8; ++ks) {
                const bf16x8 a0 = *(const LAS bf16x8*)(Ks + lq * KS_STRIDE + 16 * ks + 8 * h);
                const bf16x8 a1 = *(const LAS bf16x8*)(Ks + (32 + lq) * KS_STRIDE + 16 * ks + 8 * h);
                const bf16x8 bq = __builtin_bit_cast(bf16x8, qf[ks]);
                s0 = __builtin_amdgcn_mfma_f32_32x32x16_bf16(a0, bq, s0, 0, 0, 0);
                s1 = __builtin_amdgcn_mfma_f32_32x32x16_bf16(a1, bq, s1, 0, 0, 0);
            }
            if (local) {
#pragma unroll
                for (int r = 0; r < 16; ++r) {
                    const int kl = (r & 3) + 8 * (r >> 2) + 4 * h;
                    const int d0 = k0 + kl - t, d1 = d0 + 32;
                    s0[r] = ((d0 <= 128) && (d0 >= -128)) ? s0[r] : -1e30f; s1[r] = ((d1 <= 128) && (d1 >= -128)) ? s1[r] : -1e30f;
                }
            }
            float mx = fmaxf(s0[0], s1[0]);
#pragma unroll
            for (int r = 1; r < 16; ++r) mx = fmaxf(mx, fmaxf(s0[r], s1[r]));
            mx = fmaxf(mx, __shfl_xor(mx, 32));
            const float mnew = fmaxf(mrun, mx * c2);
            const float alpha = fexp2(mrun - mnew);
            float ps = 0.f;
#pragma unroll
            for (int r = 0; r < 16; ++r) {
                const float p0 = fexp2(__builtin_fmaf(s0[r], c2, -mnew)), p1 = fexp2(__builtin_fmaf(s1[r], c2, -mnew));
                s0[r] = p0; s1[r] = p1; ps += p0 + p1;
            }
            lrun = lrun * alpha + ps; mrun = mnew;
            if (__any(alpha != 1.0f)) {
#pragma unroll
                for (int db = 0; db < 4; ++db)
#pragma unroll
                    for (int r = 0; r < 16; ++r) o[db][r] *= alpha;
            }
            u32x4 pf[4];
#pragma unroll
            for (int s = 0; s < 2; ++s) {
                pf[s].x = cvt_pk(s0[8 * s + 0], s0[8 * s + 1]); pf[s].y = cvt_pk(s0[8 * s + 2], s0[8 * s + 3]); pf[s].z = cvt_pk(s0[8 * s + 4], s0[8 * s + 5]); pf[s].w = cvt_pk(s0[8 * s + 6], s0[8 * s + 7]);
                pf[2 + s].x = cvt_pk(s1[8 * s + 0], s1[8 * s + 1]); pf[2 + s].y = cvt_pk(s1[8 * s + 2], s1[8 * s + 3]); pf[2 + s].z = cvt_pk(s1[8 * s + 4], s1[8 * s + 5]); pf[2 + s].w = cvt_pk(s1[8 * s + 6], s1[8 * s + 7]);
            }
#pragma unroll
            for (int db = 0; db < 4; ++db)
#pragma unroll
                for (int s2 = 0; s2 < 4; ++s2) {
                    const LAS bf16_t* vr = Vt + (16 * s2 + 4 * (lane >> 5) + ((lane & 15) >> 2)) * KS_STRIDE + 32 * db + 16 * ((lane >> 4) & 1) + 4 * (lane & 3);
                    const s16x4 lo = __builtin_amdgcn_ds_read_tr16_b64_v4i16((LAS s16x4*)vr), hi = __builtin_amdgcn_ds_read_tr16_b64_v4i16((LAS s16x4*)(vr + 8 * KS_STRIDE));
                    const u32x2 lo2 = __builtin_bit_cast(u32x2, lo), hi2 = __builtin_bit_cast(u32x2, hi);
                    u32x4 av; av.x = lo2.x; av.y = lo2.y; av.z = hi2.x; av.w = hi2.y;
                    o[db] = __builtin_amdgcn_mfma_f32_32x32x16_bf16(__builtin_bit_cast(bf16x8, av), __builtin_bit_cast(bf16x8, pf[s2]), o[db], 0, 0, 0);
                }
            if (ti + 1 < ntot) {
                LAS bf16_t* Ksn = (LAS bf16_t*)(C.lds + ((ti + 1) & 1) * ATT_BUF_BYTES + ATT_KS_OFF);
                LAS bf16_t* Vtn = (LAS bf16_t*)(C.lds + ((ti + 1) & 1) * ATT_BUF_BYTES + ATT_VT_OFF);
                ATT_STAGE(ti + 1, Ksn, Vtn);
                if (ti + 2 < ntot) ATT_LOAD(ti + 2);
            }
            __syncthreads();
        }
        {
            const float sk = sink[head] * 1.4426950408889634f;
            const float mnew = fmaxf(mrun, sk), alpha = fexp2(mrun - mnew);
            float l = lrun * alpha; l += __shfl_xor(l, 32); l += fexp2(sk - mnew);
            const float sc = alpha * frcp(l);
            bf16_t* op = O + (size_t)(R0 + t) * D + head * 128 + 4 * h;
#pragma unroll
            for (int db = 0; db < 4; ++db)
#pragma unroll
                for (int g4 = 0; g4 < 4; ++g4) {
                    u32x2 wv; wv.x = cvt_pk(o[db][4 * g4 + 0] * sc, o[db][4 * g4 + 1] * sc); wv.y = cvt_pk(o[db][4 * g4 + 2] * sc, o[db][4 * g4 + 3] * sc);
                    *(u32x2*)(op + 32 * db + 8 * g4) = wv;
                }
        }
    }
#undef ATT_TILE
#undef ATT_LOAD
#undef ATT_STAGE
    __syncthreads();
}

__device__ __forceinline__ void phase_hy_gate(const Ctx& C, const bf16_t* Pm, const float* cw, const float* cb, bf16_t* X0, bf16_t* ZTp, bf16_t* ZTs) {
    const int tid = C.tid;
    LAS bf16_t* zs = (LAS bf16_t*)C.lds;
    for (int it = C.bid; it < 6144; it += C.G) {
        const bool smp = it >= 2048; const int q = smp ? it - 2048 : it;
        const int cbk = q & 31, tb = smp ? (q >> 5) & 15 : (q >> 5) & 3, b = smp ? q >> 9 : q >> 7;
        const int L = smp ? 1024 : 256, R0 = smp ? MP + b * 1024 : b * 256, NB = smp ? 8 : 16;
        const int tl = tid >> 3, c8 = tid & 7, t = tb * 64 + tl, c0 = cbk * 64 + 8 * c8;
        float u[3][8];
#pragma unroll
        for (int g = 0; g < 3; ++g) {
            const int gc = g * D + c0;
            const bf16_t* pr = Pm + (size_t)(R0 + t) * 6144 + gc;
            u32x4 pm1 = *(const u32x4*)(pr - (t > 0 ? 6144 : 0)), pp1 = *(const u32x4*)(pr + (t < L - 1 ? 6144 : 0)); const u32x4 p0 = *(const u32x4*)pr;
            { const unsigned mk0 = t > 0 ? 0xffffffffu : 0u, mk1 = t < L - 1 ? 0xffffffffu : 0u; pm1.x &= mk0; pm1.y &= mk0; pm1.z &= mk0; pm1.w &= mk0; pp1.x &= mk1; pp1.y &= mk1; pp1.z &= mk1; pp1.w &= mk1; }
            const unsigned* a = (const unsigned*)&pm1; const unsigned* bq = (const unsigned*)&p0; const unsigned* cq = (const unsigned*)&pp1;
#pragma unroll
            for (int j = 0; j < 4; ++j) {
                const f32x2 w0 = *(const f32x2*)(cw + gc + 2 * j), w1 = *(const f32x2*)(cw + 6144 + gc + 2 * j), w2 = *(const f32x2*)(cw + 12288 + gc + 2 * j), bb = *(const f32x2*)(cb + gc + 2 * j);
#if defined(MK_GATE_VARIANT) && MK_GATE_VARIANT == 1
                u[g][2 * j] = bflo(bq[j]); u[g][2 * j + 1] = bfhi(bq[j]);
#elif defined(MK_GATE_VARIANT) && MK_GATE_VARIANT == 2
                u[g][2 * j] = bflo(bq[j]) * w1.x + bb.x; u[g][2 * j + 1] = bfhi(bq[j]) * w1.y + bb.y;
#elif defined(MK_GATE_VARIANT) && MK_GATE_VARIANT == 3
                u[g][2 * j] = bflo(a[j]) + bflo(bq[j]) + bflo(cq[j]); u[g][2 * j + 1] = bfhi(a[j]) + bfhi(bq[j]) + bfhi(cq[j]);
#else
                u[g][2 * j] = bflo(a[j]) * w0.x + bflo(bq[j]) * w1.x + bflo(cq[j]) * w2.x + bb.x;
                u[g][2 * j + 1] = bfhi(a[j]) * w0.y + bfhi(bq[j]) * w1.y + bfhi(cq[j]) * w2.y + bb.y;
#endif
            }
        }
        { u32x4 o; o.x = cvt_pk(u[0][0], u[0][1]); o.y = cvt_pk(u[0][2], u[0][3]); o.z = cvt_pk(u[0][4], u[0][5]); o.w = cvt_pk(u[0][6], u[0][7]);
          *(u32x4*)(X0 + (size_t)(R0 + t) * D + c0) = o; }
        __syncthreads();
#pragma unroll
        for (int j = 0; j < 8; ++j) zs[(8 * c8 + j) * 72 + tl] = (bf16_t)(cvt_pk(u[2][j] * u[1][j], 0.f) & 0xffffu);
        __syncthreads();
        { const int cl = tid >> 3, t8 = tid & 7;
          const u32x4 o = *(const LAS u32x4*)(zs + cl * 72 + 8 * t8);
          bf16_t* ZT = smp ? ZTs : ZTp;
          *(u32x4*)(ZT + ((size_t)(cbk * 64 + cl) * NB + b) * L + tb * 64 + 8 * t8) = o; }
    }
    __syncthreads();
}

template <int L, int NB>
__device__ __forceinline__ void phase_hy_conv(const Ctx& C, const bf16_t* FG, const bf16_t* ZT, bf16_t* YT) {
    constexpr int WPC = L / 256, CPB = 8 / WPC, NS = L / 32, ROW = 2 * L + 64, UNITS = L / 4, COPYB = UNITS * 16, CHB = 8 * COPYB;
    constexpr int NH = NS > 16 ? NS / 16 : 1, JH = NS / NH;
    const int lane = C.lane, w = C.wave, ch_local = w / WPC, w4 = w % WPC, r = lane & 15, q = lane >> 4;
    for (int it = C.bid; it < 2048 / CPB; it += C.G) {
        const int c = it * CPB + ch_local;
        __syncthreads();
        {
            const int tcid = w4 * 64 + lane;
            const bf16_t* frow = FG + (size_t)c * ROW;
            for (int x = tcid; x < UNITS; x += 64 * WPC) {
                const u32x4 d0 = *(const u32x4*)(frow + 8 * x), d1 = *(const u32x4*)(frow + 8 * x + 8);
                const unsigned dd[8] = {d0.x, d0.y, d0.z, d0.w, d1.x, d1.y, d1.z, d1.w};
#pragma unroll
                for (int k = 0; k < 8; ++k) {
                    u32x4 o;
                    if ((k & 1) == 0) { o.x = dd[k / 2]; o.y = dd[k / 2 + 1]; o.z = dd[k / 2 + 2]; o.w = dd[k / 2 + 3]; }
                    else { const int b0 = (k - 1) / 2;
                        o.x = (dd[b0] >> 16) | (dd[b0 + 1] << 16); o.y = (dd[b0 + 1] >> 16) | (dd[b0 + 2] << 16); o.z = (dd[b0 + 2] >> 16) | (dd[b0 + 3] << 16); o.w = (dd[b0 + 3] >> 16) | (dd[b0 + 4] << 16); }
                    *(LAS u32x4*)(C.lds + ch_local * CHB + k * COPYB + x * 16) = o;
                }
            }
        }
        __syncthreads();
        f32x4 acc[16];
        { const float z0 = opaque_zero();
#pragma unroll
        for (int i = 0; i < 16; ++i) acc[i] = (f32x4){z0, z0, z0, z0}; }
        const bf16_t* zrow = ZT + ((size_t)c * NB + (r % NB)) * L + 8 * q;
        const LAS unsigned char* abase = C.lds + ch_local * CHB + (7 - (r & 7)) * COPYB + ((L - 8) / 8 - (r >> 3) + q - 32 * w4) * 16;
#pragma unroll
        for (int hh = 0; hh < NH; ++hh) {
            bf16x8 bf[JH];
#pragma unroll
            for (int j = 0; j < JH; ++j) bf[j] = *(const bf16x8*)(zrow + 32 * (hh * JH + j));
#pragma unroll
            for (int e = -2 * (hh * JH + JH - 1); e <= 15 - 2 * (hh * JH); ++e) {
                const bf16x8 a = *(const LAS bf16x8*)(abase - 32 * e);
#pragma unroll
                for (int j = 0; j < JH; ++j) { const int il = e + 2 * (hh * JH + j);
                    if (il >= 0 && il < 16) asm volatile("v_mfma_f32_16x16x32_bf16 %0, %1, %2, %0" : "+v"(acc[il]) : "v"(a), "v"(bf[j])); }
                asm volatile("" :: "v"(a));
            }
#pragma unroll
            for (int j = 0; j < JH; ++j) asm volatile("" :: "v"(bf[j]));
        }
        asm volatile("s_nop 15\n\ts_nop 15" : "+v"(acc[0]), "+v"(acc[1]), "+v"(acc[2]), "+v"(acc[3]), "+v"(acc[4]), "+v"(acc[5]), "+v"(acc[6]), "+v"(acc[7]));
        asm volatile("" : "+v"(acc[8]), "+v"(acc[9]), "+v"(acc[10]), "+v"(acc[11]), "+v"(acc[12]), "+v"(acc[13]), "+v"(acc[14]), "+v"(acc[15]));
        if (r < NB) {
            bf16_t* yrow = YT + ((size_t)c * NB + r) * L + 256 * w4 + 4 * q;
#pragma unroll
            for (int i = 0; i < 16; ++i) { u32x2 o; o.x = cvt_pk(acc[i][0], acc[i][1]); o.y = cvt_pk(acc[i][2], acc[i][3]);
#if defined(MK_CONV_VARIANT) && MK_CONV_VARIANT == 1
                { const u32x4 zz = *(const u32x4*)(zrow + 32 * (i & 7)); o.x = zz.x; o.y = zz.y; }
#elif defined(MK_CONV_VARIANT) && MK_CONV_VARIANT == 2
                { const u32x4 aa = *(const LAS u32x4*)(abase - 32 * (i - 8)); o.x = aa.x; o.y = aa.w; }
#endif
                *(u32x2*)(yrow + 16 * i) = o; }
        }
    }
    __syncthreads();
}

__device__ __forceinline__ void phase_hy_out(const Ctx& C, const bf16_t* YTp, const bf16_t* YTs, const bf16_t* X0, bf16_t* Om) {
    const int tid = C.tid;
    LAS bf16_t* ys = (LAS bf16_t*)C.lds;
    for (int it = C.bid; it < 6144; it += C.G) {
        const bool smp = it >= 2048; const int q = smp ? it - 2048 : it;
        const int cbk = q & 31, tb = smp ? (q >> 5) & 15 : (q >> 5) & 3, b = smp ? q >> 9 : q >> 7;
        const int L = smp ? 1024 : 256, R0 = smp ? MP + b * 1024 : b * 256, NB = smp ? 8 : 16;
        __syncthreads();
        { const int cl = tid >> 3, t8 = tid & 7;
          const bf16_t* YT = smp ? YTs : YTp;
          const u32x4 v = *(const u32x4*)(YT + ((size_t)(cbk * 64 + cl) * NB + b) * L + tb * 64 + 8 * t8);
          const unsigned* pv = (const unsigned*)&v;
#pragma unroll
          for (int j = 0; j < 4; ++j) { ys[(8 * t8 + 2 * j) * 72 + cl] = (bf16_t)(pv[j] & 0xffffu); ys[(8 * t8 + 2 * j + 1) * 72 + cl] = (bf16_t)(pv[j] >> 16); } }
        __syncthreads();
        { const int tl = tid >> 3, c8 = tid & 7; const size_t off = (size_t)(R0 + tb * 64 + tl) * D + cbk * 64 + 8 * c8;
          const u32x4 yv = *(const LAS u32x4*)(ys + tl * 72 + 8 * c8), xv = *(const u32x4*)(X0 + off);
          const unsigned* py = (const unsigned*)&yv; const unsigned* px = (const unsigned*)&xv; u32x4 o; unsigned* po = (unsigned*)&o;
#pragma unroll
          for (int j = 0; j < 4; ++j) po[j] = cvt_pk(bflo(py[j]) * bflo(px[j]), bfhi(py[j]) * bfhi(px[j]));
          *(u32x4*)(Om + off) = o; }
    }
    __syncthreads();
}

__device__ __forceinline__ void phase_rw_mix(const Ctx& C, const bf16_t* H, const float* mu, bf16_t* XM) {
    const int gw = C.bid * 8 + C.wave, NGW = C.G * 8, lane = C.lane;
    for (int m = gw; m < MT; m += NGW) {
        const int t = m < MP ? (m & 255) : ((m - MP) & 1023), L = m < MP ? 256 : 1024;
        const bool hasp = t > 0, hasn = t < L - 1;
#pragma unroll
        for (int ch = 0; ch < 4; ++ch) {
            const int c0 = 8 * (lane + 64 * ch);
            const bf16_t* hp = H + (size_t)m * D + c0;
            u32x4 a = *(const u32x4*)(hp - (hasp ? D : 0)), c = *(const u32x4*)(hp + (hasn ? D : 0)); const u32x4 b = *(const u32x4*)hp;
            { const unsigned mk0 = hasp ? 0xffffffffu : 0u, mk1 = hasn ? 0xffffffffu : 0u; a.x &= mk0; a.y &= mk0; a.z &= mk0; a.w &= mk0; c.x &= mk1; c.y &= mk1; c.z &= mk1; c.w &= mk1; }
            const unsigned* pa = (const unsigned*)&a; const unsigned* pb = (const unsigned*)&b; const unsigned* pc = (const unsigned*)&c;
            float hv[8], xx[8];
#pragma unroll
            for (int j = 0; j < 4; ++j) { hv[2 * j] = bflo(pb[j]); hv[2 * j + 1] = bfhi(pb[j]);
                xx[2 * j] = 0.5f * (bflo(pa[j]) + bflo(pc[j])) - hv[2 * j]; xx[2 * j + 1] = 0.5f * (bfhi(pa[j]) + bfhi(pc[j])) - hv[2 * j + 1]; }
#pragma unroll
            for (int s = 0; s < 6; ++s) {
                const int mi = s == 0 ? 0 : s == 1 ? 2 : s == 2 ? 3 : s == 3 ? 1 : s;
                const f32x4 m0 = *(const f32x4*)(mu + mi * D + c0), m1 = *(const f32x4*)(mu + mi * D + c0 + 4);
                u32x4 o; o.x = cvt_pk(hv[0] + xx[0] * m0.x, hv[1] + xx[1] * m0.y); o.y = cvt_pk(hv[2] + xx[2] * m0.z, hv[3] + xx[3] * m0.w);
                o.z = cvt_pk(hv[4] + xx[4] * m1.x, hv[5] + xx[5] * m1.y); o.w = cvt_pk(hv[6] + xx[6] * m1.z, hv[7] + xx[7] * m1.w);
                *(u32x4*)(XM + ((size_t)s * MT + m) * D + c0) = o;
            }
        }
    }
}

__device__ __forceinline__ float dpp_xor1(float x) { return __int_as_float(__builtin_amdgcn_update_dpp(0, __float_as_int(x), 0xB1, 0xF, 0xF, true)); }
__device__ __forceinline__ float dpp_xor2(float x) { return __int_as_float(__builtin_amdgcn_update_dpp(0, __float_as_int(x), 0x4E, 0xF, 0xF, true)); }

constexpr int SC_STEP = 6 * 64;
template <int R, int SC_TS>
__device__ __forceinline__ void rw_scan_task(LAS float* buf, int lane, const bf16_t* Rm, const bf16_t* Km, const bf16_t* Vm, const bf16_t* LD, const bf16_t* LA,
                                             const float* k_k, const float* k_a, const float* invsq, const float* state_in, bf16_t* YB, float* state_out, bool smp, int b, int head, int dir, int half) {
    const int rg = lane >> 2, kq = lane & 3;
    const int L = smp ? 1024 : 256, R0 = smp ? MP + b * 1024 : b * 256;
    const int row0 = half * (16 * R) + R * rg;
    f32x2 S[R][8];
    if (smp) {
        const float* sp = state_in + ((size_t)(b * 2 + dir) * 32 + head) * 4096 + row0 * 64 + 16 * kq;
#pragma unroll
        for (int rr = 0; rr < R; ++rr)
#pragma unroll
            for (int j4 = 0; j4 < 4; ++j4) { const f32x4 v = *(const f32x4*)(sp + rr * 64 + 4 * j4); S[rr][2 * j4] = (f32x2){v.x, v.y}; S[rr][2 * j4 + 1] = (f32x2){v.z, v.w}; }
    } else {
#pragma unroll
        for (int rr = 0; rr < R; ++rr)
#pragma unroll
            for (int j = 0; j < 8; ++j) S[rr][j] = (f32x2){0.f, 0.f};
    }
    const int ch = head * 64 + lane; const size_t hbase = (size_t)head * MT * 64 + lane;
    const float kkc = k_k[ch], kac = k_a[ch];
    const bf16_t* ldp = LD + (size_t)dir * MT * D; const bf16_t* lap = LA + (size_t)dir * MT * D;
    bf16_t* yb = YB + (size_t)dir * MT * D;
    bf16_t pr[SC_TS], pk[SC_TS], pv[SC_TS], pl[SC_TS], pa[SC_TS], qr[SC_TS], qk[SC_TS], qv[SC_TS], ql[SC_TS], qa[SC_TS];
    const int tstart = dir ? L - 1 : 0, tstep = dir ? -1 : 1;
    const int NCH = L / SC_TS;
#define SC_PREFETCH(c) do { _Pragma("unroll") for (int s_ = 0; s_ < SC_TS; ++s_) { const size_t o_ = hbase + (size_t)(R0 + tstart + tstep * ((c) * SC_TS + s_)) * 64; pr[s_] = Rm[o_]; pk[s_] = Km[o_]; pv[s_] = Vm[o_]; pl[s_] = ldp[o_]; pa[s_] = lap[o_]; } } while (0)
#define SC_DERIVE(s_, bufp) do { const float r_ = bf2f(pr[s_]), k_ = bf2f(pk[s_]), v_ = bf2f(pv[s_]), ld_ = bf2f(pl[s_]), a_ = fsigmoid(bf2f(pa[s_])); \
        const float kr_ = k_ * kkc; const float kk_ = kr_ * __builtin_amdgcn_rsqf(wave_sum(kr_ * kr_) + 1e-12f); \
        const unsigned sa_ = (unsigned)(unsigned long)((bufp) + (s_) * SC_STEP) + 4u * (unsigned)lane;     \
        asm volatile("ds_write_b32 %0, %1" :: "v"(sa_), "v"(fexp(ld_))); asm volatile("ds_write_b32 %0, %1 offset:256" :: "v"(sa_), "v"(kk_ * a_)); \
        asm volatile("ds_write_b32 %0, %1 offset:512" :: "v"(sa_), "v"(k_ * (1.0f + (a_ - 1.0f) * kac))); asm volatile("ds_write_b32 %0, %1 offset:768" :: "v"(sa_), "v"(-kk_)); \
        asm volatile("ds_write_b32 %0, %1 offset:1024" :: "v"(sa_), "v"(r_)); asm volatile("ds_write_b32 %0, %1 offset:1280" :: "v"(sa_), "v"(v_)); } while (0)
#define SC_PREFETCH2(c) do { _Pragma("unroll") for (int s_ = 0; s_ < SC_TS; ++s_) { const size_t o_ = hbase + (size_t)(R0 + tstart + tstep * ((c) * SC_TS + s_)) * 64; qr[s_] = Rm[o_]; qk[s_] = Km[o_]; qv[s_] = Vm[o_]; ql[s_] = ldp[o_]; qa[s_] = lap[o_]; } } while (0)
    SC_PREFETCH(0);
#pragma unroll
    for (int s = 0; s < SC_TS; ++s) SC_DERIVE(s, buf);
    asm volatile("s_waitcnt lgkmcnt(0)" ::: "memory");
    SC_PREFETCH(1);
    SC_PREFETCH2(2);
#define SC_DERIVE_Q(s_, bufp) do { const float r_ = bf2f(qr[s_]), k_ = bf2f(qk[s_]), v_ = bf2f(qv[s_]), ld_ = bf2f(ql[s_]), a_ = fsigmoid(bf2f(qa[s_])); \
        const float kr_ = k_ * kkc; const float kk_ = kr_ * __builtin_amdgcn_rsqf(wave_sum(kr_ * kr_) + 1e-12f); \
        const unsigned sa_ = (unsigned)(unsigned long)((bufp) + (s_) * SC_STEP) + 4u * (unsigned)lane; \
        asm volatile("ds_write_b32 %0, %1" :: "v"(sa_), "v"(fexp(ld_))); asm volatile("ds_write_b32 %0, %1 offset:256" :: "v"(sa_), "v"(kk_ * a_)); \
        asm volatile("ds_write_b32 %0, %1 offset:512" :: "v"(sa_), "v"(k_ * (1.0f + (a_ - 1.0f) * kac))); asm volatile("ds_write_b32 %0, %1 offset:768" :: "v"(sa_), "v"(-kk_)); \
        asm volatile("ds_write_b32 %0, %1 offset:1024" :: "v"(sa_), "v"(r_)); asm volatile("ds_write_b32 %0, %1 offset:1280" :: "v"(sa_), "v"(v_)); } while (0)
    LAS float* const buf0 = buf; LAS float* const buf1 = buf + SC_TS * SC_STEP;
    for (int cix = 0; cix < NCH; cix += 2) {
#pragma unroll
        for (int s = 0; s < SC_TS; ++s) {
            SC_DERIVE(s, buf1);
            if (cix + 3 < NCH) { const size_t o_ = hbase + (size_t)(R0 + tstart + tstep * ((cix + 3) * SC_TS + s)) * 64; pr[s] = Rm[o_]; pk[s] = Km[o_]; pv[s] = Vm[o_]; pl[s] = ldp[o_]; pa[s] = lap[o_]; }
#define BC_ buf0
#define CX_ cix
            const LAS float* sb = BC_ + s * SC_STEP;
            f32x2 w2[8], b2[8], d2[8], n2[8], r2[8];
#pragma unroll
            for (int j4 = 0; j4 < 4; ++j4) { const f32x4 nv = *(const LAS f32x4*)(sb + 192 + 16 * kq + 4 * j4); n2[2 * j4] = (f32x2){nv.x, nv.y}; n2[2 * j4 + 1] = (f32x2){nv.z, nv.w}; }
#pragma unroll
            for (int j4 = 0; j4 < 4; ++j4) {
                const f32x4 bv = *(const LAS f32x4*)(sb + 64 + 16 * kq + 4 * j4), dv = *(const LAS f32x4*)(sb + 128 + 16 * kq + 4 * j4), wv = *(const LAS f32x4*)(sb + 16 * kq + 4 * j4), rv = *(const LAS f32x4*)(sb + 256 + 16 * kq + 4 * j4);
                w2[2 * j4] = (f32x2){wv.x, wv.y}; w2[2 * j4 + 1] = (f32x2){wv.z, wv.w}; b2[2 * j4] = (f32x2){bv.x, bv.y}; b2[2 * j4 + 1] = (f32x2){bv.z, bv.w};
                d2[2 * j4] = (f32x2){dv.x, dv.y}; d2[2 * j4 + 1] = (f32x2){dv.z, dv.w}; r2[2 * j4] = (f32x2){rv.x, rv.y}; r2[2 * j4 + 1] = (f32x2){rv.z, rv.w};
            }
            float vrow[R];
            if (R == 4) { const f32x4 vv = *(const LAS f32x4*)(sb + 320 + row0); vrow[0] = vv.x; vrow[R > 1 ? 1 : 0] = vv.y; vrow[R > 2 ? R - 2 : 0] = vv.z; vrow[R - 1] = vv.w; }
            else if (R == 2) { const f32x2 vv = *(const LAS f32x2*)(sb + 320 + row0); vrow[0] = vv.x; vrow[R - 1] = vv.y; }
            else vrow[0] = sb[320 + row0];
            float y[R];
#pragma unroll
            for (int rr = 0; rr < R; ++rr) {
                f32x2 a0 = S[rr][0] * n2[0], a1 = S[rr][1] * n2[1];
#pragma unroll
                for (int j = 2; j < 8; j += 2) { a0 = S[rr][j] * n2[j] + a0; a1 = S[rr][j + 1] * n2[j + 1] + a1; }
                a0 = a0 + a1;
                float sa = a0.x + a0.y; sa += dpp_xor1(sa); sa += dpp_xor2(sa);
                const f32x2 sa2 = (f32x2){sa, sa}, vr2 = (f32x2){vrow[rr], vrow[rr]};
                f32x2 y0 = (f32x2){0.f, 0.f}, y1 = (f32x2){0.f, 0.f};
#pragma unroll
                for (int j = 0; j < 8; j += 2) {
                    S[rr][j] = S[rr][j] * w2[j] + (sa2 * b2[j] + vr2 * d2[j]);
                    S[rr][j + 1] = S[rr][j + 1] * w2[j + 1] + (sa2 * b2[j + 1] + vr2 * d2[j + 1]);
                    y0 = S[rr][j] * r2[j] + y0; y1 = S[rr][j + 1] * r2[j + 1] + y1;
                }
                y0 = y0 + y1;
                float yy = y0.x + y0.y; yy += dpp_xor1(yy); yy += dpp_xor2(yy); y[rr] = yy;
            }
            {
                const int t = tstart + tstep * ((CX_) * SC_TS + s); bf16_t* yp = yb + (size_t)(R0 + t) * D + head * 64;
                if (R == 4) { const float ys = kq == 0 ? y[0] : kq == 1 ? y[R > 1 ? 1 : 0] : kq == 2 ? y[R > 2 ? R - 2 : 0] : y[R - 1]; yp[lane] = (bf16_t)cvt_pk(ys, ys); }
                else if (R == 2) { const float ys = (kq & 1) ? y[R - 1] : y[0]; yp[half * 32 + 2 * rg + (kq & 1)] = (bf16_t)cvt_pk(ys, ys); }
                else yp[row0] = (bf16_t)cvt_pk(y[0], y[0]);
            }
#undef BC_
#undef CX_
        }
        asm volatile("s_waitcnt lgkmcnt(0)" ::: "memory");
#pragma unroll
        for (int s = 0; s < SC_TS; ++s) {
            SC_DERIVE_Q(s, buf0);
            if (cix + 4 < NCH) { const size_t o_ = hbase + (size_t)(R0 + tstart + tstep * ((cix + 4) * SC_TS + s)) * 64; qr[s] = Rm[o_]; qk[s] = Km[o_]; qv[s] = Vm[o_]; ql[s] = ldp[o_]; qa[s] = lap[o_]; }
#define BC_ buf1
#define CX_ (cix + 1)
            const LAS float* sb = BC_ + s * SC_STEP;
            f32x2 w2[8], b2[8], d2[8], n2[8], r2[8];
#pragma unroll
            for (int j4 = 0; j4 < 4; ++j4) { const f32x4 nv = *(const LAS f32x4*)(sb + 192 + 16 * kq + 4 * j4); n2[2 * j4] = (f32x2){nv.x, nv.y}; n2[2 * j4 + 1] = (f32x2){nv.z, nv.w}; }
#pragma unroll
            for (int j4 = 0; j4 < 4; ++j4) {
                const f32x4 bv = *(const LAS f32x4*)(sb + 64 + 16 * kq + 4 * j4), dv = *(const LAS f32x4*)(sb + 128 + 16 * kq + 4 * j4), wv = *(const LAS f32x4*)(sb + 16 * kq + 4 * j4), rv = *(const LAS f32x4*)(sb + 256 + 16 * kq + 4 * j4);
                w2[2 * j4] = (f32x2){wv.x, wv.y}; w2[2 * j4 + 1] = (f32x2){wv.z, wv.w}; b2[2 * j4] = (f32x2){bv.x, bv.y}; b2[2 * j4 + 1] = (f32x2){bv.z, bv.w};
                d2[2 * j4] = (f32x2){dv.x, dv.y}; d2[2 * j4 + 1] = (f32x2){dv.z, dv.w}; r2[2 * j4] = (f32x2){rv.x, rv.y}; r2[2 * j4 + 1] = (f32x2){rv.z, rv.w};
            }
            float vrow[R];
            if (R == 4) { const f32x4 vv = *(const LAS f32x4*)(sb + 320 + row0); vrow[0] = vv.x; vrow[R > 1 ? 1 : 0] = vv.y; vrow[R > 2 ? R - 2 : 0] = vv.z; vrow[R - 1] = vv.w; }
            else if (R == 2) { const f32x2 vv = *(const LAS f32x2*)(sb + 320 + row0); vrow[0] = vv.x; vrow[R - 1] = vv.y; }
            else vrow[0] = sb[320 + row0];
            float y[R];
#pragma unroll
            for (int rr = 0; rr < R; ++rr) {
                f32x2 a0 = S[rr][0] * n2[0], a1 = S[rr][1] * n2[1];
#pragma unroll
                for (int j = 2; j < 8; j += 2) { a0 = S[rr][j] * n2[j] + a0; a1 = S[rr][j + 1] * n2[j + 1] + a1; }
                a0 = a0 + a1;
                float sa = a0.x + a0.y; sa += dpp_xor1(sa); sa += dpp_xor2(sa);
                const f32x2 sa2 = (f32x2){sa, sa}, vr2 = (f32x2){vrow[rr], vrow[rr]};
                f32x2 y0 = (f32x2){0.f, 0.f}, y1 = (f32x2){0.f, 0.f};
#pragma unroll
                for (int j = 0; j < 8; j += 2) {
                    S[rr][j] = S[rr][j] * w2[j] + (sa2 * b2[j] + vr2 * d2[j]);
                    S[rr][j + 1] = S[rr][j + 1] * w2[j + 1] + (sa2 * b2[j + 1] + vr2 * d2[j + 1]);
                    y0 = S[rr][j] * r2[j] + y0; y1 = S[rr][j + 1] * r2[j + 1] + y1;
                }
                y0 = y0 + y1;
                float yy = y0.x + y0.y; yy += dpp_xor1(yy); yy += dpp_xor2(yy); y[rr] = yy;
            }
            {
                const int t = tstart + tstep * ((CX_) * SC_TS + s); bf16_t* yp = yb + (size_t)(R0 + t) * D + head * 64;
                if (R == 4) { const float ys = kq == 0 ? y[0] : kq == 1 ? y[R > 1 ? 1 : 0] : kq == 2 ? y[R > 2 ? R - 2 : 0] : y[R - 1]; yp[lane] = (bf16_t)cvt_pk(ys, ys); }
                else if (R == 2) { const float ys = (kq & 1) ? y[R - 1] : y[0]; yp[half * 32 + 2 * rg + (kq & 1)] = (bf16_t)cvt_pk(ys, ys); }
                else yp[row0] = (bf16_t)cvt_pk(y[0], y[0]);
            }
#undef BC_
#undef CX_
        }
        asm volatile("s_waitcnt lgkmcnt(0)" ::: "memory");
    }
#undef SC_DERIVE_Q
#undef SC_PREFETCH
#undef SC_PREFETCH2
#undef SC_DERIVE
    if (!smp) {
        float* sp = state_out + ((size_t)(b * 2 + dir) * 32 + head) * 4096 + row0 * 64 + 16 * kq;
#pragma unroll
        for (int rr = 0; rr < R; ++rr)
#pragma unroll
            for (int j4 = 0; j4 < 4; ++j4) *(f32x4*)(sp + rr * 64 + 4 * j4) = (f32x4){S[rr][2 * j4].x, S[rr][2 * j4].y, S[rr][2 * j4 + 1].x, S[rr][2 * j4 + 1].y};
    }
}
__device__ __forceinline__ void phase_rw_scan(const Ctx& C, const bf16_t* Rm, const bf16_t* Km, const bf16_t* Vm, const bf16_t* LD, const bf16_t* LA,
                                              const float* k_k, const float* k_a, const float* invsq, const float* state_in, bf16_t* YB, float* state_out) {
    const int lane = C.lane, w = C.wave;
    LAS float* buf = (LAS float*)(C.lds + (w < 4 ? w * 24576 : 98304 + (w - 4) * 12288));
    if (w < 4) { for (int slot = C.bid * 4 + w; slot < 1024; slot += C.G * 4) { const int id = slot >> 1; rw_scan_task<2, 8>(buf, lane, Rm, Km, Vm, LD, LA, k_k, k_a, invsq, state_in, YB, state_out, true, id >> 6, (id >> 1) & 31, id & 1, slot & 1); } }
    else { for (int id = C.bid * 4 + (w - 4); id < 1024; id += C.G * 4) rw_scan_task<4, 4>(buf, lane, Rm, Km, Vm, LD, LA, k_k, k_a, invsq, state_in, YB, state_out, false, id >> 6, (id >> 1) & 31, id & 1, 0); }
    if (w >= 4) late_transposes(C, buf, C.bid * 4 + (w - 4), C.G * 4);
    __syncthreads();
}

__device__ __forceinline__ float head8_sum(float v) { v = DPP_ADD(v, 0xB1); v = DPP_ADD(v, 0x4E); v = DPP_ADD(v, 0x141); return v; }
__device__ __forceinline__ void phase_rw_post(const Ctx& C, const bf16_t* YB, const bf16_t* Rm, const bf16_t* Km, const bf16_t* Vm, const bf16_t* LA, const bf16_t* Gt,
                                              const float* k_a, const float* r_k, const float* ln_w, const float* ln_b, bf16_t* Om) {
    const int gw = C.bid * 8 + C.wave, NGW = C.G * 8, lane = C.lane;
    for (int m = gw; m < MT; m += NGW) {
#pragma unroll 1
        for (int ch = 0; ch < 4; ++ch) {
            const int c0 = 8 * (lane + 64 * ch); const size_t o = (size_t)m * D + c0;
            const u32x4 yfw = *(const u32x4*)(YB + o), ybw = *(const u32x4*)(YB + (size_t)MT * D + o); const unsigned* pyf = (const unsigned*)&yfw; const unsigned* pyb = (const unsigned*)&ybw;
            const size_t oh = hm_index(m, c0);
            const u32x4 rr = *(const u32x4*)(Rm + oh), kk = *(const u32x4*)(Km + oh), vv = *(const u32x4*)(Vm + oh), gg = *(const u32x4*)(Gt + o), l0 = *(const u32x4*)(LA + oh), l1 = *(const u32x4*)(LA + (size_t)MT * D + oh);
            const f32x4 ka0 = *(const f32x4*)(k_a + c0), ka1 = *(const f32x4*)(k_a + c0 + 4), rk0 = *(const f32x4*)(r_k + c0), rk1 = *(const f32x4*)(r_k + c0 + 4);
            const f32x4 lw0 = *(const f32x4*)(ln_w + c0), lw1 = *(const f32x4*)(ln_w + c0 + 4), lb0 = *(const f32x4*)(ln_b + c0), lb1 = *(const f32x4*)(ln_b + c0 + 4);
            float y[8], r[8], k[8], v[8], g[8], a0[8], a1[8], ka[8], rk[8], lw[8], lb[8];
            const unsigned* pr = (const unsigned*)&rr; const unsigned* pk = (const unsigned*)&kk; const unsigned* pv = (const unsigned*)&vv; const unsigned* pg = (const unsigned*)&gg; const unsigned* p0 = (const unsigned*)&l0; const unsigned* p1 = (const unsigned*)&l1;
#pragma unroll
            for (int j = 0; j < 4; ++j) {
                y[2 * j] = bflo(pyf[j]) + bflo(pyb[j]); y[2 * j + 1] = bfhi(pyf[j]) + bfhi(pyb[j]); ka[j] = ka0[j]; ka[4 + j] = ka1[j]; rk[j] = rk0[j]; rk[4 + j] = rk1[j]; lw[j] = lw0[j]; lw[4 + j] = lw1[j]; lb[j] = lb0[j]; lb[4 + j] = lb1[j];
                r[2 * j] = bflo(pr[j]); r[2 * j + 1] = bfhi(pr[j]); k[2 * j] = bflo(pk[j]); k[2 * j + 1] = bfhi(pk[j]); v[2 * j] = bflo(pv[j]); v[2 * j + 1] = bfhi(pv[j]);
                g[2 * j] = bflo(pg[j]); g[2 * j + 1] = bfhi(pg[j]); a0[2 * j] = fsigmoid(bflo(p0[j])); a0[2 * j + 1] = fsigmoid(bfhi(p0[j])); a1[2 * j] = fsigmoid(bflo(p1[j])); a1[2 * j + 1] = fsigmoid(bfhi(p1[j]));
            }
            float s = 0.f, bon = 0.f;
#pragma unroll
            for (int j = 0; j < 8; ++j) { s += y[j]; bon += r[j] * (k[j] * (2.0f + (a0[j] + a1[j] - 2.0f) * ka[j])) * rk[j]; }
            const float mean = head8_sum(s) * (1.0f / 64.0f); bon = head8_sum(bon);
            float q = 0.f;
#pragma unroll
            for (int j = 0; j < 8; ++j) { y[j] -= mean; q += y[j] * y[j]; }
            const float rstd = __builtin_amdgcn_rsqf(head8_sum(q) * (1.0f / 64.0f) + 64e-5f);
            float ov[8];
#pragma unroll
            for (int j = 0; j < 8; ++j) ov[j] = (y[j] * rstd * lw[j] + lb[j] + bon * v[j]) * g[j];
            u32x4 w; w.x = cvt_pk(ov[0], ov[1]); w.y = cvt_pk(ov[2], ov[3]); w.z = cvt_pk(ov[4], ov[5]); w.w = cvt_pk(ov[6], ov[7]);
            *(u32x4*)(Om + o) = w;
        }
    }
}

constexpr int NPH = 35;
#define IN(k) (lo <= (k) && (k) < hi)
#define SEAM(k) do { if (IN(k) && IN((k) + 1)) xcd_barrier(bar); } while (0)
#define LDSG ((PG8_LAS unsigned char*)C.lds)
#ifndef MK_REP_MASK
#define MK_REP_MASK 0ull
#endif
#define REPQ(k) (((MK_REP_MASK) >> (k)) & 1ull)

template <class Epi>
__device__ __forceinline__ void run_gemm(const Ctx& C, const bf16_t* A, const bf16_t* Bt, int N, int K, const Epi& E) {
    pg8::Gemm g{A, Bt, MT, N, K, K}; pg8::StaticOrder S; S.init(MT, N, C.G, C.bid);
    pg8::gemm_phase<Epi, pg8::StaticOrder, false>(LDSG, g, S, E, nullptr);
}

#ifndef MK_SPLIT_MASK
#define MK_SPLIT_MASK 15
#endif
#define PREVP1(L) (((L) > 0 && (((MK_SPLIT_MASK) >> ((L) - 1)) & 1)) ? (const bf16_t*)WSP(bf16_t, WS_ARENA + AR_SLAB) : (const bf16_t*)nullptr)
constexpr size_t AR_SLAB = 200 * MiB;
constexpr size_t CTL_SPLIT = 65536;
template <int SET>
__device__ __forceinline__ void run_gemm_split_res(const Ctx& C, const bf16_t* A, const bf16_t* Bt, int K, bf16_t* X, const float* gate_base) {
    pg8::Gemm g{A, Bt, MT, D, K, K / 2}; SplitOrder S; S.init(D, C.G, C.bid);
    EpiResidualSplitB E{X, gate_base, WSP(bf16_t, WS_ARENA + AR_SLAB)};
    pg8::gemm_phase<EpiResidualSplitB, SplitOrder, false>(LDSG, g, S, E, nullptr);
}
constexpr size_t AR_P1W = 548 * MiB;
__device__ __forceinline__ void run_gemm_tail_res(const Ctx& C, const bf16_t* A, const bf16_t* Bt, bf16_t* X, const float* gate_base) {
    pg8::Gemm g{A, Bt, MT, D, D, D / 2}; TailSplitOrder S; S.init(C.G, C.bid);
    EpiResidualSplitB E{X, gate_base, WSP(bf16_t, WS_ARENA + AR_P1W)};
    pg8::gemm_phase<EpiResidualSplitB, TailSplitOrder, false>(LDSG, g, S, E, nullptr);
}
template <int LAYER>
__device__ __forceinline__ void mlp_block(const Ctx& C, const XcdBarrier& bar, int lo, int hi, int b0) {
    bf16_t* X = WSP(bf16_t, WS_X); bf16_t* H = WSP(bf16_t, WS_H); bf16_t* U = WSP(bf16_t, WS_ARENA + AR_U);
    if (IN(b0)) { { phase_norm_mod_b(C, X, karg<I_N2G>() + LAYER * D, LAYER, 3, H, LAYER > 0 ? (const bf16_t*)WSP(bf16_t, WS_ARENA + AR_P1W) : (const bf16_t*)nullptr, X, 8192); } if (REPQ(b0)) { phase_norm_mod_b(C, X, karg<I_N2G>() + LAYER * D, LAYER, 3, H, LAYER > 0 ? (const bf16_t*)WSP(bf16_t, WS_ARENA + AR_P1W) : (const bf16_t*)nullptr, X, 8192); } }
    SEAM(b0);
    if (IN(b0 + 1)) { { EpiBf16<1> E{U, FF}; run_gemm(C, H, WSP(bf16_t, WS_W1T) + (size_t)LAYER * D * FF, FF, D, E); } if (REPQ(b0 + 1)) { EpiBf16<1> E{U, FF}; run_gemm(C, H, WSP(bf16_t, WS_W1T) + (size_t)LAYER * D * FF, FF, D, E); } }
    SEAM(b0 + 1);
    if (IN(b0 + 2)) { { if constexpr (((MK_SPLIT_MASK) >> LAYER) & 1) run_gemm_split_res<LAYER>(C, U, WSP(bf16_t, WS_W2T) + (size_t)LAYER * D * FF, FF, X, MODP(LAYER, 0, 5)); else { EpiResidualB<false> E{X, MODP(LAYER, 0, 5), nullptr, nullptr}; run_gemm(C, U, WSP(bf16_t, WS_W2T) + (size_t)LAYER * D * FF, D, FF, E); } } if (REPQ(b0 + 2)) { if constexpr (((MK_SPLIT_MASK) >> LAYER) & 1) run_gemm_split_res<LAYER>(C, U, WSP(bf16_t, WS_W2T) + (size_t)LAYER * D * FF, FF, X, MODP(LAYER, 0, 5)); else { EpiResidualB<false> E{X, MODP(LAYER, 0, 5), nullptr, nullptr}; run_gemm(C, U, WSP(bf16_t, WS_W2T) + (size_t)LAYER * D * FF, D, FF, E); } } }
    SEAM(b0 + 2);
}

template <int LAYER, int J>
__device__ __forceinline__ void attn_layer(const Ctx& C, const XcdBarrier& bar, int lo, int hi, int b0) {
    bf16_t* X = WSP(bf16_t, WS_X); bf16_t* H = WSP(bf16_t, WS_H);
    bf16_t *Q = WSP(bf16_t, WS_ARENA + AR_Q), *Kb = WSP(bf16_t, WS_ARENA + AR_K), *Vb = WSP(bf16_t, WS_ARENA + AR_V), *O = WSP(bf16_t, WS_ARENA + AR_O);
    if (IN(b0)) { { if (LAYER == 0) { phase_fg_transpose(C); phase_norm_mod(C, karg<I_XP>(), karg<I_XS>(), karg<I_N1G>() + LAYER * D, LAYER, 0, H); } else phase_norm_mod_b(C, X, karg<I_N1G>() + LAYER * D, LAYER, 0, H, PREVP1(LAYER), X); } if (REPQ(b0)) { if (LAYER == 0) { phase_fg_transpose(C); phase_norm_mod(C, karg<I_XP>(), karg<I_XS>(), karg<I_N1G>() + LAYER * D, LAYER, 0, H); } else phase_norm_mod_b(C, X, karg<I_N1G>() + LAYER * D, LAYER, 0, H, PREVP1(LAYER), X); } }
    SEAM(b0);
    if (IN(b0 + 1)) { { EpiQKV E{Q, Kb, Vb, C.out + OUT_NK + (size_t)J * 256 * 512, C.out + OUT_NV + (size_t)J * 256 * 512}; run_gemm(C, H, WSP(bf16_t, WS_WQKVT) + (size_t)J * D * 3072, 3072, D, E); } if (REPQ(b0 + 1)) { EpiQKV E{Q, Kb, Vb, C.out + OUT_NK + (size_t)J * 256 * 512, C.out + OUT_NV + (size_t)J * 256 * 512}; run_gemm(C, H, WSP(bf16_t, WS_WQKVT) + (size_t)J * D * 3072, 3072, D, E); } }
    SEAM(b0 + 1);
    if (IN(b0 + 2)) { { phase_attention(C, Q, Kb, Vb, WSP(bf16_t, WS_KC) + (size_t)J * 512 * 512, WSP(bf16_t, WS_VC) + (size_t)J * 512 * 512, karg<I_SINK>() + J * 16, O); } if (REPQ(b0 + 2)) { phase_attention(C, Q, Kb, Vb, WSP(bf16_t, WS_KC) + (size_t)J * 512 * 512, WSP(bf16_t, WS_VC) + (size_t)J * 512 * 512, karg<I_SINK>() + J * 16, O); } }
    SEAM(b0 + 2);
    if (IN(b0 + 3)) { { if constexpr (LAYER == 0) { EpiResidualB<true> E{X, MODP(LAYER, 0, 2), karg<I_XP>(), karg<I_XS>()}; run_gemm(C, O, WSP(bf16_t, WS_WOT) + (size_t)J * D * D, D, D, E); } else run_gemm_tail_res(C, O, WSP(bf16_t, WS_WOT) + (size_t)J * D * D, X, MODP(LAYER, 0, 2)); } if (REPQ(b0 + 3)) { if constexpr (LAYER == 0) { EpiResidualB<true> E{X, MODP(LAYER, 0, 2), karg<I_XP>(), karg<I_XS>()}; run_gemm(C, O, WSP(bf16_t, WS_WOT) + (size_t)J * D * D, D, D, E); } else run_gemm_tail_res(C, O, WSP(bf16_t, WS_WOT) + (size_t)J * D * D, X, MODP(LAYER, 0, 2)); } }
    SEAM(b0 + 3);
    mlp_block<LAYER>(C, bar, lo, hi, b0 + 4);
}

template <int LAYER>
__device__ __forceinline__ void hyena_layer(const Ctx& C, const XcdBarrier& bar, int lo, int hi, int b0) {
    bf16_t* X = WSP(bf16_t, WS_X); bf16_t* H = WSP(bf16_t, WS_H);
    bf16_t *Pm = WSP(bf16_t, WS_ARENA + AR_P), *X0 = WSP(bf16_t, WS_ARENA + AR_X0), *ZT = WSP(bf16_t, WS_ARENA + AR_ZT), *YT = WSP(bf16_t, WS_ARENA + AR_YT), *HO = WSP(bf16_t, WS_ARENA + AR_HO);
    bf16_t *ZTp = ZT, *ZTs = ZT + (size_t)MP * D, *YTp = YT, *YTs = YT + (size_t)MP * D;
    if (IN(b0)) { { phase_norm_mod_b(C, X, karg<I_N1G>() + LAYER * D, LAYER, 0, H, PREVP1(LAYER), X); } if (REPQ(b0)) { phase_norm_mod_b(C, X, karg<I_N1G>() + LAYER * D, LAYER, 0, H, PREVP1(LAYER), X); } }
    SEAM(b0);
    if (IN(b0 + 1)) { { EpiBf16<0> E{Pm, 6144}; run_gemm(C, H, WSP(bf16_t, WS_HYINT), 6144, D, E); } if (REPQ(b0 + 1)) { EpiBf16<0> E{Pm, 6144}; run_gemm(C, H, WSP(bf16_t, WS_HYINT), 6144, D, E); } }
    SEAM(b0 + 1);
    if (IN(b0 + 2)) { { phase_hy_gate(C, Pm, karg<I_HYCW>(), karg<I_HYCB>(), X0, ZTp, ZTs); } if (REPQ(b0 + 2)) { phase_hy_gate(C, Pm, karg<I_HYCW>(), karg<I_HYCB>(), X0, ZTp, ZTs); } }
    SEAM(b0 + 2);
    if (IN(b0 + 3)) { { phase_hy_conv<1024, 8>(C, WSP(bf16_t, WS_FGS), ZTs, YTs); phase_hy_conv<256, 16>(C, WSP(bf16_t, WS_FGP), ZTp, YTp); } if (REPQ(b0 + 3)) { phase_hy_conv<1024, 8>(C, WSP(bf16_t, WS_FGS), ZTs, YTs); phase_hy_conv<256, 16>(C, WSP(bf16_t, WS_FGP), ZTp, YTp); } }
    SEAM(b0 + 3);
    if (IN(b0 + 4)) { { phase_hy_out(C, YTp, YTs, X0, HO); } if (REPQ(b0 + 4)) { phase_hy_out(C, YTp, YTs, X0, HO); } }
    SEAM(b0 + 4);
    if (IN(b0 + 5)) { { run_gemm_tail_res(C, HO, WSP(bf16_t, WS_HYOUTT), X, MODP(LAYER, 0, 2)); } if (REPQ(b0 + 5)) { run_gemm_tail_res(C, HO, WSP(bf16_t, WS_HYOUTT), X, MODP(LAYER, 0, 2)); } }
    SEAM(b0 + 5);
    mlp_block<LAYER>(C, bar, lo, hi, b0 + 6);
}

template <int LAYER>
__device__ __forceinline__ void rwkv_layer(const Ctx& C, const XcdBarrier& bar, int lo, int hi, int b0) {
    bf16_t* X = WSP(bf16_t, WS_X); bf16_t* H = WSP(bf16_t, WS_H);
    bf16_t *XM = WSP(bf16_t, WS_ARENA + AR_XMIX), *LD = WSP(bf16_t, WS_ARENA + AR_LD), *LA = WSP(bf16_t, WS_ARENA + AR_LA), *Gt = WSP(bf16_t, WS_ARENA + AR_G), *RO = WSP(bf16_t, WS_ARENA + AR_RO);
    bf16_t *Rm = WSP(bf16_t, WS_ARENA + AR_R), *Km = WSP(bf16_t, WS_ARENA + AR_KK), *Vm = WSP(bf16_t, WS_ARENA + AR_VV), *A3 = WSP(bf16_t, WS_ARENA + AR_A3);
    bf16_t* YB = WSP(bf16_t, WS_ARENA + AR_YB);
    if (IN(b0)) { { phase_norm_mod_b(C, X, karg<I_N1G>() + LAYER * D, LAYER, 0, H, PREVP1(LAYER), X); } if (REPQ(b0)) { phase_norm_mod_b(C, X, karg<I_N1G>() + LAYER * D, LAYER, 0, H, PREVP1(LAYER), X); } }
    SEAM(b0);
    if (IN(b0 + 1)) { { phase_rw_mix(C, H, karg<I_MU>(), XM); } if (REPQ(b0 + 1)) { phase_rw_mix(C, H, karg<I_MU>(), XM); } }
    SEAM(b0 + 1);
    if (IN(b0 + 2)) { { pg8::Gemm g{XM, WSP(bf16_t, WS_RWBT), 6 * MT, 27 * 256, D, D}; RwOrder1 S{C.G, C.bid}; EpiRw1 E{Rm, A3, karg<I_KK>(), WSP(float, WS_INVSQ)}; pg8::gemm_phase<EpiRw1, RwOrder1, false>(LDSG, g, S, E, nullptr); } if (REPQ(b0 + 2)) { pg8::Gemm g{XM, WSP(bf16_t, WS_RWBT), 6 * MT, 27 * 256, D, D}; RwOrder1 S{C.G, C.bid}; EpiRw1 E{Rm, A3, karg<I_KK>(), WSP(float, WS_INVSQ)}; pg8::gemm_phase<EpiRw1, RwOrder1, false>(LDSG, g, S, E, nullptr); } }
    SEAM(b0 + 2);
    if (IN(b0 + 3)) { { pg8::Gemm g{A3, WSP(bf16_t, WS_LORA2T), 3 * MT, 40 * 256, 256, 256}; RwOrder2 S{C.G, C.bid}; EpiRw2 E{LD, LA, Gt, karg<I_W0>(), karg<I_A0>()}; pg8::gemm_phase<EpiRw2, RwOrder2, false>(LDSG, g, S, E, nullptr); } if (REPQ(b0 + 3)) { pg8::Gemm g{A3, WSP(bf16_t, WS_LORA2T), 3 * MT, 40 * 256, 256, 256}; RwOrder2 S{C.G, C.bid}; EpiRw2 E{LD, LA, Gt, karg<I_W0>(), karg<I_A0>()}; pg8::gemm_phase<EpiRw2, RwOrder2, false>(LDSG, g, S, E, nullptr); } }
    SEAM(b0 + 3);
    if (IN(b0 + 4)) { { phase_rw_scan(C, Rm, Km, Vm, LD, LA, karg<I_KK>(), karg<I_KA>(), WSP(float, WS_INVSQ), karg<I_ST>(), YB, C.out + OUT_ST); } if (REPQ(b0 + 4)) { phase_rw_scan(C, Rm, Km, Vm, LD, LA, karg<I_KK>(), karg<I_KA>(), WSP(float, WS_INVSQ), karg<I_ST>(), YB, C.out + OUT_ST); } }
    SEAM(b0 + 4);
    if (IN(b0 + 5)) { { phase_rw_post(C, YB, Rm, Km, Vm, LA, Gt, karg<I_KA>(), karg<I_RK>(), karg<I_LNW>(), karg<I_LNB>(), RO); } if (REPQ(b0 + 5)) { phase_rw_post(C, YB, Rm, Km, Vm, LA, Gt, karg<I_KA>(), karg<I_RK>(), karg<I_LNW>(), karg<I_LNB>(), RO); } }
    SEAM(b0 + 5);
    if (IN(b0 + 6)) { { run_gemm_tail_res(C, RO, WSP(bf16_t, WS_RWOT), X, MODP(LAYER, 0, 2)); } if (REPQ(b0 + 6)) { run_gemm_tail_res(C, RO, WSP(bf16_t, WS_RWOT), X, MODP(LAYER, 0, 2)); } }
    SEAM(b0 + 6);
    mlp_block<LAYER>(C, bar, lo, hi, b0 + 7);
}

__global__ void __launch_bounds__(512, 2) fwd_kernel(Params prm) {
    extern __shared__ __attribute__((aligned(16))) unsigned char lds_raw[];
    Ctx C;
    C.lds = (LAS unsigned char*)lds_raw;
    C.tid = threadIdx.x; C.lane = C.tid & 63; C.wave = __builtin_amdgcn_readfirstlane(C.tid >> 6); C.G = gridDim.x; C.bid = blockIdx.x;
    C.out = prm.out; C.ws = prm.ws;
    const int lo = prm.ph_lo, hi = prm.ph_hi;
    volatile LAS unsigned* xbw = (volatile LAS unsigned*)(C.lds + LDS_BAR_OFF);
    if (C.tid < 4) xbw[C.tid] = 0u;
    __syncthreads();
    XcdBarrier bar; bar.bar = (unsigned*)(C.ws + WS_CTL) + 1024; bar.x = 0; bar.st = xbw;
    if (hi - lo > 1) bar = xcd_barrier_post((unsigned*)(C.ws + WS_CTL) + 1024, xbw);

#ifdef MK_SKIP_FROM
    if (IN(0)) { for (size_t i = (size_t)C.bid * 512 + C.tid; i < (size_t)3 * 4194304; i += (size_t)C.G * 512) prm.out[OUT_NK + i] = 0.f; }
#endif
    if (IN(0)) { { phase_prologue(C); } if (REPQ(0)) { phase_prologue(C); } }
    SEAM(0);
    attn_layer<0, 0>(C, bar, lo, hi, 1);
    hyena_layer<1>(C, bar, lo, hi, 8);
    rwkv_layer<2>(C, bar, lo, hi, 17);
    attn_layer<3, 1>(C, bar, lo, hi, 27);
#ifndef MK_DBG_N
#define MK_DBG_N ((size_t)MT * D)
#endif
#ifndef MK_DBG_SCALE
#define MK_DBG_SCALE 1.0f
#endif
#ifdef MK_DBG_OFF
    if (IN(34)) { for (size_t i = (size_t)C.bid * 512 + C.tid; i < (size_t)MT * D; i += (size_t)C.G * 512) prm.out[OUT_Y + i] = i < (size_t)(MK_DBG_N) ? MK_DBG_SCALE * (MK_DBG_BF16 ? bf2f(WSP(bf16_t, MK_DBG_OFF)[i]) : WSP(float, MK_DBG_OFF)[i]) : 0.f; }
#else
    if (IN(34)) { { phase_norm_final_b(C, WSP(bf16_t, WS_X), karg<I_FNG>(), prm.out + OUT_Y, PREVP1(4)); } if (REPQ(34)) { phase_norm_final_b(C, WSP(bf16_t, WS_X), karg<I_FNG>(), prm.out + OUT_Y, PREVP1(4)); } }
#endif
}

#ifdef MK_SEP_CONV
__global__ void __launch_bounds__(512, 2) k_hyconv(Params prm) {
    extern __shared__ __attribute__((aligned(16))) unsigned char lds_raw3[];
    Ctx C; C.lds = (LAS unsigned char*)lds_raw3; C.tid = threadIdx.x; C.lane = C.tid & 63; C.wave = __builtin_amdgcn_readfirstlane(C.tid >> 6); C.G = gridDim.x; C.bid = blockIdx.x; C.out = prm.out; C.ws = prm.ws;
    bf16_t *ZT = WSP(bf16_t, WS_ARENA + AR_ZT), *YT = WSP(bf16_t, WS_ARENA + AR_YT);
    phase_hy_conv<1024, 8>(C, WSP(bf16_t, WS_FGS), ZT + (size_t)MP * D, YT + (size_t)MP * D); phase_hy_conv<256, 16>(C, WSP(bf16_t, WS_FGP), ZT, YT);
}
#endif
#ifdef MK_SEP_GATE
__global__ void __launch_bounds__(512, 2) k_hygate(Params prm) {
    extern __shared__ __attribute__((aligned(16))) unsigned char lds_raw2[];
    Ctx C; C.lds = (LAS unsigned char*)lds_raw2; C.tid = threadIdx.x; C.lane = C.tid & 63; C.wave = __builtin_amdgcn_readfirstlane(C.tid >> 6); C.G = gridDim.x; C.bid = blockIdx.x; C.out = prm.out; C.ws = prm.ws;
    bf16_t* ZT = WSP(bf16_t, WS_ARENA + AR_ZT);
    phase_hy_gate(C, WSP(bf16_t, WS_ARENA + AR_P), karg<I_HYCW>(), karg<I_HYCB>(), WSP(bf16_t, WS_ARENA + AR_X0), ZT, ZT + (size_t)MP * D);
}
#endif
#ifndef MK_PER_PHASE
#define MK_PER_PHASE 0
#endif
extern "C" void kernel_launch(void* const* d_in, const int* in_sizes, int n_in, void* d_out, int out_size, void* d_ws, size_t ws_size, hipStream_t stream) {
    static int grid = 0;
    if (grid == 0) {
        if (n_in != N_IN || ws_size < WS_END || out_size != 37748736) { fprintf(stderr, "kernel_launch: unexpected shapes (n_in %d, ws %zu, out %d); nothing launched\n", n_in, ws_size, out_size); grid = -1; return; }
        int dev = 0, cus = 0, per_cu = 0;
        if (hipGetDevice(&dev) != hipSuccess || hipDeviceGetAttribute(&cus, hipDeviceAttributeMultiprocessorCount, dev) != hipSuccess) { grid = -1; return; }
        if (hipFuncSetAttribute((const void*)fwd_kernel, hipFuncAttributeMaxDynamicSharedMemorySize, LDS_BYTES) != hipSuccess) { fprintf(stderr, "kernel_launch: hipFuncSetAttribute failed\n"); grid = -1; return; }
        if (hipOccupancyMaxActiveBlocksPerMultiprocessor(&per_cu, (const void*)fwd_kernel, 512, LDS_BYTES) != hipSuccess || per_cu < 1) { fprintf(stderr, "kernel_launch: occupancy query says %d\n", per_cu); }
        (void)hipGetLastError();
        grid = cus;
    }
    if (grid < 0) return;
    (void)hipMemsetAsync((char*)d_ws, 0, WS_ZERO_BYTES, stream);
    Params p{};
    for (int i = 0; i < N_IN; ++i) p.in[i] = (const float*)d_in[i];
    p.out = (float*)d_out; p.ws = (unsigned char*)d_ws;
#ifndef MK_LASTP
#define MK_LASTP NPH
#endif
#ifndef MK_FIRSTP
#define MK_FIRSTP 0
#endif
#if MK_PER_PHASE
    for (int k = MK_FIRSTP; k < MK_LASTP; ++k) {
#ifdef MK_SKIP_FROM
        if (k >= MK_SKIP_FROM && k < NPH - 1) continue;
#endif
#ifdef MK_SEP_CONV
        if (k == 11) { static bool a3 = false; if (!a3) { (void)hipFuncSetAttribute((const void*)k_hyconv, hipFuncAttributeMaxDynamicSharedMemorySize, 70000); a3 = true; } hipLaunchKernelGGL(k_hyconv, dim3(grid), dim3(512), 70000, stream, p); continue; }
#endif
#ifdef MK_SEP_GATE
        if (k == 10) { hipLaunchKernelGGL(k_hygate, dim3(grid), dim3(512), 16384, stream, p); continue; }
#endif
#ifdef MK_REPEAT_PH
        if (k == MK_REPEAT_PH) { p.ph_lo = k; p.ph_hi = k + 1; hipLaunchKernelGGL(fwd_kernel, dim3(grid), dim3(512), LDS_BYTES, stream, p); }
#endif
 p.ph_lo = k; p.ph_hi = k + 1; hipLaunchKernelGGL(fwd_kernel, dim3(grid), dim3(512), LDS_BYTES, stream, p); }
#else
    p.ph_lo = 0; p.ph_hi = NPH; hipLaunchKernelGGL(fwd_kernel, dim3(grid), dim3(512), LDS_BYTES, stream, p);
#endif
}
```

```cpp
#include <hip/hip_runtime.h>
#include <cstdio>
#include <cstdint>
namespace pg8 {
#define PG8_LAS __attribute__((address_space(3)))
typedef unsigned short bf16_t;
typedef short bf16x8 __attribute__((ext_vector_type(8)));
typedef float f32x4 __attribute__((ext_vector_type(4)));
typedef unsigned u32x4 __attribute__((ext_vector_type(4)));
constexpr int BM = 256, BK = 64, HALF = 128, HTB = HALF * BK * 2  , STAGE_BYTES = 8 * HTB, NXCD = 8, WGM = 4;

__host__ __device__ __forceinline__ int lds_byte(int r, int c) { const int st = (r >> 4) * 2 + (c >> 5), rr = r & 15, cc = c & 31, ob = rr * 64 + cc * 2; return st * 1024 + (ob ^ (((ob >> 9) & 1) << 5)); }
__host__ __device__ __forceinline__ void stage_rc(int b, int& R, int& C) { const int st = b / 1024, sb = b % 1024, swz = sb ^ (((sb >> 9) & 1) << 5); R = (st >> 1) * 16 + swz / 64; C = (st & 1) * 32 + (swz % 64) / 2; }
__host__ __device__ __forceinline__ int perm32(int rho) { const int n = rho >> 4, i = rho & 15; return 8 * (i >> 2) + 4 * n + (i & 3); }

struct Unit { int pm, pn, kh, mask; int nt = 0; };
struct Gemm { const bf16_t* A; const bf16_t* Bt; int M, N, K, KU; };

__host__ __device__ __forceinline__ bool tail_deal(int nwg, int G, int i, int c, int& L, int& mask) {
    const int full = nwg / G, rem = nwg - full * G;
    if (i < full) { L = i * G + c; mask = 15; return true; }
    if (i > full || rem == 0) return false;
    const int parts = (4 * rem <= G) ? 4 : ((2 * rem <= G) ? 2 : 1);
    if (c >= parts * rem) return false;
    L = full * G + c / parts; const int sub = c % parts;
    mask = parts == 1 ? 15 : (parts == 2 ? (sub ? 0xA : 0x5) : (1 << sub));
    return true;
}
struct StaticOrder {
    int nM, nN, nwg, G, c;
    __host__ __device__ void init(int M, int N, int G_, int c_) { nM = M / BM; nN = N / BM; nwg = nM * nN; G = G_; c = c_; }
    __host__ __device__ bool next(int i, Unit& u) const { const long L = (long)i * G + c; if (L >= nwg) return false; map((int)L, u); u.kh = 0; u.mask = 15; return true; }
    __host__ __device__ bool map(int L, Unit& u) const {
        int wgid = (int)L; { const int q = nwg / NXCD, r = nwg % NXCD, xcd = wgid % NXCD, off = wgid / NXCD; wgid = (xcd < r ? xcd * (q + 1) : r * (q + 1) + (xcd - r) * q) + off; }
        const int nig = WGM * nN, gid = wgid / nig, fm = gid * WGM, gsz = (nM - fm) < WGM ? (nM - fm) : WGM;
        u.pm = fm + ((wgid % nig) % gsz); u.pn = (wgid % nig) / gsz; return true;
    }
    __device__ __forceinline__ void a_ready(const Unit&) const {}
    __device__ __forceinline__ void done(const Unit&) const {}
};

template <class Epi, class Sched, bool STAMP = false>
__device__ __forceinline__ void gemm_phase(PG8_LAS unsigned char* lds, const Gemm g, const Sched& S, const Epi& E, unsigned long long* stamps) {
    const int tid = threadIdx.x, wid = __builtin_amdgcn_readfirstlane(tid >> 6), lane = tid & 63, wr = wid >> 2, wc = wid & 3, fr = lane & 15, fq = lane >> 4;
    const int K = g.K, nt = g.KU / BK;
    int ts_lo = 0, ts_hi = 0, nts = 0; const unsigned long long rt_entry = STAMP ? (unsigned long long)wall_clock64() : 0ull;
#define PG8_STAMP() do { if (STAMP && wid == 0 && nts < 64) { const unsigned long long _c = (unsigned long long)clock64(); \
        ts_lo = (lane == nts) ? (int)(unsigned)_c : ts_lo; ts_hi = (lane == nts) ? (int)(unsigned)(_c >> 32) : ts_hi; ++nts; } } while (0)
    PG8_STAMP();
    unsigned voffA[2], voffB[2];
#pragma unroll
    for (int i = 0; i < 2; ++i) { int R, C; stage_rc(tid * 16 + i * 8192, R, C); const int Rb = Epi::PERM ? ((R & ~31) + perm32(R & 31)) : R;
        voffA[i] = (unsigned)(R * K + C) * 2u; voffB[i] = (unsigned)(Rb * K + C) * 2u; }
    const size_t kstep = (size_t)(BK * 2);
    const size_t hstep = (size_t)HALF * K * 2;
    const size_t tstep = 2 * hstep;
    const unsigned ldsw = (unsigned)wid * 1024u;
    const int aoff = lds_byte(wr * 64 + fr, fq * 8), boff = lds_byte(wc * 32 + fr, fq * 8);
#define PG8_SA(b, h) (((b) * 2 + (h)) * HTB)
#define PG8_SB(b, h) ((4 + (b) * 2 + (h)) * HTB)
#define PG8_STAGE(bufoff, gbase, voff) do { _Pragma("unroll") for (int _i = 0; _i < 2; ++_i) \
        __builtin_amdgcn_global_load_lds((const unsigned*)((const char*)(gbase) + (voff)[_i]), (PG8_LAS unsigned*)(lds + (bufoff) + ldsw + _i * 8192), 16, 0, 0); } while (0)
#define PG8_LDA(dst, b, h) do { _Pragma("unroll") for (int m = 0; m < 4; ++m) _Pragma("unroll") for (int k = 0; k < 2; ++k) dst[m][k] = *(const PG8_LAS bf16x8*)(lds + PG8_SA(b, h) + aoff + m * 2048 + k * 1024); } while (0)
#define PG8_LDB(dst, b, h) do { _Pragma("unroll") for (int n = 0; n < 2; ++n) _Pragma("unroll") for (int k = 0; k < 2; ++k) dst[n][k] = *(const PG8_LAS bf16x8*)(lds + PG8_SB(b, h) + boff + n * 2048 + k * 1024); } while (0)
#define PG8_MMA(ai, bj, At, Bt) do { __builtin_amdgcn_s_setprio(1); _Pragma("unroll") for (int k = 0; k < 2; ++k) _Pragma("unroll") for (int m = 0; m < 4; ++m) _Pragma("unroll") for (int n = 0; n < 2; ++n) \
        asm volatile("v_mfma_f32_16x16x32_bf16 %0, %1, %2, %0" : "+v"(acc[ai][bj][m][n]) : "v"(Bt[n][k]), "v"(At[m][k])); __builtin_amdgcn_s_setprio(0); } while (0)
#define PG8_ACC_FENCE1(ai, bj) asm volatile("s_nop 15\n\ts_nop 15" : "+v"(acc[ai][bj][0][0]), "+v"(acc[ai][bj][0][1]), "+v"(acc[ai][bj][1][0]), "+v"(acc[ai][bj][1][1]), "+v"(acc[ai][bj][2][0]), "+v"(acc[ai][bj][2][1]), "+v"(acc[ai][bj][3][0]), "+v"(acc[ai][bj][3][1]))
#define PG8_ACC_FENCE() do { PG8_ACC_FENCE1(0, 0); PG8_ACC_FENCE1(0, 1); PG8_ACC_FENCE1(1, 0); PG8_ACC_FENCE1(1, 1); } while (0)
#define PG8_WAIT_V(n) asm volatile("s_waitcnt vmcnt(" #n ")" ::: "memory")
#define PG8_WAIT_L(n) asm volatile("s_waitcnt lgkmcnt(" #n ")" ::: "memory")
#define PG8_BAR __builtin_amdgcn_s_barrier()
#define PG8_SCHED __builtin_amdgcn_sched_barrier(0)
    Unit cur, nxt; int ui = 0;
    if (!S.next(0, cur)) return;
    f32x4 acc[2][2][4][2];
#pragma unroll
    for (int a = 0; a < 2; ++a)
#pragma unroll
        for (int b = 0; b < 2; ++b)
#pragma unroll
            for (int m = 0; m < 4; ++m)
#pragma unroll
                for (int n = 0; n < 2; ++n) acc[a][b][m][n] = (f32x4){0.f, 0.f, 0.f, 0.f};
    bf16x8 At[4][2], B0[2][2], B1[2][2];
    const size_t kslice = (size_t)g.KU * 2;
    const char* cA = (const char*)g.A + (size_t)cur.pm * tstep + cur.kh * kslice; const char* cB = (const char*)g.Bt + (size_t)cur.pn * tstep + cur.kh * kslice;
    S.a_ready(cur);
    PG8_STAGE(PG8_SB(0, 0), cB, voffB); PG8_STAGE(PG8_SA(0, 0), cA, voffA); PG8_STAGE(PG8_SB(0, 1), cB + hstep, voffB); PG8_STAGE(PG8_SA(0, 1), cA + hstep, voffA);
    if (wr == 1) PG8_BAR;
    PG8_WAIT_V(4); PG8_BAR;
    PG8_STAGE(PG8_SB(1, 0), cB + kstep, voffB); PG8_STAGE(PG8_SA(1, 0), cA + kstep, voffA); PG8_STAGE(PG8_SB(1, 1), cB + hstep + kstep, voffB);
    PG8_WAIT_V(6); PG8_BAR;
    PG8_STAMP();
    for (;;) {
        const bool has_next = S.next(ui + 1, nxt);
        const char* nA = has_next ? (const char*)g.A + (size_t)nxt.pm * tstep + nxt.kh * kslice : cA; const char* nB = has_next ? (const char*)g.Bt + (size_t)nxt.pn * tstep + nxt.kh * kslice : cB;
        const int unt = cur.nt ? cur.nt : nt;
        for (int t = 0; t < unt; t += 2) {
            const bool last = (t == unt - 2);
            const char* a1 = cA + (size_t)(t + 1) * kstep;
            const char* a2 = last ? nA : cA + (size_t)(t + 2) * kstep; const char* b2 = last ? nB : cB + (size_t)(t + 2) * kstep;
            const char* a3 = a2 + kstep; const char* b3 = b2 + kstep;
            if (last && has_next) S.a_ready(nxt);
            PG8_LDB(B0, 0, 0); PG8_SCHED; PG8_LDA(At, 0, 0); PG8_STAGE(PG8_SA(1, 1), a1 + hstep, voffA);
            PG8_WAIT_L(8); PG8_BAR; PG8_WAIT_L(0); PG8_MMA(0, 0, At, B0); PG8_BAR; PG8_SCHED;
            PG8_LDB(B1, 0, 1); PG8_STAGE(PG8_SB(0, 0), b2, voffB);
            PG8_BAR; PG8_WAIT_L(0); PG8_MMA(0, 1, At, B1); PG8_BAR;
            PG8_LDA(At, 0, 1); PG8_STAGE(PG8_SA(0, 0), a2, voffA);
            PG8_BAR; PG8_WAIT_L(0); PG8_MMA(1, 0, At, B0); PG8_BAR; PG8_SCHED;
            PG8_STAGE(PG8_SB(0, 1), b2 + hstep, voffB);
            PG8_WAIT_V(6); PG8_BAR; PG8_MMA(1, 1, At, B1); PG8_BAR;
            PG8_LDB(B0, 1, 0); PG8_SCHED; PG8_LDA(At, 1, 0); PG8_STAGE(PG8_SA(0, 1), a2 + hstep, voffA);
            PG8_WAIT_L(8); PG8_BAR; PG8_WAIT_L(0); PG8_MMA(0, 0, At, B0); PG8_BAR; PG8_SCHED;
            PG8_LDB(B1, 1, 1); PG8_STAGE(PG8_SB(1, 0), b3, voffB);
            PG8_BAR; PG8_WAIT_L(0); PG8_MMA(0, 1, At, B1); PG8_BAR;
            PG8_LDA(At, 1, 1); PG8_STAGE(PG8_SA(1, 0), a3, voffA);
            PG8_BAR; PG8_WAIT_L(0); PG8_MMA(1, 0, At, B0); PG8_BAR; PG8_SCHED;
            PG8_STAGE(PG8_SB(1, 1), b3 + hstep, voffB);
            PG8_WAIT_V(6); PG8_BAR; PG8_MMA(1, 1, At, B1); PG8_BAR;
        }
        PG8_STAMP();
        PG8_ACC_FENCE();
        if constexpr (!Epi::AFTER_DRAIN) { E(acc, cur, wr, wc, fr, fq); S.done(cur); }
        PG8_STAMP();
        if (!has_next) break;
#pragma unroll
        for (int a = 0; a < 2; ++a)
#pragma unroll
            for (int b = 0; b < 2; ++b)
#pragma unroll
                for (int m = 0; m < 4; ++m)
#pragma unroll
                    for (int n = 0; n < 2; ++n) acc[a][b][m][n] = (f32x4){0.f, 0.f, 0.f, 0.f};
        cur = nxt; cA = nA; cB = nB; ++ui;
    }
    PG8_WAIT_V(0);
    if (wr == 0) PG8_BAR;
    PG8_BAR;
    if constexpr (Epi::AFTER_DRAIN) { E.fused(acc, cur, wr, wc, fr, fq, lds, wid, lane); S.done(cur); }
    PG8_STAMP();
    if (STAMP && wid == 0) { stamps[lane] = lane < nts ? (((unsigned long long)(unsigned)ts_hi << 32) | (unsigned)ts_lo) : 0ull;
        if (lane == 62) stamps[62] = rt_entry; if (lane == 63) stamps[63] = (unsigned long long)wall_clock64(); }
#undef PG8_STAMP
#undef PG8_SA
#undef PG8_SB
#undef PG8_STAGE
#undef PG8_LDA
#undef PG8_LDB
#undef PG8_MMA
#undef PG8_ACC_FENCE
#undef PG8_ACC_FENCE1
#undef PG8_WAIT_V
#undef PG8_WAIT_L
#undef PG8_BAR
#undef PG8_SCHED
}
}

#define XB_TMO      128
#define XB_XCNT(j)  (256  + 64 * (j))
#define XB_XSUB(j)  (1280 + 64 * (j))
#define XB_XGEN(j)  (2304 + 64 * (j))
#define XB_TOP      3328
#define XB_TOPGEN   3392
#define XCD_BAR_WORDS 3456
#define XB_SPIN_CAP (1u << 20)
#define LAS __attribute__((address_space(3)))

__device__ __forceinline__ unsigned xb_ld(unsigned* p)              { return __hip_atomic_load(p, __ATOMIC_RELAXED, __HIP_MEMORY_SCOPE_AGENT); }
__device__ __forceinline__ unsigned xb_add(unsigned* p, unsigned v) { return __hip_atomic_fetch_add(p, v, __ATOMIC_RELAXED, __HIP_MEMORY_SCOPE_AGENT); }
__device__ __forceinline__ unsigned xb_xcc_id() { return (unsigned)__builtin_amdgcn_s_getreg((3 << 11) | 20) & 0xFu; }
#define XB_SPIN(cond, bar) do { unsigned _sp = 0; while (cond) { __builtin_amdgcn_s_sleep(1); \
    if ((++_sp & 255u) == 0u) { if (xb_ld(&(bar)[XB_TMO])) break; if (_sp > XB_SPIN_CAP) { atomicAdd(&(bar)[XB_TMO], 1u); break; } } } } while (0)

struct XcdBarrier {
    unsigned* bar; unsigned x;
    volatile LAS unsigned* st;
};

__device__ __forceinline__ XcdBarrier xcd_barrier_post(unsigned* bar, volatile LAS unsigned* st) {
    XcdBarrier b; b.bar = bar; b.x = xb_xcc_id(); b.st = st;
    if (threadIdx.x == 0) (void)xb_add(&bar[XB_XCNT(b.x)], 1u);
    return b;
}
__device__ __forceinline__ void xcd_barrier_complete(unsigned* bar, unsigned x, unsigned& nloc, unsigned& nx) {
    const unsigned G = gridDim.x * gridDim.y * gridDim.z;
    unsigned sum, cnt, mine, sp = 0u;
    for (;;) {
        sum = 0u; cnt = 0u; mine = 0u;
#pragma unroll
        for (unsigned j = 0; j < 16; ++j) { const unsigned c = xb_ld(&bar[XB_XCNT(j)]); sum += c; cnt += (c > 0u) ? 1u : 0u; mine = (j == x) ? c : mine; }
        if (sum == G) break;
        __builtin_amdgcn_s_sleep(1);
        if ((++sp & 255u) == 0u) { if (xb_ld(&bar[XB_TMO])) break; if (sp > XB_SPIN_CAP) { atomicAdd(&bar[XB_TMO], 1u); break; } }
    }
    nloc = mine > 0u ? mine : 1u; nx = cnt > 0u ? cnt : 1u;
}

__device__ __forceinline__ void xcd_barrier(const XcdBarrier& b) {
    asm volatile("s_waitcnt vmcnt(0)" ::: "memory");
    __syncthreads();
    if (threadIdx.x == 0) {
        unsigned* bar = b.bar;
        __builtin_amdgcn_s_waitcnt(0);
        unsigned nloc = b.st[0], nx = b.st[1];
        if (nloc == 0u) { xcd_barrier_complete(bar, b.x, nloc, nx); b.st[0] = nloc; b.st[1] = nx; }
        const unsigned old = xb_add(&bar[XB_XSUB(b.x)], 1u);
        const unsigned gen = old / nloc;
        if (old + 1u == (gen + 1u) * nloc) {
            __builtin_amdgcn_fence(__ATOMIC_RELEASE, "agent");
            asm volatile("s_waitcnt vmcnt(0)" ::: "memory");
            const unsigned og = xb_add(&bar[XB_TOP], 1u);
            const unsigned tg = og / nx;
            if (og + 1u == (tg + 1u) * nx) xb_add(&bar[XB_TOPGEN], 1u);
            else XB_SPIN(xb_ld(&bar[XB_TOPGEN]) == tg, bar);
            __builtin_amdgcn_fence(__ATOMIC_ACQUIRE, "agent");
            xb_add(&bar[XB_XGEN(b.x)], 1u);
            asm volatile("s_waitcnt vmcnt(0)" ::: "memory");
        } else {
            XB_SPIN(xb_ld(&bar[XB_XGEN(b.x)]) == gen, bar);
            __builtin_amdgcn_fence(__ATOMIC_ACQUIRE, "agent");
            asm volatile("s_waitcnt vmcnt(0)" ::: "memory");
        }
    }
    __syncthreads();
}

typedef unsigned short bf16_t;
typedef short bf16x8 __attribute__((ext_vector_type(8)));
typedef short bf16x4 __attribute__((ext_vector_type(4)));
typedef float f32x2 __attribute__((ext_vector_type(2)));
typedef float f32x4 __attribute__((ext_vector_type(4)));
typedef float f32x16 __attribute__((ext_vector_type(16)));
typedef unsigned u32x4 __attribute__((ext_vector_type(4)));
typedef unsigned u32x2 __attribute__((ext_vector_type(2)));

constexpr int D = 2048, FF = 8192, MP = 4096, MS = 8192, MT = 12288;
constexpr int NPANEL = MT / 256;
constexpr size_t MiB = 1u << 20;
constexpr size_t WS_CTL = 0, WS_MOD = 1 * MiB, WS_ZERO_BYTES = 3 * MiB;
constexpr size_t WS_ROPE = 3 * MiB;
constexpr size_t WS_W1T = 4 * MiB, WS_W2T = 132 * MiB, WS_WQKVT = 260 * MiB, WS_WOT = 284 * MiB, WS_HYINT = 300 * MiB, WS_HYOUTT = 324 * MiB;
constexpr size_t WS_RWBT = 332 * MiB, WS_LORA2T = 359 * MiB, WS_RWOT = 364 * MiB, WS_KC = 372 * MiB, WS_VC = 380 * MiB, WS_FGS = 388 * MiB, WS_FGP = 397 * MiB;
constexpr size_t WS_X = 400 * MiB, WS_H = 496 * MiB, WS_ARENA = 544 * MiB, WS_INVSQ = 1186 * MiB, WS_END = 1188 * MiB;
constexpr size_t AR_U = 0;
constexpr size_t AR_Q = 0, AR_K = 48 * MiB, AR_V = 60 * MiB, AR_O = 72 * MiB;
constexpr size_t AR_P = 0, AR_X0 = 144 * MiB, AR_ZT = 192 * MiB, AR_YT = 240 * MiB, AR_HO = 288 * MiB;
constexpr size_t AR_XMIX = 0, AR_LD = 0, AR_LA = 96 * MiB, AR_G = 192 * MiB, AR_RO = 240 * MiB, AR_R = 288 * MiB, AR_KK = 336 * MiB, AR_VV = 384 * MiB, AR_A3 = 432 * MiB, AR_YB = 450 * MiB;
constexpr size_t OUT_Y = 0, OUT_NK = 25165824, OUT_NV = 29360128, OUT_ST = 33554432;
constexpr int FGS_ROW = 2112, FGP_ROW = 576;
constexpr size_t AR_FILT = 600 * MiB;
constexpr int LDS_BAR_OFF = 147456, LDS_BYTES = 147456 + 1024;

enum { I_XP = 0, I_XS, I_CK, I_CV, I_ST, I_C, I_CCTX, I_ADAW, I_ADAB, I_N1G, I_N2G, I_MW1, I_MW2, I_WQKV, I_WO, I_SINK, I_HYWIN, I_HYCW, I_HYCB, I_FW1, I_FB1, I_FW2, I_FB2, I_FW3, I_FB3,
       I_FREQ, I_FWOUT, I_HYBIAS, I_HYWOUT, I_MU, I_WR, I_WK, I_WV, I_RWO, I_W0, I_W1, I_W2, I_A0, I_A1, I_A2, I_G1, I_G2, I_KK, I_KA, I_RK, I_LNW, I_LNB, I_FNG, N_IN };

struct Params { const float* in[N_IN]; float* out; unsigned char* ws; int ph_lo, ph_hi; };

__device__ __forceinline__ unsigned cvt_pk(float lo, float hi) { unsigned r; asm("v_cvt_pk_bf16_f32 %0, %1, %2" : "=v"(r) : "v"(lo), "v"(hi)); return r; }
__device__ __forceinline__ float bflo(unsigned w) { return __uint_as_float(w << 16); }
__device__ __forceinline__ float bfhi(unsigned w) { return __uint_as_float(w & 0xffff0000u); }
__device__ __forceinline__ float bf2f(bf16_t b) { return __uint_as_float(((unsigned)b) << 16); }
__device__ __forceinline__ float dpp_f(float x, const int ctrl) { return x; }
#define DPP_ADD(x, ctrl) ((x) + __int_as_float(__builtin_amdgcn_update_dpp(0, __float_as_int(x), (ctrl), 0xF, 0xF, true)))
__device__ __forceinline__ float wave_sum(float v) {
    v = DPP_ADD(v, 0xB1); v = DPP_ADD(v, 0x4E); v = DPP_ADD(v, 0x141); v = DPP_ADD(v, 0x140);
    const int vi = __float_as_int(v);
    const float r0 = __int_as_float(__builtin_amdgcn_readlane(vi, 0)), r1 = __int_as_float(__builtin_amdgcn_readlane(vi, 16)),
                r2 = __int_as_float(__builtin_amdgcn_readlane(vi, 32)), r3 = __int_as_float(__builtin_amdgcn_readlane(vi, 48));
    return (r0 + r1) + (r2 + r3);
}
__device__ __forceinline__ float opaque_zero() { float z; asm volatile("v_mov_b32 %0, 0" : "=v"(z)); return z; }
__device__ __forceinline__ float fexp2(float x) { return __builtin_amdgcn_exp2f(x); }
__device__ __forceinline__ float fexp(float x) { return __builtin_amdgcn_exp2f(x * 1.4426950408889634f); }
__device__ __forceinline__ float flog(float x) { return __builtin_amdgcn_logf(x) * 0.6931471805599453f; }
__device__ __forceinline__ float frcp(float x) { return __builtin_amdgcn_rcpf(x); }
__device__ __forceinline__ float fsigmoid(float x) { return frcp(1.0f + fexp(-x)); }
__device__ __forceinline__ float ftanh(float x) { const float e = fexp(2.0f * x); return 1.0f - 2.0f * frcp(e + 1.0f); }
__device__ __forceinline__ float fsoftplus(float x) { return fmaxf(x, 0.0f) + flog(1.0f + fexp(-fabsf(x))); }
__device__ __forceinline__ float fsin_rev(float rev) { return __builtin_amdgcn_sinf(rev - rintf(rev)); }
__device__ __forceinline__ float fcos_rev(float rev) { return __builtin_amdgcn_cosf(rev - rintf(rev)); }
__device__ __forceinline__ float fsin(float x) { return fsin_rev(x * 0.15915494309189535f); }
__device__ __forceinline__ int cond_of_row(int m) { return m < MP ? 0 : 1 + ((m - MP) >> 10); }
__device__ __forceinline__ int cond_of_panel(int pm) { return pm < 16 ? 0 : 1 + ((pm - 16) >> 2); }

struct Ctx {
    LAS unsigned char* lds;
    int tid, lane, wave, G, bid;
    float* out;
    unsigned char* ws;
};
template <int IDX> __device__ __forceinline__ const float* karg() {
    unsigned long long v;
    asm volatile("s_load_dwordx2 %0, %1, %2\n\ts_waitcnt lgkmcnt(0)" : "=s"(v) : "s"(__builtin_amdgcn_kernarg_segment_ptr()), "n"(IDX * 8));
    return (const float*)v;
}
#define WSP(T, off) ((T*)(C.ws + (off)))
#define MODP(l, cond, which) (WSP(float, WS_MOD) + ((size_t)((l) * 9 + (cond)) * 6 + (which)) * D)

__device__ __forceinline__ void p0_transpose_item(const float* W, int K, int N, bf16_t* WT, LAS float* scr, int item, int lane) {
    const int nblk = N / 32, kb = item / nblk, nb = item % nblk, k0 = 64 * kb, n0 = 32 * nb;
    const int rsub = lane >> 3, c4 = (lane & 7) * 4;
    f32x4 v[8];
#pragma unroll
    for (int i = 0; i < 8; ++i) v[i] = *(const f32x4*)(W + (size_t)(k0 + 8 * i + rsub) * N + n0 + c4);
#pragma unroll
    for (int i = 0; i < 8; ++i) { LAS float* d = scr + (8 * i + rsub) * 33 + c4; d[0] = v[i].x; d[1] = v[i].y; d[2] = v[i].z; d[3] = v[i].w; }
    asm volatile("s_waitcnt lgkmcnt(0)" ::: "memory");
    const int c = lane & 7;
#pragma unroll
    for (int j = 0; j < 4; ++j) { const int n = (lane >> 3) + 8 * j; const LAS float* s = scr + (8 * c) * 33 + n;
        u32x4 o; o.x = cvt_pk(s[0 * 33], s[1 * 33]); o.y = cvt_pk(s[2 * 33], s[3 * 33]); o.z = cvt_pk(s[4 * 33], s[5 * 33]); o.w = cvt_pk(s[6 * 33], s[7 * 33]);
        *(u32x4*)(WT + (size_t)(n0 + n) * K + k0 + 8 * c) = o; }
    asm volatile("s_waitcnt lgkmcnt(0)" ::: "memory");
}

__device__ __forceinline__ void late_transposes(const Ctx& C, LAS float* scr, int wv, int nwv) {
    constexpr int I_M = 8192, I_QKV = 3072, I_O = 2048;
    constexpr int NIT = 4 * I_M + I_QKV + I_O;
    for (int it = wv; it < NIT; it += nwv) {
        int r = it;
        if (r < 2 * I_M) { const int l = 2 + r / I_M; p0_transpose_item(karg<I_MW1>() + (size_t)l * D * FF, D, FF, WSP(bf16_t, WS_W1T) + (size_t)l * D * FF, scr, r % I_M, C.lane); continue; } r -= 2 * I_M;
        if (r < 2 * I_M) { const int l = 2 + r / I_M; p0_transpose_item(karg<I_MW2>() + (size_t)l * D * FF, FF, D, WSP(bf16_t, WS_W2T) + (size_t)l * D * FF, scr, r % I_M, C.lane); continue; } r -= 2 * I_M;
        if (r < I_QKV) { p0_transpose_item(karg<I_WQKV>() + (size_t)D * 3072, D, 3072, WSP(bf16_t, WS_WQKVT) + (size_t)D * 3072, scr, r, C.lane); continue; } r -= I_QKV;
        p0_transpose_item(karg<I_WO>() + (size_t)D * D, D, D, WSP(bf16_t, WS_WOT) + (size_t)D * D, scr, r, C.lane);
    }
}
#ifndef MK_PRO_MASK
#define MK_PRO_MASK 127
#endif
__device__ __forceinline__ void phase_prologue(const Ctx& C) {
    const int gw = C.bid * 8 + C.wave, NGW = C.G * 8, lane = C.lane;
    const size_t gt = (size_t)C.bid * 512 + C.tid, NGT = (size_t)C.G * 512;
    LAS float* scr = (LAS float*)(C.lds + C.wave * 16384);
    if (MK_PRO_MASK & 1)
    {
        constexpr int I_M1 = 8192, I_M2 = 8192, I_QKV = 3072, I_O = 2048, I_HI = 6144, I_SQ = 2048;
        constexpr int NIT = 2 * I_M1 + 2 * I_M2 + I_QKV + I_O + I_HI + I_SQ + 4 * I_SQ;
        for (int it = gw; it < NIT; it += NGW) {
            int r = it;
            if (r < 2 * I_M1) { const int l = r / I_M1; p0_transpose_item(karg<I_MW1>() + (size_t)l * D * FF, D, FF, WSP(bf16_t, WS_W1T) + (size_t)l * D * FF, scr, r % I_M1, lane); continue; } r -= 2 * I_M1;
            if (r < 2 * I_M2) { const int l = r / I_M2; p0_transpose_item(karg<I_MW2>() + (size_t)l * D * FF, FF, D, WSP(bf16_t, WS_W2T) + (size_t)l * D * FF, scr, r % I_M2, lane); continue; } r -= 2 * I_M2;
            if (r < I_QKV) { p0_transpose_item(karg<I_WQKV>(), D, 3072, WSP(bf16_t, WS_WQKVT), scr, r, lane); continue; } r -= I_QKV;
            if (r < I_O) { p0_transpose_item(karg<I_WO>(), D, D, WSP(bf16_t, WS_WOT), scr, r, lane); continue; } r -= I_O;
            if (r < I_HI) { p0_transpose_item(karg<I_HYWIN>(), D, 6144, WSP(bf16_t, WS_HYINT), scr, r, lane); continue; } r -= I_HI;
            if (r < I_SQ) { p0_transpose_item(karg<I_HYWOUT>(), D, D, WSP(bf16_t, WS_HYOUTT), scr, r, lane); continue; } r -= I_SQ;
            if (r < I_SQ) { p0_transpose_item(karg<I_WR>(), D, D, WSP(bf16_t, WS_RWBT), scr, r, lane); continue; } r -= I_SQ;
            if (r < I_SQ) { p0_transpose_item(karg<I_WK>(), D, D, WSP(bf16_t, WS_RWBT) + (size_t)D * D, scr, r, lane); continue; } r -= I_SQ;
            if (r < I_SQ) { p0_transpose_item(karg<I_WV>(), D, D, WSP(bf16_t, WS_RWBT) + (size_t)2 * D * D, scr, r, lane); continue; } r -= I_SQ;
            p0_transpose_item(karg<I_RWO>(), D, D, WSP(bf16_t, WS_RWOT), scr, r, lane);
        }
    }
    if (MK_PRO_MASK & 2)
    {
        bf16_t* L1 = WSP(bf16_t, WS_RWBT) + (size_t)3 * D * D;
#pragma unroll
        for (int part = 0; part < 7; ++part) {
            const int row0 = part == 0 ? 0 : part == 1 ? 96 : part == 2 ? 192 : part == 3 ? 256 : part == 4 ? 352 : part == 5 ? 448 : 512;
            const int nrow = (part == 2 || part == 5) ? 64 : (part == 6 ? 256 : 96);
            const int ld = part == 6 ? 256 : 96;
            const float* src = part == 0 ? karg<I_W1>() : part == 1 ? karg<I_W1>() + (size_t)D * 96 : part == 3 ? karg<I_A1>() : part == 4 ? karg<I_A1>() + (size_t)D * 96 : karg<I_G1>();
            const bool zero = (part == 2 || part == 5);
            for (size_t i = gt; i < (size_t)nrow * 256; i += NGT) {
                const int rr = (int)(i / 256), k8 = (int)(i % 256);
                float v[8];
#pragma unroll
                for (int j = 0; j < 8; ++j) v[j] = zero ? 0.0f : src[(size_t)(8 * k8 + j) * ld + rr];
                u32x4 o; o.x = cvt_pk(v[0], v[1]); o.y = cvt_pk(v[2], v[3]); o.z = cvt_pk(v[4], v[5]); o.w = cvt_pk(v[6], v[7]);
                *(u32x4*)(L1 + (size_t)(row0 + rr) * D + 8 * k8) = o;
            }
        }
        bf16_t* L2 = WSP(bf16_t, WS_LORA2T);
#pragma unroll
        for (int mat = 0; mat < 5; ++mat) {
            const float* src = mat == 0 ? karg<I_W2>() : mat == 1 ? karg<I_W2>() + (size_t)96 * D : mat == 2 ? karg<I_A2>() : mat == 3 ? karg<I_A2>() + (size_t)96 * D : karg<I_G2>();
            const int kofs = (mat == 1 || mat == 3) ? 96 : 0, klen = mat == 4 ? 256 : 96;
            for (size_t i = gt; i < (size_t)2048 * 32; i += NGT) {
                const int n = (int)(i / 32), k8 = (int)(i % 32);
                float v[8];
#pragma unroll
                for (int j = 0; j < 8; ++j) { const int k = 8 * k8 + j - kofs; const int kc = k < 0 ? 0 : (k >= klen ? klen - 1 : k); const float x = src[(size_t)kc * D + n]; v[j] = (k >= 0 && k < klen) ? x : 0.0f; }
                u32x4 o; o.x = cvt_pk(v[0], v[1]); o.y = cvt_pk(v[2], v[3]); o.z = cvt_pk(v[4], v[5]); o.w = cvt_pk(v[6], v[7]);
                *(u32x4*)(L2 + ((size_t)mat * 2048 + n) * 256 + 8 * k8) = o;
            }
        }
    }
    if (MK_PRO_MASK & 4)
    for (size_t i = gt; i < 2048; i += NGT) {
        const int pos = (int)(i >> 5), fi = (int)(i & 31);
        const float inv = fexp2(-(float)(2 * fi) * (13.287712379549449f / 64.0f));
        const float rev = (float)pos * inv * 0.15915494309189535f;
        WSP(f32x2, WS_ROPE)[i] = (f32x2){fcos_rev(rev), fsin_rev(rev)};
    }
    for (size_t i = gt; i < (size_t)MT * 32 / 4; i += NGT) WSP(f32x4, WS_INVSQ)[i] = (f32x4){0.f, 0.f, 0.f, 0.f};
    if (MK_PRO_MASK & 8)
    { const float *ckp = karg<I_CK>(), *cvp = karg<I_CV>();
    for (size_t i = gt; i < (size_t)2 * 524288; i += NGT) {
        const bool isv = i >= 524288; const size_t e = (isv ? i - 524288 : i) * 8;
        const float* src = (isv ? cvp : ckp) + e;
        const f32x4 a = *(const f32x4*)src, b = *(const f32x4*)(src + 4);
        u32x4 o; o.x = cvt_pk(a.x, a.y); o.y = cvt_pk(a.z, a.w); o.z = cvt_pk(b.x, b.y); o.w = cvt_pk(b.z, b.w);
        *(u32x4*)(WSP(bf16_t, isv ? WS_VC : WS_KC) + e) = o;
    } }
    if (MK_PRO_MASK & 32)
    {
        __syncthreads();
        LAS float* tab = (LAS float*)C.lds;
        LAS float* red = (LAS float*)(C.lds + 73728);
        const float *cctx = karg<I_CCTX>(), *cc = karg<I_C>();
        for (int e = C.tid; e < 9 * D; e += 512) { const int j = e >> 11, k = e & (D - 1);
            const float cv = j == 0 ? cctx[k] : cc[(size_t)(j == 0 ? 0 : j - 1) * D + k]; tab[e] = cv * fsigmoid(cv); }
        __syncthreads();
        const float* adaw = karg<I_ADAW>(); const float* adab = karg<I_ADAB>();
        for (int it = C.bid; it < 4 * 192; it += C.G) {
            const int nb = it % 192, l = it / 192, w = C.wave;
            float acc[9];
#pragma unroll
            for (int j = 0; j < 9; ++j) acc[j] = 0.f;
            const float* wp = adaw + ((size_t)l * D + 256 * w) * (6 * D) + nb * 64 + lane;
#pragma unroll 4
            for (int k4 = 0; k4 < 256; k4 += 4) {
                const float w0 = wp[(size_t)(k4 + 0) * (6 * D)], w1 = wp[(size_t)(k4 + 1) * (6 * D)], w2 = wp[(size_t)(k4 + 2) * (6 * D)], w3 = wp[(size_t)(k4 + 3) * (6 * D)];
#pragma unroll
                for (int j = 0; j < 9; ++j) { const f32x4 sv = *(const LAS f32x4*)(tab + j * D + 256 * w + k4); acc[j] += (w0 * sv.x + w1 * sv.y) + (w2 * sv.z + w3 * sv.w); }
            }
#pragma unroll
            for (int j = 0; j < 9; ++j) red[(w * 9 + j) * 64 + lane] = acc[j];
            __syncthreads();
            for (int e = C.tid; e < 9 * 64; e += 512) { const int j = e >> 6, c = e & 63; float sum = adab[(size_t)l * 6 * D + nb * 64 + c];
#pragma unroll
                for (int ww = 0; ww < 8; ++ww) sum += red[(ww * 9 + j) * 64 + c];
                WSP(float, WS_MOD)[((size_t)l * 9 + j) * 6 * D + nb * 64 + c] = sum; }
            __syncthreads();
        }
    }
    if (MK_PRO_MASK & 64)
    {
        const float *fw1 = karg<I_FW1>(), *fw2 = karg<I_FW2>(), *fw3 = karg<I_FW3>(), *fwout = karg<I_FWOUT>(), *hbias = karg<I_HYBIAS>();
        const float fq = karg<I_FREQ>()[lane]; const float fb1 = karg<I_FB1>()[lane], fb2 = karg<I_FB2>()[lane], fb3 = karg<I_FB3>()[lane];
        for (int it = C.bid; it < 160; it += C.G) {
            const bool smp = it >= 32; const int nbase = (smp ? it - 32 : it) * 8; const int L = smp ? 1024 : 256; const int n = nbase + C.wave;
            float* FILT = WSP(float, WS_ARENA + AR_FILT) + (smp ? 0 : (size_t)1024 * 4096);
            __syncthreads();
            if (lane < 33) {
                float z;
                if (lane == 0) z = (float)n / (float)(L - 1);
                else { const int i = (lane - 1) & 15; const float fr = 1e-4f + (float)i * ((15.0f - 1e-4f) / 15.0f); const float rev = fr * (float)n / (float)L;
                       z = lane <= 16 ? fcos_rev(rev) : -fsin_rev(rev); }
                scr[lane] = z;
            }
            asm volatile("s_waitcnt lgkmcnt(0)" ::: "memory");
            float pre = fb1;
#pragma unroll 3
            for (int e = 0; e < 33; ++e) pre += scr[e] * fw1[e * 64 + lane];
            float hv = fsin(fq * pre);
            asm volatile("s_waitcnt lgkmcnt(0)" ::: "memory");
            scr[64 + lane] = hv;
            asm volatile("s_waitcnt lgkmcnt(0)" ::: "memory");
            pre = fb2;
#pragma unroll 4
            for (int e = 0; e < 64; ++e) pre += scr[64 + e] * fw2[e * 64 + lane];
            hv = fsin(fq * pre);
            asm volatile("s_waitcnt lgkmcnt(0)" ::: "memory");
            scr[128 + lane] = hv;
            asm volatile("s_waitcnt lgkmcnt(0)" ::: "memory");
            pre = fb3;
#pragma unroll 4
            for (int e = 0; e < 64; ++e) pre += scr[128 + e] * fw3[e * 64 + lane];
            hv = fsin(fq * pre);
            scr[1024 + lane] = hv;
            __syncthreads();
            float acc[8][8];
#pragma unroll
            for (int nn = 0; nn < 8; ++nn)
#pragma unroll
                for (int i = 0; i < 8; ++i) acc[nn][i] = 0.f;
            const float* wo = fwout + 512 * C.wave + lane;
#pragma unroll 2
            for (int e = 0; e < 64; ++e) {
                float wv[8];
#pragma unroll
                for (int i = 0; i < 8; ++i) wv[i] = wo[(size_t)e * 4096 + i * 64];
#pragma unroll
                for (int nn = 0; nn < 8; ++nn) { const float hh = ((const LAS float*)(C.lds + nn * 16384))[1024 + e];
#pragma unroll
                    for (int i = 0; i < 8; ++i) acc[nn][i] += hh * wv[i]; }
            }
#pragma unroll
            for (int nn = 0; nn < 8; ++nn) { const int n2 = nbase + nn; const float tn = (float)n2 / (float)(L - 1);
#pragma unroll
                for (int i = 0; i < 8; ++i) {
                    const int o = 512 * C.wave + i * 64 + lane, dir = o >> 11, c = o & 2047;
                    const float delta = -3.0701134573253944f + (float)c * ((-15.350567286626972f + 3.0701134573253944f) / 2047.0f);
                    float val = acc[nn][i] * fexp(-tn * fabsf(delta));
                    if (dir == 0 && n2 == 0) val += hbias[c];
                    FILT[(size_t)n2 * 4096 + o] = val;
                } }
        }
        __syncthreads();
    }
}

__device__ __forceinline__ void phase_fg_transpose(const Ctx& C) {
    const int tid = C.tid;
    LAS float* tl = (LAS float*)C.lds;
    for (int it = C.bid; it < 1280; it += C.G) {
        const bool smp = it < 1024; const int q = smp ? it : it - 1024;
        const int L = smp ? 1024 : 256, ROW = smp ? FGS_ROW : FGP_ROW;
        const int cbk = q & 31, nb = smp ? (q >> 5) & 15 : (q >> 5) & 3, dir = smp ? q >> 9 : q >> 7;
        const float* FILT = WSP(float, WS_ARENA + AR_FILT) + (smp ? 0 : (size_t)1024 * 4096);
        bf16_t* FG = WSP(bf16_t, smp ? WS_FGS : WS_FGP);
        const int n0 = nb * 64 + dir;
        __syncthreads();
        { const int nl = tid >> 3, c8 = tid & 7; const int n = n0 + nl;
          f32x4 a = (f32x4){0.f, 0.f, 0.f, 0.f}, b = a;
          const int nc = n < L ? n : L - 1;
          const float* src = FILT + (size_t)nc * 4096 + dir * 2048 + cbk * 64 + 8 * c8;
          a = *(const f32x4*)src; b = *(const f32x4*)(src + 4);
          if (n >= L) { a = (f32x4){0.f, 0.f, 0.f, 0.f}; b = a; }
          LAS float* d = tl + nl * 65 + 8 * c8;
          d[0] = a.x; d[1] = a.y; d[2] = a.z; d[3] = a.w; d[4] = b.x; d[5] = b.y; d[6] = b.z; d[7] = b.w; }
        __syncthreads();
        { const int cl = tid >> 3, i8 = tid & 7;
          float v[8];
#pragma unroll
          for (int j = 0; j < 8; ++j) { const int il = 8 * i8 + j; const int nl = dir ? il : 63 - il; v[j] = tl[nl * 65 + cl]; }
          const int idx0 = dir ? (L + nb * 64) : (L - 64 - nb * 64);
          u32x4 o; o.x = cvt_pk(v[0], v[1]); o.y = cvt_pk(v[2], v[3]); o.z = cvt_pk(v[4], v[5]); o.w = cvt_pk(v[6], v[7]);
          bf16_t* dst = FG + (size_t)(cbk * 64 + cl) * ROW;
          *(u32x4*)(dst + idx0 + 8 * i8) = o;
          if (dir && nb * 64 + 64 == L) *(u32x4*)(dst + 2 * L + 8 * i8) = (u32x4){0u, 0u, 0u, 0u}; }
    }
    __syncthreads();
}

__device__ __forceinline__ void phase_norm_mod(const Ctx& C, const float* Xp, const float* Xs, const float* g, int layer, int which_sh, bf16_t* H, const bf16_t* P1 = nullptr, float* Xw = nullptr) {
    const int gw = C.bid * 8 + C.wave, NGW = C.G * 8, lane = C.lane;
    for (int m = gw; m < MT; m += NGW) {
        const int cond = cond_of_row(m);
        const float* sh = MODP(layer, cond, which_sh); const float* sc = MODP(layer, cond, which_sh + 1);
        const f32x4* xr = (const f32x4*)(m < MP ? Xp + (size_t)m * D : Xs + (size_t)(m - MP) * D) + lane;
        f32x4 v[8]; float ss = 0.f;
#pragma unroll
        for (int j = 0; j < 8; ++j) { v[j] = xr[64 * j]; if (P1) { const u32x2 pw = ((const u32x2*)(P1 + (size_t)m * D) + lane)[64 * j]; v[j] += (f32x4){bflo(pw.x), bfhi(pw.x), bflo(pw.y), bfhi(pw.y)}; ((f32x4*)(Xw + (size_t)m * D) + lane)[64 * j] = v[j]; }
            ss += (v[j].x * v[j].x + v[j].y * v[j].y) + (v[j].z * v[j].z + v[j].w * v[j].w); }
        const float rstd = __builtin_amdgcn_rsqf(wave_sum(ss) * (1.0f / D) + 1e-6f);
        u32x2* o = (u32x2*)(H + (size_t)m * D) + lane;
#pragma unroll
        for (int j = 0; j < 8; ++j) {
            const f32x4 gv = ((const f32x4*)g)[lane + 64 * j], sv = ((const f32x4*)sh)[lane + 64 * j], cv = ((const f32x4*)sc)[lane + 64 * j];
            const f32x4 y = (v[j] * rstd * gv) * (cv + 1.0f) + sv;
            u32x2 w; w.x = cvt_pk(y.x, y.y); w.y = cvt_pk(y.z, y.w); o[64 * j] = w;
        }
    }
}
__device__ __forceinline__ void phase_norm_final(const Ctx& C, const float* X, const float* g, float* out, const bf16_t* P1 = nullptr) {
    const int gw = C.bid * 8 + C.wave, NGW = C.G * 8, lane = C.lane;
    for (int m = gw; m < MT; m += NGW) {
        const f32x4* xr = (const f32x4*)(X + (size_t)m * D) + lane;
        f32x4 v[8]; float ss = 0.f;
#pragma unroll
        for (int j = 0; j < 8; ++j) { v[j] = xr[64 * j]; if (P1) { const u32x2 pw = ((const u32x2*)(P1 + (size_t)m * D) + lane)[64 * j]; v[j] += (f32x4){bflo(pw.x), bfhi(pw.x), bflo(pw.y), bfhi(pw.y)}; } ss += (v[j].x * v[j].x + v[j].y * v[j].y) + (v[j].z * v[j].z + v[j].w * v[j].w); }
        const float rstd = __builtin_amdgcn_rsqf(wave_sum(ss) * (1.0f / D) + 1e-6f);
        f32x4* o = (f32x4*)(out + (size_t)m * D) + lane;
#pragma unroll
        for (int j = 0; j < 8; ++j) o[64 * j] = v[j] * rstd * ((const f32x4*)g)[lane + 64 * j];
    }
}

__device__ __forceinline__ void unpack8(const u32x4 w, float (&f)[8]) { f[0] = bflo(w.x); f[1] = bfhi(w.x); f[2] = bflo(w.y); f[3] = bfhi(w.y); f[4] = bflo(w.z); f[5] = bfhi(w.z); f[6] = bflo(w.w); f[7] = bfhi(w.w); }
__device__ __forceinline__ u32x4 pack8(const float (&f)[8]) { u32x4 o; o.x = cvt_pk(f[0], f[1]); o.y = cvt_pk(f[2], f[3]); o.z = cvt_pk(f[4], f[5]); o.w = cvt_pk(f[6], f[7]); return o; }
__device__ __forceinline__ void phase_norm_mod_b(const Ctx& C, const bf16_t* X, const float* g, int layer, int which_sh, bf16_t* H, const bf16_t* P1 = nullptr, bf16_t* Xw = nullptr, int p1_row0 = 0) {
    const int gw = C.bid * 8 + C.wave, NGW = C.G * 8, lane = C.lane;
    f32x4 gv[4][2];
#pragma unroll
    for (int j = 0; j < 4; ++j)
#pragma unroll
        for (int h = 0; h < 2; ++h) gv[j][h] = ((const f32x4*)g)[2 * (lane + 64 * j) + h];
    u32x4 xa[4], pa[4]; f32x4 sv[4][2], cv[4][2];
#define NM_LOAD(m_) do { const int cond_ = cond_of_row(m_); const f32x4* sh_ = (const f32x4*)MODP(layer, cond_, which_sh); const f32x4* sc_ = (const f32x4*)MODP(layer, cond_, which_sh + 1); \
        _Pragma("unroll") for (int j = 0; j < 4; ++j) { xa[j] = ((const u32x4*)(X + (size_t)(m_) * D) + lane)[64 * j]; if (P1 && (m_) >= p1_row0) pa[j] = ((const u32x4*)(P1 + (size_t)(m_) * D) + lane)[64 * j]; } \
        _Pragma("unroll") for (int j = 0; j < 4; ++j) { _Pragma("unroll") for (int h = 0; h < 2; ++h) { const int ci_ = 2 * (lane + 64 * j) + h; sv[j][h] = sh_[ci_]; cv[j][h] = sc_[ci_]; } } } while (0)
    int m = gw;
    if (m < MT) NM_LOAD(m);
    for (; m < MT; m += NGW) {
        const bool fold = P1 && m >= p1_row0;
        float v[4][8]; float ss = 0.f;
#pragma unroll
        for (int j = 0; j < 4; ++j) {
            unpack8(xa[j], v[j]);
            if (fold) { float p[8]; unpack8(pa[j], p);
#pragma unroll
                for (int e = 0; e < 8; ++e) v[j][e] += p[e]; }
#pragma unroll
            for (int e = 0; e < 8; ++e) ss += v[j][e] * v[j][e];
        }
        const float rstd = __builtin_amdgcn_rsqf(wave_sum(ss) * (1.0f / D) + 1e-6f);
        u32x4 xo[4], ho[4];
#pragma unroll
        for (int j = 0; j < 4; ++j) {
            if (fold) xo[j] = pack8(v[j]);
            float y[8];
#pragma unroll
            for (int h = 0; h < 2; ++h)
#pragma unroll
                for (int e = 0; e < 4; ++e) y[4 * h + e] = (v[j][4 * h + e] * rstd * gv[j][h][e]) * (cv[j][h][e] + 1.0f) + sv[j][h][e];
            ho[j] = pack8(y);
        }
        const int mn = m + NGW;
        if (mn < MT) NM_LOAD(mn);
        asm volatile("" ::: "memory");
#pragma unroll
        for (int j = 0; j < 4; ++j) { if (fold) ((u32x4*)(Xw + (size_t)m * D) + lane)[64 * j] = xo[j]; ((u32x4*)(H + (size_t)m * D) + lane)[64 * j] = ho[j]; }
    }
#undef NM_LOAD
}
__device__ __forceinline__ void phase_norm_final_b(const Ctx& C, const bf16_t* X, const float* g, float* out, const bf16_t* P1 = nullptr, int p1_row0 = 0) {
    const int gw = C.bid * 8 + C.wave, NGW = C.G * 8, lane = C.lane;
    for (int m = gw; m < MT; m += NGW) {
        const u32x4* xr = (const u32x4*)(X + (size_t)m * D) + lane;
        float v[4][8]; float ss = 0.f;
#pragma unroll
        for (int j = 0; j < 4; ++j) {
            unpack8(xr[64 * j], v[j]);
            if (P1 && m >= p1_row0) { float p[8]; unpack8(((const u32x4*)(P1 + (size_t)m * D) + lane)[64 * j], p);
#pragma unroll
                for (int e = 0; e < 8; ++e) v[j][e] += p[e]; }
#pragma unroll
            for (int e = 0; e < 8; ++e) ss += v[j][e] * v[j][e];
        }
        const float rstd = __builtin_amdgcn_rsqf(wave_sum(ss) * (1.0f / D) + 1e-6f);
        f32x4* o = (f32x4*)(out + (size_t)m * D);
#pragma unroll
        for (int j = 0; j < 4; ++j)
#pragma unroll
            for (int h = 0; h < 2; ++h) {
                const int ci = 2 * (lane + 64 * j) + h;
                const f32x4 gv = ((const f32x4*)g)[ci];
                f32x4 y;
#pragma unroll
                for (int e = 0; e < 4; ++e) y[e] = v[j][4 * h + e] * rstd * gv[e];
                o[ci] = y;
            }
    }
}

using pg8::Unit;
constexpr int HALF = 128;

struct EpiResidual {
    static constexpr bool PERM = false, AFTER_DRAIN = false;
    float* X; const float* gate_base;
    const float *Bp, *Bs;
    __device__ __forceinline__ void operator()(const f32x4 (&acc)[2][2][4][2], const Unit& u, int wr, int wc, int fr, int fq) const {
        const int row0 = u.pm * 256 + wr * 64 + fr, col0 = u.pn * 256 + wc * 32 + 4 * fq;
        const float* gp = gate_base + (size_t)cond_of_panel(u.pm) * 6 * D + col0;
        f32x4 gv[2][2];
#pragma unroll
        for (int bj = 0; bj < 2; ++bj)
#pragma unroll
            for (int n = 0; n < 2; ++n) gv[bj][n] = *(const f32x4*)(gp + bj * HALF + n * 16);
        const float* sbase = (u.pm < 16 ? Bp + (size_t)row0 * D : Bs + (size_t)(row0 - MP) * D) + col0;
#pragma unroll
        for (int ai = 0; ai < 2; ++ai) {
            f32x4 q[4][2][2];
#pragma unroll
            for (int m = 0; m < 4; ++m)
#pragma unroll
                for (int bj = 0; bj < 2; ++bj)
#pragma unroll
                    for (int n = 0; n < 2; ++n) if ((u.mask >> (ai * 2 + bj)) & 1) q[m][bj][n] = *(const f32x4*)(sbase + (size_t)(ai * HALF + m * 16) * D + bj * HALF + n * 16);
#pragma unroll
            for (int m = 0; m < 4; ++m) { float* rowp = X + (size_t)(row0 + ai * HALF + m * 16) * D + col0;
#pragma unroll
                for (int bj = 0; bj < 2; ++bj)
#pragma unroll
                    for (int n = 0; n < 2; ++n) if ((u.mask >> (ai * 2 + bj)) & 1) *(f32x4*)(rowp + bj * HALF + n * 16) = q[m][bj][n] + gv[bj][n] * acc[ai][bj][m][n]; }
            asm volatile("" ::: "memory");
        }
    }
};
template <int ACT> struct EpiBf16 {
    static constexpr bool PERM = true, AFTER_DRAIN = false;
    bf16_t* O; int ldc;
    __device__ __forceinline__ void operator()(const f32x4 (&acc)[2][2][4][2], const Unit& u, int wr, int wc, int fr, int fq) const {
        const int row0 = u.pm * 256 + wr * 64 + fr, col0 = u.pn * 256 + wc * 32 + 8 * fq;
#pragma unroll
        for (int ai = 0; ai < 2; ++ai)
#pragma unroll
            for (int m = 0; m < 4; ++m) { bf16_t* rowp = O + (size_t)(row0 + ai * HALF + m * 16) * ldc + col0;
#pragma unroll
                for (int bj = 0; bj < 2; ++bj) { if (!((u.mask >> (ai * 2 + bj)) & 1)) continue; f32x4 v0 = acc[ai][bj][m][0], v1 = acc[ai][bj][m][1];
                    if (ACT == 1) {
#pragma unroll
                        for (int j = 0; j < 4; ++j) { const float a = fmaxf(v0[j], 0.f), b = fmaxf(v1[j], 0.f); v0[j] = a * a; v1[j] = b * b; } }
                    u32x4 w; w.x = cvt_pk(v0[0], v0[1]); w.y = cvt_pk(v0[2], v0[3]); w.z = cvt_pk(v1[0], v1[1]); w.w = cvt_pk(v1[2], v1[3]);
                    *(u32x4*)(rowp + bj * HALF) = w; } }
    }
};
struct EpiQKV {
    static constexpr bool PERM = true, AFTER_DRAIN = false;
    bf16_t *Q, *K, *V; float *NK, *NV;
    __device__ __forceinline__ void operator()(const f32x4 (&acc)[2][2][4][2], const Unit& u, int wr, int wc, int fr, int fq) const {
        const int row0 = u.pm * 256 + wr * 64 + fr; const int cin = wc * 32 + 8 * fq;
        bf16_t* base; int ldc, colt; float* fo = nullptr;
        if (u.pn < 8) { base = Q; ldc = 2048; colt = u.pn * 256; }
        else if (u.pn < 10) { base = K; ldc = 512; colt = (u.pn - 8) * 256; if (u.pm < 16) fo = NK; }
        else { base = V; ldc = 512; colt = (u.pn - 10) * 256; if (u.pm < 16) fo = NV; }
#pragma unroll
        for (int ai = 0; ai < 2; ++ai)
#pragma unroll
            for (int m = 0; m < 4; ++m) { const int r = row0 + ai * HALF + m * 16; bf16_t* rowp = base + (size_t)r * ldc + colt + cin;
#pragma unroll
                for (int bj = 0; bj < 2; ++bj) { if (!((u.mask >> (ai * 2 + bj)) & 1)) continue; const f32x4 v0 = acc[ai][bj][m][0], v1 = acc[ai][bj][m][1];
                    u32x4 w; w.x = cvt_pk(v0[0], v0[1]); w.y = cvt_pk(v0[2], v0[3]); w.z = cvt_pk(v1[0], v1[1]); w.w = cvt_pk(v1[2], v1[3]);
                    *(u32x4*)(rowp + bj * HALF) = w;
                    if (fo) { float* fp = fo + ((size_t)(r >> 8) * 512 + (r & 255)) * 512 + colt + cin + bj * HALF; *(f32x4*)fp = v0; *(f32x4*)(fp + 4) = v1; } } }
    }
};
__device__ __forceinline__ size_t hm_index(int m, int c) { return ((size_t)(c >> 6) * MT + m) * 64 + (c & 63); }
struct EpiRw1 {
    static constexpr bool PERM = true, AFTER_DRAIN = false;
    bf16_t *R, *A3;
    const float* k_k; float* invsq;
    __device__ __forceinline__ void operator()(const f32x4 (&acc)[2][2][4][2], const Unit& u, int wr, int wc, int fr, int fq) const {
        const int ct = u.pn, panel = u.pm % NPANEL;
        const int row0 = panel * 256 + wr * 64 + fr; const int cin = wc * 32 + 8 * fq;
        bf16_t* base; int ldc, colt, act = 0;
        if (ct < 24) { base = R + (size_t)(ct >> 3) * MT * D; ldc = D; colt = (ct & 7) * 256; }
        else { base = A3 + (size_t)(ct - 24) * MT * 256; ldc = 256; colt = 0; act = ct - 23; }
#pragma unroll
        for (int ai = 0; ai < 2; ++ai)
#pragma unroll
            for (int m = 0; m < 4; ++m) { const int rrow = row0 + ai * HALF + m * 16; bf16_t* rowp = base + (size_t)rrow * ldc + colt + cin;
#pragma unroll
                for (int bj = 0; bj < 2; ++bj) { if (!((u.mask >> (ai * 2 + bj)) & 1)) continue; f32x4 v0 = acc[ai][bj][m][0], v1 = acc[ai][bj][m][1];
                    if (act == 1) {
#pragma unroll
                        for (int j = 0; j < 4; ++j) { v0[j] = ftanh(v0[j]); v1[j] = ftanh(v1[j]); } }
                    else if (act == 3) {
#pragma unroll
                        for (int j = 0; j < 4; ++j) { v0[j] = fsigmoid(v0[j]); v1[j] = fsigmoid(v1[j]); } }
                    u32x4 w; w.x = cvt_pk(v0[0], v0[1]); w.y = cvt_pk(v0[2], v0[3]); w.z = cvt_pk(v1[0], v1[1]); w.w = cvt_pk(v1[2], v1[3]);
                    if (ct < 24) *(u32x4*)(base + hm_index(rrow, colt + cin + bj * HALF)) = w; else *(u32x4*)(rowp + bj * HALF) = w;
} }
    }
};
struct EpiRw2 {
    static constexpr bool PERM = true, AFTER_DRAIN = false;
    bf16_t *LD, *LA, *Gt; const float *w0, *a0;
    __device__ __forceinline__ void operator()(const f32x4 (&acc)[2][2][4][2], const Unit& u, int wr, int wc, int fr, int fq) const {
        const int ct = u.pn, panel = u.pm % NPANEL, grp = ct >> 3;
        const int row0 = panel * 256 + wr * 64 + fr; const int col0 = (ct & 7) * 256 + wc * 32 + 8 * fq;
        bf16_t* base; const float* bias = nullptr;
        if (grp < 2) { base = LD + (size_t)grp * MT * D; bias = w0 + grp * D; }
        else if (grp < 4) { base = LA + (size_t)(grp - 2) * MT * D; bias = a0 + (grp - 2) * D; }
        else base = Gt;
        f32x4 bv[2][2];
#pragma unroll
        for (int bj = 0; bj < 2; ++bj)
#pragma unroll
            for (int n = 0; n < 2; ++n) bv[bj][n] = bias ? *(const f32x4*)(bias + col0 + bj * HALF + 4 * n) : (f32x4){0.f, 0.f, 0.f, 0.f};
#pragma unroll
        for (int ai = 0; ai < 2; ++ai)
#pragma unroll
            for (int m = 0; m < 4; ++m) { const int rrow = row0 + ai * HALF + m * 16; bf16_t* rowp = base + (size_t)rrow * D + col0;
#pragma unroll
                for (int bj = 0; bj < 2; ++bj) {
                    f32x4 v0 = acc[ai][bj][m][0] + bv[bj][0], v1 = acc[ai][bj][m][1] + bv[bj][1];
                    if (grp < 2) {
#pragma unroll
                        for (int j = 0; j < 4; ++j) { v0[j] = -fexp(-fsoftplus(-v0[j]) - 0.5f); v1[j] = -fexp(-fsoftplus(-v1[j]) - 0.5f); } }
                    u32x4 w; w.x = cvt_pk(v0[0], v0[1]); w.y = cvt_pk(v0[2], v0[3]); w.z = cvt_pk(v1[0], v1[1]); w.w = cvt_pk(v1[2], v1[3]);
                    if (grp < 4) *(u32x4*)(base + hm_index(rrow, col0 + bj * HALF)) = w; else *(u32x4*)(rowp + bj * HALF) = w; }
                asm volatile("" : "+v"(bv[0][0]), "+v"(bv[0][1]), "+v"(bv[1][0]), "+v"(bv[1][1]));
            }
    }
};
struct RwOrder1 {
    int G, c;
    __device__ __forceinline__ bool next(int i, Unit& u) const { const int L = i * G + c; if (L >= 27 * NPANEL) return false; u.mask = 15; const int panel = L / 27, ct = L % 27; const int ai = ct < 24 ? (ct >> 3) : ct - 21; u.pm = ai * NPANEL + panel; u.pn = ct; u.kh = 0; return true; }
    __device__ __forceinline__ void a_ready(const Unit&) const {}
    __device__ __forceinline__ void done(const Unit&) const {}
};
struct RwOrder2 {
    int G, c;
    __device__ __forceinline__ bool next(int i, Unit& u) const { const int L = i * G + c; if (L >= 40 * NPANEL) return false; const int panel = L / 40, ct = L % 40; const int ai = ct < 16 ? 0 : (ct < 32 ? 1 : 2); u.pm = ai * NPANEL + panel; u.pn = ct; u.kh = 0; u.mask = 15; return true; }
    __device__ __forceinline__ void a_ready(const Unit&) const {}
    __device__ __forceinline__ void done(const Unit&) const {}
};

struct SplitOrder {
    pg8::StaticOrder so; int G, c, ntiles;
    __device__ __forceinline__ void init(int N, int G_, int c_) { so.init(MT, N, G_, c_); G = G_; c = c_; ntiles = so.nwg; }
    __device__ __forceinline__ bool next(int i, Unit& u) const { const int L = i * G + c; if (L >= 2 * ntiles) return false; const int kh = L >= ntiles; so.map(kh ? L - ntiles : L, u); u.kh = kh; u.mask = 15; return true; }
    __device__ __forceinline__ void a_ready(const Unit&) const {}
    __device__ __forceinline__ void done(const Unit&) const {}
};
struct EpiResidualSplit {
    static constexpr bool PERM = false, AFTER_DRAIN = false;
    float* X; const float* gate_base; bf16_t* P1;
    __device__ __forceinline__ void operator()(const f32x4 (&acc)[2][2][4][2], const Unit& u, int wr, int wc, int fr, int fq) const {
        const int row0 = u.pm * 256 + wr * 64 + fr, col0 = u.pn * 256 + wc * 32 + 4 * fq;
        const float* gp = gate_base + (size_t)cond_of_panel(u.pm) * 6 * D + col0;
        f32x4 gv[2][2];
#pragma unroll
        for (int bj = 0; bj < 2; ++bj)
#pragma unroll
            for (int n = 0; n < 2; ++n) gv[bj][n] = *(const f32x4*)(gp + bj * HALF + n * 16);
        if (u.kh == 0) {
#pragma unroll
            for (int ai = 0; ai < 2; ++ai) {
                f32x4 q[4][2][2];
#pragma unroll
                for (int m = 0; m < 4; ++m)
#pragma unroll
                    for (int bj = 0; bj < 2; ++bj)
#pragma unroll
                        for (int n = 0; n < 2; ++n) q[m][bj][n] = *(const f32x4*)(X + (size_t)(row0 + ai * HALF + m * 16) * D + col0 + bj * HALF + n * 16);
#pragma unroll
                for (int m = 0; m < 4; ++m) { float* rowp = X + (size_t)(row0 + ai * HALF + m * 16) * D + col0;
#pragma unroll
                    for (int bj = 0; bj < 2; ++bj)
#pragma unroll
                        for (int n = 0; n < 2; ++n) *(f32x4*)(rowp + bj * HALF + n * 16) = q[m][bj][n] + gv[bj][n] * acc[ai][bj][m][n]; }
                asm volatile("" ::: "memory");
            }
        } else {
#pragma unroll
            for (int ai = 0; ai < 2; ++ai)
#pragma unroll
                for (int m = 0; m < 4; ++m) { bf16_t* rowp = P1 + (size_t)(row0 + ai * HALF + m * 16) * D + col0;
#pragma unroll
                    for (int bj = 0; bj < 2; ++bj)
#pragma unroll
                        for (int n = 0; n < 2; ++n) { const f32x4 v = gv[bj][n] * acc[ai][bj][m][n]; u32x2 w; w.x = cvt_pk(v.x, v.y); w.y = cvt_pk(v.z, v.w); *(u32x2*)(rowp + bj * HALF + n * 16) = w; } }
        }
    }
};

template <bool SRCF32> struct EpiResidualB {
    static constexpr bool PERM = true, AFTER_DRAIN = false;
    bf16_t* X; const float* gate_base; const float *Bp, *Bs;
    __device__ __forceinline__ void operator()(const f32x4 (&acc)[2][2][4][2], const Unit& u, int wr, int wc, int fr, int fq) const {
        const int row0 = u.pm * 256 + wr * 64 + fr, col0 = u.pn * 256 + wc * 32 + 8 * fq;
        const float* gp = gate_base + (size_t)cond_of_panel(u.pm) * 6 * D + col0;
        f32x4 gv[2][2];
#pragma unroll
        for (int bj = 0; bj < 2; ++bj)
#pragma unroll
            for (int n = 0; n < 2; ++n) gv[bj][n] = *(const f32x4*)(gp + bj * HALF + 4 * n);
#pragma unroll
        for (int ai = 0; ai < 2; ++ai) {
            if constexpr (SRCF32) {
                const float* sbase = (u.pm < 16 ? Bp + (size_t)row0 * D : Bs + (size_t)(row0 - MP) * D) + col0;
                f32x4 q[4][2][2];
#pragma unroll
                for (int m = 0; m < 4; ++m)
#pragma unroll
                    for (int bj = 0; bj < 2; ++bj)
#pragma unroll
                        for (int n = 0; n < 2; ++n) q[m][bj][n] = *(const f32x4*)(sbase + (size_t)(ai * HALF + m * 16) * D + bj * HALF + 4 * n);
#pragma unroll
                for (int m = 0; m < 4; ++m) { bf16_t* rowp = X + (size_t)(row0 + ai * HALF + m * 16) * D + col0;
#pragma unroll
                    for (int bj = 0; bj < 2; ++bj) { const f32x4 v0 = q[m][bj][0] + gv[bj][0] * acc[ai][bj][m][0], v1 = q[m][bj][1] + gv[bj][1] * acc[ai][bj][m][1];
                        u32x4 w; w.x = cvt_pk(v0.x, v0.y); w.y = cvt_pk(v0.z, v0.w); w.z = cvt_pk(v1.x, v1.y); w.w = cvt_pk(v1.z, v1.w); *(u32x4*)(rowp + bj * HALF) = w; } }
            } else {
                u32x4 q[4][2];
#pragma unroll
                for (int m = 0; m < 4; ++m)
#pragma unroll
                    for (int bj = 0; bj < 2; ++bj) q[m][bj] = *(const u32x4*)(X + (size_t)(row0 + ai * HALF + m * 16) * D + col0 + bj * HALF);
#pragma unroll
                for (int m = 0; m < 4; ++m) { bf16_t* rowp = X + (size_t)(row0 + ai * HALF + m * 16) * D + col0;
#pragma unroll
                    for (int bj = 0; bj < 2; ++bj) { const u32x4 o = q[m][bj];
                        const f32x4 v0 = (f32x4){bflo(o.x), bfhi(o.x), bflo(o.y), bfhi(o.y)} + gv[bj][0] * acc[ai][bj][m][0], v1 = (f32x4){bflo(o.z), bfhi(o.z), bflo(o.w), bfhi(o.w)} + gv[bj][1] * acc[ai][bj][m][1];
                        u32x4 w; w.x = cvt_pk(v0.x, v0.y); w.y = cvt_pk(v0.z, v0.w); w.z = cvt_pk(v1.x, v1.y); w.w = cvt_pk(v1.z, v1.w); *(u32x4*)(rowp + bj * HALF) = w; } }
            }
            asm volatile("" ::: "memory");
        }
    }
};
struct EpiResidualSplitB {
    static constexpr bool PERM = true, AFTER_DRAIN = false;
    bf16_t* X; const float* gate_base; bf16_t* P1;
    __device__ __forceinline__ void operator()(const f32x4 (&acc)[2][2][4][2], const Unit& u, int wr, int wc, int fr, int fq) const {
        const int row0 = u.pm * 256 + wr * 64 + fr, col0 = u.pn * 256 + wc * 32 + 8 * fq;
        const float* gp = gate_base + (size_t)cond_of_panel(u.pm) * 6 * D + col0;
        f32x4 gv[2][2];
#pragma unroll
        for (int bj = 0; bj < 2; ++bj)
#pragma unroll
            for (int n = 0; n < 2; ++n) gv[bj][n] = *(const f32x4*)(gp + bj * HALF + 4 * n);
        if (u.kh == 0) {
#pragma unroll
            for (int ai = 0; ai < 2; ++ai) {
                u32x4 q[4][2];
#pragma unroll
                for (int m = 0; m < 4; ++m)
#pragma unroll
                    for (int bj = 0; bj < 2; ++bj) q[m][bj] = *(const u32x4*)(X + (size_t)(row0 + ai * HALF + m * 16) * D + col0 + bj * HALF);
#pragma unroll
                for (int m = 0; m < 4; ++m) { bf16_t* rowp = X + (size_t)(row0 + ai * HALF + m * 16) * D + col0;
#pragma unroll
                    for (int bj = 0; bj < 2; ++bj) { const u32x4 o = q[m][bj];
                        const f32x4 v0 = (f32x4){bflo(o.x), bfhi(o.x), bflo(o.y), bfhi(o.y)} + gv[bj][0] * acc[ai][bj][m][0], v1 = (f32x4){bflo(o.z), bfhi(o.z), bflo(o.w), bfhi(o.w)} + gv[bj][1] * acc[ai][bj][m][1];
                        u32x4 w; w.x = cvt_pk(v0.x, v0.y); w.y = cvt_pk(v0.z, v0.w); w.z = cvt_pk(v1.x, v1.y); w.w = cvt_pk(v1.z, v1.w); *(u32x4*)(rowp + bj * HALF) = w; } }
                asm volatile("" ::: "memory");
            }
        } else {
#pragma unroll
            for (int ai = 0; ai < 2; ++ai)
#pragma unroll
                for (int m = 0; m < 4; ++m) { bf16_t* rowp = P1 + (size_t)(row0 + ai * HALF + m * 16) * D + col0;
#pragma unroll
                    for (int bj = 0; bj < 2; ++bj) { const f32x4 v0 = gv[bj][0] * acc[ai][bj][m][0], v1 = gv[bj][1] * acc[ai][bj][m][1];
                        u32x4 w; w.x = cvt_pk(v0.x, v0.y); w.y = cvt_pk(v0.z, v0.w); w.z = cvt_pk(v1.x, v1.y); w.w = cvt_pk(v1.z, v1.w); *(u32x4*)(rowp + bj * HALF) = w; } }
        }
    }
};
struct TailSplitOrder {
    pg8::StaticOrder sf, st; int G, c, ntf;
    __device__ __forceinline__ void init(int G_, int c_, int ntf_ = 32) { sf.init(8192, D, G_, c_); st.init(4096, D, G_, c_); G = G_; c = c_; ntf = ntf_; }
    __device__ __forceinline__ bool next(int i, Unit& u) const {
        const int L = i * G + c; if (L >= 512) return false;
        if (L < 256) { sf.map(L, u); u.kh = 0; u.nt = ntf; }
        else { const int h = L - 256, kh = h >= 128; st.map(kh ? h - 128 : h, u); u.pm += 32; u.kh = kh; u.nt = ntf >> 1; }
        u.mask = 15; return true; }
    __device__ __forceinline__ void a_ready(const Unit&) const {}
    __device__ __forceinline__ void done(const Unit&) const {}
};


typedef short s16x4 __attribute__((ext_vector_type(4)));
constexpr int KS_STRIDE = 136;
constexpr int VT_STRIDE = 72;
constexpr int ATT_KS_OFF = 0, ATT_VT_OFF = 64 * KS_STRIDE * 2, ATT_BUF_BYTES = 36864;

__device__ __forceinline__ void rope8(u32x4& a, u32x4& b, const f32x2* tab) {
    unsigned* pa = (unsigned*)&a; unsigned* pb = (unsigned*)&b;
#pragma unroll
    for (int w = 0; w < 4; ++w) {
        const f32x4 cs = *(const f32x4*)(tab + 2 * w);
        const float x1l = bflo(pa[w]), x1h = bfhi(pa[w]), x2l = bflo(pb[w]), x2h = bfhi(pb[w]);
        const float o1l = x1l * cs.x - x2l * cs.y, o2l = x1l * cs.y + x2l * cs.x;
        const float o1h = x1h * cs.z - x2h * cs.w, o2h = x1h * cs.w + x2h * cs.z;
        pa[w] = cvt_pk(o1l, o1h); pb[w] = cvt_pk(o2l, o2h);
    }
}

__device__ __forceinline__ void phase_attention(const Ctx& C, const bf16_t* Q, const bf16_t* Kb, const bf16_t* Vb, const bf16_t* KC, const bf16_t* VC, const float* sink, bf16_t* O) {
    const int tid = C.tid, lane = C.lane, w = C.wave, h = lane >> 5, lq = lane & 31;
    LAS bf16_t* Ks = (LAS bf16_t*)(C.lds + ATT_KS_OFF);
    LAS bf16_t* Vt = (LAS bf16_t*)(C.lds + ATT_VT_OFF);
    const f32x2* rope = WSP(f32x2, WS_ROPE);
    const float c2 = 0.08838834764831845f * 1.4426950408889634f;
    for (int it = C.bid; it < 768; it += C.G) {
        const bool smp = it < 512;
        int bb, kvh, qb, R0;
        if (smp) { bb = it >> 6; kvh = (it >> 4) & 3; qb = it & 15; R0 = MP + bb * 1024; }
        else { const int p = it - 512; bb = p >> 4; kvh = (p >> 2) & 3; qb = p & 3; R0 = bb * 256; }
        const int head = kvh * 4 + (w >> 1);
        const int t = qb * 64 + (w & 1) * 32 + lq;
        u32x4 qf[8];
        { const bf16_t* qp = Q + (size_t)(R0 + t) * D + head * 128 + 8 * h;
#pragma unroll
          for (int ks = 0; ks < 8; ++ks) qf[ks] = *(const u32x4*)(qp + 16 * ks); }
        if (smp) {
#pragma unroll
            for (int half = 0; half < 2; ++half) { const int pos = half ? (t & 63) : (t >> 6);
#pragma unroll
                for (int kk = 0; kk < 2; ++kk) rope8(qf[4 * half + kk], qf[4 * half + kk + 2], rope + pos * 32 + 16 * kk + 8 * h); }
        }
        f32x16 o[4];
#pragma unroll
        for (int db = 0; db < 4; ++db)
#pragma unroll
            for (int r = 0; r < 16; ++r) o[db][r] = 0.f;
        float mrun = -1e30f, lrun = 0.f;
        const int li0 = smp ? (qb >= 2 ? 0 : 2 - qb) : 0, li1 = smp ? (17 - qb < 4 ? 17 - qb : 4) : 0;
        const int ntot = smp ? 8 + (li1 - li0 + 1) : 4;
        const int key = tid >> 3, cc = tid & 7, c1 = (cc & 3) + (cc >> 2) * 8;
#define ATT_TILE(i, kp_, vp_, k0_, loc_) do { if (smp) { if ((i) < 8) { const size_t off_ = ((size_t)(bb * 2) * 512 + (i) * 64) * 512 + kvh * 128; kp_ = KC + off_; vp_ = VC + off_; k0_ = 0; loc_ = false; } \
            else { k0_ = qb * 64 - 128 + 64 * ((i) - 8 + li0); loc_ = true; const size_t off_ = (size_t)(R0 + k0_) * 512 + kvh * 128; kp_ = Kb + off_; vp_ = Vb + off_; } } \
          else { k0_ = (i) * 64; loc_ = false; const size_t off_ = (size_t)(R0 + k0_) * 512 + kvh * 128; kp_ = Kb + off_; vp_ = Vb + off_; } } while (0)
        u32x4 ka, kb2, va, vb2;
#define ATT_LOAD(i) do { const bf16_t *kp_, *vp_; int k0_; bool loc_; ATT_TILE(i, kp_, vp_, k0_, loc_); (void)k0_; (void)loc_; \
          ka = *(const u32x4*)(kp_ + (size_t)key * 512 + 8 * c1); kb2 = *(const u32x4*)(kp_ + (size_t)key * 512 + 8 * c1 + 32); \
          va = *(const u32x4*)(vp_ + (size_t)key * 512 + 8 * c1); vb2 = *(const u32x4*)(vp_ + (size_t)key * 512 + 8 * c1 + 32); } while (0)
#define ATT_STAGE(i, KsB, VtB) do { const bf16_t *kp_, *vp_; int k0_; bool loc_; ATT_TILE(i, kp_, vp_, k0_, loc_); (void)kp_; (void)vp_; \
          if (loc_) { const int kpos = k0_ + key; const int pos = (cc >> 2) ? (kpos & 63) : (kpos >> 6); rope8(ka, kb2, rope + pos * 32 + 8 * (cc & 3)); } \
          *(LAS u32x4*)((KsB) + key * KS_STRIDE + 8 * c1) = ka; *(LAS u32x4*)((KsB) + key * KS_STRIDE + 8 * c1 + 32) = kb2; \
          *(LAS u32x4*)((VtB) + key * KS_STRIDE + 8 * c1) = va; *(LAS u32x4*)((VtB) + key * KS_STRIDE + 8 * c1 + 32) = vb2; } while (0)
        ATT_LOAD(0); ATT_STAGE(0, Ks, Vt); if (ntot > 1) ATT_LOAD(1);
        __syncthreads();
        for (int ti = 0; ti < ntot; ++ti) {
            const bf16_t *kp, *vp; int k0; bool local; ATT_TILE(ti, kp, vp, k0, local); (void)kp; (void)vp;
            LAS bf16_t* Ks = (LAS bf16_t*)(C.lds + (ti & 1) * ATT_BUF_BYTES + ATT_KS_OFF);
            LAS bf16_t* Vt = (LAS bf16_t*)(C.lds + (ti & 1) * ATT_BUF_BYTES + ATT_VT_OFF);
            f32x16 s0, s1;
            { const float z0 = opaque_zero();
#pragma unroll
            for (int r = 0; r < 16; ++r) { s0[r] = z0; s1[r] = z0; } }
#pragma unroll
            for (int ks = 0; ks < 8; ++ks) {
                const bf16x8 a0 = *(const LAS bf16x8*)(Ks + lq * KS_STRIDE + 16 * ks + 8 * h);
                const bf16x8 a1 = *(const LAS bf16x8*)(Ks + (32 + lq) * KS_STRIDE + 16 * ks + 8 * h);
                const bf16x8 bq = __builtin_bit_cast(bf16x8, qf[ks]);
                s0 = __builtin_amdgcn_mfma_f32_32x32x16_bf16(a0, bq, s0, 0, 0, 0);
                s1 = __builtin_amdgcn_mfma_f32_32x32x16_bf16(a1, bq, s1, 0, 0, 0);
            }
            if (local) {
#pragma unroll
                for (int r = 0; r < 16; ++r) {
                    const int kl = (r & 3) + 8 * (r >> 2) + 4 * h;
                    const int d0 = k0 + kl - t, d1 = d0 + 32;
                    s0[r] = ((d0 <= 128) && (d0 >= -128)) ? s0[r] : -1e30f; s1[r] = ((d1 <= 128) && (d1 >= -128)) ? s1[r] : -1e30f;
                }
            }
            float mx = fmaxf(s0[0], s1[0]);
#pragma unroll
            for (int r = 1; r < 16; ++r) mx = fmaxf(mx, fmaxf(s0[r], s1[r]));
            mx = fmaxf(mx, __shfl_xor(mx, 32));
            const float mnew = fmaxf(mrun, mx * c2);
            const float alpha = fexp2(mrun - mnew);
            float ps = 0.f;
#pragma unroll
            for (int r = 0; r < 16; ++r) {
                const float p0 = fexp2(__builtin_fmaf(s0[r], c2, -mnew)), p1 = fexp2(__builtin_fmaf(s1[r], c2, -mnew));
                s0[r] = p0; s1[r] = p1; ps += p0 + p1;
            }
            lrun = lrun * alpha + ps; mrun = mnew;
            if (__any(alpha != 1.0f)) {
#pragma unroll
                for (int db = 0; db < 4; ++db)
#pragma unroll
                    for (int r = 0; r < 16; ++r) o[db][r] *= alpha;
            }
            u32x4 pf[4];
#pragma unroll
            for (int s = 0; s < 2; ++s) {
                pf[s].x = cvt_pk(s0[8 * s + 0], s0[8 * s + 1]); pf[s].y = cvt_pk(s0[8 * s + 2], s0[8 * s + 3]); pf[s].z = cvt_pk(s0[8 * s + 4], s0[8 * s + 5]); pf[s].w = cvt_pk(s0[8 * s + 6], s0[8 * s + 7]);
                pf[2 + s].x = cvt_pk(s1[8 * s + 0], s1[8 * s + 1]); pf[2 + s].y = cvt_pk(s1[8 * s + 2], s1[8 * s + 3]); pf[2 + s].z = cvt_pk(s1[8 * s + 4], s1[8 * s + 5]); pf[2 + s].w = cvt_pk(s1[8 * s + 6], s1[8 * s + 7]);
            }
#pragma unroll
            for (int db = 0; db < 4; ++db)
#pragma unroll
                for (int s2 = 0; s2 < 4; ++s2) {
                    const LAS bf16_t* vr = Vt + (16 * s2 + 4 * (lane >> 5) + ((lane & 15) >> 2)) * KS_STRIDE + 32 * db + 16 * ((lane >> 4) & 1) + 4 * (lane & 3);
                    const s16x4 lo = __builtin_amdgcn_ds_read_tr16_b64_v4i16((LAS s16x4*)vr), hi = __builtin_amdgcn_ds_read_tr16_b64_v4i16((LAS s16x4*)(vr + 8 * KS_STRIDE));
                    const u32x2 lo2 = __builtin_bit_cast(u32x2, lo), hi2 = __builtin_bit_cast(u32x2, hi);
                    u32x4 av; av.x = lo2.x; av.y = lo2.y; av.z = hi2.x; av.w = hi2.y;
                    o[db] = __builtin_amdgcn_mfma_f32_32x32x16_bf16(__builtin_bit_cast(bf16x8, av), __builtin_bit_cast(bf16x8, pf[s2]), o[db], 0, 0, 0);
                }
            if (ti + 1 < ntot) {
                LAS bf16_t* Ksn = (LAS bf16_t*)(C.lds + ((ti + 1) & 1) * ATT_BUF_BYTES + ATT_KS_OFF);
                LAS bf16_t* Vtn = (LAS bf16_t*)(C.lds + ((ti + 1) & 1) * ATT_BUF_BYTES + ATT_VT_OFF);
                ATT_STAGE(ti + 1, Ksn, Vtn);
                if (ti + 2 < ntot) ATT_LOAD(ti + 2);
            }
            __syncthreads();
        }
        {
            const float sk = sink[head] * 1.4426950408889634f;
            const float mnew = fmaxf(mrun, sk), alpha = fexp2(mrun - mnew);
            float l = lrun * alpha; l += __shfl_xor(l, 32); l += fexp2(sk - mnew);
            const float sc = alpha * frcp(l);
            bf16_t* op = O + (size_t)(R0 + t) * D + head * 128 + 4 * h;
#pragma unroll
            for (int db = 0; db < 4; ++db)
#pragma unroll
                for (int g4 = 0; g4 < 4; ++g4) {
                    u32x2 wv; wv.x = cvt_pk(o[db][4 * g4 + 0] * sc, o[db][4 * g4 + 1] * sc); wv.y = cvt_pk(o[db][4 * g4 + 2] * sc, o[db][4 * g4 + 3] * sc);
                    *(u32x2*)(op + 32 * db + 8 * g4) = wv;
                }
        }
    }
#undef ATT_TILE
#undef ATT_LOAD
#undef ATT_STAGE
    __syncthreads();
}

__device__ __forceinline__ void phase_hy_gate(const Ctx& C, const bf16_t* Pm, const float* cw, const float* cb, bf16_t* X0, bf16_t* ZTp, bf16_t* ZTs) {
    const int tid = C.tid;
    LAS bf16_t* zs = (LAS bf16_t*)C.lds;
    for (int it = C.bid; it < 6144; it += C.G) {
        const bool smp = it >= 2048; const int q = smp ? it - 2048 : it;
        const int cbk = q & 31, tb = smp ? (q >> 5) & 15 : (q >> 5) & 3, b = smp ? q >> 9 : q >> 7;
        const int L = smp ? 1024 : 256, R0 = smp ? MP + b * 1024 : b * 256, NB = smp ? 8 : 16;
        const int tl = tid >> 3, c8 = tid & 7, t = tb * 64 + tl, c0 = cbk * 64 + 8 * c8;
        float u[3][8];
#pragma unroll
        for (int g = 0; g < 3; ++g) {
            const int gc = g * D + c0;
            const bf16_t* pr = Pm + (size_t)(R0 + t) * 6144 + gc;
            u32x4 pm1 = *(const u32x4*)(pr - (t > 0 ? 6144 : 0)), pp1 = *(const u32x4*)(pr + (t < L - 1 ? 6144 : 0)); const u32x4 p0 = *(const u32x4*)pr;
            { const unsigned mk0 = t > 0 ? 0xffffffffu : 0u, mk1 = t < L - 1 ? 0xffffffffu : 0u; pm1.x &= mk0; pm1.y &= mk0; pm1.z &= mk0; pm1.w &= mk0; pp1.x &= mk1; pp1.y &= mk1; pp1.z &= mk1; pp1.w &= mk1; }
            const unsigned* a = (const unsigned*)&pm1; const unsigned* bq = (const unsigned*)&p0; const unsigned* cq = (const unsigned*)&pp1;
#pragma unroll
            for (int j = 0; j < 4; ++j) {
                const f32x2 w0 = *(const f32x2*)(cw + gc + 2 * j), w1 = *(const f32x2*)(cw + 6144 + gc + 2 * j), w2 = *(const f32x2*)(cw + 12288 + gc + 2 * j), bb = *(const f32x2*)(cb + gc + 2 * j);
#if defined(MK_GATE_VARIANT) && MK_GATE_VARIANT == 1
                u[g][2 * j] = bflo(bq[j]); u[g][2 * j + 1] = bfhi(bq[j]);
#elif defined(MK_GATE_VARIANT) && MK_GATE_VARIANT == 2
                u[g][2 * j] = bflo(bq[j]) * w1.x + bb.x; u[g][2 * j + 1] = bfhi(bq[j]) * w1.y + bb.y;
#elif defined(MK_GATE_VARIANT) && MK_GATE_VARIANT == 3
                u[g][2 * j] = bflo(a[j]) + bflo(bq[j]) + bflo(cq[j]); u[g][2 * j + 1] = bfhi(a[j]) + bfhi(bq[j]) + bfhi(cq[j]);
#else
                u[g][2 * j] = bflo(a[j]) * w0.x + bflo(bq[j]) * w1.x + bflo(cq[j]) * w2.x + bb.x;
                u[g][2 * j + 1] = bfhi(a[j]) * w0.y + bfhi(bq[j]) * w1.y + bfhi(cq[j]) * w2.y + bb.y;
#endif
            }
        }
        { u32x4 o; o.x = cvt_pk(u[0][0], u[0][1]); o.y = cvt_pk(u[0][2], u[0][3]); o.z = cvt_pk(u[0][4], u[0][5]); o.w = cvt_pk(u[0][6], u[0][7]);
          *(u32x4*)(X0 + (size_t)(R0 + t) * D + c0) = o; }
        __syncthreads();
#pragma unroll
        for (int j = 0; j < 8; ++j) zs[(8 * c8 + j) * 72 + tl] = (bf16_t)(cvt_pk(u[2][j] * u[1][j], 0.f) & 0xffffu);
        __syncthreads();
        { const int cl = tid >> 3, t8 = tid & 7;
          const u32x4 o = *(const LAS u32x4*)(zs + cl * 72 + 8 * t8);
          bf16_t* ZT = smp ? ZTs : ZTp;
          *(u32x4*)(ZT + ((size_t)(cbk * 64 + cl) * NB + b) * L + tb * 64 + 8 * t8) = o; }
    }
    __syncthreads();
}

template <int L, int NB>
__device__ __forceinline__ void phase_hy_conv(const Ctx& C, const bf16_t* FG, const bf16_t* ZT, bf16_t* YT) {
    constexpr int WPC = L / 256, CPB = 8 / WPC, NS = L / 32, ROW = 2 * L + 64, UNITS = L / 4, COPYB = UNITS * 16, CHB = 8 * COPYB;
    constexpr int NH = NS > 16 ? NS / 16 : 1, JH = NS / NH;
    const int lane = C.lane, w = C.wave, ch_local = w / WPC, w4 = w % WPC, r = lane & 15, q = lane >> 4;
    for (int it = C.bid; it < 2048 / CPB; it += C.G) {
        const int c = it * CPB + ch_local;
        __syncthreads();
        {
            const int tcid = w4 * 64 + lane;
            const bf16_t* frow = FG + (size_t)c * ROW;
            for (int x = tcid; x < UNITS; x += 64 * WPC) {
                const u32x4 d0 = *(const u32x4*)(frow + 8 * x), d1 = *(const u32x4*)(frow + 8 * x + 8);
                const unsigned dd[8] = {d0.x, d0.y, d0.z, d0.w, d1.x, d1.y, d1.z, d1.w};
#pragma unroll
                for (int k = 0; k < 8; ++k) {
                    u32x4 o;
                    if ((k & 1) == 0) { o.x = dd[k / 2]; o.y = dd[k / 2 + 1]; o.z = dd[k / 2 + 2]; o.w = dd[k / 2 + 3]; }
                    else { const int b0 = (k - 1) / 2;
                        o.x = (dd[b0] >> 16) | (dd[b0 + 1] << 16); o.y = (dd[b0 + 1] >> 16) | (dd[b0 + 2] << 16); o.z = (dd[b0 + 2] >> 16) | (dd[b0 + 3] << 16); o.w = (dd[b0 + 3] >> 16) | (dd[b0 + 4] << 16); }
                    *(LAS u32x4*)(C.lds + ch_local * CHB + k * COPYB + x * 16) = o;
                }
            }
        }
        __syncthreads();
        f32x4 acc[16];
        { const float z0 = opaque_zero();
#pragma unroll
        for (int i = 0; i < 16; ++i) acc[i] = (f32x4){z0, z0, z0, z0}; }
        const bf16_t* zrow = ZT + ((size_t)c * NB + (r % NB)) * L + 8 * q;
        const LAS unsigned char* abase = C.lds + ch_local * CHB + (7 - (r & 7)) * COPYB + ((L - 8) / 8 - (r >> 3) + q - 32 * w4) * 16;
#pragma unroll
        for (int hh = 0; hh < NH; ++hh) {
            bf16x8 bf[JH];
#pragma unroll
            for (int j = 0; j < JH; ++j) bf[j] = *(const bf16x8*)(zrow + 32 * (hh * JH + j));
#pragma unroll
            for (int e = -2 * (hh * JH + JH - 1); e <= 15 - 2 * (hh * JH); ++e) {
                const bf16x8 a = *(const LAS bf16x8*)(abase - 32 * e);
#pragma unroll
                for (int j = 0; j < JH; ++j) { const int il = e + 2 * (hh * JH + j);
                    if (il >= 0 && il < 16) asm volatile("v_mfma_f32_16x16x32_bf16 %0, %1, %2, %0" : "+v"(acc[il]) : "v"(a), "v"(bf[j])); }
                asm volatile("" :: "v"(a));
            }
#pragma unroll
            for (int j = 0; j < JH; ++j) asm volatile("" :: "v"(bf[j]));
        }
        asm volatile("s_nop 15\n\ts_nop 15" : "+v"(acc[0]), "+v"(acc[1]), "+v"(acc[2]), "+v"(acc[3]), "+v"(acc[4]), "+v"(acc[5]), "+v"(acc[6]), "+v"(acc[7]));
        asm volatile("" : "+v"(acc[8]), "+v"(acc[9]), "+v"(acc[10]), "+v"(acc[11]), "+v"(acc[12]), "+v"(acc[13]), "+v"(acc[14]), "+v"(acc[15]));
        if (r < NB) {
            bf16_t* yrow = YT + ((size_t)c * NB + r) * L + 256 * w4 + 4 * q;
#pragma unroll
            for (int i = 0; i < 16; ++i) { u32x2 o; o.x = cvt_pk(acc[i][0], acc[i][1]); o.y = cvt_pk(acc[i][2], acc[i][3]);
#if defined(MK_CONV_VARIANT) && MK_CONV_VARIANT == 1
                { const u32x4 zz = *(const u32x4*)(zrow + 32 * (i & 7)); o.x = zz.x; o.y = zz.y; }
#elif defined(MK_CONV_VARIANT) && MK_CONV_VARIANT == 2
                { const u32x4 aa = *(const LAS u32x4*)(abase - 32 * (i - 8)); o.x = aa.x; o.y = aa.w; }
#endif
                *(u32x2*)(yrow + 16 * i) = o; }
        }
    }
    __syncthreads();
}

__device__ __forceinline__ void phase_hy_out(const Ctx& C, const bf16_t* YTp, const bf16_t* YTs, const bf16_t* X0, bf16_t* Om) {
    const int tid = C.tid;
    LAS bf16_t* ys = (LAS bf16_t*)C.lds;
    for (int it = C.bid; it < 6144; it += C.G) {
        const bool smp = it >= 2048; const int q = smp ? it - 2048 : it;
        const int cbk = q & 31, tb = smp ? (q >> 5) & 15 : (q >> 5) & 3, b = smp ? q >> 9 : q >> 7;
        const int L = smp ? 1024 : 256, R0 = smp ? MP + b * 1024 : b * 256, NB = smp ? 8 : 16;
        __syncthreads();
        { const int cl = tid >> 3, t8 = tid & 7;
          const bf16_t* YT = smp ? YTs : YTp;
          const u32x4 v = *(const u32x4*)(YT + ((size_t)(cbk * 64 + cl) * NB + b) * L + tb * 64 + 8 * t8);
          const unsigned* pv = (const unsigned*)&v;
#pragma unroll
          for (int j = 0; j < 4; ++j) { ys[(8 * t8 + 2 * j) * 72 + cl] = (bf16_t)(pv[j] & 0xffffu); ys[(8 * t8 + 2 * j + 1) * 72 + cl] = (bf16_t)(pv[j] >> 16); } }
        __syncthreads();
        { const int tl = tid >> 3, c8 = tid & 7; const size_t off = (size_t)(R0 + tb * 64 + tl) * D + cbk * 64 + 8 * c8;
          const u32x4 yv = *(const LAS u32x4*)(ys + tl * 72 + 8 * c8), xv = *(const u32x4*)(X0 + off);
          const unsigned* py = (const unsigned*)&yv; const unsigned* px = (const unsigned*)&xv; u32x4 o; unsigned* po = (unsigned*)&o;
#pragma unroll
          for (int j = 0; j < 4; ++j) po[j] = cvt_pk(bflo(py[j]) * bflo(px[j]), bfhi(py[j]) * bfhi(px[j]));
          *(u32x4*)(Om + off) = o; }
    }
    __syncthreads();
}

__device__ __forceinline__ void phase_rw_mix(const Ctx& C, const bf16_t* H, const float* mu, bf16_t* XM) {
    const int gw = C.bid * 8 + C.wave, NGW = C.G * 8, lane = C.lane;
    for (int m = gw; m < MT; m += NGW) {
        const int t = m < MP ? (m & 255) : ((m - MP) & 1023), L = m < MP ? 256 : 1024;
        const bool hasp = t > 0, hasn = t < L - 1;
#pragma unroll
        for (int ch = 0; ch < 4; ++ch) {
            const int c0 = 8 * (lane + 64 * ch);
            const bf16_t* hp = H + (size_t)m * D + c0;
            u32x4 a = *(const u32x4*)(hp - (hasp ? D : 0)), c = *(const u32x4*)(hp + (hasn ? D : 0)); const u32x4 b = *(const u32x4*)hp;
            { const unsigned mk0 = hasp ? 0xffffffffu : 0u, mk1 = hasn ? 0xffffffffu : 0u; a.x &= mk0; a.y &= mk0; a.z &= mk0; a.w &= mk0; c.x &= mk1; c.y &= mk1; c.z &= mk1; c.w &= mk1; }
            const unsigned* pa = (const unsigned*)&a; const unsigned* pb = (const unsigned*)&b; const unsigned* pc = (const unsigned*)&c;
            float hv[8], xx[8];
#pragma unroll
            for (int j = 0; j < 4; ++j) { hv[2 * j] = bflo(pb[j]); hv[2 * j + 1] = bfhi(pb[j]);
                xx[2 * j] = 0.5f * (bflo(pa[j]) + bflo(pc[j])) - hv[2 * j]; xx[2 * j + 1] = 0.5f * (bfhi(pa[j]) + bfhi(pc[j])) - hv[2 * j + 1]; }
#pragma unroll
            for (int s = 0; s < 6; ++s) {
                const int mi = s == 0 ? 0 : s == 1 ? 2 : s == 2 ? 3 : s == 3 ? 1 : s;
                const f32x4 m0 = *(const f32x4*)(mu + mi * D + c0), m1 = *(const f32x4*)(mu + mi * D + c0 + 4);
                u32x4 o; o.x = cvt_pk(hv[0] + xx[0] * m0.x, hv[1] + xx[1] * m0.y); o.y = cvt_pk(hv[2] + xx[2] * m0.z, hv[3] + xx[3] * m0.w);
                o.z = cvt_pk(hv[4] + xx[4] * m1.x, hv[5] + xx[5] * m1.y); o.w = cvt_pk(hv[6] + xx[6] * m1.z, hv[7] + xx[7] * m1.w);
                *(u32x4*)(XM + ((size_t)s * MT + m) * D + c0) = o;
            }
        }
    }
}

__device__ __forceinline__ float dpp_xor1(float x) { return __int_as_float(__builtin_amdgcn_update_dpp(0, __float_as_int(x), 0xB1, 0xF, 0xF, true)); }
__device__ __forceinline__ float dpp_xor2(float x) { return __int_as_float(__builtin_amdgcn_update_dpp(0, __float_as_int(x), 0x4E, 0xF, 0xF, true)); }

constexpr int SC_STEP = 6 * 64;
template <int R, int SC_TS>
__device__ __forceinline__ void rw_scan_task(LAS float* buf, int lane, const bf16_t* Rm, const bf16_t* Km, const bf16_t* Vm, const bf16_t* LD, const bf16_t* LA,
                                             const float* k_k, const float* k_a, const float* invsq, const float* state_in, bf16_t* YB, float* state_out, bool smp, int b, int head, int dir, int half) {
    const int rg = lane >> 2, kq = lane & 3;
    const int L = smp ? 1024 : 256, R0 = smp ? MP + b * 1024 : b * 256;
    const int row0 = half * (16 * R) + R * rg;
    f32x2 S[R][8];
    if (smp) {
        const float* sp = state_in + ((size_t)(b * 2 + dir) * 32 + head) * 4096 + row0 * 64 + 16 * kq;
#pragma unroll
        for (int rr = 0; rr < R; ++rr)
#pragma unroll
            for (int j4 = 0; j4 < 4; ++j4) { const f32x4 v = *(const f32x4*)(sp + rr * 64 + 4 * j4); S[rr][2 * j4] = (f32x2){v.x, v.y}; S[rr][2 * j4 + 1] = (f32x2){v.z, v.w}; }
    } else {
#pragma unroll
        for (int rr = 0; rr < R; ++rr)
#pragma unroll
            for (int j = 0; j < 8; ++j) S[rr][j] = (f32x2){0.f, 0.f};
    }
    const int ch = head * 64 + lane; const size_t hbase = (size_t)head * MT * 64 + lane;
    const float kkc = k_k[ch], kac = k_a[ch];
    const bf16_t* ldp = LD + (size_t)dir * MT * D; const bf16_t* lap = LA + (size_t)dir * MT * D;
    bf16_t* yb = YB + (size_t)dir * MT * D;
    bf16_t pr[SC_TS], pk[SC_TS], pv[SC_TS], pl[SC_TS], pa[SC_TS], qr[SC_TS], qk[SC_TS], qv[SC_TS], ql[SC_TS], qa[SC_TS];
    const int tstart = dir ? L - 1 : 0, tstep = dir ? -1 : 1;
    const int NCH = L / SC_TS;
#define SC_PREFETCH(c) do { _Pragma("unroll") for (int s_ = 0; s_ < SC_TS; ++s_) { const size_t o_ = hbase + (size_t)(R0 + tstart + tstep * ((c) * SC_TS + s_)) * 64; pr[s_] = Rm[o_]; pk[s_] = Km[o_]; pv[s_] = Vm[o_]; pl[s_] = ldp[o_]; pa[s_] = lap[o_]; } } while (0)
#define SC_DERIVE(s_, bufp) do { const float r_ = bf2f(pr[s_]), k_ = bf2f(pk[s_]), v_ = bf2f(pv[s_]), ld_ = bf2f(pl[s_]), a_ = fsigmoid(bf2f(pa[s_])); \
        const float kr_ = k_ * kkc; const float kk_ = kr_ * __builtin_amdgcn_rsqf(wave_sum(kr_ * kr_) + 1e-12f); \
        const unsigned sa_ = (unsigned)(unsigned long)((bufp) + (s_) * SC_STEP) + 4u * (unsigned)lane;     \
        asm volatile("ds_write_b32 %0, %1" :: "v"(sa_), "v"(fexp(ld_))); asm volatile("ds_write_b32 %0, %1 offset:256" :: "v"(sa_), "v"(kk_ * a_)); \
        asm volatile("ds_write_b32 %0, %1 offset:512" :: "v"(sa_), "v"(k_ * (1.0f + (a_ - 1.0f) * kac))); asm volatile("ds_write_b32 %0, %1 offset:768" :: "v"(sa_), "v"(-kk_)); \
        asm volatile("ds_write_b32 %0, %1 offset:1024" :: "v"(sa_), "v"(r_)); asm volatile("ds_write_b32 %0, %1 offset:1280" :: "v"(sa_), "v"(v_)); } while (0)
#define SC_PREFETCH2(c) do { _Pragma("unroll") for (int s_ = 0; s_ < SC_TS; ++s_) { const size_t o_ = hbase + (size_t)(R0 + tstart + tstep * ((c) * SC_TS + s_)) * 64; qr[s_] = Rm[o_]; qk[s_] = Km[o_]; qv[s_] = Vm[o_]; ql[s_] = ldp[o_]; qa[s_] = lap[o_]; } } while (0)
    SC_PREFETCH(0);
#pragma unroll
    for (int s = 0; s < SC_TS; ++s) SC_DERIVE(s, buf);
    asm volatile("s_waitcnt lgkmcnt(0)" ::: "memory");
    SC_PREFETCH(1);
    SC_PREFETCH2(2);
#define SC_DERIVE_Q(s_, bufp) do { const float r_ = bf2f(qr[s_]), k_ = bf2f(qk[s_]), v_ = bf2f(qv[s_]), ld_ = bf2f(ql[s_]), a_ = fsigmoid(bf2f(qa[s_])); \
        const float kr_ = k_ * kkc; const float kk_ = kr_ * __builtin_amdgcn_rsqf(wave_sum(kr_ * kr_) + 1e-12f); \
        const unsigned sa_ = (unsigned)(unsigned long)((bufp) + (s_) * SC_STEP) + 4u * (unsigned)lane; \
        asm volatile("ds_write_b32 %0, %1" :: "v"(sa_), "v"(fexp(ld_))); asm volatile("ds_write_b32 %0, %1 offset:256" :: "v"(sa_), "v"(kk_ * a_)); \
        asm volatile("ds_write_b32 %0, %1 offset:512" :: "v"(sa_), "v"(k_ * (1.0f + (a_ - 1.0f) * kac))); asm volatile("ds_write_b32 %0, %1 offset:768" :: "v"(sa_), "v"(-kk_)); \
        asm volatile("ds_write_b32 %0, %1 offset:1024" :: "v"(sa_), "v"(r_)); asm volatile("ds_write_b32 %0, %1 offset:1280" :: "v"(sa_), "v"(v_)); } while (0)
    LAS float* const buf0 = buf; LAS float* const buf1 = buf + SC_TS * SC_STEP;
    for (int cix = 0; cix < NCH; cix += 2) {
#pragma unroll
        for (int s = 0; s < SC_TS; ++s) {
            SC_DERIVE(s, buf1);
            if (cix + 3 < NCH) { const size_t o_ = hbase + (size_t)(R0 + tstart + tstep * ((cix + 3) * SC_TS + s)) * 64; pr[s] = Rm[o_]; pk[s] = Km[o_]; pv[s] = Vm[o_]; pl[s] = ldp[o_]; pa[s] = lap[o_]; }
#define BC_ buf0
#define CX_ cix
            const LAS float* sb = BC_ + s * SC_STEP;
            f32x2 w2[8], b2[8], d2[8], n2[8], r2[8];
#pragma unroll
            for (int j4 = 0; j4 < 4; ++j4) { const f32x4 nv = *(const LAS f32x4*)(sb + 192 + 16 * kq + 4 * j4); n2[2 * j4] = (f32x2){nv.x, nv.y}; n2[2 * j4 + 1] = (f32x2){nv.z, nv.w}; }
#pragma unroll
            for (int j4 = 0; j4 < 4; ++j4) {
                const f32x4 bv = *(const LAS f32x4*)(sb + 64 + 16 * kq + 4 * j4), dv = *(const LAS f32x4*)(sb + 128 + 16 * kq + 4 * j4), wv = *(const LAS f32x4*)(sb + 16 * kq + 4 * j4), rv = *(const LAS f32x4*)(sb + 256 + 16 * kq + 4 * j4);
                w2[2 * j4] = (f32x2){wv.x, wv.y}; w2[2 * j4 + 1] = (f32x2){wv.z, wv.w}; b2[2 * j4] = (f32x2){bv.x, bv.y}; b2[2 * j4 + 1] = (f32x2){bv.z, bv.w};
                d2[2 * j4] = (f32x2){dv.x, dv.y}; d2[2 * j4 + 1] = (f32x2){dv.z, dv.w}; r2[2 * j4] = (f32x2){rv.x, rv.y}; r2[2 * j4 + 1] = (f32x2){rv.z, rv.w};
            }
            float vrow[R];
            if (R == 4) { const f32x4 vv = *(const LAS f32x4*)(sb + 320 + row0); vrow[0] = vv.x; vrow[R > 1 ? 1 : 0] = vv.y; vrow[R > 2 ? R - 2 : 0] = vv.z; vrow[R - 1] = vv.w; }
            else if (R == 2) { const f32x2 vv = *(const LAS f32x2*)(sb + 320 + row0); vrow[0] = vv.x; vrow[R - 1] = vv.y; }
            else vrow[0] = sb[320 + row0];
            float y[R];
#pragma unroll
            for (int rr = 0; rr < R; ++rr) {
                f32x2 a0 = S[rr][0] * n2[0], a1 = S[rr][1] * n2[1];
#pragma unroll
                for (int j = 2; j < 8; j += 2) { a0 = S[rr][j] * n2[j] + a0; a1 = S[rr][j + 1] * n2[j + 1] + a1; }
                a0 = a0 + a1;
                float sa = a0.x + a0.y; sa += dpp_xor1(sa); sa += dpp_xor2(sa);
                const f32x2 sa2 = (f32x2){sa, sa}, vr2 = (f32x2){vrow[rr], vrow[rr]};
                f32x2 y0 = (f32x2){0.f, 0.f}, y1 = (f32x2){0.f, 0.f};
#pragma unroll
                for (int j = 0; j < 8; j += 2) {
                    S[rr][j] = S[rr][j] * w2[j] + (sa2 * b2[j] + vr2 * d2[j]);
                    S[rr][j + 1] = S[rr][j + 1] * w2[j + 1] + (sa2 * b2[j + 1] + vr2 * d2[j + 1]);
                    y0 = S[rr][j] * r2[j] + y0; y1 = S[rr][j + 1] * r2[j + 1] + y1;
                }
                y0 = y0 + y1;
                float yy = y0.x + y0.y; yy += dpp_xor1(yy); yy += dpp_xor2(yy); y[rr] = yy;
            }
            {
                const int t = tstart + tstep * ((CX_) * SC_TS + s); bf16_t* yp = yb + (size_t)(R0 + t) * D + head * 64;
                if (R == 4) { const float ys = kq == 0 ? y[0] : kq == 1 ? y[R > 1 ? 1 : 0] : kq == 2 ? y[R > 2 ? R - 2 : 0] : y[R - 1]; yp[lane] = (bf16_t)cvt_pk(ys, ys); }
                else if (R == 2) { const float ys = (kq & 1) ? y[R - 1] : y[0]; yp[half * 32 + 2 * rg + (kq & 1)] = (bf16_t)cvt_pk(ys, ys); }
                else yp[row0] = (bf16_t)cvt_pk(y[0], y[0]);
            }
#undef BC_
#undef CX_
        }
        asm volatile("s_waitcnt lgkmcnt(0)" ::: "memory");
#pragma unroll
        for (int s = 0; s < SC_TS; ++s) {
            SC_DERIVE_Q(s, buf0);
            if (cix + 4 < NCH) { const size_t o_ = hbase + (size_t)(R0 + tstart + tstep * ((cix + 4) * SC_TS + s)) * 64; qr[s] = Rm[o_]; qk[s] = Km[o_]; qv[s] = Vm[o_]; ql[s] = ldp[o_]; qa[s] = lap[o_]; }
#define BC_ buf1
#define CX_ (cix + 1)
            const LAS float* sb = BC_ + s * SC_STEP;
            f32x2 w2[8], b2[8], d2[8], n2[8], r2[8];
#pragma unroll
            for (int j4 = 0; j4 < 4; ++j4) { const f32x4 nv = *(const LAS f32x4*)(sb + 192 + 16 * kq + 4 * j4); n2[2 * j4] = (f32x2){nv.x, nv.y}; n2[2 * j4 + 1] = (f32x2){nv.z, nv.w}; }
#pragma unroll
            for (int j4 = 0; j4 < 4; ++j4) {
                const f32x4 bv = *(const LAS f32x4*)(sb + 64 + 16 * kq + 4 * j4), dv = *(const LAS f32x4*)(sb + 128 + 16 * kq + 4 * j4), wv = *(const LAS f32x4*)(sb + 16 * kq + 4 * j4), rv = *(const LAS f32x4*)(sb + 256 + 16 * kq + 4 * j4);
                w2[2 * j4] = (f32x2){wv.x, wv.y}; w2[2 * j4 + 1] = (f32x2){wv.z, wv.w}; b2[2 * j4] = (f32x2){bv.x, bv.y}; b2[2 * j4 + 1] = (f32x2){bv.z, bv.w};
                d2[2 * j4] = (f32x2){dv.x, dv.y}; d2[2 * j4 + 1] = (f32x2){dv.z, dv.w}; r2[2 * j4] = (f32x2){rv.x, rv.y}; r2[2 * j4 + 1] = (f32x2){rv.z, rv.w};
            }
            float vrow[R];
            if (R == 4) { const f32x4 vv = *(const LAS f32x4*)(sb + 320 + row0); vrow[0] = vv.x; vrow[R > 1 ? 1 : 0] = vv.y; vrow[R > 2 ? R - 2 : 0] = vv.z; vrow[R - 1] = vv.w; }
            else if (R == 2) { const f32x2 vv = *(const LAS f32x2*)(sb + 320 + row0); vrow[0] = vv.x; vrow[R - 1] = vv.y; }
            else vrow[0] = sb[320 + row0];
            float y[R];
#pragma unroll
            for (int rr = 0; rr < R; ++rr) {
                f32x2 a0 = S[rr][0] * n2[0], a1 = S[rr][1] * n2[1];
#pragma unroll
                for (int j = 2; j < 8; j += 2) { a0 = S[rr][j] * n2[j] + a0; a1 = S[rr][j + 1] * n2[j + 1] + a1; }
                a0 = a0 + a1;
                float sa = a0.x + a0.y; sa += dpp_xor1(sa); sa += dpp_xor2(sa);
                const f32x2 sa2 = (f32x2){sa, sa}, vr2 = (f32x2){vrow[rr], vrow[rr]};
                f32x2 y0 = (f32x2){0.f, 0.f}, y1 = (f32x2){0.f, 0.f};
#pragma unroll
                for (int j = 0; j < 8; j += 2) {
                    S[rr][j] = S[rr][j] * w2[j] + (sa2 * b2[j] + vr2 * d2[j]);
                    S[rr][j + 1] = S[rr][j + 1] * w2[j + 1] + (sa2 * b2[j + 1] + vr2 * d2[j + 1]);
                    y0 = S[rr][j] * r2[j] + y0; y1 = S[rr][j + 1] * r2[j + 1] + y1;
                }
                y0 = y0 + y1;
                float yy = y0.x + y0.y; yy += dpp_xor1(yy); yy += dpp_xor2(yy); y[rr] = yy;
            }
            {
                const int t = tstart + tstep * ((CX_) * SC_TS + s); bf16_t* yp = yb + (size_t)(R0 + t) * D + head * 64;
                if (R == 4) { const float ys = kq == 0 ? y[0] : kq == 1 ? y[R > 1 ? 1 : 0] : kq == 2 ? y[R > 2 ? R - 2 : 0] : y[R - 1]; yp[lane] = (bf16_t)cvt_pk(ys, ys); }
                else if (R == 2) { const float ys = (kq & 1) ? y[R - 1] : y[0]; yp[half * 32 + 2 * rg + (kq & 1)] = (bf16_t)cvt_pk(ys, ys); }
                else yp[row0] = (bf16_t)cvt_pk(y[0], y[0]);
            }
#undef BC_
#undef CX_
        }
        asm volatile("s_waitcnt lgkmcnt(0)" ::: "memory");
    }
#undef SC_DERIVE_Q
#undef SC_PREFETCH
#undef SC_PREFETCH2
#undef SC_DERIVE
    if (!smp) {
        float* sp = state_out + ((size_t)(b * 2 + dir) * 32 + head) * 4096 + row0 * 64 + 16 * kq;
#pragma unroll
        for (int rr = 0; rr < R; ++rr)
#pragma unroll
            for (int j4 = 0; j4 < 4; ++j4) *(f32x4*)(sp + rr * 64 + 4 * j4) = (f32x4){S[rr][2 * j4].x, S[rr][2 * j4].y, S[rr][2 * j4 + 1].x, S[rr][2 * j4 + 1].y};
    }
}
__device__ __forceinline__ void phase_rw_scan(const Ctx& C, const bf16_t* Rm, const bf16_t* Km, const bf16_t* Vm, const bf16_t* LD, const bf16_t* LA,
                                              const float* k_k, const float* k_a, const float* invsq, const float* state_in, bf16_t* YB, float* state_out) {
    const int lane = C.lane, w = C.wave;
    LAS float* buf = (LAS float*)(C.lds + (w < 4 ? w * 24576 : 98304 + (w - 4) * 12288));
    if (w < 4) { for (int slot = C.bid * 4 + w; slot < 1024; slot += C.G * 4) { const int id = slot >> 1; rw_scan_task<2, 8>(buf, lane, Rm, Km, Vm, LD, LA, k_k, k_a, invsq, state_in, YB, state_out, true, id >> 6, (id >> 1) & 31, id & 1, slot & 1); } }
    else { for (int id = C.bid * 4 + (w - 4); id < 1024; id += C.G * 4) rw_scan_task<4, 4>(buf, lane, Rm, Km, Vm, LD, LA, k_k, k_a, invsq, state_in, YB, state_out, false, id >> 6, (id >> 1) & 31, id & 1, 0); }
    if (w >= 4) late_transposes(C, buf, C.bid * 4 + (w - 4), C.G * 4);
    __syncthreads();
}

__device__ __forceinline__ float head8_sum(float v) { v = DPP_ADD(v, 0xB1); v = DPP_ADD(v, 0x4E); v = DPP_ADD(v, 0x141); return v; }
__device__ __forceinline__ void phase_rw_post(const Ctx& C, const bf16_t* YB, const bf16_t* Rm, const bf16_t* Km, const bf16_t* Vm, const bf16_t* LA, const bf16_t* Gt,
                                              const float* k_a, const float* r_k, const float* ln_w, const float* ln_b, bf16_t* Om) {
    const int gw = C.bid * 8 + C.wave, NGW = C.G * 8, lane = C.lane;
    for (int m = gw; m < MT; m += NGW) {
#pragma unroll 1
        for (int ch = 0; ch < 4; ++ch) {
            const int c0 = 8 * (lane + 64 * ch); const size_t o = (size_t)m * D + c0;
            const u32x4 yfw = *(const u32x4*)(YB + o), ybw = *(const u32x4*)(YB + (size_t)MT * D + o); const unsigned* pyf = (const unsigned*)&yfw; const unsigned* pyb = (const unsigned*)&ybw;
            const size_t oh = hm_index(m, c0);
            const u32x4 rr = *(const u32x4*)(Rm + oh), kk = *(const u32x4*)(Km + oh), vv = *(const u32x4*)(Vm + oh), gg = *(const u32x4*)(Gt + o), l0 = *(const u32x4*)(LA + oh), l1 = *(const u32x4*)(LA + (size_t)MT * D + oh);
            const f32x4 ka0 = *(const f32x4*)(k_a + c0), ka1 = *(const f32x4*)(k_a + c0 + 4), rk0 = *(const f32x4*)(r_k + c0), rk1 = *(const f32x4*)(r_k + c0 + 4);
            const f32x4 lw0 = *(const f32x4*)(ln_w + c0), lw1 = *(const f32x4*)(ln_w + c0 + 4), lb0 = *(const f32x4*)(ln_b + c0), lb1 = *(const f32x4*)(ln_b + c0 + 4);
            float y[8], r[8], k[8], v[8], g[8], a0[8], a1[8], ka[8], rk[8], lw[8], lb[8];
            const unsigned* pr = (const unsigned*)&rr; const unsigned* pk = (const unsigned*)&kk; const unsigned* pv = (const unsigned*)&vv; const unsigned* pg = (const unsigned*)&gg; const unsigned* p0 = (const unsigned*)&l0; const unsigned* p1 = (const unsigned*)&l1;
#pragma unroll
            for (int j = 0; j < 4; ++j) {
                y[2 * j] = bflo(pyf[j]) + bflo(pyb[j]); y[2 * j + 1] = bfhi(pyf[j]) + bfhi(pyb[j]); ka[j] = ka0[j]; ka[4 + j] = ka1[j]; rk[j] = rk0[j]; rk[4 + j] = rk1[j]; lw[j] = lw0[j]; lw[4 + j] = lw1[j]; lb[j] = lb0[j]; lb[4 + j] = lb1[j];
                r[2 * j] = bflo(pr[j]); r[2 * j + 1] = bfhi(pr[j]); k[2 * j] = bflo(pk[j]); k[2 * j + 1] = bfhi(pk[j]); v[2 * j] = bflo(pv[j]); v[2 * j + 1] = bfhi(pv[j]);
                g[2 * j] = bflo(pg[j]); g[2 * j + 1] = bfhi(pg[j]); a0[2 * j] = fsigmoid(bflo(p0[j])); a0[2 * j + 1] = fsigmoid(bfhi(p0[j])); a1[2 * j] = fsigmoid(bflo(p1[j])); a1[2 * j + 1] = fsigmoid(bfhi(p1[j]));
            }
            float s = 0.f, bon = 0.f;
#pragma unroll
            for (int j = 0; j < 8; ++j) { s += y[j]; bon += r[j] * (k[j] * (2.0f + (a0[j] + a1[j] - 2.0f) * ka[j])) * rk[j]; }
            const float mean = head8_sum(s) * (1.0f / 64.0f); bon = head8_sum(bon);
            float q = 0.f;
#pragma unroll
            for (int j = 0; j < 8; ++j) { y[j] -= mean; q += y[j] * y[j]; }
            const float rstd = __builtin_amdgcn_rsqf(head8_sum(q) * (1.0f / 64.0f) + 64e-5f);
            float ov[8];
#pragma unroll
            for (int j = 0; j < 8; ++j) ov[j] = (y[j] * rstd * lw[j] + lb[j] + bon * v[j]) * g[j];
            u32x4 w; w.x = cvt_pk(ov[0], ov[1]); w.y = cvt_pk(ov[2], ov[3]); w.z = cvt_pk(ov[4], ov[5]); w.w = cvt_pk(ov[6], ov[7]);
            *(u32x4*)(Om + o) = w;
        }
    }
}

constexpr int NPH = 35;
#define IN(k) (lo <= (k) && (k) < hi)
#define SEAM(k) do { if (IN(k) && IN((k) + 1)) xcd_barrier(bar); } while (0)
#define LDSG ((PG8_LAS unsigned char*)C.lds)
#ifndef MK_REP_MASK
#define MK_REP_MASK 0ull
#endif
#define REPQ(k) (((MK_REP_MASK) >> (k)) & 1ull)

template <class Epi>
__device__ __forceinline__ void run_gemm(const Ctx& C, const bf16_t* A, const bf16_t* Bt, int N, int K, const Epi& E) {
    pg8::Gemm g{A, Bt, MT, N, K, K}; pg8::StaticOrder S; S.init(MT, N, C.G, C.bid);
    pg8::gemm_phase<Epi, pg8::StaticOrder, false>(LDSG, g, S, E, nullptr);
}

#ifndef MK_SPLIT_MASK
#define MK_SPLIT_MASK 15
#endif
#define PREVP1(L) (((L) > 0 && (((MK_SPLIT_MASK) >> ((L) - 1)) & 1)) ? (const bf16_t*)WSP(bf16_t, WS_ARENA + AR_SLAB) : (const bf16_t*)nullptr)
constexpr size_t AR_SLAB = 200 * MiB;
constexpr size_t CTL_SPLIT = 65536;
template <int SET>
__device__ __forceinline__ void run_gemm_split_res(const Ctx& C, const bf16_t* A, const bf16_t* Bt, int K, bf16_t* X, const float* gate_base) {
    pg8::Gemm g{A, Bt, MT, D, K, K / 2}; TailSplitOrder S; S.init(C.G, C.bid, K / 64);
    EpiResidualSplitB E{X, gate_base, WSP(bf16_t, WS_ARENA + AR_SLAB)};
    pg8::gemm_phase<EpiResidualSplitB, TailSplitOrder, false>(LDSG, g, S, E, nullptr);
}
template <int LAYER>
__device__ __forceinline__ void mlp_block(const Ctx& C, const XcdBarrier& bar, int lo, int hi, int b0) {
    bf16_t* X = WSP(bf16_t, WS_X); bf16_t* H = WSP(bf16_t, WS_H); bf16_t* U = WSP(bf16_t, WS_ARENA + AR_U);
    if (IN(b0)) { { phase_norm_mod_b(C, X, karg<I_N2G>() + LAYER * D, LAYER, 3, H); } if (REPQ(b0)) { phase_norm_mod_b(C, X, karg<I_N2G>() + LAYER * D, LAYER, 3, H); } }
    SEAM(b0);
    if (IN(b0 + 1)) { { EpiBf16<1> E{U, FF}; run_gemm(C, H, WSP(bf16_t, WS_W1T) + (size_t)LAYER * D * FF, FF, D, E); } if (REPQ(b0 + 1)) { EpiBf16<1> E{U, FF}; run_gemm(C, H, WSP(bf16_t, WS_W1T) + (size_t)LAYER * D * FF, FF, D, E); } }
    SEAM(b0 + 1);
    if (IN(b0 + 2)) { { if constexpr (((MK_SPLIT_MASK) >> LAYER) & 1) run_gemm_split_res<LAYER>(C, U, WSP(bf16_t, WS_W2T) + (size_t)LAYER * D * FF, FF, X, MODP(LAYER, 0, 5)); else { EpiResidualB<false> E{X, MODP(LAYER, 0, 5), nullptr, nullptr}; run_gemm(C, U, WSP(bf16_t, WS_W2T) + (size_t)LAYER * D * FF, D, FF, E); } } if (REPQ(b0 + 2)) { if constexpr (((MK_SPLIT_MASK) >> LAYER) & 1) run_gemm_split_res<LAYER>(C, U, WSP(bf16_t, WS_W2T) + (size_t)LAYER * D * FF, FF, X, MODP(LAYER, 0, 5)); else { EpiResidualB<false> E{X, MODP(LAYER, 0, 5), nullptr, nullptr}; run_gemm(C, U, WSP(bf16_t, WS_W2T) + (size_t)LAYER * D * FF, D, FF, E); } } }
    SEAM(b0 + 2);
}

template <int LAYER, int J>
__device__ __forceinline__ void attn_layer(const Ctx& C, const XcdBarrier& bar, int lo, int hi, int b0) {
    bf16_t* X = WSP(bf16_t, WS_X); bf16_t* H = WSP(bf16_t, WS_H);
    bf16_t *Q = WSP(bf16_t, WS_ARENA + AR_Q), *Kb = WSP(bf16_t, WS_ARENA + AR_K), *Vb = WSP(bf16_t, WS_ARENA + AR_V), *O = WSP(bf16_t, WS_ARENA + AR_O);
    if (IN(b0)) { { if (LAYER == 0) { phase_fg_transpose(C); phase_norm_mod(C, karg<I_XP>(), karg<I_XS>(), karg<I_N1G>() + LAYER * D, LAYER, 0, H); } else phase_norm_mod_b(C, X, karg<I_N1G>() + LAYER * D, LAYER, 0, H, PREVP1(LAYER), X, 8192); } if (REPQ(b0)) { if (LAYER == 0) { phase_fg_transpose(C); phase_norm_mod(C, karg<I_XP>(), karg<I_XS>(), karg<I_N1G>() + LAYER * D, LAYER, 0, H); } else phase_norm_mod_b(C, X, karg<I_N1G>() + LAYER * D, LAYER, 0, H, PREVP1(LAYER), X, 8192); } }
    SEAM(b0);
    if (IN(b0 + 1)) { { EpiQKV E{Q, Kb, Vb, C.out + OUT_NK + (size_t)J * 256 * 512, C.out + OUT_NV + (size_t)J * 256 * 512}; run_gemm(C, H, WSP(bf16_t, WS_WQKVT) + (size_t)J * D * 3072, 3072, D, E); } if (REPQ(b0 + 1)) { EpiQKV E{Q, Kb, Vb, C.out + OUT_NK + (size_t)J * 256 * 512, C.out + OUT_NV + (size_t)J * 256 * 512}; run_gemm(C, H, WSP(bf16_t, WS_WQKVT) + (size_t)J * D * 3072, 3072, D, E); } }
    SEAM(b0 + 1);
    if (IN(b0 + 2)) { { phase_attention(C, Q, Kb, Vb, WSP(bf16_t, WS_KC) + (size_t)J * 512 * 512, WSP(bf16_t, WS_VC) + (size_t)J * 512 * 512, karg<I_SINK>() + J * 16, O); } if (REPQ(b0 + 2)) { phase_attention(C, Q, Kb, Vb, WSP(bf16_t, WS_KC) + (size_t)J * 512 * 512, WSP(bf16_t, WS_VC) + (size_t)J * 512 * 512, karg<I_SINK>() + J * 16, O); } }
    SEAM(b0 + 2);
    if (IN(b0 + 3)) { { EpiResidualB<LAYER == 0> E{X, MODP(LAYER, 0, 2), LAYER == 0 ? karg<I_XP>() : nullptr, LAYER == 0 ? karg<I_XS>() : nullptr}; run_gemm(C, O, WSP(bf16_t, WS_WOT) + (size_t)J * D * D, D, D, E); } if (REPQ(b0 + 3)) { EpiResidualB<LAYER == 0> E{X, MODP(LAYER, 0, 2), LAYER == 0 ? karg<I_XP>() : nullptr, LAYER == 0 ? karg<I_XS>() : nullptr}; run_gemm(C, O, WSP(bf16_t, WS_WOT) + (size_t)J * D * D, D, D, E); } }
    SEAM(b0 + 3);
    mlp_block<LAYER>(C, bar, lo, hi, b0 + 4);
}

template <int LAYER>
__device__ __forceinline__ void hyena_layer(const Ctx& C, const XcdBarrier& bar, int lo, int hi, int b0) {
    bf16_t* X = WSP(bf16_t, WS_X); bf16_t* H = WSP(bf16_t, WS_H);
    bf16_t *Pm = WSP(bf16_t, WS_ARENA + AR_P), *X0 = WSP(bf16_t, WS_ARENA + AR_X0), *ZT = WSP(bf16_t, WS_ARENA + AR_ZT), *YT = WSP(bf16_t, WS_ARENA + AR_YT), *HO = WSP(bf16_t, WS_ARENA + AR_HO);
    bf16_t *ZTp = ZT, *ZTs = ZT + (size_t)MP * D, *YTp = YT, *YTs = YT + (size_t)MP * D;
    if (IN(b0)) { { phase_norm_mod_b(C, X, karg<I_N1G>() + LAYER * D, LAYER, 0, H, PREVP1(LAYER), X, 8192); } if (REPQ(b0)) { phase_norm_mod_b(C, X, karg<I_N1G>() + LAYER * D, LAYER, 0, H, PREVP1(LAYER), X, 8192); } }
    SEAM(b0);
    if (IN(b0 + 1)) { { EpiBf16<0> E{Pm, 6144}; run_gemm(C, H, WSP(bf16_t, WS_HYINT), 6144, D, E); } if (REPQ(b0 + 1)) { EpiBf16<0> E{Pm, 6144}; run_gemm(C, H, WSP(bf16_t, WS_HYINT), 6144, D, E); } }
    SEAM(b0 + 1);
    if (IN(b0 + 2)) { { phase_hy_gate(C, Pm, karg<I_HYCW>(), karg<I_HYCB>(), X0, ZTp, ZTs); } if (REPQ(b0 + 2)) { phase_hy_gate(C, Pm, karg<I_HYCW>(), karg<I_HYCB>(), X0, ZTp, ZTs); } }
    SEAM(b0 + 2);
    if (IN(b0 + 3)) { { phase_hy_conv<1024, 8>(C, WSP(bf16_t, WS_FGS), ZTs, YTs); phase_hy_conv<256, 16>(C, WSP(bf16_t, WS_FGP), ZTp, YTp); } if (REPQ(b0 + 3)) { phase_hy_conv<1024, 8>(C, WSP(bf16_t, WS_FGS), ZTs, YTs); phase_hy_conv<256, 16>(C, WSP(bf16_t, WS_FGP), ZTp, YTp); } }
    SEAM(b0 + 3);
    if (IN(b0 + 4)) { { phase_hy_out(C, YTp, YTs, X0, HO); } if (REPQ(b0 + 4)) { phase_hy_out(C, YTp, YTs, X0, HO); } }
    SEAM(b0 + 4);
    if (IN(b0 + 5)) { { EpiResidualB<false> E{X, MODP(LAYER, 0, 2), nullptr, nullptr}; run_gemm(C, HO, WSP(bf16_t, WS_HYOUTT), D, D, E); } if (REPQ(b0 + 5)) { EpiResidualB<false> E{X, MODP(LAYER, 0, 2), nullptr, nullptr}; run_gemm(C, HO, WSP(bf16_t, WS_HYOUTT), D, D, E); } }
    SEAM(b0 + 5);
    mlp_block<LAYER>(C, bar, lo, hi, b0 + 6);
}

template <int LAYER>
__device__ __forceinline__ void rwkv_layer(const Ctx& C, const XcdBarrier& bar, int lo, int hi, int b0) {
    bf16_t* X = WSP(bf16_t, WS_X); bf16_t* H = WSP(bf16_t, WS_H);
    bf16_t *XM = WSP(bf16_t, WS_ARENA + AR_XMIX), *LD = WSP(bf16_t, WS_ARENA + AR_LD), *LA = WSP(bf16_t, WS_ARENA + AR_LA), *Gt = WSP(bf16_t, WS_ARENA + AR_G), *RO = WSP(bf16_t, WS_ARENA + AR_RO);
    bf16_t *Rm = WSP(bf16_t, WS_ARENA + AR_R), *Km = WSP(bf16_t, WS_ARENA + AR_KK), *Vm = WSP(bf16_t, WS_ARENA + AR_VV), *A3 = WSP(bf16_t, WS_ARENA + AR_A3);
    bf16_t* YB = WSP(bf16_t, WS_ARENA + AR_YB);
    if (IN(b0)) { { phase_norm_mod_b(C, X, karg<I_N1G>() + LAYER * D, LAYER, 0, H, PREVP1(LAYER), X, 8192); } if (REPQ(b0)) { phase_norm_mod_b(C, X, karg<I_N1G>() + LAYER * D, LAYER, 0, H, PREVP1(LAYER), X, 8192); } }
    SEAM(b0);
    if (IN(b0 + 1)) { { phase_rw_mix(C, H, karg<I_MU>(), XM); } if (REPQ(b0 + 1)) { phase_rw_mix(C, H, karg<I_MU>(), XM); } }
    SEAM(b0 + 1);
    if (IN(b0 + 2)) { { pg8::Gemm g{XM, WSP(bf16_t, WS_RWBT), 6 * MT, 27 * 256, D, D}; RwOrder1 S{C.G, C.bid}; EpiRw1 E{Rm, A3, karg<I_KK>(), WSP(float, WS_INVSQ)}; pg8::gemm_phase<EpiRw1, RwOrder1, false>(LDSG, g, S, E, nullptr); } if (REPQ(b0 + 2)) { pg8::Gemm g{XM, WSP(bf16_t, WS_RWBT), 6 * MT, 27 * 256, D, D}; RwOrder1 S{C.G, C.bid}; EpiRw1 E{Rm, A3, karg<I_KK>(), WSP(float, WS_INVSQ)}; pg8::gemm_phase<EpiRw1, RwOrder1, false>(LDSG, g, S, E, nullptr); } }
    SEAM(b0 + 2);
    if (IN(b0 + 3)) { { pg8::Gemm g{A3, WSP(bf16_t, WS_LORA2T), 3 * MT, 40 * 256, 256, 256}; RwOrder2 S{C.G, C.bid}; EpiRw2 E{LD, LA, Gt, karg<I_W0>(), karg<I_A0>()}; pg8::gemm_phase<EpiRw2, RwOrder2, false>(LDSG, g, S, E, nullptr); } if (REPQ(b0 + 3)) { pg8::Gemm g{A3, WSP(bf16_t, WS_LORA2T), 3 * MT, 40 * 256, 256, 256}; RwOrder2 S{C.G, C.bid}; EpiRw2 E{LD, LA, Gt, karg<I_W0>(), karg<I_A0>()}; pg8::gemm_phase<EpiRw2, RwOrder2, false>(LDSG, g, S, E, nullptr); } }
    SEAM(b0 + 3);
    if (IN(b0 + 4)) { { phase_rw_scan(C, Rm, Km, Vm, LD, LA, karg<I_KK>(), karg<I_KA>(), WSP(float, WS_INVSQ), karg<I_ST>(), YB, C.out + OUT_ST); } if (REPQ(b0 + 4)) { phase_rw_scan(C, Rm, Km, Vm, LD, LA, karg<I_KK>(), karg<I_KA>(), WSP(float, WS_INVSQ), karg<I_ST>(), YB, C.out + OUT_ST); } }
    SEAM(b0 + 4);
    if (IN(b0 + 5)) { { phase_rw_post(C, YB, Rm, Km, Vm, LA, Gt, karg<I_KA>(), karg<I_RK>(), karg<I_LNW>(), karg<I_LNB>(), RO); } if (REPQ(b0 + 5)) { phase_rw_post(C, YB, Rm, Km, Vm, LA, Gt, karg<I_KA>(), karg<I_RK>(), karg<I_LNW>(), karg<I_LNB>(), RO); } }
    SEAM(b0 + 5);
    if (IN(b0 + 6)) { { EpiResidualB<false> E{X, MODP(LAYER, 0, 2), nullptr, nullptr}; run_gemm(C, RO, WSP(bf16_t, WS_RWOT), D, D, E); } if (REPQ(b0 + 6)) { EpiResidualB<false> E{X, MODP(LAYER, 0, 2), nullptr, nullptr}; run_gemm(C, RO, WSP(bf16_t, WS_RWOT), D, D, E); } }
    SEAM(b0 + 6);
    mlp_block<LAYER>(C, bar, lo, hi, b0 + 7);
}

__global__ void __launch_bounds__(512, 2) fwd_kernel(Params prm) {
    extern __shared__ __attribute__((aligned(16))) unsigned char lds_raw[];
    Ctx C;
    C.lds = (LAS unsigned char*)lds_raw;
    C.tid = threadIdx.x; C.lane = C.tid & 63; C.wave = __builtin_amdgcn_readfirstlane(C.tid >> 6); C.G = gridDim.x; C.bid = blockIdx.x;
    C.out = prm.out; C.ws = prm.ws;
    const int lo = prm.ph_lo, hi = prm.ph_hi;
    volatile LAS unsigned* xbw = (volatile LAS unsigned*)(C.lds + LDS_BAR_OFF);
    if (C.tid < 4) xbw[C.tid] = 0u;
    __syncthreads();
    XcdBarrier bar; bar.bar = (unsigned*)(C.ws + WS_CTL) + 1024; bar.x = 0; bar.st = xbw;
    if (hi - lo > 1) bar = xcd_barrier_post((unsigned*)(C.ws + WS_CTL) + 1024, xbw);

#ifdef MK_SKIP_FROM
    if (IN(0)) { for (size_t i = (size_t)C.bid * 512 + C.tid; i < (size_t)3 * 4194304; i += (size_t)C.G * 512) prm.out[OUT_NK + i] = 0.f; }
#endif
    if (IN(0)) { { phase_prologue(C); } if (REPQ(0)) { phase_prologue(C); } }
    SEAM(0);
    attn_layer<0, 0>(C, bar, lo, hi, 1);
    hyena_layer<1>(C, bar, lo, hi, 8);
    rwkv_layer<2>(C, bar, lo, hi, 17);
    attn_layer<3, 1>(C, bar, lo, hi, 27);
#ifndef MK_DBG_N
#define MK_DBG_N ((size_t)MT * D)
#endif
#ifndef MK_DBG_SCALE
#define MK_DBG_SCALE 1.0f
#endif
#ifdef MK_DBG_OFF
    if (IN(34)) { for (size_t i = (size_t)C.bid * 512 + C.tid; i < (size_t)MT * D; i += (size_t)C.G * 512) prm.out[OUT_Y + i] = i < (size_t)(MK_DBG_N) ? MK_DBG_SCALE * (MK_DBG_BF16 ? bf2f(WSP(bf16_t, MK_DBG_OFF)[i]) : WSP(float, MK_DBG_OFF)[i]) : 0.f; }
#else
    if (IN(34)) { { phase_norm_final_b(C, WSP(bf16_t, WS_X), karg<I_FNG>(), prm.out + OUT_Y, PREVP1(4), 8192); } if (REPQ(34)) { phase_norm_final_b(C, WSP(bf16_t, WS_X), karg<I_FNG>(), prm.out + OUT_Y, PREVP1(4), 8192); } }
#endif
}

#ifdef MK_SEP_CONV
__global__ void __launch_bounds__(512, 2) k_hyconv(Params prm) {
    extern __shared__ __attribute__((aligned(16))) unsigned char lds_raw3[];
    Ctx C; C.lds = (LAS unsigned char*)lds_raw3; C.tid = threadIdx.x; C.lane = C.tid & 63; C.wave = __builtin_amdgcn_readfirstlane(C.tid >> 6); C.G = gridDim.x; C.bid = blockIdx.x; C.out = prm.out; C.ws = prm.ws;
    bf16_t *ZT = WSP(bf16_t, WS_ARENA + AR_ZT), *YT = WSP(bf16_t, WS_ARENA + AR_YT);
    phase_hy_conv<1024, 8>(C, WSP(bf16_t, WS_FGS), ZT + (size_t)MP * D, YT + (size_t)MP * D); phase_hy_conv<256, 16>(C, WSP(bf16_t, WS_FGP), ZT, YT);
}
#endif
#ifdef MK_SEP_GATE
__global__ void __launch_bounds__(512, 2) k_hygate(Params prm) {
    extern __shared__ __attribute__((aligned(16))) unsigned char lds_raw2[];
    Ctx C; C.lds = (LAS unsigned char*)lds_raw2; C.tid = threadIdx.x; C.lane = C.tid & 63; C.wave = __builtin_amdgcn_readfirstlane(C.tid >> 6); C.G = gridDim.x; C.bid = blockIdx.x; C.out = prm.out; C.ws = prm.ws;
    bf16_t* ZT = WSP(bf16_t, WS_ARENA + AR_ZT);
    phase_hy_gate(C, WSP(bf16_t, WS_ARENA + AR_P), karg<I_HYCW>(), karg<I_HYCB>(), WSP(bf16_t, WS_ARENA + AR_X0), ZT, ZT + (size_t)MP * D);
}
#endif
#ifndef MK_PER_PHASE
#define MK_PER_PHASE 0
#endif
extern "C" void kernel_launch(void* const* d_in, const int* in_sizes, int n_in, void* d_out, int out_size, void* d_ws, size_t ws_size, hipStream_t stream) {
    static int grid = 0;
    if (grid == 0) {
        if (n_in != N_IN || ws_size < WS_END || out_size != 37748736) { fprintf(stderr, "kernel_launch: unexpected shapes (n_in %d, ws %zu, out %d); nothing launched\n", n_in, ws_size, out_size); grid = -1; return; }
        int dev = 0, cus = 0, per_cu = 0;
        if (hipGetDevice(&dev) != hipSuccess || hipDeviceGetAttribute(&cus, hipDeviceAttributeMultiprocessorCount, dev) != hipSuccess) { grid = -1; return; }
        if (hipFuncSetAttribute((const void*)fwd_kernel, hipFuncAttributeMaxDynamicSharedMemorySize, LDS_BYTES) != hipSuccess) { fprintf(stderr, "kernel_launch: hipFuncSetAttribute failed\n"); grid = -1; return; }
        if (hipOccupancyMaxActiveBlocksPerMultiprocessor(&per_cu, (const void*)fwd_kernel, 512, LDS_BYTES) != hipSuccess || per_cu < 1) { fprintf(stderr, "kernel_launch: occupancy query says %d\n", per_cu); }
        (void)hipGetLastError();
        grid = cus;
    }
    if (grid < 0) return;
    (void)hipMemsetAsync((char*)d_ws, 0, WS_ZERO_BYTES, stream);
    Params p{};
    for (int i = 0; i < N_IN; ++i) p.in[i] = (const float*)d_in[i];
    p.out = (float*)d_out; p.ws = (unsigned char*)d_ws;
#ifndef MK_LASTP
#define MK_LASTP NPH
#endif
#ifndef MK_FIRSTP
#define MK_FIRSTP 0
#endif
#if MK_PER_PHASE
    for (int k = MK_FIRSTP; k < MK_LASTP; ++k) {
#ifdef MK_SKIP_FROM
        if (k >= MK_SKIP_FROM && k < NPH - 1) continue;
#endif
#ifdef MK_SEP_CONV
        if (k == 11) { static bool a3 = false; if (!a3) { (void)hipFuncSetAttribute((const void*)k_hyconv, hipFuncAttributeMaxDynamicSharedMemorySize, 70000); a3 = true; } hipLaunchKernelGGL(k_hyconv, dim3(grid), dim3(512), 70000, stream, p); continue; }
#endif
#ifdef MK_SEP_GATE
        if (k == 10) { hipLaunchKernelGGL(k_hygate, dim3(grid), dim3(512), 16384, stream, p); continue; }
#endif
#ifdef MK_REPEAT_PH
        if (k == MK_REPEAT_PH) { p.ph_lo = k; p.ph_hi = k + 1; hipLaunchKernelGGL(fwd_kernel, dim3(grid), dim3(512), LDS_BYTES, stream, p); }
#endif
 p.ph_lo = k; p.ph_hi = k + 1; hipLaunchKernelGGL(fwd_kernel, dim3(grid), dim3(512), LDS_BYTES, stream, p); }
#else
    p.ph_lo = 0; p.ph_hi = NPH; hipLaunchKernelGGL(fwd_kernel, dim3(grid), dim3(512), LDS_BYTES, stream, p);
#endif
}
```

```cpp
#include <hip/hip_runtime.h>
#include <cstdio>
#include <cstdint>
namespace pg8 {
#define PG8_LAS __attribute__((address_space(3)))
typedef unsigned short bf16_t;
typedef short bf16x8 __attribute__((ext_vector_type(8)));
typedef float f32x4 __attribute__((ext_vector_type(4)));
typedef unsigned u32x4 __attribute__((ext_vector_type(4)));
constexpr int BM = 256, BK = 64, HALF = 128, HTB = HALF * BK * 2  , STAGE_BYTES = 8 * HTB, NXCD = 8, WGM = 4;

__host__ __device__ __forceinline__ int lds_byte(int r, int c) { const int st = (r >> 4) * 2 + (c >> 5), rr = r & 15, cc = c & 31, ob = rr * 64 + cc * 2; return st * 1024 + (ob ^ (((ob >> 9) & 1) << 5)); }
__host__ __device__ __forceinline__ void stage_rc(int b, int& R, int& C) { const int st = b / 1024, sb = b % 1024, swz = sb ^ (((sb >> 9) & 1) << 5); R = (st >> 1) * 16 + swz / 64; C = (st & 1) * 32 + (swz % 64) / 2; }
__host__ __device__ __forceinline__ int perm32(int rho) { const int n = rho >> 4, i = rho & 15; return 8 * (i >> 2) + 4 * n + (i & 3); }

struct Unit { int pm, pn, kh, mask; int nt = 0; };
struct Gemm { const bf16_t* A; const bf16_t* Bt; int M, N, K, KU; };

__host__ __device__ __forceinline__ bool tail_deal(int nwg, int G, int i, int c, int& L, int& mask) {
    const int full = nwg / G, rem = nwg - full * G;
    if (i < full) { L = i * G + c; mask = 15; return true; }
    if (i > full || rem == 0) return false;
    const int parts = (4 * rem <= G) ? 4 : ((2 * rem <= G) ? 2 : 1);
    if (c >= parts * rem) return false;
    L = full * G + c / parts; const int sub = c % parts;
    mask = parts == 1 ? 15 : (parts == 2 ? (sub ? 0xA : 0x5) : (1 << sub));
    return true;
}
struct StaticOrder {
    int nM, nN, nwg, G, c;
    __host__ __device__ void init(int M, int N, int G_, int c_) { nM = M / BM; nN = N / BM; nwg = nM * nN; G = G_; c = c_; }
    __host__ __device__ bool next(int i, Unit& u) const { const long L = (long)i * G + c; if (L >= nwg) return false; map((int)L, u); u.kh = 0; u.mask = 15; return true; }
    __host__ __device__ bool map(int L, Unit& u) const {
        int wgid = (int)L; { const int q = nwg / NXCD, r = nwg % NXCD, xcd = wgid % NXCD, off = wgid / NXCD; wgid = (xcd < r ? xcd * (q + 1) : r * (q + 1) + (xcd - r) * q) + off; }
        const int nig = WGM * nN, gid = wgid / nig, fm = gid * WGM, gsz = (nM - fm) < WGM ? (nM - fm) : WGM;
        u.pm = fm + ((wgid % nig) % gsz); u.pn = (wgid % nig) / gsz; return true;
    }
    __device__ __forceinline__ void a_ready(const Unit&) const {}
    __device__ __forceinline__ void done(const Unit&) const {}
};

template <class Epi, class Sched, bool STAMP = false>
__device__ __forceinline__ void gemm_phase(PG8_LAS unsigned char* lds, const Gemm g, const Sched& S, const Epi& E, unsigned long long* stamps) {
    const int tid = threadIdx.x, wid = __builtin_amdgcn_readfirstlane(tid >> 6), lane = tid & 63, wr = wid >> 2, wc = wid & 3, fr = lane & 15, fq = lane >> 4;
    const int K = g.K, nt = g.KU / BK;
    int ts_lo = 0, ts_hi = 0, nts = 0; const unsigned long long rt_entry = STAMP ? (unsigned long long)wall_clock64() : 0ull;
#define PG8_STAMP() do { if (STAMP && wid == 0 && nts < 64) { const unsigned long long _c = (unsigned long long)clock64(); \
        ts_lo = (lane == nts) ? (int)(unsigned)_c : ts_lo; ts_hi = (lane == nts) ? (int)(unsigned)(_c >> 32) : ts_hi; ++nts; } } while (0)
    PG8_STAMP();
    unsigned voffA[2], voffB[2];
#pragma unroll
    for (int i = 0; i < 2; ++i) { int R, C; stage_rc(tid * 16 + i * 8192, R, C); const int Rb = Epi::PERM ? ((R & ~31) + perm32(R & 31)) : R;
        voffA[i] = (unsigned)(R * K + C) * 2u; voffB[i] = (unsigned)(Rb * K + C) * 2u; }
    const size_t kstep = (size_t)(BK * 2);
    const size_t hstep = (size_t)HALF * K * 2;
    const size_t tstep = 2 * hstep;
    const unsigned ldsw = (unsigned)wid * 1024u;
    const int aoff = lds_byte(wr * 64 + fr, fq * 8), boff = lds_byte(wc * 32 + fr, fq * 8);
#define PG8_SA(b, h) (((b) * 2 + (h)) * HTB)
#define PG8_SB(b, h) ((4 + (b) * 2 + (h)) * HTB)
#define PG8_STAGE(bufoff, gbase, voff) do { _Pragma("unroll") for (int _i = 0; _i < 2; ++_i) \
        __builtin_amdgcn_global_load_lds((const unsigned*)((const char*)(gbase) + (voff)[_i]), (PG8_LAS unsigned*)(lds + (bufoff) + ldsw + _i * 8192), 16, 0, 0); } while (0)
#define PG8_LDA(dst, b, h) do { _Pragma("unroll") for (int m = 0; m < 4; ++m) _Pragma("unroll") for (int k = 0; k < 2; ++k) dst[m][k] = *(const PG8_LAS bf16x8*)(lds + PG8_SA(b, h) + aoff + m * 2048 + k * 1024); } while (0)
#define PG8_LDB(dst, b, h) do { _Pragma("unroll") for (int n = 0; n < 2; ++n) _Pragma("unroll") for (int k = 0; k < 2; ++k) dst[n][k] = *(const PG8_LAS bf16x8*)(lds + PG8_SB(b, h) + boff + n * 2048 + k * 1024); } while (0)
#define PG8_MMA(ai, bj, At, Bt) do { __builtin_amdgcn_s_setprio(1); _Pragma("unroll") for (int k = 0; k < 2; ++k) _Pragma("unroll") for (int m = 0; m < 4; ++m) _Pragma("unroll") for (int n = 0; n < 2; ++n) \
        asm volatile("v_mfma_f32_16x16x32_bf16 %0, %1, %2, %0" : "+v"(acc[ai][bj][m][n]) : "v"(Bt[n][k]), "v"(At[m][k])); __builtin_amdgcn_s_setprio(0); } while (0)
#define PG8_ACC_FENCE1(ai, bj) asm volatile("s_nop 15\n\ts_nop 15" : "+v"(acc[ai][bj][0][0]), "+v"(acc[ai][bj][0][1]), "+v"(acc[ai][bj][1][0]), "+v"(acc[ai][bj][1][1]), "+v"(acc[ai][bj][2][0]), "+v"(acc[ai][bj][2][1]), "+v"(acc[ai][bj][3][0]), "+v"(acc[ai][bj][3][1]))
#define PG8_ACC_FENCE() do { PG8_ACC_FENCE1(0, 0); PG8_ACC_FENCE1(0, 1); PG8_ACC_FENCE1(1, 0); PG8_ACC_FENCE1(1, 1); } while (0)
#define PG8_WAIT_V(n) asm volatile("s_waitcnt vmcnt(" #n ")" ::: "memory")
#define PG8_WAIT_L(n) asm volatile("s_waitcnt lgkmcnt(" #n ")" ::: "memory")
#define PG8_BAR __builtin_amdgcn_s_barrier()
#define PG8_SCHED __builtin_amdgcn_sched_barrier(0)
    Unit cur, nxt; int ui = 0;
    if (!S.next(0, cur)) return;
    f32x4 acc[2][2][4][2];
#pragma unroll
    for (int a = 0; a < 2; ++a)
#pragma unroll
        for (int b = 0; b < 2; ++b)
#pragma unroll
            for (int m = 0; m < 4; ++m)
#pragma unroll
                for (int n = 0; n < 2; ++n) acc[a][b][m][n] = (f32x4){0.f, 0.f, 0.f, 0.f};
    bf16x8 At[4][2], B0[2][2], B1[2][2];
    const size_t kslice = (size_t)g.KU * 2;
    const char* cA = (const char*)g.A + (size_t)cur.pm * tstep + cur.kh * kslice; const char* cB = (const char*)g.Bt + (size_t)cur.pn * tstep + cur.kh * kslice;
    S.a_ready(cur);
    PG8_STAGE(PG8_SB(0, 0), cB, voffB); PG8_STAGE(PG8_SA(0, 0), cA, voffA); PG8_STAGE(PG8_SB(0, 1), cB + hstep, voffB); PG8_STAGE(PG8_SA(0, 1), cA + hstep, voffA);
    if (wr == 1) PG8_BAR;
    PG8_WAIT_V(4); PG8_BAR;
    PG8_STAGE(PG8_SB(1, 0), cB + kstep, voffB); PG8_STAGE(PG8_SA(1, 0), cA + kstep, voffA); PG8_STAGE(PG8_SB(1, 1), cB + hstep + kstep, voffB);
    PG8_WAIT_V(6); PG8_BAR;
    PG8_STAMP();
    for (;;) {
        const bool has_next = S.next(ui + 1, nxt);
        const char* nA = has_next ? (const char*)g.A + (size_t)nxt.pm * tstep + nxt.kh * kslice : cA; const char* nB = has_next ? (const char*)g.Bt + (size_t)nxt.pn * tstep + nxt.kh * kslice : cB;
        const int unt = cur.nt ? cur.nt : nt;
        for (int t = 0; t < unt; t += 2) {
            const bool last = (t == unt - 2);
            const char* a1 = cA + (size_t)(t + 1) * kstep;
            const char* a2 = last ? nA : cA + (size_t)(t + 2) * kstep; const char* b2 = last ? nB : cB + (size_t)(t + 2) * kstep;
            const char* a3 = a2 + kstep; const char* b3 = b2 + kstep;
            if (last && has_next) S.a_ready(nxt);
            PG8_LDB(B0, 0, 0); PG8_SCHED; PG8_LDA(At, 0, 0); PG8_STAGE(PG8_SA(1, 1), a1 + hstep, voffA);
            PG8_WAIT_L(8); PG8_BAR; PG8_WAIT_L(0); PG8_MMA(0, 0, At, B0); PG8_BAR; PG8_SCHED;
            PG8_LDB(B1, 0, 1); PG8_STAGE(PG8_SB(0, 0), b2, voffB);
            PG8_BAR; PG8_WAIT_L(0); PG8_MMA(0, 1, At, B1); PG8_BAR;
            PG8_LDA(At, 0, 1); PG8_STAGE(PG8_SA(0, 0), a2, voffA);
            PG8_BAR; PG8_WAIT_L(0); PG8_MMA(1, 0, At, B0); PG8_BAR; PG8_SCHED;
            PG8_STAGE(PG8_SB(0, 1), b2 + hstep, voffB);
            PG8_WAIT_V(6); PG8_BAR; PG8_MMA(1, 1, At, B1); PG8_BAR;
            PG8_LDB(B0, 1, 0); PG8_SCHED; PG8_LDA(At, 1, 0); PG8_STAGE(PG8_SA(0, 1), a2 + hstep, voffA);
            PG8_WAIT_L(8); PG8_BAR; PG8_WAIT_L(0); PG8_MMA(0, 0, At, B0); PG8_BAR; PG8_SCHED;
            PG8_LDB(B1, 1, 1); PG8_STAGE(PG8_SB(1, 0), b3, voffB);
            PG8_BAR; PG8_WAIT_L(0); PG8_MMA(0, 1, At, B1); PG8_BAR;
            PG8_LDA(At, 1, 1); PG8_STAGE(PG8_SA(1, 0), a3, voffA);
            PG8_BAR; PG8_WAIT_L(0); PG8_MMA(1, 0, At, B0); PG8_BAR; PG8_SCHED;
            PG8_STAGE(PG8_SB(1, 1), b3 + hstep, voffB);
            PG8_WAIT_V(6); PG8_BAR; PG8_MMA(1, 1, At, B1); PG8_BAR;
        }
        PG8_STAMP();
        PG8_ACC_FENCE();
        if constexpr (!Epi::AFTER_DRAIN) { E(acc, cur, wr, wc, fr, fq); S.done(cur); }
        PG8_STAMP();
        if (!has_next) break;
#pragma unroll
        for (int a = 0; a < 2; ++a)
#pragma unroll
            for (int b = 0; b < 2; ++b)
#pragma unroll
                for (int m = 0; m < 4; ++m)
#pragma unroll
                    for (int n = 0; n < 2; ++n) acc[a][b][m][n] = (f32x4){0.f, 0.f, 0.f, 0.f};
        cur = nxt; cA = nA; cB = nB; ++ui;
    }
    PG8_WAIT_V(0);
    if (wr == 0) PG8_BAR;
    PG8_BAR;
    if constexpr (Epi::AFTER_DRAIN) { E.fused(acc, cur, wr, wc, fr, fq, lds, wid, lane); S.done(cur); }
    PG8_STAMP();
    if (STAMP && wid == 0) { stamps[lane] = lane < nts ? (((unsigned long long)(unsigned)ts_hi << 32) | (unsigned)ts_lo) : 0ull;
        if (lane == 62) stamps[62] = rt_entry; if (lane == 63) stamps[63] = (unsigned long long)wall_clock64(); }
#undef PG8_STAMP
#undef PG8_SA
#undef PG8_SB
#undef PG8_STAGE
#undef PG8_LDA
#undef PG8_LDB
#undef PG8_MMA
#undef PG8_ACC_FENCE
#undef PG8_ACC_FENCE1
#undef PG8_WAIT_V
#undef PG8_WAIT_L
#undef PG8_BAR
#undef PG8_SCHED
}
}

#define XB_TMO      128
#define XB_XCNT(j)  (256  + 64 * (j))
#define XB_XSUB(j)  (1280 + 64 * (j))
#define XB_XGEN(j)  (2304 + 64 * (j))
#define XB_TOP      3328
#define XB_TOPGEN   3392
#define XCD_BAR_WORDS 3456
#define XB_SPIN_CAP (1u << 20)
#define LAS __attribute__((address_space(3)))

__device__ __forceinline__ unsigned xb_ld(unsigned* p)              { return __hip_atomic_load(p, __ATOMIC_RELAXED, __HIP_MEMORY_SCOPE_AGENT); }
__device__ __forceinline__ unsigned xb_add(unsigned* p, unsigned v) { return __hip_atomic_fetch_add(p, v, __ATOMIC_RELAXED, __HIP_MEMORY_SCOPE_AGENT); }
__device__ __forceinline__ unsigned xb_xcc_id() { return (unsigned)__builtin_amdgcn_s_getreg((3 << 11) | 20) & 0xFu; }
#define XB_SPIN(cond, bar) do { unsigned _sp = 0; while (cond) { __builtin_amdgcn_s_sleep(1); \
    if ((++_sp & 255u) == 0u) { if (xb_ld(&(bar)[XB_TMO])) break; if (_sp > XB_SPIN_CAP) { atomicAdd(&(bar)[XB_TMO], 1u); break; } } } } while (0)

struct XcdBarrier {
    unsigned* bar; unsigned x;
    volatile LAS unsigned* st;
};

__device__ __forceinline__ XcdBarrier xcd_barrier_post(unsigned* bar, volatile LAS unsigned* st) {
    XcdBarrier b; b.bar = bar; b.x = xb_xcc_id(); b.st = st;
    if (threadIdx.x == 0) (void)xb_add(&bar[XB_XCNT(b.x)], 1u);
    return b;
}
__device__ __forceinline__ void xcd_barrier_complete(unsigned* bar, unsigned x, unsigned& nloc, unsigned& nx) {
    const unsigned G = gridDim.x * gridDim.y * gridDim.z;
    unsigned sum, cnt, mine, sp = 0u;
    for (;;) {
        sum = 0u; cnt = 0u; mine = 0u;
#pragma unroll
        for (unsigned j = 0; j < 16; ++j) { const unsigned c = xb_ld(&bar[XB_XCNT(j)]); sum += c; cnt += (c > 0u) ? 1u : 0u; mine = (j == x) ? c : mine; }
        if (sum == G) break;
        __builtin_amdgcn_s_sleep(1);
        if ((++sp & 255u) == 0u) { if (xb_ld(&bar[XB_TMO])) break; if (sp > XB_SPIN_CAP) { atomicAdd(&bar[XB_TMO], 1u); break; } }
    }
    nloc = mine > 0u ? mine : 1u; nx = cnt > 0u ? cnt : 1u;
}

__device__ __forceinline__ void xcd_barrier(const XcdBarrier& b) {
    asm volatile("s_waitcnt vmcnt(0)" ::: "memory");
    __syncthreads();
    if (threadIdx.x == 0) {
        unsigned* bar = b.bar;
        __builtin_amdgcn_s_waitcnt(0);
        unsigned nloc = b.st[0], nx = b.st[1];
        if (nloc == 0u) { xcd_barrier_complete(bar, b.x, nloc, nx); b.st[0] = nloc; b.st[1] = nx; }
        const unsigned old = xb_add(&bar[XB_XSUB(b.x)], 1u);
        const unsigned gen = old / nloc;
        if (old + 1u == (gen + 1u) * nloc) {
            __builtin_amdgcn_fence(__ATOMIC_RELEASE, "agent");
            asm volatile("s_waitcnt vmcnt(0)" ::: "memory");
            const unsigned og = xb_add(&bar[XB_TOP], 1u);
            const unsigned tg = og / nx;
            if (og + 1u == (tg + 1u) * nx) xb_add(&bar[XB_TOPGEN], 1u);
            else XB_SPIN(xb_ld(&bar[XB_TOPGEN]) == tg, bar);
            __builtin_amdgcn_fence(__ATOMIC_ACQUIRE, "agent");
            xb_add(&bar[XB_XGEN(b.x)], 1u);
            asm volatile("s_waitcnt vmcnt(0)" ::: "memory");
        } else {
            XB_SPIN(xb_ld(&bar[XB_XGEN(b.x)]) == gen, bar);
            __builtin_amdgcn_fence(__ATOMIC_ACQUIRE, "agent");
            asm volatile("s_waitcnt vmcnt(0)" ::: "memory");
        }
    }
    __syncthreads();
}

typedef unsigned short bf16_t;
typedef short bf16x8 __attribute__((ext_vector_type(8)));
typedef short bf16x4 __attribute__((ext_vector_type(4)));
typedef float f32x2 __attribute__((ext_vector_type(2)));
typedef float f32x4 __attribute__((ext_vector_type(4)));
typedef float f32x16 __attribute__((ext_vector_type(16)));
typedef unsigned u32x4 __attribute__((ext_vector_type(4)));
typedef unsigned u32x2 __attribute__((ext_vector_type(2)));

constexpr int D = 2048, FF = 8192, MP = 4096, MS = 8192, MT = 12288;
constexpr int NPANEL = MT / 256;
constexpr size_t MiB = 1u << 20;
constexpr size_t WS_CTL = 0, WS_MOD = 1 * MiB, WS_ZERO_BYTES = 3 * MiB;
constexpr size_t WS_ROPE = 3 * MiB;
constexpr size_t WS_W1T = 4 * MiB, WS_W2T = 132 * MiB, WS_WQKVT = 260 * MiB, WS_WOT = 284 * MiB, WS_HYINT = 300 * MiB, WS_HYOUTT = 324 * MiB;
constexpr size_t WS_RWBT = 332 * MiB, WS_LORA2T = 359 * MiB, WS_RWOT = 364 * MiB, WS_KC = 372 * MiB, WS_VC = 380 * MiB, WS_FGS = 388 * MiB, WS_FGP = 397 * MiB;
constexpr size_t WS_X = 400 * MiB, WS_H = 496 * MiB, WS_ARENA = 544 * MiB, WS_INVSQ = 1186 * MiB, WS_END = 1188 * MiB;
constexpr size_t AR_U = 0;
constexpr size_t AR_Q = 0, AR_K = 48 * MiB, AR_V = 60 * MiB, AR_O = 72 * MiB;
constexpr size_t AR_P = 0, AR_X0 = 144 * MiB, AR_ZT = 192 * MiB, AR_YT = 240 * MiB, AR_HO = 288 * MiB;
constexpr size_t AR_XMIX = 0, AR_LD = 546 * MiB  , AR_LA = 96 * MiB, AR_G = 192 * MiB, AR_RO = 240 * MiB, AR_R = 288 * MiB, AR_KK = 336 * MiB, AR_VV = 384 * MiB, AR_A3 = 432 * MiB, AR_YB = 450 * MiB;
constexpr size_t OUT_Y = 0, OUT_NK = 25165824, OUT_NV = 29360128, OUT_ST = 33554432;
constexpr int FGS_ROW = 2112, FGP_ROW = 576;
constexpr size_t AR_FILT = 600 * MiB;
constexpr int LDS_BAR_OFF = 147456, LDS_BYTES = 147456 + 1024;

enum { I_XP = 0, I_XS, I_CK, I_CV, I_ST, I_C, I_CCTX, I_ADAW, I_ADAB, I_N1G, I_N2G, I_MW1, I_MW2, I_WQKV, I_WO, I_SINK, I_HYWIN, I_HYCW, I_HYCB, I_FW1, I_FB1, I_FW2, I_FB2, I_FW3, I_FB3,
       I_FREQ, I_FWOUT, I_HYBIAS, I_HYWOUT, I_MU, I_WR, I_WK, I_WV, I_RWO, I_W0, I_W1, I_W2, I_A0, I_A1, I_A2, I_G1, I_G2, I_KK, I_KA, I_RK, I_LNW, I_LNB, I_FNG, N_IN };

struct Params { const float* in[N_IN]; float* out; unsigned char* ws; int ph_lo, ph_hi; };

__device__ __forceinline__ unsigned cvt_pk(float lo, float hi) { unsigned r; asm("v_cvt_pk_bf16_f32 %0, %1, %2" : "=v"(r) : "v"(lo), "v"(hi)); return r; }
__device__ __forceinline__ float bflo(unsigned w) { return __uint_as_float(w << 16); }
__device__ __forceinline__ float bfhi(unsigned w) { return __uint_as_float(w & 0xffff0000u); }
__device__ __forceinline__ float bf2f(bf16_t b) { return __uint_as_float(((unsigned)b) << 16); }
__device__ __forceinline__ float dpp_f(float x, const int ctrl) { return x; }
#define DPP_ADD(x, ctrl) ((x) + __int_as_float(__builtin_amdgcn_update_dpp(0, __float_as_int(x), (ctrl), 0xF, 0xF, true)))
__device__ __forceinline__ float wave_sum(float v) {
    v = DPP_ADD(v, 0xB1); v = DPP_ADD(v, 0x4E); v = DPP_ADD(v, 0x141); v = DPP_ADD(v, 0x140);
    const int vi = __float_as_int(v);
    const float r0 = __int_as_float(__builtin_amdgcn_readlane(vi, 0)), r1 = __int_as_float(__builtin_amdgcn_readlane(vi, 16)),
                r2 = __int_as_float(__builtin_amdgcn_readlane(vi, 32)), r3 = __int_as_float(__builtin_amdgcn_readlane(vi, 48));
    return (r0 + r1) + (r2 + r3);
}
__device__ __forceinline__ float opaque_zero() { float z; asm volatile("v_mov_b32 %0, 0" : "=v"(z)); return z; }
__device__ __forceinline__ float fexp2(float x) { return __builtin_amdgcn_exp2f(x); }
__device__ __forceinline__ float fexp(float x) { return __builtin_amdgcn_exp2f(x * 1.4426950408889634f); }
__device__ __forceinline__ float flog(float x) { return __builtin_amdgcn_logf(x) * 0.6931471805599453f; }
__device__ __forceinline__ float frcp(float x) { return __builtin_amdgcn_rcpf(x); }
__device__ __forceinline__ float fsigmoid(float x) { return frcp(1.0f + fexp(-x)); }
__device__ __forceinline__ float ftanh(float x) { const float e = fexp(2.0f * x); return 1.0f - 2.0f * frcp(e + 1.0f); }
__device__ __forceinline__ float fsoftplus(float x) { return fmaxf(x, 0.0f) + flog(1.0f + fexp(-fabsf(x))); }
__device__ __forceinline__ float fsin_rev(float rev) { return __builtin_amdgcn_sinf(rev - rintf(rev)); }
__device__ __forceinline__ float fcos_rev(float rev) { return __builtin_amdgcn_cosf(rev - rintf(rev)); }
__device__ __forceinline__ float fsin(float x) { return fsin_rev(x * 0.15915494309189535f); }
__device__ __forceinline__ int cond_of_row(int m) { return m < MP ? 0 : 1 + ((m - MP) >> 10); }
__device__ __forceinline__ int cond_of_panel(int pm) { return pm < 16 ? 0 : 1 + ((pm - 16) >> 2); }

struct Ctx {
    LAS unsigned char* lds;
    int tid, lane, wave, G, bid;
    float* out;
    unsigned char* ws;
};
template <int IDX> __device__ __forceinline__ const float* karg() {
    unsigned long long v;
    asm volatile("s_load_dwordx2 %0, %1, %2\n\ts_waitcnt lgkmcnt(0)" : "=s"(v) : "s"(__builtin_amdgcn_kernarg_segment_ptr()), "n"(IDX * 8));
    return (const float*)v;
}
#define WSP(T, off) ((T*)(C.ws + (off)))
#define MODP(l, cond, which) (WSP(float, WS_MOD) + ((size_t)((l) * 9 + (cond)) * 6 + (which)) * D)

__device__ __forceinline__ void p0_transpose_item(const float* W, int K, int N, bf16_t* WT, LAS float* scr, int item, int lane) {
    const int nblk = N / 32, kb = item / nblk, nb = item % nblk, k0 = 64 * kb, n0 = 32 * nb;
    const int rsub = lane >> 3, c4 = (lane & 7) * 4;
    f32x4 v[8];
#pragma unroll
    for (int i = 0; i < 8; ++i) v[i] = *(const f32x4*)(W + (size_t)(k0 + 8 * i + rsub) * N + n0 + c4);
#pragma unroll
    for (int i = 0; i < 8; ++i) { LAS float* d = scr + (8 * i + rsub) * 33 + c4; d[0] = v[i].x; d[1] = v[i].y; d[2] = v[i].z; d[3] = v[i].w; }
    asm volatile("s_waitcnt lgkmcnt(0)" ::: "memory");
    const int c = lane & 7;
#pragma unroll
    for (int j = 0; j < 4; ++j) { const int n = (lane >> 3) + 8 * j; const LAS float* s = scr + (8 * c) * 33 + n;
        u32x4 o; o.x = cvt_pk(s[0 * 33], s[1 * 33]); o.y = cvt_pk(s[2 * 33], s[3 * 33]); o.z = cvt_pk(s[4 * 33], s[5 * 33]); o.w = cvt_pk(s[6 * 33], s[7 * 33]);
        *(u32x4*)(WT + (size_t)(n0 + n) * K + k0 + 8 * c) = o; }
    asm volatile("s_waitcnt lgkmcnt(0)" ::: "memory");
}

__device__ __forceinline__ void late_transposes(const Ctx& C, LAS float* scr, int wv, int nwv) {
    constexpr int I_M = 8192, I_QKV = 3072, I_O = 2048;
    constexpr int NIT = 4 * I_M + I_QKV + I_O;
    for (int it = wv; it < NIT; it += nwv) {
        int r = it;
        if (r < 2 * I_M) { const int l = 2 + r / I_M; p0_transpose_item(karg<I_MW1>() + (size_t)l * D * FF, D, FF, WSP(bf16_t, WS_W1T) + (size_t)l * D * FF, scr, r % I_M, C.lane); continue; } r -= 2 * I_M;
        if (r < 2 * I_M) { const int l = 2 + r / I_M; p0_transpose_item(karg<I_MW2>() + (size_t)l * D * FF, FF, D, WSP(bf16_t, WS_W2T) + (size_t)l * D * FF, scr, r % I_M, C.lane); continue; } r -= 2 * I_M;
        if (r < I_QKV) { p0_transpose_item(karg<I_WQKV>() + (size_t)D * 3072, D, 3072, WSP(bf16_t, WS_WQKVT) + (size_t)D * 3072, scr, r, C.lane); continue; } r -= I_QKV;
        p0_transpose_item(karg<I_WO>() + (size_t)D * D, D, D, WSP(bf16_t, WS_WOT) + (size_t)D * D, scr, r, C.lane);
    }
}
#ifndef MK_PRO_MASK
#define MK_PRO_MASK 127
#endif
__device__ __forceinline__ void phase_prologue(const Ctx& C) {
    const int gw = C.bid * 8 + C.wave, NGW = C.G * 8, lane = C.lane;
    const size_t gt = (size_t)C.bid * 512 + C.tid, NGT = (size_t)C.G * 512;
    LAS float* scr = (LAS float*)(C.lds + C.wave * 16384);
    if (MK_PRO_MASK & 1)
    {
        constexpr int I_M1 = 8192, I_M2 = 8192, I_QKV = 3072, I_O = 2048, I_HI = 6144, I_SQ = 2048;
        constexpr int NIT = 2 * I_M1 + 2 * I_M2 + I_QKV + I_O + I_HI + I_SQ + 4 * I_SQ;
        for (int it = gw; it < NIT; it += NGW) {
            int r = it;
            if (r < 2 * I_M1) { const int l = r / I_M1; p0_transpose_item(karg<I_MW1>() + (size_t)l * D * FF, D, FF, WSP(bf16_t, WS_W1T) + (size_t)l * D * FF, scr, r % I_M1, lane); continue; } r -= 2 * I_M1;
            if (r < 2 * I_M2) { const int l = r / I_M2; p0_transpose_item(karg<I_MW2>() + (size_t)l * D * FF, FF, D, WSP(bf16_t, WS_W2T) + (size_t)l * D * FF, scr, r % I_M2, lane); continue; } r -= 2 * I_M2;
            if (r < I_QKV) { p0_transpose_item(karg<I_WQKV>(), D, 3072, WSP(bf16_t, WS_WQKVT), scr, r, lane); continue; } r -= I_QKV;
            if (r < I_O) { p0_transpose_item(karg<I_WO>(), D, D, WSP(bf16_t, WS_WOT), scr, r, lane); continue; } r -= I_O;
            if (r < I_HI) { p0_transpose_item(karg<I_HYWIN>(), D, 6144, WSP(bf16_t, WS_HYINT), scr, r, lane); continue; } r -= I_HI;
            if (r < I_SQ) { p0_transpose_item(karg<I_HYWOUT>(), D, D, WSP(bf16_t, WS_HYOUTT), scr, r, lane); continue; } r -= I_SQ;
            if (r < I_SQ) { p0_transpose_item(karg<I_WR>(), D, D, WSP(bf16_t, WS_RWBT), scr, r, lane); continue; } r -= I_SQ;
            if (r < I_SQ) { p0_transpose_item(karg<I_WK>(), D, D, WSP(bf16_t, WS_RWBT) + (size_t)D * D, scr, r, lane); continue; } r -= I_SQ;
            if (r < I_SQ) { p0_transpose_item(karg<I_WV>(), D, D, WSP(bf16_t, WS_RWBT) + (size_t)2 * D * D, scr, r, lane); continue; } r -= I_SQ;
            p0_transpose_item(karg<I_RWO>(), D, D, WSP(bf16_t, WS_RWOT), scr, r, lane);
        }
    }
    if (MK_PRO_MASK & 2)
    {
        bf16_t* L1 = WSP(bf16_t, WS_RWBT) + (size_t)3 * D * D;
#pragma unroll
        for (int part = 0; part < 7; ++part) {
            const int row0 = part == 0 ? 0 : part == 1 ? 96 : part == 2 ? 192 : part == 3 ? 256 : part == 4 ? 352 : part == 5 ? 448 : 512;
            const int nrow = (part == 2 || part == 5) ? 64 : (part == 6 ? 256 : 96);
            const int ld = part == 6 ? 256 : 96;
            const float* src = part == 0 ? karg<I_W1>() : part == 1 ? karg<I_W1>() + (size_t)D * 96 : part == 3 ? karg<I_A1>() : part == 4 ? karg<I_A1>() + (size_t)D * 96 : karg<I_G1>();
            const bool zero = (part == 2 || part == 5);
            for (size_t i = gt; i < (size_t)nrow * 256; i += NGT) {
                const int rr = (int)(i / 256), k8 = (int)(i % 256);
                float v[8];
#pragma unroll
                for (int j = 0; j < 8; ++j) v[j] = zero ? 0.0f : src[(size_t)(8 * k8 + j) * ld + rr];
                u32x4 o; o.x = cvt_pk(v[0], v[1]); o.y = cvt_pk(v[2], v[3]); o.z = cvt_pk(v[4], v[5]); o.w = cvt_pk(v[6], v[7]);
                *(u32x4*)(L1 + (size_t)(row0 + rr) * D + 8 * k8) = o;
            }
        }
        bf16_t* L2 = WSP(bf16_t, WS_LORA2T);
#pragma unroll
        for (int mat = 0; mat < 5; ++mat) {
            const float* src = mat == 0 ? karg<I_W2>() : mat == 1 ? karg<I_W2>() + (size_t)96 * D : mat == 2 ? karg<I_A2>() : mat == 3 ? karg<I_A2>() + (size_t)96 * D : karg<I_G2>();
            const int kofs = (mat == 1 || mat == 3) ? 96 : 0, klen = mat == 4 ? 256 : 96;
            for (size_t i = gt; i < (size_t)2048 * 32; i += NGT) {
                const int n = (int)(i / 32), k8 = (int)(i % 32);
                float v[8];
#pragma unroll
                for (int j = 0; j < 8; ++j) { const int k = 8 * k8 + j - kofs; const int kc = k < 0 ? 0 : (k >= klen ? klen - 1 : k); const float x = src[(size_t)kc * D + n]; v[j] = (k >= 0 && k < klen) ? x : 0.0f; }
                u32x4 o; o.x = cvt_pk(v[0], v[1]); o.y = cvt_pk(v[2], v[3]); o.z = cvt_pk(v[4], v[5]); o.w = cvt_pk(v[6], v[7]);
                *(u32x4*)(L2 + ((size_t)mat * 2048 + n) * 256 + 8 * k8) = o;
            }
        }
    }
    if (MK_PRO_MASK & 4)
    for (size_t i = gt; i < 2048; i += NGT) {
        const int pos = (int)(i >> 5), fi = (int)(i & 31);
        const float inv = fexp2(-(float)(2 * fi) * (13.287712379549449f / 64.0f));
        const float rev = (float)pos * inv * 0.15915494309189535f;
        WSP(f32x2, WS_ROPE)[i] = (f32x2){fcos_rev(rev), fsin_rev(rev)};
    }
    for (size_t i = gt; i < (size_t)MT * 32 / 4; i += NGT) WSP(f32x4, WS_INVSQ)[i] = (f32x4){0.f, 0.f, 0.f, 0.f};
    if (MK_PRO_MASK & 8)
    { const float *ckp = karg<I_CK>(), *cvp = karg<I_CV>();
    for (size_t i = gt; i < (size_t)2 * 524288; i += NGT) {
        const bool isv = i >= 524288; const size_t e = (isv ? i - 524288 : i) * 8;
        const float* src = (isv ? cvp : ckp) + e;
        const f32x4 a = *(const f32x4*)src, b = *(const f32x4*)(src + 4);
        u32x4 o; o.x = cvt_pk(a.x, a.y); o.y = cvt_pk(a.z, a.w); o.z = cvt_pk(b.x, b.y); o.w = cvt_pk(b.z, b.w);
        *(u32x4*)(WSP(bf16_t, isv ? WS_VC : WS_KC) + e) = o;
    } }
    if (MK_PRO_MASK & 32)
    {
        __syncthreads();
        LAS float* tab = (LAS float*)C.lds;
        LAS float* red = (LAS float*)(C.lds + 73728);
        const float *cctx = karg<I_CCTX>(), *cc = karg<I_C>();
        for (int e = C.tid; e < 9 * D; e += 512) { const int j = e >> 11, k = e & (D - 1);
            const float cv = j == 0 ? cctx[k] : cc[(size_t)(j == 0 ? 0 : j - 1) * D + k]; tab[e] = cv * fsigmoid(cv); }
        __syncthreads();
        const float* adaw = karg<I_ADAW>(); const float* adab = karg<I_ADAB>();
        for (int it = C.bid; it < 4 * 192; it += C.G) {
            const int nb = it % 192, l = it / 192, w = C.wave;
            float acc[9];
#pragma unroll
            for (int j = 0; j < 9; ++j) acc[j] = 0.f;
            const float* wp = adaw + ((size_t)l * D + 256 * w) * (6 * D) + nb * 64 + lane;
#pragma unroll 4
            for (int k4 = 0; k4 < 256; k4 += 4) {
                const float w0 = wp[(size_t)(k4 + 0) * (6 * D)], w1 = wp[(size_t)(k4 + 1) * (6 * D)], w2 = wp[(size_t)(k4 + 2) * (6 * D)], w3 = wp[(size_t)(k4 + 3) * (6 * D)];
#pragma unroll
                for (int j = 0; j < 9; ++j) { const f32x4 sv = *(const LAS f32x4*)(tab + j * D + 256 * w + k4); acc[j] += (w0 * sv.x + w1 * sv.y) + (w2 * sv.z + w3 * sv.w); }
            }
#pragma unroll
            for (int j = 0; j < 9; ++j) red[(w * 9 + j) * 64 + lane] = acc[j];
            __syncthreads();
            for (int e = C.tid; e < 9 * 64; e += 512) { const int j = e >> 6, c = e & 63; float sum = adab[(size_t)l * 6 * D + nb * 64 + c];
#pragma unroll
                for (int ww = 0; ww < 8; ++ww) sum += red[(ww * 9 + j) * 64 + c];
                WSP(float, WS_MOD)[((size_t)l * 9 + j) * 6 * D + nb * 64 + c] = sum; }
            __syncthreads();
        }
    }
    if (MK_PRO_MASK & 64)
    {
        const float *fw1 = karg<I_FW1>(), *fw2 = karg<I_FW2>(), *fw3 = karg<I_FW3>(), *fwout = karg<I_FWOUT>(), *hbias = karg<I_HYBIAS>();
        const float fq = karg<I_FREQ>()[lane]; const float fb1 = karg<I_FB1>()[lane], fb2 = karg<I_FB2>()[lane], fb3 = karg<I_FB3>()[lane];
        for (int it = C.bid; it < 160; it += C.G) {
            const bool smp = it >= 32; const int nbase = (smp ? it - 32 : it) * 8; const int L = smp ? 1024 : 256; const int n = nbase + C.wave;
            float* FILT = WSP(float, WS_ARENA + AR_FILT) + (smp ? 0 : (size_t)1024 * 4096);
            __syncthreads();
            if (lane < 33) {
                float z;
                if (lane == 0) z = (float)n / (float)(L - 1);
                else { const int i = (lane - 1) & 15; const float fr = 1e-4f + (float)i * ((15.0f - 1e-4f) / 15.0f); const float rev = fr * (float)n / (float)L;
                       z = lane <= 16 ? fcos_rev(rev) : -fsin_rev(rev); }
                scr[lane] = z;
            }
            asm volatile("s_waitcnt lgkmcnt(0)" ::: "memory");
            float pre = fb1;
#pragma unroll 3
            for (int e = 0; e < 33; ++e) pre += scr[e] * fw1[e * 64 + lane];
            float hv = fsin(fq * pre);
            asm volatile("s_waitcnt lgkmcnt(0)" ::: "memory");
            scr[64 + lane] = hv;
            asm volatile("s_waitcnt lgkmcnt(0)" ::: "memory");
            pre = fb2;
#pragma unroll 4
            for (int e = 0; e < 64; ++e) pre += scr[64 + e] * fw2[e * 64 + lane];
            hv = fsin(fq * pre);
            asm volatile("s_waitcnt lgkmcnt(0)" ::: "memory");
            scr[128 + lane] = hv;
            asm volatile("s_waitcnt lgkmcnt(0)" ::: "memory");
            pre = fb3;
#pragma unroll 4
            for (int e = 0; e < 64; ++e) pre += scr[128 + e] * fw3[e * 64 + lane];
            hv = fsin(fq * pre);
            scr[1024 + lane] = hv;
            __syncthreads();
            float acc[8][8];
#pragma unroll
            for (int nn = 0; nn < 8; ++nn)
#pragma unroll
                for (int i = 0; i < 8; ++i) acc[nn][i] = 0.f;
            const float* wo = fwout + 512 * C.wave + lane;
#pragma unroll 2
            for (int e = 0; e < 64; ++e) {
                float wv[8];
#pragma unroll
                for (int i = 0; i < 8; ++i) wv[i] = wo[(size_t)e * 4096 + i * 64];
#pragma unroll
                for (int nn = 0; nn < 8; ++nn) { const float hh = ((const LAS float*)(C.lds + nn * 16384))[1024 + e];
#pragma unroll
                    for (int i = 0; i < 8; ++i) acc[nn][i] += hh * wv[i]; }
            }
#pragma unroll
            for (int nn = 0; nn < 8; ++nn) { const int n2 = nbase + nn; const float tn = (float)n2 / (float)(L - 1);
#pragma unroll
                for (int i = 0; i < 8; ++i) {
                    const int o = 512 * C.wave + i * 64 + lane, dir = o >> 11, c = o & 2047;
                    const float delta = -3.0701134573253944f + (float)c * ((-15.350567286626972f + 3.0701134573253944f) / 2047.0f);
                    float val = acc[nn][i] * fexp(-tn * fabsf(delta));
                    if (dir == 0 && n2 == 0) val += hbias[c];
                    FILT[(size_t)n2 * 4096 + o] = val;
                } }
        }
        __syncthreads();
    }
}

__device__ __forceinline__ void phase_fg_transpose(const Ctx& C) {
    const int tid = C.tid;
    LAS float* tl = (LAS float*)C.lds;
    for (int it = C.bid; it < 1280; it += C.G) {
        const bool smp = it < 1024; const int q = smp ? it : it - 1024;
        const int L = smp ? 1024 : 256, ROW = smp ? FGS_ROW : FGP_ROW;
        const int cbk = q & 31, nb = smp ? (q >> 5) & 15 : (q >> 5) & 3, dir = smp ? q >> 9 : q >> 7;
        const float* FILT = WSP(float, WS_ARENA + AR_FILT) + (smp ? 0 : (size_t)1024 * 4096);
        bf16_t* FG = WSP(bf16_t, smp ? WS_FGS : WS_FGP);
        const int n0 = nb * 64 + dir;
        __syncthreads();
        { const int nl = tid >> 3, c8 = tid & 7; const int n = n0 + nl;
          f32x4 a = (f32x4){0.f, 0.f, 0.f, 0.f}, b = a;
          const int nc = n < L ? n : L - 1;
          const float* src = FILT + (size_t)nc * 4096 + dir * 2048 + cbk * 64 + 8 * c8;
          a = *(const f32x4*)src; b = *(const f32x4*)(src + 4);
          if (n >= L) { a = (f32x4){0.f, 0.f, 0.f, 0.f}; b = a; }
          LAS float* d = tl + nl * 65 + 8 * c8;
          d[0] = a.x; d[1] = a.y; d[2] = a.z; d[3] = a.w; d[4] = b.x; d[5] = b.y; d[6] = b.z; d[7] = b.w; }
        __syncthreads();
        { const int cl = tid >> 3, i8 = tid & 7;
          float v[8];
#pragma unroll
          for (int j = 0; j < 8; ++j) { const int il = 8 * i8 + j; const int nl = dir ? il : 63 - il; v[j] = tl[nl * 65 + cl]; }
          const int idx0 = dir ? (L + nb * 64) : (L - 64 - nb * 64);
          u32x4 o; o.x = cvt_pk(v[0], v[1]); o.y = cvt_pk(v[2], v[3]); o.z = cvt_pk(v[4], v[5]); o.w = cvt_pk(v[6], v[7]);
          bf16_t* dst = FG + (size_t)(cbk * 64 + cl) * ROW;
          *(u32x4*)(dst + idx0 + 8 * i8) = o;
          if (dir && nb * 64 + 64 == L) *(u32x4*)(dst + 2 * L + 8 * i8) = (u32x4){0u, 0u, 0u, 0u}; }
    }
    __syncthreads();
}

__device__ __forceinline__ void phase_norm_mod(const Ctx& C, const float* Xp, const float* Xs, const float* g, int layer, int which_sh, bf16_t* H, const bf16_t* P1 = nullptr, float* Xw = nullptr) {
    const int gw = C.bid * 8 + C.wave, NGW = C.G * 8, lane = C.lane;
    for (int m = gw; m < MT; m += NGW) {
        const int cond = cond_of_row(m);
        const float* sh = MODP(layer, cond, which_sh); const float* sc = MODP(layer, cond, which_sh + 1);
        const f32x4* xr = (const f32x4*)(m < MP ? Xp + (size_t)m * D : Xs + (size_t)(m - MP) * D) + lane;
        f32x4 v[8]; float ss = 0.f;
#pragma unroll
        for (int j = 0; j < 8; ++j) { v[j] = xr[64 * j]; if (P1) { const u32x2 pw = ((const u32x2*)(P1 + (size_t)m * D) + lane)[64 * j]; v[j] += (f32x4){bflo(pw.x), bfhi(pw.x), bflo(pw.y), bfhi(pw.y)}; ((f32x4*)(Xw + (size_t)m * D) + lane)[64 * j] = v[j]; }
            ss += (v[j].x * v[j].x + v[j].y * v[j].y) + (v[j].z * v[j].z + v[j].w * v[j].w); }
        const float rstd = __builtin_amdgcn_rsqf(wave_sum(ss) * (1.0f / D) + 1e-6f);
        u32x2* o = (u32x2*)(H + (size_t)m * D) + lane;
#pragma unroll
        for (int j = 0; j < 8; ++j) {
            const f32x4 gv = ((const f32x4*)g)[lane + 64 * j], sv = ((const f32x4*)sh)[lane + 64 * j], cv = ((const f32x4*)sc)[lane + 64 * j];
            const f32x4 y = (v[j] * rstd * gv) * (cv + 1.0f) + sv;
            u32x2 w; w.x = cvt_pk(y.x, y.y); w.y = cvt_pk(y.z, y.w); o[64 * j] = w;
        }
    }
}
__device__ __forceinline__ void phase_norm_final(const Ctx& C, const float* X, const float* g, float* out, const bf16_t* P1 = nullptr) {
    const int gw = C.bid * 8 + C.wave, NGW = C.G * 8, lane = C.lane;
    for (int m = gw; m < MT; m += NGW) {
        const f32x4* xr = (const f32x4*)(X + (size_t)m * D) + lane;
        f32x4 v[8]; float ss = 0.f;
#pragma unroll
        for (int j = 0; j < 8; ++j) { v[j] = xr[64 * j]; if (P1) { const u32x2 pw = ((const u32x2*)(P1 + (size_t)m * D) + lane)[64 * j]; v[j] += (f32x4){bflo(pw.x), bfhi(pw.x), bflo(pw.y), bfhi(pw.y)}; } ss += (v[j].x * v[j].x + v[j].y * v[j].y) + (v[j].z * v[j].z + v[j].w * v[j].w); }
        const float rstd = __builtin_amdgcn_rsqf(wave_sum(ss) * (1.0f / D) + 1e-6f);
        f32x4* o = (f32x4*)(out + (size_t)m * D) + lane;
#pragma unroll
        for (int j = 0; j < 8; ++j) o[64 * j] = v[j] * rstd * ((const f32x4*)g)[lane + 64 * j];
    }
}

__device__ __forceinline__ void unpack8(const u32x4 w, float (&f)[8]) { f[0] = bflo(w.x); f[1] = bfhi(w.x); f[2] = bflo(w.y); f[3] = bfhi(w.y); f[4] = bflo(w.z); f[5] = bfhi(w.z); f[6] = bflo(w.w); f[7] = bfhi(w.w); }
__device__ __forceinline__ u32x4 pack8(const float (&f)[8]) { u32x4 o; o.x = cvt_pk(f[0], f[1]); o.y = cvt_pk(f[2], f[3]); o.z = cvt_pk(f[4], f[5]); o.w = cvt_pk(f[6], f[7]); return o; }
__device__ __forceinline__ void phase_norm_mod_b(const Ctx& C, const bf16_t* X, const float* g, int layer, int which_sh, bf16_t* H, const bf16_t* P1 = nullptr, bf16_t* Xw = nullptr, int p1_row0 = 0) {
    const int gw = C.bid * 8 + C.wave, NGW = C.G * 8, lane = C.lane;
    f32x4 gv[4][2];
#pragma unroll
    for (int j = 0; j < 4; ++j)
#pragma unroll
        for (int h = 0; h < 2; ++h) gv[j][h] = ((const f32x4*)g)[2 * (lane + 64 * j) + h];
    u32x4 xa[4], pa[4]; f32x4 sv[4][2], cv[4][2];
#define NM_LOAD(m_) do { const int cond_ = cond_of_row(m_); const f32x4* sh_ = (const f32x4*)MODP(layer, cond_, which_sh); const f32x4* sc_ = (const f32x4*)MODP(layer, cond_, which_sh + 1); \
        _Pragma("unroll") for (int j = 0; j < 4; ++j) { xa[j] = ((const u32x4*)(X + (size_t)(m_) * D) + lane)[64 * j]; if (P1 && (m_) >= p1_row0) pa[j] = ((const u32x4*)(P1 + (size_t)(m_) * D) + lane)[64 * j]; } \
        _Pragma("unroll") for (int j = 0; j < 4; ++j) { _Pragma("unroll") for (int h = 0; h < 2; ++h) { const int ci_ = 2 * (lane + 64 * j) + h; sv[j][h] = sh_[ci_]; cv[j][h] = sc_[ci_]; } } } while (0)
    int m = gw;
    if (m < MT) NM_LOAD(m);
    for (; m < MT; m += NGW) {
        const bool fold = P1 && m >= p1_row0;
        float v[4][8]; float ss = 0.f;
#pragma unroll
        for (int j = 0; j < 4; ++j) {
            unpack8(xa[j], v[j]);
            if (fold) { float p[8]; unpack8(pa[j], p);
#pragma unroll
                for (int e = 0; e < 8; ++e) v[j][e] += p[e]; }
#pragma unroll
            for (int e = 0; e < 8; ++e) ss += v[j][e] * v[j][e];
        }
        const float rstd = __builtin_amdgcn_rsqf(wave_sum(ss) * (1.0f / D) + 1e-6f);
        u32x4 xo[4], ho[4];
#pragma unroll
        for (int j = 0; j < 4; ++j) {
            if (fold) xo[j] = pack8(v[j]);
            float y[8];
#pragma unroll
            for (int h = 0; h < 2; ++h)
#pragma unroll
                for (int e = 0; e < 4; ++e) y[4 * h + e] = (v[j][4 * h + e] * rstd * gv[j][h][e]) * (cv[j][h][e] + 1.0f) + sv[j][h][e];
            ho[j] = pack8(y);
        }
        const int mn = m + NGW;
        if (mn < MT) NM_LOAD(mn);
        asm volatile("" ::: "memory");
#pragma unroll
        for (int j = 0; j < 4; ++j) { if (fold) ((u32x4*)(Xw + (size_t)m * D) + lane)[64 * j] = xo[j]; ((u32x4*)(H + (size_t)m * D) + lane)[64 * j] = ho[j]; }
    }
#undef NM_LOAD
}
__device__ __forceinline__ void phase_norm_final_b(const Ctx& C, const bf16_t* X, const float* g, float* out, const bf16_t* P1 = nullptr, int p1_row0 = 0) {
    const int gw = C.bid * 8 + C.wave, NGW = C.G * 8, lane = C.lane;
    for (int m = gw; m < MT; m += NGW) {
        const u32x4* xr = (const u32x4*)(X + (size_t)m * D) + lane;
        float v[4][8]; float ss = 0.f;
#pragma unroll
        for (int j = 0; j < 4; ++j) {
            unpack8(xr[64 * j], v[j]);
            if (P1 && m >= p1_row0) { float p[8]; unpack8(((const u32x4*)(P1 + (size_t)m * D) + lane)[64 * j], p);
#pragma unroll
                for (int e = 0; e < 8; ++e) v[j][e] += p[e]; }
#pragma unroll
            for (int e = 0; e < 8; ++e) ss += v[j][e] * v[j][e];
        }
        const float rstd = __builtin_amdgcn_rsqf(wave_sum(ss) * (1.0f / D) + 1e-6f);
        f32x4* o = (f32x4*)(out + (size_t)m * D);
#pragma unroll
        for (int j = 0; j < 4; ++j)
#pragma unroll
            for (int h = 0; h < 2; ++h) {
                const int ci = 2 * (lane + 64 * j) + h;
                const f32x4 gv = ((const f32x4*)g)[ci];
                f32x4 y;
#pragma unroll
                for (int e = 0; e < 4; ++e) y[e] = v[j][4 * h + e] * rstd * gv[e];
                o[ci] = y;
            }
    }
}

using pg8::Unit;
constexpr int HALF = 128;

struct EpiResidual {
    static constexpr bool PERM = false, AFTER_DRAIN = false;
    float* X; const float* gate_base;
    const float *Bp, *Bs;
    __device__ __forceinline__ void operator()(const f32x4 (&acc)[2][2][4][2], const Unit& u, int wr, int wc, int fr, int fq) const {
        const int row0 = u.pm * 256 + wr * 64 + fr, col0 = u.pn * 256 + wc * 32 + 4 * fq;
        const float* gp = gate_base + (size_t)cond_of_panel(u.pm) * 6 * D + col0;
        f32x4 gv[2][2];
#pragma unroll
        for (int bj = 0; bj < 2; ++bj)
#pragma unroll
            for (int n = 0; n < 2; ++n) gv[bj][n] = *(const f32x4*)(gp + bj * HALF + n * 16);
        const float* sbase = (u.pm < 16 ? Bp + (size_t)row0 * D : Bs + (size_t)(row0 - MP) * D) + col0;
#pragma unroll
        for (int ai = 0; ai < 2; ++ai) {
            f32x4 q[4][2][2];
#pragma unroll
            for (int m = 0; m < 4; ++m)
#pragma unroll
                for (int bj = 0; bj < 2; ++bj)
#pragma unroll
                    for (int n = 0; n < 2; ++n) if ((u.mask >> (ai * 2 + bj)) & 1) q[m][bj][n] = *(const f32x4*)(sbase + (size_t)(ai * HALF + m * 16) * D + bj * HALF + n * 16);
#pragma unroll
            for (int m = 0; m < 4; ++m) { float* rowp = X + (size_t)(row0 + ai * HALF + m * 16) * D + col0;
#pragma unroll
                for (int bj = 0; bj < 2; ++bj)
#pragma unroll
                    for (int n = 0; n < 2; ++n) if ((u.mask >> (ai * 2 + bj)) & 1) *(f32x4*)(rowp + bj * HALF + n * 16) = q[m][bj][n] + gv[bj][n] * acc[ai][bj][m][n]; }
            asm volatile("" ::: "memory");
        }
    }
};
template <int ACT> struct EpiBf16 {
    static constexpr bool PERM = true, AFTER_DRAIN = false;
    bf16_t* O; int ldc;
    __device__ __forceinline__ void operator()(const f32x4 (&acc)[2][2][4][2], const Unit& u, int wr, int wc, int fr, int fq) const {
        const int row0 = u.pm * 256 + wr * 64 + fr, col0 = u.pn * 256 + wc * 32 + 8 * fq;
#pragma unroll
        for (int ai = 0; ai < 2; ++ai)
#pragma unroll
            for (int m = 0; m < 4; ++m) { bf16_t* rowp = O + (size_t)(row0 + ai * HALF + m * 16) * ldc + col0;
#pragma unroll
                for (int bj = 0; bj < 2; ++bj) { if (!((u.mask >> (ai * 2 + bj)) & 1)) continue; f32x4 v0 = acc[ai][bj][m][0], v1 = acc[ai][bj][m][1];
                    if (ACT == 1) {
#pragma unroll
                        for (int j = 0; j < 4; ++j) { const float a = fmaxf(v0[j], 0.f), b = fmaxf(v1[j], 0.f); v0[j] = a * a; v1[j] = b * b; } }
                    u32x4 w; w.x = cvt_pk(v0[0], v0[1]); w.y = cvt_pk(v0[2], v0[3]); w.z = cvt_pk(v1[0], v1[1]); w.w = cvt_pk(v1[2], v1[3]);
                    *(u32x4*)(rowp + bj * HALF) = w; } }
    }
};
struct EpiQKV {
    static constexpr bool PERM = true, AFTER_DRAIN = false;
    bf16_t *Q, *K, *V; float *NK, *NV;
    __device__ __forceinline__ void operator()(const f32x4 (&acc)[2][2][4][2], const Unit& u, int wr, int wc, int fr, int fq) const {
        const int row0 = u.pm * 256 + wr * 64 + fr; const int cin = wc * 32 + 8 * fq;
        bf16_t* base; int ldc, colt; float* fo = nullptr;
        if (u.pn < 8) { base = Q; ldc = 2048; colt = u.pn * 256; }
        else if (u.pn < 10) { base = K; ldc = 512; colt = (u.pn - 8) * 256; if (u.pm < 16) fo = NK; }
        else { base = V; ldc = 512; colt = (u.pn - 10) * 256; if (u.pm < 16) fo = NV; }
#pragma unroll
        for (int ai = 0; ai < 2; ++ai)
#pragma unroll
            for (int m = 0; m < 4; ++m) { const int r = row0 + ai * HALF + m * 16; bf16_t* rowp = base + (size_t)r * ldc + colt + cin;
#pragma unroll
                for (int bj = 0; bj < 2; ++bj) { if (!((u.mask >> (ai * 2 + bj)) & 1)) continue; const f32x4 v0 = acc[ai][bj][m][0], v1 = acc[ai][bj][m][1];
                    u32x4 w; w.x = cvt_pk(v0[0], v0[1]); w.y = cvt_pk(v0[2], v0[3]); w.z = cvt_pk(v1[0], v1[1]); w.w = cvt_pk(v1[2], v1[3]);
                    *(u32x4*)(rowp + bj * HALF) = w;
                    if (fo) { float* fp = fo + ((size_t)(r >> 8) * 512 + (r & 255)) * 512 + colt + cin + bj * HALF; *(f32x4*)fp = v0; *(f32x4*)(fp + 4) = v1; } } }
    }
};
__device__ __forceinline__ size_t hm_index(int m, int c) { return ((size_t)(c >> 6) * MT + m) * 64 + (c & 63); }
struct EpiRw1 {
    static constexpr bool PERM = true, AFTER_DRAIN = false;
    bf16_t *R, *A3;
    const float* k_k; float* invsq;
    __device__ __forceinline__ void operator()(const f32x4 (&acc)[2][2][4][2], const Unit& u, int wr, int wc, int fr, int fq) const {
        const int ct = u.pn, panel = u.pm % NPANEL;
        const int row0 = panel * 256 + wr * 64 + fr; const int cin = wc * 32 + 8 * fq;
        bf16_t* base; int ldc, colt, act = 0;
        if (ct < 24) { base = R + (size_t)(ct >> 3) * MT * D; ldc = D; colt = (ct & 7) * 256; }
        else { base = A3 + (size_t)(ct - 24) * MT * 256; ldc = 256; colt = 0; act = ct - 23; }
#pragma unroll
        for (int ai = 0; ai < 2; ++ai)
#pragma unroll
            for (int m = 0; m < 4; ++m) { const int rrow = row0 + ai * HALF + m * 16; bf16_t* rowp = base + (size_t)rrow * ldc + colt + cin;
#pragma unroll
                for (int bj = 0; bj < 2; ++bj) { if (!((u.mask >> (ai * 2 + bj)) & 1)) continue; f32x4 v0 = acc[ai][bj][m][0], v1 = acc[ai][bj][m][1];
                    if (act == 1) {
#pragma unroll
                        for (int j = 0; j < 4; ++j) { v0[j] = ftanh(v0[j]); v1[j] = ftanh(v1[j]); } }
                    else if (act == 3) {
#pragma unroll
                        for (int j = 0; j < 4; ++j) { v0[j] = fsigmoid(v0[j]); v1[j] = fsigmoid(v1[j]); } }
                    u32x4 w; w.x = cvt_pk(v0[0], v0[1]); w.y = cvt_pk(v0[2], v0[3]); w.z = cvt_pk(v1[0], v1[1]); w.w = cvt_pk(v1[2], v1[3]);
                    if (ct < 24) *(u32x4*)(base + hm_index(rrow, colt + cin + bj * HALF)) = w; else *(u32x4*)(rowp + bj * HALF) = w;
} }
    }
};
struct EpiRw2 {
    static constexpr bool PERM = true, AFTER_DRAIN = false;
    bf16_t *LD, *LA, *Gt; const float *w0, *a0;
    __device__ __forceinline__ void operator()(const f32x4 (&acc)[2][2][4][2], const Unit& u, int wr, int wc, int fr, int fq) const {
        const int ct = u.pn, panel = u.pm % NPANEL, grp = ct >> 3;
        const int row0 = panel * 256 + wr * 64 + fr; const int col0 = (ct & 7) * 256 + wc * 32 + 8 * fq;
        bf16_t* base; const float* bias = nullptr;
        if (grp < 2) { base = LD + (size_t)grp * MT * D; bias = w0 + grp * D; }
        else if (grp < 4) { base = LA + (size_t)(grp - 2) * MT * D; bias = a0 + (grp - 2) * D; }
        else base = Gt;
        f32x4 bv[2][2];
#pragma unroll
        for (int bj = 0; bj < 2; ++bj)
#pragma unroll
            for (int n = 0; n < 2; ++n) bv[bj][n] = bias ? *(const f32x4*)(bias + col0 + bj * HALF + 4 * n) : (f32x4){0.f, 0.f, 0.f, 0.f};
#pragma unroll
        for (int ai = 0; ai < 2; ++ai)
#pragma unroll
            for (int m = 0; m < 4; ++m) { const int rrow = row0 + ai * HALF + m * 16; bf16_t* rowp = base + (size_t)rrow * D + col0;
#pragma unroll
                for (int bj = 0; bj < 2; ++bj) {
                    f32x4 v0 = acc[ai][bj][m][0] + bv[bj][0], v1 = acc[ai][bj][m][1] + bv[bj][1];
                    if (grp < 2) {
#pragma unroll
                        for (int j = 0; j < 4; ++j) { v0[j] = -fexp(-fsoftplus(-v0[j]) - 0.5f); v1[j] = -fexp(-fsoftplus(-v1[j]) - 0.5f); } }
                    u32x4 w; w.x = cvt_pk(v0[0], v0[1]); w.y = cvt_pk(v0[2], v0[3]); w.z = cvt_pk(v1[0], v1[1]); w.w = cvt_pk(v1[2], v1[3]);
                    if (grp < 4) *(u32x4*)(base + hm_index(rrow, col0 + bj * HALF)) = w; else *(u32x4*)(rowp + bj * HALF) = w; }
                asm volatile("" : "+v"(bv[0][0]), "+v"(bv[0][1]), "+v"(bv[1][0]), "+v"(bv[1][1]));
            }
    }
};
struct RwOrder1 {
    int G, c, lo, hi;
    __device__ __forceinline__ bool next(int i, Unit& u) const { const int L = lo + i * G + c; if (L >= hi) return false; u.mask = 15;
        int panel, ct;
        if (L < 1242) { panel = L / 27; ct = L % 27; } else if (L < 1280) { const int q = L - 1242; panel = 46 + q / 19; ct = 8 + q % 19; } else { const int q = L - 1280; panel = 46 + (q >> 3); ct = q & 7; }
        const int ai = ct < 24 ? (ct >> 3) : ct - 21; u.pm = ai * NPANEL + panel; u.pn = ct; u.kh = 0; return true; }
    __device__ __forceinline__ void a_ready(const Unit&) const {}
    __device__ __forceinline__ void done(const Unit&) const {}
};
struct RwOrder2 {
    int G, c; unsigned* cnt; unsigned need;
    __device__ __forceinline__ bool next(int i, Unit& u) const { const int L = i * G + c; if (L >= 40 * NPANEL) return false; const int panel = L / 40, ct = L % 40; const int ai = ct < 16 ? 0 : (ct < 32 ? 1 : 2); u.pm = ai * NPANEL + panel; u.pn = ct; u.kh = 0; u.mask = 15; return true; }
    __device__ __forceinline__ void a_ready(const Unit& u) const {
        if (cnt && (u.pm % NPANEL) == NPANEL - 1) {
            unsigned sp = 0u;
            while (xb_ld(cnt) < need) { __builtin_amdgcn_s_sleep(2); if (++sp > (1u << 24)) break; }
            __builtin_amdgcn_fence(__ATOMIC_ACQUIRE, "agent");
            asm volatile("s_waitcnt vmcnt(0)" ::: "memory");
        }
    }
    __device__ __forceinline__ void done(const Unit&) const {}
};

struct SplitOrder {
    pg8::StaticOrder so; int G, c, ntiles;
    __device__ __forceinline__ void init(int N, int G_, int c_) { so.init(MT, N, G_, c_); G = G_; c = c_; ntiles = so.nwg; }
    __device__ __forceinline__ bool next(int i, Unit& u) const { const int L = i * G + c; if (L >= 2 * ntiles) return false; const int kh = L >= ntiles; so.map(kh ? L - ntiles : L, u); u.kh = kh; u.mask = 15; return true; }
    __device__ __forceinline__ void a_ready(const Unit&) const {}
    __device__ __forceinline__ void done(const Unit&) const {}
};
struct EpiResidualSplit {
    static constexpr bool PERM = false, AFTER_DRAIN = false;
    float* X; const float* gate_base; bf16_t* P1;
    __device__ __forceinline__ void operator()(const f32x4 (&acc)[2][2][4][2], const Unit& u, int wr, int wc, int fr, int fq) const {
        const int row0 = u.pm * 256 + wr * 64 + fr, col0 = u.pn * 256 + wc * 32 + 4 * fq;
        const float* gp = gate_base + (size_t)cond_of_panel(u.pm) * 6 * D + col0;
        f32x4 gv[2][2];
#pragma unroll
        for (int bj = 0; bj < 2; ++bj)
#pragma unroll
            for (int n = 0; n < 2; ++n) gv[bj][n] = *(const f32x4*)(gp + bj * HALF + n * 16);
        if (u.kh == 0) {
#pragma unroll
            for (int ai = 0; ai < 2; ++ai) {
                f32x4 q[4][2][2];
#pragma unroll
                for (int m = 0; m < 4; ++m)
#pragma unroll
                    for (int bj = 0; bj < 2; ++bj)
#pragma unroll
                        for (int n = 0; n < 2; ++n) q[m][bj][n] = *(const f32x4*)(X + (size_t)(row0 + ai * HALF + m * 16) * D + col0 + bj * HALF + n * 16);
#pragma unroll
                for (int m = 0; m < 4; ++m) { float* rowp = X + (size_t)(row0 + ai * HALF + m * 16) * D + col0;
#pragma unroll
                    for (int bj = 0; bj < 2; ++bj)
#pragma unroll
                        for (int n = 0; n < 2; ++n) *(f32x4*)(rowp + bj * HALF + n * 16) = q[m][bj][n] + gv[bj][n] * acc[ai][bj][m][n]; }
                asm volatile("" ::: "memory");
            }
        } else {
#pragma unroll
            for (int ai = 0; ai < 2; ++ai)
#pragma unroll
                for (int m = 0; m < 4; ++m) { bf16_t* rowp = P1 + (size_t)(row0 + ai * HALF + m * 16) * D + col0;
#pragma unroll
                    for (int bj = 0; bj < 2; ++bj)
#pragma unroll
                        for (int n = 0; n < 2; ++n) { const f32x4 v = gv[bj][n] * acc[ai][bj][m][n]; u32x2 w; w.x = cvt_pk(v.x, v.y); w.y = cvt_pk(v.z, v.w); *(u32x2*)(rowp + bj * HALF + n * 16) = w; } }
        }
    }
};

template <bool SRCF32> struct EpiResidualB {
    static constexpr bool PERM = true, AFTER_DRAIN = false;
    bf16_t* X; const float* gate_base; const float *Bp, *Bs;
    __device__ __forceinline__ void operator()(const f32x4 (&acc)[2][2][4][2], const Unit& u, int wr, int wc, int fr, int fq) const {
        const int row0 = u.pm * 256 + wr * 64 + fr, col0 = u.pn * 256 + wc * 32 + 8 * fq;
        const float* gp = gate_base + (size_t)cond_of_panel(u.pm) * 6 * D + col0;
        f32x4 gv[2][2];
#pragma unroll
        for (int bj = 0; bj < 2; ++bj)
#pragma unroll
            for (int n = 0; n < 2; ++n) gv[bj][n] = *(const f32x4*)(gp + bj * HALF + 4 * n);
#pragma unroll
        for (int ai = 0; ai < 2; ++ai) {
            if constexpr (SRCF32) {
                const float* sbase = (u.pm < 16 ? Bp + (size_t)row0 * D : Bs + (size_t)(row0 - MP) * D) + col0;
                f32x4 q[4][2][2];
#pragma unroll
                for (int m = 0; m < 4; ++m)
#pragma unroll
                    for (int bj = 0; bj < 2; ++bj)
#pragma unroll
                        for (int n = 0; n < 2; ++n) q[m][bj][n] = *(const f32x4*)(sbase + (size_t)(ai * HALF + m * 16) * D + bj * HALF + 4 * n);
#pragma unroll
                for (int m = 0; m < 4; ++m) { bf16_t* rowp = X + (size_t)(row0 + ai * HALF + m * 16) * D + col0;
#pragma unroll
                    for (int bj = 0; bj < 2; ++bj) { const f32x4 v0 = q[m][bj][0] + gv[bj][0] * acc[ai][bj][m][0], v1 = q[m][bj][1] + gv[bj][1] * acc[ai][bj][m][1];
                        u32x4 w; w.x = cvt_pk(v0.x, v0.y); w.y = cvt_pk(v0.z, v0.w); w.z = cvt_pk(v1.x, v1.y); w.w = cvt_pk(v1.z, v1.w); *(u32x4*)(rowp + bj * HALF) = w; } }
            } else {
                u32x4 q[4][2];
#pragma unroll
                for (int m = 0; m < 4; ++m)
#pragma unroll
                    for (int bj = 0; bj < 2; ++bj) q[m][bj] = *(const u32x4*)(X + (size_t)(row0 + ai * HALF + m * 16) * D + col0 + bj * HALF);
#pragma unroll
                for (int m = 0; m < 4; ++m) { bf16_t* rowp = X + (size_t)(row0 + ai * HALF + m * 16) * D + col0;
#pragma unroll
                    for (int bj = 0; bj < 2; ++bj) { const u32x4 o = q[m][bj];
                        const f32x4 v0 = (f32x4){bflo(o.x), bfhi(o.x), bflo(o.y), bfhi(o.y)} + gv[bj][0] * acc[ai][bj][m][0], v1 = (f32x4){bflo(o.z), bfhi(o.z), bflo(o.w), bfhi(o.w)} + gv[bj][1] * acc[ai][bj][m][1];
                        u32x4 w; w.x = cvt_pk(v0.x, v0.y); w.y = cvt_pk(v0.z, v0.w); w.z = cvt_pk(v1.x, v1.y); w.w = cvt_pk(v1.z, v1.w); *(u32x4*)(rowp + bj * HALF) = w; } }
            }
            asm volatile("" ::: "memory");
        }
    }
};
struct EpiResidualSplitB {
    static constexpr bool PERM = true, AFTER_DRAIN = false;
    bf16_t* X; const float* gate_base; bf16_t* P1;
    __device__ __forceinline__ void operator()(const f32x4 (&acc)[2][2][4][2], const Unit& u, int wr, int wc, int fr, int fq) const {
        const int row0 = u.pm * 256 + wr * 64 + fr, col0 = u.pn * 256 + wc * 32 + 8 * fq;
        const float* gp = gate_base + (size_t)cond_of_panel(u.pm) * 6 * D + col0;
        f32x4 gv[2][2];
#pragma unroll
        for (int bj = 0; bj < 2; ++bj)
#pragma unroll
            for (int n = 0; n < 2; ++n) gv[bj][n] = *(const f32x4*)(gp + bj * HALF + 4 * n);
        if (u.kh == 0) {
#pragma unroll
            for (int ai = 0; ai < 2; ++ai) {
                u32x4 q[4][2];
#pragma unroll
                for (int m = 0; m < 4; ++m)
#pragma unroll
                    for (int bj = 0; bj < 2; ++bj) q[m][bj] = *(const u32x4*)(X + (size_t)(row0 + ai * HALF + m * 16) * D + col0 + bj * HALF);
#pragma unroll
                for (int m = 0; m < 4; ++m) { bf16_t* rowp = X + (size_t)(row0 + ai * HALF + m * 16) * D + col0;
#pragma unroll
                    for (int bj = 0; bj < 2; ++bj) { const u32x4 o = q[m][bj];
                        const f32x4 v0 = (f32x4){bflo(o.x), bfhi(o.x), bflo(o.y), bfhi(o.y)} + gv[bj][0] * acc[ai][bj][m][0], v1 = (f32x4){bflo(o.z), bfhi(o.z), bflo(o.w), bfhi(o.w)} + gv[bj][1] * acc[ai][bj][m][1];
                        u32x4 w; w.x = cvt_pk(v0.x, v0.y); w.y = cvt_pk(v0.z, v0.w); w.z = cvt_pk(v1.x, v1.y); w.w = cvt_pk(v1.z, v1.w); *(u32x4*)(rowp + bj * HALF) = w; } }
                asm volatile("" ::: "memory");
            }
        } else {
#pragma unroll
            for (int ai = 0; ai < 2; ++ai)
#pragma unroll
                for (int m = 0; m < 4; ++m) { bf16_t* rowp = P1 + (size_t)(row0 + ai * HALF + m * 16) * D + col0;
#pragma unroll
                    for (int bj = 0; bj < 2; ++bj) { const f32x4 v0 = gv[bj][0] * acc[ai][bj][m][0], v1 = gv[bj][1] * acc[ai][bj][m][1];
                        u32x4 w; w.x = cvt_pk(v0.x, v0.y); w.y = cvt_pk(v0.z, v0.w); w.z = cvt_pk(v1.x, v1.y); w.w = cvt_pk(v1.z, v1.w); *(u32x4*)(rowp + bj * HALF) = w; } }
        }
    }
};
struct TailSplitOrder {
    pg8::StaticOrder sf, st; int G, c, ntf;
    __device__ __forceinline__ void init(int G_, int c_, int ntf_ = 32) { sf.init(8192, D, G_, c_); st.init(4096, D, G_, c_); G = G_; c = c_; ntf = ntf_; }
    __device__ __forceinline__ bool next(int i, Unit& u) const {
        const int L = i * G + c; if (L >= 512) return false;
        if (L < 256) { sf.map(L, u); u.kh = 0; u.nt = ntf; }
        else { const int h = L - 256, kh = h >= 128; st.map(kh ? h - 128 : h, u); u.pm += 32; u.kh = kh; u.nt = ntf >> 1; }
        u.mask = 15; return true; }
    __device__ __forceinline__ void a_ready(const Unit&) const {}
    __device__ __forceinline__ void done(const Unit&) const {}
};


typedef short s16x4 __attribute__((ext_vector_type(4)));
constexpr int KS_STRIDE = 136;
constexpr int VT_STRIDE = 72;
constexpr int ATT_KS_OFF = 0, ATT_VT_OFF = 64 * KS_STRIDE * 2, ATT_BUF_BYTES = 36864;

__device__ __forceinline__ void rope8(u32x4& a, u32x4& b, const f32x2* tab) {
    unsigned* pa = (unsigned*)&a; unsigned* pb = (unsigned*)&b;
#pragma unroll
    for (int w = 0; w < 4; ++w) {
        const f32x4 cs = *(const f32x4*)(tab + 2 * w);
        const float x1l = bflo(pa[w]), x1h = bfhi(pa[w]), x2l = bflo(pb[w]), x2h = bfhi(pb[w]);
        const float o1l = x1l * cs.x - x2l * cs.y, o2l = x1l * cs.y + x2l * cs.x;
        const float o1h = x1h * cs.z - x2h * cs.w, o2h = x1h * cs.w + x2h * cs.z;
        pa[w] = cvt_pk(o1l, o1h); pb[w] = cvt_pk(o2l, o2h);
    }
}

__device__ __forceinline__ void phase_attention(const Ctx& C, const bf16_t* Q, const bf16_t* Kb, const bf16_t* Vb, const bf16_t* KC, const bf16_t* VC, const float* sink, bf16_t* O) {
    const int tid = C.tid, lane = C.lane, w = C.wave, h = lane >> 5, lq = lane & 31;
    LAS bf16_t* Ks = (LAS bf16_t*)(C.lds + ATT_KS_OFF);
    LAS bf16_t* Vt = (LAS bf16_t*)(C.lds + ATT_VT_OFF);
    const f32x2* rope = WSP(f32x2, WS_ROPE);
    const float c2 = 0.08838834764831845f * 1.4426950408889634f;
    for (int it = C.bid; it < 768; it += C.G) {
        const bool smp = it < 512;
        int bb, kvh, qb, R0;
        if (smp) { bb = it >> 6; kvh = (it >> 4) & 3; qb = it & 15; R0 = MP + bb * 1024; }
        else { const int p = it - 512; bb = p >> 4; kvh = (p >> 2) & 3; qb = p & 3; R0 = bb * 256; }
        const int head = kvh * 4 + (w >> 1);
        const int t = qb * 64 + (w & 1) * 32 + lq;
        u32x4 qf[8];
        { const bf16_t* qp = Q + (size_t)(R0 + t) * D + head * 128 + 8 * h;
#pragma unroll
          for (int ks = 0; ks < 8; ++ks) qf[ks] = *(const u32x4*)(qp + 16 * ks); }
        if (smp) {
#pragma unroll
            for (int half = 0; half < 2; ++half) { const int pos = half ? (t & 63) : (t >> 6);
#pragma unroll
                for (int kk = 0; kk < 2; ++kk) rope8(qf[4 * half + kk], qf[4 * half + kk + 2], rope + pos * 32 + 16 * kk + 8 * h); }
        }
        f32x16 o[4];
#pragma unroll
        for (int db = 0; db < 4; ++db)
#pragma unroll
            for (int r = 0; r < 16; ++r) o[db][r] = 0.f;
        float mrun = -1e30f, lrun = 0.f;
        const int li0 = smp ? (qb >= 2 ? 0 : 2 - qb) : 0, li1 = smp ? (17 - qb < 4 ? 17 - qb : 4) : 0;
        const int ntot = smp ? 8 + (li1 - li0 + 1) : 4;
        const int key = tid >> 3, cc = tid & 7, c1 = (cc & 3) + (cc >> 2) * 8;
#define ATT_TILE(i, kp_, vp_, k0_, loc_) do { if (smp) { if ((i) < 8) { const size_t off_ = ((size_t)(bb * 2) * 512 + (i) * 64) * 512 + kvh * 128; kp_ = KC + off_; vp_ = VC + off_; k0_ = 0; loc_ = false; } \
            else { k0_ = qb * 64 - 128 + 64 * ((i) - 8 + li0); loc_ = true; const size_t off_ = (size_t)(R0 + k0_) * 512 + kvh * 128; kp_ = Kb + off_; vp_ = Vb + off_; } } \
          else { k0_ = (i) * 64; loc_ = false; const size_t off_ = (size_t)(R0 + k0_) * 512 + kvh * 128; kp_ = Kb + off_; vp_ = Vb + off_; } } while (0)
        u32x4 ka, kb2, va, vb2;
#define ATT_LOAD(i) do { const bf16_t *kp_, *vp_; int k0_; bool loc_; ATT_TILE(i, kp_, vp_, k0_, loc_); (void)k0_; (void)loc_; \
          ka = *(const u32x4*)(kp_ + (size_t)key * 512 + 8 * c1); kb2 = *(const u32x4*)(kp_ + (size_t)key * 512 + 8 * c1 + 32); \
          va = *(const u32x4*)(vp_ + (size_t)key * 512 + 8 * c1); vb2 = *(const u32x4*)(vp_ + (size_t)key * 512 + 8 * c1 + 32); } while (0)
#define ATT_STAGE(i, KsB, VtB) do { const bf16_t *kp_, *vp_; int k0_; bool loc_; ATT_TILE(i, kp_, vp_, k0_, loc_); (void)kp_; (void)vp_; \
          if (loc_) { const int kpos = k0_ + key; const int pos = (cc >> 2) ? (kpos & 63) : (kpos >> 6); rope8(ka, kb2, rope + pos * 32 + 8 * (cc & 3)); } \
          *(LAS u32x4*)((KsB) + key * KS_STRIDE + 8 * c1) = ka; *(LAS u32x4*)((KsB) + key * KS_STRIDE + 8 * c1 + 32) = kb2; \
          *(LAS u32x4*)((VtB) + key * KS_STRIDE + 8 * c1) = va; *(LAS u32x4*)((VtB) + key * KS_STRIDE + 8 * c1 + 32) = vb2; } while (0)
        ATT_LOAD(0); ATT_STAGE(0, Ks, Vt); if (ntot > 1) ATT_LOAD(1);
        __syncthreads();
        for (int ti = 0; ti < ntot; ++ti) {
            const bf16_t *kp, *vp; int k0; bool local; ATT_TILE(ti, kp, vp, k0, local); (void)kp; (void)vp;
            LAS bf16_t* Ks = (LAS bf16_t*)(C.lds + (ti & 1) * ATT_BUF_BYTES + ATT_KS_OFF);
            LAS bf16_t* Vt = (LAS bf16_t*)(C.lds + (ti & 1) * ATT_BUF_BYTES + ATT_VT_OFF);
            f32x16 s0, s1;
            { const float z0 = opaque_zero();
#pragma unroll
            for (int r = 0; r < 16; ++r) { s0[r] = z0; s1[r] = z0; } }
#pragma unroll
            for (int ks = 0; ks < 8; ++ks) {
                const bf16x8 a0 = *(const LAS bf16x8*)(Ks + lq * KS_STRIDE + 16 * ks + 8 * h);
                const bf16x8 a1 = *(const LAS bf16x8*)(Ks + (32 + lq) * KS_STRIDE + 16 * ks + 8 * h);
                const bf16x8 bq = __builtin_bit_cast(bf16x8, qf[ks]);
                s0 = __builtin_amdgcn_mfma_f32_32x32x16_bf16(a0, bq, s0, 0, 0, 0);
                s1 = __builtin_amdgcn_mfma_f32_32x32x16_bf16(a1, bq, s1, 0, 0, 0);
            }
            if (local) {
#pragma unroll
                for (int r = 0; r < 16; ++r) {
                    const int kl = (r & 3) + 8 * (r >> 2) + 4 * h;
                    const int d0 = k0 + kl - t, d1 = d0 + 32;
                    s0[r] = ((d0 <= 128) && (d0 >= -128)) ? s0[r] : -1e30f; s1[r] = ((d1 <= 128) && (d1 >= -128)) ? s1[r] : -1e30f;
                }
            }
            float mx = fmaxf(s0[0], s1[0]);
#pragma unroll
            for (int r = 1; r < 16; ++r) mx = fmaxf(mx, fmaxf(s0[r], s1[r]));
            mx = fmaxf(mx, __shfl_xor(mx, 32));
            const float mnew = fmaxf(mrun, mx * c2);
            const float alpha = fexp2(mrun - mnew);
            float ps = 0.f;
#pragma unroll
            for (int r = 0; r < 16; ++r) {
                const float p0 = fexp2(__builtin_fmaf(s0[r], c2, -mnew)), p1 = fexp2(__builtin_fmaf(s1[r], c2, -mnew));
                s0[r] = p0; s1[r] = p1; ps += p0 + p1;
            }
            lrun = lrun * alpha + ps; mrun = mnew;
            if (__any(alpha != 1.0f)) {
#pragma unroll
                for (int db = 0; db < 4; ++db)
#pragma unroll
                    for (int r = 0; r < 16; ++r) o[db][r] *= alpha;
            }
            u32x4 pf[4];
#pragma unroll
            for (int s = 0; s < 2; ++s) {
                pf[s].x = cvt_pk(s0[8 * s + 0], s0[8 * s + 1]); pf[s].y = cvt_pk(s0[8 * s + 2], s0[8 * s + 3]); pf[s].z = cvt_pk(s0[8 * s + 4], s0[8 * s + 5]); pf[s].w = cvt_pk(s0[8 * s + 6], s0[8 * s + 7]);
                pf[2 + s].x = cvt_pk(s1[8 * s + 0], s1[8 * s + 1]); pf[2 + s].y = cvt_pk(s1[8 * s + 2], s1[8 * s + 3]); pf[2 + s].z = cvt_pk(s1[8 * s + 4], s1[8 * s + 5]); pf[2 + s].w = cvt_pk(s1[8 * s + 6], s1[8 * s + 7]);
            }
#pragma unroll
            for (int db = 0; db < 4; ++db)
#pragma unroll
                for (int s2 = 0; s2 < 4; ++s2) {
                    const LAS bf16_t* vr = Vt + (16 * s2 + 4 * (lane >> 5) + ((lane & 15) >> 2)) * KS_STRIDE + 32 * db + 16 * ((lane >> 4) & 1) + 4 * (lane & 3);
                    const s16x4 lo = __builtin_amdgcn_ds_read_tr16_b64_v4i16((LAS s16x4*)vr), hi = __builtin_amdgcn_ds_read_tr16_b64_v4i16((LAS s16x4*)(vr + 8 * KS_STRIDE));
                    const u32x2 lo2 = __builtin_bit_cast(u32x2, lo), hi2 = __builtin_bit_cast(u32x2, hi);
                    u32x4 av; av.x = lo2.x; av.y = lo2.y; av.z = hi2.x; av.w = hi2.y;
                    o[db] = __builtin_amdgcn_mfma_f32_32x32x16_bf16(__builtin_bit_cast(bf16x8, av), __builtin_bit_cast(bf16x8, pf[s2]), o[db], 0, 0, 0);
                }
            if (ti + 1 < ntot) {
                LAS bf16_t* Ksn = (LAS bf16_t*)(C.lds + ((ti + 1) & 1) * ATT_BUF_BYTES + ATT_KS_OFF);
                LAS bf16_t* Vtn = (LAS bf16_t*)(C.lds + ((ti + 1) & 1) * ATT_BUF_BYTES + ATT_VT_OFF);
                ATT_STAGE(ti + 1, Ksn, Vtn);
                if (ti + 2 < ntot) ATT_LOAD(ti + 2);
            }
            __syncthreads();
        }
        {
            const float sk = sink[head] * 1.4426950408889634f;
            const float mnew = fmaxf(mrun, sk), alpha = fexp2(mrun - mnew);
            float l = lrun * alpha; l += __shfl_xor(l, 32); l += fexp2(sk - mnew);
            const float sc = alpha * frcp(l);
            bf16_t* op = O + (size_t)(R0 + t) * D + head * 128 + 4 * h;
#pragma unroll
            for (int db = 0; db < 4; ++db)
#pragma unroll
                for (int g4 = 0; g4 < 4; ++g4) {
                    u32x2 wv; wv.x = cvt_pk(o[db][4 * g4 + 0] * sc, o[db][4 * g4 + 1] * sc); wv.y = cvt_pk(o[db][4 * g4 + 2] * sc, o[db][4 * g4 + 3] * sc);
                    *(u32x2*)(op + 32 * db + 8 * g4) = wv;
                }
        }
    }
#undef ATT_TILE
#undef ATT_LOAD
#undef ATT_STAGE
    __syncthreads();
}

__device__ __forceinline__ void phase_hy_gate(const Ctx& C, const bf16_t* Pm, const float* cw, const float* cb, bf16_t* X0, bf16_t* ZTp, bf16_t* ZTs) {
    const int tid = C.tid;
    LAS bf16_t* zs = (LAS bf16_t*)C.lds;
    for (int it = C.bid; it < 6144; it += C.G) {
        const bool smp = it >= 2048; const int q = smp ? it - 2048 : it;
        const int cbk = q & 31, tb = smp ? (q >> 5) & 15 : (q >> 5) & 3, b = smp ? q >> 9 : q >> 7;
        const int L = smp ? 1024 : 256, R0 = smp ? MP + b * 1024 : b * 256, NB = smp ? 8 : 16;
        const int tl = tid >> 3, c8 = tid & 7, t = tb * 64 + tl, c0 = cbk * 64 + 8 * c8;
        float u[3][8];
#pragma unroll
        for (int g = 0; g < 3; ++g) {
            const int gc = g * D + c0;
            const bf16_t* pr = Pm + (size_t)(R0 + t) * 6144 + gc;
            u32x4 pm1 = *(const u32x4*)(pr - (t > 0 ? 6144 : 0)), pp1 = *(const u32x4*)(pr + (t < L - 1 ? 6144 : 0)); const u32x4 p0 = *(const u32x4*)pr;
            { const unsigned mk0 = t > 0 ? 0xffffffffu : 0u, mk1 = t < L - 1 ? 0xffffffffu : 0u; pm1.x &= mk0; pm1.y &= mk0; pm1.z &= mk0; pm1.w &= mk0; pp1.x &= mk1; pp1.y &= mk1; pp1.z &= mk1; pp1.w &= mk1; }
            const unsigned* a = (const unsigned*)&pm1; const unsigned* bq = (const unsigned*)&p0; const unsigned* cq = (const unsigned*)&pp1;
#pragma unroll
            for (int j = 0; j < 4; ++j) {
                const f32x2 w0 = *(const f32x2*)(cw + gc + 2 * j), w1 = *(const f32x2*)(cw + 6144 + gc + 2 * j), w2 = *(const f32x2*)(cw + 12288 + gc + 2 * j), bb = *(const f32x2*)(cb + gc + 2 * j);
#if defined(MK_GATE_VARIANT) && MK_GATE_VARIANT == 1
                u[g][2 * j] = bflo(bq[j]); u[g][2 * j + 1] = bfhi(bq[j]);
#elif defined(MK_GATE_VARIANT) && MK_GATE_VARIANT == 2
                u[g][2 * j] = bflo(bq[j]) * w1.x + bb.x; u[g][2 * j + 1] = bfhi(bq[j]) * w1.y + bb.y;
#elif defined(MK_GATE_VARIANT) && MK_GATE_VARIANT == 3
                u[g][2 * j] = bflo(a[j]) + bflo(bq[j]) + bflo(cq[j]); u[g][2 * j + 1] = bfhi(a[j]) + bfhi(bq[j]) + bfhi(cq[j]);
#else
                u[g][2 * j] = bflo(a[j]) * w0.x + bflo(bq[j]) * w1.x + bflo(cq[j]) * w2.x + bb.x;
                u[g][2 * j + 1] = bfhi(a[j]) * w0.y + bfhi(bq[j]) * w1.y + bfhi(cq[j]) * w2.y + bb.y;
#endif
            }
        }
        { u32x4 o; o.x = cvt_pk(u[0][0], u[0][1]); o.y = cvt_pk(u[0][2], u[0][3]); o.z = cvt_pk(u[0][4], u[0][5]); o.w = cvt_pk(u[0][6], u[0][7]);
          *(u32x4*)(X0 + (size_t)(R0 + t) * D + c0) = o; }
        __syncthreads();
#pragma unroll
        for (int j = 0; j < 8; ++j) zs[(8 * c8 + j) * 72 + tl] = (bf16_t)(cvt_pk(u[2][j] * u[1][j], 0.f) & 0xffffu);
        __syncthreads();
        { const int cl = tid >> 3, t8 = tid & 7;
          const u32x4 o = *(const LAS u32x4*)(zs + cl * 72 + 8 * t8);
          bf16_t* ZT = smp ? ZTs : ZTp;
          *(u32x4*)(ZT + ((size_t)(cbk * 64 + cl) * NB + b) * L + tb * 64 + 8 * t8) = o; }
    }
    __syncthreads();
}

template <int L, int NB>
__device__ __forceinline__ void phase_hy_conv(const Ctx& C, const bf16_t* FG, const bf16_t* ZT, bf16_t* YT) {
    constexpr int WPC = L / 256, CPB = 8 / WPC, NS = L / 32, ROW = 2 * L + 64, UNITS = L / 4, COPYB = UNITS * 16, CHB = 8 * COPYB;
    constexpr int NH = NS > 16 ? NS / 16 : 1, JH = NS / NH;
    const int lane = C.lane, w = C.wave, ch_local = w / WPC, w4 = w % WPC, r = lane & 15, q = lane >> 4;
    for (int it = C.bid; it < 2048 / CPB; it += C.G) {
        const int c = it * CPB + ch_local;
        __syncthreads();
        {
            const int tcid = w4 * 64 + lane;
            const bf16_t* frow = FG + (size_t)c * ROW;
            for (int x = tcid; x < UNITS; x += 64 * WPC) {
                const u32x4 d0 = *(const u32x4*)(frow + 8 * x), d1 = *(const u32x4*)(frow + 8 * x + 8);
                const unsigned dd[8] = {d0.x, d0.y, d0.z, d0.w, d1.x, d1.y, d1.z, d1.w};
#pragma unroll
                for (int k = 0; k < 8; ++k) {
                    u32x4 o;
                    if ((k & 1) == 0) { o.x = dd[k / 2]; o.y = dd[k / 2 + 1]; o.z = dd[k / 2 + 2]; o.w = dd[k / 2 + 3]; }
                    else { const int b0 = (k - 1) / 2;
                        o.x = (dd[b0] >> 16) | (dd[b0 + 1] << 16); o.y = (dd[b0 + 1] >> 16) | (dd[b0 + 2] << 16); o.z = (dd[b0 + 2] >> 16) | (dd[b0 + 3] << 16); o.w = (dd[b0 + 3] >> 16) | (dd[b0 + 4] << 16); }
                    *(LAS u32x4*)(C.lds + ch_local * CHB + k * COPYB + x * 16) = o;
                }
            }
        }
        __syncthreads();
        f32x4 acc[16];
        { const float z0 = opaque_zero();
#pragma unroll
        for (int i = 0; i < 16; ++i) acc[i] = (f32x4){z0, z0, z0, z0}; }
        const bf16_t* zrow = ZT + ((size_t)c * NB + (r % NB)) * L + 8 * q;
        const LAS unsigned char* abase = C.lds + ch_local * CHB + (7 - (r & 7)) * COPYB + ((L - 8) / 8 - (r >> 3) + q - 32 * w4) * 16;
#pragma unroll
        for (int hh = 0; hh < NH; ++hh) {
            bf16x8 bf[JH];
#pragma unroll
            for (int j = 0; j < JH; ++j) bf[j] = *(const bf16x8*)(zrow + 32 * (hh * JH + j));
#pragma unroll
            for (int e = -2 * (hh * JH + JH - 1); e <= 15 - 2 * (hh * JH); ++e) {
                const bf16x8 a = *(const LAS bf16x8*)(abase - 32 * e);
#pragma unroll
                for (int j = 0; j < JH; ++j) { const int il = e + 2 * (hh * JH + j);
                    if (il >= 0 && il < 16) asm volatile("v_mfma_f32_16x16x32_bf16 %0, %1, %2, %0" : "+v"(acc[il]) : "v"(a), "v"(bf[j])); }
                asm volatile("" :: "v"(a));
            }
#pragma unroll
            for (int j = 0; j < JH; ++j) asm volatile("" :: "v"(bf[j]));
        }
        asm volatile("s_nop 15\n\ts_nop 15" : "+v"(acc[0]), "+v"(acc[1]), "+v"(acc[2]), "+v"(acc[3]), "+v"(acc[4]), "+v"(acc[5]), "+v"(acc[6]), "+v"(acc[7]));
        asm volatile("" : "+v"(acc[8]), "+v"(acc[9]), "+v"(acc[10]), "+v"(acc[11]), "+v"(acc[12]), "+v"(acc[13]), "+v"(acc[14]), "+v"(acc[15]));
        if (r < NB) {
            bf16_t* yrow = YT + ((size_t)c * NB + r) * L + 256 * w4 + 4 * q;
#pragma unroll
            for (int i = 0; i < 16; ++i) { u32x2 o; o.x = cvt_pk(acc[i][0], acc[i][1]); o.y = cvt_pk(acc[i][2], acc[i][3]);
#if defined(MK_CONV_VARIANT) && MK_CONV_VARIANT == 1
                { const u32x4 zz = *(const u32x4*)(zrow + 32 * (i & 7)); o.x = zz.x; o.y = zz.y; }
#elif defined(MK_CONV_VARIANT) && MK_CONV_VARIANT == 2
                { const u32x4 aa = *(const LAS u32x4*)(abase - 32 * (i - 8)); o.x = aa.x; o.y = aa.w; }
#endif
                *(u32x2*)(yrow + 16 * i) = o; }
        }
    }
    __syncthreads();
}

__device__ __forceinline__ void phase_hy_out(const Ctx& C, const bf16_t* YTp, const bf16_t* YTs, const bf16_t* X0, bf16_t* Om) {
    const int tid = C.tid;
    LAS bf16_t* ys = (LAS bf16_t*)C.lds;
    for (int it = C.bid; it < 6144; it += C.G) {
        const bool smp = it >= 2048; const int q = smp ? it - 2048 : it;
        const int cbk = q & 31, tb = smp ? (q >> 5) & 15 : (q >> 5) & 3, b = smp ? q >> 9 : q >> 7;
        const int L = smp ? 1024 : 256, R0 = smp ? MP + b * 1024 : b * 256, NB = smp ? 8 : 16;
        __syncthreads();
        { const int cl = tid >> 3, t8 = tid & 7;
          const bf16_t* YT = smp ? YTs : YTp;
          const u32x4 v = *(const u32x4*)(YT + ((size_t)(cbk * 64 + cl) * NB + b) * L + tb * 64 + 8 * t8);
          const unsigned* pv = (const unsigned*)&v;
#pragma unroll
          for (int j = 0; j < 4; ++j) { ys[(8 * t8 + 2 * j) * 72 + cl] = (bf16_t)(pv[j] & 0xffffu); ys[(8 * t8 + 2 * j + 1) * 72 + cl] = (bf16_t)(pv[j] >> 16); } }
        __syncthreads();
        { const int tl = tid >> 3, c8 = tid & 7; const size_t off = (size_t)(R0 + tb * 64 + tl) * D + cbk * 64 + 8 * c8;
          const u32x4 yv = *(const LAS u32x4*)(ys + tl * 72 + 8 * c8), xv = *(const u32x4*)(X0 + off);
          const unsigned* py = (const unsigned*)&yv; const unsigned* px = (const unsigned*)&xv; u32x4 o; unsigned* po = (unsigned*)&o;
#pragma unroll
          for (int j = 0; j < 4; ++j) po[j] = cvt_pk(bflo(py[j]) * bflo(px[j]), bfhi(py[j]) * bfhi(px[j]));
          *(u32x4*)(Om + off) = o; }
    }
    __syncthreads();
}

__device__ __forceinline__ void phase_rw_mix(const Ctx& C, const bf16_t* H, const float* mu, bf16_t* XM) {
    const int gw = C.bid * 8 + C.wave, NGW = C.G * 8, lane = C.lane;
    for (int m = gw; m < MT; m += NGW) {
        const int t = m < MP ? (m & 255) : ((m - MP) & 1023), L = m < MP ? 256 : 1024;
        const bool hasp = t > 0, hasn = t < L - 1;
#pragma unroll
        for (int ch = 0; ch < 4; ++ch) {
            const int c0 = 8 * (lane + 64 * ch);
            const bf16_t* hp = H + (size_t)m * D + c0;
            u32x4 a = *(const u32x4*)(hp - (hasp ? D : 0)), c = *(const u32x4*)(hp + (hasn ? D : 0)); const u32x4 b = *(const u32x4*)hp;
            { const unsigned mk0 = hasp ? 0xffffffffu : 0u, mk1 = hasn ? 0xffffffffu : 0u; a.x &= mk0; a.y &= mk0; a.z &= mk0; a.w &= mk0; c.x &= mk1; c.y &= mk1; c.z &= mk1; c.w &= mk1; }
            const unsigned* pa = (const unsigned*)&a; const unsigned* pb = (const unsigned*)&b; const unsigned* pc = (const unsigned*)&c;
            float hv[8], xx[8];
#pragma unroll
            for (int j = 0; j < 4; ++j) { hv[2 * j] = bflo(pb[j]); hv[2 * j + 1] = bfhi(pb[j]);
                xx[2 * j] = 0.5f * (bflo(pa[j]) + bflo(pc[j])) - hv[2 * j]; xx[2 * j + 1] = 0.5f * (bfhi(pa[j]) + bfhi(pc[j])) - hv[2 * j + 1]; }
#pragma unroll
            for (int s = 0; s < 6; ++s) {
                const int mi = s == 0 ? 0 : s == 1 ? 2 : s == 2 ? 3 : s == 3 ? 1 : s;
                const f32x4 m0 = *(const f32x4*)(mu + mi * D + c0), m1 = *(const f32x4*)(mu + mi * D + c0 + 4);
                u32x4 o; o.x = cvt_pk(hv[0] + xx[0] * m0.x, hv[1] + xx[1] * m0.y); o.y = cvt_pk(hv[2] + xx[2] * m0.z, hv[3] + xx[3] * m0.w);
                o.z = cvt_pk(hv[4] + xx[4] * m1.x, hv[5] + xx[5] * m1.y); o.w = cvt_pk(hv[6] + xx[6] * m1.z, hv[7] + xx[7] * m1.w);
                *(u32x4*)(XM + ((size_t)s * MT + m) * D + c0) = o;
            }
        }
    }
}

__device__ __forceinline__ float dpp_xor1(float x) { return __int_as_float(__builtin_amdgcn_update_dpp(0, __float_as_int(x), 0xB1, 0xF, 0xF, true)); }
__device__ __forceinline__ float dpp_xor2(float x) { return __int_as_float(__builtin_amdgcn_update_dpp(0, __float_as_int(x), 0x4E, 0xF, 0xF, true)); }

constexpr int SC_STEP = 6 * 64;
template <int R, int SC_TS>
__device__ __forceinline__ void rw_scan_task(LAS float* buf, int lane, const bf16_t* Rm, const bf16_t* Km, const bf16_t* Vm, const bf16_t* LD, const bf16_t* LA,
                                             const float* k_k, const float* k_a, const float* invsq, const float* state_in, bf16_t* YB, float* state_out, bool smp, int b, int head, int dir, int half) {
    const int rg = lane >> 2, kq = lane & 3;
    const int L = smp ? 1024 : 256, R0 = smp ? MP + b * 1024 : b * 256;
    const int row0 = half * (16 * R) + R * rg;
    f32x2 S[R][8];
    if (smp) {
        const float* sp = state_in + ((size_t)(b * 2 + dir) * 32 + head) * 4096 + row0 * 64 + 16 * kq;
#pragma unroll
        for (int rr = 0; rr < R; ++rr)
#pragma unroll
            for (int j4 = 0; j4 < 4; ++j4) { const f32x4 v = *(const f32x4*)(sp + rr * 64 + 4 * j4); S[rr][2 * j4] = (f32x2){v.x, v.y}; S[rr][2 * j4 + 1] = (f32x2){v.z, v.w}; }
    } else {
#pragma unroll
        for (int rr = 0; rr < R; ++rr)
#pragma unroll
            for (int j = 0; j < 8; ++j) S[rr][j] = (f32x2){0.f, 0.f};
    }
    const int ch = head * 64 + lane; const size_t hbase = (size_t)head * MT * 64 + lane;
    const float kkc = k_k[ch], kac = k_a[ch];
    const bf16_t* ldp = LD + (size_t)dir * MT * D; const bf16_t* lap = LA + (size_t)dir * MT * D;
    bf16_t* yb = YB + (size_t)dir * MT * D;
    bf16_t pr[SC_TS], pk[SC_TS], pv[SC_TS], pl[SC_TS], pa[SC_TS], qr[SC_TS], qk[SC_TS], qv[SC_TS], ql[SC_TS], qa[SC_TS];
    const int tstart = dir ? L - 1 : 0, tstep = dir ? -1 : 1;
    const int NCH = L / SC_TS;
#define SC_PREFETCH(c) do { _Pragma("unroll") for (int s_ = 0; s_ < SC_TS; ++s_) { const size_t o_ = hbase + (size_t)(R0 + tstart + tstep * ((c) * SC_TS + s_)) * 64; pr[s_] = Rm[o_]; pk[s_] = Km[o_]; pv[s_] = Vm[o_]; pl[s_] = ldp[o_]; pa[s_] = lap[o_]; } } while (0)
#define SC_DERIVE(s_, bufp) do { const float r_ = bf2f(pr[s_]), k_ = bf2f(pk[s_]), v_ = bf2f(pv[s_]), ld_ = bf2f(pl[s_]), a_ = fsigmoid(bf2f(pa[s_])); \
        const float kr_ = k_ * kkc; const float kk_ = kr_ * __builtin_amdgcn_rsqf(wave_sum(kr_ * kr_) + 1e-12f); \
        const unsigned sa_ = (unsigned)(unsigned long)((bufp) + (s_) * SC_STEP) + 4u * (unsigned)lane;     \
        asm volatile("ds_write_b32 %0, %1" :: "v"(sa_), "v"(fexp(ld_))); asm volatile("ds_write_b32 %0, %1 offset:256" :: "v"(sa_), "v"(kk_ * a_)); \
        asm volatile("ds_write_b32 %0, %1 offset:512" :: "v"(sa_), "v"(k_ * (1.0f + (a_ - 1.0f) * kac))); asm volatile("ds_write_b32 %0, %1 offset:768" :: "v"(sa_), "v"(-kk_)); \
        asm volatile("ds_write_b32 %0, %1 offset:1024" :: "v"(sa_), "v"(r_)); asm volatile("ds_write_b32 %0, %1 offset:1280" :: "v"(sa_), "v"(v_)); } while (0)
#define SC_PREFETCH2(c) do { _Pragma("unroll") for (int s_ = 0; s_ < SC_TS; ++s_) { const size_t o_ = hbase + (size_t)(R0 + tstart + tstep * ((c) * SC_TS + s_)) * 64; qr[s_] = Rm[o_]; qk[s_] = Km[o_]; qv[s_] = Vm[o_]; ql[s_] = ldp[o_]; qa[s_] = lap[o_]; } } while (0)
    SC_PREFETCH(0);
#pragma unroll
    for (int s = 0; s < SC_TS; ++s) SC_DERIVE(s, buf);
    asm volatile("s_waitcnt lgkmcnt(0)" ::: "memory");
    SC_PREFETCH(1);
    SC_PREFETCH2(2);
#define SC_DERIVE_Q(s_, bufp) do { const float r_ = bf2f(qr[s_]), k_ = bf2f(qk[s_]), v_ = bf2f(qv[s_]), ld_ = bf2f(ql[s_]), a_ = fsigmoid(bf2f(qa[s_])); \
        const float kr_ = k_ * kkc; const float kk_ = kr_ * __builtin_amdgcn_rsqf(wave_sum(kr_ * kr_) + 1e-12f); \
        const unsigned sa_ = (unsigned)(unsigned long)((bufp) + (s_) * SC_STEP) + 4u * (unsigned)lane; \
        asm volatile("ds_write_b32 %0, %1" :: "v"(sa_), "v"(fexp(ld_))); asm volatile("ds_write_b32 %0, %1 offset:256" :: "v"(sa_), "v"(kk_ * a_)); \
        asm volatile("ds_write_b32 %0, %1 offset:512" :: "v"(sa_), "v"(k_ * (1.0f + (a_ - 1.0f) * kac))); asm volatile("ds_write_b32 %0, %1 offset:768" :: "v"(sa_), "v"(-kk_)); \
        asm volatile("ds_write_b32 %0, %1 offset:1024" :: "v"(sa_), "v"(r_)); asm volatile("ds_write_b32 %0, %1 offset:1280" :: "v"(sa_), "v"(v_)); } while (0)
    LAS float* const buf0 = buf; LAS float* const buf1 = buf + SC_TS * SC_STEP;
    for (int cix = 0; cix < NCH; cix += 2) {
#pragma unroll
        for (int s = 0; s < SC_TS; ++s) {
            SC_DERIVE(s, buf1);
            if (cix + 3 < NCH) { const size_t o_ = hbase + (size_t)(R0 + tstart + tstep * ((cix + 3) * SC_TS + s)) * 64; pr[s] = Rm[o_]; pk[s] = Km[o_]; pv[s] = Vm[o_]; pl[s] = ldp[o_]; pa[s] = lap[o_]; }
#define BC_ buf0
#define CX_ cix
            const LAS float* sb = BC_ + s * SC_STEP;
            f32x2 w2[8], b2[8], d2[8], n2[8], r2[8];
#pragma unroll
            for (int j4 = 0; j4 < 4; ++j4) { const f32x4 nv = *(const LAS f32x4*)(sb + 192 + 16 * kq + 4 * j4); n2[2 * j4] = (f32x2){nv.x, nv.y}; n2[2 * j4 + 1] = (f32x2){nv.z, nv.w}; }
#pragma unroll
            for (int j4 = 0; j4 < 4; ++j4) {
                const f32x4 bv = *(const LAS f32x4*)(sb + 64 + 16 * kq + 4 * j4), dv = *(const LAS f32x4*)(sb + 128 + 16 * kq + 4 * j4), wv = *(const LAS f32x4*)(sb + 16 * kq + 4 * j4), rv = *(const LAS f32x4*)(sb + 256 + 16 * kq + 4 * j4);
                w2[2 * j4] = (f32x2){wv.x, wv.y}; w2[2 * j4 + 1] = (f32x2){wv.z, wv.w}; b2[2 * j4] = (f32x2){bv.x, bv.y}; b2[2 * j4 + 1] = (f32x2){bv.z, bv.w};
                d2[2 * j4] = (f32x2){dv.x, dv.y}; d2[2 * j4 + 1] = (f32x2){dv.z, dv.w}; r2[2 * j4] = (f32x2){rv.x, rv.y}; r2[2 * j4 + 1] = (f32x2){rv.z, rv.w};
            }
            float vrow[R];
            if (R == 4) { const f32x4 vv = *(const LAS f32x4*)(sb + 320 + row0); vrow[0] = vv.x; vrow[R > 1 ? 1 : 0] = vv.y; vrow[R > 2 ? R - 2 : 0] = vv.z; vrow[R - 1] = vv.w; }
            else if (R == 2) { const f32x2 vv = *(const LAS f32x2*)(sb + 320 + row0); vrow[0] = vv.x; vrow[R - 1] = vv.y; }
            else vrow[0] = sb[320 + row0];
            float y[R];
#pragma unroll
            for (int rr = 0; rr < R; ++rr) {
                f32x2 a0 = S[rr][0] * n2[0], a1 = S[rr][1] * n2[1];
#pragma unroll
                for (int j = 2; j < 8; j += 2) { a0 = S[rr][j] * n2[j] + a0; a1 = S[rr][j + 1] * n2[j + 1] + a1; }
                a0 = a0 + a1;
                float sa = a0.x + a0.y; sa += dpp_xor1(sa); sa += dpp_xor2(sa);
                const f32x2 sa2 = (f32x2){sa, sa}, vr2 = (f32x2){vrow[rr], vrow[rr]};
                f32x2 y0 = (f32x2){0.f, 0.f}, y1 = (f32x2){0.f, 0.f};
#pragma unroll
                for (int j = 0; j < 8; j += 2) {
                    S[rr][j] = S[rr][j] * w2[j] + (sa2 * b2[j] + vr2 * d2[j]);
                    S[rr][j + 1] = S[rr][j + 1] * w2[j + 1] + (sa2 * b2[j + 1] + vr2 * d2[j + 1]);
                    y0 = S[rr][j] * r2[j] + y0; y1 = S[rr][j + 1] * r2[j + 1] + y1;
                }
                y0 = y0 + y1;
                float yy = y0.x + y0.y; yy += dpp_xor1(yy); yy += dpp_xor2(yy); y[rr] = yy;
            }
            {
                const int t = tstart + tstep * ((CX_) * SC_TS + s); bf16_t* yp = yb + (size_t)(R0 + t) * D + head * 64;
                if (R == 4) { const float ys = kq == 0 ? y[0] : kq == 1 ? y[R > 1 ? 1 : 0] : kq == 2 ? y[R > 2 ? R - 2 : 0] : y[R - 1]; yp[lane] = (bf16_t)cvt_pk(ys, ys); }
                else if (R == 2) { const float ys = (kq & 1) ? y[R - 1] : y[0]; yp[half * 32 + 2 * rg + (kq & 1)] = (bf16_t)cvt_pk(ys, ys); }
                else yp[row0] = (bf16_t)cvt_pk(y[0], y[0]);
            }
#undef BC_
#undef CX_
        }
        asm volatile("s_waitcnt lgkmcnt(0)" ::: "memory");
#pragma unroll
        for (int s = 0; s < SC_TS; ++s) {
            SC_DERIVE_Q(s, buf0);
            if (cix + 4 < NCH) { const size_t o_ = hbase + (size_t)(R0 + tstart + tstep * ((cix + 4) * SC_TS + s)) * 64; qr[s] = Rm[o_]; qk[s] = Km[o_]; qv[s] = Vm[o_]; ql[s] = ldp[o_]; qa[s] = lap[o_]; }
#define BC_ buf1
#define CX_ (cix + 1)
            const LAS float* sb = BC_ + s * SC_STEP;
            f32x2 w2[8], b2[8], d2[8], n2[8], r2[8];
#pragma unroll
            for (int j4 = 0; j4 < 4; ++j4) { const f32x4 nv = *(const LAS f32x4*)(sb + 192 + 16 * kq + 4 * j4); n2[2 * j4] = (f32x2){nv.x, nv.y}; n2[2 * j4 + 1] = (f32x2){nv.z, nv.w}; }
#pragma unroll
            for (int j4 = 0; j4 < 4; ++j4) {
                const f32x4 bv = *(const LAS f32x4*)(sb + 64 + 16 * kq + 4 * j4), dv = *(const LAS f32x4*)(sb + 128 + 16 * kq + 4 * j4), wv = *(const LAS f32x4*)(sb + 16 * kq + 4 * j4), rv = *(const LAS f32x4*)(sb + 256 + 16 * kq + 4 * j4);
                w2[2 * j4] = (f32x2){wv.x, wv.y}; w2[2 * j4 + 1] = (f32x2){wv.z, wv.w}; b2[2 * j4] = (f32x2){bv.x, bv.y}; b2[2 * j4 + 1] = (f32x2){bv.z, bv.w};
                d2[2 * j4] = (f32x2){dv.x, dv.y}; d2[2 * j4 + 1] = (f32x2){dv.z, dv.w}; r2[2 * j4] = (f32x2){rv.x, rv.y}; r2[2 * j4 + 1] = (f32x2){rv.z, rv.w};
            }
            float vrow[R];
            if (R == 4) { const f32x4 vv = *(const LAS f32x4*)(sb + 320 + row0); vrow[0] = vv.x; vrow[R > 1 ? 1 : 0] = vv.y; vrow[R > 2 ? R - 2 : 0] = vv.z; vrow[R - 1] = vv.w; }
            else if (R == 2) { const f32x2 vv = *(const LAS f32x2*)(sb + 320 + row0); vrow[0] = vv.x; vrow[R - 1] = vv.y; }
            else vrow[0] = sb[320 + row0];
            float y[R];
#pragma unroll
            for (int rr = 0; rr < R; ++rr) {
                f32x2 a0 = S[rr][0] * n2[0], a1 = S[rr][1] * n2[1];
#pragma unroll
                for (int j = 2; j < 8; j += 2) { a0 = S[rr][j] * n2[j] + a0; a1 = S[rr][j + 1] * n2[j + 1] + a1; }
                a0 = a0 + a1;
                float sa = a0.x + a0.y; sa += dpp_xor1(sa); sa += dpp_xor2(sa);
                const f32x2 sa2 = (f32x2){sa, sa}, vr2 = (f32x2){vrow[rr], vrow[rr]};
                f32x2 y0 = (f32x2){0.f, 0.f}, y1 = (f32x2){0.f, 0.f};
#pragma unroll
                for (int j = 0; j < 8; j += 2) {
                    S[rr][j] = S[rr][j] * w2[j] + (sa2 * b2[j] + vr2 * d2[j]);
                    S[rr][j + 1] = S[rr][j + 1] * w2[j + 1] + (sa2 * b2[j + 1] + vr2 * d2[j + 1]);
                    y0 = S[rr][j] * r2[j] + y0; y1 = S[rr][j + 1] * r2[j + 1] + y1;
                }
                y0 = y0 + y1;
                float yy = y0.x + y0.y; yy += dpp_xor1(yy); yy += dpp_xor2(yy); y[rr] = yy;
            }
            {
                const int t = tstart + tstep * ((CX_) * SC_TS + s); bf16_t* yp = yb + (size_t)(R0 + t) * D + head * 64;
                if (R == 4) { const float ys = kq == 0 ? y[0] : kq == 1 ? y[R > 1 ? 1 : 0] : kq == 2 ? y[R > 2 ? R - 2 : 0] : y[R - 1]; yp[lane] = (bf16_t)cvt_pk(ys, ys); }
                else if (R == 2) { const float ys = (kq & 1) ? y[R - 1] : y[0]; yp[half * 32 + 2 * rg + (kq & 1)] = (bf16_t)cvt_pk(ys, ys); }
                else yp[row0] = (bf16_t)cvt_pk(y[0], y[0]);
            }
#undef BC_
#undef CX_
        }
        asm volatile("s_waitcnt lgkmcnt(0)" ::: "memory");
    }
#undef SC_DERIVE_Q
#undef SC_PREFETCH
#undef SC_PREFETCH2
#undef SC_DERIVE
    if (!smp) {
        float* sp = state_out + ((size_t)(b * 2 + dir) * 32 + head) * 4096 + row0 * 64 + 16 * kq;
#pragma unroll
        for (int rr = 0; rr < R; ++rr)
#pragma unroll
            for (int j4 = 0; j4 < 4; ++j4) *(f32x4*)(sp + rr * 64 + 4 * j4) = (f32x4){S[rr][2 * j4].x, S[rr][2 * j4].y, S[rr][2 * j4 + 1].x, S[rr][2 * j4 + 1].y};
    }
}
__device__ __forceinline__ void phase_rw_scan(const Ctx& C, const bf16_t* Rm, const bf16_t* Km, const bf16_t* Vm, const bf16_t* LD, const bf16_t* LA,
                                              const float* k_k, const float* k_a, const float* invsq, const float* state_in, bf16_t* YB, float* state_out) {
    const int lane = C.lane, w = C.wave;
    LAS float* buf = (LAS float*)(C.lds + (w < 4 ? w * 24576 : 98304 + (w - 4) * 12288));
    if (w < 4) { for (int slot = C.bid * 4 + w; slot < 1024; slot += C.G * 4) { const int id = slot >> 1; rw_scan_task<2, 8>(buf, lane, Rm, Km, Vm, LD, LA, k_k, k_a, invsq, state_in, YB, state_out, true, id >> 6, (id >> 1) & 31, id & 1, slot & 1); } }
    else { for (int id = C.bid * 4 + (w - 4); id < 1024; id += C.G * 4) rw_scan_task<4, 4>(buf, lane, Rm, Km, Vm, LD, LA, k_k, k_a, invsq, state_in, YB, state_out, false, id >> 6, (id >> 1) & 31, id & 1, 0); }
    if (w >= 4) late_transposes(C, buf, C.bid * 4 + (w - 4), C.G * 4);
    __syncthreads();
}

__device__ __forceinline__ float head8_sum(float v) { v = DPP_ADD(v, 0xB1); v = DPP_ADD(v, 0x4E); v = DPP_ADD(v, 0x141); return v; }
__device__ __forceinline__ void phase_rw_post(const Ctx& C, const bf16_t* YB, const bf16_t* Rm, const bf16_t* Km, const bf16_t* Vm, const bf16_t* LA, const bf16_t* Gt,
                                              const float* k_a, const float* r_k, const float* ln_w, const float* ln_b, bf16_t* Om) {
    const int gw = C.bid * 8 + C.wave, NGW = C.G * 8, lane = C.lane;
    for (int m = gw; m < MT; m += NGW) {
#pragma unroll 1
        for (int ch = 0; ch < 4; ++ch) {
            const int c0 = 8 * (lane + 64 * ch); const size_t o = (size_t)m * D + c0;
            const u32x4 yfw = *(const u32x4*)(YB + o), ybw = *(const u32x4*)(YB + (size_t)MT * D + o); const unsigned* pyf = (const unsigned*)&yfw; const unsigned* pyb = (const unsigned*)&ybw;
            const size_t oh = hm_index(m, c0);
            const u32x4 rr = *(const u32x4*)(Rm + oh), kk = *(const u32x4*)(Km + oh), vv = *(const u32x4*)(Vm + oh), gg = *(const u32x4*)(Gt + o), l0 = *(const u32x4*)(LA + oh), l1 = *(const u32x4*)(LA + (size_t)MT * D + oh);
            const f32x4 ka0 = *(const f32x4*)(k_a + c0), ka1 = *(const f32x4*)(k_a + c0 + 4), rk0 = *(const f32x4*)(r_k + c0), rk1 = *(const f32x4*)(r_k + c0 + 4);
            const f32x4 lw0 = *(const f32x4*)(ln_w + c0), lw1 = *(const f32x4*)(ln_w + c0 + 4), lb0 = *(const f32x4*)(ln_b + c0), lb1 = *(const f32x4*)(ln_b + c0 + 4);
            float y[8], r[8], k[8], v[8], g[8], a0[8], a1[8], ka[8], rk[8], lw[8], lb[8];
            const unsigned* pr = (const unsigned*)&rr; const unsigned* pk = (const unsigned*)&kk; const unsigned* pv = (const unsigned*)&vv; const unsigned* pg = (const unsigned*)&gg; const unsigned* p0 = (const unsigned*)&l0; const unsigned* p1 = (const unsigned*)&l1;
#pragma unroll
            for (int j = 0; j < 4; ++j) {
                y[2 * j] = bflo(pyf[j]) + bflo(pyb[j]); y[2 * j + 1] = bfhi(pyf[j]) + bfhi(pyb[j]); ka[j] = ka0[j]; ka[4 + j] = ka1[j]; rk[j] = rk0[j]; rk[4 + j] = rk1[j]; lw[j] = lw0[j]; lw[4 + j] = lw1[j]; lb[j] = lb0[j]; lb[4 + j] = lb1[j];
                r[2 * j] = bflo(pr[j]); r[2 * j + 1] = bfhi(pr[j]); k[2 * j] = bflo(pk[j]); k[2 * j + 1] = bfhi(pk[j]); v[2 * j] = bflo(pv[j]); v[2 * j + 1] = bfhi(pv[j]);
                g[2 * j] = bflo(pg[j]); g[2 * j + 1] = bfhi(pg[j]); a0[2 * j] = fsigmoid(bflo(p0[j])); a0[2 * j + 1] = fsigmoid(bfhi(p0[j])); a1[2 * j] = fsigmoid(bflo(p1[j])); a1[2 * j + 1] = fsigmoid(bfhi(p1[j]));
            }
            float s = 0.f, bon = 0.f;
#pragma unroll
            for (int j = 0; j < 8; ++j) { s += y[j]; bon += r[j] * (k[j] * (2.0f + (a0[j] + a1[j] - 2.0f) * ka[j])) * rk[j]; }
            const float mean = head8_sum(s) * (1.0f / 64.0f); bon = head8_sum(bon);
            float q = 0.f;
#pragma unroll
            for (int j = 0; j < 8; ++j) { y[j] -= mean; q += y[j] * y[j]; }
            const float rstd = __builtin_amdgcn_rsqf(head8_sum(q) * (1.0f / 64.0f) + 64e-5f);
            float ov[8];
#pragma unroll
            for (int j = 0; j < 8; ++j) ov[j] = (y[j] * rstd * lw[j] + lb[j] + bon * v[j]) * g[j];
            u32x4 w; w.x = cvt_pk(ov[0], ov[1]); w.y = cvt_pk(ov[2], ov[3]); w.z = cvt_pk(ov[4], ov[5]); w.w = cvt_pk(ov[6], ov[7]);
            *(u32x4*)(Om + o) = w;
        }
    }
}

constexpr int NPH = 35;
#define IN(k) (lo <= (k) && (k) < hi)
#define SEAM(k) do { if (IN(k) && IN((k) + 1)) xcd_barrier(bar); } while (0)
#define LDSG ((PG8_LAS unsigned char*)C.lds)
#ifndef MK_REP_MASK
#define MK_REP_MASK 0ull
#endif
#define REPQ(k) (((MK_REP_MASK) >> (k)) & 1ull)

template <class Epi>
__device__ __forceinline__ void run_gemm(const Ctx& C, const bf16_t* A, const bf16_t* Bt, int N, int K, const Epi& E) {
    pg8::Gemm g{A, Bt, MT, N, K, K}; pg8::StaticOrder S; S.init(MT, N, C.G, C.bid);
    pg8::gemm_phase<Epi, pg8::StaticOrder, false>(LDSG, g, S, E, nullptr);
}

#ifndef MK_SPLIT_MASK
#define MK_SPLIT_MASK 15
#endif
#define PREVP1(L) (((L) > 0 && (((MK_SPLIT_MASK) >> ((L) - 1)) & 1)) ? (const bf16_t*)WSP(bf16_t, WS_ARENA + AR_SLAB) : (const bf16_t*)nullptr)
constexpr size_t AR_SLAB = 200 * MiB;
constexpr size_t CTL_SPLIT = 65536;
template <int SET>
__device__ __forceinline__ void run_gemm_split_res(const Ctx& C, const bf16_t* A, const bf16_t* Bt, int K, bf16_t* X, const float* gate_base) {
    pg8::Gemm g{A, Bt, MT, D, K, K / 2}; TailSplitOrder S; S.init(C.G, C.bid, K / 64);
    EpiResidualSplitB E{X, gate_base, WSP(bf16_t, WS_ARENA + AR_SLAB)};
    pg8::gemm_phase<EpiResidualSplitB, TailSplitOrder, false>(LDSG, g, S, E, nullptr);
}
template <int LAYER>
__device__ __forceinline__ void mlp_block(const Ctx& C, const XcdBarrier& bar, int lo, int hi, int b0) {
    bf16_t* X = WSP(bf16_t, WS_X); bf16_t* H = WSP(bf16_t, WS_H); bf16_t* U = WSP(bf16_t, WS_ARENA + AR_U);
    if (IN(b0)) { { phase_norm_mod_b(C, X, karg<I_N2G>() + LAYER * D, LAYER, 3, H); } if (REPQ(b0)) { phase_norm_mod_b(C, X, karg<I_N2G>() + LAYER * D, LAYER, 3, H); } }
    SEAM(b0);
    if (IN(b0 + 1)) { { EpiBf16<1> E{U, FF}; run_gemm(C, H, WSP(bf16_t, WS_W1T) + (size_t)LAYER * D * FF, FF, D, E); } if (REPQ(b0 + 1)) { EpiBf16<1> E{U, FF}; run_gemm(C, H, WSP(bf16_t, WS_W1T) + (size_t)LAYER * D * FF, FF, D, E); } }
    SEAM(b0 + 1);
    if (IN(b0 + 2)) { { if constexpr (((MK_SPLIT_MASK) >> LAYER) & 1) run_gemm_split_res<LAYER>(C, U, WSP(bf16_t, WS_W2T) + (size_t)LAYER * D * FF, FF, X, MODP(LAYER, 0, 5)); else { EpiResidualB<false> E{X, MODP(LAYER, 0, 5), nullptr, nullptr}; run_gemm(C, U, WSP(bf16_t, WS_W2T) + (size_t)LAYER * D * FF, D, FF, E); } } if (REPQ(b0 + 2)) { if constexpr (((MK_SPLIT_MASK) >> LAYER) & 1) run_gemm_split_res<LAYER>(C, U, WSP(bf16_t, WS_W2T) + (size_t)LAYER * D * FF, FF, X, MODP(LAYER, 0, 5)); else { EpiResidualB<false> E{X, MODP(LAYER, 0, 5), nullptr, nullptr}; run_gemm(C, U, WSP(bf16_t, WS_W2T) + (size_t)LAYER * D * FF, D, FF, E); } } }
    SEAM(b0 + 2);
}

template <int LAYER, int J>
__device__ __forceinline__ void attn_layer(const Ctx& C, const XcdBarrier& bar, int lo, int hi, int b0) {
    bf16_t* X = WSP(bf16_t, WS_X); bf16_t* H = WSP(bf16_t, WS_H);
    bf16_t *Q = WSP(bf16_t, WS_ARENA + AR_Q), *Kb = WSP(bf16_t, WS_ARENA + AR_K), *Vb = WSP(bf16_t, WS_ARENA + AR_V), *O = WSP(bf16_t, WS_ARENA + AR_O);
    if (IN(b0)) { { if (LAYER == 0) { phase_fg_transpose(C); phase_norm_mod(C, karg<I_XP>(), karg<I_XS>(), karg<I_N1G>() + LAYER * D, LAYER, 0, H); } else phase_norm_mod_b(C, X, karg<I_N1G>() + LAYER * D, LAYER, 0, H, PREVP1(LAYER), X, 8192); } if (REPQ(b0)) { if (LAYER == 0) { phase_fg_transpose(C); phase_norm_mod(C, karg<I_XP>(), karg<I_XS>(), karg<I_N1G>() + LAYER * D, LAYER, 0, H); } else phase_norm_mod_b(C, X, karg<I_N1G>() + LAYER * D, LAYER, 0, H, PREVP1(LAYER), X, 8192); } }
    SEAM(b0);
    if (IN(b0 + 1)) { { EpiQKV E{Q, Kb, Vb, C.out + OUT_NK + (size_t)J * 256 * 512, C.out + OUT_NV + (size_t)J * 256 * 512}; run_gemm(C, H, WSP(bf16_t, WS_WQKVT) + (size_t)J * D * 3072, 3072, D, E); } if (REPQ(b0 + 1)) { EpiQKV E{Q, Kb, Vb, C.out + OUT_NK + (size_t)J * 256 * 512, C.out + OUT_NV + (size_t)J * 256 * 512}; run_gemm(C, H, WSP(bf16_t, WS_WQKVT) + (size_t)J * D * 3072, 3072, D, E); } }
    SEAM(b0 + 1);
    if (IN(b0 + 2)) { { phase_attention(C, Q, Kb, Vb, WSP(bf16_t, WS_KC) + (size_t)J * 512 * 512, WSP(bf16_t, WS_VC) + (size_t)J * 512 * 512, karg<I_SINK>() + J * 16, O); } if (REPQ(b0 + 2)) { phase_attention(C, Q, Kb, Vb, WSP(bf16_t, WS_KC) + (size_t)J * 512 * 512, WSP(bf16_t, WS_VC) + (size_t)J * 512 * 512, karg<I_SINK>() + J * 16, O); } }
    SEAM(b0 + 2);
    if (IN(b0 + 3)) { { EpiResidualB<LAYER == 0> E{X, MODP(LAYER, 0, 2), LAYER == 0 ? karg<I_XP>() : nullptr, LAYER == 0 ? karg<I_XS>() : nullptr}; run_gemm(C, O, WSP(bf16_t, WS_WOT) + (size_t)J * D * D, D, D, E); } if (REPQ(b0 + 3)) { EpiResidualB<LAYER == 0> E{X, MODP(LAYER, 0, 2), LAYER == 0 ? karg<I_XP>() : nullptr, LAYER == 0 ? karg<I_XS>() : nullptr}; run_gemm(C, O, WSP(bf16_t, WS_WOT) + (size_t)J * D * D, D, D, E); } }
    SEAM(b0 + 3);
    mlp_block<LAYER>(C, bar, lo, hi, b0 + 4);
}

template <int LAYER>
__device__ __forceinline__ void hyena_layer(const Ctx& C, const XcdBarrier& bar, int lo, int hi, int b0) {
    bf16_t* X = WSP(bf16_t, WS_X); bf16_t* H = WSP(bf16_t, WS_H);
    bf16_t *Pm = WSP(bf16_t, WS_ARENA + AR_P), *X0 = WSP(bf16_t, WS_ARENA + AR_X0), *ZT = WSP(bf16_t, WS_ARENA + AR_ZT), *YT = WSP(bf16_t, WS_ARENA + AR_YT), *HO = WSP(bf16_t, WS_ARENA + AR_HO);
    bf16_t *ZTp = ZT, *ZTs = ZT + (size_t)MP * D, *YTp = YT, *YTs = YT + (size_t)MP * D;
    if (IN(b0)) { { phase_norm_mod_b(C, X, karg<I_N1G>() + LAYER * D, LAYER, 0, H, PREVP1(LAYER), X, 8192); } if (REPQ(b0)) { phase_norm_mod_b(C, X, karg<I_N1G>() + LAYER * D, LAYER, 0, H, PREVP1(LAYER), X, 8192); } }
    SEAM(b0);
    if (IN(b0 + 1)) { { EpiBf16<0> E{Pm, 6144}; run_gemm(C, H, WSP(bf16_t, WS_HYINT), 6144, D, E); } if (REPQ(b0 + 1)) { EpiBf16<0> E{Pm, 6144}; run_gemm(C, H, WSP(bf16_t, WS_HYINT), 6144, D, E); } }
    SEAM(b0 + 1);
    if (IN(b0 + 2)) { { phase_hy_gate(C, Pm, karg<I_HYCW>(), karg<I_HYCB>(), X0, ZTp, ZTs); } if (REPQ(b0 + 2)) { phase_hy_gate(C, Pm, karg<I_HYCW>(), karg<I_HYCB>(), X0, ZTp, ZTs); } }
    SEAM(b0 + 2);
    if (IN(b0 + 3)) { { phase_hy_conv<1024, 8>(C, WSP(bf16_t, WS_FGS), ZTs, YTs); phase_hy_conv<256, 16>(C, WSP(bf16_t, WS_FGP), ZTp, YTp); } if (REPQ(b0 + 3)) { phase_hy_conv<1024, 8>(C, WSP(bf16_t, WS_FGS), ZTs, YTs); phase_hy_conv<256, 16>(C, WSP(bf16_t, WS_FGP), ZTp, YTp); } }
    SEAM(b0 + 3);
    if (IN(b0 + 4)) { { phase_hy_out(C, YTp, YTs, X0, HO); } if (REPQ(b0 + 4)) { phase_hy_out(C, YTp, YTs, X0, HO); } }
    SEAM(b0 + 4);
    if (IN(b0 + 5)) { { EpiResidualB<false> E{X, MODP(LAYER, 0, 2), nullptr, nullptr}; run_gemm(C, HO, WSP(bf16_t, WS_HYOUTT), D, D, E); } if (REPQ(b0 + 5)) { EpiResidualB<false> E{X, MODP(LAYER, 0, 2), nullptr, nullptr}; run_gemm(C, HO, WSP(bf16_t, WS_HYOUTT), D, D, E); } }
    SEAM(b0 + 5);
    mlp_block<LAYER>(C, bar, lo, hi, b0 + 6);
}

__device__ __forceinline__ void rw_g2_phase(const Ctx& C, const bf16_t* XM, bf16_t* Rm, bf16_t* A3, bf16_t* LD, bf16_t* LA, bf16_t* Gt) {
    if (C.G == 256 && C.bid >= 240) { pg8::Gemm g{XM, WSP(bf16_t, WS_RWBT), 6 * MT, 27 * 256, D, D}; RwOrder1 S{16, C.bid - 240, 1280, 27 * NPANEL}; EpiRw1 E{Rm, A3, karg<I_KK>(), WSP(float, WS_INVSQ)}; pg8::gemm_phase<EpiRw1, RwOrder1, false>(LDSG, g, S, E, nullptr); }
    else { pg8::Gemm g{A3, WSP(bf16_t, WS_LORA2T), 3 * MT, 40 * 256, 256, 256}; RwOrder2 S{C.G == 256 ? 240 : C.G, C.bid, nullptr, 0u}; EpiRw2 E{LD, LA, Gt, karg<I_W0>(), karg<I_A0>()}; pg8::gemm_phase<EpiRw2, RwOrder2, false>(LDSG, g, S, E, nullptr); }
}
template <int LAYER>
__device__ __forceinline__ void rwkv_layer(const Ctx& C, const XcdBarrier& bar, int lo, int hi, int b0) {
    bf16_t* X = WSP(bf16_t, WS_X); bf16_t* H = WSP(bf16_t, WS_H);
    bf16_t *XM = WSP(bf16_t, WS_ARENA + AR_XMIX), *LD = WSP(bf16_t, WS_ARENA + AR_LD), *LA = WSP(bf16_t, WS_ARENA + AR_LA), *Gt = WSP(bf16_t, WS_ARENA + AR_G), *RO = WSP(bf16_t, WS_ARENA + AR_RO);
    bf16_t *Rm = WSP(bf16_t, WS_ARENA + AR_R), *Km = WSP(bf16_t, WS_ARENA + AR_KK), *Vm = WSP(bf16_t, WS_ARENA + AR_VV), *A3 = WSP(bf16_t, WS_ARENA + AR_A3);
    bf16_t* YB = WSP(bf16_t, WS_ARENA + AR_YB);
    if (IN(b0)) { { phase_norm_mod_b(C, X, karg<I_N1G>() + LAYER * D, LAYER, 0, H, PREVP1(LAYER), X, 8192); } if (REPQ(b0)) { phase_norm_mod_b(C, X, karg<I_N1G>() + LAYER * D, LAYER, 0, H, PREVP1(LAYER), X, 8192); } }
    SEAM(b0);
    if (IN(b0 + 1)) { { phase_rw_mix(C, H, karg<I_MU>(), XM); } if (REPQ(b0 + 1)) { phase_rw_mix(C, H, karg<I_MU>(), XM); } }
    SEAM(b0 + 1);
    if (IN(b0 + 2)) { { pg8::Gemm g{XM, WSP(bf16_t, WS_RWBT), 6 * MT, 27 * 256, D, D}; RwOrder1 S{C.G, C.bid, 0, C.G == 256 ? 1280 : 27 * NPANEL}; EpiRw1 E{Rm, A3, karg<I_KK>(), WSP(float, WS_INVSQ)}; pg8::gemm_phase<EpiRw1, RwOrder1, false>(LDSG, g, S, E, nullptr); } if (REPQ(b0 + 2)) { pg8::Gemm g{XM, WSP(bf16_t, WS_RWBT), 6 * MT, 27 * 256, D, D}; RwOrder1 S{C.G, C.bid, 0, C.G == 256 ? 1280 : 27 * NPANEL}; EpiRw1 E{Rm, A3, karg<I_KK>(), WSP(float, WS_INVSQ)}; pg8::gemm_phase<EpiRw1, RwOrder1, false>(LDSG, g, S, E, nullptr); } }
    SEAM(b0 + 2);
    if (IN(b0 + 3)) { { rw_g2_phase(C, XM, Rm, A3, LD, LA, Gt); } if (REPQ(b0 + 3)) { rw_g2_phase(C, XM, Rm, A3, LD, LA, Gt); } }
    SEAM(b0 + 3);
    if (IN(b0 + 4)) { { phase_rw_scan(C, Rm, Km, Vm, LD, LA, karg<I_KK>(), karg<I_KA>(), WSP(float, WS_INVSQ), karg<I_ST>(), YB, C.out + OUT_ST); } if (REPQ(b0 + 4)) { phase_rw_scan(C, Rm, Km, Vm, LD, LA, karg<I_KK>(), karg<I_KA>(), WSP(float, WS_INVSQ), karg<I_ST>(), YB, C.out + OUT_ST); } }
    SEAM(b0 + 4);
    if (IN(b0 + 5)) { { phase_rw_post(C, YB, Rm, Km, Vm, LA, Gt, karg<I_KA>(), karg<I_RK>(), karg<I_LNW>(), karg<I_LNB>(), RO); } if (REPQ(b0 + 5)) { phase_rw_post(C, YB, Rm, Km, Vm, LA, Gt, karg<I_KA>(), karg<I_RK>(), karg<I_LNW>(), karg<I_LNB>(), RO); } }
    SEAM(b0 + 5);
    if (IN(b0 + 6)) { { EpiResidualB<false> E{X, MODP(LAYER, 0, 2), nullptr, nullptr}; run_gemm(C, RO, WSP(bf16_t, WS_RWOT), D, D, E); } if (REPQ(b0 + 6)) { EpiResidualB<false> E{X, MODP(LAYER, 0, 2), nullptr, nullptr}; run_gemm(C, RO, WSP(bf16_t, WS_RWOT), D, D, E); } }
    SEAM(b0 + 6);
    mlp_block<LAYER>(C, bar, lo, hi, b0 + 7);
}

__global__ void __launch_bounds__(512, 2) fwd_kernel(Params prm) {
    extern __shared__ __attribute__((aligned(16))) unsigned char lds_raw[];
    Ctx C;
    C.lds = (LAS unsigned char*)lds_raw;
    C.tid = threadIdx.x; C.lane = C.tid & 63; C.wave = __builtin_amdgcn_readfirstlane(C.tid >> 6); C.G = gridDim.x; C.bid = blockIdx.x;
    C.out = prm.out; C.ws = prm.ws;
    const int lo = prm.ph_lo, hi = prm.ph_hi;
    volatile LAS unsigned* xbw = (volatile LAS unsigned*)(C.lds + LDS_BAR_OFF);
    if (C.tid < 4) xbw[C.tid] = 0u;
    __syncthreads();
    XcdBarrier bar; bar.bar = (unsigned*)(C.ws + WS_CTL) + 1024; bar.x = 0; bar.st = xbw;
    if (hi - lo > 1) bar = xcd_barrier_post((unsigned*)(C.ws + WS_CTL) + 1024, xbw);

#ifdef MK_SKIP_FROM
    if (IN(0)) { for (size_t i = (size_t)C.bid * 512 + C.tid; i < (size_t)3 * 4194304; i += (size_t)C.G * 512) prm.out[OUT_NK + i] = 0.f; }
#endif
    if (IN(0)) { { phase_prologue(C); } if (REPQ(0)) { phase_prologue(C); } }
    SEAM(0);
    attn_layer<0, 0>(C, bar, lo, hi, 1);
    hyena_layer<1>(C, bar, lo, hi, 8);
    rwkv_layer<2>(C, bar, lo, hi, 17);
    attn_layer<3, 1>(C, bar, lo, hi, 27);
#ifndef MK_DBG_N
#define MK_DBG_N ((size_t)MT * D)
#endif
#ifndef MK_DBG_SCALE
#define MK_DBG_SCALE 1.0f
#endif
#ifdef MK_DBG_OFF
    if (IN(34)) { for (size_t i = (size_t)C.bid * 512 + C.tid; i < (size_t)MT * D; i += (size_t)C.G * 512) prm.out[OUT_Y + i] = i < (size_t)(MK_DBG_N) ? MK_DBG_SCALE * (MK_DBG_BF16 ? bf2f(WSP(bf16_t, MK_DBG_OFF)[i]) : WSP(float, MK_DBG_OFF)[i]) : 0.f; }
#else
    if (IN(34)) { { phase_norm_final_b(C, WSP(bf16_t, WS_X), karg<I_FNG>(), prm.out + OUT_Y, PREVP1(4), 8192); } if (REPQ(34)) { phase_norm_final_b(C, WSP(bf16_t, WS_X), karg<I_FNG>(), prm.out + OUT_Y, PREVP1(4), 8192); } }
#endif
}

#ifdef MK_SEP_CONV
__global__ void __launch_bounds__(512, 2) k_hyconv(Params prm) {
    extern __shared__ __attribute__((aligned(16))) unsigned char lds_raw3[];
    Ctx C; C.lds = (LAS unsigned char*)lds_raw3; C.tid = threadIdx.x; C.lane = C.tid & 63; C.wave = __builtin_amdgcn_readfirstlane(C.tid >> 6); C.G = gridDim.x; C.bid = blockIdx.x; C.out = prm.out; C.ws = prm.ws;
    bf16_t *ZT = WSP(bf16_t, WS_ARENA + AR_ZT), *YT = WSP(bf16_t, WS_ARENA + AR_YT);
    phase_hy_conv<1024, 8>(C, WSP(bf16_t, WS_FGS), ZT + (size_t)MP * D, YT + (size_t)MP * D); phase_hy_conv<256, 16>(C, WSP(bf16_t, WS_FGP), ZT, YT);
}
#endif
#ifdef MK_SEP_GATE
__global__ void __launch_bounds__(512, 2) k_hygate(Params prm) {
    extern __shared__ __attribute__((aligned(16))) unsigned char lds_raw2[];
    Ctx C; C.lds = (LAS unsigned char*)lds_raw2; C.tid = threadIdx.x; C.lane = C.tid & 63; C.wave = __builtin_amdgcn_readfirstlane(C.tid >> 6); C.G = gridDim.x; C.bid = blockIdx.x; C.out = prm.out; C.ws = prm.ws;
    bf16_t* ZT = WSP(bf16_t, WS_ARENA + AR_ZT);
    phase_hy_gate(C, WSP(bf16_t, WS_ARENA + AR_P), karg<I_HYCW>(), karg<I_HYCB>(), WSP(bf16_t, WS_ARENA + AR_X0), ZT, ZT + (size_t)MP * D);
}
#endif
#ifndef MK_PER_PHASE
#define MK_PER_PHASE 0
#endif
extern "C" void kernel_launch(void* const* d_in, const int* in_sizes, int n_in, void* d_out, int out_size, void* d_ws, size_t ws_size, hipStream_t stream) {
    static int grid = 0;
    if (grid == 0) {
        if (n_in != N_IN || ws_size < WS_END || out_size != 37748736) { fprintf(stderr, "kernel_launch: unexpected shapes (n_in %d, ws %zu, out %d); nothing launched\n", n_in, ws_size, out_size); grid = -1; return; }
        int dev = 0, cus = 0, per_cu = 0;
        if (hipGetDevice(&dev) != hipSuccess || hipDeviceGetAttribute(&cus, hipDeviceAttributeMultiprocessorCount, dev) != hipSuccess) { grid = -1; return; }
        if (hipFuncSetAttribute((const void*)fwd_kernel, hipFuncAttributeMaxDynamicSharedMemorySize, LDS_BYTES) != hipSuccess) { fprintf(stderr, "kernel_launch: hipFuncSetAttribute failed\n"); grid = -1; return; }
        if (hipOccupancyMaxActiveBlocksPerMultiprocessor(&per_cu, (const void*)fwd_kernel, 512, LDS_BYTES) != hipSuccess || per_cu < 1) { fprintf(stderr, "kernel_launch: occupancy query says %d\n", per_cu); }
        (void)hipGetLastError();
        grid = cus;
    }
    if (grid < 0) return;
    (void)hipMemsetAsync((char*)d_ws, 0, WS_ZERO_BYTES, stream);
    Params p{};
    for (int i = 0; i < N_IN; ++i) p.in[i] = (const float*)d_in[i];
    p.out = (float*)d_out; p.ws = (unsigned char*)d_ws;
#ifndef MK_LASTP
#define MK_LASTP NPH
#endif
#ifndef MK_FIRSTP
#define MK_FIRSTP 0
#endif
#if MK_PER_PHASE
    for (int k = MK_FIRSTP; k < MK_LASTP; ++k) {
#ifdef MK_SKIP_FROM
        if (k >= MK_SKIP_FROM && k < NPH - 1) continue;
#endif
#ifdef MK_SEP_CONV
        if (k == 11) { static bool a3 = false; if (!a3) { (void)hipFuncSetAttribute((const void*)k_hyconv, hipFuncAttributeMaxDynamicSharedMemorySize, 70000); a3 = true; } hipLaunchKernelGGL(k_hyconv, dim3(grid), dim3(512), 70000, stream, p); continue; }
#endif
#ifdef MK_SEP_GATE
        if (k == 10) { hipLaunchKernelGGL(k_hygate, dim3(grid), dim3(512), 16384, stream, p); continue; }
#endif
#ifdef MK_REPEAT_PH
        if (k == MK_REPEAT_PH) { p.ph_lo = k; p.ph_hi = k + 1; hipLaunchKernelGGL(fwd_kernel, dim3(grid), dim3(512), LDS_BYTES, stream, p); }
#endif
 p.ph_lo = k; p.ph_hi = k + 1; hipLaunchKernelGGL(fwd_kernel, dim3(grid), dim3(512), LDS_BYTES, stream, p); }
#else
    p.ph_lo = 0; p.ph_hi = NPH; hipLaunchKernelGGL(fwd_kernel, dim3(grid), dim3(512), LDS_BYTES, stream, p);
#endif
}
```

```cpp
#include <hip/hip_runtime.h>
#include <cstdio>
#include <cstdint>
namespace pg8 {
#define PG8_LAS __attribute__((address_space(3)))
typedef unsigned short bf16_t;
typedef short bf16x8 __attribute__((ext_vector_type(8)));
typedef float f32x4 __attribute__((ext_vector_type(4)));
typedef unsigned u32x4 __attribute__((ext_vector_type(4)));
constexpr int BM = 256, BK = 64, HALF = 128, HTB = HALF * BK * 2  , STAGE_BYTES = 8 * HTB, NXCD = 8, WGM = 4;

__host__ __device__ __forceinline__ int lds_byte(int r, int c) { const int st = (r >> 4) * 2 + (c >> 5), rr = r & 15, cc = c & 31, ob = rr * 64 + cc * 2; return st * 1024 + (ob ^ (((ob >> 9) & 1) << 5)); }
__host__ __device__ __forceinline__ void stage_rc(int b, int& R, int& C) { const int st = b / 1024, sb = b % 1024, swz = sb ^ (((sb >> 9) & 1) << 5); R = (st >> 1) * 16 + swz / 64; C = (st & 1) * 32 + (swz % 64) / 2; }
__host__ __device__ __forceinline__ int perm32(int rho) { const int n = rho >> 4, i = rho & 15; return 8 * (i >> 2) + 4 * n + (i & 3); }

struct Unit { int pm, pn, kh, mask; int nt = 0; };
struct Gemm { const bf16_t* A; const bf16_t* Bt; int M, N, K, KU; };

__host__ __device__ __forceinline__ bool tail_deal(int nwg, int G, int i, int c, int& L, int& mask) {
    const int full = nwg / G, rem = nwg - full * G;
    if (i < full) { L = i * G + c; mask = 15; return true; }
    if (i > full || rem == 0) return false;
    const int parts = (4 * rem <= G) ? 4 : ((2 * rem <= G) ? 2 : 1);
    if (c >= parts * rem) return false;
    L = full * G + c / parts; const int sub = c % parts;
    mask = parts == 1 ? 15 : (parts == 2 ? (sub ? 0xA : 0x5) : (1 << sub));
    return true;
}
struct StaticOrder {
    int nM, nN, nwg, G, c;
    __host__ __device__ void init(int M, int N, int G_, int c_) { nM = M / BM; nN = N / BM; nwg = nM * nN; G = G_; c = c_; }
    __host__ __device__ bool next(int i, Unit& u) const { const long L = (long)i * G + c; if (L >= nwg) return false; map((int)L, u); u.kh = 0; u.mask = 15; return true; }
    __host__ __device__ bool map(int L, Unit& u) const {
        int wgid = (int)L; { const int q = nwg / NXCD, r = nwg % NXCD, xcd = wgid % NXCD, off = wgid / NXCD; wgid = (xcd < r ? xcd * (q + 1) : r * (q + 1) + (xcd - r) * q) + off; }
        const int nig = WGM * nN, gid = wgid / nig, fm = gid * WGM, gsz = (nM - fm) < WGM ? (nM - fm) : WGM;
        u.pm = fm + ((wgid % nig) % gsz); u.pn = (wgid % nig) / gsz; return true;
    }
    __device__ __forceinline__ void a_ready(const Unit&) const {}
    __device__ __forceinline__ void done(const Unit&) const {}
};

template <class Epi, class Sched, bool STAMP = false>
__device__ __forceinline__ void gemm_phase(PG8_LAS unsigned char* lds, const Gemm g, const Sched& S, const Epi& E, unsigned long long* stamps) {
    const int tid = threadIdx.x, wid = __builtin_amdgcn_readfirstlane(tid >> 6), lane = tid & 63, wr = wid >> 2, wc = wid & 3, fr = lane & 15, fq = lane >> 4;
    const int K = g.K, nt = g.KU / BK;
    int ts_lo = 0, ts_hi = 0, nts = 0; const unsigned long long rt_entry = STAMP ? (unsigned long long)wall_clock64() : 0ull;
#define PG8_STAMP() do { if (STAMP && wid == 0 && nts < 64) { const unsigned long long _c = (unsigned long long)clock64(); \
        ts_lo = (lane == nts) ? (int)(unsigned)_c : ts_lo; ts_hi = (lane == nts) ? (int)(unsigned)(_c >> 32) : ts_hi; ++nts; } } while (0)
    PG8_STAMP();
    unsigned voffA[2], voffB[2];
#pragma unroll
    for (int i = 0; i < 2; ++i) { int R, C; stage_rc(tid * 16 + i * 8192, R, C); const int Rb = Epi::PERM ? ((R & ~31) + perm32(R & 31)) : R;
        voffA[i] = (unsigned)(R * K + C) * 2u; voffB[i] = (unsigned)(Rb * K + C) * 2u; }
    const size_t kstep = (size_t)(BK * 2);
    const size_t hstep = (size_t)HALF * K * 2;
    const size_t tstep = 2 * hstep;
    const unsigned ldsw = (unsigned)wid * 1024u;
    const int aoff = lds_byte(wr * 64 + fr, fq * 8), boff = lds_byte(wc * 32 + fr, fq * 8);
#define PG8_SA(b, h) (((b) * 2 + (h)) * HTB)
#define PG8_SB(b, h) ((4 + (b) * 2 + (h)) * HTB)
#define PG8_STAGE(bufoff, gbase, voff) do { _Pragma("unroll") for (int _i = 0; _i < 2; ++_i) \
        __builtin_amdgcn_global_load_lds((const unsigned*)((const char*)(gbase) + (voff)[_i]), (PG8_LAS unsigned*)(lds + (bufoff) + ldsw + _i * 8192), 16, 0, 0); } while (0)
#define PG8_LDA(dst, b, h) do { _Pragma("unroll") for (int m = 0; m < 4; ++m) _Pragma("unroll") for (int k = 0; k < 2; ++k) dst[m][k] = *(const PG8_LAS bf16x8*)(lds + PG8_SA(b, h) + aoff + m * 2048 + k * 1024); } while (0)
#define PG8_LDB(dst, b, h) do { _Pragma("unroll") for (int n = 0; n < 2; ++n) _Pragma("unroll") for (int k = 0; k < 2; ++k) dst[n][k] = *(const PG8_LAS bf16x8*)(lds + PG8_SB(b, h) + boff + n * 2048 + k * 1024); } while (0)
#define PG8_MMA(ai, bj, At, Bt) do { __builtin_amdgcn_s_setprio(1); _Pragma("unroll") for (int k = 0; k < 2; ++k) _Pragma("unroll") for (int m = 0; m < 4; ++m) _Pragma("unroll") for (int n = 0; n < 2; ++n) \
        asm volatile("v_mfma_f32_16x16x32_bf16 %0, %1, %2, %0" : "+v"(acc[ai][bj][m][n]) : "v"(Bt[n][k]), "v"(At[m][k])); __builtin_amdgcn_s_setprio(0); } while (0)
#define PG8_ACC_FENCE1(ai, bj) asm volatile("s_nop 15\n\ts_nop 15" : "+v"(acc[ai][bj][0][0]), "+v"(acc[ai][bj][0][1]), "+v"(acc[ai][bj][1][0]), "+v"(acc[ai][bj][1][1]), "+v"(acc[ai][bj][2][0]), "+v"(acc[ai][bj][2][1]), "+v"(acc[ai][bj][3][0]), "+v"(acc[ai][bj][3][1]))
#define PG8_ACC_FENCE() do { PG8_ACC_FENCE1(0, 0); PG8_ACC_FENCE1(0, 1); PG8_ACC_FENCE1(1, 0); PG8_ACC_FENCE1(1, 1); } while (0)
#define PG8_WAIT_V(n) asm volatile("s_waitcnt vmcnt(" #n ")" ::: "memory")
#define PG8_WAIT_L(n) asm volatile("s_waitcnt lgkmcnt(" #n ")" ::: "memory")
#define PG8_BAR __builtin_amdgcn_s_barrier()
#define PG8_SCHED __builtin_amdgcn_sched_barrier(0)
    Unit cur, nxt; int ui = 0;
    if (!S.next(0, cur)) return;
    f32x4 acc[2][2][4][2];
#pragma unroll
    for (int a = 0; a < 2; ++a)
#pragma unroll
        for (int b = 0; b < 2; ++b)
#pragma unroll
            for (int m = 0; m < 4; ++m)
#pragma unroll
                for (int n = 0; n < 2; ++n) acc[a][b][m][n] = (f32x4){0.f, 0.f, 0.f, 0.f};
    bf16x8 At[4][2], B0[2][2], B1[2][2];
    const size_t kslice = (size_t)g.KU * 2;
    const char* cA = (const char*)g.A + (size_t)cur.pm * tstep + cur.kh * kslice; const char* cB = (const char*)g.Bt + (size_t)cur.pn * tstep + cur.kh * kslice;
    S.a_ready(cur);
    PG8_STAGE(PG8_SB(0, 0), cB, voffB); PG8_STAGE(PG8_SA(0, 0), cA, voffA); PG8_STAGE(PG8_SB(0, 1), cB + hstep, voffB); PG8_STAGE(PG8_SA(0, 1), cA + hstep, voffA);
    if (wr == 1) PG8_BAR;
    PG8_WAIT_V(4); PG8_BAR;
    PG8_STAGE(PG8_SB(1, 0), cB + kstep, voffB); PG8_STAGE(PG8_SA(1, 0), cA + kstep, voffA); PG8_STAGE(PG8_SB(1, 1), cB + hstep + kstep, voffB);
    PG8_WAIT_V(6); PG8_BAR;
    PG8_STAMP();
    for (;;) {
        const bool has_next = S.next(ui + 1, nxt);
        const char* nA = has_next ? (const char*)g.A + (size_t)nxt.pm * tstep + nxt.kh * kslice : cA; const char* nB = has_next ? (const char*)g.Bt + (size_t)nxt.pn * tstep + nxt.kh * kslice : cB;
        const int unt = cur.nt ? cur.nt : nt;
        for (int t = 0; t < unt; t += 2) {
            const bool last = (t == unt - 2);
            const char* a1 = cA + (size_t)(t + 1) * kstep;
            const char* a2 = last ? nA : cA + (size_t)(t + 2) * kstep; const char* b2 = last ? nB : cB + (size_t)(t + 2) * kstep;
            const char* a3 = a2 + kstep; const char* b3 = b2 + kstep;
            if (last && has_next) S.a_ready(nxt);
            PG8_LDB(B0, 0, 0); PG8_SCHED; PG8_LDA(At, 0, 0); PG8_STAGE(PG8_SA(1, 1), a1 + hstep, voffA);
            PG8_WAIT_L(8); PG8_BAR; PG8_WAIT_L(0); PG8_MMA(0, 0, At, B0); PG8_BAR; PG8_SCHED;
            PG8_LDB(B1, 0, 1); PG8_STAGE(PG8_SB(0, 0), b2, voffB);
            PG8_BAR; PG8_WAIT_L(0); PG8_MMA(0, 1, At, B1); PG8_BAR;
            PG8_LDA(At, 0, 1); PG8_STAGE(PG8_SA(0, 0), a2, voffA);
            PG8_BAR; PG8_WAIT_L(0); PG8_MMA(1, 0, At, B0); PG8_BAR; PG8_SCHED;
            PG8_STAGE(PG8_SB(0, 1), b2 + hstep, voffB);
            PG8_WAIT_V(6); PG8_BAR; PG8_MMA(1, 1, At, B1); PG8_BAR;
            PG8_LDB(B0, 1, 0); PG8_SCHED; PG8_LDA(At, 1, 0); PG8_STAGE(PG8_SA(0, 1), a2 + hstep, voffA);
            PG8_WAIT_L(8); PG8_BAR; PG8_WAIT_L(0); PG8_MMA(0, 0, At, B0); PG8_BAR; PG8_SCHED;
            PG8_LDB(B1, 1, 1); PG8_STAGE(PG8_SB(1, 0), b3, voffB);
            PG8_BAR; PG8_WAIT_L(0); PG8_MMA(0, 1, At, B1); PG8_BAR;
            PG8_LDA(At, 1, 1); PG8_STAGE(PG8_SA(1, 0), a3, voffA);
            PG8_BAR; PG8_WAIT_L(0); PG8_MMA(1, 0, At, B0); PG8_BAR; PG8_SCHED;
            PG8_STAGE(PG8_SB(1, 1), b3 + hstep, voffB);
            PG8_WAIT_V(6); PG8_BAR; PG8_MMA(1, 1, At, B1); PG8_BAR;
        }
        PG8_STAMP();
        PG8_ACC_FENCE();
        if constexpr (!Epi::AFTER_DRAIN) { E(acc, cur, wr, wc, fr, fq); S.done(cur); }
        PG8_STAMP();
        if (!has_next) break;
#pragma unroll
        for (int a = 0; a < 2; ++a)
#pragma unroll
            for (int b = 0; b < 2; ++b)
#pragma unroll
                for (int m = 0; m < 4; ++m)
#pragma unroll
                    for (int n = 0; n < 2; ++n) acc[a][b][m][n] = (f32x4){0.f, 0.f, 0.f, 0.f};
        cur = nxt; cA = nA; cB = nB; ++ui;
    }
    PG8_WAIT_V(0);
    if (wr == 0) PG8_BAR;
    PG8_BAR;
    if constexpr (Epi::AFTER_DRAIN) { E.fused(acc, cur, wr, wc, fr, fq, lds, wid, lane); S.done(cur); }
    PG8_STAMP();
    if (STAMP && wid == 0) { stamps[lane] = lane < nts ? (((unsigned long long)(unsigned)ts_hi << 32) | (unsigned)ts_lo) : 0ull;
        if (lane == 62) stamps[62] = rt_entry; if (lane == 63) stamps[63] = (unsigned long long)wall_clock64(); }
#undef PG8_STAMP
#undef PG8_SA
#undef PG8_SB
#undef PG8_STAGE
#undef PG8_LDA
#undef PG8_LDB
#undef PG8_MMA
#undef PG8_ACC_FENCE
#undef PG8_ACC_FENCE1
#undef PG8_WAIT_V
#undef PG8_WAIT_L
#undef PG8_BAR
#undef PG8_SCHED
}
}

#define XB_TMO      128
#define XB_XCNT(j)  (256  + 64 * (j))
#define XB_XSUB(j)  (1280 + 64 * (j))
#define XB_XGEN(j)  (2304 + 64 * (j))
#define XB_TOP      3328
#define XB_TOPGEN   3392
#define XCD_BAR_WORDS 3456
#define XB_SPIN_CAP (1u << 20)
#define LAS __attribute__((address_space(3)))

__device__ __forceinline__ unsigned xb_ld(unsigned* p)              { return __hip_atomic_load(p, __ATOMIC_RELAXED, __HIP_MEMORY_SCOPE_AGENT); }
__device__ __forceinline__ unsigned xb_add(unsigned* p, unsigned v) { return __hip_atomic_fetch_add(p, v, __ATOMIC_RELAXED, __HIP_MEMORY_SCOPE_AGENT); }
__device__ __forceinline__ unsigned xb_xcc_id() { return (unsigned)__builtin_amdgcn_s_getreg((3 << 11) | 20) & 0xFu; }
#define XB_SPIN(cond, bar) do { unsigned _sp = 0; while (cond) { __builtin_amdgcn_s_sleep(1); \
    if ((++_sp & 255u) == 0u) { if (xb_ld(&(bar)[XB_TMO])) break; if (_sp > XB_SPIN_CAP) { atomicAdd(&(bar)[XB_TMO], 1u); break; } } } } while (0)

struct XcdBarrier {
    unsigned* bar; unsigned x;
    volatile LAS unsigned* st;
};

__device__ __forceinline__ XcdBarrier xcd_barrier_post(unsigned* bar, volatile LAS unsigned* st) {
    XcdBarrier b; b.bar = bar; b.x = xb_xcc_id(); b.st = st;
    if (threadIdx.x == 0) (void)xb_add(&bar[XB_XCNT(b.x)], 1u);
    return b;
}
__device__ __forceinline__ void xcd_barrier_complete(unsigned* bar, unsigned x, unsigned& nloc, unsigned& nx) {
    const unsigned G = gridDim.x * gridDim.y * gridDim.z;
    unsigned sum, cnt, mine, sp = 0u;
    for (;;) {
        sum = 0u; cnt = 0u; mine = 0u;
#pragma unroll
        for (unsigned j = 0; j < 16; ++j) { const unsigned c = xb_ld(&bar[XB_XCNT(j)]); sum += c; cnt += (c > 0u) ? 1u : 0u; mine = (j == x) ? c : mine; }
        if (sum == G) break;
        __builtin_amdgcn_s_sleep(1);
        if ((++sp & 255u) == 0u) { if (xb_ld(&bar[XB_TMO])) break; if (sp > XB_SPIN_CAP) { atomicAdd(&bar[XB_TMO], 1u); break; } }
    }
    nloc = mine > 0u ? mine : 1u; nx = cnt > 0u ? cnt : 1u;
}

__device__ __forceinline__ void xcd_barrier(const XcdBarrier& b) {
    asm volatile("s_waitcnt vmcnt(0)" ::: "memory");
    __syncthreads();
    if (threadIdx.x == 0) {
        unsigned* bar = b.bar;
        __builtin_amdgcn_s_waitcnt(0);
        unsigned nloc = b.st[0], nx = b.st[1];
        if (nloc == 0u) { xcd_barrier_complete(bar, b.x, nloc, nx); b.st[0] = nloc; b.st[1] = nx; }
        const unsigned old = xb_add(&bar[XB_XSUB(b.x)], 1u);
        const unsigned gen = old / nloc;
        if (old + 1u == (gen + 1u) * nloc) {
            __builtin_amdgcn_fence(__ATOMIC_RELEASE, "agent");
            asm volatile("s_waitcnt vmcnt(0)" ::: "memory");
            const unsigned og = xb_add(&bar[XB_TOP], 1u);
            const unsigned tg = og / nx;
            if (og + 1u == (tg + 1u) * nx) xb_add(&bar[XB_TOPGEN], 1u);
            else XB_SPIN(xb_ld(&bar[XB_TOPGEN]) == tg, bar);
            __builtin_amdgcn_fence(__ATOMIC_ACQUIRE, "agent");
            xb_add(&bar[XB_XGEN(b.x)], 1u);
            asm volatile("s_waitcnt vmcnt(0)" ::: "memory");
        } else {
            XB_SPIN(xb_ld(&bar[XB_XGEN(b.x)]) == gen, bar);
            __builtin_amdgcn_fence(__ATOMIC_ACQUIRE, "agent");
            asm volatile("s_waitcnt vmcnt(0)" ::: "memory");
        }
    }
    __syncthreads();
}

typedef unsigned short bf16_t;
typedef short bf16x8 __attribute__((ext_vector_type(8)));
typedef short bf16x4 __attribute__((ext_vector_type(4)));
typedef float f32x2 __attribute__((ext_vector_type(2)));
typedef float f32x4 __attribute__((ext_vector_type(4)));
typedef float f32x16 __attribute__((ext_vector_type(16)));
typedef unsigned u32x4 __attribute__((ext_vector_type(4)));
typedef unsigned u32x2 __attribute__((ext_vector_type(2)));

constexpr int D = 2048, FF = 8192, MP = 4096, MS = 8192, MT = 12288;
constexpr int NPANEL = MT / 256;
constexpr size_t MiB = 1u << 20;
constexpr size_t WS_CTL = 0, WS_MOD = 1 * MiB, WS_ZERO_BYTES = 3 * MiB;
constexpr size_t WS_ROPE = 3 * MiB;
constexpr size_t WS_W1T = 4 * MiB, WS_W2T = 132 * MiB, WS_WQKVT = 260 * MiB, WS_WOT = 284 * MiB, WS_HYINT = 300 * MiB, WS_HYOUTT = 324 * MiB;
constexpr size_t WS_RWBT = 332 * MiB, WS_LORA2T = 359 * MiB, WS_RWOT = 364 * MiB, WS_KC = 372 * MiB, WS_VC = 380 * MiB, WS_FGS = 388 * MiB, WS_FGP = 397 * MiB;
constexpr size_t WS_X = 400 * MiB, WS_H = 496 * MiB, WS_ARENA = 544 * MiB, WS_INVSQ = 1186 * MiB, WS_END = 1188 * MiB;
constexpr size_t AR_U = 0;
constexpr size_t AR_Q = 0, AR_K = 48 * MiB, AR_V = 60 * MiB, AR_O = 72 * MiB;
constexpr size_t AR_P = 0, AR_X0 = 144 * MiB, AR_ZT = 192 * MiB, AR_YT = 240 * MiB, AR_HO = 288 * MiB;
constexpr size_t AR_XMIX = 0, AR_LD = 546 * MiB  , AR_LA = 96 * MiB, AR_G = 192 * MiB, AR_RO = 240 * MiB, AR_R = 288 * MiB, AR_KK = 336 * MiB, AR_VV = 384 * MiB, AR_A3 = 432 * MiB, AR_YB = 450 * MiB;
constexpr size_t OUT_Y = 0, OUT_NK = 25165824, OUT_NV = 29360128, OUT_ST = 33554432;
constexpr int FGS_ROW = 2112, FGP_ROW = 576;
constexpr size_t AR_FILT = 600 * MiB;
constexpr int LDS_BAR_OFF = 147456, LDS_BYTES = 147456 + 1024;

enum { I_XP = 0, I_XS, I_CK, I_CV, I_ST, I_C, I_CCTX, I_ADAW, I_ADAB, I_N1G, I_N2G, I_MW1, I_MW2, I_WQKV, I_WO, I_SINK, I_HYWIN, I_HYCW, I_HYCB, I_FW1, I_FB1, I_FW2, I_FB2, I_FW3, I_FB3,
       I_FREQ, I_FWOUT, I_HYBIAS, I_HYWOUT, I_MU, I_WR, I_WK, I_WV, I_RWO, I_W0, I_W1, I_W2, I_A0, I_A1, I_A2, I_G1, I_G2, I_KK, I_KA, I_RK, I_LNW, I_LNB, I_FNG, N_IN };

struct Params { const float* in[N_IN]; float* out; unsigned char* ws; int ph_lo, ph_hi; };

__device__ __forceinline__ unsigned cvt_pk(float lo, float hi) { unsigned r; asm("v_cvt_pk_bf16_f32 %0, %1, %2" : "=v"(r) : "v"(lo), "v"(hi)); return r; }
__device__ __forceinline__ float bflo(unsigned w) { return __uint_as_float(w << 16); }
__device__ __forceinline__ float bfhi(unsigned w) { return __uint_as_float(w & 0xffff0000u); }
__device__ __forceinline__ float bf2f(bf16_t b) { return __uint_as_float(((unsigned)b) << 16); }
__device__ __forceinline__ float dpp_f(float x, const int ctrl) { return x; }
#define DPP_ADD(x, ctrl) ((x) + __int_as_float(__builtin_amdgcn_update_dpp(0, __float_as_int(x), (ctrl), 0xF, 0xF, true)))
__device__ __forceinline__ float wave_sum(float v) {
    v = DPP_ADD(v, 0xB1); v = DPP_ADD(v, 0x4E); v = DPP_ADD(v, 0x141); v = DPP_ADD(v, 0x140);
    const int vi = __float_as_int(v);
    const float r0 = __int_as_float(__builtin_amdgcn_readlane(vi, 0)), r1 = __int_as_float(__builtin_amdgcn_readlane(vi, 16)),
                r2 = __int_as_float(__builtin_amdgcn_readlane(vi, 32)), r3 = __int_as_float(__builtin_amdgcn_readlane(vi, 48));
    return (r0 + r1) + (r2 + r3);
}
__device__ __forceinline__ float opaque_zero() { float z; asm volatile("v_mov_b32 %0, 0" : "=v"(z)); return z; }
__device__ __forceinline__ float fexp2(float x) { return __builtin_amdgcn_exp2f(x); }
__device__ __forceinline__ float fexp(float x) { return __builtin_amdgcn_exp2f(x * 1.4426950408889634f); }
__device__ __forceinline__ float flog(float x) { return __builtin_amdgcn_logf(x) * 0.6931471805599453f; }
__device__ __forceinline__ float frcp(float x) { return __builtin_amdgcn_rcpf(x); }
__device__ __forceinline__ float fsigmoid(float x) { return frcp(1.0f + fexp(-x)); }
__device__ __forceinline__ float ftanh(float x) { const float e = fexp(2.0f * x); return 1.0f - 2.0f * frcp(e + 1.0f); }
__device__ __forceinline__ float fsoftplus(float x) { return fmaxf(x, 0.0f) + flog(1.0f + fexp(-fabsf(x))); }
__device__ __forceinline__ float fsin_rev(float rev) { return __builtin_amdgcn_sinf(rev - rintf(rev)); }
__device__ __forceinline__ float fcos_rev(float rev) { return __builtin_amdgcn_cosf(rev - rintf(rev)); }
__device__ __forceinline__ float fsin(float x) { return fsin_rev(x * 0.15915494309189535f); }
__device__ __forceinline__ int cond_of_row(int m) { return m < MP ? 0 : 1 + ((m - MP) >> 10); }
__device__ __forceinline__ int cond_of_panel(int pm) { return pm < 16 ? 0 : 1 + ((pm - 16) >> 2); }

struct Ctx {
    LAS unsigned char* lds;
    int tid, lane, wave, G, bid;
    float* out;
    unsigned char* ws;
};
template <int IDX> __device__ __forceinline__ const float* karg() {
    unsigned long long v;
    asm volatile("s_load_dwordx2 %0, %1, %2\n\ts_waitcnt lgkmcnt(0)" : "=s"(v) : "s"(__builtin_amdgcn_kernarg_segment_ptr()), "n"(IDX * 8));
    return (const float*)v;
}
#define WSP(T, off) ((T*)(C.ws + (off)))
#define MODP(l, cond, which) (WSP(float, WS_MOD) + ((size_t)((l) * 9 + (cond)) * 6 + (which)) * D)

__device__ __forceinline__ void p0_transpose_item(const float* W, int K, int N, bf16_t* WT, LAS float* scr, int item, int lane) {
    const int nblk = N / 32, kb = item / nblk, nb = item % nblk, k0 = 64 * kb, n0 = 32 * nb;
    const int rsub = lane >> 3, c4 = (lane & 7) * 4;
    f32x4 v[8];
#pragma unroll
    for (int i = 0; i < 8; ++i) v[i] = *(const f32x4*)(W + (size_t)(k0 + 8 * i + rsub) * N + n0 + c4);
#pragma unroll
    for (int i = 0; i < 8; ++i) { LAS float* d = scr + (8 * i + rsub) * 33 + c4; d[0] = v[i].x; d[1] = v[i].y; d[2] = v[i].z; d[3] = v[i].w; }
    asm volatile("s_waitcnt lgkmcnt(0)" ::: "memory");
    const int c = lane & 7;
#pragma unroll
    for (int j = 0; j < 4; ++j) { const int n = (lane >> 3) + 8 * j; const LAS float* s = scr + (8 * c) * 33 + n;
        u32x4 o; o.x = cvt_pk(s[0 * 33], s[1 * 33]); o.y = cvt_pk(s[2 * 33], s[3 * 33]); o.z = cvt_pk(s[4 * 33], s[5 * 33]); o.w = cvt_pk(s[6 * 33], s[7 * 33]);
        *(u32x4*)(WT + (size_t)(n0 + n) * K + k0 + 8 * c) = o; }
    asm volatile("s_waitcnt lgkmcnt(0)" ::: "memory");
}

__device__ __forceinline__ void late_transposes(const Ctx& C, LAS float* scr, int wv, int nwv) {
    constexpr int I_M = 8192, I_QKV = 3072, I_O = 2048;
    constexpr int NIT = 4 * I_M + I_QKV + I_O;
    for (int it = wv; it < NIT; it += nwv) {
        int r = it;
        if (r < 2 * I_M) { const int l = 2 + r / I_M; p0_transpose_item(karg<I_MW1>() + (size_t)l * D * FF, D, FF, WSP(bf16_t, WS_W1T) + (size_t)l * D * FF, scr, r % I_M, C.lane); continue; } r -= 2 * I_M;
        if (r < 2 * I_M) { const int l = 2 + r / I_M; p0_transpose_item(karg<I_MW2>() + (size_t)l * D * FF, FF, D, WSP(bf16_t, WS_W2T) + (size_t)l * D * FF, scr, r % I_M, C.lane); continue; } r -= 2 * I_M;
        if (r < I_QKV) { p0_transpose_item(karg<I_WQKV>() + (size_t)D * 3072, D, 3072, WSP(bf16_t, WS_WQKVT) + (size_t)D * 3072, scr, r, C.lane); continue; } r -= I_QKV;
        p0_transpose_item(karg<I_WO>() + (size_t)D * D, D, D, WSP(bf16_t, WS_WOT) + (size_t)D * D, scr, r, C.lane);
    }
}
#ifndef MK_PRO_MASK
#define MK_PRO_MASK 127
#endif
__device__ __forceinline__ void phase_prologue(const Ctx& C) {
    const int gw = C.bid * 8 + C.wave, NGW = C.G * 8, lane = C.lane;
    const size_t gt = (size_t)C.bid * 512 + C.tid, NGT = (size_t)C.G * 512;
    LAS float* scr = (LAS float*)(C.lds + C.wave * 16384);
    if (MK_PRO_MASK & 1)
    {
        constexpr int I_M1 = 8192, I_M2 = 8192, I_QKV = 3072, I_O = 2048, I_HI = 6144, I_SQ = 2048;
        constexpr int NIT = 2 * I_M1 + 2 * I_M2 + I_QKV + I_O + I_HI + I_SQ + 4 * I_SQ;
        for (int it = gw; it < NIT; it += NGW) {
            int r = it;
            if (r < 2 * I_M1) { const int l = r / I_M1; p0_transpose_item(karg<I_MW1>() + (size_t)l * D * FF, D, FF, WSP(bf16_t, WS_W1T) + (size_t)l * D * FF, scr, r % I_M1, lane); continue; } r -= 2 * I_M1;
            if (r < 2 * I_M2) { const int l = r / I_M2; p0_transpose_item(karg<I_MW2>() + (size_t)l * D * FF, FF, D, WSP(bf16_t, WS_W2T) + (size_t)l * D * FF, scr, r % I_M2, lane); continue; } r -= 2 * I_M2;
            if (r < I_QKV) { p0_transpose_item(karg<I_WQKV>(), D, 3072, WSP(bf16_t, WS_WQKVT), scr, r, lane); continue; } r -= I_QKV;
            if (r < I_O) { p0_transpose_item(karg<I_WO>(), D, D, WSP(bf16_t, WS_WOT), scr, r, lane); continue; } r -= I_O;
            if (r < I_HI) { p0_transpose_item(karg<I_HYWIN>(), D, 6144, WSP(bf16_t, WS_HYINT), scr, r, lane); continue; } r -= I_HI;
            if (r < I_SQ) { p0_transpose_item(karg<I_HYWOUT>(), D, D, WSP(bf16_t, WS_HYOUTT), scr, r, lane); continue; } r -= I_SQ;
            if (r < I_SQ) { p0_transpose_item(karg<I_WR>(), D, D, WSP(bf16_t, WS_RWBT), scr, r, lane); continue; } r -= I_SQ;
            if (r < I_SQ) { p0_transpose_item(karg<I_WK>(), D, D, WSP(bf16_t, WS_RWBT) + (size_t)D * D, scr, r, lane); continue; } r -= I_SQ;
            if (r < I_SQ) { p0_transpose_item(karg<I_WV>(), D, D, WSP(bf16_t, WS_RWBT) + (size_t)2 * D * D, scr, r, lane); continue; } r -= I_SQ;
            p0_transpose_item(karg<I_RWO>(), D, D, WSP(bf16_t, WS_RWOT), scr, r, lane);
        }
    }
    if (MK_PRO_MASK & 2)
    {
        bf16_t* L1 = WSP(bf16_t, WS_RWBT) + (size_t)3 * D * D;
#pragma unroll
        for (int part = 0; part < 7; ++part) {
            const int row0 = part == 0 ? 0 : part == 1 ? 96 : part == 2 ? 192 : part == 3 ? 256 : part == 4 ? 352 : part == 5 ? 448 : 512;
            const int nrow = (part == 2 || part == 5) ? 64 : (part == 6 ? 256 : 96);
            const int ld = part == 6 ? 256 : 96;
            const float* src = part == 0 ? karg<I_W1>() : part == 1 ? karg<I_W1>() + (size_t)D * 96 : part == 3 ? karg<I_A1>() : part == 4 ? karg<I_A1>() + (size_t)D * 96 : karg<I_G1>();
            const bool zero = (part == 2 || part == 5);
            for (size_t i = gt; i < (size_t)nrow * 256; i += NGT) {
                const int rr = (int)(i / 256), k8 = (int)(i % 256);
                float v[8];
#pragma unroll
                for (int j = 0; j < 8; ++j) v[j] = zero ? 0.0f : src[(size_t)(8 * k8 + j) * ld + rr];
                u32x4 o; o.x = cvt_pk(v[0], v[1]); o.y = cvt_pk(v[2], v[3]); o.z = cvt_pk(v[4], v[5]); o.w = cvt_pk(v[6], v[7]);
                *(u32x4*)(L1 + (size_t)(row0 + rr) * D + 8 * k8) = o;
            }
        }
        bf16_t* L2 = WSP(bf16_t, WS_LORA2T);
#pragma unroll
        for (int mat = 0; mat < 5; ++mat) {
            const float* src = mat == 0 ? karg<I_W2>() : mat == 1 ? karg<I_W2>() + (size_t)96 * D : mat == 2 ? karg<I_A2>() : mat == 3 ? karg<I_A2>() + (size_t)96 * D : karg<I_G2>();
            const int kofs = (mat == 1 || mat == 3) ? 96 : 0, klen = mat == 4 ? 256 : 96;
            for (size_t i = gt; i < (size_t)2048 * 32; i += NGT) {
                const int n = (int)(i / 32), k8 = (int)(i % 32);
                float v[8];
#pragma unroll
                for (int j = 0; j < 8; ++j) { const int k = 8 * k8 + j - kofs; const int kc = k < 0 ? 0 : (k >= klen ? klen - 1 : k); const float x = src[(size_t)kc * D + n]; v[j] = (k >= 0 && k < klen) ? x : 0.0f; }
                u32x4 o; o.x = cvt_pk(v[0], v[1]); o.y = cvt_pk(v[2], v[3]); o.z = cvt_pk(v[4], v[5]); o.w = cvt_pk(v[6], v[7]);
                *(u32x4*)(L2 + ((size_t)mat * 2048 + n) * 256 + 8 * k8) = o;
            }
        }
    }
    if (MK_PRO_MASK & 4)
    for (size_t i = gt; i < 2048; i += NGT) {
        const int pos = (int)(i >> 5), fi = (int)(i & 31);
        const float inv = fexp2(-(float)(2 * fi) * (13.287712379549449f / 64.0f));
        const float rev = (float)pos * inv * 0.15915494309189535f;
        WSP(f32x2, WS_ROPE)[i] = (f32x2){fcos_rev(rev), fsin_rev(rev)};
    }
    for (size_t i = gt; i < (size_t)MT * 32 / 4; i += NGT) WSP(f32x4, WS_INVSQ)[i] = (f32x4){0.f, 0.f, 0.f, 0.f};
    if (MK_PRO_MASK & 8)
    { const float *ckp = karg<I_CK>(), *cvp = karg<I_CV>();
    for (size_t i = gt; i < (size_t)2 * 524288; i += NGT) {
        const bool isv = i >= 524288; const size_t e = (isv ? i - 524288 : i) * 8;
        const float* src = (isv ? cvp : ckp) + e;
        const f32x4 a = *(const f32x4*)src, b = *(const f32x4*)(src + 4);
        u32x4 o; o.x = cvt_pk(a.x, a.y); o.y = cvt_pk(a.z, a.w); o.z = cvt_pk(b.x, b.y); o.w = cvt_pk(b.z, b.w);
        *(u32x4*)(WSP(bf16_t, isv ? WS_VC : WS_KC) + e) = o;
    } }
    if (MK_PRO_MASK & 32)
    {
        __syncthreads();
        LAS float* tab = (LAS float*)C.lds;
        LAS float* red = (LAS float*)(C.lds + 73728);
        const float *cctx = karg<I_CCTX>(), *cc = karg<I_C>();
        for (int e = C.tid; e < 9 * D; e += 512) { const int j = e >> 11, k = e & (D - 1);
            const float cv = j == 0 ? cctx[k] : cc[(size_t)(j == 0 ? 0 : j - 1) * D + k]; tab[e] = cv * fsigmoid(cv); }
        __syncthreads();
        const float* adaw = karg<I_ADAW>(); const float* adab = karg<I_ADAB>();
        for (int it = C.bid; it < 4 * 192; it += C.G) {
            const int nb = it % 192, l = it / 192, w = C.wave;
            float acc[9];
#pragma unroll
            for (int j = 0; j < 9; ++j) acc[j] = 0.f;
            const float* wp = adaw + ((size_t)l * D + 256 * w) * (6 * D) + nb * 64 + lane;
#pragma unroll 4
            for (int k4 = 0; k4 < 256; k4 += 4) {
                const float w0 = wp[(size_t)(k4 + 0) * (6 * D)], w1 = wp[(size_t)(k4 + 1) * (6 * D)], w2 = wp[(size_t)(k4 + 2) * (6 * D)], w3 = wp[(size_t)(k4 + 3) * (6 * D)];
#pragma unroll
                for (int j = 0; j < 9; ++j) { const f32x4 sv = *(const LAS f32x4*)(tab + j * D + 256 * w + k4); acc[j] += (w0 * sv.x + w1 * sv.y) + (w2 * sv.z + w3 * sv.w); }
            }
#pragma unroll
            for (int j = 0; j < 9; ++j) red[(w * 9 + j) * 64 + lane] = acc[j];
            __syncthreads();
            for (int e = C.tid; e < 9 * 64; e += 512) { const int j = e >> 6, c = e & 63; float sum = adab[(size_t)l * 6 * D + nb * 64 + c];
#pragma unroll
                for (int ww = 0; ww < 8; ++ww) sum += red[(ww * 9 + j) * 64 + c];
                WSP(float, WS_MOD)[((size_t)l * 9 + j) * 6 * D + nb * 64 + c] = sum; }
            __syncthreads();
        }
    }
    if (MK_PRO_MASK & 64)
    {
        const float *fw1 = karg<I_FW1>(), *fw2 = karg<I_FW2>(), *fw3 = karg<I_FW3>(), *fwout = karg<I_FWOUT>(), *hbias = karg<I_HYBIAS>();
        const float fq = karg<I_FREQ>()[lane]; const float fb1 = karg<I_FB1>()[lane], fb2 = karg<I_FB2>()[lane], fb3 = karg<I_FB3>()[lane];
        for (int it = C.bid; it < 160; it += C.G) {
            const bool smp = it >= 32; const int nbase = (smp ? it - 32 : it) * 8; const int L = smp ? 1024 : 256; const int n = nbase + C.wave;
            float* FILT = WSP(float, WS_ARENA + AR_FILT) + (smp ? 0 : (size_t)1024 * 4096);
            __syncthreads();
            if (lane < 33) {
                float z;
                if (lane == 0) z = (float)n / (float)(L - 1);
                else { const int i = (lane - 1) & 15; const float fr = 1e-4f + (float)i * ((15.0f - 1e-4f) / 15.0f); const float rev = fr * (float)n / (float)L;
                       z = lane <= 16 ? fcos_rev(rev) : -fsin_rev(rev); }
                scr[lane] = z;
            }
            asm volatile("s_waitcnt lgkmcnt(0)" ::: "memory");
            float pre = fb1;
#pragma unroll 3
            for (int e = 0; e < 33; ++e) pre += scr[e] * fw1[e * 64 + lane];
            float hv = fsin(fq * pre);
            asm volatile("s_waitcnt lgkmcnt(0)" ::: "memory");
            scr[64 + lane] = hv;
            asm volatile("s_waitcnt lgkmcnt(0)" ::: "memory");
            pre = fb2;
#pragma unroll 4
            for (int e = 0; e < 64; ++e) pre += scr[64 + e] * fw2[e * 64 + lane];
            hv = fsin(fq * pre);
            asm volatile("s_waitcnt lgkmcnt(0)" ::: "memory");
            scr[128 + lane] = hv;
            asm volatile("s_waitcnt lgkmcnt(0)" ::: "memory");
            pre = fb3;
#pragma unroll 4
            for (int e = 0; e < 64; ++e) pre += scr[128 + e] * fw3[e * 64 + lane];
            hv = fsin(fq * pre);
            scr[1024 + lane] = hv;
            __syncthreads();
            float acc[8][8];
#pragma unroll
            for (int nn = 0; nn < 8; ++nn)
#pragma unroll
                for (int i = 0; i < 8; ++i) acc[nn][i] = 0.f;
            const float* wo = fwout + 512 * C.wave + lane;
#pragma unroll 2
            for (int e = 0; e < 64; ++e) {
                float wv[8];
#pragma unroll
                for (int i = 0; i < 8; ++i) wv[i] = wo[(size_t)e * 4096 + i * 64];
#pragma unroll
                for (int nn = 0; nn < 8; ++nn) { const float hh = ((const LAS float*)(C.lds + nn * 16384))[1024 + e];
#pragma unroll
                    for (int i = 0; i < 8; ++i) acc[nn][i] += hh * wv[i]; }
            }
#pragma unroll
            for (int nn = 0; nn < 8; ++nn) { const int n2 = nbase + nn; const float tn = (float)n2 / (float)(L - 1);
#pragma unroll
                for (int i = 0; i < 8; ++i) {
                    const int o = 512 * C.wave + i * 64 + lane, dir = o >> 11, c = o & 2047;
                    const float delta = -3.0701134573253944f + (float)c * ((-15.350567286626972f + 3.0701134573253944f) / 2047.0f);
                    float val = acc[nn][i] * fexp(-tn * fabsf(delta));
                    if (dir == 0 && n2 == 0) val += hbias[c];
                    FILT[(size_t)n2 * 4096 + o] = val;
                } }
        }
        __syncthreads();
    }
}

__device__ __forceinline__ void phase_fg_transpose(const Ctx& C) {
    const int tid = C.tid;
    LAS float* tl = (LAS float*)C.lds;
    for (int it = C.bid; it < 1280; it += C.G) {
        const bool smp = it < 1024; const int q = smp ? it : it - 1024;
        const int L = smp ? 1024 : 256, ROW = smp ? FGS_ROW : FGP_ROW;
        const int cbk = q & 31, nb = smp ? (q >> 5) & 15 : (q >> 5) & 3, dir = smp ? q >> 9 : q >> 7;
        const float* FILT = WSP(float, WS_ARENA + AR_FILT) + (smp ? 0 : (size_t)1024 * 4096);
        bf16_t* FG = WSP(bf16_t, smp ? WS_FGS : WS_FGP);
        const int n0 = nb * 64 + dir;
        __syncthreads();
        { const int nl = tid >> 3, c8 = tid & 7; const int n = n0 + nl;
          f32x4 a = (f32x4){0.f, 0.f, 0.f, 0.f}, b = a;
          const int nc = n < L ? n : L - 1;
          const float* src = FILT + (size_t)nc * 4096 + dir * 2048 + cbk * 64 + 8 * c8;
          a = *(const f32x4*)src; b = *(const f32x4*)(src + 4);
          if (n >= L) { a = (f32x4){0.f, 0.f, 0.f, 0.f}; b = a; }
          LAS float* d = tl + nl * 65 + 8 * c8;
          d[0] = a.x; d[1] = a.y; d[2] = a.z; d[3] = a.w; d[4] = b.x; d[5] = b.y; d[6] = b.z; d[7] = b.w; }
        __syncthreads();
        { const int cl = tid >> 3, i8 = tid & 7;
          float v[8];
#pragma unroll
          for (int j = 0; j < 8; ++j) { const int il = 8 * i8 + j; const int nl = dir ? il : 63 - il; v[j] = tl[nl * 65 + cl]; }
          const int idx0 = dir ? (L + nb * 64) : (L - 64 - nb * 64);
          u32x4 o; o.x = cvt_pk(v[0], v[1]); o.y = cvt_pk(v[2], v[3]); o.z = cvt_pk(v[4], v[5]); o.w = cvt_pk(v[6], v[7]);
          bf16_t* dst = FG + (size_t)(cbk * 64 + cl) * ROW;
          *(u32x4*)(dst + idx0 + 8 * i8) = o;
          if (dir && nb * 64 + 64 == L) *(u32x4*)(dst + 2 * L + 8 * i8) = (u32x4){0u, 0u, 0u, 0u}; }
    }
    __syncthreads();
}

__device__ __forceinline__ void phase_norm_mod(const Ctx& C, const float* Xp, const float* Xs, const float* g, int layer, int which_sh, bf16_t* H, const bf16_t* P1 = nullptr, float* Xw = nullptr) {
    const int gw = C.bid * 8 + C.wave, NGW = C.G * 8, lane = C.lane;
    for (int m = gw; m < MT; m += NGW) {
        const int cond = cond_of_row(m);
        const float* sh = MODP(layer, cond, which_sh); const float* sc = MODP(layer, cond, which_sh + 1);
        const f32x4* xr = (const f32x4*)(m < MP ? Xp + (size_t)m * D : Xs + (size_t)(m - MP) * D) + lane;
        f32x4 v[8]; float ss = 0.f;
#pragma unroll
        for (int j = 0; j < 8; ++j) { v[j] = xr[64 * j]; if (P1) { const u32x2 pw = ((const u32x2*)(P1 + (size_t)m * D) + lane)[64 * j]; v[j] += (f32x4){bflo(pw.x), bfhi(pw.x), bflo(pw.y), bfhi(pw.y)}; ((f32x4*)(Xw + (size_t)m * D) + lane)[64 * j] = v[j]; }
            ss += (v[j].x * v[j].x + v[j].y * v[j].y) + (v[j].z * v[j].z + v[j].w * v[j].w); }
        const float rstd = __builtin_amdgcn_rsqf(wave_sum(ss) * (1.0f / D) + 1e-6f);
        u32x2* o = (u32x2*)(H + (size_t)m * D) + lane;
#pragma unroll
        for (int j = 0; j < 8; ++j) {
            const f32x4 gv = ((const f32x4*)g)[lane + 64 * j], sv = ((const f32x4*)sh)[lane + 64 * j], cv = ((const f32x4*)sc)[lane + 64 * j];
            const f32x4 y = (v[j] * rstd * gv) * (cv + 1.0f) + sv;
            u32x2 w; w.x = cvt_pk(y.x, y.y); w.y = cvt_pk(y.z, y.w); o[64 * j] = w;
        }
    }
}
__device__ __forceinline__ void phase_norm_final(const Ctx& C, const float* X, const float* g, float* out, const bf16_t* P1 = nullptr) {
    const int gw = C.bid * 8 + C.wave, NGW = C.G * 8, lane = C.lane;
    for (int m = gw; m < MT; m += NGW) {
        const f32x4* xr = (const f32x4*)(X + (size_t)m * D) + lane;
        f32x4 v[8]; float ss = 0.f;
#pragma unroll
        for (int j = 0; j < 8; ++j) { v[j] = xr[64 * j]; if (P1) { const u32x2 pw = ((const u32x2*)(P1 + (size_t)m * D) + lane)[64 * j]; v[j] += (f32x4){bflo(pw.x), bfhi(pw.x), bflo(pw.y), bfhi(pw.y)}; } ss += (v[j].x * v[j].x + v[j].y * v[j].y) + (v[j].z * v[j].z + v[j].w * v[j].w); }
        const float rstd = __builtin_amdgcn_rsqf(wave_sum(ss) * (1.0f / D) + 1e-6f);
        f32x4* o = (f32x4*)(out + (size_t)m * D) + lane;
#pragma unroll
        for (int j = 0; j < 8; ++j) o[64 * j] = v[j] * rstd * ((const f32x4*)g)[lane + 64 * j];
    }
}

__device__ __forceinline__ void unpack8(const u32x4 w, float (&f)[8]) { f[0] = bflo(w.x); f[1] = bfhi(w.x); f[2] = bflo(w.y); f[3] = bfhi(w.y); f[4] = bflo(w.z); f[5] = bfhi(w.z); f[6] = bflo(w.w); f[7] = bfhi(w.w); }
__device__ __forceinline__ u32x4 pack8(const float (&f)[8]) { u32x4 o; o.x = cvt_pk(f[0], f[1]); o.y = cvt_pk(f[2], f[3]); o.z = cvt_pk(f[4], f[5]); o.w = cvt_pk(f[6], f[7]); return o; }
__device__ __forceinline__ void phase_norm_mod_b(const Ctx& C, const bf16_t* X, const float* g, int layer, int which_sh, bf16_t* H, const bf16_t* P1 = nullptr, bf16_t* Xw = nullptr, int p1_row0 = 0) {
    const int gw = C.bid * 8 + C.wave, NGW = C.G * 8, lane = C.lane;
    f32x4 gv[4][2];
#pragma unroll
    for (int j = 0; j < 4; ++j)
#pragma unroll
        for (int h = 0; h < 2; ++h) gv[j][h] = ((const f32x4*)g)[2 * (lane + 64 * j) + h];
    u32x4 xa[4], pa[4]; f32x4 sv[4][2], cv[4][2];
#define NM_LOAD(m_) do { const int cond_ = cond_of_row(m_); const f32x4* sh_ = (const f32x4*)MODP(layer, cond_, which_sh); const f32x4* sc_ = (const f32x4*)MODP(layer, cond_, which_sh + 1); \
        _Pragma("unroll") for (int j = 0; j < 4; ++j) { xa[j] = ((const u32x4*)(X + (size_t)(m_) * D) + lane)[64 * j]; if (P1 && (m_) >= p1_row0) pa[j] = ((const u32x4*)(P1 + (size_t)(m_) * D) + lane)[64 * j]; } \
        _Pragma("unroll") for (int j = 0; j < 4; ++j) { _Pragma("unroll") for (int h = 0; h < 2; ++h) { const int ci_ = 2 * (lane + 64 * j) + h; sv[j][h] = sh_[ci_]; cv[j][h] = sc_[ci_]; } } } while (0)
    int m = gw;
    if (m < MT) NM_LOAD(m);
    for (; m < MT; m += NGW) {
        const bool fold = P1 && m >= p1_row0;
        float v[4][8]; float ss = 0.f;
#pragma unroll
        for (int j = 0; j < 4; ++j) {
            unpack8(xa[j], v[j]);
            if (fold) { float p[8]; unpack8(pa[j], p);
#pragma unroll
                for (int e = 0; e < 8; ++e) v[j][e] += p[e]; }
#pragma unroll
            for (int e = 0; e < 8; ++e) ss += v[j][e] * v[j][e];
        }
        const float rstd = __builtin_amdgcn_rsqf(wave_sum(ss) * (1.0f / D) + 1e-6f);
        u32x4 xo[4], ho[4];
#pragma unroll
        for (int j = 0; j < 4; ++j) {
            if (fold) xo[j] = pack8(v[j]);
            float y[8];
#pragma unroll
            for (int h = 0; h < 2; ++h)
#pragma unroll
                for (int e = 0; e < 4; ++e) y[4 * h + e] = (v[j][4 * h + e] * rstd * gv[j][h][e]) * (cv[j][h][e] + 1.0f) + sv[j][h][e];
            ho[j] = pack8(y);
        }
        const int mn = m + NGW;
        if (mn < MT) NM_LOAD(mn);
        asm volatile("" ::: "memory");
#pragma unroll
        for (int j = 0; j < 4; ++j) { if (fold) ((u32x4*)(Xw + (size_t)m * D) + lane)[64 * j] = xo[j]; ((u32x4*)(H + (size_t)m * D) + lane)[64 * j] = ho[j]; }
    }
#undef NM_LOAD
}
__device__ __forceinline__ void phase_norm_final_b(const Ctx& C, const bf16_t* X, const float* g, float* out, const bf16_t* P1 = nullptr, int p1_row0 = 0) {
    const int gw = C.bid * 8 + C.wave, NGW = C.G * 8, lane = C.lane;
    for (int m = gw; m < MT; m += NGW) {
        const u32x4* xr = (const u32x4*)(X + (size_t)m * D) + lane;
        float v[4][8]; float ss = 0.f;
#pragma unroll
        for (int j = 0; j < 4; ++j) {
            unpack8(xr[64 * j], v[j]);
            if (P1 && m >= p1_row0) { float p[8]; unpack8(((const u32x4*)(P1 + (size_t)m * D) + lane)[64 * j], p);
#pragma unroll
                for (int e = 0; e < 8; ++e) v[j][e] += p[e]; }
#pragma unroll
            for (int e = 0; e < 8; ++e) ss += v[j][e] * v[j][e];
        }
        const float rstd = __builtin_amdgcn_rsqf(wave_sum(ss) * (1.0f / D) + 1e-6f);
        f32x4* o = (f32x4*)(out + (size_t)m * D);
#pragma unroll
        for (int j = 0; j < 4; ++j)
#pragma unroll
            for (int h = 0; h < 2; ++h) {
                const int ci = 2 * (lane + 64 * j) + h;
                const f32x4 gv = ((const f32x4*)g)[ci];
                f32x4 y;
#pragma unroll
                for (int e = 0; e < 4; ++e) y[e] = v[j][4 * h + e] * rstd * gv[e];
                o[ci] = y;
            }
    }
}

using pg8::Unit;
constexpr int HALF = 128;

struct EpiResidual {
    static constexpr bool PERM = false, AFTER_DRAIN = false;
    float* X; const float* gate_base;
    const float *Bp, *Bs;
    __device__ __forceinline__ void operator()(const f32x4 (&acc)[2][2][4][2], const Unit& u, int wr, int wc, int fr, int fq) const {
        const int row0 = u.pm * 256 + wr * 64 + fr, col0 = u.pn * 256 + wc * 32 + 4 * fq;
        const float* gp = gate_base + (size_t)cond_of_panel(u.pm) * 6 * D + col0;
        f32x4 gv[2][2];
#pragma unroll
        for (int bj = 0; bj < 2; ++bj)
#pragma unroll
            for (int n = 0; n < 2; ++n) gv[bj][n] = *(const f32x4*)(gp + bj * HALF + n * 16);
        const float* sbase = (u.pm < 16 ? Bp + (size_t)row0 * D : Bs + (size_t)(row0 - MP) * D) + col0;
#pragma unroll
        for (int ai = 0; ai < 2; ++ai) {
            f32x4 q[4][2][2];
#pragma unroll
            for (int m = 0; m < 4; ++m)
#pragma unroll
                for (int bj = 0; bj < 2; ++bj)
#pragma unroll
                    for (int n = 0; n < 2; ++n) if ((u.mask >> (ai * 2 + bj)) & 1) q[m][bj][n] = *(const f32x4*)(sbase + (size_t)(ai * HALF + m * 16) * D + bj * HALF + n * 16);
#pragma unroll
            for (int m = 0; m < 4; ++m) { float* rowp = X + (size_t)(row0 + ai * HALF + m * 16) * D + col0;
#pragma unroll
                for (int bj = 0; bj < 2; ++bj)
#pragma unroll
                    for (int n = 0; n < 2; ++n) if ((u.mask >> (ai * 2 + bj)) & 1) *(f32x4*)(rowp + bj * HALF + n * 16) = q[m][bj][n] + gv[bj][n] * acc[ai][bj][m][n]; }
            asm volatile("" ::: "memory");
        }
    }
};
template <int ACT> struct EpiBf16 {
    static constexpr bool PERM = true, AFTER_DRAIN = false;
    bf16_t* O; int ldc;
    __device__ __forceinline__ void operator()(const f32x4 (&acc)[2][2][4][2], const Unit& u, int wr, int wc, int fr, int fq) const {
        const int row0 = u.pm * 256 + wr * 64 + fr, col0 = u.pn * 256 + wc * 32 + 8 * fq;
#pragma unroll
        for (int ai = 0; ai < 2; ++ai)
#pragma unroll
            for (int m = 0; m < 4; ++m) { bf16_t* rowp = O + (size_t)(row0 + ai * HALF + m * 16) * ldc + col0;
#pragma unroll
                for (int bj = 0; bj < 2; ++bj) { if (!((u.mask >> (ai * 2 + bj)) & 1)) continue; f32x4 v0 = acc[ai][bj][m][0], v1 = acc[ai][bj][m][1];
                    if (ACT == 1) {
#pragma unroll
                        for (int j = 0; j < 4; ++j) { const float a = fmaxf(v0[j], 0.f), b = fmaxf(v1[j], 0.f); v0[j] = a * a; v1[j] = b * b; } }
                    u32x4 w; w.x = cvt_pk(v0[0], v0[1]); w.y = cvt_pk(v0[2], v0[3]); w.z = cvt_pk(v1[0], v1[1]); w.w = cvt_pk(v1[2], v1[3]);
                    *(u32x4*)(rowp + bj * HALF) = w; } }
    }
};
struct EpiQKV {
    static constexpr bool PERM = true, AFTER_DRAIN = false;
    bf16_t *Q, *K, *V; float *NK, *NV;
    __device__ __forceinline__ void operator()(const f32x4 (&acc)[2][2][4][2], const Unit& u, int wr, int wc, int fr, int fq) const {
        const int row0 = u.pm * 256 + wr * 64 + fr; const int cin = wc * 32 + 8 * fq;
        bf16_t* base; int ldc, colt; float* fo = nullptr;
        if (u.pn < 8) { base = Q; ldc = 2048; colt = u.pn * 256; }
        else if (u.pn < 10) { base = K; ldc = 512; colt = (u.pn - 8) * 256; if (u.pm < 16) fo = NK; }
        else { base = V; ldc = 512; colt = (u.pn - 10) * 256; if (u.pm < 16) fo = NV; }
#pragma unroll
        for (int ai = 0; ai < 2; ++ai)
#pragma unroll
            for (int m = 0; m < 4; ++m) { const int r = row0 + ai * HALF + m * 16; bf16_t* rowp = base + (size_t)r * ldc + colt + cin;
#pragma unroll
                for (int bj = 0; bj < 2; ++bj) { if (!((u.mask >> (ai * 2 + bj)) & 1)) continue; const f32x4 v0 = acc[ai][bj][m][0], v1 = acc[ai][bj][m][1];
                    u32x4 w; w.x = cvt_pk(v0[0], v0[1]); w.y = cvt_pk(v0[2], v0[3]); w.z = cvt_pk(v1[0], v1[1]); w.w = cvt_pk(v1[2], v1[3]);
                    *(u32x4*)(rowp + bj * HALF) = w;
                    if (fo) { float* fp = fo + ((size_t)(r >> 8) * 512 + (r & 255)) * 512 + colt + cin + bj * HALF; *(f32x4*)fp = v0; *(f32x4*)(fp + 4) = v1; } } }
    }
};
__device__ __forceinline__ size_t hm_index(int m, int c) { return ((size_t)(c >> 6) * MT + m) * 64 + (c & 63); }
struct EpiRw1 {
    static constexpr bool PERM = true, AFTER_DRAIN = false;
    bf16_t *R, *A3;
    const float* k_k; float* invsq;
    __device__ __forceinline__ void operator()(const f32x4 (&acc)[2][2][4][2], const Unit& u, int wr, int wc, int fr, int fq) const {
        const int ct = u.pn, panel = u.pm % NPANEL;
        const int row0 = panel * 256 + wr * 64 + fr; const int cin = wc * 32 + 8 * fq;
        bf16_t* base; int ldc, colt, act = 0;
        if (ct < 24) { base = R + (size_t)(ct >> 3) * MT * D; ldc = D; colt = (ct & 7) * 256; }
        else { base = A3 + (size_t)(ct - 24) * MT * 256; ldc = 256; colt = 0; act = ct - 23; }
#pragma unroll
        for (int ai = 0; ai < 2; ++ai)
#pragma unroll
            for (int m = 0; m < 4; ++m) { const int rrow = row0 + ai * HALF + m * 16; bf16_t* rowp = base + (size_t)rrow * ldc + colt + cin;
#pragma unroll
                for (int bj = 0; bj < 2; ++bj) { if (!((u.mask >> (ai * 2 + bj)) & 1)) continue; f32x4 v0 = acc[ai][bj][m][0], v1 = acc[ai][bj][m][1];
                    if (act == 1) {
#pragma unroll
                        for (int j = 0; j < 4; ++j) { v0[j] = ftanh(v0[j]); v1[j] = ftanh(v1[j]); } }
                    else if (act == 3) {
#pragma unroll
                        for (int j = 0; j < 4; ++j) { v0[j] = fsigmoid(v0[j]); v1[j] = fsigmoid(v1[j]); } }
                    u32x4 w; w.x = cvt_pk(v0[0], v0[1]); w.y = cvt_pk(v0[2], v0[3]); w.z = cvt_pk(v1[0], v1[1]); w.w = cvt_pk(v1[2], v1[3]);
                    if (ct < 24) *(u32x4*)(base + hm_index(rrow, colt + cin + bj * HALF)) = w; else *(u32x4*)(rowp + bj * HALF) = w;
} }
    }
};
struct EpiRw2 {
    static constexpr bool PERM = true, AFTER_DRAIN = false;
    bf16_t *LD, *LA, *Gt; const float *w0, *a0;
    __device__ __forceinline__ void operator()(const f32x4 (&acc)[2][2][4][2], const Unit& u, int wr, int wc, int fr, int fq) const {
        const int ct = u.pn, panel = u.pm % NPANEL, grp = ct >> 3;
        const int row0 = panel * 256 + wr * 64 + fr; const int col0 = (ct & 7) * 256 + wc * 32 + 8 * fq;
        bf16_t* base; const float* bias = nullptr;
        if (grp < 2) { base = LD + (size_t)grp * MT * D; bias = w0 + grp * D; }
        else if (grp < 4) { base = LA + (size_t)(grp - 2) * MT * D; bias = a0 + (grp - 2) * D; }
        else base = Gt;
        f32x4 bv[2][2];
#pragma unroll
        for (int bj = 0; bj < 2; ++bj)
#pragma unroll
            for (int n = 0; n < 2; ++n) bv[bj][n] = bias ? *(const f32x4*)(bias + col0 + bj * HALF + 4 * n) : (f32x4){0.f, 0.f, 0.f, 0.f};
#pragma unroll
        for (int ai = 0; ai < 2; ++ai)
#pragma unroll
            for (int m = 0; m < 4; ++m) { const int rrow = row0 + ai * HALF + m * 16; bf16_t* rowp = base + (size_t)rrow * D + col0;
#pragma unroll
                for (int bj = 0; bj < 2; ++bj) {
                    f32x4 v0 = acc[ai][bj][m][0] + bv[bj][0], v1 = acc[ai][bj][m][1] + bv[bj][1];
                    if (grp < 2) {
#pragma unroll
                        for (int j = 0; j < 4; ++j) { v0[j] = -fexp(-fsoftplus(-v0[j]) - 0.5f); v1[j] = -fexp(-fsoftplus(-v1[j]) - 0.5f); } }
                    u32x4 w; w.x = cvt_pk(v0[0], v0[1]); w.y = cvt_pk(v0[2], v0[3]); w.z = cvt_pk(v1[0], v1[1]); w.w = cvt_pk(v1[2], v1[3]);
                    if (grp < 4) *(u32x4*)(base + hm_index(rrow, col0 + bj * HALF)) = w; else *(u32x4*)(rowp + bj * HALF) = w; }
                asm volatile("" : "+v"(bv[0][0]), "+v"(bv[0][1]), "+v"(bv[1][0]), "+v"(bv[1][1]));
            }
    }
};
struct RwOrder1 {
    int G, c, lo, hi; bool xcd;
    __device__ __forceinline__ bool next(int i, Unit& u) const { const int L = lo + i * G + c; if (L >= hi) return false; u.mask = 15;
        int panel, ct;
        if (xcd) {
            if (L < 1280) {
                const int cc = L & 255, T = (((L >> 8) * 8 + (cc & 7)) << 5) + (cc >> 3);
                if (T < 1056) { const int blk = T >> 5, j = T & 31, pq = blk / 3, g = blk - 3 * pq; panel = pq * 4 + (j >> 3); ct = g * 8 + (j & 7); }
                else if (T < 1120) { const int blk = (T - 1056) >> 5, j = T & 31; panel = 44 + (j >> 3); ct = (1 + blk) * 8 + (j & 7); }
                else { const int U = T - 1120; if (U < 16) { panel = 44 + (U >> 3); ct = U & 7; } else { const int q = U - 16; panel = q / 3; ct = 24 + q - 3 * panel; } }
            } else { const int q = L - 1280; panel = 46 + (q >> 3); ct = q & 7; }
        } else { panel = L / 27; ct = L % 27; }
        const int ai = ct < 24 ? (ct >> 3) : ct - 21; u.pm = ai * NPANEL + panel; u.pn = ct; u.kh = 0; return true; }
    __device__ __forceinline__ void a_ready(const Unit&) const {}
    __device__ __forceinline__ void done(const Unit&) const {}
};
struct RwOrder2 {
    int G, c; unsigned* cnt; unsigned need;
    __device__ __forceinline__ bool next(int i, Unit& u) const { const int L = i * G + c; if (L >= 40 * NPANEL) return false; const int panel = L / 40, ct = L % 40; const int ai = ct < 16 ? 0 : (ct < 32 ? 1 : 2); u.pm = ai * NPANEL + panel; u.pn = ct; u.kh = 0; u.mask = 15; return true; }
    __device__ __forceinline__ void a_ready(const Unit& u) const {
        if (cnt && (u.pm % NPANEL) == NPANEL - 1) {
            unsigned sp = 0u;
            while (xb_ld(cnt) < need) { __builtin_amdgcn_s_sleep(2); if (++sp > (1u << 24)) break; }
            __builtin_amdgcn_fence(__ATOMIC_ACQUIRE, "agent");
            asm volatile("s_waitcnt vmcnt(0)" ::: "memory");
        }
    }
    __device__ __forceinline__ void done(const Unit&) const {}
};

struct SplitOrder {
    pg8::StaticOrder so; int G, c, ntiles;
    __device__ __forceinline__ void init(int N, int G_, int c_) { so.init(MT, N, G_, c_); G = G_; c = c_; ntiles = so.nwg; }
    __device__ __forceinline__ bool next(int i, Unit& u) const { const int L = i * G + c; if (L >= 2 * ntiles) return false; const int kh = L >= ntiles; so.map(kh ? L - ntiles : L, u); u.kh = kh; u.mask = 15; return true; }
    __device__ __forceinline__ void a_ready(const Unit&) const {}
    __device__ __forceinline__ void done(const Unit&) const {}
};
struct EpiResidualSplit {
    static constexpr bool PERM = false, AFTER_DRAIN = false;
    float* X; const float* gate_base; bf16_t* P1;
    __device__ __forceinline__ void operator()(const f32x4 (&acc)[2][2][4][2], const Unit& u, int wr, int wc, int fr, int fq) const {
        const int row0 = u.pm * 256 + wr * 64 + fr, col0 = u.pn * 256 + wc * 32 + 4 * fq;
        const float* gp = gate_base + (size_t)cond_of_panel(u.pm) * 6 * D + col0;
        f32x4 gv[2][2];
#pragma unroll
        for (int bj = 0; bj < 2; ++bj)
#pragma unroll
            for (int n = 0; n < 2; ++n) gv[bj][n] = *(const f32x4*)(gp + bj * HALF + n * 16);
        if (u.kh == 0) {
#pragma unroll
            for (int ai = 0; ai < 2; ++ai) {
                f32x4 q[4][2][2];
#pragma unroll
                for (int m = 0; m < 4; ++m)
#pragma unroll
                    for (int bj = 0; bj < 2; ++bj)
#pragma unroll
                        for (int n = 0; n < 2; ++n) q[m][bj][n] = *(const f32x4*)(X + (size_t)(row0 + ai * HALF + m * 16) * D + col0 + bj * HALF + n * 16);
#pragma unroll
                for (int m = 0; m < 4; ++m) { float* rowp = X + (size_t)(row0 + ai * HALF + m * 16) * D + col0;
#pragma unroll
                    for (int bj = 0; bj < 2; ++bj)
#pragma unroll
                        for (int n = 0; n < 2; ++n) *(f32x4*)(rowp + bj * HALF + n * 16) = q[m][bj][n] + gv[bj][n] * acc[ai][bj][m][n]; }
                asm volatile("" ::: "memory");
            }
        } else {
#pragma unroll
            for (int ai = 0; ai < 2; ++ai)
#pragma unroll
                for (int m = 0; m < 4; ++m) { bf16_t* rowp = P1 + (size_t)(row0 + ai * HALF + m * 16) * D + col0;
#pragma unroll
                    for (int bj = 0; bj < 2; ++bj)
#pragma unroll
                        for (int n = 0; n < 2; ++n) { const f32x4 v = gv[bj][n] * acc[ai][bj][m][n]; u32x2 w; w.x = cvt_pk(v.x, v.y); w.y = cvt_pk(v.z, v.w); *(u32x2*)(rowp + bj * HALF + n * 16) = w; } }
        }
    }
};

template <bool SRCF32> struct EpiResidualB {
    static constexpr bool PERM = true, AFTER_DRAIN = false;
    bf16_t* X; const float* gate_base; const float *Bp, *Bs;
    __device__ __forceinline__ void operator()(const f32x4 (&acc)[2][2][4][2], const Unit& u, int wr, int wc, int fr, int fq) const {
        const int row0 = u.pm * 256 + wr * 64 + fr, col0 = u.pn * 256 + wc * 32 + 8 * fq;
        const float* gp = gate_base + (size_t)cond_of_panel(u.pm) * 6 * D + col0;
        f32x4 gv[2][2];
#pragma unroll
        for (int bj = 0; bj < 2; ++bj)
#pragma unroll
            for (int n = 0; n < 2; ++n) gv[bj][n] = *(const f32x4*)(gp + bj * HALF + 4 * n);
#pragma unroll
        for (int ai = 0; ai < 2; ++ai) {
            if constexpr (SRCF32) {
                const float* sbase = (u.pm < 16 ? Bp + (size_t)row0 * D : Bs + (size_t)(row0 - MP) * D) + col0;
                f32x4 q[4][2][2];
#pragma unroll
                for (int m = 0; m < 4; ++m)
#pragma unroll
                    for (int bj = 0; bj < 2; ++bj)
#pragma unroll
                        for (int n = 0; n < 2; ++n) q[m][bj][n] = *(const f32x4*)(sbase + (size_t)(ai * HALF + m * 16) * D + bj * HALF + 4 * n);
#pragma unroll
                for (int m = 0; m < 4; ++m) { bf16_t* rowp = X + (size_t)(row0 + ai * HALF + m * 16) * D + col0;
#pragma unroll
                    for (int bj = 0; bj < 2; ++bj) { const f32x4 v0 = q[m][bj][0] + gv[bj][0] * acc[ai][bj][m][0], v1 = q[m][bj][1] + gv[bj][1] * acc[ai][bj][m][1];
                        u32x4 w; w.x = cvt_pk(v0.x, v0.y); w.y = cvt_pk(v0.z, v0.w); w.z = cvt_pk(v1.x, v1.y); w.w = cvt_pk(v1.z, v1.w); *(u32x4*)(rowp + bj * HALF) = w; } }
            } else {
                u32x4 q[4][2];
#pragma unroll
                for (int m = 0; m < 4; ++m)
#pragma unroll
                    for (int bj = 0; bj < 2; ++bj) q[m][bj] = *(const u32x4*)(X + (size_t)(row0 + ai * HALF + m * 16) * D + col0 + bj * HALF);
#pragma unroll
                for (int m = 0; m < 4; ++m) { bf16_t* rowp = X + (size_t)(row0 + ai * HALF + m * 16) * D + col0;
#pragma unroll
                    for (int bj = 0; bj < 2; ++bj) { const u32x4 o = q[m][bj];
                        const f32x4 v0 = (f32x4){bflo(o.x), bfhi(o.x), bflo(o.y), bfhi(o.y)} + gv[bj][0] * acc[ai][bj][m][0], v1 = (f32x4){bflo(o.z), bfhi(o.z), bflo(o.w), bfhi(o.w)} + gv[bj][1] * acc[ai][bj][m][1];
                        u32x4 w; w.x = cvt_pk(v0.x, v0.y); w.y = cvt_pk(v0.z, v0.w); w.z = cvt_pk(v1.x, v1.y); w.w = cvt_pk(v1.z, v1.w); *(u32x4*)(rowp + bj * HALF) = w; } }
            }
            asm volatile("" ::: "memory");
        }
    }
};
struct EpiResidualSplitB {
    static constexpr bool PERM = true, AFTER_DRAIN = false;
    bf16_t* X; const float* gate_base; bf16_t* P1;
    __device__ __forceinline__ void operator()(const f32x4 (&acc)[2][2][4][2], const Unit& u, int wr, int wc, int fr, int fq) const {
        const int row0 = u.pm * 256 + wr * 64 + fr, col0 = u.pn * 256 + wc * 32 + 8 * fq;
        const float* gp = gate_base + (size_t)cond_of_panel(u.pm) * 6 * D + col0;
        f32x4 gv[2][2];
#pragma unroll
        for (int bj = 0; bj < 2; ++bj)
#pragma unroll
            for (int n = 0; n < 2; ++n) gv[bj][n] = *(const f32x4*)(gp + bj * HALF + 4 * n);
        if (u.kh == 0) {
#pragma unroll
            for (int ai = 0; ai < 2; ++ai) {
                u32x4 q[4][2];
#pragma unroll
                for (int m = 0; m < 4; ++m)
#pragma unroll
                    for (int bj = 0; bj < 2; ++bj) q[m][bj] = *(const u32x4*)(X + (size_t)(row0 + ai * HALF + m * 16) * D + col0 + bj * HALF);
#pragma unroll
                for (int m = 0; m < 4; ++m) { bf16_t* rowp = X + (size_t)(row0 + ai * HALF + m * 16) * D + col0;
#pragma unroll
                    for (int bj = 0; bj < 2; ++bj) { const u32x4 o = q[m][bj];
                        const f32x4 v0 = (f32x4){bflo(o.x), bfhi(o.x), bflo(o.y), bfhi(o.y)} + gv[bj][0] * acc[ai][bj][m][0], v1 = (f32x4){bflo(o.z), bfhi(o.z), bflo(o.w), bfhi(o.w)} + gv[bj][1] * acc[ai][bj][m][1];
                        u32x4 w; w.x = cvt_pk(v0.x, v0.y); w.y = cvt_pk(v0.z, v0.w); w.z = cvt_pk(v1.x, v1.y); w.w = cvt_pk(v1.z, v1.w); *(u32x4*)(rowp + bj * HALF) = w; } }
                asm volatile("" ::: "memory");
            }
        } else {
#pragma unroll
            for (int ai = 0; ai < 2; ++ai)
#pragma unroll
                for (int m = 0; m < 4; ++m) { bf16_t* rowp = P1 + (size_t)(row0 + ai * HALF + m * 16) * D + col0;
#pragma unroll
                    for (int bj = 0; bj < 2; ++bj) { const f32x4 v0 = gv[bj][0] * acc[ai][bj][m][0], v1 = gv[bj][1] * acc[ai][bj][m][1];
                        u32x4 w; w.x = cvt_pk(v0.x, v0.y); w.y = cvt_pk(v0.z, v0.w); w.z = cvt_pk(v1.x, v1.y); w.w = cvt_pk(v1.z, v1.w); *(u32x4*)(rowp + bj * HALF) = w; } }
        }
    }
};
struct TailSplitOrder {
    pg8::StaticOrder sf, st; int G, c, ntf;
    __device__ __forceinline__ void init(int G_, int c_, int ntf_ = 32) { sf.init(8192, D, G_, c_); st.init(4096, D, G_, c_); G = G_; c = c_; ntf = ntf_; }
    __device__ __forceinline__ bool next(int i, Unit& u) const {
        const int L = i * G + c; if (L >= 512) return false;
        if (L < 256) { sf.map(L, u); u.kh = 0; u.nt = ntf; }
        else { const int h = L - 256, kh = h >= 128; st.map(kh ? h - 128 : h, u); u.pm += 32; u.kh = kh; u.nt = ntf >> 1; }
        u.mask = 15; return true; }
    __device__ __forceinline__ void a_ready(const Unit&) const {}
    __device__ __forceinline__ void done(const Unit&) const {}
};


typedef short s16x4 __attribute__((ext_vector_type(4)));
constexpr int KS_STRIDE = 136;
constexpr int VT_STRIDE = 72;
constexpr int ATT_KS_OFF = 0, ATT_VT_OFF = 64 * KS_STRIDE * 2, ATT_BUF_BYTES = 36864;

__device__ __forceinline__ void rope8(u32x4& a, u32x4& b, const f32x2* tab) {
    unsigned* pa = (unsigned*)&a; unsigned* pb = (unsigned*)&b;
#pragma unroll
    for (int w = 0; w < 4; ++w) {
        const f32x4 cs = *(const f32x4*)(tab + 2 * w);
        const float x1l = bflo(pa[w]), x1h = bfhi(pa[w]), x2l = bflo(pb[w]), x2h = bfhi(pb[w]);
        const float o1l = x1l * cs.x - x2l * cs.y, o2l = x1l * cs.y + x2l * cs.x;
        const float o1h = x1h * cs.z - x2h * cs.w, o2h = x1h * cs.w + x2h * cs.z;
        pa[w] = cvt_pk(o1l, o1h); pb[w] = cvt_pk(o2l, o2h);
    }
}

__device__ __forceinline__ void phase_attention(const Ctx& C, const bf16_t* Q, const bf16_t* Kb, const bf16_t* Vb, const bf16_t* KC, const bf16_t* VC, const float* sink, bf16_t* O) {
    const int tid = C.tid, lane = C.lane, w = C.wave, h = lane >> 5, lq = lane & 31;
    LAS bf16_t* Ks = (LAS bf16_t*)(C.lds + ATT_KS_OFF);
    LAS bf16_t* Vt = (LAS bf16_t*)(C.lds + ATT_VT_OFF);
    const f32x2* rope = WSP(f32x2, WS_ROPE);
    const float c2 = 0.08838834764831845f * 1.4426950408889634f;
    for (int it = C.bid; it < 768; it += C.G) {
        const bool smp = it < 512;
        int bb, kvh, qb, R0;
        if (smp) { bb = it >> 6; kvh = (it >> 4) & 3; qb = it & 15; R0 = MP + bb * 1024; }
        else { const int p = it - 512; bb = p >> 4; kvh = (p >> 2) & 3; qb = p & 3; R0 = bb * 256; }
        const int head = kvh * 4 + (w >> 1);
        const int t = qb * 64 + (w & 1) * 32 + lq;
        u32x4 qf[8];
        { const bf16_t* qp = Q + (size_t)(R0 + t) * D + head * 128 + 8 * h;
#pragma unroll
          for (int ks = 0; ks < 8; ++ks) qf[ks] = *(const u32x4*)(qp + 16 * ks); }
        if (smp) {
#pragma unroll
            for (int half = 0; half < 2; ++half) { const int pos = half ? (t & 63) : (t >> 6);
#pragma unroll
                for (int kk = 0; kk < 2; ++kk) rope8(qf[4 * half + kk], qf[4 * half + kk + 2], rope + pos * 32 + 16 * kk + 8 * h); }
        }
        f32x16 o[4];
#pragma unroll
        for (int db = 0; db < 4; ++db)
#pragma unroll
            for (int r = 0; r < 16; ++r) o[db][r] = 0.f;
        float mrun = -1e30f, lrun = 0.f;
        const int li0 = smp ? (qb >= 2 ? 0 : 2 - qb) : 0, li1 = smp ? (17 - qb < 4 ? 17 - qb : 4) : 0;
        const int ntot = smp ? 8 + (li1 - li0 + 1) : 4;
        const int key = tid >> 3, cc = tid & 7, c1 = (cc & 3) + (cc >> 2) * 8;
#define ATT_TILE(i, kp_, vp_, k0_, loc_) do { if (smp) { if ((i) < 8) { const size_t off_ = ((size_t)(bb * 2) * 512 + (i) * 64) * 512 + kvh * 128; kp_ = KC + off_; vp_ = VC + off_; k0_ = 0; loc_ = false; } \
            else { k0_ = qb * 64 - 128 + 64 * ((i) - 8 + li0); loc_ = true; const size_t off_ = (size_t)(R0 + k0_) * 512 + kvh * 128; kp_ = Kb + off_; vp_ = Vb + off_; } } \
          else { k0_ = (i) * 64; loc_ = false; const size_t off_ = (size_t)(R0 + k0_) * 512 + kvh * 128; kp_ = Kb + off_; vp_ = Vb + off_; } } while (0)
        u32x4 ka, kb2, va, vb2;
#define ATT_LOAD(i) do { const bf16_t *kp_, *vp_; int k0_; bool loc_; ATT_TILE(i, kp_, vp_, k0_, loc_); (void)k0_; (void)loc_; \
          ka = *(const u32x4*)(kp_ + (size_t)key * 512 + 8 * c1); kb2 = *(const u32x4*)(kp_ + (size_t)key * 512 + 8 * c1 + 32); \
          va = *(const u32x4*)(vp_ + (size_t)key * 512 + 8 * c1); vb2 = *(const u32x4*)(vp_ + (size_t)key * 512 + 8 * c1 + 32); } while (0)
#define ATT_STAGE(i, KsB, VtB) do { const bf16_t *kp_, *vp_; int k0_; bool loc_; ATT_TILE(i, kp_, vp_, k0_, loc_); (void)kp_; (void)vp_; \
          if (loc_) { const int kpos = k0_ + key; const int pos = (cc >> 2) ? (kpos & 63) : (kpos >> 6); rope8(ka, kb2, rope + pos * 32 + 8 * (cc & 3)); } \
          *(LAS u32x4*)((KsB) + key * KS_STRIDE + 8 * c1) = ka; *(LAS u32x4*)((KsB) + key * KS_STRIDE + 8 * c1 + 32) = kb2; \
          *(LAS u32x4*)((VtB) + key * KS_STRIDE + 8 * c1) = va; *(LAS u32x4*)((VtB) + key * KS_STRIDE + 8 * c1 + 32) = vb2; } while (0)
        ATT_LOAD(0); ATT_STAGE(0, Ks, Vt); if (ntot > 1) ATT_LOAD(1);
        __syncthreads();
        for (int ti = 0; ti < ntot; ++ti) {
            const bf16_t *kp, *vp; int k0; bool local; ATT_TILE(ti, kp, vp, k0, local); (void)kp; (void)vp;
            LAS bf16_t* Ks = (LAS bf16_t*)(C.lds + (ti & 1) * ATT_BUF_BYTES + ATT_KS_OFF);
            LAS bf16_t* Vt = (LAS bf16_t*)(C.lds + (ti & 1) * ATT_BUF_BYTES + ATT_VT_OFF);
            f32x16 s0, s1;
            { const float z0 = opaque_zero();
#pragma unroll
            for (int r = 0; r < 16; ++r) { s0[r] = z0; s1[r] = z0; } }
#pragma unroll
            for (int ks = 0; ks < 8; ++ks) {
                const bf16x8 a0 = *(const LAS bf16x8*)(Ks + lq * KS_STRIDE + 16 * ks + 8 * h);
                const bf16x8 a1 = *(const LAS bf16x8*)(Ks + (32 + lq) * KS_STRIDE + 16 * ks + 8 * h);
                const bf16x8 bq = __builtin_bit_cast(bf16x8, qf[ks]);
                s0 = __builtin_amdgcn_mfma_f32_32x32x16_bf16(a0, bq, s0, 0, 0, 0);
                s1 = __builtin_amdgcn_mfma_f32_32x32x16_bf16(a1, bq, s1, 0, 0, 0);
            }
            if (local) {
#pragma unroll
                for (int r = 0; r < 16; ++r) {
                    const int kl = (r & 3) + 8 * (r >> 2) + 4 * h;
                    const int d0 = k0 + kl - t, d1 = d0 + 32;
                    s0[r] = ((d0 <= 128) && (d0 >= -128)) ? s0[r] : -1e30f; s1[r] = ((d1 <= 128) && (d1 >= -128)) ? s1[r] : -1e30f;
                }
            }
            float mx = fmaxf(s0[0], s1[0]);
#pragma unroll
            for (int r = 1; r < 16; ++r) mx = fmaxf(mx, fmaxf(s0[r], s1[r]));
            mx = fmaxf(mx, __shfl_xor(mx, 32));
            const float mnew = fmaxf(mrun, mx * c2);
            const float alpha = fexp2(mrun - mnew);
            float ps = 0.f;
#pragma unroll
            for (int r = 0; r < 16; ++r) {
                const float p0 = fexp2(__builtin_fmaf(s0[r], c2, -mnew)), p1 = fexp2(__builtin_fmaf(s1[r], c2, -mnew));
                s0[r] = p0; s1[r] = p1; ps += p0 + p1;
            }
            lrun = lrun * alpha + ps; mrun = mnew;
            if (__any(alpha != 1.0f)) {
#pragma unroll
                for (int db = 0; db < 4; ++db)
#pragma unroll
                    for (int r = 0; r < 16; ++r) o[db][r] *= alpha;
            }
            u32x4 pf[4];
#pragma unroll
            for (int s = 0; s < 2; ++s) {
                pf[s].x = cvt_pk(s0[8 * s + 0], s0[8 * s + 1]); pf[s].y = cvt_pk(s0[8 * s + 2], s0[8 * s + 3]); pf[s].z = cvt_pk(s0[8 * s + 4], s0[8 * s + 5]); pf[s].w = cvt_pk(s0[8 * s + 6], s0[8 * s + 7]);
                pf[2 + s].x = cvt_pk(s1[8 * s + 0], s1[8 * s + 1]); pf[2 + s].y = cvt_pk(s1[8 * s + 2], s1[8 * s + 3]); pf[2 + s].z = cvt_pk(s1[8 * s + 4], s1[8 * s + 5]); pf[2 + s].w = cvt_pk(s1[8 * s + 6], s1[8 * s + 7]);
            }
#pragma unroll
            for (int db = 0; db < 4; ++db)
#pragma unroll
                for (int s2 = 0; s2 < 4; ++s2) {
                    const LAS bf16_t* vr = Vt + (16 * s2 + 4 * (lane >> 5) + ((lane & 15) >> 2)) * KS_STRIDE + 32 * db + 16 * ((lane >> 4) & 1) + 4 * (lane & 3);
                    const s16x4 lo = __builtin_amdgcn_ds_read_tr16_b64_v4i16((LAS s16x4*)vr), hi = __builtin_amdgcn_ds_read_tr16_b64_v4i16((LAS s16x4*)(vr + 8 * KS_STRIDE));
                    const u32x2 lo2 = __builtin_bit_cast(u32x2, lo), hi2 = __builtin_bit_cast(u32x2, hi);
                    u32x4 av; av.x = lo2.x; av.y = lo2.y; av.z = hi2.x; av.w = hi2.y;
                    o[db] = __builtin_amdgcn_mfma_f32_32x32x16_bf16(__builtin_bit_cast(bf16x8, av), __builtin_bit_cast(bf16x8, pf[s2]), o[db], 0, 0, 0);
                }
            if (ti + 1 < ntot) {
                LAS bf16_t* Ksn = (LAS bf16_t*)(C.lds + ((ti + 1) & 1) * ATT_BUF_BYTES + ATT_KS_OFF);
                LAS bf16_t* Vtn = (LAS bf16_t*)(C.lds + ((ti + 1) & 1) * ATT_BUF_BYTES + ATT_VT_OFF);
                ATT_STAGE(ti + 1, Ksn, Vtn);
                if (ti + 2 < ntot) ATT_LOAD(ti + 2);
            }
            __syncthreads();
        }
        {
            const float sk = sink[head] * 1.4426950408889634f;
            const float mnew = fmaxf(mrun, sk), alpha = fexp2(mrun - mnew);
            float l = lrun * alpha; l += __shfl_xor(l, 32); l += fexp2(sk - mnew);
            const float sc = alpha * frcp(l);
            bf16_t* op = O + (size_t)(R0 + t) * D + head * 128 + 4 * h;
#pragma unroll
            for (int db = 0; db < 4; ++db)
#pragma unroll
                for (int g4 = 0; g4 < 4; ++g4) {
                    u32x2 wv; wv.x = cvt_pk(o[db][4 * g4 + 0] * sc, o[db][4 * g4 + 1] * sc); wv.y = cvt_pk(o[db][4 * g4 + 2] * sc, o[db][4 * g4 + 3] * sc);
                    *(u32x2*)(op + 32 * db + 8 * g4) = wv;
                }
        }
    }
#undef ATT_TILE
#undef ATT_LOAD
#undef ATT_STAGE
    __syncthreads();
}

__device__ __forceinline__ void phase_hy_gate(const Ctx& C, const bf16_t* Pm, const float* cw, const float* cb, bf16_t* X0, bf16_t* ZTp, bf16_t* ZTs) {
    const int tid = C.tid;
    LAS bf16_t* zs = (LAS bf16_t*)C.lds;
    for (int it = C.bid; it < 6144; it += C.G) {
        const bool smp = it >= 2048; const int q = smp ? it - 2048 : it;
        const int cbk = q & 31, tb = smp ? (q >> 5) & 15 : (q >> 5) & 3, b = smp ? q >> 9 : q >> 7;
        const int L = smp ? 1024 : 256, R0 = smp ? MP + b * 1024 : b * 256, NB = smp ? 8 : 16;
        const int tl = tid >> 3, c8 = tid & 7, t = tb * 64 + tl, c0 = cbk * 64 + 8 * c8;
        float u[3][8];
#pragma unroll
        for (int g = 0; g < 3; ++g) {
            const int gc = g * D + c0;
            const bf16_t* pr = Pm + (size_t)(R0 + t) * 6144 + gc;
            u32x4 pm1 = *(const u32x4*)(pr - (t > 0 ? 6144 : 0)), pp1 = *(const u32x4*)(pr + (t < L - 1 ? 6144 : 0)); const u32x4 p0 = *(const u32x4*)pr;
            { const unsigned mk0 = t > 0 ? 0xffffffffu : 0u, mk1 = t < L - 1 ? 0xffffffffu : 0u; pm1.x &= mk0; pm1.y &= mk0; pm1.z &= mk0; pm1.w &= mk0; pp1.x &= mk1; pp1.y &= mk1; pp1.z &= mk1; pp1.w &= mk1; }
            const unsigned* a = (const unsigned*)&pm1; const unsigned* bq = (const unsigned*)&p0; const unsigned* cq = (const unsigned*)&pp1;
#pragma unroll
            for (int j = 0; j < 4; ++j) {
                const f32x2 w0 = *(const f32x2*)(cw + gc + 2 * j), w1 = *(const f32x2*)(cw + 6144 + gc + 2 * j), w2 = *(const f32x2*)(cw + 12288 + gc + 2 * j), bb = *(const f32x2*)(cb + gc + 2 * j);
#if defined(MK_GATE_VARIANT) && MK_GATE_VARIANT == 1
                u[g][2 * j] = bflo(bq[j]); u[g][2 * j + 1] = bfhi(bq[j]);
#elif defined(MK_GATE_VARIANT) && MK_GATE_VARIANT == 2
                u[g][2 * j] = bflo(bq[j]) * w1.x + bb.x; u[g][2 * j + 1] = bfhi(bq[j]) * w1.y + bb.y;
#elif defined(MK_GATE_VARIANT) && MK_GATE_VARIANT == 3
                u[g][2 * j] = bflo(a[j]) + bflo(bq[j]) + bflo(cq[j]); u[g][2 * j + 1] = bfhi(a[j]) + bfhi(bq[j]) + bfhi(cq[j]);
#else
                u[g][2 * j] = bflo(a[j]) * w0.x + bflo(bq[j]) * w1.x + bflo(cq[j]) * w2.x + bb.x;
                u[g][2 * j + 1] = bfhi(a[j]) * w0.y + bfhi(bq[j]) * w1.y + bfhi(cq[j]) * w2.y + bb.y;
#endif
            }
        }
        { u32x4 o; o.x = cvt_pk(u[0][0], u[0][1]); o.y = cvt_pk(u[0][2], u[0][3]); o.z = cvt_pk(u[0][4], u[0][5]); o.w = cvt_pk(u[0][6], u[0][7]);
          *(u32x4*)(X0 + (size_t)(R0 + t) * D + c0) = o; }
        __syncthreads();
#pragma unroll
        for (int j = 0; j < 8; ++j) zs[(8 * c8 + j) * 72 + tl] = (bf16_t)(cvt_pk(u[2][j] * u[1][j], 0.f) & 0xffffu);
        __syncthreads();
        { const int cl = tid >> 3, t8 = tid & 7;
          const u32x4 o = *(const LAS u32x4*)(zs + cl * 72 + 8 * t8);
          bf16_t* ZT = smp ? ZTs : ZTp;
          *(u32x4*)(ZT + ((size_t)(cbk * 64 + cl) * NB + b) * L + tb * 64 + 8 * t8) = o; }
    }
    __syncthreads();
}

template <int L, int NB>
__device__ __forceinline__ void phase_hy_conv(const Ctx& C, const bf16_t* FG, const bf16_t* ZT, bf16_t* YT) {
    constexpr int WPC = L / 256, CPB = 8 / WPC, NS = L / 32, ROW = 2 * L + 64, UNITS = L / 4, COPYB = UNITS * 16, CHB = 8 * COPYB;
    constexpr int NH = NS > 16 ? NS / 16 : 1, JH = NS / NH;
    const int lane = C.lane, w = C.wave, ch_local = w / WPC, w4 = w % WPC, r = lane & 15, q = lane >> 4;
    for (int it = C.bid; it < 2048 / CPB; it += C.G) {
        const int c = it * CPB + ch_local;
        __syncthreads();
        {
            const int tcid = w4 * 64 + lane;
            const bf16_t* frow = FG + (size_t)c * ROW;
            for (int x = tcid; x < UNITS; x += 64 * WPC) {
                const u32x4 d0 = *(const u32x4*)(frow + 8 * x), d1 = *(const u32x4*)(frow + 8 * x + 8);
                const unsigned dd[8] = {d0.x, d0.y, d0.z, d0.w, d1.x, d1.y, d1.z, d1.w};
#pragma unroll
                for (int k = 0; k < 8; ++k) {
                    u32x4 o;
                    if ((k & 1) == 0) { o.x = dd[k / 2]; o.y = dd[k / 2 + 1]; o.z = dd[k / 2 + 2]; o.w = dd[k / 2 + 3]; }
                    else { const int b0 = (k - 1) / 2;
                        o.x = (dd[b0] >> 16) | (dd[b0 + 1] << 16); o.y = (dd[b0 + 1] >> 16) | (dd[b0 + 2] << 16); o.z = (dd[b0 + 2] >> 16) | (dd[b0 + 3] << 16); o.w = (dd[b0 + 3] >> 16) | (dd[b0 + 4] << 16); }
                    *(LAS u32x4*)(C.lds + ch_local * CHB + k * COPYB + x * 16) = o;
                }
            }
        }
        __syncthreads();
        f32x4 acc[16];
        { const float z0 = opaque_zero();
#pragma unroll
        for (int i = 0; i < 16; ++i) acc[i] = (f32x4){z0, z0, z0, z0}; }
        const bf16_t* zrow = ZT + ((size_t)c * NB + (r % NB)) * L + 8 * q;
        const LAS unsigned char* abase = C.lds + ch_local * CHB + (7 - (r & 7)) * COPYB + ((L - 8) / 8 - (r >> 3) + q - 32 * w4) * 16;
#pragma unroll
        for (int hh = 0; hh < NH; ++hh) {
            bf16x8 bf[JH];
#pragma unroll
            for (int j = 0; j < JH; ++j) bf[j] = *(const bf16x8*)(zrow + 32 * (hh * JH + j));
#pragma unroll
            for (int e = -2 * (hh * JH + JH - 1); e <= 15 - 2 * (hh * JH); ++e) {
                const bf16x8 a = *(const LAS bf16x8*)(abase - 32 * e);
#pragma unroll
                for (int j = 0; j < JH; ++j) { const int il = e + 2 * (hh * JH + j);
                    if (il >= 0 && il < 16) asm volatile("v_mfma_f32_16x16x32_bf16 %0, %1, %2, %0" : "+v"(acc[il]) : "v"(a), "v"(bf[j])); }
                asm volatile("" :: "v"(a));
            }
#pragma unroll
            for (int j = 0; j < JH; ++j) asm volatile("" :: "v"(bf[j]));
        }
        asm volatile("s_nop 15\n\ts_nop 15" : "+v"(acc[0]), "+v"(acc[1]), "+v"(acc[2]), "+v"(acc[3]), "+v"(acc[4]), "+v"(acc[5]), "+v"(acc[6]), "+v"(acc[7]));
        asm volatile("" : "+v"(acc[8]), "+v"(acc[9]), "+v"(acc[10]), "+v"(acc[11]), "+v"(acc[12]), "+v"(acc[13]), "+v"(acc[14]), "+v"(acc[15]));
        if (r < NB) {
            bf16_t* yrow = YT + ((size_t)c * NB + r) * L + 256 * w4 + 4 * q;
#pragma unroll
            for (int i = 0; i < 16; ++i) { u32x2 o; o.x = cvt_pk(acc[i][0], acc[i][1]); o.y = cvt_pk(acc[i][2], acc[i][3]);
#if defined(MK_CONV_VARIANT) && MK_CONV_VARIANT == 1
                { const u32x4 zz = *(const u32x4*)(zrow + 32 * (i & 7)); o.x = zz.x; o.y = zz.y; }
#elif defined(MK_CONV_VARIANT) && MK_CONV_VARIANT == 2
                { const u32x4 aa = *(const LAS u32x4*)(abase - 32 * (i - 8)); o.x = aa.x; o.y = aa.w; }
#endif
                *(u32x2*)(yrow + 16 * i) = o; }
        }
    }
    __syncthreads();
}

__device__ __forceinline__ void phase_hy_out(const Ctx& C, const bf16_t* YTp, const bf16_t* YTs, const bf16_t* X0, bf16_t* Om) {
    const int tid = C.tid;
    LAS bf16_t* ys = (LAS bf16_t*)C.lds;
    for (int it = C.bid; it < 6144; it += C.G) {
        const bool smp = it >= 2048; const int q = smp ? it - 2048 : it;
        const int cbk = q & 31, tb = smp ? (q >> 5) & 15 : (q >> 5) & 3, b = smp ? q >> 9 : q >> 7;
        const int L = smp ? 1024 : 256, R0 = smp ? MP + b * 1024 : b * 256, NB = smp ? 8 : 16;
        __syncthreads();
        { const int cl = tid >> 3, t8 = tid & 7;
          const bf16_t* YT = smp ? YTs : YTp;
          const u32x4 v = *(const u32x4*)(YT + ((size_t)(cbk * 64 + cl) * NB + b) * L + tb * 64 + 8 * t8);
          const unsigned* pv = (const unsigned*)&v;
#pragma unroll
          for (int j = 0; j < 4; ++j) { ys[(8 * t8 + 2 * j) * 72 + cl] = (bf16_t)(pv[j] & 0xffffu); ys[(8 * t8 + 2 * j + 1) * 72 + cl] = (bf16_t)(pv[j] >> 16); } }
        __syncthreads();
        { const int tl = tid >> 3, c8 = tid & 7; const size_t off = (size_t)(R0 + tb * 64 + tl) * D + cbk * 64 + 8 * c8;
          const u32x4 yv = *(const LAS u32x4*)(ys + tl * 72 + 8 * c8), xv = *(const u32x4*)(X0 + off);
          const unsigned* py = (const unsigned*)&yv; const unsigned* px = (const unsigned*)&xv; u32x4 o; unsigned* po = (unsigned*)&o;
#pragma unroll
          for (int j = 0; j < 4; ++j) po[j] = cvt_pk(bflo(py[j]) * bflo(px[j]), bfhi(py[j]) * bfhi(px[j]));
          *(u32x4*)(Om + off) = o; }
    }
    __syncthreads();
}

__device__ __forceinline__ void phase_rw_mix(const Ctx& C, const bf16_t* H, const float* mu, bf16_t* XM) {
    const int gw = C.bid * 8 + C.wave, NGW = C.G * 8, lane = C.lane;
    for (int m = gw; m < MT; m += NGW) {
        const int t = m < MP ? (m & 255) : ((m - MP) & 1023), L = m < MP ? 256 : 1024;
        const bool hasp = t > 0, hasn = t < L - 1;
#pragma unroll
        for (int ch = 0; ch < 4; ++ch) {
            const int c0 = 8 * (lane + 64 * ch);
            const bf16_t* hp = H + (size_t)m * D + c0;
            u32x4 a = *(const u32x4*)(hp - (hasp ? D : 0)), c = *(const u32x4*)(hp + (hasn ? D : 0)); const u32x4 b = *(const u32x4*)hp;
            { const unsigned mk0 = hasp ? 0xffffffffu : 0u, mk1 = hasn ? 0xffffffffu : 0u; a.x &= mk0; a.y &= mk0; a.z &= mk0; a.w &= mk0; c.x &= mk1; c.y &= mk1; c.z &= mk1; c.w &= mk1; }
            const unsigned* pa = (const unsigned*)&a; const unsigned* pb = (const unsigned*)&b; const unsigned* pc = (const unsigned*)&c;
            float hv[8], xx[8];
#pragma unroll
            for (int j = 0; j < 4; ++j) { hv[2 * j] = bflo(pb[j]); hv[2 * j + 1] = bfhi(pb[j]);
                xx[2 * j] = 0.5f * (bflo(pa[j]) + bflo(pc[j])) - hv[2 * j]; xx[2 * j + 1] = 0.5f * (bfhi(pa[j]) + bfhi(pc[j])) - hv[2 * j + 1]; }
#pragma unroll
            for (int s = 0; s < 6; ++s) {
                const int mi = s == 0 ? 0 : s == 1 ? 2 : s == 2 ? 3 : s == 3 ? 1 : s;
                const f32x4 m0 = *(const f32x4*)(mu + mi * D + c0), m1 = *(const f32x4*)(mu + mi * D + c0 + 4);
                u32x4 o; o.x = cvt_pk(hv[0] + xx[0] * m0.x, hv[1] + xx[1] * m0.y); o.y = cvt_pk(hv[2] + xx[2] * m0.z, hv[3] + xx[3] * m0.w);
                o.z = cvt_pk(hv[4] + xx[4] * m1.x, hv[5] + xx[5] * m1.y); o.w = cvt_pk(hv[6] + xx[6] * m1.z, hv[7] + xx[7] * m1.w);
                *(u32x4*)(XM + ((size_t)s * MT + m) * D + c0) = o;
            }
        }
    }
}

__device__ __forceinline__ float dpp_xor1(float x) { return __int_as_float(__builtin_amdgcn_update_dpp(0, __float_as_int(x), 0xB1, 0xF, 0xF, true)); }
__device__ __forceinline__ float dpp_xor2(float x) { return __int_as_float(__builtin_amdgcn_update_dpp(0, __float_as_int(x), 0x4E, 0xF, 0xF, true)); }

constexpr int SC_STEP = 6 * 64;
template <int R, int SC_TS>
__device__ __forceinline__ void rw_scan_task(LAS float* buf, int lane, const bf16_t* Rm, const bf16_t* Km, const bf16_t* Vm, const bf16_t* LD, const bf16_t* LA,
                                             const float* k_k, const float* k_a, const float* invsq, const float* state_in, bf16_t* YB, float* state_out, bool smp, int b, int head, int dir, int half) {
    const int rg = lane >> 2, kq = lane & 3;
    const int L = smp ? 1024 : 256, R0 = smp ? MP + b * 1024 : b * 256;
    const int row0 = half * (16 * R) + R * rg;
    f32x2 S[R][8];
    if (smp) {
        const float* sp = state_in + ((size_t)(b * 2 + dir) * 32 + head) * 4096 + row0 * 64 + 16 * kq;
#pragma unroll
        for (int rr = 0; rr < R; ++rr)
#pragma unroll
            for (int j4 = 0; j4 < 4; ++j4) { const f32x4 v = *(const f32x4*)(sp + rr * 64 + 4 * j4); S[rr][2 * j4] = (f32x2){v.x, v.y}; S[rr][2 * j4 + 1] = (f32x2){v.z, v.w}; }
    } else {
#pragma unroll
        for (int rr = 0; rr < R; ++rr)
#pragma unroll
            for (int j = 0; j < 8; ++j) S[rr][j] = (f32x2){0.f, 0.f};
    }
    const int ch = head * 64 + lane; const size_t hbase = (size_t)head * MT * 64 + lane;
    const float kkc = k_k[ch], kac = k_a[ch];
    const bf16_t* ldp = LD + (size_t)dir * MT * D; const bf16_t* lap = LA + (size_t)dir * MT * D;
    bf16_t* yb = YB + (size_t)dir * MT * D;
    bf16_t pr[SC_TS], pk[SC_TS], pv[SC_TS], pl[SC_TS], pa[SC_TS], qr[SC_TS], qk[SC_TS], qv[SC_TS], ql[SC_TS], qa[SC_TS];
    const int tstart = dir ? L - 1 : 0, tstep = dir ? -1 : 1;
    const int NCH = L / SC_TS;
#define SC_PREFETCH(c) do { _Pragma("unroll") for (int s_ = 0; s_ < SC_TS; ++s_) { const size_t o_ = hbase + (size_t)(R0 + tstart + tstep * ((c) * SC_TS + s_)) * 64; pr[s_] = Rm[o_]; pk[s_] = Km[o_]; pv[s_] = Vm[o_]; pl[s_] = ldp[o_]; pa[s_] = lap[o_]; } } while (0)
#define SC_DERIVE(s_, bufp) do { const float r_ = bf2f(pr[s_]), k_ = bf2f(pk[s_]), v_ = bf2f(pv[s_]), ld_ = bf2f(pl[s_]), a_ = fsigmoid(bf2f(pa[s_])); \
        const float kr_ = k_ * kkc; const float kk_ = kr_ * __builtin_amdgcn_rsqf(wave_sum(kr_ * kr_) + 1e-12f); \
        const unsigned sa_ = (unsigned)(unsigned long)((bufp) + (s_) * SC_STEP) + 4u * (unsigned)lane;     \
        asm volatile("ds_write_b32 %0, %1" :: "v"(sa_), "v"(fexp(ld_))); asm volatile("ds_write_b32 %0, %1 offset:256" :: "v"(sa_), "v"(kk_ * a_)); \
        asm volatile("ds_write_b32 %0, %1 offset:512" :: "v"(sa_), "v"(k_ * (1.0f + (a_ - 1.0f) * kac))); asm volatile("ds_write_b32 %0, %1 offset:768" :: "v"(sa_), "v"(-kk_)); \
        asm volatile("ds_write_b32 %0, %1 offset:1024" :: "v"(sa_), "v"(r_)); asm volatile("ds_write_b32 %0, %1 offset:1280" :: "v"(sa_), "v"(v_)); } while (0)
#define SC_PREFETCH2(c) do { _Pragma("unroll") for (int s_ = 0; s_ < SC_TS; ++s_) { const size_t o_ = hbase + (size_t)(R0 + tstart + tstep * ((c) * SC_TS + s_)) * 64; qr[s_] = Rm[o_]; qk[s_] = Km[o_]; qv[s_] = Vm[o_]; ql[s_] = ldp[o_]; qa[s_] = lap[o_]; } } while (0)
    SC_PREFETCH(0);
#pragma unroll
    for (int s = 0; s < SC_TS; ++s) SC_DERIVE(s, buf);
    asm volatile("s_waitcnt lgkmcnt(0)" ::: "memory");
    SC_PREFETCH(1);
    SC_PREFETCH2(2);
#define SC_DERIVE_Q(s_, bufp) do { const float r_ = bf2f(qr[s_]), k_ = bf2f(qk[s_]), v_ = bf2f(qv[s_]), ld_ = bf2f(ql[s_]), a_ = fsigmoid(bf2f(qa[s_])); \
        const float kr_ = k_ * kkc; const float kk_ = kr_ * __builtin_amdgcn_rsqf(wave_sum(kr_ * kr_) + 1e-12f); \
        const unsigned sa_ = (unsigned)(unsigned long)((bufp) + (s_) * SC_STEP) + 4u * (unsigned)lane; \
        asm volatile("ds_write_b32 %0, %1" :: "v"(sa_), "v"(fexp(ld_))); asm volatile("ds_write_b32 %0, %1 offset:256" :: "v"(sa_), "v"(kk_ * a_)); \
        asm volatile("ds_write_b32 %0, %1 offset:512" :: "v"(sa_), "v"(k_ * (1.0f + (a_ - 1.0f) * kac))); asm volatile("ds_write_b32 %0, %1 offset:768" :: "v"(sa_), "v"(-kk_)); \
        asm volatile("ds_write_b32 %0, %1 offset:1024" :: "v"(sa_), "v"(r_)); asm volatile("ds_write_b32 %0, %1 offset:1280" :: "v"(sa_), "v"(v_)); } while (0)
    LAS float* const buf0 = buf; LAS float* const buf1 = buf + SC_TS * SC_STEP;
    for (int cix = 0; cix < NCH; cix += 2) {
#pragma unroll
        for (int s = 0; s < SC_TS; ++s) {
            SC_DERIVE(s, buf1);
            if (cix + 3 < NCH) { const size_t o_ = hbase + (size_t)(R0 + tstart + tstep * ((cix + 3) * SC_TS + s)) * 64; pr[s] = Rm[o_]; pk[s] = Km[o_]; pv[s] = Vm[o_]; pl[s] = ldp[o_]; pa[s] = lap[o_]; }
#define BC_ buf0
#define CX_ cix
            const LAS float* sb = BC_ + s * SC_STEP;
            f32x2 w2[8], b2[8], d2[8], n2[8], r2[8];
#pragma unroll
            for (int j4 = 0; j4 < 4; ++j4) { const f32x4 nv = *(const LAS f32x4*)(sb + 192 + 16 * kq + 4 * j4); n2[2 * j4] = (f32x2){nv.x, nv.y}; n2[2 * j4 + 1] = (f32x2){nv.z, nv.w}; }
#pragma unroll
            for (int j4 = 0; j4 < 4; ++j4) {
                const f32x4 bv = *(const LAS f32x4*)(sb + 64 + 16 * kq + 4 * j4), dv = *(const LAS f32x4*)(sb + 128 + 16 * kq + 4 * j4), wv = *(const LAS f32x4*)(sb + 16 * kq + 4 * j4), rv = *(const LAS f32x4*)(sb + 256 + 16 * kq + 4 * j4);
                w2[2 * j4] = (f32x2){wv.x, wv.y}; w2[2 * j4 + 1] = (f32x2){wv.z, wv.w}; b2[2 * j4] = (f32x2){bv.x, bv.y}; b2[2 * j4 + 1] = (f32x2){bv.z, bv.w};
                d2[2 * j4] = (f32x2){dv.x, dv.y}; d2[2 * j4 + 1] = (f32x2){dv.z, dv.w}; r2[2 * j4] = (f32x2){rv.x, rv.y}; r2[2 * j4 + 1] = (f32x2){rv.z, rv.w};
            }
            float vrow[R];
            if (R == 4) { const f32x4 vv = *(const LAS f32x4*)(sb + 320 + row0); vrow[0] = vv.x; vrow[R > 1 ? 1 : 0] = vv.y; vrow[R > 2 ? R - 2 : 0] = vv.z; vrow[R - 1] = vv.w; }
            else if (R == 2) { const f32x2 vv = *(const LAS f32x2*)(sb + 320 + row0); vrow[0] = vv.x; vrow[R - 1] = vv.y; }
            else vrow[0] = sb[320 + row0];
            float y[R];
#pragma unroll
            for (int rr = 0; rr < R; ++rr) {
                f32x2 a0 = S[rr][0] * n2[0], a1 = S[rr][1] * n2[1];
#pragma unroll
                for (int j = 2; j < 8; j += 2) { a0 = S[rr][j] * n2[j] + a0; a1 = S[rr][j + 1] * n2[j + 1] + a1; }
                a0 = a0 + a1;
                float sa = a0.x + a0.y; sa += dpp_xor1(sa); sa += dpp_xor2(sa);
                const f32x2 sa2 = (f32x2){sa, sa}, vr2 = (f32x2){vrow[rr], vrow[rr]};
                f32x2 y0 = (f32x2){0.f, 0.f}, y1 = (f32x2){0.f, 0.f};
#pragma unroll
                for (int j = 0; j < 8; j += 2) {
                    S[rr][j] = S[rr][j] * w2[j] + (sa2 * b2[j] + vr2 * d2[j]);
                    S[rr][j + 1] = S[rr][j + 1] * w2[j + 1] + (sa2 * b2[j + 1] + vr2 * d2[j + 1]);
                    y0 = S[rr][j] * r2[j] + y0; y1 = S[rr][j + 1] * r2[j + 1] + y1;
                }
                y0 = y0 + y1;
                float yy = y0.x + y0.y; yy += dpp_xor1(yy); yy += dpp_xor2(yy); y[rr] = yy;
            }
            {
                const int t = tstart + tstep * ((CX_) * SC_TS + s); bf16_t* yp = yb + (size_t)(R0 + t) * D + head * 64;
                if (R == 4) { const float ys = kq == 0 ? y[0] : kq == 1 ? y[R > 1 ? 1 : 0] : kq == 2 ? y[R > 2 ? R - 2 : 0] : y[R - 1]; yp[lane] = (bf16_t)cvt_pk(ys, ys); }
                else if (R == 2) { const float ys = (kq & 1) ? y[R - 1] : y[0]; yp[half * 32 + 2 * rg + (kq & 1)] = (bf16_t)cvt_pk(ys, ys); }
                else yp[row0] = (bf16_t)cvt_pk(y[0], y[0]);
            }
#undef BC_
#undef CX_
        }
        asm volatile("s_waitcnt lgkmcnt(0)" ::: "memory");
#pragma unroll
        for (int s = 0; s < SC_TS; ++s) {
            SC_DERIVE_Q(s, buf0);
            if (cix + 4 < NCH) { const size_t o_ = hbase + (size_t)(R0 + tstart + tstep * ((cix + 4) * SC_TS + s)) * 64; qr[s] = Rm[o_]; qk[s] = Km[o_]; qv[s] = Vm[o_]; ql[s] = ldp[o_]; qa[s] = lap[o_]; }
#define BC_ buf1
#define CX_ (cix + 1)
            const LAS float* sb = BC_ + s * SC_STEP;
            f32x2 w2[8], b2[8], d2[8], n2[8], r2[8];
#pragma unroll
            for (int j4 = 0; j4 < 4; ++j4) { const f32x4 nv = *(const LAS f32x4*)(sb + 192 + 16 * kq + 4 * j4); n2[2 * j4] = (f32x2){nv.x, nv.y}; n2[2 * j4 + 1] = (f32x2){nv.z, nv.w}; }
#pragma unroll
            for (int j4 = 0; j4 < 4; ++j4) {
                const f32x4 bv = *(const LAS f32x4*)(sb + 64 + 16 * kq + 4 * j4), dv = *(const LAS f32x4*)(sb + 128 + 16 * kq + 4 * j4), wv = *(const LAS f32x4*)(sb + 16 * kq + 4 * j4), rv = *(const LAS f32x4*)(sb + 256 + 16 * kq + 4 * j4);
                w2[2 * j4] = (f32x2){wv.x, wv.y}; w2[2 * j4 + 1] = (f32x2){wv.z, wv.w}; b2[2 * j4] = (f32x2){bv.x, bv.y}; b2[2 * j4 + 1] = (f32x2){bv.z, bv.w};
                d2[2 * j4] = (f32x2){dv.x, dv.y}; d2[2 * j4 + 1] = (f32x2){dv.z, dv.w}; r2[2 * j4] = (f32x2){rv.x, rv.y}; r2[2 * j4 + 1] = (f32x2){rv.z, rv.w};
            }
            float vrow[R];
            if (R == 4) { const f32x4 vv = *(const LAS f32x4*)(sb + 320 + row0); vrow[0] = vv.x; vrow[R > 1 ? 1 : 0] = vv.y; vrow[R > 2 ? R - 2 : 0] = vv.z; vrow[R - 1] = vv.w; }
            else if (R == 2) { const f32x2 vv = *(const LAS f32x2*)(sb + 320 + row0); vrow[0] = vv.x; vrow[R - 1] = vv.y; }
            else vrow[0] = sb[320 + row0];
            float y[R];
#pragma unroll
            for (int rr = 0; rr < R; ++rr) {
                f32x2 a0 = S[rr][0] * n2[0], a1 = S[rr][1] * n2[1];
#pragma unroll
                for (int j = 2; j < 8; j += 2) { a0 = S[rr][j] * n2[j] + a0; a1 = S[rr][j + 1] * n2[j + 1] + a1; }
                a0 = a0 + a1;
                float sa = a0.x + a0.y; sa += dpp_xor1(sa); sa += dpp_xor2(sa);
                const f32x2 sa2 = (f32x2){sa, sa}, vr2 = (f32x2){vrow[rr], vrow[rr]};
                f32x2 y0 = (f32x2){0.f, 0.f}, y1 = (f32x2){0.f, 0.f};
#pragma unroll
                for (int j = 0; j < 8; j += 2) {
                    S[rr][j] = S[rr][j] * w2[j] + (sa2 * b2[j] + vr2 * d2[j]);
                    S[rr][j + 1] = S[rr][j + 1] * w2[j + 1] + (sa2 * b2[j + 1] + vr2 * d2[j + 1]);
                    y0 = S[rr][j] * r2[j] + y0; y1 = S[rr][j + 1] * r2[j + 1] + y1;
                }
                y0 = y0 + y1;
                float yy = y0.x + y0.y; yy += dpp_xor1(yy); yy += dpp_xor2(yy); y[rr] = yy;
            }
            {
                const int t = tstart + tstep * ((CX_) * SC_TS + s); bf16_t* yp = yb + (size_t)(R0 + t) * D + head * 64;
                if (R == 4) { const float ys = kq == 0 ? y[0] : kq == 1 ? y[R > 1 ? 1 : 0] : kq == 2 ? y[R > 2 ? R - 2 : 0] : y[R - 1]; yp[lane] = (bf16_t)cvt_pk(ys, ys); }
                else if (R == 2) { const float ys = (kq & 1) ? y[R - 1] : y[0]; yp[half * 32 + 2 * rg + (kq & 1)] = (bf16_t)cvt_pk(ys, ys); }
                else yp[row0] = (bf16_t)cvt_pk(y[0], y[0]);
            }
#undef BC_
#undef CX_
        }
        asm volatile("s_waitcnt lgkmcnt(0)" ::: "memory");
    }
#undef SC_DERIVE_Q
#undef SC_PREFETCH
#undef SC_PREFETCH2
#undef SC_DERIVE
    if (!smp) {
        float* sp = state_out + ((size_t)(b * 2 + dir) * 32 + head) * 4096 + row0 * 64 + 16 * kq;
#pragma unroll
        for (int rr = 0; rr < R; ++rr)
#pragma unroll
            for (int j4 = 0; j4 < 4; ++j4) *(f32x4*)(sp + rr * 64 + 4 * j4) = (f32x4){S[rr][2 * j4].x, S[rr][2 * j4].y, S[rr][2 * j4 + 1].x, S[rr][2 * j4 + 1].y};
    }
}
__device__ __forceinline__ void phase_rw_scan(const Ctx& C, const bf16_t* Rm, const bf16_t* Km, const bf16_t* Vm, const bf16_t* LD, const bf16_t* LA,
                                              const float* k_k, const float* k_a, const float* invsq, const float* state_in, bf16_t* YB, float* state_out) {
    const int lane = C.lane, w = C.wave;
    LAS float* buf = (LAS float*)(C.lds + (w < 4 ? w * 24576 : 98304 + (w - 4) * 12288));
    if (w < 4) { for (int slot = C.bid * 4 + w; slot < 1024; slot += C.G * 4) { const int id = slot >> 1; rw_scan_task<2, 8>(buf, lane, Rm, Km, Vm, LD, LA, k_k, k_a, invsq, state_in, YB, state_out, true, id >> 6, (id >> 1) & 31, id & 1, slot & 1); } }
    else { for (int id = C.bid * 4 + (w - 4); id < 1024; id += C.G * 4) rw_scan_task<4, 4>(buf, lane, Rm, Km, Vm, LD, LA, k_k, k_a, invsq, state_in, YB, state_out, false, id >> 6, (id >> 1) & 31, id & 1, 0); }
    if (w >= 4) late_transposes(C, buf, C.bid * 4 + (w - 4), C.G * 4);
    __syncthreads();
}

__device__ __forceinline__ float head8_sum(float v) { v = DPP_ADD(v, 0xB1); v = DPP_ADD(v, 0x4E); v = DPP_ADD(v, 0x141); return v; }
__device__ __forceinline__ void phase_rw_post(const Ctx& C, const bf16_t* YB, const bf16_t* Rm, const bf16_t* Km, const bf16_t* Vm, const bf16_t* LA, const bf16_t* Gt,
                                              const float* k_a, const float* r_k, const float* ln_w, const float* ln_b, bf16_t* Om) {
    const int gw = C.bid * 8 + C.wave, NGW = C.G * 8, lane = C.lane;
    for (int m = gw; m < MT; m += NGW) {
#pragma unroll 1
        for (int ch = 0; ch < 4; ++ch) {
            const int c0 = 8 * (lane + 64 * ch); const size_t o = (size_t)m * D + c0;
            const u32x4 yfw = *(const u32x4*)(YB + o), ybw = *(const u32x4*)(YB + (size_t)MT * D + o); const unsigned* pyf = (const unsigned*)&yfw; const unsigned* pyb = (const unsigned*)&ybw;
            const size_t oh = hm_index(m, c0);
            const u32x4 rr = *(const u32x4*)(Rm + oh), kk = *(const u32x4*)(Km + oh), vv = *(const u32x4*)(Vm + oh), gg = *(const u32x4*)(Gt + o), l0 = *(const u32x4*)(LA + oh), l1 = *(const u32x4*)(LA + (size_t)MT * D + oh);
            const f32x4 ka0 = *(const f32x4*)(k_a + c0), ka1 = *(const f32x4*)(k_a + c0 + 4), rk0 = *(const f32x4*)(r_k + c0), rk1 = *(const f32x4*)(r_k + c0 + 4);
            const f32x4 lw0 = *(const f32x4*)(ln_w + c0), lw1 = *(const f32x4*)(ln_w + c0 + 4), lb0 = *(const f32x4*)(ln_b + c0), lb1 = *(const f32x4*)(ln_b + c0 + 4);
            float y[8], r[8], k[8], v[8], g[8], a0[8], a1[8], ka[8], rk[8], lw[8], lb[8];
            const unsigned* pr = (const unsigned*)&rr; const unsigned* pk = (const unsigned*)&kk; const unsigned* pv = (const unsigned*)&vv; const unsigned* pg = (const unsigned*)&gg; const unsigned* p0 = (const unsigned*)&l0; const unsigned* p1 = (const unsigned*)&l1;
#pragma unroll
            for (int j = 0; j < 4; ++j) {
                y[2 * j] = bflo(pyf[j]) + bflo(pyb[j]); y[2 * j + 1] = bfhi(pyf[j]) + bfhi(pyb[j]); ka[j] = ka0[j]; ka[4 + j] = ka1[j]; rk[j] = rk0[j]; rk[4 + j] = rk1[j]; lw[j] = lw0[j]; lw[4 + j] = lw1[j]; lb[j] = lb0[j]; lb[4 + j] = lb1[j];
                r[2 * j] = bflo(pr[j]); r[2 * j + 1] = bfhi(pr[j]); k[2 * j] = bflo(pk[j]); k[2 * j + 1] = bfhi(pk[j]); v[2 * j] = bflo(pv[j]); v[2 * j + 1] = bfhi(pv[j]);
                g[2 * j] = bflo(pg[j]); g[2 * j + 1] = bfhi(pg[j]); a0[2 * j] = fsigmoid(bflo(p0[j])); a0[2 * j + 1] = fsigmoid(bfhi(p0[j])); a1[2 * j] = fsigmoid(bflo(p1[j])); a1[2 * j + 1] = fsigmoid(bfhi(p1[j]));
            }
            float s = 0.f, bon = 0.f;
#pragma unroll
            for (int j = 0; j < 8; ++j) { s += y[j]; bon += r[j] * (k[j] * (2.0f + (a0[j] + a1[j] - 2.0f) * ka[j])) * rk[j]; }
            const float mean = head8_sum(s) * (1.0f / 64.0f); bon = head8_sum(bon);
            float q = 0.f;
#pragma unroll
            for (int j = 0; j < 8; ++j) { y[j] -= mean; q += y[j] * y[j]; }
            const float rstd = __builtin_amdgcn_rsqf(head8_sum(q) * (1.0f / 64.0f) + 64e-5f);
            float ov[8];
#pragma unroll
            for (int j = 0; j < 8; ++j) ov[j] = (y[j] * rstd * lw[j] + lb[j] + bon * v[j]) * g[j];
            u32x4 w; w.x = cvt_pk(ov[0], ov[1]); w.y = cvt_pk(ov[2], ov[3]); w.z = cvt_pk(ov[4], ov[5]); w.w = cvt_pk(ov[6], ov[7]);
            *(u32x4*)(Om + o) = w;
        }
    }
}

constexpr int NPH = 35;
#define IN(k) (lo <= (k) && (k) < hi)
#define SEAM(k) do { if (IN(k) && IN((k) + 1)) xcd_barrier(bar); } while (0)
#define LDSG ((PG8_LAS unsigned char*)C.lds)
#ifndef MK_REP_MASK
#define MK_REP_MASK 0ull
#endif
#define REPQ(k) (((MK_REP_MASK) >> (k)) & 1ull)

template <class Epi>
__device__ __forceinline__ void run_gemm(const Ctx& C, const bf16_t* A, const bf16_t* Bt, int N, int K, const Epi& E) {
    pg8::Gemm g{A, Bt, MT, N, K, K}; pg8::StaticOrder S; S.init(MT, N, C.G, C.bid);
    pg8::gemm_phase<Epi, pg8::StaticOrder, false>(LDSG, g, S, E, nullptr);
}

#ifndef MK_SPLIT_MASK
#define MK_SPLIT_MASK 15
#endif
#define PREVP1(L) (((L) > 0 && (((MK_SPLIT_MASK) >> ((L) - 1)) & 1)) ? (const bf16_t*)WSP(bf16_t, WS_ARENA + AR_SLAB) : (const bf16_t*)nullptr)
constexpr size_t AR_SLAB = 200 * MiB;
constexpr size_t CTL_SPLIT = 65536;
template <int SET>
__device__ __forceinline__ void run_gemm_split_res(const Ctx& C, const bf16_t* A, const bf16_t* Bt, int K, bf16_t* X, const float* gate_base) {
    pg8::Gemm g{A, Bt, MT, D, K, K / 2}; TailSplitOrder S; S.init(C.G, C.bid, K / 64);
    EpiResidualSplitB E{X, gate_base, WSP(bf16_t, WS_ARENA + AR_SLAB)};
    pg8::gemm_phase<EpiResidualSplitB, TailSplitOrder, false>(LDSG, g, S, E, nullptr);
}
template <int LAYER>
__device__ __forceinline__ void mlp_block(const Ctx& C, const XcdBarrier& bar, int lo, int hi, int b0) {
    bf16_t* X = WSP(bf16_t, WS_X); bf16_t* H = WSP(bf16_t, WS_H); bf16_t* U = WSP(bf16_t, WS_ARENA + AR_U);
    if (IN(b0)) { { phase_norm_mod_b(C, X, karg<I_N2G>() + LAYER * D, LAYER, 3, H); } if (REPQ(b0)) { phase_norm_mod_b(C, X, karg<I_N2G>() + LAYER * D, LAYER, 3, H); } }
    SEAM(b0);
    if (IN(b0 + 1)) { { EpiBf16<1> E{U, FF}; run_gemm(C, H, WSP(bf16_t, WS_W1T) + (size_t)LAYER * D * FF, FF, D, E); } if (REPQ(b0 + 1)) { EpiBf16<1> E{U, FF}; run_gemm(C, H, WSP(bf16_t, WS_W1T) + (size_t)LAYER * D * FF, FF, D, E); } }
    SEAM(b0 + 1);
    if (IN(b0 + 2)) { { if constexpr (((MK_SPLIT_MASK) >> LAYER) & 1) run_gemm_split_res<LAYER>(C, U, WSP(bf16_t, WS_W2T) + (size_t)LAYER * D * FF, FF, X, MODP(LAYER, 0, 5)); else { EpiResidualB<false> E{X, MODP(LAYER, 0, 5), nullptr, nullptr}; run_gemm(C, U, WSP(bf16_t, WS_W2T) + (size_t)LAYER * D * FF, D, FF, E); } } if (REPQ(b0 + 2)) { if constexpr (((MK_SPLIT_MASK) >> LAYER) & 1) run_gemm_split_res<LAYER>(C, U, WSP(bf16_t, WS_W2T) + (size_t)LAYER * D * FF, FF, X, MODP(LAYER, 0, 5)); else { EpiResidualB<false> E{X, MODP(LAYER, 0, 5), nullptr, nullptr}; run_gemm(C, U, WSP(bf16_t, WS_W2T) + (size_t)LAYER * D * FF, D, FF, E); } } }
    SEAM(b0 + 2);
}

template <int LAYER, int J>
__device__ __forceinline__ void attn_layer(const Ctx& C, const XcdBarrier& bar, int lo, int hi, int b0) {
    bf16_t* X = WSP(bf16_t, WS_X); bf16_t* H = WSP(bf16_t, WS_H);
    bf16_t *Q = WSP(bf16_t, WS_ARENA + AR_Q), *Kb = WSP(bf16_t, WS_ARENA + AR_K), *Vb = WSP(bf16_t, WS_ARENA + AR_V), *O = WSP(bf16_t, WS_ARENA + AR_O);
    if (IN(b0)) { { if (LAYER == 0) { phase_fg_transpose(C); phase_norm_mod(C, karg<I_XP>(), karg<I_XS>(), karg<I_N1G>() + LAYER * D, LAYER, 0, H); } else phase_norm_mod_b(C, X, karg<I_N1G>() + LAYER * D, LAYER, 0, H, PREVP1(LAYER), X, 8192); } if (REPQ(b0)) { if (LAYER == 0) { phase_fg_transpose(C); phase_norm_mod(C, karg<I_XP>(), karg<I_XS>(), karg<I_N1G>() + LAYER * D, LAYER, 0, H); } else phase_norm_mod_b(C, X, karg<I_N1G>() + LAYER * D, LAYER, 0, H, PREVP1(LAYER), X, 8192); } }
    SEAM(b0);
    if (IN(b0 + 1)) { { EpiQKV E{Q, Kb, Vb, C.out + OUT_NK + (size_t)J * 256 * 512, C.out + OUT_NV + (size_t)J * 256 * 512}; run_gemm(C, H, WSP(bf16_t, WS_WQKVT) + (size_t)J * D * 3072, 3072, D, E); } if (REPQ(b0 + 1)) { EpiQKV E{Q, Kb, Vb, C.out + OUT_NK + (size_t)J * 256 * 512, C.out + OUT_NV + (size_t)J * 256 * 512}; run_gemm(C, H, WSP(bf16_t, WS_WQKVT) + (size_t)J * D * 3072, 3072, D, E); } }
    SEAM(b0 + 1);
    if (IN(b0 + 2)) { { phase_attention(C, Q, Kb, Vb, WSP(bf16_t, WS_KC) + (size_t)J * 512 * 512, WSP(bf16_t, WS_VC) + (size_t)J * 512 * 512, karg<I_SINK>() + J * 16, O); } if (REPQ(b0 + 2)) { phase_attention(C, Q, Kb, Vb, WSP(bf16_t, WS_KC) + (size_t)J * 512 * 512, WSP(bf16_t, WS_VC) + (size_t)J * 512 * 512, karg<I_SINK>() + J * 16, O); } }
    SEAM(b0 + 2);
    if (IN(b0 + 3)) { { EpiResidualB<LAYER == 0> E{X, MODP(LAYER, 0, 2), LAYER == 0 ? karg<I_XP>() : nullptr, LAYER == 0 ? karg<I_XS>() : nullptr}; run_gemm(C, O, WSP(bf16_t, WS_WOT) + (size_t)J * D * D, D, D, E); } if (REPQ(b0 + 3)) { EpiResidualB<LAYER == 0> E{X, MODP(LAYER, 0, 2), LAYER == 0 ? karg<I_XP>() : nullptr, LAYER == 0 ? karg<I_XS>() : nullptr}; run_gemm(C, O, WSP(bf16_t, WS_WOT) + (size_t)J * D * D, D, D, E); } }
    SEAM(b0 + 3);
    mlp_block<LAYER>(C, bar, lo, hi, b0 + 4);
}

template <int LAYER>
__device__ __forceinline__ void hyena_layer(const Ctx& C, const XcdBarrier& bar, int lo, int hi, int b0) {
    bf16_t* X = WSP(bf16_t, WS_X); bf16_t* H = WSP(bf16_t, WS_H);
    bf16_t *Pm = WSP(bf16_t, WS_ARENA + AR_P), *X0 = WSP(bf16_t, WS_ARENA + AR_X0), *ZT = WSP(bf16_t, WS_ARENA + AR_ZT), *YT = WSP(bf16_t, WS_ARENA + AR_YT), *HO = WSP(bf16_t, WS_ARENA + AR_HO);
    bf16_t *ZTp = ZT, *ZTs = ZT + (size_t)MP * D, *YTp = YT, *YTs = YT + (size_t)MP * D;
    if (IN(b0)) { { phase_norm_mod_b(C, X, karg<I_N1G>() + LAYER * D, LAYER, 0, H, PREVP1(LAYER), X, 8192); } if (REPQ(b0)) { phase_norm_mod_b(C, X, karg<I_N1G>() + LAYER * D, LAYER, 0, H, PREVP1(LAYER), X, 8192); } }
    SEAM(b0);
    if (IN(b0 + 1)) { { EpiBf16<0> E{Pm, 6144}; run_gemm(C, H, WSP(bf16_t, WS_HYINT), 6144, D, E); } if (REPQ(b0 + 1)) { EpiBf16<0> E{Pm, 6144}; run_gemm(C, H, WSP(bf16_t, WS_HYINT), 6144, D, E); } }
    SEAM(b0 + 1);
    if (IN(b0 + 2)) { { phase_hy_gate(C, Pm, karg<I_HYCW>(), karg<I_HYCB>(), X0, ZTp, ZTs); } if (REPQ(b0 + 2)) { phase_hy_gate(C, Pm, karg<I_HYCW>(), karg<I_HYCB>(), X0, ZTp, ZTs); } }
    SEAM(b0 + 2);
    if (IN(b0 + 3)) { { phase_hy_conv<1024, 8>(C, WSP(bf16_t, WS_FGS), ZTs, YTs); phase_hy_conv<256, 16>(C, WSP(bf16_t, WS_FGP), ZTp, YTp); } if (REPQ(b0 + 3)) { phase_hy_conv<1024, 8>(C, WSP(bf16_t, WS_FGS), ZTs, YTs); phase_hy_conv<256, 16>(C, WSP(bf16_t, WS_FGP), ZTp, YTp); } }
    SEAM(b0 + 3);
    if (IN(b0 + 4)) { { phase_hy_out(C, YTp, YTs, X0, HO); } if (REPQ(b0 + 4)) { phase_hy_out(C, YTp, YTs, X0, HO); } }
    SEAM(b0 + 4);
    if (IN(b0 + 5)) { { EpiResidualB<false> E{X, MODP(LAYER, 0, 2), nullptr, nullptr}; run_gemm(C, HO, WSP(bf16_t, WS_HYOUTT), D, D, E); } if (REPQ(b0 + 5)) { EpiResidualB<false> E{X, MODP(LAYER, 0, 2), nullptr, nullptr}; run_gemm(C, HO, WSP(bf16_t, WS_HYOUTT), D, D, E); } }
    SEAM(b0 + 5);
    mlp_block<LAYER>(C, bar, lo, hi, b0 + 6);
}

__device__ __forceinline__ void rw_g2_phase(const Ctx& C, const bf16_t* XM, bf16_t* Rm, bf16_t* A3, bf16_t* LD, bf16_t* LA, bf16_t* Gt) {
    if (C.G == 256 && C.bid >= 240) { pg8::Gemm g{XM, WSP(bf16_t, WS_RWBT), 6 * MT, 27 * 256, D, D}; RwOrder1 S{16, C.bid - 240, 1280, 27 * NPANEL, true}; EpiRw1 E{Rm, A3, karg<I_KK>(), WSP(float, WS_INVSQ)}; pg8::gemm_phase<EpiRw1, RwOrder1, false>(LDSG, g, S, E, nullptr); }
    else { pg8::Gemm g{A3, WSP(bf16_t, WS_LORA2T), 3 * MT, 40 * 256, 256, 256}; RwOrder2 S{C.G == 256 ? 240 : C.G, C.bid, nullptr, 0u}; EpiRw2 E{LD, LA, Gt, karg<I_W0>(), karg<I_A0>()}; pg8::gemm_phase<EpiRw2, RwOrder2, false>(LDSG, g, S, E, nullptr); }
}
template <int LAYER>
__device__ __forceinline__ void rwkv_layer(const Ctx& C, const XcdBarrier& bar, int lo, int hi, int b0) {
    bf16_t* X = WSP(bf16_t, WS_X); bf16_t* H = WSP(bf16_t, WS_H);
    bf16_t *XM = WSP(bf16_t, WS_ARENA + AR_XMIX), *LD = WSP(bf16_t, WS_ARENA + AR_LD), *LA = WSP(bf16_t, WS_ARENA + AR_LA), *Gt = WSP(bf16_t, WS_ARENA + AR_G), *RO = WSP(bf16_t, WS_ARENA + AR_RO);
    bf16_t *Rm = WSP(bf16_t, WS_ARENA + AR_R), *Km = WSP(bf16_t, WS_ARENA + AR_KK), *Vm = WSP(bf16_t, WS_ARENA + AR_VV), *A3 = WSP(bf16_t, WS_ARENA + AR_A3);
    bf16_t* YB = WSP(bf16_t, WS_ARENA + AR_YB);
    if (IN(b0)) { { phase_norm_mod_b(C, X, karg<I_N1G>() + LAYER * D, LAYER, 0, H, PREVP1(LAYER), X, 8192); } if (REPQ(b0)) { phase_norm_mod_b(C, X, karg<I_N1G>() + LAYER * D, LAYER, 0, H, PREVP1(LAYER), X, 8192); } }
    SEAM(b0);
    if (IN(b0 + 1)) { { phase_rw_mix(C, H, karg<I_MU>(), XM); } if (REPQ(b0 + 1)) { phase_rw_mix(C, H, karg<I_MU>(), XM); } }
    SEAM(b0 + 1);
    if (IN(b0 + 2)) { { pg8::Gemm g{XM, WSP(bf16_t, WS_RWBT), 6 * MT, 27 * 256, D, D}; RwOrder1 S{C.G, C.bid, 0, C.G == 256 ? 1280 : 27 * NPANEL, C.G == 256}; EpiRw1 E{Rm, A3, karg<I_KK>(), WSP(float, WS_INVSQ)}; pg8::gemm_phase<EpiRw1, RwOrder1, false>(LDSG, g, S, E, nullptr); } if (REPQ(b0 + 2)) { pg8::Gemm g{XM, WSP(bf16_t, WS_RWBT), 6 * MT, 27 * 256, D, D}; RwOrder1 S{C.G, C.bid, 0, C.G == 256 ? 1280 : 27 * NPANEL, C.G == 256}; EpiRw1 E{Rm, A3, karg<I_KK>(), WSP(float, WS_INVSQ)}; pg8::gemm_phase<EpiRw1, RwOrder1, false>(LDSG, g, S, E, nullptr); } }
    SEAM(b0 + 2);
    if (IN(b0 + 3)) { { rw_g2_phase(C, XM, Rm, A3, LD, LA, Gt); } if (REPQ(b0 + 3)) { rw_g2_phase(C, XM, Rm, A3, LD, LA, Gt); } }
    SEAM(b0 + 3);
    if (IN(b0 + 4)) { { phase_rw_scan(C, Rm, Km, Vm, LD, LA, karg<I_KK>(), karg<I_KA>(), WSP(float, WS_INVSQ), karg<I_ST>(), YB, C.out + OUT_ST); } if (REPQ(b0 + 4)) { phase_rw_scan(C, Rm, Km, Vm, LD, LA, karg<I_KK>(), karg<I_KA>(), WSP(float, WS_INVSQ), karg<I_ST>(), YB, C.out + OUT_ST); } }
    SEAM(b0 + 4);
    if (IN(b0 + 5)) { { phase_rw_post(C, YB, Rm, Km, Vm, LA, Gt, karg<I_KA>(), karg<I_RK>(), karg<I_LNW>(), karg<I_LNB>(), RO); } if (REPQ(b0 + 5)) { phase_rw_post(C, YB, Rm, Km, Vm, LA, Gt, karg<I_KA>(), karg<I_RK>(), karg<I_LNW>(), karg<I_LNB>(), RO); } }
    SEAM(b0 + 5);
    if (IN(b0 + 6)) { { EpiResidualB<false> E{X, MODP(LAYER, 0, 2), nullptr, nullptr}; run_gemm(C, RO, WSP(bf16_t, WS_RWOT), D, D, E); } if (REPQ(b0 + 6)) { EpiResidualB<false> E{X, MODP(LAYER, 0, 2), nullptr, nullptr}; run_gemm(C, RO, WSP(bf16_t, WS_RWOT), D, D, E); } }
    SEAM(b0 + 6);
    mlp_block<LAYER>(C, bar, lo, hi, b0 + 7);
}

__global__ void __launch_bounds__(512, 2) fwd_kernel(Params prm) {
    extern __shared__ __attribute__((aligned(16))) unsigned char lds_raw[];
    Ctx C;
    C.lds = (LAS unsigned char*)lds_raw;
    C.tid = threadIdx.x; C.lane = C.tid & 63; C.wave = __builtin_amdgcn_readfirstlane(C.tid >> 6); C.G = gridDim.x; C.bid = blockIdx.x;
    C.out = prm.out; C.ws = prm.ws;
    const int lo = prm.ph_lo, hi = prm.ph_hi;
    volatile LAS unsigned* xbw = (volatile LAS unsigned*)(C.lds + LDS_BAR_OFF);
    if (C.tid < 4) xbw[C.tid] = 0u;
    __syncthreads();
    XcdBarrier bar; bar.bar = (unsigned*)(C.ws + WS_CTL) + 1024; bar.x = 0; bar.st = xbw;
    if (hi - lo > 1) bar = xcd_barrier_post((unsigned*)(C.ws + WS_CTL) + 1024, xbw);

#ifdef MK_SKIP_FROM
    if (IN(0)) { for (size_t i = (size_t)C.bid * 512 + C.tid; i < (size_t)3 * 4194304; i += (size_t)C.G * 512) prm.out[OUT_NK + i] = 0.f; }
#endif
    if (IN(0)) { { phase_prologue(C); } if (REPQ(0)) { phase_prologue(C); } }
    SEAM(0);
    attn_layer<0, 0>(C, bar, lo, hi, 1);
    hyena_layer<1>(C, bar, lo, hi, 8);
    rwkv_layer<2>(C, bar, lo, hi, 17);
    attn_layer<3, 1>(C, bar, lo, hi, 27);
#ifndef MK_DBG_N
#define MK_DBG_N ((size_t)MT * D)
#endif
#ifndef MK_DBG_SCALE
#define MK_DBG_SCALE 1.0f
#endif
#ifdef MK_DBG_OFF
    if (IN(34)) { for (size_t i = (size_t)C.bid * 512 + C.tid; i < (size_t)MT * D; i += (size_t)C.G * 512) prm.out[OUT_Y + i] = i < (size_t)(MK_DBG_N) ? MK_DBG_SCALE * (MK_DBG_BF16 ? bf2f(WSP(bf16_t, MK_DBG_OFF)[i]) : WSP(float, MK_DBG_OFF)[i]) : 0.f; }
#else
    if (IN(34)) { { phase_norm_final_b(C, WSP(bf16_t, WS_X), karg<I_FNG>(), prm.out + OUT_Y, PREVP1(4), 8192); } if (REPQ(34)) { phase_norm_final_b(C, WSP(bf16_t, WS_X), karg<I_FNG>(), prm.out + OUT_Y, PREVP1(4), 8192); } }
#endif
}

#ifdef MK_SEP_CONV
__global__ void __launch_bounds__(512, 2) k_hyconv(Params prm) {
    extern __shared__ __attribute__((aligned(16))) unsigned char lds_raw3[];
    Ctx C; C.lds = (LAS unsigned char*)lds_raw3; C.tid = threadIdx.x; C.lane = C.tid & 63; C.wave = __builtin_amdgcn_readfirstlane(C.tid >> 6); C.G = gridDim.x; C.bid = blockIdx.x; C.out = prm.out; C.ws = prm.ws;
    bf16_t *ZT = WSP(bf16_t, WS_ARENA + AR_ZT), *YT = WSP(bf16_t, WS_ARENA + AR_YT);
    phase_hy_conv<1024, 8>(C, WSP(bf16_t, WS_FGS), ZT + (size_t)MP * D, YT + (size_t)MP * D); phase_hy_conv<256, 16>(C, WSP(bf16_t, WS_FGP), ZT, YT);
}
#endif
#ifdef MK_SEP_GATE
__global__ void __launch_bounds__(512, 2) k_hygate(Params prm) {
    extern __shared__ __attribute__((aligned(16))) unsigned char lds_raw2[];
    Ctx C; C.lds = (LAS unsigned char*)lds_raw2; C.tid = threadIdx.x; C.lane = C.tid & 63; C.wave = __builtin_amdgcn_readfirstlane(C.tid >> 6); C.G = gridDim.x; C.bid = blockIdx.x; C.out = prm.out; C.ws = prm.ws;
    bf16_t* ZT = WSP(bf16_t, WS_ARENA + AR_ZT);
    phase_hy_gate(C, WSP(bf16_t, WS_ARENA + AR_P), karg<I_HYCW>(), karg<I_HYCB>(), WSP(bf16_t, WS_ARENA + AR_X0), ZT, ZT + (size_t)MP * D);
}
#endif
#ifndef MK_PER_PHASE
#define MK_PER_PHASE 0
#endif
extern "C" void kernel_launch(void* const* d_in, const int* in_sizes, int n_in, void* d_out, int out_size, void* d_ws, size_t ws_size, hipStream_t stream) {
    static int grid = 0;
    if (grid == 0) {
        if (n_in != N_IN || ws_size < WS_END || out_size != 37748736) { fprintf(stderr, "kernel_launch: unexpected shapes (n_in %d, ws %zu, out %d); nothing launched\n", n_in, ws_size, out_size); grid = -1; return; }
        int dev = 0, cus = 0, per_cu = 0;
        if (hipGetDevice(&dev) != hipSuccess || hipDeviceGetAttribute(&cus, hipDeviceAttributeMultiprocessorCount, dev) != hipSuccess) { grid = -1; return; }
        if (hipFuncSetAttribute((const void*)fwd_kernel, hipFuncAttributeMaxDynamicSharedMemorySize, LDS_BYTES) != hipSuccess) { fprintf(stderr, "kernel_launch: hipFuncSetAttribute failed\n"); grid = -1; return; }
        if (hipOccupancyMaxActiveBlocksPerMultiprocessor(&per_cu, (const void*)fwd_kernel, 512, LDS_BYTES) != hipSuccess || per_cu < 1) { fprintf(stderr, "kernel_launch: occupancy query says %d\n", per_cu); }
        (void)hipGetLastError();
        grid = cus;
    }
    if (grid < 0) return;
    (void)hipMemsetAsync((char*)d_ws, 0, WS_ZERO_BYTES, stream);
    Params p{};
    for (int i = 0; i < N_IN; ++i) p.in[i] = (const float*)d_in[i];
    p.out = (float*)d_out; p.ws = (unsigned char*)d_ws;
#ifndef MK_LASTP
#define MK_LASTP NPH
#endif
#ifndef MK_FIRSTP
#define MK_FIRSTP 0
#endif
#if MK_PER_PHASE
    for (int k = MK_FIRSTP; k < MK_LASTP; ++k) {
#ifdef MK_SKIP_FROM
        if (k >= MK_SKIP_FROM && k < NPH - 1) continue;
#endif
#ifdef MK_SEP_CONV
        if (k == 11) { static bool a3 = false; if (!a3) { (void)hipFuncSetAttribute((const void*)k_hyconv, hipFuncAttributeMaxDynamicSharedMemorySize, 70000); a3 = true; } hipLaunchKernelGGL(k_hyconv, dim3(grid), dim3(512), 70000, stream, p); continue; }
#endif
#ifdef MK_SEP_GATE
        if (k == 10) { hipLaunchKernelGGL(k_hygate, dim3(grid), dim3(512), 16384, stream, p); continue; }
#endif
#ifdef MK_REPEAT_PH
        if (k == MK_REPEAT_PH) { p.ph_lo = k; p.ph_hi = k + 1; hipLaunchKernelGGL(fwd_kernel, dim3(grid), dim3(512), LDS_BYTES, stream, p); }
#endif
 p.ph_lo = k; p.ph_hi = k + 1; hipLaunchKernelGGL(fwd_kernel, dim3(grid), dim3(512), LDS_BYTES, stream, p); }
#else
    p.ph_lo = 0; p.ph_hi = NPH; hipLaunchKernelGGL(fwd_kernel, dim3(grid), dim3(512), LDS_BYTES, stream, p);
#endif
}
```

```cpp
#include <hip/hip_runtime.h>
#include <cstdio>
#include <cstdint>
namespace pg8 {
#define PG8_LAS __attribute__((address_space(3)))
typedef unsigned short bf16_t;
typedef short bf16x8 __attribute__((ext_vector_type(8)));
typedef float f32x4 __attribute__((ext_vector_type(4)));
typedef unsigned u32x4 __attribute__((ext_vector_type(4)));
constexpr int BM = 256, BK = 64, HALF = 128, HTB = HALF * BK * 2  , STAGE_BYTES = 8 * HTB, NXCD = 8, WGM = 4;

__host__ __device__ __forceinline__ int lds_byte(int r, int c) { const int st = (r >> 4) * 2 + (c >> 5), rr = r & 15, cc = c & 31, ob = rr * 64 + cc * 2; return st * 1024 + (ob ^ (((ob >> 9) & 1) << 5)); }
__host__ __device__ __forceinline__ void stage_rc(int b, int& R, int& C) { const int st = b / 1024, sb = b % 1024, swz = sb ^ (((sb >> 9) & 1) << 5); R = (st >> 1) * 16 + swz / 64; C = (st & 1) * 32 + (swz % 64) / 2; }
__host__ __device__ __forceinline__ int perm32(int rho) { const int n = rho >> 4, i = rho & 15; return 8 * (i >> 2) + 4 * n + (i & 3); }

struct Unit { int pm, pn, kh, mask; int nt = 0; };
struct Gemm { const bf16_t* A; const bf16_t* Bt; int M, N, K, KU; };

__host__ __device__ __forceinline__ bool tail_deal(int nwg, int G, int i, int c, int& L, int& mask) {
    const int full = nwg / G, rem = nwg - full * G;
    if (i < full) { L = i * G + c; mask = 15; return true; }
    if (i > full || rem == 0) return false;
    const int parts = (4 * rem <= G) ? 4 : ((2 * rem <= G) ? 2 : 1);
    if (c >= parts * rem) return false;
    L = full * G + c / parts; const int sub = c % parts;
    mask = parts == 1 ? 15 : (parts == 2 ? (sub ? 0xA : 0x5) : (1 << sub));
    return true;
}
struct StaticOrder {
    int nM, nN, nwg, G, c;
    __host__ __device__ void init(int M, int N, int G_, int c_) { nM = M / BM; nN = N / BM; nwg = nM * nN; G = G_; c = c_; }
    __host__ __device__ bool next(int i, Unit& u) const { const long L = (long)i * G + c; if (L >= nwg) return false; map((int)L, u); u.kh = 0; u.mask = 15; return true; }
    __host__ __device__ bool map(int L, Unit& u) const {
        int wgid = (int)L; { const int q = nwg / NXCD, r = nwg % NXCD, xcd = wgid % NXCD, off = wgid / NXCD; wgid = (xcd < r ? xcd * (q + 1) : r * (q + 1) + (xcd - r) * q) + off; }
        const int nig = WGM * nN, gid = wgid / nig, fm = gid * WGM, gsz = (nM - fm) < WGM ? (nM - fm) : WGM;
        u.pm = fm + ((wgid % nig) % gsz); u.pn = (wgid % nig) / gsz; return true;
    }
    __device__ __forceinline__ void a_ready(const Unit&) const {}
    __device__ __forceinline__ void done(const Unit&) const {}
};

template <class Epi, class Sched, bool STAMP = false>
__device__ __forceinline__ void gemm_phase(PG8_LAS unsigned char* lds, const Gemm g, const Sched& S, const Epi& E, unsigned long long* stamps) {
    const int tid = threadIdx.x, wid = __builtin_amdgcn_readfirstlane(tid >> 6), lane = tid & 63, wr = wid >> 2, wc = wid & 3, fr = lane & 15, fq = lane >> 4;
    const int K = g.K, nt = g.KU / BK;
    int ts_lo = 0, ts_hi = 0, nts = 0; const unsigned long long rt_entry = STAMP ? (unsigned long long)wall_clock64() : 0ull;
#define PG8_STAMP() do { if (STAMP && wid == 0 && nts < 64) { const unsigned long long _c = (unsigned long long)clock64(); \
        ts_lo = (lane == nts) ? (int)(unsigned)_c : ts_lo; ts_hi = (lane == nts) ? (int)(unsigned)(_c >> 32) : ts_hi; ++nts; } } while (0)
    PG8_STAMP();
    unsigned voffA[2], voffB[2];
#pragma unroll
    for (int i = 0; i < 2; ++i) { int R, C; stage_rc(tid * 16 + i * 8192, R, C); const int Rb = Epi::PERM ? ((R & ~31) + perm32(R & 31)) : R;
        voffA[i] = (unsigned)(R * K + C) * 2u; voffB[i] = (unsigned)(Rb * K + C) * 2u; }
    const size_t kstep = (size_t)(BK * 2);
    const size_t hstep = (size_t)HALF * K * 2;
    const size_t tstep = 2 * hstep;
    const unsigned ldsw = (unsigned)wid * 1024u;
    const int aoff = lds_byte(wr * 64 + fr, fq * 8), boff = lds_byte(wc * 32 + fr, fq * 8);
#define PG8_SA(b, h) (((b) * 2 + (h)) * HTB)
#define PG8_SB(b, h) ((4 + (b) * 2 + (h)) * HTB)
#define PG8_STAGE(bufoff, gbase, voff) do { _Pragma("unroll") for (int _i = 0; _i < 2; ++_i) \
        __builtin_amdgcn_global_load_lds((const unsigned*)((const char*)(gbase) + (voff)[_i]), (PG8_LAS unsigned*)(lds + (bufoff) + ldsw + _i * 8192), 16, 0, 0); } while (0)
#define PG8_LDA(dst, b, h) do { _Pragma("unroll") for (int m = 0; m < 4; ++m) _Pragma("unroll") for (int k = 0; k < 2; ++k) dst[m][k] = *(const PG8_LAS bf16x8*)(lds + PG8_SA(b, h) + aoff + m * 2048 + k * 1024); } while (0)
#define PG8_LDB(dst, b, h) do { _Pragma("unroll") for (int n = 0; n < 2; ++n) _Pragma("unroll") for (int k = 0; k < 2; ++k) dst[n][k] = *(const PG8_LAS bf16x8*)(lds + PG8_SB(b, h) + boff + n * 2048 + k * 1024); } while (0)
#define PG8_MMA(ai, bj, At, Bt) do { __builtin_amdgcn_s_setprio(1); _Pragma("unroll") for (int k = 0; k < 2; ++k) _Pragma("unroll") for (int m = 0; m < 4; ++m) _Pragma("unroll") for (int n = 0; n < 2; ++n) \
        asm volatile("v_mfma_f32_16x16x32_bf16 %0, %1, %2, %0" : "+v"(acc[ai][bj][m][n]) : "v"(Bt[n][k]), "v"(At[m][k])); __builtin_amdgcn_s_setprio(0); } while (0)
#define PG8_ACC_FENCE1(ai, bj) asm volatile("s_nop 15\n\ts_nop 15" : "+v"(acc[ai][bj][0][0]), "+v"(acc[ai][bj][0][1]), "+v"(acc[ai][bj][1][0]), "+v"(acc[ai][bj][1][1]), "+v"(acc[ai][bj][2][0]), "+v"(acc[ai][bj][2][1]), "+v"(acc[ai][bj][3][0]), "+v"(acc[ai][bj][3][1]))
#define PG8_ACC_FENCE() do { PG8_ACC_FENCE1(0, 0); PG8_ACC_FENCE1(0, 1); PG8_ACC_FENCE1(1, 0); PG8_ACC_FENCE1(1, 1); } while (0)
#define PG8_WAIT_V(n) asm volatile("s_waitcnt vmcnt(" #n ")" ::: "memory")
#define PG8_WAIT_L(n) asm volatile("s_waitcnt lgkmcnt(" #n ")" ::: "memory")
#define PG8_BAR __builtin_amdgcn_s_barrier()
#define PG8_SCHED __builtin_amdgcn_sched_barrier(0)
    Unit cur, nxt; int ui = 0;
    if (!S.next(0, cur)) return;
    f32x4 acc[2][2][4][2];
#pragma unroll
    for (int a = 0; a < 2; ++a)
#pragma unroll
        for (int b = 0; b < 2; ++b)
#pragma unroll
            for (int m = 0; m < 4; ++m)
#pragma unroll
                for (int n = 0; n < 2; ++n) acc[a][b][m][n] = (f32x4){0.f, 0.f, 0.f, 0.f};
    bf16x8 At[4][2], B0[2][2], B1[2][2];
    const size_t kslice = (size_t)g.KU * 2;
    const char* cA = (const char*)g.A + (size_t)cur.pm * tstep + cur.kh * kslice; const char* cB = (const char*)g.Bt + (size_t)cur.pn * tstep + cur.kh * kslice;
    S.a_ready(cur);
    PG8_STAGE(PG8_SB(0, 0), cB, voffB); PG8_STAGE(PG8_SA(0, 0), cA, voffA); PG8_STAGE(PG8_SB(0, 1), cB + hstep, voffB); PG8_STAGE(PG8_SA(0, 1), cA + hstep, voffA);
    if (wr == 1) PG8_BAR;
    PG8_WAIT_V(4); PG8_BAR;
    PG8_STAGE(PG8_SB(1, 0), cB + kstep, voffB); PG8_STAGE(PG8_SA(1, 0), cA + kstep, voffA); PG8_STAGE(PG8_SB(1, 1), cB + hstep + kstep, voffB);
    PG8_WAIT_V(6); PG8_BAR;
    PG8_STAMP();
    for (;;) {
        const bool has_next = S.next(ui + 1, nxt);
        const char* nA = has_next ? (const char*)g.A + (size_t)nxt.pm * tstep + nxt.kh * kslice : cA; const char* nB = has_next ? (const char*)g.Bt + (size_t)nxt.pn * tstep + nxt.kh * kslice : cB;
        const int unt = cur.nt ? cur.nt : nt;
        const bool pre = ui > 0;
        for (int t = 0; t < unt; t += 2) {
            const bool last = (t == unt - 2);
            const char* a1 = cA + (size_t)(t + 1) * kstep;
            const char* a2 = last ? nA : cA + (size_t)(t + 2) * kstep; const char* b2 = last ? nB : cB + (size_t)(t + 2) * kstep;
            const char* a3 = a2 + kstep; const char* b3 = b2 + kstep;
            if (last && has_next) S.a_ready(nxt);
            PG8_LDB(B0, 0, 0); PG8_SCHED; PG8_LDA(At, 0, 0); if (!(pre && t == 0)) PG8_STAGE(PG8_SA(1, 1), a1 + hstep, voffA);
            PG8_WAIT_L(8); PG8_BAR; PG8_WAIT_L(0); PG8_MMA(0, 0, At, B0); PG8_BAR; PG8_SCHED;
            PG8_LDB(B1, 0, 1); PG8_STAGE(PG8_SB(0, 0), b2, voffB);
            PG8_BAR; PG8_WAIT_L(0); PG8_MMA(0, 1, At, B1); PG8_BAR;
            PG8_LDA(At, 0, 1); PG8_STAGE(PG8_SA(0, 0), a2, voffA);
            PG8_BAR; PG8_WAIT_L(0); PG8_MMA(1, 0, At, B0); PG8_BAR; PG8_SCHED;
            PG8_STAGE(PG8_SB(0, 1), b2 + hstep, voffB);
            if (pre && t == 0) PG8_WAIT_V(22); else PG8_WAIT_V(6);
            PG8_BAR; PG8_MMA(1, 1, At, B1); PG8_BAR;
            PG8_LDB(B0, 1, 0); PG8_SCHED; PG8_LDA(At, 1, 0); PG8_STAGE(PG8_SA(0, 1), a2 + hstep, voffA);
            PG8_WAIT_L(8); PG8_BAR; PG8_WAIT_L(0); PG8_MMA(0, 0, At, B0); PG8_BAR; PG8_SCHED;
            PG8_LDB(B1, 1, 1); PG8_STAGE(PG8_SB(1, 0), b3, voffB);
            PG8_BAR; PG8_WAIT_L(0); PG8_MMA(0, 1, At, B1); PG8_BAR;
            PG8_LDA(At, 1, 1); PG8_STAGE(PG8_SA(1, 0), a3, voffA);
            PG8_BAR; PG8_WAIT_L(0); PG8_MMA(1, 0, At, B0); PG8_BAR; PG8_SCHED;
            PG8_STAGE(PG8_SB(1, 1), b3 + hstep, voffB);
            PG8_WAIT_V(6); PG8_BAR; PG8_MMA(1, 1, At, B1); PG8_BAR;
        }
        PG8_STAMP();
        if (has_next) { PG8_STAGE(PG8_SA(1, 1), nA + kstep + hstep, voffA); }
        asm volatile("" ::: "memory"); PG8_SCHED;
        PG8_ACC_FENCE();
        if constexpr (!Epi::AFTER_DRAIN) { E(acc, cur, wr, wc, fr, fq); S.done(cur); }
        PG8_STAMP();
        if (!has_next) break;
#pragma unroll
        for (int a = 0; a < 2; ++a)
#pragma unroll
            for (int b = 0; b < 2; ++b)
#pragma unroll
                for (int m = 0; m < 4; ++m)
#pragma unroll
                    for (int n = 0; n < 2; ++n) acc[a][b][m][n] = (f32x4){0.f, 0.f, 0.f, 0.f};
        cur = nxt; cA = nA; cB = nB; ++ui;
    }
    PG8_WAIT_V(0);
    if (wr == 0) PG8_BAR;
    PG8_BAR;
    if constexpr (Epi::AFTER_DRAIN) { E.fused(acc, cur, wr, wc, fr, fq, lds, wid, lane); S.done(cur); }
    PG8_STAMP();
    if (STAMP && wid == 0) { stamps[lane] = lane < nts ? (((unsigned long long)(unsigned)ts_hi << 32) | (unsigned)ts_lo) : 0ull;
        if (lane == 62) stamps[62] = rt_entry; if (lane == 63) stamps[63] = (unsigned long long)wall_clock64(); }
#undef PG8_STAMP
#undef PG8_SA
#undef PG8_SB
#undef PG8_STAGE
#undef PG8_LDA
#undef PG8_LDB
#undef PG8_MMA
#undef PG8_ACC_FENCE
#undef PG8_ACC_FENCE1
#undef PG8_WAIT_V
#undef PG8_WAIT_L
#undef PG8_BAR
#undef PG8_SCHED
}
}

#define XB_TMO      128
#define XB_XCNT(j)  (256  + 64 * (j))
#define XB_XSUB(j)  (1280 + 64 * (j))
#define XB_XGEN(j)  (2304 + 64 * (j))
#define XB_TOP      3328
#define XB_TOPGEN   3392
#define XCD_BAR_WORDS 3456
#define XB_SPIN_CAP (1u << 20)
#define LAS __attribute__((address_space(3)))

__device__ __forceinline__ unsigned xb_ld(unsigned* p)              { return __hip_atomic_load(p, __ATOMIC_RELAXED, __HIP_MEMORY_SCOPE_AGENT); }
__device__ __forceinline__ unsigned xb_add(unsigned* p, unsigned v) { return __hip_atomic_fetch_add(p, v, __ATOMIC_RELAXED, __HIP_MEMORY_SCOPE_AGENT); }
__device__ __forceinline__ unsigned xb_xcc_id() { return (unsigned)__builtin_amdgcn_s_getreg((3 << 11) | 20) & 0xFu; }
#define XB_SPIN(cond, bar) do { unsigned _sp = 0; while (cond) { __builtin_amdgcn_s_sleep(1); \
    if ((++_sp & 255u) == 0u) { if (xb_ld(&(bar)[XB_TMO])) break; if (_sp > XB_SPIN_CAP) { atomicAdd(&(bar)[XB_TMO], 1u); break; } } } } while (0)

struct XcdBarrier {
    unsigned* bar; unsigned x;
    volatile LAS unsigned* st;
};

__device__ __forceinline__ XcdBarrier xcd_barrier_post(unsigned* bar, volatile LAS unsigned* st) {
    XcdBarrier b; b.bar = bar; b.x = xb_xcc_id(); b.st = st;
    if (threadIdx.x == 0) (void)xb_add(&bar[XB_XCNT(b.x)], 1u);
    return b;
}
__device__ __forceinline__ void xcd_barrier_complete(unsigned* bar, unsigned x, unsigned& nloc, unsigned& nx) {
    const unsigned G = gridDim.x * gridDim.y * gridDim.z;
    unsigned sum, cnt, mine, sp = 0u;
    for (;;) {
        sum = 0u; cnt = 0u; mine = 0u;
#pragma unroll
        for (unsigned j = 0; j < 16; ++j) { const unsigned c = xb_ld(&bar[XB_XCNT(j)]); sum += c; cnt += (c > 0u) ? 1u : 0u; mine = (j == x) ? c : mine; }
        if (sum == G) break;
        __builtin_amdgcn_s_sleep(1);
        if ((++sp & 255u) == 0u) { if (xb_ld(&bar[XB_TMO])) break; if (sp > XB_SPIN_CAP) { atomicAdd(&bar[XB_TMO], 1u); break; } }
    }
    nloc = mine > 0u ? mine : 1u; nx = cnt > 0u ? cnt : 1u;
}

__device__ __forceinline__ void xcd_barrier(const XcdBarrier& b) {
    asm volatile("s_waitcnt vmcnt(0)" ::: "memory");
    __syncthreads();
    if (threadIdx.x == 0) {
        unsigned* bar = b.bar;
        __builtin_amdgcn_s_waitcnt(0);
        unsigned nloc = b.st[0], nx = b.st[1];
        if (nloc == 0u) { xcd_barrier_complete(bar, b.x, nloc, nx); b.st[0] = nloc; b.st[1] = nx; }
        const unsigned old = xb_add(&bar[XB_XSUB(b.x)], 1u);
        const unsigned gen = old / nloc;
        if (old + 1u == (gen + 1u) * nloc) {
            __builtin_amdgcn_fence(__ATOMIC_RELEASE, "agent");
            asm volatile("s_waitcnt vmcnt(0)" ::: "memory");
            const unsigned og = xb_add(&bar[XB_TOP], 1u);
            const unsigned tg = og / nx;
            if (og + 1u == (tg + 1u) * nx) xb_add(&bar[XB_TOPGEN], 1u);
            else XB_SPIN(xb_ld(&bar[XB_TOPGEN]) == tg, bar);
            __builtin_amdgcn_fence(__ATOMIC_ACQUIRE, "agent");
            xb_add(&bar[XB_XGEN(b.x)], 1u);
            asm volatile("s_waitcnt vmcnt(0)" ::: "memory");
        } else {
            XB_SPIN(xb_ld(&bar[XB_XGEN(b.x)]) == gen, bar);
            __builtin_amdgcn_fence(__ATOMIC_ACQUIRE, "agent");
            asm volatile("s_waitcnt vmcnt(0)" ::: "memory");
        }
    }
    __syncthreads();
}

typedef unsigned short bf16_t;
typedef short bf16x8 __attribute__((ext_vector_type(8)));
typedef short bf16x4 __attribute__((ext_vector_type(4)));
typedef float f32x2 __attribute__((ext_vector_type(2)));
typedef float f32x4 __attribute__((ext_vector_type(4)));
typedef float f32x16 __attribute__((ext_vector_type(16)));
typedef unsigned u32x4 __attribute__((ext_vector_type(4)));
typedef unsigned u32x2 __attribute__((ext_vector_type(2)));

constexpr int D = 2048, FF = 8192, MP = 4096, MS = 8192, MT = 12288;
constexpr int NPANEL = MT / 256;
constexpr size_t MiB = 1u << 20;
constexpr size_t WS_CTL = 0, WS_MOD = 1 * MiB, WS_ZERO_BYTES = 3 * MiB;
constexpr size_t WS_ROPE = 3 * MiB;
constexpr size_t WS_W1T = 4 * MiB, WS_W2T = 132 * MiB, WS_WQKVT = 260 * MiB, WS_WOT = 284 * MiB, WS_HYINT = 300 * MiB, WS_HYOUTT = 324 * MiB;
constexpr size_t WS_RWBT = 332 * MiB, WS_LORA2T = 359 * MiB, WS_RWOT = 364 * MiB, WS_KC = 372 * MiB, WS_VC = 380 * MiB, WS_FGS = 388 * MiB, WS_FGP = 397 * MiB;
constexpr size_t WS_X = 400 * MiB, WS_H = 496 * MiB, WS_ARENA = 544 * MiB, WS_INVSQ = 1186 * MiB, WS_END = 1188 * MiB;
constexpr size_t AR_U = 0;
constexpr size_t AR_Q = 0, AR_K = 48 * MiB, AR_V = 60 * MiB, AR_O = 72 * MiB;
constexpr size_t AR_P = 0, AR_X0 = 144 * MiB, AR_ZT = 192 * MiB, AR_YT = 240 * MiB, AR_HO = 288 * MiB;
constexpr size_t AR_XMIX = 0, AR_LD = 546 * MiB  , AR_LA = 96 * MiB, AR_G = 192 * MiB, AR_RO = 240 * MiB, AR_R = 288 * MiB, AR_KK = 336 * MiB, AR_VV = 384 * MiB, AR_A3 = 432 * MiB, AR_YB = 450 * MiB;
constexpr size_t OUT_Y = 0, OUT_NK = 25165824, OUT_NV = 29360128, OUT_ST = 33554432;
constexpr int FGS_ROW = 2112, FGP_ROW = 576;
constexpr size_t AR_FILT = 600 * MiB;
constexpr int LDS_BAR_OFF = 147456, LDS_BYTES = 147456 + 1024;

enum { I_XP = 0, I_XS, I_CK, I_CV, I_ST, I_C, I_CCTX, I_ADAW, I_ADAB, I_N1G, I_N2G, I_MW1, I_MW2, I_WQKV, I_WO, I_SINK, I_HYWIN, I_HYCW, I_HYCB, I_FW1, I_FB1, I_FW2, I_FB2, I_FW3, I_FB3,
       I_FREQ, I_FWOUT, I_HYBIAS, I_HYWOUT, I_MU, I_WR, I_WK, I_WV, I_RWO, I_W0, I_W1, I_W2, I_A0, I_A1, I_A2, I_G1, I_G2, I_KK, I_KA, I_RK, I_LNW, I_LNB, I_FNG, N_IN };

struct Params { const float* in[N_IN]; float* out; unsigned char* ws; int ph_lo, ph_hi; };

__device__ __forceinline__ unsigned cvt_pk(float lo, float hi) { unsigned r; asm("v_cvt_pk_bf16_f32 %0, %1, %2" : "=v"(r) : "v"(lo), "v"(hi)); return r; }
__device__ __forceinline__ float bflo(unsigned w) { return __uint_as_float(w << 16); }
__device__ __forceinline__ float bfhi(unsigned w) { return __uint_as_float(w & 0xffff0000u); }
__device__ __forceinline__ float bf2f(bf16_t b) { return __uint_as_float(((unsigned)b) << 16); }
__device__ __forceinline__ float dpp_f(float x, const int ctrl) { return x; }
#define DPP_ADD(x, ctrl) ((x) + __int_as_float(__builtin_amdgcn_update_dpp(0, __float_as_int(x), (ctrl), 0xF, 0xF, true)))
__device__ __forceinline__ float wave_sum(float v) {
    v = DPP_ADD(v, 0xB1); v = DPP_ADD(v, 0x4E); v = DPP_ADD(v, 0x141); v = DPP_ADD(v, 0x140);
    const int vi = __float_as_int(v);
    const float r0 = __int_as_float(__builtin_amdgcn_readlane(vi, 0)), r1 = __int_as_float(__builtin_amdgcn_readlane(vi, 16)),
                r2 = __int_as_float(__builtin_amdgcn_readlane(vi, 32)), r3 = __int_as_float(__builtin_amdgcn_readlane(vi, 48));
    return (r0 + r1) + (r2 + r3);
}
__device__ __forceinline__ float opaque_zero() { float z; asm volatile("v_mov_b32 %0, 0" : "=v"(z)); return z; }
__device__ __forceinline__ float fexp2(float x) { return __builtin_amdgcn_exp2f(x); }
__device__ __forceinline__ float fexp(float x) { return __builtin_amdgcn_exp2f(x * 1.4426950408889634f); }
__device__ __forceinline__ float flog(float x) { return __builtin_amdgcn_logf(x) * 0.6931471805599453f; }
__device__ __forceinline__ float frcp(float x) { return __builtin_amdgcn_rcpf(x); }
__device__ __forceinline__ float fsigmoid(float x) { return frcp(1.0f + fexp(-x)); }
__device__ __forceinline__ float ftanh(float x) { const float e = fexp(2.0f * x); return 1.0f - 2.0f * frcp(e + 1.0f); }
__device__ __forceinline__ float fsoftplus(float x) { return fmaxf(x, 0.0f) + flog(1.0f + fexp(-fabsf(x))); }
__device__ __forceinline__ float fsin_rev(float rev) { return __builtin_amdgcn_sinf(rev - rintf(rev)); }
__device__ __forceinline__ float fcos_rev(float rev) { return __builtin_amdgcn_cosf(rev - rintf(rev)); }
__device__ __forceinline__ float fsin(float x) { return fsin_rev(x * 0.15915494309189535f); }
__device__ __forceinline__ int cond_of_row(int m) { return m < MP ? 0 : 1 + ((m - MP) >> 10); }
__device__ __forceinline__ int cond_of_panel(int pm) { return pm < 16 ? 0 : 1 + ((pm - 16) >> 2); }

struct Ctx {
    LAS unsigned char* lds;
    int tid, lane, wave, G, bid;
    float* out;
    unsigned char* ws;
};
template <int IDX> __device__ __forceinline__ const float* karg() {
    unsigned long long v;
    asm volatile("s_load_dwordx2 %0, %1, %2\n\ts_waitcnt lgkmcnt(0)" : "=s"(v) : "s"(__builtin_amdgcn_kernarg_segment_ptr()), "n"(IDX * 8));
    return (const float*)v;
}
#define WSP(T, off) ((T*)(C.ws + (off)))
#define MODP(l, cond, which) (WSP(float, WS_MOD) + ((size_t)((l) * 9 + (cond)) * 6 + (which)) * D)

__device__ __forceinline__ void p0_transpose_item(const float* W, int K, int N, bf16_t* WT, LAS float* scr, int item, int lane) {
    const int nblk = N / 32, kb = item / nblk, nb = item % nblk, k0 = 64 * kb, n0 = 32 * nb;
    const int rsub = lane >> 3, c4 = (lane & 7) * 4;
    f32x4 v[8];
#pragma unroll
    for (int i = 0; i < 8; ++i) v[i] = *(const f32x4*)(W + (size_t)(k0 + 8 * i + rsub) * N + n0 + c4);
#pragma unroll
    for (int i = 0; i < 8; ++i) { LAS float* d = scr + (8 * i + rsub) * 33 + c4; d[0] = v[i].x; d[1] = v[i].y; d[2] = v[i].z; d[3] = v[i].w; }
    asm volatile("s_waitcnt lgkmcnt(0)" ::: "memory");
    const int c = lane & 7;
#pragma unroll
    for (int j = 0; j < 4; ++j) { const int n = (lane >> 3) + 8 * j; const LAS float* s = scr + (8 * c) * 33 + n;
        u32x4 o; o.x = cvt_pk(s[0 * 33], s[1 * 33]); o.y = cvt_pk(s[2 * 33], s[3 * 33]); o.z = cvt_pk(s[4 * 33], s[5 * 33]); o.w = cvt_pk(s[6 * 33], s[7 * 33]);
        *(u32x4*)(WT + (size_t)(n0 + n) * K + k0 + 8 * c) = o; }
    asm volatile("s_waitcnt lgkmcnt(0)" ::: "memory");
}

__device__ __forceinline__ void late_transposes(const Ctx& C, LAS float* scr, int wv, int nwv) {
    constexpr int I_M = 8192, I_QKV = 3072, I_O = 2048;
    constexpr int NIT = 4 * I_M + I_QKV + I_O;
    for (int it = wv; it < NIT; it += nwv) {
        int r = it;
        if (r < 2 * I_M) { const int l = 2 + r / I_M; p0_transpose_item(karg<I_MW1>() + (size_t)l * D * FF, D, FF, WSP(bf16_t, WS_W1T) + (size_t)l * D * FF, scr, r % I_M, C.lane); continue; } r -= 2 * I_M;
        if (r < 2 * I_M) { const int l = 2 + r / I_M; p0_transpose_item(karg<I_MW2>() + (size_t)l * D * FF, FF, D, WSP(bf16_t, WS_W2T) + (size_t)l * D * FF, scr, r % I_M, C.lane); continue; } r -= 2 * I_M;
        if (r < I_QKV) { p0_transpose_item(karg<I_WQKV>() + (size_t)D * 3072, D, 3072, WSP(bf16_t, WS_WQKVT) + (size_t)D * 3072, scr, r, C.lane); continue; } r -= I_QKV;
        p0_transpose_item(karg<I_WO>() + (size_t)D * D, D, D, WSP(bf16_t, WS_WOT) + (size_t)D * D, scr, r, C.lane);
    }
}
#ifndef MK_PRO_MASK
#define MK_PRO_MASK 127
#endif
__device__ __forceinline__ void phase_prologue(const Ctx& C) {
    const int gw = C.bid * 8 + C.wave, NGW = C.G * 8, lane = C.lane;
    const size_t gt = (size_t)C.bid * 512 + C.tid, NGT = (size_t)C.G * 512;
    LAS float* scr = (LAS float*)(C.lds + C.wave * 16384);
    if (MK_PRO_MASK & 1)
    {
        constexpr int I_M1 = 8192, I_M2 = 8192, I_QKV = 3072, I_O = 2048, I_HI = 6144, I_SQ = 2048;
        constexpr int NIT = 2 * I_M1 + 2 * I_M2 + I_QKV + I_O + I_HI + I_SQ + 4 * I_SQ;
        for (int it = gw; it < NIT; it += NGW) {
            int r = it;
            if (r < 2 * I_M1) { const int l = r / I_M1; p0_transpose_item(karg<I_MW1>() + (size_t)l * D * FF, D, FF, WSP(bf16_t, WS_W1T) + (size_t)l * D * FF, scr, r % I_M1, lane); continue; } r -= 2 * I_M1;
            if (r < 2 * I_M2) { const int l = r / I_M2; p0_transpose_item(karg<I_MW2>() + (size_t)l * D * FF, FF, D, WSP(bf16_t, WS_W2T) + (size_t)l * D * FF, scr, r % I_M2, lane); continue; } r -= 2 * I_M2;
            if (r < I_QKV) { p0_transpose_item(karg<I_WQKV>(), D, 3072, WSP(bf16_t, WS_WQKVT), scr, r, lane); continue; } r -= I_QKV;
            if (r < I_O) { p0_transpose_item(karg<I_WO>(), D, D, WSP(bf16_t, WS_WOT), scr, r, lane); continue; } r -= I_O;
            if (r < I_HI) { p0_transpose_item(karg<I_HYWIN>(), D, 6144, WSP(bf16_t, WS_HYINT), scr, r, lane); continue; } r -= I_HI;
            if (r < I_SQ) { p0_transpose_item(karg<I_HYWOUT>(), D, D, WSP(bf16_t, WS_HYOUTT), scr, r, lane); continue; } r -= I_SQ;
            if (r < I_SQ) { p0_transpose_item(karg<I_WR>(), D, D, WSP(bf16_t, WS_RWBT), scr, r, lane); continue; } r -= I_SQ;
            if (r < I_SQ) { p0_transpose_item(karg<I_WK>(), D, D, WSP(bf16_t, WS_RWBT) + (size_t)D * D, scr, r, lane); continue; } r -= I_SQ;
            if (r < I_SQ) { p0_transpose_item(karg<I_WV>(), D, D, WSP(bf16_t, WS_RWBT) + (size_t)2 * D * D, scr, r, lane); continue; } r -= I_SQ;
            p0_transpose_item(karg<I_RWO>(), D, D, WSP(bf16_t, WS_RWOT), scr, r, lane);
        }
    }
    if (MK_PRO_MASK & 2)
    {
        bf16_t* L1 = WSP(bf16_t, WS_RWBT) + (size_t)3 * D * D;
#pragma unroll
        for (int part = 0; part < 7; ++part) {
            const int row0 = part == 0 ? 0 : part == 1 ? 96 : part == 2 ? 192 : part == 3 ? 256 : part == 4 ? 352 : part == 5 ? 448 : 512;
            const int nrow = (part == 2 || part == 5) ? 64 : (part == 6 ? 256 : 96);
            const int ld = part == 6 ? 256 : 96;
            const float* src = part == 0 ? karg<I_W1>() : part == 1 ? karg<I_W1>() + (size_t)D * 96 : part == 3 ? karg<I_A1>() : part == 4 ? karg<I_A1>() + (size_t)D * 96 : karg<I_G1>();
            const bool zero = (part == 2 || part == 5);
            for (size_t i = gt; i < (size_t)nrow * 256; i += NGT) {
                const int rr = (int)(i / 256), k8 = (int)(i % 256);
                float v[8];
#pragma unroll
                for (int j = 0; j < 8; ++j) v[j] = zero ? 0.0f : src[(size_t)(8 * k8 + j) * ld + rr];
                u32x4 o; o.x = cvt_pk(v[0], v[1]); o.y = cvt_pk(v[2], v[3]); o.z = cvt_pk(v[4], v[5]); o.w = cvt_pk(v[6], v[7]);
                *(u32x4*)(L1 + (size_t)(row0 + rr) * D + 8 * k8) = o;
            }
        }
        bf16_t* L2 = WSP(bf16_t, WS_LORA2T);
#pragma unroll
        for (int mat = 0; mat < 5; ++mat) {
            const float* src = mat == 0 ? karg<I_W2>() : mat == 1 ? karg<I_W2>() + (size_t)96 * D : mat == 2 ? karg<I_A2>() : mat == 3 ? karg<I_A2>() + (size_t)96 * D : karg<I_G2>();
            const int kofs = (mat == 1 || mat == 3) ? 96 : 0, klen = mat == 4 ? 256 : 96;
            for (size_t i = gt; i < (size_t)2048 * 32; i += NGT) {
                const int n = (int)(i / 32), k8 = (int)(i % 32);
                float v[8];
#pragma unroll
                for (int j = 0; j < 8; ++j) { const int k = 8 * k8 + j - kofs; const int kc = k < 0 ? 0 : (k >= klen ? klen - 1 : k); const float x = src[(size_t)kc * D + n]; v[j] = (k >= 0 && k < klen) ? x : 0.0f; }
                u32x4 o; o.x = cvt_pk(v[0], v[1]); o.y = cvt_pk(v[2], v[3]); o.z = cvt_pk(v[4], v[5]); o.w = cvt_pk(v[6], v[7]);
                *(u32x4*)(L2 + ((size_t)mat * 2048 + n) * 256 + 8 * k8) = o;
            }
        }
    }
    if (MK_PRO_MASK & 4)
    for (size_t i = gt; i < 2048; i += NGT) {
        const int pos = (int)(i >> 5), fi = (int)(i & 31);
        const float inv = fexp2(-(float)(2 * fi) * (13.287712379549449f / 64.0f));
        const float rev = (float)pos * inv * 0.15915494309189535f;
        WSP(f32x2, WS_ROPE)[i] = (f32x2){fcos_rev(rev), fsin_rev(rev)};
    }
    for (size_t i = gt; i < (size_t)MT * 32 / 4; i += NGT) WSP(f32x4, WS_INVSQ)[i] = (f32x4){0.f, 0.f, 0.f, 0.f};
    if (MK_PRO_MASK & 8)
    { const float *ckp = karg<I_CK>(), *cvp = karg<I_CV>();
    for (size_t i = gt; i < (size_t)2 * 524288; i += NGT) {
        const bool isv = i >= 524288; const size_t e = (isv ? i - 524288 : i) * 8;
        const float* src = (isv ? cvp : ckp) + e;
        const f32x4 a = *(const f32x4*)src, b = *(const f32x4*)(src + 4);
        u32x4 o; o.x = cvt_pk(a.x, a.y); o.y = cvt_pk(a.z, a.w); o.z = cvt_pk(b.x, b.y); o.w = cvt_pk(b.z, b.w);
        *(u32x4*)(WSP(bf16_t, isv ? WS_VC : WS_KC) + e) = o;
    } }
    if (MK_PRO_MASK & 32)
    {
        __syncthreads();
        LAS float* tab = (LAS float*)C.lds;
        LAS float* red = (LAS float*)(C.lds + 73728);
        const float *cctx = karg<I_CCTX>(), *cc = karg<I_C>();
        for (int e = C.tid; e < 9 * D; e += 512) { const int j = e >> 11, k = e & (D - 1);
            const float cv = j == 0 ? cctx[k] : cc[(size_t)(j == 0 ? 0 : j - 1) * D + k]; tab[e] = cv * fsigmoid(cv); }
        __syncthreads();
        const float* adaw = karg<I_ADAW>(); const float* adab = karg<I_ADAB>();
        for (int it = C.bid; it < 4 * 192; it += C.G) {
            const int nb = it % 192, l = it / 192, w = C.wave;
            float acc[9];
#pragma unroll
            for (int j = 0; j < 9; ++j) acc[j] = 0.f;
            const float* wp = adaw + ((size_t)l * D + 256 * w) * (6 * D) + nb * 64 + lane;
#pragma unroll 4
            for (int k4 = 0; k4 < 256; k4 += 4) {
                const float w0 = wp[(size_t)(k4 + 0) * (6 * D)], w1 = wp[(size_t)(k4 + 1) * (6 * D)], w2 = wp[(size_t)(k4 + 2) * (6 * D)], w3 = wp[(size_t)(k4 + 3) * (6 * D)];
#pragma unroll
                for (int j = 0; j < 9; ++j) { const f32x4 sv = *(const LAS f32x4*)(tab + j * D + 256 * w + k4); acc[j] += (w0 * sv.x + w1 * sv.y) + (w2 * sv.z + w3 * sv.w); }
            }
#pragma unroll
            for (int j = 0; j < 9; ++j) red[(w * 9 + j) * 64 + lane] = acc[j];
            __syncthreads();
            for (int e = C.tid; e < 9 * 64; e += 512) { const int j = e >> 6, c = e & 63; float sum = adab[(size_t)l * 6 * D + nb * 64 + c];
#pragma unroll
                for (int ww = 0; ww < 8; ++ww) sum += red[(ww * 9 + j) * 64 + c];
                WSP(float, WS_MOD)[((size_t)l * 9 + j) * 6 * D + nb * 64 + c] = sum; }
            __syncthreads();
        }
    }
    if (MK_PRO_MASK & 64)
    {
        const float *fw1 = karg<I_FW1>(), *fw2 = karg<I_FW2>(), *fw3 = karg<I_FW3>(), *fwout = karg<I_FWOUT>(), *hbias = karg<I_HYBIAS>();
        const float fq = karg<I_FREQ>()[lane]; const float fb1 = karg<I_FB1>()[lane], fb2 = karg<I_FB2>()[lane], fb3 = karg<I_FB3>()[lane];
        for (int it = C.bid; it < 160; it += C.G) {
            const bool smp = it >= 32; const int nbase = (smp ? it - 32 : it) * 8; const int L = smp ? 1024 : 256; const int n = nbase + C.wave;
            float* FILT = WSP(float, WS_ARENA + AR_FILT) + (smp ? 0 : (size_t)1024 * 4096);
            __syncthreads();
            if (lane < 33) {
                float z;
                if (lane == 0) z = (float)n / (float)(L - 1);
                else { const int i = (lane - 1) & 15; const float fr = 1e-4f + (float)i * ((15.0f - 1e-4f) / 15.0f); const float rev = fr * (float)n / (float)L;
                       z = lane <= 16 ? fcos_rev(rev) : -fsin_rev(rev); }
                scr[lane] = z;
            }
            asm volatile("s_waitcnt lgkmcnt(0)" ::: "memory");
            float pre = fb1;
#pragma unroll 3
            for (int e = 0; e < 33; ++e) pre += scr[e] * fw1[e * 64 + lane];
            float hv = fsin(fq * pre);
            asm volatile("s_waitcnt lgkmcnt(0)" ::: "memory");
            scr[64 + lane] = hv;
            asm volatile("s_waitcnt lgkmcnt(0)" ::: "memory");
            pre = fb2;
#pragma unroll 4
            for (int e = 0; e < 64; ++e) pre += scr[64 + e] * fw2[e * 64 + lane];
            hv = fsin(fq * pre);
            asm volatile("s_waitcnt lgkmcnt(0)" ::: "memory");
            scr[128 + lane] = hv;
            asm volatile("s_waitcnt lgkmcnt(0)" ::: "memory");
            pre = fb3;
#pragma unroll 4
            for (int e = 0; e < 64; ++e) pre += scr[128 + e] * fw3[e * 64 + lane];
            hv = fsin(fq * pre);
            scr[1024 + lane] = hv;
            __syncthreads();
            float acc[8][8];
#pragma unroll
            for (int nn = 0; nn < 8; ++nn)
#pragma unroll
                for (int i = 0; i < 8; ++i) acc[nn][i] = 0.f;
            const float* wo = fwout + 512 * C.wave + lane;
#pragma unroll 2
            for (int e = 0; e < 64; ++e) {
                float wv[8];
#pragma unroll
                for (int i = 0; i < 8; ++i) wv[i] = wo[(size_t)e * 4096 + i * 64];
#pragma unroll
                for (int nn = 0; nn < 8; ++nn) { const float hh = ((const LAS float*)(C.lds + nn * 16384))[1024 + e];
#pragma unroll
                    for (int i = 0; i < 8; ++i) acc[nn][i] += hh * wv[i]; }
            }
#pragma unroll
            for (int nn = 0; nn < 8; ++nn) { const int n2 = nbase + nn; const float tn = (float)n2 / (float)(L - 1);
#pragma unroll
                for (int i = 0; i < 8; ++i) {
                    const int o = 512 * C.wave + i * 64 + lane, dir = o >> 11, c = o & 2047;
                    const float delta = -3.0701134573253944f + (float)c * ((-15.350567286626972f + 3.0701134573253944f) / 2047.0f);
                    float val = acc[nn][i] * fexp(-tn * fabsf(delta));
                    if (dir == 0 && n2 == 0) val += hbias[c];
                    FILT[(size_t)n2 * 4096 + o] = val;
                } }
        }
        __syncthreads();
    }
}

__device__ __forceinline__ void phase_fg_transpose(const Ctx& C) {
    const int tid = C.tid;
    LAS float* tl = (LAS float*)C.lds;
    for (int it = C.bid; it < 1280; it += C.G) {
        const bool smp = it < 1024; const int q = smp ? it : it - 1024;
        const int L = smp ? 1024 : 256, ROW = smp ? FGS_ROW : FGP_ROW;
        const int cbk = q & 31, nb = smp ? (q >> 5) & 15 : (q >> 5) & 3, dir = smp ? q >> 9 : q >> 7;
        const float* FILT = WSP(float, WS_ARENA + AR_FILT) + (smp ? 0 : (size_t)1024 * 4096);
        bf16_t* FG = WSP(bf16_t, smp ? WS_FGS : WS_FGP);
        const int n0 = nb * 64 + dir;
        __syncthreads();
        { const int nl = tid >> 3, c8 = tid & 7; const int n = n0 + nl;
          f32x4 a = (f32x4){0.f, 0.f, 0.f, 0.f}, b = a;
          const int nc = n < L ? n : L - 1;
          const float* src = FILT + (size_t)nc * 4096 + dir * 2048 + cbk * 64 + 8 * c8;
          a = *(const f32x4*)src; b = *(const f32x4*)(src + 4);
          if (n >= L) { a = (f32x4){0.f, 0.f, 0.f, 0.f}; b = a; }
          LAS float* d = tl + nl * 65 + 8 * c8;
          d[0] = a.x; d[1] = a.y; d[2] = a.z; d[3] = a.w; d[4] = b.x; d[5] = b.y; d[6] = b.z; d[7] = b.w; }
        __syncthreads();
        { const int cl = tid >> 3, i8 = tid & 7;
          float v[8];
#pragma unroll
          for (int j = 0; j < 8; ++j) { const int il = 8 * i8 + j; const int nl = dir ? il : 63 - il; v[j] = tl[nl * 65 + cl]; }
          const int idx0 = dir ? (L + nb * 64) : (L - 64 - nb * 64);
          u32x4 o; o.x = cvt_pk(v[0], v[1]); o.y = cvt_pk(v[2], v[3]); o.z = cvt_pk(v[4], v[5]); o.w = cvt_pk(v[6], v[7]);
          bf16_t* dst = FG + (size_t)(cbk * 64 + cl) * ROW;
          *(u32x4*)(dst + idx0 + 8 * i8) = o;
          if (dir && nb * 64 + 64 == L) *(u32x4*)(dst + 2 * L + 8 * i8) = (u32x4){0u, 0u, 0u, 0u}; }
    }
    __syncthreads();
}

__device__ __forceinline__ void phase_norm_mod(const Ctx& C, const float* Xp, const float* Xs, const float* g, int layer, int which_sh, bf16_t* H, const bf16_t* P1 = nullptr, float* Xw = nullptr) {
    const int gw = C.bid * 8 + C.wave, NGW = C.G * 8, lane = C.lane;
    for (int m = gw; m < MT; m += NGW) {
        const int cond = cond_of_row(m);
        const float* sh = MODP(layer, cond, which_sh); const float* sc = MODP(layer, cond, which_sh + 1);
        const f32x4* xr = (const f32x4*)(m < MP ? Xp + (size_t)m * D : Xs + (size_t)(m - MP) * D) + lane;
        f32x4 v[8]; float ss = 0.f;
#pragma unroll
        for (int j = 0; j < 8; ++j) { v[j] = xr[64 * j]; if (P1) { const u32x2 pw = ((const u32x2*)(P1 + (size_t)m * D) + lane)[64 * j]; v[j] += (f32x4){bflo(pw.x), bfhi(pw.x), bflo(pw.y), bfhi(pw.y)}; ((f32x4*)(Xw + (size_t)m * D) + lane)[64 * j] = v[j]; }
            ss += (v[j].x * v[j].x + v[j].y * v[j].y) + (v[j].z * v[j].z + v[j].w * v[j].w); }
        const float rstd = __builtin_amdgcn_rsqf(wave_sum(ss) * (1.0f / D) + 1e-6f);
        u32x2* o = (u32x2*)(H + (size_t)m * D) + lane;
#pragma unroll
        for (int j = 0; j < 8; ++j) {
            const f32x4 gv = ((const f32x4*)g)[lane + 64 * j], sv = ((const f32x4*)sh)[lane + 64 * j], cv = ((const f32x4*)sc)[lane + 64 * j];
            const f32x4 y = (v[j] * rstd * gv) * (cv + 1.0f) + sv;
            u32x2 w; w.x = cvt_pk(y.x, y.y); w.y = cvt_pk(y.z, y.w); o[64 * j] = w;
        }
    }
}
__device__ __forceinline__ void phase_norm_final(const Ctx& C, const float* X, const float* g, float* out, const bf16_t* P1 = nullptr) {
    const int gw = C.bid * 8 + C.wave, NGW = C.G * 8, lane = C.lane;
    for (int m = gw; m < MT; m += NGW) {
        const f32x4* xr = (const f32x4*)(X + (size_t)m * D) + lane;
        f32x4 v[8]; float ss = 0.f;
#pragma unroll
        for (int j = 0; j < 8; ++j) { v[j] = xr[64 * j]; if (P1) { const u32x2 pw = ((const u32x2*)(P1 + (size_t)m * D) + lane)[64 * j]; v[j] += (f32x4){bflo(pw.x), bfhi(pw.x), bflo(pw.y), bfhi(pw.y)}; } ss += (v[j].x * v[j].x + v[j].y * v[j].y) + (v[j].z * v[j].z + v[j].w * v[j].w); }
        const float rstd = __builtin_amdgcn_rsqf(wave_sum(ss) * (1.0f / D) + 1e-6f);
        f32x4* o = (f32x4*)(out + (size_t)m * D) + lane;
#pragma unroll
        for (int j = 0; j < 8; ++j) o[64 * j] = v[j] * rstd * ((const f32x4*)g)[lane + 64 * j];
    }
}

__device__ __forceinline__ void unpack8(const u32x4 w, float (&f)[8]) { f[0] = bflo(w.x); f[1] = bfhi(w.x); f[2] = bflo(w.y); f[3] = bfhi(w.y); f[4] = bflo(w.z); f[5] = bfhi(w.z); f[6] = bflo(w.w); f[7] = bfhi(w.w); }
__device__ __forceinline__ u32x4 pack8(const float (&f)[8]) { u32x4 o; o.x = cvt_pk(f[0], f[1]); o.y = cvt_pk(f[2], f[3]); o.z = cvt_pk(f[4], f[5]); o.w = cvt_pk(f[6], f[7]); return o; }
__device__ __forceinline__ void phase_norm_mod_b(const Ctx& C, const bf16_t* X, const float* g, int layer, int which_sh, bf16_t* H, const bf16_t* P1 = nullptr, bf16_t* Xw = nullptr, int p1_row0 = 0) {
    const int gw = C.bid * 8 + C.wave, NGW = C.G * 8, lane = C.lane;
    f32x4 gv[4][2];
#pragma unroll
    for (int j = 0; j < 4; ++j)
#pragma unroll
        for (int h = 0; h < 2; ++h) gv[j][h] = ((const f32x4*)g)[2 * (lane + 64 * j) + h];
    u32x4 xa[4], pa[4]; f32x4 sv[4][2], cv[4][2];
#define NM_LOAD(m_) do { const int cond_ = cond_of_row(m_); const f32x4* sh_ = (const f32x4*)MODP(layer, cond_, which_sh); const f32x4* sc_ = (const f32x4*)MODP(layer, cond_, which_sh + 1); \
        _Pragma("unroll") for (int j = 0; j < 4; ++j) { xa[j] = ((const u32x4*)(X + (size_t)(m_) * D) + lane)[64 * j]; if (P1 && (m_) >= p1_row0) pa[j] = ((const u32x4*)(P1 + (size_t)(m_) * D) + lane)[64 * j]; } \
        _Pragma("unroll") for (int j = 0; j < 4; ++j) { _Pragma("unroll") for (int h = 0; h < 2; ++h) { const int ci_ = 2 * (lane + 64 * j) + h; sv[j][h] = sh_[ci_]; cv[j][h] = sc_[ci_]; } } } while (0)
    int m = gw;
    if (m < MT) NM_LOAD(m);
    for (; m < MT; m += NGW) {
        const bool fold = P1 && m >= p1_row0;
        float v[4][8]; float ss = 0.f;
#pragma unroll
        for (int j = 0; j < 4; ++j) {
            unpack8(xa[j], v[j]);
            if (fold) { float p[8]; unpack8(pa[j], p);
#pragma unroll
                for (int e = 0; e < 8; ++e) v[j][e] += p[e]; }
#pragma unroll
            for (int e = 0; e < 8; ++e) ss += v[j][e] * v[j][e];
        }
        const float rstd = __builtin_amdgcn_rsqf(wave_sum(ss) * (1.0f / D) + 1e-6f);
        u32x4 xo[4], ho[4];
#pragma unroll
        for (int j = 0; j < 4; ++j) {
            if (fold) xo[j] = pack8(v[j]);
            float y[8];
#pragma unroll
            for (int h = 0; h < 2; ++h)
#pragma unroll
                for (int e = 0; e < 4; ++e) y[4 * h + e] = (v[j][4 * h + e] * rstd * gv[j][h][e]) * (cv[j][h][e] + 1.0f) + sv[j][h][e];
            ho[j] = pack8(y);
        }
        const int mn = m + NGW;
        if (mn < MT) NM_LOAD(mn);
        asm volatile("" ::: "memory");
#pragma unroll
        for (int j = 0; j < 4; ++j) { if (fold) ((u32x4*)(Xw + (size_t)m * D) + lane)[64 * j] = xo[j]; ((u32x4*)(H + (size_t)m * D) + lane)[64 * j] = ho[j]; }
    }
#undef NM_LOAD
}
__device__ __forceinline__ void phase_norm_final_b(const Ctx& C, const bf16_t* X, const float* g, float* out, const bf16_t* P1 = nullptr, int p1_row0 = 0) {
    const int gw = C.bid * 8 + C.wave, NGW = C.G * 8, lane = C.lane;
    for (int m = gw; m < MT; m += NGW) {
        const u32x4* xr = (const u32x4*)(X + (size_t)m * D) + lane;
        float v[4][8]; float ss = 0.f;
#pragma unroll
        for (int j = 0; j < 4; ++j) {
            unpack8(xr[64 * j], v[j]);
            if (P1 && m >= p1_row0) { float p[8]; unpack8(((const u32x4*)(P1 + (size_t)m * D) + lane)[64 * j], p);
#pragma unroll
                for (int e = 0; e < 8; ++e) v[j][e] += p[e]; }
#pragma unroll
            for (int e = 0; e < 8; ++e) ss += v[j][e] * v[j][e];
        }
        const float rstd = __builtin_amdgcn_rsqf(wave_sum(ss) * (1.0f / D) + 1e-6f);
        f32x4* o = (f32x4*)(out + (size_t)m * D);
#pragma unroll
        for (int j = 0; j < 4; ++j)
#pragma unroll
            for (int h = 0; h < 2; ++h) {
                const int ci = 2 * (lane + 64 * j) + h;
                const f32x4 gv = ((const f32x4*)g)[ci];
                f32x4 y;
#pragma unroll
                for (int e = 0; e < 4; ++e) y[e] = v[j][4 * h + e] * rstd * gv[e];
                o[ci] = y;
            }
    }
}

using pg8::Unit;
constexpr int HALF = 128;

struct EpiResidual {
    static constexpr bool PERM = false, AFTER_DRAIN = false;
    float* X; const float* gate_base;
    const float *Bp, *Bs;
    __device__ __forceinline__ void operator()(const f32x4 (&acc)[2][2][4][2], const Unit& u, int wr, int wc, int fr, int fq) const {
        const int row0 = u.pm * 256 + wr * 64 + fr, col0 = u.pn * 256 + wc * 32 + 4 * fq;
        const float* gp = gate_base + (size_t)cond_of_panel(u.pm) * 6 * D + col0;
        f32x4 gv[2][2];
#pragma unroll
        for (int bj = 0; bj < 2; ++bj)
#pragma unroll
            for (int n = 0; n < 2; ++n) gv[bj][n] = *(const f32x4*)(gp + bj * HALF + n * 16);
        const float* sbase = (u.pm < 16 ? Bp + (size_t)row0 * D : Bs + (size_t)(row0 - MP) * D) + col0;
#pragma unroll
        for (int ai = 0; ai < 2; ++ai) {
            f32x4 q[4][2][2];
#pragma unroll
            for (int m = 0; m < 4; ++m)
#pragma unroll
                for (int bj = 0; bj < 2; ++bj)
#pragma unroll
                    for (int n = 0; n < 2; ++n) if ((u.mask >> (ai * 2 + bj)) & 1) q[m][bj][n] = *(const f32x4*)(sbase + (size_t)(ai * HALF + m * 16) * D + bj * HALF + n * 16);
#pragma unroll
            for (int m = 0; m < 4; ++m) { float* rowp = X + (size_t)(row0 + ai * HALF + m * 16) * D + col0;
#pragma unroll
                for (int bj = 0; bj < 2; ++bj)
#pragma unroll
                    for (int n = 0; n < 2; ++n) if ((u.mask >> (ai * 2 + bj)) & 1) *(f32x4*)(rowp + bj * HALF + n * 16) = q[m][bj][n] + gv[bj][n] * acc[ai][bj][m][n]; }
            asm volatile("" ::: "memory");
        }
    }
};
template <int ACT> struct EpiBf16 {
    static constexpr bool PERM = true, AFTER_DRAIN = false;
    bf16_t* O; int ldc;
    __device__ __forceinline__ void operator()(const f32x4 (&acc)[2][2][4][2], const Unit& u, int wr, int wc, int fr, int fq) const {
        const int row0 = u.pm * 256 + wr * 64 + fr, col0 = u.pn * 256 + wc * 32 + 8 * fq;
#pragma unroll
        for (int ai = 0; ai < 2; ++ai)
#pragma unroll
            for (int m = 0; m < 4; ++m) { bf16_t* rowp = O + (size_t)(row0 + ai * HALF + m * 16) * ldc + col0;
#pragma unroll
                for (int bj = 0; bj < 2; ++bj) { if (!((u.mask >> (ai * 2 + bj)) & 1)) continue; f32x4 v0 = acc[ai][bj][m][0], v1 = acc[ai][bj][m][1];
                    if (ACT == 1) {
#pragma unroll
                        for (int j = 0; j < 4; ++j) { const float a = fmaxf(v0[j], 0.f), b = fmaxf(v1[j], 0.f); v0[j] = a * a; v1[j] = b * b; } }
                    u32x4 w; w.x = cvt_pk(v0[0], v0[1]); w.y = cvt_pk(v0[2], v0[3]); w.z = cvt_pk(v1[0], v1[1]); w.w = cvt_pk(v1[2], v1[3]);
                    *(u32x4*)(rowp + bj * HALF) = w; } }
    }
};
struct EpiQKV {
    static constexpr bool PERM = true, AFTER_DRAIN = false;
    bf16_t *Q, *K, *V; float *NK, *NV;
    __device__ __forceinline__ void operator()(const f32x4 (&acc)[2][2][4][2], const Unit& u, int wr, int wc, int fr, int fq) const {
        const int row0 = u.pm * 256 + wr * 64 + fr; const int cin = wc * 32 + 8 * fq;
        bf16_t* base; int ldc, colt; float* fo = nullptr;
        if (u.pn < 8) { base = Q; ldc = 2048; colt = u.pn * 256; }
        else if (u.pn < 10) { base = K; ldc = 512; colt = (u.pn - 8) * 256; if (u.pm < 16) fo = NK; }
        else { base = V; ldc = 512; colt = (u.pn - 10) * 256; if (u.pm < 16) fo = NV; }
#pragma unroll
        for (int ai = 0; ai < 2; ++ai)
#pragma unroll
            for (int m = 0; m < 4; ++m) { const int r = row0 + ai * HALF + m * 16; bf16_t* rowp = base + (size_t)r * ldc + colt + cin;
#pragma unroll
                for (int bj = 0; bj < 2; ++bj) { if (!((u.mask >> (ai * 2 + bj)) & 1)) continue; const f32x4 v0 = acc[ai][bj][m][0], v1 = acc[ai][bj][m][1];
                    u32x4 w; w.x = cvt_pk(v0[0], v0[1]); w.y = cvt_pk(v0[2], v0[3]); w.z = cvt_pk(v1[0], v1[1]); w.w = cvt_pk(v1[2], v1[3]);
                    *(u32x4*)(rowp + bj * HALF) = w;
                    if (fo) { float* fp = fo + ((size_t)(r >> 8) * 512 + (r & 255)) * 512 + colt + cin + bj * HALF; *(f32x4*)fp = v0; *(f32x4*)(fp + 4) = v1; } } }
    }
};
__device__ __forceinline__ size_t hm_index(int m, int c) { return ((size_t)(c >> 6) * MT + m) * 64 + (c & 63); }
struct EpiRw1 {
    static constexpr bool PERM = true, AFTER_DRAIN = false;
    bf16_t *R, *A3;
    const float* k_k; float* invsq;
    __device__ __forceinline__ void operator()(const f32x4 (&acc)[2][2][4][2], const Unit& u, int wr, int wc, int fr, int fq) const {
        const int ct = u.pn, panel = u.pm % NPANEL;
        const int row0 = panel * 256 + wr * 64 + fr; const int cin = wc * 32 + 8 * fq;
        bf16_t* base; int ldc, colt, act = 0;
        if (ct < 24) { base = R + (size_t)(ct >> 3) * MT * D; ldc = D; colt = (ct & 7) * 256; }
        else { base = A3 + (size_t)(ct - 24) * MT * 256; ldc = 256; colt = 0; act = ct - 23; }
#pragma unroll
        for (int ai = 0; ai < 2; ++ai)
#pragma unroll
            for (int m = 0; m < 4; ++m) { const int rrow = row0 + ai * HALF + m * 16; bf16_t* rowp = base + (size_t)rrow * ldc + colt + cin;
#pragma unroll
                for (int bj = 0; bj < 2; ++bj) { if (!((u.mask >> (ai * 2 + bj)) & 1)) continue; f32x4 v0 = acc[ai][bj][m][0], v1 = acc[ai][bj][m][1];
                    if (act == 1) {
#pragma unroll
                        for (int j = 0; j < 4; ++j) { v0[j] = ftanh(v0[j]); v1[j] = ftanh(v1[j]); } }
                    else if (act == 3) {
#pragma unroll
                        for (int j = 0; j < 4; ++j) { v0[j] = fsigmoid(v0[j]); v1[j] = fsigmoid(v1[j]); } }
                    u32x4 w; w.x = cvt_pk(v0[0], v0[1]); w.y = cvt_pk(v0[2], v0[3]); w.z = cvt_pk(v1[0], v1[1]); w.w = cvt_pk(v1[2], v1[3]);
                    if (ct < 24) *(u32x4*)(base + hm_index(rrow, colt + cin + bj * HALF)) = w; else *(u32x4*)(rowp + bj * HALF) = w;
} }
    }
};
struct EpiRw2 {
    static constexpr bool PERM = true, AFTER_DRAIN = false;
    bf16_t *LD, *LA, *Gt; const float *w0, *a0;
    __device__ __forceinline__ void operator()(const f32x4 (&acc)[2][2][4][2], const Unit& u, int wr, int wc, int fr, int fq) const {
        const int ct = u.pn, panel = u.pm % NPANEL, grp = ct >> 3;
        const int row0 = panel * 256 + wr * 64 + fr; const int col0 = (ct & 7) * 256 + wc * 32 + 8 * fq;
        bf16_t* base; const float* bias = nullptr;
        if (grp < 2) { base = LD + (size_t)grp * MT * D; bias = w0 + grp * D; }
        else if (grp < 4) { base = LA + (size_t)(grp - 2) * MT * D; bias = a0 + (grp - 2) * D; }
        else base = Gt;
        f32x4 bv[2][2];
#pragma unroll
        for (int bj = 0; bj < 2; ++bj)
#pragma unroll
            for (int n = 0; n < 2; ++n) bv[bj][n] = bias ? *(const f32x4*)(bias + col0 + bj * HALF + 4 * n) : (f32x4){0.f, 0.f, 0.f, 0.f};
#pragma unroll
        for (int ai = 0; ai < 2; ++ai)
#pragma unroll
            for (int m = 0; m < 4; ++m) { const int rrow = row0 + ai * HALF + m * 16; bf16_t* rowp = base + (size_t)rrow * D + col0;
#pragma unroll
                for (int bj = 0; bj < 2; ++bj) {
                    f32x4 v0 = acc[ai][bj][m][0] + bv[bj][0], v1 = acc[ai][bj][m][1] + bv[bj][1];
                    if (grp < 2) {
#pragma unroll
                        for (int j = 0; j < 4; ++j) { v0[j] = -fexp(-fsoftplus(-v0[j]) - 0.5f); v1[j] = -fexp(-fsoftplus(-v1[j]) - 0.5f); } }
                    u32x4 w; w.x = cvt_pk(v0[0], v0[1]); w.y = cvt_pk(v0[2], v0[3]); w.z = cvt_pk(v1[0], v1[1]); w.w = cvt_pk(v1[2], v1[3]);
                    if (grp < 4) *(u32x4*)(base + hm_index(rrow, col0 + bj * HALF)) = w; else *(u32x4*)(rowp + bj * HALF) = w; }
                asm volatile("" : "+v"(bv[0][0]), "+v"(bv[0][1]), "+v"(bv[1][0]), "+v"(bv[1][1]));
            }
    }
};
struct RwOrder1 {
    int G, c, lo, hi; bool xcd;
    __device__ __forceinline__ bool next(int i, Unit& u) const { const int L = lo + i * G + c; if (L >= hi) return false; u.mask = 15;
        int panel, ct;
        if (xcd) {
            if (L < 1280) {
                const int cc = L & 255, T = (((L >> 8) * 8 + (cc & 7)) << 5) + (cc >> 3);
                if (T < 1056) { const int blk = T >> 5, j = T & 31, pq = blk / 3, g = blk - 3 * pq; panel = pq * 4 + (j >> 3); ct = g * 8 + (j & 7); }
                else if (T < 1120) { const int blk = (T - 1056) >> 5, j = T & 31; panel = 44 + (j >> 3); ct = (1 + blk) * 8 + (j & 7); }
                else { const int U = T - 1120; if (U < 16) { panel = 44 + (U >> 3); ct = U & 7; } else { const int q = U - 16; panel = q / 3; ct = 24 + q - 3 * panel; } }
            } else { const int q = L - 1280; panel = 46 + (q >> 3); ct = q & 7; }
        } else { panel = L / 27; ct = L % 27; }
        const int ai = ct < 24 ? (ct >> 3) : ct - 21; u.pm = ai * NPANEL + panel; u.pn = ct; u.kh = 0; return true; }
    __device__ __forceinline__ void a_ready(const Unit&) const {}
    __device__ __forceinline__ void done(const Unit&) const {}
};
struct RwOrder2 {
    int G, c; unsigned* cnt; unsigned need;
    __device__ __forceinline__ bool next(int i, Unit& u) const { const int L = i * G + c; if (L >= 40 * NPANEL) return false; const int panel = L / 40, ct = L % 40; const int ai = ct < 16 ? 0 : (ct < 32 ? 1 : 2); u.pm = ai * NPANEL + panel; u.pn = ct; u.kh = 0; u.mask = 15; return true; }
    __device__ __forceinline__ void a_ready(const Unit& u) const {
        if (cnt && (u.pm % NPANEL) == NPANEL - 1) {
            unsigned sp = 0u;
            while (xb_ld(cnt) < need) { __builtin_amdgcn_s_sleep(2); if (++sp > (1u << 24)) break; }
            __builtin_amdgcn_fence(__ATOMIC_ACQUIRE, "agent");
            asm volatile("s_waitcnt vmcnt(0)" ::: "memory");
        }
    }
    __device__ __forceinline__ void done(const Unit&) const {}
};

struct SplitOrder {
    pg8::StaticOrder so; int G, c, ntiles;
    __device__ __forceinline__ void init(int N, int G_, int c_) { so.init(MT, N, G_, c_); G = G_; c = c_; ntiles = so.nwg; }
    __device__ __forceinline__ bool next(int i, Unit& u) const { const int L = i * G + c; if (L >= 2 * ntiles) return false; const int kh = L >= ntiles; so.map(kh ? L - ntiles : L, u); u.kh = kh; u.mask = 15; return true; }
    __device__ __forceinline__ void a_ready(const Unit&) const {}
    __device__ __forceinline__ void done(const Unit&) const {}
};
struct EpiResidualSplit {
    static constexpr bool PERM = false, AFTER_DRAIN = false;
    float* X; const float* gate_base; bf16_t* P1;
    __device__ __forceinline__ void operator()(const f32x4 (&acc)[2][2][4][2], const Unit& u, int wr, int wc, int fr, int fq) const {
        const int row0 = u.pm * 256 + wr * 64 + fr, col0 = u.pn * 256 + wc * 32 + 4 * fq;
        const float* gp = gate_base + (size_t)cond_of_panel(u.pm) * 6 * D + col0;
        f32x4 gv[2][2];
#pragma unroll
        for (int bj = 0; bj < 2; ++bj)
#pragma unroll
            for (int n = 0; n < 2; ++n) gv[bj][n] = *(const f32x4*)(gp + bj * HALF + n * 16);
        if (u.kh == 0) {
#pragma unroll
            for (int ai = 0; ai < 2; ++ai) {
                f32x4 q[4][2][2];
#pragma unroll
                for (int m = 0; m < 4; ++m)
#pragma unroll
                    for (int bj = 0; bj < 2; ++bj)
#pragma unroll
                        for (int n = 0; n < 2; ++n) q[m][bj][n] = *(const f32x4*)(X + (size_t)(row0 + ai * HALF + m * 16) * D + col0 + bj * HALF + n * 16);
#pragma unroll
                for (int m = 0; m < 4; ++m) { float* rowp = X + (size_t)(row0 + ai * HALF + m * 16) * D + col0;
#pragma unroll
                    for (int bj = 0; bj < 2; ++bj)
#pragma unroll
                        for (int n = 0; n < 2; ++n) *(f32x4*)(rowp + bj * HALF + n * 16) = q[m][bj][n] + gv[bj][n] * acc[ai][bj][m][n]; }
                asm volatile("" ::: "memory");
            }
        } else {
#pragma unroll
            for (int ai = 0; ai < 2; ++ai)
#pragma unroll
                for (int m = 0; m < 4; ++m) { bf16_t* rowp = P1 + (size_t)(row0 + ai * HALF + m * 16) * D + col0;
#pragma unroll
                    for (int bj = 0; bj < 2; ++bj)
#pragma unroll
                        for (int n = 0; n < 2; ++n) { const f32x4 v = gv[bj][n] * acc[ai][bj][m][n]; u32x2 w; w.x = cvt_pk(v.x, v.y); w.y = cvt_pk(v.z, v.w); *(u32x2*)(rowp + bj * HALF + n * 16) = w; } }
        }
    }
};

template <bool SRCF32> struct EpiResidualB {
    static constexpr bool PERM = true, AFTER_DRAIN = false;
    bf16_t* X; const float* gate_base; const float *Bp, *Bs;
    __device__ __forceinline__ void operator()(const f32x4 (&acc)[2][2][4][2], const Unit& u, int wr, int wc, int fr, int fq) const {
        const int row0 = u.pm * 256 + wr * 64 + fr, col0 = u.pn * 256 + wc * 32 + 8 * fq;
        const float* gp = gate_base + (size_t)cond_of_panel(u.pm) * 6 * D + col0;
        f32x4 gv[2][2];
#pragma unroll
        for (int bj = 0; bj < 2; ++bj)
#pragma unroll
            for (int n = 0; n < 2; ++n) gv[bj][n] = *(const f32x4*)(gp + bj * HALF + 4 * n);
#pragma unroll
        for (int ai = 0; ai < 2; ++ai) {
            if constexpr (SRCF32) {
                const float* sbase = (u.pm < 16 ? Bp + (size_t)row0 * D : Bs + (size_t)(row0 - MP) * D) + col0;
                f32x4 q[4][2][2];
#pragma unroll
                for (int m = 0; m < 4; ++m)
#pragma unroll
                    for (int bj = 0; bj < 2; ++bj)
#pragma unroll
                        for (int n = 0; n < 2; ++n) q[m][bj][n] = *(const f32x4*)(sbase + (size_t)(ai * HALF + m * 16) * D + bj * HALF + 4 * n);
#pragma unroll
                for (int m = 0; m < 4; ++m) { bf16_t* rowp = X + (size_t)(row0 + ai * HALF + m * 16) * D + col0;
#pragma unroll
                    for (int bj = 0; bj < 2; ++bj) { const f32x4 v0 = q[m][bj][0] + gv[bj][0] * acc[ai][bj][m][0], v1 = q[m][bj][1] + gv[bj][1] * acc[ai][bj][m][1];
                        u32x4 w; w.x = cvt_pk(v0.x, v0.y); w.y = cvt_pk(v0.z, v0.w); w.z = cvt_pk(v1.x, v1.y); w.w = cvt_pk(v1.z, v1.w); *(u32x4*)(rowp + bj * HALF) = w; } }
            } else {
                u32x4 q[4][2];
#pragma unroll
                for (int m = 0; m < 4; ++m)
#pragma unroll
                    for (int bj = 0; bj < 2; ++bj) q[m][bj] = *(const u32x4*)(X + (size_t)(row0 + ai * HALF + m * 16) * D + col0 + bj * HALF);
#pragma unroll
                for (int m = 0; m < 4; ++m) { bf16_t* rowp = X + (size_t)(row0 + ai * HALF + m * 16) * D + col0;
#pragma unroll
                    for (int bj = 0; bj < 2; ++bj) { const u32x4 o = q[m][bj];
                        const f32x4 v0 = (f32x4){bflo(o.x), bfhi(o.x), bflo(o.y), bfhi(o.y)} + gv[bj][0] * acc[ai][bj][m][0], v1 = (f32x4){bflo(o.z), bfhi(o.z), bflo(o.w), bfhi(o.w)} + gv[bj][1] * acc[ai][bj][m][1];
                        u32x4 w; w.x = cvt_pk(v0.x, v0.y); w.y = cvt_pk(v0.z, v0.w); w.z = cvt_pk(v1.x, v1.y); w.w = cvt_pk(v1.z, v1.w); *(u32x4*)(rowp + bj * HALF) = w; } }
            }
            asm volatile("" ::: "memory");
        }
    }
};
struct EpiResidualSplitB {
    static constexpr bool PERM = true, AFTER_DRAIN = false;
    bf16_t* X; const float* gate_base; bf16_t* P1;
    __device__ __forceinline__ void operator()(const f32x4 (&acc)[2][2][4][2], const Unit& u, int wr, int wc, int fr, int fq) const {
        const int row0 = u.pm * 256 + wr * 64 + fr, col0 = u.pn * 256 + wc * 32 + 8 * fq;
        const float* gp = gate_base + (size_t)cond_of_panel(u.pm) * 6 * D + col0;
        f32x4 gv[2][2];
#pragma unroll
        for (int bj = 0; bj < 2; ++bj)
#pragma unroll
            for (int n = 0; n < 2; ++n) gv[bj][n] = *(const f32x4*)(gp + bj * HALF + 4 * n);
        if (u.kh == 0) {
#pragma unroll
            for (int ai = 0; ai < 2; ++ai) {
                u32x4 q[4][2];
#pragma unroll
                for (int m = 0; m < 4; ++m)
#pragma unroll
                    for (int bj = 0; bj < 2; ++bj) q[m][bj] = *(const u32x4*)(X + (size_t)(row0 + ai * HALF + m * 16) * D + col0 + bj * HALF);
#pragma unroll
                for (int m = 0; m < 4; ++m) { bf16_t* rowp = X + (size_t)(row0 + ai * HALF + m * 16) * D + col0;
#pragma unroll
                    for (int bj = 0; bj < 2; ++bj) { const u32x4 o = q[m][bj];
                        const f32x4 v0 = (f32x4){bflo(o.x), bfhi(o.x), bflo(o.y), bfhi(o.y)} + gv[bj][0] * acc[ai][bj][m][0], v1 = (f32x4){bflo(o.z), bfhi(o.z), bflo(o.w), bfhi(o.w)} + gv[bj][1] * acc[ai][bj][m][1];
                        u32x4 w; w.x = cvt_pk(v0.x, v0.y); w.y = cvt_pk(v0.z, v0.w); w.z = cvt_pk(v1.x, v1.y); w.w = cvt_pk(v1.z, v1.w); *(u32x4*)(rowp + bj * HALF) = w; } }
                asm volatile("" ::: "memory");
            }
        } else {
#pragma unroll
            for (int ai = 0; ai < 2; ++ai)
#pragma unroll
                for (int m = 0; m < 4; ++m) { bf16_t* rowp = P1 + (size_t)(row0 + ai * HALF + m * 16) * D + col0;
#pragma unroll
                    for (int bj = 0; bj < 2; ++bj) { const f32x4 v0 = gv[bj][0] * acc[ai][bj][m][0], v1 = gv[bj][1] * acc[ai][bj][m][1];
                        u32x4 w; w.x = cvt_pk(v0.x, v0.y); w.y = cvt_pk(v0.z, v0.w); w.z = cvt_pk(v1.x, v1.y); w.w = cvt_pk(v1.z, v1.w); *(u32x4*)(rowp + bj * HALF) = w; } }
        }
    }
};
struct TailSplitOrder {
    pg8::StaticOrder sf, st; int G, c, ntf;
    __device__ __forceinline__ void init(int G_, int c_, int ntf_ = 32) { sf.init(8192, D, G_, c_); st.init(4096, D, G_, c_); G = G_; c = c_; ntf = ntf_; }
    __device__ __forceinline__ bool next(int i, Unit& u) const {
        const int L = i * G + c; if (L >= 512) return false;
        if (L < 256) { sf.map(L, u); u.kh = 0; u.nt = ntf; }
        else { const int h = L - 256, kh = h >= 128; st.map(kh ? h - 128 : h, u); u.pm += 32; u.kh = kh; u.nt = ntf >> 1; }
        u.mask = 15; return true; }
    __device__ __forceinline__ void a_ready(const Unit&) const {}
    __device__ __forceinline__ void done(const Unit&) const {}
};


typedef short s16x4 __attribute__((ext_vector_type(4)));
constexpr int KS_STRIDE = 136;
constexpr int VT_STRIDE = 72;
constexpr int ATT_KS_OFF = 0, ATT_VT_OFF = 64 * KS_STRIDE * 2, ATT_BUF_BYTES = 36864;

__device__ __forceinline__ void rope8(u32x4& a, u32x4& b, const f32x2* tab) {
    unsigned* pa = (unsigned*)&a; unsigned* pb = (unsigned*)&b;
#pragma unroll
    for (int w = 0; w < 4; ++w) {
        const f32x4 cs = *(const f32x4*)(tab + 2 * w);
        const float x1l = bflo(pa[w]), x1h = bfhi(pa[w]), x2l = bflo(pb[w]), x2h = bfhi(pb[w]);
        const float o1l = x1l * cs.x - x2l * cs.y, o2l = x1l * cs.y + x2l * cs.x;
        const float o1h = x1h * cs.z - x2h * cs.w, o2h = x1h * cs.w + x2h * cs.z;
        pa[w] = cvt_pk(o1l, o1h); pb[w] = cvt_pk(o2l, o2h);
    }
}

__device__ __forceinline__ void phase_attention(const Ctx& C, const bf16_t* Q, const bf16_t* Kb, const bf16_t* Vb, const bf16_t* KC, const bf16_t* VC, const float* sink, bf16_t* O) {
    const int tid = C.tid, lane = C.lane, w = C.wave, h = lane >> 5, lq = lane & 31;
    LAS bf16_t* Ks = (LAS bf16_t*)(C.lds + ATT_KS_OFF);
    LAS bf16_t* Vt = (LAS bf16_t*)(C.lds + ATT_VT_OFF);
    const f32x2* rope = WSP(f32x2, WS_ROPE);
    const float c2 = 0.08838834764831845f * 1.4426950408889634f;
    for (int it = C.bid; it < 768; it += C.G) {
        const bool smp = it < 512;
        int bb, kvh, qb, R0;
        if (smp) { bb = it >> 6; kvh = (it >> 4) & 3; qb = it & 15; R0 = MP + bb * 1024; }
        else { const int p = it - 512; bb = p >> 4; kvh = (p >> 2) & 3; qb = p & 3; R0 = bb * 256; }
        const int head = kvh * 4 + (w >> 1);
        const int t = qb * 64 + (w & 1) * 32 + lq;
        u32x4 qf[8];
        { const bf16_t* qp = Q + (size_t)(R0 + t) * D + head * 128 + 8 * h;
#pragma unroll
          for (int ks = 0; ks < 8; ++ks) qf[ks] = *(const u32x4*)(qp + 16 * ks); }
        if (smp) {
#pragma unroll
            for (int half = 0; half < 2; ++half) { const int pos = half ? (t & 63) : (t >> 6);
#pragma unroll
                for (int kk = 0; kk < 2; ++kk) rope8(qf[4 * half + kk], qf[4 * half + kk + 2], rope + pos * 32 + 16 * kk + 8 * h); }
        }
        f32x16 o[4];
#pragma unroll
        for (int db = 0; db < 4; ++db)
#pragma unroll
            for (int r = 0; r < 16; ++r) o[db][r] = 0.f;
        float mrun = -1e30f, lrun = 0.f;
        const int li0 = smp ? (qb >= 2 ? 0 : 2 - qb) : 0, li1 = smp ? (17 - qb < 4 ? 17 - qb : 4) : 0;
        const int ntot = smp ? 8 + (li1 - li0 + 1) : 4;
        const int key = tid >> 3, cc = tid & 7, c1 = (cc & 3) + (cc >> 2) * 8;
#define ATT_TILE(i, kp_, vp_, k0_, loc_) do { if (smp) { if ((i) < 8) { const size_t off_ = ((size_t)(bb * 2) * 512 + (i) * 64) * 512 + kvh * 128; kp_ = KC + off_; vp_ = VC + off_; k0_ = 0; loc_ = false; } \
            else { k0_ = qb * 64 - 128 + 64 * ((i) - 8 + li0); loc_ = true; const size_t off_ = (size_t)(R0 + k0_) * 512 + kvh * 128; kp_ = Kb + off_; vp_ = Vb + off_; } } \
          else { k0_ = (i) * 64; loc_ = false; const size_t off_ = (size_t)(R0 + k0_) * 512 + kvh * 128; kp_ = Kb + off_; vp_ = Vb + off_; } } while (0)
        u32x4 ka, kb2, va, vb2;
#define ATT_LOAD(i) do { const bf16_t *kp_, *vp_; int k0_; bool loc_; ATT_TILE(i, kp_, vp_, k0_, loc_); (void)k0_; (void)loc_; \
          ka = *(const u32x4*)(kp_ + (size_t)key * 512 + 8 * c1); kb2 = *(const u32x4*)(kp_ + (size_t)key * 512 + 8 * c1 + 32); \
          va = *(const u32x4*)(vp_ + (size_t)key * 512 + 8 * c1); vb2 = *(const u32x4*)(vp_ + (size_t)key * 512 + 8 * c1 + 32); } while (0)
#define ATT_STAGE(i, KsB, VtB) do { const bf16_t *kp_, *vp_; int k0_; bool loc_; ATT_TILE(i, kp_, vp_, k0_, loc_); (void)kp_; (void)vp_; \
          if (loc_) { const int kpos = k0_ + key; const int pos = (cc >> 2) ? (kpos & 63) : (kpos >> 6); rope8(ka, kb2, rope + pos * 32 + 8 * (cc & 3)); } \
          *(LAS u32x4*)((KsB) + key * KS_STRIDE + 8 * c1) = ka; *(LAS u32x4*)((KsB) + key * KS_STRIDE + 8 * c1 + 32) = kb2; \
          *(LAS u32x4*)((VtB) + key * KS_STRIDE + 8 * c1) = va; *(LAS u32x4*)((VtB) + key * KS_STRIDE + 8 * c1 + 32) = vb2; } while (0)
        ATT_LOAD(0); ATT_STAGE(0, Ks, Vt); if (ntot > 1) ATT_LOAD(1);
        __syncthreads();
        for (int ti = 0; ti < ntot; ++ti) {
            const bf16_t *kp, *vp; int k0; bool local; ATT_TILE(ti, kp, vp, k0, local); (void)kp; (void)vp;
            LAS bf16_t* Ks = (LAS bf16_t*)(C.lds + (ti & 1) * ATT_BUF_BYTES + ATT_KS_OFF);
            LAS bf16_t* Vt = (LAS bf16_t*)(C.lds + (ti & 1) * ATT_BUF_BYTES + ATT_VT_OFF);
            f32x16 s0, s1;
            { const float z0 = opaque_zero();
#pragma unroll
            for (int r = 0; r < 16; ++r) { s0[r] = z0; s1[r] = z0; } }
#pragma unroll
            for (int ks = 0; ks < 8; ++ks) {
                const bf16x8 a0 = *(const LAS bf16x8*)(Ks + lq * KS_STRIDE + 16 * ks + 8 * h);
                const bf16x8 a1 = *(const LAS bf16x8*)(Ks + (32 + lq) * KS_STRIDE + 16 * ks + 8 * h);
                const bf16x8 bq = __builtin_bit_cast(bf16x8, qf[ks]);
                s0 = __builtin_amdgcn_mfma_f32_32x32x16_bf16(a0, bq, s0, 0, 0, 0);
                s1 = __builtin_amdgcn_mfma_f32_32x32x16_bf16(a1, bq, s1, 0, 0, 0);
            }
            if (local) {
#pragma unroll
                for (int r = 0; r < 16; ++r) {
                    const int kl = (r & 3) + 8 * (r >> 2) + 4 * h;
                    const int d0 = k0 + kl - t, d1 = d0 + 32;
                    s0[r] = ((d0 <= 128) && (d0 >= -128)) ? s0[r] : -1e30f; s1[r] = ((d1 <= 128) && (d1 >= -128)) ? s1[r] : -1e30f;
                }
            }
            float mx = fmaxf(s0[0], s1[0]);
#pragma unroll
            for (int r = 1; r < 16; ++r) mx = fmaxf(mx, fmaxf(s0[r], s1[r]));
            mx = fmaxf(mx, __shfl_xor(mx, 32));
            const float mnew = fmaxf(mrun, mx * c2);
            const float alpha = fexp2(mrun - mnew);
            float ps = 0.f;
#pragma unroll
            for (int r = 0; r < 16; ++r) {
                const float p0 = fexp2(__builtin_fmaf(s0[r], c2, -mnew)), p1 = fexp2(__builtin_fmaf(s1[r], c2, -mnew));
                s0[r] = p0; s1[r] = p1; ps += p0 + p1;
            }
            lrun = lrun * alpha + ps; mrun = mnew;
            if (__any(alpha != 1.0f)) {
#pragma unroll
                for (int db = 0; db < 4; ++db)
#pragma unroll
                    for (int r = 0; r < 16; ++r) o[db][r] *= alpha;
            }
            u32x4 pf[4];
#pragma unroll
            for (int s = 0; s < 2; ++s) {
                pf[s].x = cvt_pk(s0[8 * s + 0], s0[8 * s + 1]); pf[s].y = cvt_pk(s0[8 * s + 2], s0[8 * s + 3]); pf[s].z = cvt_pk(s0[8 * s + 4], s0[8 * s + 5]); pf[s].w = cvt_pk(s0[8 * s + 6], s0[8 * s + 7]);
                pf[2 + s].x = cvt_pk(s1[8 * s + 0], s1[8 * s + 1]); pf[2 + s].y = cvt_pk(s1[8 * s + 2], s1[8 * s + 3]); pf[2 + s].z = cvt_pk(s1[8 * s + 4], s1[8 * s + 5]); pf[2 + s].w = cvt_pk(s1[8 * s + 6], s1[8 * s + 7]);
            }
#pragma unroll
            for (int db = 0; db < 4; ++db)
#pragma unroll
                for (int s2 = 0; s2 < 4; ++s2) {
                    const LAS bf16_t* vr = Vt + (16 * s2 + 4 * (lane >> 5) + ((lane & 15) >> 2)) * KS_STRIDE + 32 * db + 16 * ((lane >> 4) & 1) + 4 * (lane & 3);
                    const s16x4 lo = __builtin_amdgcn_ds_read_tr16_b64_v4i16((LAS s16x4*)vr), hi = __builtin_amdgcn_ds_read_tr16_b64_v4i16((LAS s16x4*)(vr + 8 * KS_STRIDE));
                    const u32x2 lo2 = __builtin_bit_cast(u32x2, lo), hi2 = __builtin_bit_cast(u32x2, hi);
                    u32x4 av; av.x = lo2.x; av.y = lo2.y; av.z = hi2.x; av.w = hi2.y;
                    o[db] = __builtin_amdgcn_mfma_f32_32x32x16_bf16(__builtin_bit_cast(bf16x8, av), __builtin_bit_cast(bf16x8, pf[s2]), o[db], 0, 0, 0);
                }
            if (ti + 1 < ntot) {
                LAS bf16_t* Ksn = (LAS bf16_t*)(C.lds + ((ti + 1) & 1) * ATT_BUF_BYTES + ATT_KS_OFF);
                LAS bf16_t* Vtn = (LAS bf16_t*)(C.lds + ((ti + 1) & 1) * ATT_BUF_BYTES + ATT_VT_OFF);
                ATT_STAGE(ti + 1, Ksn, Vtn);
                if (ti + 2 < ntot) ATT_LOAD(ti + 2);
            }
            __syncthreads();
        }
        {
            const float sk = sink[head] * 1.4426950408889634f;
            const float mnew = fmaxf(mrun, sk), alpha = fexp2(mrun - mnew);
            float l = lrun * alpha; l += __shfl_xor(l, 32); l += fexp2(sk - mnew);
            const float sc = alpha * frcp(l);
            bf16_t* op = O + (size_t)(R0 + t) * D + head * 128 + 4 * h;
#pragma unroll
            for (int db = 0; db < 4; ++db)
#pragma unroll
                for (int g4 = 0; g4 < 4; ++g4) {
                    u32x2 wv; wv.x = cvt_pk(o[db][4 * g4 + 0] * sc, o[db][4 * g4 + 1] * sc); wv.y = cvt_pk(o[db][4 * g4 + 2] * sc, o[db][4 * g4 + 3] * sc);
                    *(u32x2*)(op + 32 * db + 8 * g4) = wv;
                }
        }
    }
#undef ATT_TILE
#undef ATT_LOAD
#undef ATT_STAGE
    __syncthreads();
}

__device__ __forceinline__ void phase_hy_gate(const Ctx& C, const bf16_t* Pm, const float* cw, const float* cb, bf16_t* X0, bf16_t* ZTp, bf16_t* ZTs) {
    const int tid = C.tid;
    LAS bf16_t* zs = (LAS bf16_t*)C.lds;
    for (int it = C.bid; it < 6144; it += C.G) {
        const bool smp = it >= 2048; const int q = smp ? it - 2048 : it;
        const int cbk = q & 31, tb = smp ? (q >> 5) & 15 : (q >> 5) & 3, b = smp ? q >> 9 : q >> 7;
        const int L = smp ? 1024 : 256, R0 = smp ? MP + b * 1024 : b * 256, NB = smp ? 8 : 16;
        const int tl = tid >> 3, c8 = tid & 7, t = tb * 64 + tl, c0 = cbk * 64 + 8 * c8;
        float u[3][8];
#pragma unroll
        for (int g = 0; g < 3; ++g) {
            const int gc = g * D + c0;
            const bf16_t* pr = Pm + (size_t)(R0 + t) * 6144 + gc;
            u32x4 pm1 = *(const u32x4*)(pr - (t > 0 ? 6144 : 0)), pp1 = *(const u32x4*)(pr + (t < L - 1 ? 6144 : 0)); const u32x4 p0 = *(const u32x4*)pr;
            { const unsigned mk0 = t > 0 ? 0xffffffffu : 0u, mk1 = t < L - 1 ? 0xffffffffu : 0u; pm1.x &= mk0; pm1.y &= mk0; pm1.z &= mk0; pm1.w &= mk0; pp1.x &= mk1; pp1.y &= mk1; pp1.z &= mk1; pp1.w &= mk1; }
            const unsigned* a = (const unsigned*)&pm1; const unsigned* bq = (const unsigned*)&p0; const unsigned* cq = (const unsigned*)&pp1;
#pragma unroll
            for (int j = 0; j < 4; ++j) {
                const f32x2 w0 = *(const f32x2*)(cw + gc + 2 * j), w1 = *(const f32x2*)(cw + 6144 + gc + 2 * j), w2 = *(const f32x2*)(cw + 12288 + gc + 2 * j), bb = *(const f32x2*)(cb + gc + 2 * j);
#if defined(MK_GATE_VARIANT) && MK_GATE_VARIANT == 1
                u[g][2 * j] = bflo(bq[j]); u[g][2 * j + 1] = bfhi(bq[j]);
#elif defined(MK_GATE_VARIANT) && MK_GATE_VARIANT == 2
                u[g][2 * j] = bflo(bq[j]) * w1.x + bb.x; u[g][2 * j + 1] = bfhi(bq[j]) * w1.y + bb.y;
#elif defined(MK_GATE_VARIANT) && MK_GATE_VARIANT == 3
                u[g][2 * j] = bflo(a[j]) + bflo(bq[j]) + bflo(cq[j]); u[g][2 * j + 1] = bfhi(a[j]) + bfhi(bq[j]) + bfhi(cq[j]);
#else
                u[g][2 * j] = bflo(a[j]) * w0.x + bflo(bq[j]) * w1.x + bflo(cq[j]) * w2.x + bb.x;
                u[g][2 * j + 1] = bfhi(a[j]) * w0.y + bfhi(bq[j]) * w1.y + bfhi(cq[j]) * w2.y + bb.y;
#endif
            }
        }
        { u32x4 o; o.x = cvt_pk(u[0][0], u[0][1]); o.y = cvt_pk(u[0][2], u[0][3]); o.z = cvt_pk(u[0][4], u[0][5]); o.w = cvt_pk(u[0][6], u[0][7]);
          *(u32x4*)(X0 + (size_t)(R0 + t) * D + c0) = o; }
        __syncthreads();
#pragma unroll
        for (int j = 0; j < 8; ++j) zs[(8 * c8 + j) * 72 + tl] = (bf16_t)(cvt_pk(u[2][j] * u[1][j], 0.f) & 0xffffu);
        __syncthreads();
        { const int cl = tid >> 3, t8 = tid & 7;
          const u32x4 o = *(const LAS u32x4*)(zs + cl * 72 + 8 * t8);
          bf16_t* ZT = smp ? ZTs : ZTp;
          *(u32x4*)(ZT + ((size_t)(cbk * 64 + cl) * NB + b) * L + tb * 64 + 8 * t8) = o; }
    }
    __syncthreads();
}

template <int L, int NB>
__device__ __forceinline__ void phase_hy_conv(const Ctx& C, const bf16_t* FG, const bf16_t* ZT, bf16_t* YT) {
    constexpr int WPC = L / 256, CPB = 8 / WPC, NS = L / 32, ROW = 2 * L + 64, UNITS = L / 4, COPYB = UNITS * 16, CHB = 8 * COPYB;
    constexpr int NH = NS > 16 ? NS / 16 : 1, JH = NS / NH;
    const int lane = C.lane, w = C.wave, ch_local = w / WPC, w4 = w % WPC, r = lane & 15, q = lane >> 4;
    for (int it = C.bid; it < 2048 / CPB; it += C.G) {
        const int c = it * CPB + ch_local;
        __syncthreads();
        {
            const int tcid = w4 * 64 + lane;
            const bf16_t* frow = FG + (size_t)c * ROW;
            for (int x = tcid; x < UNITS; x += 64 * WPC) {
                const u32x4 d0 = *(const u32x4*)(frow + 8 * x), d1 = *(const u32x4*)(frow + 8 * x + 8);
                const unsigned dd[8] = {d0.x, d0.y, d0.z, d0.w, d1.x, d1.y, d1.z, d1.w};
#pragma unroll
                for (int k = 0; k < 8; ++k) {
                    u32x4 o;
                    if ((k & 1) == 0) { o.x = dd[k / 2]; o.y = dd[k / 2 + 1]; o.z = dd[k / 2 + 2]; o.w = dd[k / 2 + 3]; }
                    else { const int b0 = (k - 1) / 2;
                        o.x = (dd[b0] >> 16) | (dd[b0 + 1] << 16); o.y = (dd[b0 + 1] >> 16) | (dd[b0 + 2] << 16); o.z = (dd[b0 + 2] >> 16) | (dd[b0 + 3] << 16); o.w = (dd[b0 + 3] >> 16) | (dd[b0 + 4] << 16); }
                    *(LAS u32x4*)(C.lds + ch_local * CHB + k * COPYB + x * 16) = o;
                }
            }
        }
        __syncthreads();
        f32x4 acc[16];
        { const float z0 = opaque_zero();
#pragma unroll
        for (int i = 0; i < 16; ++i) acc[i] = (f32x4){z0, z0, z0, z0}; }
        const bf16_t* zrow = ZT + ((size_t)c * NB + (r % NB)) * L + 8 * q;
        const LAS unsigned char* abase = C.lds + ch_local * CHB + (7 - (r & 7)) * COPYB + ((L - 8) / 8 - (r >> 3) + q - 32 * w4) * 16;
#pragma unroll
        for (int hh = 0; hh < NH; ++hh) {
            bf16x8 bf[JH];
#pragma unroll
            for (int j = 0; j < JH; ++j) bf[j] = *(const bf16x8*)(zrow + 32 * (hh * JH + j));
#pragma unroll
            for (int e = -2 * (hh * JH + JH - 1); e <= 15 - 2 * (hh * JH); ++e) {
                const bf16x8 a = *(const LAS bf16x8*)(abase - 32 * e);
#pragma unroll
                for (int j = 0; j < JH; ++j) { const int il = e + 2 * (hh * JH + j);
                    if (il >= 0 && il < 16) asm volatile("v_mfma_f32_16x16x32_bf16 %0, %1, %2, %0" : "+v"(acc[il]) : "v"(a), "v"(bf[j])); }
                asm volatile("" :: "v"(a));
            }
#pragma unroll
            for (int j = 0; j < JH; ++j) asm volatile("" :: "v"(bf[j]));
        }
        asm volatile("s_nop 15\n\ts_nop 15" : "+v"(acc[0]), "+v"(acc[1]), "+v"(acc[2]), "+v"(acc[3]), "+v"(acc[4]), "+v"(acc[5]), "+v"(acc[6]), "+v"(acc[7]));
        asm volatile("" : "+v"(acc[8]), "+v"(acc[9]), "+v"(acc[10]), "+v"(acc[11]), "+v"(acc[12]), "+v"(acc[13]), "+v"(acc[14]), "+v"(acc[15]));
        if (r < NB) {
            bf16_t* yrow = YT + ((size_t)c * NB + r) * L + 256 * w4 + 4 * q;
#pragma unroll
            for (int i = 0; i < 16; ++i) { u32x2 o; o.x = cvt_pk(acc[i][0], acc[i][1]); o.y = cvt_pk(acc[i][2], acc[i][3]);
#if defined(MK_CONV_VARIANT) && MK_CONV_VARIANT == 1
                { const u32x4 zz = *(const u32x4*)(zrow + 32 * (i & 7)); o.x = zz.x; o.y = zz.y; }
#elif defined(MK_CONV_VARIANT) && MK_CONV_VARIANT == 2
                { const u32x4 aa = *(const LAS u32x4*)(abase - 32 * (i - 8)); o.x = aa.x; o.y = aa.w; }
#endif
                *(u32x2*)(yrow + 16 * i) = o; }
        }
    }
    __syncthreads();
}

__device__ __forceinline__ void phase_hy_out(const Ctx& C, const bf16_t* YTp, const bf16_t* YTs, const bf16_t* X0, bf16_t* Om) {
    const int tid = C.tid;
    LAS bf16_t* ys = (LAS bf16_t*)C.lds;
    for (int it = C.bid; it < 6144; it += C.G) {
        const bool smp = it >= 2048; const int q = smp ? it - 2048 : it;
        const int cbk = q & 31, tb = smp ? (q >> 5) & 15 : (q >> 5) & 3, b = smp ? q >> 9 : q >> 7;
        const int L = smp ? 1024 : 256, R0 = smp ? MP + b * 1024 : b * 256, NB = smp ? 8 : 16;
        __syncthreads();
        { const int cl = tid >> 3, t8 = tid & 7;
          const bf16_t* YT = smp ? YTs : YTp;
          const u32x4 v = *(const u32x4*)(YT + ((size_t)(cbk * 64 + cl) * NB + b) * L + tb * 64 + 8 * t8);
          const unsigned* pv = (const unsigned*)&v;
#pragma unroll
          for (int j = 0; j < 4; ++j) { ys[(8 * t8 + 2 * j) * 72 + cl] = (bf16_t)(pv[j] & 0xffffu); ys[(8 * t8 + 2 * j + 1) * 72 + cl] = (bf16_t)(pv[j] >> 16); } }
        __syncthreads();
        { const int tl = tid >> 3, c8 = tid & 7; const size_t off = (size_t)(R0 + tb * 64 + tl) * D + cbk * 64 + 8 * c8;
          const u32x4 yv = *(const LAS u32x4*)(ys + tl * 72 + 8 * c8), xv = *(const u32x4*)(X0 + off);
          const unsigned* py = (const unsigned*)&yv; const unsigned* px = (const unsigned*)&xv; u32x4 o; unsigned* po = (unsigned*)&o;
#pragma unroll
          for (int j = 0; j < 4; ++j) po[j] = cvt_pk(bflo(py[j]) * bflo(px[j]), bfhi(py[j]) * bfhi(px[j]));
          *(u32x4*)(Om + off) = o; }
    }
    __syncthreads();
}

__device__ __forceinline__ void phase_rw_mix(const Ctx& C, const bf16_t* H, const float* mu, bf16_t* XM) {
    const int gw = C.bid * 8 + C.wave, NGW = C.G * 8, lane = C.lane;
    for (int m = gw; m < MT; m += NGW) {
        const int t = m < MP ? (m & 255) : ((m - MP) & 1023), L = m < MP ? 256 : 1024;
        const bool hasp = t > 0, hasn = t < L - 1;
#pragma unroll
        for (int ch = 0; ch < 4; ++ch) {
            const int c0 = 8 * (lane + 64 * ch);
            const bf16_t* hp = H + (size_t)m * D + c0;
            u32x4 a = *(const u32x4*)(hp - (hasp ? D : 0)), c = *(const u32x4*)(hp + (hasn ? D : 0)); const u32x4 b = *(const u32x4*)hp;
            { const unsigned mk0 = hasp ? 0xffffffffu : 0u, mk1 = hasn ? 0xffffffffu : 0u; a.x &= mk0; a.y &= mk0; a.z &= mk0; a.w &= mk0; c.x &= mk1; c.y &= mk1; c.z &= mk1; c.w &= mk1; }
            const unsigned* pa = (const unsigned*)&a; const unsigned* pb = (const unsigned*)&b; const unsigned* pc = (const unsigned*)&c;
            float hv[8], xx[8];
#pragma unroll
            for (int j = 0; j < 4; ++j) { hv[2 * j] = bflo(pb[j]); hv[2 * j + 1] = bfhi(pb[j]);
                xx[2 * j] = 0.5f * (bflo(pa[j]) + bflo(pc[j])) - hv[2 * j]; xx[2 * j + 1] = 0.5f * (bfhi(pa[j]) + bfhi(pc[j])) - hv[2 * j + 1]; }
#pragma unroll
            for (int s = 0; s < 6; ++s) {
                const int mi = s == 0 ? 0 : s == 1 ? 2 : s == 2 ? 3 : s == 3 ? 1 : s;
                const f32x4 m0 = *(const f32x4*)(mu + mi * D + c0), m1 = *(const f32x4*)(mu + mi * D + c0 + 4);
                u32x4 o; o.x = cvt_pk(hv[0] + xx[0] * m0.x, hv[1] + xx[1] * m0.y); o.y = cvt_pk(hv[2] + xx[2] * m0.z, hv[3] + xx[3] * m0.w);
                o.z = cvt_pk(hv[4] + xx[4] * m1.x, hv[5] + xx[5] * m1.y); o.w = cvt_pk(hv[6] + xx[6] * m1.z, hv[7] + xx[7] * m1.w);
                *(u32x4*)(XM + ((size_t)s * MT + m) * D + c0) = o;
            }
        }
    }
}

__device__ __forceinline__ float dpp_xor1(float x) { return __int_as_float(__builtin_amdgcn_update_dpp(0, __float_as_int(x), 0xB1, 0xF, 0xF, true)); }
__device__ __forceinline__ float dpp_xor2(float x) { return __int_as_float(__builtin_amdgcn_update_dpp(0, __float_as_int(x), 0x4E, 0xF, 0xF, true)); }

constexpr int SC_STEP = 6 * 64;
template <int R, int SC_TS>
__device__ __forceinline__ void rw_scan_task(LAS float* buf, int lane, const bf16_t* Rm, const bf16_t* Km, const bf16_t* Vm, const bf16_t* LD, const bf16_t* LA,
                                             const float* k_k, const float* k_a, const float* invsq, const float* state_in, bf16_t* YB, float* state_out, bool smp, int b, int head, int dir, int half) {
    const int rg = lane >> 2, kq = lane & 3;
    const int L = smp ? 1024 : 256, R0 = smp ? MP + b * 1024 : b * 256;
    const int row0 = half * (16 * R) + R * rg;
    f32x2 S[R][8];
    if (smp) {
        const float* sp = state_in + ((size_t)(b * 2 + dir) * 32 + head) * 4096 + row0 * 64 + 16 * kq;
#pragma unroll
        for (int rr = 0; rr < R; ++rr)
#pragma unroll
            for (int j4 = 0; j4 < 4; ++j4) { const f32x4 v = *(const f32x4*)(sp + rr * 64 + 4 * j4); S[rr][2 * j4] = (f32x2){v.x, v.y}; S[rr][2 * j4 + 1] = (f32x2){v.z, v.w}; }
    } else {
#pragma unroll
        for (int rr = 0; rr < R; ++rr)
#pragma unroll
            for (int j = 0; j < 8; ++j) S[rr][j] = (f32x2){0.f, 0.f};
    }
    const int ch = head * 64 + lane; const size_t hbase = (size_t)head * MT * 64 + lane;
    const float kkc = k_k[ch], kac = k_a[ch];
    const bf16_t* ldp = LD + (size_t)dir * MT * D; const bf16_t* lap = LA + (size_t)dir * MT * D;
    bf16_t* yb = YB + (size_t)dir * MT * D;
    bf16_t pr[SC_TS], pk[SC_TS], pv[SC_TS], pl[SC_TS], pa[SC_TS], qr[SC_TS], qk[SC_TS], qv[SC_TS], ql[SC_TS], qa[SC_TS];
    const int tstart = dir ? L - 1 : 0, tstep = dir ? -1 : 1;
    const int NCH = L / SC_TS;
#define SC_PREFETCH(c) do { _Pragma("unroll") for (int s_ = 0; s_ < SC_TS; ++s_) { const size_t o_ = hbase + (size_t)(R0 + tstart + tstep * ((c) * SC_TS + s_)) * 64; pr[s_] = Rm[o_]; pk[s_] = Km[o_]; pv[s_] = Vm[o_]; pl[s_] = ldp[o_]; pa[s_] = lap[o_]; } } while (0)
#define SC_DERIVE(s_, bufp) do { const float r_ = bf2f(pr[s_]), k_ = bf2f(pk[s_]), v_ = bf2f(pv[s_]), ld_ = bf2f(pl[s_]), a_ = fsigmoid(bf2f(pa[s_])); \
        const float kr_ = k_ * kkc; const float kk_ = kr_ * __builtin_amdgcn_rsqf(wave_sum(kr_ * kr_) + 1e-12f); \
        const unsigned sa_ = (unsigned)(unsigned long)((bufp) + (s_) * SC_STEP) + 4u * (unsigned)lane;     \
        asm volatile("ds_write_b32 %0, %1" :: "v"(sa_), "v"(fexp(ld_))); asm volatile("ds_write_b32 %0, %1 offset:256" :: "v"(sa_), "v"(kk_ * a_)); \
        asm volatile("ds_write_b32 %0, %1 offset:512" :: "v"(sa_), "v"(k_ * (1.0f + (a_ - 1.0f) * kac))); asm volatile("ds_write_b32 %0, %1 offset:768" :: "v"(sa_), "v"(-kk_)); \
        asm volatile("ds_write_b32 %0, %1 offset:1024" :: "v"(sa_), "v"(r_)); asm volatile("ds_write_b32 %0, %1 offset:1280" :: "v"(sa_), "v"(v_)); } while (0)
#define SC_PREFETCH2(c) do { _Pragma("unroll") for (int s_ = 0; s_ < SC_TS; ++s_) { const size_t o_ = hbase + (size_t)(R0 + tstart + tstep * ((c) * SC_TS + s_)) * 64; qr[s_] = Rm[o_]; qk[s_] = Km[o_]; qv[s_] = Vm[o_]; ql[s_] = ldp[o_]; qa[s_] = lap[o_]; } } while (0)
    SC_PREFETCH(0);
#pragma unroll
    for (int s = 0; s < SC_TS; ++s) SC_DERIVE(s, buf);
    asm volatile("s_waitcnt lgkmcnt(0)" ::: "memory");
    SC_PREFETCH(1);
    SC_PREFETCH2(2);
#define SC_DERIVE_Q(s_, bufp) do { const float r_ = bf2f(qr[s_]), k_ = bf2f(qk[s_]), v_ = bf2f(qv[s_]), ld_ = bf2f(ql[s_]), a_ = fsigmoid(bf2f(qa[s_])); \
        const float kr_ = k_ * kkc; const float kk_ = kr_ * __builtin_amdgcn_rsqf(wave_sum(kr_ * kr_) + 1e-12f); \
        const unsigned sa_ = (unsigned)(unsigned long)((bufp) + (s_) * SC_STEP) + 4u * (unsigned)lane; \
        asm volatile("ds_write_b32 %0, %1" :: "v"(sa_), "v"(fexp(ld_))); asm volatile("ds_write_b32 %0, %1 offset:256" :: "v"(sa_), "v"(kk_ * a_)); \
        asm volatile("ds_write_b32 %0, %1 offset:512" :: "v"(sa_), "v"(k_ * (1.0f + (a_ - 1.0f) * kac))); asm volatile("ds_write_b32 %0, %1 offset:768" :: "v"(sa_), "v"(-kk_)); \
        asm volatile("ds_write_b32 %0, %1 offset:1024" :: "v"(sa_), "v"(r_)); asm volatile("ds_write_b32 %0, %1 offset:1280" :: "v"(sa_), "v"(v_)); } while (0)
    LAS float* const buf0 = buf; LAS float* const buf1 = buf + SC_TS * SC_STEP;
    for (int cix = 0; cix < NCH; cix += 2) {
#pragma unroll
        for (int s = 0; s < SC_TS; ++s) {
            SC_DERIVE(s, buf1);
            if (cix + 3 < NCH) { const size_t o_ = hbase + (size_t)(R0 + tstart + tstep * ((cix + 3) * SC_TS + s)) * 64; pr[s] = Rm[o_]; pk[s] = Km[o_]; pv[s] = Vm[o_]; pl[s] = ldp[o_]; pa[s] = lap[o_]; }
#define BC_ buf0
#define CX_ cix
            const LAS float* sb = BC_ + s * SC_STEP;
            f32x2 w2[8], b2[8], d2[8], n2[8], r2[8];
#pragma unroll
            for (int j4 = 0; j4 < 4; ++j4) { const f32x4 nv = *(const LAS f32x4*)(sb + 192 + 16 * kq + 4 * j4); n2[2 * j4] = (f32x2){nv.x, nv.y}; n2[2 * j4 + 1] = (f32x2){nv.z, nv.w}; }
#pragma unroll
            for (int j4 = 0; j4 < 4; ++j4) {
                const f32x4 bv = *(const LAS f32x4*)(sb + 64 + 16 * kq + 4 * j4), dv = *(const LAS f32x4*)(sb + 128 + 16 * kq + 4 * j4), wv = *(const LAS f32x4*)(sb + 16 * kq + 4 * j4), rv = *(const LAS f32x4*)(sb + 256 + 16 * kq + 4 * j4);
                w2[2 * j4] = (f32x2){wv.x, wv.y}; w2[2 * j4 + 1] = (f32x2){wv.z, wv.w}; b2[2 * j4] = (f32x2){bv.x, bv.y}; b2[2 * j4 + 1] = (f32x2){bv.z, bv.w};
                d2[2 * j4] = (f32x2){dv.x, dv.y}; d2[2 * j4 + 1] = (f32x2){dv.z, dv.w}; r2[2 * j4] = (f32x2){rv.x, rv.y}; r2[2 * j4 + 1] = (f32x2){rv.z, rv.w};
            }
            float vrow[R];
            if (R == 4) { const f32x4 vv = *(const LAS f32x4*)(sb + 320 + row0); vrow[0] = vv.x; vrow[R > 1 ? 1 : 0] = vv.y; vrow[R > 2 ? R - 2 : 0] = vv.z; vrow[R - 1] = vv.w; }
            else if (R == 2) { const f32x2 vv = *(const LAS f32x2*)(sb + 320 + row0); vrow[0] = vv.x; vrow[R - 1] = vv.y; }
            else vrow[0] = sb[320 + row0];
            float y[R];
#pragma unroll
            for (int rr = 0; rr < R; ++rr) {
                f32x2 a0 = S[rr][0] * n2[0], a1 = S[rr][1] * n2[1];
#pragma unroll
                for (int j = 2; j < 8; j += 2) { a0 = S[rr][j] * n2[j] + a0; a1 = S[rr][j + 1] * n2[j + 1] + a1; }
                a0 = a0 + a1;
                float sa = a0.x + a0.y; sa += dpp_xor1(sa); sa += dpp_xor2(sa);
                const f32x2 sa2 = (f32x2){sa, sa}, vr2 = (f32x2){vrow[rr], vrow[rr]};
                f32x2 y0 = (f32x2){0.f, 0.f}, y1 = (f32x2){0.f, 0.f};
#pragma unroll
                for (int j = 0; j < 8; j += 2) {
                    S[rr][j] = S[rr][j] * w2[j] + (sa2 * b2[j] + vr2 * d2[j]);
                    S[rr][j + 1] = S[rr][j + 1] * w2[j + 1] + (sa2 * b2[j + 1] + vr2 * d2[j + 1]);
                    y0 = S[rr][j] * r2[j] + y0; y1 = S[rr][j + 1] * r2[j + 1] + y1;
                }
                y0 = y0 + y1;
                float yy = y0.x + y0.y; yy += dpp_xor1(yy); yy += dpp_xor2(yy); y[rr] = yy;
            }
            {
                const int t = tstart + tstep * ((CX_) * SC_TS + s); bf16_t* yp = yb + (size_t)(R0 + t) * D + head * 64;
                if (R == 4) { const float ys = kq == 0 ? y[0] : kq == 1 ? y[R > 1 ? 1 : 0] : kq == 2 ? y[R > 2 ? R - 2 : 0] : y[R - 1]; yp[lane] = (bf16_t)cvt_pk(ys, ys); }
                else if (R == 2) { const float ys = (kq & 1) ? y[R - 1] : y[0]; yp[half * 32 + 2 * rg + (kq & 1)] = (bf16_t)cvt_pk(ys, ys); }
                else yp[row0] = (bf16_t)cvt_pk(y[0], y[0]);
            }
#undef BC_
#undef CX_
        }
        asm volatile("s_waitcnt lgkmcnt(0)" ::: "memory");
#pragma unroll
        for (int s = 0; s < SC_TS; ++s) {
            SC_DERIVE_Q(s, buf0);
            if (cix + 4 < NCH) { const size_t o_ = hbase + (size_t)(R0 + tstart + tstep * ((cix + 4) * SC_TS + s)) * 64; qr[s] = Rm[o_]; qk[s] = Km[o_]; qv[s] = Vm[o_]; ql[s] = ldp[o_]; qa[s] = lap[o_]; }
#define BC_ buf1
#define CX_ (cix + 1)
            const LAS float* sb = BC_ + s * SC_STEP;
            f32x2 w2[8], b2[8], d2[8], n2[8], r2[8];
#pragma unroll
            for (int j4 = 0; j4 < 4; ++j4) { const f32x4 nv = *(const LAS f32x4*)(sb + 192 + 16 * kq + 4 * j4); n2[2 * j4] = (f32x2){nv.x, nv.y}; n2[2 * j4 + 1] = (f32x2){nv.z, nv.w}; }
#pragma unroll
            for (int j4 = 0; j4 < 4; ++j4) {
                const f32x4 bv = *(const LAS f32x4*)(sb + 64 + 16 * kq + 4 * j4), dv = *(const LAS f32x4*)(sb + 128 + 16 * kq + 4 * j4), wv = *(const LAS f32x4*)(sb + 16 * kq + 4 * j4), rv = *(const LAS f32x4*)(sb + 256 + 16 * kq + 4 * j4);
                w2[2 * j4] = (f32x2){wv.x, wv.y}; w2[2 * j4 + 1] = (f32x2){wv.z, wv.w}; b2[2 * j4] = (f32x2){bv.x, bv.y}; b2[2 * j4 + 1] = (f32x2){bv.z, bv.w};
                d2[2 * j4] = (f32x2){dv.x, dv.y}; d2[2 * j4 + 1] = (f32x2){dv.z, dv.w}; r2[2 * j4] = (f32x2){rv.x, rv.y}; r2[2 * j4 + 1] = (f32x2){rv.z, rv.w};
            }
            float vrow[R];
            if (R == 4) { const f32x4 vv = *(const LAS f32x4*)(sb + 320 + row0); vrow[0] = vv.x; vrow[R > 1 ? 1 : 0] = vv.y; vrow[R > 2 ? R - 2 : 0] = vv.z; vrow[R - 1] = vv.w; }
            else if (R == 2) { const f32x2 vv = *(const LAS f32x2*)(sb + 320 + row0); vrow[0] = vv.x; vrow[R - 1] = vv.y; }
            else vrow[0] = sb[320 + row0];
            float y[R];
#pragma unroll
            for (int rr = 0; rr < R; ++rr) {
                f32x2 a0 = S[rr][0] * n2[0], a1 = S[rr][1] * n2[1];
#pragma unroll
                for (int j = 2; j < 8; j += 2) { a0 = S[rr][j] * n2[j] + a0; a1 = S[rr][j + 1] * n2[j + 1] + a1; }
                a0 = a0 + a1;
                float sa = a0.x + a0.y; sa += dpp_xor1(sa); sa += dpp_xor2(sa);
                const f32x2 sa2 = (f32x2){sa, sa}, vr2 = (f32x2){vrow[rr], vrow[rr]};
                f32x2 y0 = (f32x2){0.f, 0.f}, y1 = (f32x2){0.f, 0.f};
#pragma unroll
                for (int j = 0; j < 8; j += 2) {
                    S[rr][j] = S[rr][j] * w2[j] + (sa2 * b2[j] + vr2 * d2[j]);
                    S[rr][j + 1] = S[rr][j + 1] * w2[j + 1] + (sa2 * b2[j + 1] + vr2 * d2[j + 1]);
                    y0 = S[rr][j] * r2[j] + y0; y1 = S[rr][j + 1] * r2[j + 1] + y1;
                }
                y0 = y0 + y1;
                float yy = y0.x + y0.y; yy += dpp_xor1(yy); yy += dpp_xor2(yy); y[rr] = yy;
            }
            {
                const int t = tstart + tstep * ((CX_) * SC_TS + s); bf16_t* yp = yb + (size_t)(R0 + t) * D + head * 64;
                if (R == 4) { const float ys = kq == 0 ? y[0] : kq == 1 ? y[R > 1 ? 1 : 0] : kq == 2 ? y[R > 2 ? R - 2 : 0] : y[R - 1]; yp[lane] = (bf16_t)cvt_pk(ys, ys); }
                else if (R == 2) { const float ys = (kq & 1) ? y[R - 1] : y[0]; yp[half * 32 + 2 * rg + (kq & 1)] = (bf16_t)cvt_pk(ys, ys); }
                else yp[row0] = (bf16_t)cvt_pk(y[0], y[0]);
            }
#undef BC_
#undef CX_
        }
        asm volatile("s_waitcnt lgkmcnt(0)" ::: "memory");
    }
#undef SC_DERIVE_Q
#undef SC_PREFETCH
#undef SC_PREFETCH2
#undef SC_DERIVE
    if (!smp) {
        float* sp = state_out + ((size_t)(b * 2 + dir) * 32 + head) * 4096 + row0 * 64 + 16 * kq;
#pragma unroll
        for (int rr = 0; rr < R; ++rr)
#pragma unroll
            for (int j4 = 0; j4 < 4; ++j4) *(f32x4*)(sp + rr * 64 + 4 * j4) = (f32x4){S[rr][2 * j4].x, S[rr][2 * j4].y, S[rr][2 * j4 + 1].x, S[rr][2 * j4 + 1].y};
    }
}
__device__ __forceinline__ void phase_rw_scan(const Ctx& C, const bf16_t* Rm, const bf16_t* Km, const bf16_t* Vm, const bf16_t* LD, const bf16_t* LA,
                                              const float* k_k, const float* k_a, const float* invsq, const float* state_in, bf16_t* YB, float* state_out) {
    const int lane = C.lane, w = C.wave;
    LAS float* buf = (LAS float*)(C.lds + (w < 4 ? w * 24576 : 98304 + (w - 4) * 12288));
    if (w < 4) { for (int slot = C.bid * 4 + w; slot < 1024; slot += C.G * 4) { const int id = slot >> 1; rw_scan_task<2, 8>(buf, lane, Rm, Km, Vm, LD, LA, k_k, k_a, invsq, state_in, YB, state_out, true, id >> 6, (id >> 1) & 31, id & 1, slot & 1); } }
    else { for (int id = C.bid * 4 + (w - 4); id < 1024; id += C.G * 4) rw_scan_task<4, 4>(buf, lane, Rm, Km, Vm, LD, LA, k_k, k_a, invsq, state_in, YB, state_out, false, id >> 6, (id >> 1) & 31, id & 1, 0); }
    if (w >= 4) late_transposes(C, buf, C.bid * 4 + (w - 4), C.G * 4);
    __syncthreads();
}

__device__ __forceinline__ float head8_sum(float v) { v = DPP_ADD(v, 0xB1); v = DPP_ADD(v, 0x4E); v = DPP_ADD(v, 0x141); return v; }
__device__ __forceinline__ void phase_rw_post(const Ctx& C, const bf16_t* YB, const bf16_t* Rm, const bf16_t* Km, const bf16_t* Vm, const bf16_t* LA, const bf16_t* Gt,
                                              const float* k_a, const float* r_k, const float* ln_w, const float* ln_b, bf16_t* Om) {
    const int gw = C.bid * 8 + C.wave, NGW = C.G * 8, lane = C.lane;
    for (int m = gw; m < MT; m += NGW) {
#pragma unroll 1
        for (int ch = 0; ch < 4; ++ch) {
            const int c0 = 8 * (lane + 64 * ch); const size_t o = (size_t)m * D + c0;
            const u32x4 yfw = *(const u32x4*)(YB + o), ybw = *(const u32x4*)(YB + (size_t)MT * D + o); const unsigned* pyf = (const unsigned*)&yfw; const unsigned* pyb = (const unsigned*)&ybw;
            const size_t oh = hm_index(m, c0);
            const u32x4 rr = *(const u32x4*)(Rm + oh), kk = *(const u32x4*)(Km + oh), vv = *(const u32x4*)(Vm + oh), gg = *(const u32x4*)(Gt + o), l0 = *(const u32x4*)(LA + oh), l1 = *(const u32x4*)(LA + (size_t)MT * D + oh);
            const f32x4 ka0 = *(const f32x4*)(k_a + c0), ka1 = *(const f32x4*)(k_a + c0 + 4), rk0 = *(const f32x4*)(r_k + c0), rk1 = *(const f32x4*)(r_k + c0 + 4);
            const f32x4 lw0 = *(const f32x4*)(ln_w + c0), lw1 = *(const f32x4*)(ln_w + c0 + 4), lb0 = *(const f32x4*)(ln_b + c0), lb1 = *(const f32x4*)(ln_b + c0 + 4);
            float y[8], r[8], k[8], v[8], g[8], a0[8], a1[8], ka[8], rk[8], lw[8], lb[8];
            const unsigned* pr = (const unsigned*)&rr; const unsigned* pk = (const unsigned*)&kk; const unsigned* pv = (const unsigned*)&vv; const unsigned* pg = (const unsigned*)&gg; const unsigned* p0 = (const unsigned*)&l0; const unsigned* p1 = (const unsigned*)&l1;
#pragma unroll
            for (int j = 0; j < 4; ++j) {
                y[2 * j] = bflo(pyf[j]) + bflo(pyb[j]); y[2 * j + 1] = bfhi(pyf[j]) + bfhi(pyb[j]); ka[j] = ka0[j]; ka[4 + j] = ka1[j]; rk[j] = rk0[j]; rk[4 + j] = rk1[j]; lw[j] = lw0[j]; lw[4 + j] = lw1[j]; lb[j] = lb0[j]; lb[4 + j] = lb1[j];
                r[2 * j] = bflo(pr[j]); r[2 * j + 1] = bfhi(pr[j]); k[2 * j] = bflo(pk[j]); k[2 * j + 1] = bfhi(pk[j]); v[2 * j] = bflo(pv[j]); v[2 * j + 1] = bfhi(pv[j]);
                g[2 * j] = bflo(pg[j]); g[2 * j + 1] = bfhi(pg[j]); a0[2 * j] = fsigmoid(bflo(p0[j])); a0[2 * j + 1] = fsigmoid(bfhi(p0[j])); a1[2 * j] = fsigmoid(bflo(p1[j])); a1[2 * j + 1] = fsigmoid(bfhi(p1[j]));
            }
            float s = 0.f, bon = 0.f;
#pragma unroll
            for (int j = 0; j < 8; ++j) { s += y[j]; bon += r[j] * (k[j] * (2.0f + (a0[j] + a1[j] - 2.0f) * ka[j])) * rk[j]; }
            const float mean = head8_sum(s) * (1.0f / 64.0f); bon = head8_sum(bon);
            float q = 0.f;
#pragma unroll
            for (int j = 0; j < 8; ++j) { y[j] -= mean; q += y[j] * y[j]; }
            const float rstd = __builtin_amdgcn_rsqf(head8_sum(q) * (1.0f / 64.0f) + 64e-5f);
            float ov[8];
#pragma unroll
            for (int j = 0; j < 8; ++j) ov[j] = (y[j] * rstd * lw[j] + lb[j] + bon * v[j]) * g[j];
            u32x4 w; w.x = cvt_pk(ov[0], ov[1]); w.y = cvt_pk(ov[2], ov[3]); w.z = cvt_pk(ov[4], ov[5]); w.w = cvt_pk(ov[6], ov[7]);
            *(u32x4*)(Om + o) = w;
        }
    }
}

constexpr int NPH = 35;
#define IN(k) (lo <= (k) && (k) < hi)
#define SEAM(k) do { if (IN(k) && IN((k) + 1)) xcd_barrier(bar); } while (0)
#define LDSG ((PG8_LAS unsigned char*)C.lds)
#ifndef MK_REP_MASK
#define MK_REP_MASK 0ull
#endif
#define REPQ(k) (((MK_REP_MASK) >> (k)) & 1ull)

template <class Epi>
__device__ __forceinline__ void run_gemm(const Ctx& C, const bf16_t* A, const bf16_t* Bt, int N, int K, const Epi& E) {
    pg8::Gemm g{A, Bt, MT, N, K, K}; pg8::StaticOrder S; S.init(MT, N, C.G, C.bid);
    pg8::gemm_phase<Epi, pg8::StaticOrder, false>(LDSG, g, S, E, nullptr);
}

#ifndef MK_SPLIT_MASK
#define MK_SPLIT_MASK 15
#endif
#define PREVP1(L) (((L) > 0 && (((MK_SPLIT_MASK) >> ((L) - 1)) & 1)) ? (const bf16_t*)WSP(bf16_t, WS_ARENA + AR_SLAB) : (const bf16_t*)nullptr)
constexpr size_t AR_SLAB = 200 * MiB;
constexpr size_t CTL_SPLIT = 65536;
template <int SET>
__device__ __forceinline__ void run_gemm_split_res(const Ctx& C, const bf16_t* A, const bf16_t* Bt, int K, bf16_t* X, const float* gate_base) {
    pg8::Gemm g{A, Bt, MT, D, K, K / 2}; TailSplitOrder S; S.init(C.G, C.bid, K / 64);
    EpiResidualSplitB E{X, gate_base, WSP(bf16_t, WS_ARENA + AR_SLAB)};
    pg8::gemm_phase<EpiResidualSplitB, TailSplitOrder, false>(LDSG, g, S, E, nullptr);
}
template <int LAYER>
__device__ __forceinline__ void mlp_block(const Ctx& C, const XcdBarrier& bar, int lo, int hi, int b0) {
    bf16_t* X = WSP(bf16_t, WS_X); bf16_t* H = WSP(bf16_t, WS_H); bf16_t* U = WSP(bf16_t, WS_ARENA + AR_U);
    if (IN(b0)) { { phase_norm_mod_b(C, X, karg<I_N2G>() + LAYER * D, LAYER, 3, H); } if (REPQ(b0)) { phase_norm_mod_b(C, X, karg<I_N2G>() + LAYER * D, LAYER, 3, H); } }
    SEAM(b0);
    if (IN(b0 + 1)) { { EpiBf16<1> E{U, FF}; run_gemm(C, H, WSP(bf16_t, WS_W1T) + (size_t)LAYER * D * FF, FF, D, E); } if (REPQ(b0 + 1)) { EpiBf16<1> E{U, FF}; run_gemm(C, H, WSP(bf16_t, WS_W1T) + (size_t)LAYER * D * FF, FF, D, E); } }
    SEAM(b0 + 1);
    if (IN(b0 + 2)) { { if constexpr (((MK_SPLIT_MASK) >> LAYER) & 1) run_gemm_split_res<LAYER>(C, U, WSP(bf16_t, WS_W2T) + (size_t)LAYER * D * FF, FF, X, MODP(LAYER, 0, 5)); else { EpiResidualB<false> E{X, MODP(LAYER, 0, 5), nullptr, nullptr}; run_gemm(C, U, WSP(bf16_t, WS_W2T) + (size_t)LAYER * D * FF, D, FF, E); } } if (REPQ(b0 + 2)) { if constexpr (((MK_SPLIT_MASK) >> LAYER) & 1) run_gemm_split_res<LAYER>(C, U, WSP(bf16_t, WS_W2T) + (size_t)LAYER * D * FF, FF, X, MODP(LAYER, 0, 5)); else { EpiResidualB<false> E{X, MODP(LAYER, 0, 5), nullptr, nullptr}; run_gemm(C, U, WSP(bf16_t, WS_W2T) + (size_t)LAYER * D * FF, D, FF, E); } } }
    SEAM(b0 + 2);
}

template <int LAYER, int J>
__device__ __forceinline__ void attn_layer(const Ctx& C, const XcdBarrier& bar, int lo, int hi, int b0) {
    bf16_t* X = WSP(bf16_t, WS_X); bf16_t* H = WSP(bf16_t, WS_H);
    bf16_t *Q = WSP(bf16_t, WS_ARENA + AR_Q), *Kb = WSP(bf16_t, WS_ARENA + AR_K), *Vb = WSP(bf16_t, WS_ARENA + AR_V), *O = WSP(bf16_t, WS_ARENA + AR_O);
    if (IN(b0)) { { if (LAYER == 0) { phase_fg_transpose(C); phase_norm_mod(C, karg<I_XP>(), karg<I_XS>(), karg<I_N1G>() + LAYER * D, LAYER, 0, H); } else phase_norm_mod_b(C, X, karg<I_N1G>() + LAYER * D, LAYER, 0, H, PREVP1(LAYER), X, 8192); } if (REPQ(b0)) { if (LAYER == 0) { phase_fg_transpose(C); phase_norm_mod(C, karg<I_XP>(), karg<I_XS>(), karg<I_N1G>() + LAYER * D, LAYER, 0, H); } else phase_norm_mod_b(C, X, karg<I_N1G>() + LAYER * D, LAYER, 0, H, PREVP1(LAYER), X, 8192); } }
    SEAM(b0);
    if (IN(b0 + 1)) { { EpiQKV E{Q, Kb, Vb, C.out + OUT_NK + (size_t)J * 256 * 512, C.out + OUT_NV + (size_t)J * 256 * 512}; run_gemm(C, H, WSP(bf16_t, WS_WQKVT) + (size_t)J * D * 3072, 3072, D, E); } if (REPQ(b0 + 1)) { EpiQKV E{Q, Kb, Vb, C.out + OUT_NK + (size_t)J * 256 * 512, C.out + OUT_NV + (size_t)J * 256 * 512}; run_gemm(C, H, WSP(bf16_t, WS_WQKVT) + (size_t)J * D * 3072, 3072, D, E); } }
    SEAM(b0 + 1);
    if (IN(b0 + 2)) { { phase_attention(C, Q, Kb, Vb, WSP(bf16_t, WS_KC) + (size_t)J * 512 * 512, WSP(bf16_t, WS_VC) + (size_t)J * 512 * 512, karg<I_SINK>() + J * 16, O); } if (REPQ(b0 + 2)) { phase_attention(C, Q, Kb, Vb, WSP(bf16_t, WS_KC) + (size_t)J * 512 * 512, WSP(bf16_t, WS_VC) + (size_t)J * 512 * 512, karg<I_SINK>() + J * 16, O); } }
    SEAM(b0 + 2);
    if (IN(b0 + 3)) { { EpiResidualB<LAYER == 0> E{X, MODP(LAYER, 0, 2), LAYER == 0 ? karg<I_XP>() : nullptr, LAYER == 0 ? karg<I_XS>() : nullptr}; run_gemm(C, O, WSP(bf16_t, WS_WOT) + (size_t)J * D * D, D, D, E); } if (REPQ(b0 + 3)) { EpiResidualB<LAYER == 0> E{X, MODP(LAYER, 0, 2), LAYER == 0 ? karg<I_XP>() : nullptr, LAYER == 0 ? karg<I_XS>() : nullptr}; run_gemm(C, O, WSP(bf16_t, WS_WOT) + (size_t)J * D * D, D, D, E); } }
    SEAM(b0 + 3);
    mlp_block<LAYER>(C, bar, lo, hi, b0 + 4);
}

template <int LAYER>
__device__ __forceinline__ void hyena_layer(const Ctx& C, const XcdBarrier& bar, int lo, int hi, int b0) {
    bf16_t* X = WSP(bf16_t, WS_X); bf16_t* H = WSP(bf16_t, WS_H);
    bf16_t *Pm = WSP(bf16_t, WS_ARENA + AR_P), *X0 = WSP(bf16_t, WS_ARENA + AR_X0), *ZT = WSP(bf16_t, WS_ARENA + AR_ZT), *YT = WSP(bf16_t, WS_ARENA + AR_YT), *HO = WSP(bf16_t, WS_ARENA + AR_HO);
    bf16_t *ZTp = ZT, *ZTs = ZT + (size_t)MP * D, *YTp = YT, *YTs = YT + (size_t)MP * D;
    if (IN(b0)) { { phase_norm_mod_b(C, X, karg<I_N1G>() + LAYER * D, LAYER, 0, H, PREVP1(LAYER), X, 8192); } if (REPQ(b0)) { phase_norm_mod_b(C, X, karg<I_N1G>() + LAYER * D, LAYER, 0, H, PREVP1(LAYER), X, 8192); } }
    SEAM(b0);
    if (IN(b0 + 1)) { { EpiBf16<0> E{Pm, 6144}; run_gemm(C, H, WSP(bf16_t, WS_HYINT), 6144, D, E); } if (REPQ(b0 + 1)) { EpiBf16<0> E{Pm, 6144}; run_gemm(C, H, WSP(bf16_t, WS_HYINT), 6144, D, E); } }
    SEAM(b0 + 1);
    if (IN(b0 + 2)) { { phase_hy_gate(C, Pm, karg<I_HYCW>(), karg<I_HYCB>(), X0, ZTp, ZTs); } if (REPQ(b0 + 2)) { phase_hy_gate(C, Pm, karg<I_HYCW>(), karg<I_HYCB>(), X0, ZTp, ZTs); } }
    SEAM(b0 + 2);
    if (IN(b0 + 3)) { { phase_hy_conv<1024, 8>(C, WSP(bf16_t, WS_FGS), ZTs, YTs); phase_hy_conv<256, 16>(C, WSP(bf16_t, WS_FGP), ZTp, YTp); } if (REPQ(b0 + 3)) { phase_hy_conv<1024, 8>(C, WSP(bf16_t, WS_FGS), ZTs, YTs); phase_hy_conv<256, 16>(C, WSP(bf16_t, WS_FGP), ZTp, YTp); } }
    SEAM(b0 + 3);
    if (IN(b0 + 4)) { { phase_hy_out(C, YTp, YTs, X0, HO); } if (REPQ(b0 + 4)) { phase_hy_out(C, YTp, YTs, X0, HO); } }
    SEAM(b0 + 4);
    if (IN(b0 + 5)) { { EpiResidualB<false> E{X, MODP(LAYER, 0, 2), nullptr, nullptr}; run_gemm(C, HO, WSP(bf16_t, WS_HYOUTT), D, D, E); } if (REPQ(b0 + 5)) { EpiResidualB<false> E{X, MODP(LAYER, 0, 2), nullptr, nullptr}; run_gemm(C, HO, WSP(bf16_t, WS_HYOUTT), D, D, E); } }
    SEAM(b0 + 5);
    mlp_block<LAYER>(C, bar, lo, hi, b0 + 6);
}

__device__ __forceinline__ void rw_g2_phase(const Ctx& C, const bf16_t* XM, bf16_t* Rm, bf16_t* A3, bf16_t* LD, bf16_t* LA, bf16_t* Gt) {
    if (C.G == 256 && C.bid >= 240) { pg8::Gemm g{XM, WSP(bf16_t, WS_RWBT), 6 * MT, 27 * 256, D, D}; RwOrder1 S{16, C.bid - 240, 1280, 27 * NPANEL, true}; EpiRw1 E{Rm, A3, karg<I_KK>(), WSP(float, WS_INVSQ)}; pg8::gemm_phase<EpiRw1, RwOrder1, false>(LDSG, g, S, E, nullptr); }
    else { pg8::Gemm g{A3, WSP(bf16_t, WS_LORA2T), 3 * MT, 40 * 256, 256, 256}; RwOrder2 S{C.G == 256 ? 240 : C.G, C.bid, nullptr, 0u}; EpiRw2 E{LD, LA, Gt, karg<I_W0>(), karg<I_A0>()}; pg8::gemm_phase<EpiRw2, RwOrder2, false>(LDSG, g, S, E, nullptr); }
}
template <int LAYER>
__device__ __forceinline__ void rwkv_layer(const Ctx& C, const XcdBarrier& bar, int lo, int hi, int b0) {
    bf16_t* X = WSP(bf16_t, WS_X); bf16_t* H = WSP(bf16_t, WS_H);
    bf16_t *XM = WSP(bf16_t, WS_ARENA + AR_XMIX), *LD = WSP(bf16_t, WS_ARENA + AR_LD), *LA = WSP(bf16_t, WS_ARENA + AR_LA), *Gt = WSP(bf16_t, WS_ARENA + AR_G), *RO = WSP(bf16_t, WS_ARENA + AR_RO);
    bf16_t *Rm = WSP(bf16_t, WS_ARENA + AR_R), *Km = WSP(bf16_t, WS_ARENA + AR_KK), *Vm = WSP(bf16_t, WS_ARENA + AR_VV), *A3 = WSP(bf16_t, WS_ARENA + AR_A3);
    bf16_t* YB = WSP(bf16_t, WS_ARENA + AR_YB);
    if (IN(b0)) { { phase_norm_mod_b(C, X, karg<I_N1G>() + LAYER * D, LAYER, 0, H, PREVP1(LAYER), X, 8192); } if (REPQ(b0)) { phase_norm_mod_b(C, X, karg<I_N1G>() + LAYER * D, LAYER, 0, H, PREVP1(LAYER), X, 8192); } }
    SEAM(b0);
    if (IN(b0 + 1)) { { phase_rw_mix(C, H, karg<I_MU>(), XM); } if (REPQ(b0 + 1)) { phase_rw_mix(C, H, karg<I_MU>(), XM); } }
    SEAM(b0 + 1);
    if (IN(b0 + 2)) { { pg8::Gemm g{XM, WSP(bf16_t, WS_RWBT), 6 * MT, 27 * 256, D, D}; RwOrder1 S{C.G, C.bid, 0, C.G == 256 ? 1280 : 27 * NPANEL, C.G == 256}; EpiRw1 E{Rm, A3, karg<I_KK>(), WSP(float, WS_INVSQ)}; pg8::gemm_phase<EpiRw1, RwOrder1, false>(LDSG, g, S, E, nullptr); } if (REPQ(b0 + 2)) { pg8::Gemm g{XM, WSP(bf16_t, WS_RWBT), 6 * MT, 27 * 256, D, D}; RwOrder1 S{C.G, C.bid, 0, C.G == 256 ? 1280 : 27 * NPANEL, C.G == 256}; EpiRw1 E{Rm, A3, karg<I_KK>(), WSP(float, WS_INVSQ)}; pg8::gemm_phase<EpiRw1, RwOrder1, false>(LDSG, g, S, E, nullptr); } }
    SEAM(b0 + 2);
    if (IN(b0 + 3)) { { rw_g2_phase(C, XM, Rm, A3, LD, LA, Gt); } if (REPQ(b0 + 3)) { rw_g2_phase(C, XM, Rm, A3, LD, LA, Gt); } }
    SEAM(b0 + 3);
    if (IN(b0 + 4)) { { phase_rw_scan(C, Rm, Km, Vm, LD, LA, karg<I_KK>(), karg<I_KA>(), WSP(float, WS_INVSQ), karg<I_ST>(), YB, C.out + OUT_ST); } if (REPQ(b0 + 4)) { phase_rw_scan(C, Rm, Km, Vm, LD, LA, karg<I_KK>(), karg<I_KA>(), WSP(float, WS_INVSQ), karg<I_ST>(), YB, C.out + OUT_ST); } }
    SEAM(b0 + 4);
    if (IN(b0 + 5)) { { phase_rw_post(C, YB, Rm, Km, Vm, LA, Gt, karg<I_KA>(), karg<I_RK>(), karg<I_LNW>(), karg<I_LNB>(), RO); } if (REPQ(b0 + 5)) { phase_rw_post(C, YB, Rm, Km, Vm, LA, Gt, karg<I_KA>(), karg<I_RK>(), karg<I_LNW>(), karg<I_LNB>(), RO); } }
    SEAM(b0 + 5);
    if (IN(b0 + 6)) { { EpiResidualB<false> E{X, MODP(LAYER, 0, 2), nullptr, nullptr}; run_gemm(C, RO, WSP(bf16_t, WS_RWOT), D, D, E); } if (REPQ(b0 + 6)) { EpiResidualB<false> E{X, MODP(LAYER, 0, 2), nullptr, nullptr}; run_gemm(C, RO, WSP(bf16_t, WS_RWOT), D, D, E); } }
    SEAM(b0 + 6);
    mlp_block<LAYER>(C, bar, lo, hi, b0 + 7);
}

__global__ void __launch_bounds__(512, 2) fwd_kernel(Params prm) {
    extern __shared__ __attribute__((aligned(16))) unsigned char lds_raw[];
    Ctx C;
    C.lds = (LAS unsigned char*)lds_raw;
    C.tid = threadIdx.x; C.lane = C.tid & 63; C.wave = __builtin_amdgcn_readfirstlane(C.tid >> 6); C.G = gridDim.x; C.bid = blockIdx.x;
    C.out = prm.out; C.ws = prm.ws;
    const int lo = prm.ph_lo, hi = prm.ph_hi;
    volatile LAS unsigned* xbw = (volatile LAS unsigned*)(C.lds + LDS_BAR_OFF);
    if (C.tid < 4) xbw[C.tid] = 0u;
    __syncthreads();
    XcdBarrier bar; bar.bar = (unsigned*)(C.ws + WS_CTL) + 1024; bar.x = 0; bar.st = xbw;
    if (hi - lo > 1) bar = xcd_barrier_post((unsigned*)(C.ws + WS_CTL) + 1024, xbw);

#ifdef MK_SKIP_FROM
    if (IN(0)) { for (size_t i = (size_t)C.bid * 512 + C.tid; i < (size_t)3 * 4194304; i += (size_t)C.G * 512) prm.out[OUT_NK + i] = 0.f; }
#endif
    if (IN(0)) { { phase_prologue(C); } if (REPQ(0)) { phase_prologue(C); } }
    SEAM(0);
    attn_layer<0, 0>(C, bar, lo, hi, 1);
    hyena_layer<1>(C, bar, lo, hi, 8);
    rwkv_layer<2>(C, bar, lo, hi, 17);
    attn_layer<3, 1>(C, bar, lo, hi, 27);
#ifndef MK_DBG_N
#define MK_DBG_N ((size_t)MT * D)
#endif
#ifndef MK_DBG_SCALE
#define MK_DBG_SCALE 1.0f
#endif
#ifdef MK_DBG_OFF
    if (IN(34)) { for (size_t i = (size_t)C.bid * 512 + C.tid; i < (size_t)MT * D; i += (size_t)C.G * 512) prm.out[OUT_Y + i] = i < (size_t)(MK_DBG_N) ? MK_DBG_SCALE * (MK_DBG_BF16 ? bf2f(WSP(bf16_t, MK_DBG_OFF)[i]) : WSP(float, MK_DBG_OFF)[i]) : 0.f; }
#else
    if (IN(34)) { { phase_norm_final_b(C, WSP(bf16_t, WS_X), karg<I_FNG>(), prm.out + OUT_Y, PREVP1(4), 8192); } if (REPQ(34)) { phase_norm_final_b(C, WSP(bf16_t, WS_X), karg<I_FNG>(), prm.out + OUT_Y, PREVP1(4), 8192); } }
#endif
}

#ifdef MK_SEP_CONV
__global__ void __launch_bounds__(512, 2) k_hyconv(Params prm) {
    extern __shared__ __attribute__((aligned(16))) unsigned char lds_raw3[];
    Ctx C; C.lds = (LAS unsigned char*)lds_raw3; C.tid = threadIdx.x; C.lane = C.tid & 63; C.wave = __builtin_amdgcn_readfirstlane(C.tid >> 6); C.G = gridDim.x; C.bid = blockIdx.x; C.out = prm.out; C.ws = prm.ws;
    bf16_t *ZT = WSP(bf16_t, WS_ARENA + AR_ZT), *YT = WSP(bf16_t, WS_ARENA + AR_YT);
    phase_hy_conv<1024, 8>(C, WSP(bf16_t, WS_FGS), ZT + (size_t)MP * D, YT + (size_t)MP * D); phase_hy_conv<256, 16>(C, WSP(bf16_t, WS_FGP), ZT, YT);
}
#endif
#ifdef MK_SEP_GATE
__global__ void __launch_bounds__(512, 2) k_hygate(Params prm) {
    extern __shared__ __attribute__((aligned(16))) unsigned char lds_raw2[];
    Ctx C; C.lds = (LAS unsigned char*)lds_raw2; C.tid = threadIdx.x; C.lane = C.tid & 63; C.wave = __builtin_amdgcn_readfirstlane(C.tid >> 6); C.G = gridDim.x; C.bid = blockIdx.x; C.out = prm.out; C.ws = prm.ws;
    bf16_t* ZT = WSP(bf16_t, WS_ARENA + AR_ZT);
    phase_hy_gate(C, WSP(bf16_t, WS_ARENA + AR_P), karg<I_HYCW>(), karg<I_HYCB>(), WSP(bf16_t, WS_ARENA + AR_X0), ZT, ZT + (size_t)MP * D);
}
#endif
#ifndef MK_PER_PHASE
#define MK_PER_PHASE 0
#endif
extern "C" void kernel_launch(void* const* d_in, const int* in_sizes, int n_in, void* d_out, int out_size, void* d_ws, size_t ws_size, hipStream_t stream) {
    static int grid = 0;
    if (grid == 0) {
        if (n_in != N_IN || ws_size < WS_END || out_size != 37748736) { fprintf(stderr, "kernel_launch: unexpected shapes (n_in %d, ws %zu, out %d); nothing launched\n", n_in, ws_size, out_size); grid = -1; return; }
        int dev = 0, cus = 0, per_cu = 0;
        if (hipGetDevice(&dev) != hipSuccess || hipDeviceGetAttribute(&cus, hipDeviceAttributeMultiprocessorCount, dev) != hipSuccess) { grid = -1; return; }
        if (hipFuncSetAttribute((const void*)fwd_kernel, hipFuncAttributeMaxDynamicSharedMemorySize, LDS_BYTES) != hipSuccess) { fprintf(stderr, "kernel_launch: hipFuncSetAttribute failed\n"); grid = -1; return; }
        if (hipOccupancyMaxActiveBlocksPerMultiprocessor(&per_cu, (const void*)fwd_kernel, 512, LDS_BYTES) != hipSuccess || per_cu < 1) { fprintf(stderr, "kernel_launch: occupancy query says %d\n", per_cu); }
        (void)hipGetLastError();
        grid = cus;
    }
    if (grid < 0) return;
    (void)hipMemsetAsync((char*)d_ws, 0, WS_ZERO_BYTES, stream);
    Params p{};
    for (int i = 0; i < N_IN; ++i) p.in[i] = (const float*)d_in[i];
    p.out = (float*)d_out; p.ws = (unsigned char*)d_ws;
#ifndef MK_LASTP
#define MK_LASTP NPH
#endif
#ifndef MK_FIRSTP
#define MK_FIRSTP 0
#endif
#if MK_PER_PHASE
    for (int k = MK_FIRSTP; k < MK_LASTP; ++k) {
#ifdef MK_SKIP_FROM
        if (k >= MK_SKIP_FROM && k < NPH - 1) continue;
#endif
#ifdef MK_SEP_CONV
        if (k == 11) { static bool a3 = false; if (!a3) { (void)hipFuncSetAttribute((const void*)k_hyconv, hipFuncAttributeMaxDynamicSharedMemorySize, 70000); a3 = true; } hipLaunchKernelGGL(k_hyconv, dim3(grid), dim3(512), 70000, stream, p); continue; }
#endif
#ifdef MK_SEP_GATE
        if (k == 10) { hipLaunchKernelGGL(k_hygate, dim3(grid), dim3(512), 16384, stream, p); continue; }
#endif
#ifdef MK_REPEAT_PH
        if (k == MK_REPEAT_PH) { p.ph_lo = k; p.ph_hi = k + 1; hipLaunchKernelGGL(fwd_kernel, dim3(grid), dim3(512), LDS_BYTES, stream, p); }
#endif
 p.ph_lo = k; p.ph_hi = k + 1; hipLaunchKernelGGL(fwd_kernel, dim3(grid), dim3(512), LDS_BYTES, stream, p); }
#else
    p.ph_lo = 0; p.ph_hi = NPH; hipLaunchKernelGGL(fwd_kernel, dim3(grid), dim3(512), LDS_BYTES, stream, p);
#endif
}
```

```cpp
#include <hip/hip_runtime.h>
#include <cstdio>
#include <cstdint>
namespace pg8 {
#define PG8_LAS __attribute__((address_space(3)))
typedef unsigned short bf16_t;
typedef short bf16x8 __attribute__((ext_vector_type(8)));
typedef float f32x4 __attribute__((ext_vector_type(4)));
typedef unsigned u32x4 __attribute__((ext_vector_type(4)));
constexpr int BM = 256, BK = 64, HALF = 128, HTB = HALF * BK * 2  , STAGE_BYTES = 8 * HTB, NXCD = 8, WGM = 4;

__host__ __device__ __forceinline__ int lds_byte(int r, int c) { const int st = (r >> 4) * 2 + (c >> 5), rr = r & 15, cc = c & 31, ob = rr * 64 + cc * 2; return st * 1024 + (ob ^ (((ob >> 9) & 1) << 5)); }
__host__ __device__ __forceinline__ void stage_rc(int b, int& R, int& C) { const int st = b / 1024, sb = b % 1024, swz = sb ^ (((sb >> 9) & 1) << 5); R = (st >> 1) * 16 + swz / 64; C = (st & 1) * 32 + (swz % 64) / 2; }
__host__ __device__ __forceinline__ int perm32(int rho) { const int n = rho >> 4, i = rho & 15; return 8 * (i >> 2) + 4 * n + (i & 3); }

struct Unit { int pm, pn, kh, mask; int nt = 0; };
struct Gemm { const bf16_t* A; const bf16_t* Bt; int M, N, K, KU; };

__host__ __device__ __forceinline__ bool tail_deal(int nwg, int G, int i, int c, int& L, int& mask) {
    const int full = nwg / G, rem = nwg - full * G;
    if (i < full) { L = i * G + c; mask = 15; return true; }
    if (i > full || rem == 0) return false;
    const int parts = (4 * rem <= G) ? 4 : ((2 * rem <= G) ? 2 : 1);
    if (c >= parts * rem) return false;
    L = full * G + c / parts; const int sub = c % parts;
    mask = parts == 1 ? 15 : (parts == 2 ? (sub ? 0xA : 0x5) : (1 << sub));
    return true;
}
struct StaticOrder {
    int nM, nN, nwg, G, c;
    __host__ __device__ void init(int M, int N, int G_, int c_) { nM = M / BM; nN = N / BM; nwg = nM * nN; G = G_; c = c_; }
    __host__ __device__ bool next(int i, Unit& u) const { const long L = (long)i * G + c; if (L >= nwg) return false; map((int)L, u); u.kh = 0; u.mask = 15; return true; }
    __host__ __device__ bool map(int L, Unit& u) const {
        int wgid = (int)L; { const int q = nwg / NXCD, r = nwg % NXCD, xcd = wgid % NXCD, off = wgid / NXCD; wgid = (xcd < r ? xcd * (q + 1) : r * (q + 1) + (xcd - r) * q) + off; }
        const int nig = WGM * nN, gid = wgid / nig, fm = gid * WGM, gsz = (nM - fm) < WGM ? (nM - fm) : WGM;
        u.pm = fm + ((wgid % nig) % gsz); u.pn = (wgid % nig) / gsz; return true;
    }
    __device__ __forceinline__ void a_ready(const Unit&) const {}
    __device__ __forceinline__ void done(const Unit&) const {}
};

template <class Epi, class Sched, bool STAMP = false>
__device__ __forceinline__ void gemm_phase(PG8_LAS unsigned char* lds, const Gemm g, const Sched& S, const Epi& E, unsigned long long* stamps) {
    const int tid = threadIdx.x, wid = __builtin_amdgcn_readfirstlane(tid >> 6), lane = tid & 63, wr = wid >> 2, wc = wid & 3, fr = lane & 15, fq = lane >> 4;
    const int K = g.K, nt = g.KU / BK;
    int ts_lo = 0, ts_hi = 0, nts = 0; const unsigned long long rt_entry = STAMP ? (unsigned long long)wall_clock64() : 0ull;
#define PG8_STAMP() do { if (STAMP && wid == 0 && nts < 64) { const unsigned long long _c = (unsigned long long)clock64(); \
        ts_lo = (lane == nts) ? (int)(unsigned)_c : ts_lo; ts_hi = (lane == nts) ? (int)(unsigned)(_c >> 32) : ts_hi; ++nts; } } while (0)
    PG8_STAMP();
    unsigned voffA[2], voffB[2];
#pragma unroll
    for (int i = 0; i < 2; ++i) { int R, C; stage_rc(tid * 16 + i * 8192, R, C); const int Rb = Epi::PERM ? ((R & ~31) + perm32(R & 31)) : R;
        voffA[i] = (unsigned)(R * K + C) * 2u; voffB[i] = (unsigned)(Rb * K + C) * 2u; }
    const size_t kstep = (size_t)(BK * 2);
    const size_t hstep = (size_t)HALF * K * 2;
    const size_t tstep = 2 * hstep;
    const unsigned ldsw = (unsigned)wid * 1024u;
    const int aoff = lds_byte(wr * 64 + fr, fq * 8), boff = lds_byte(wc * 32 + fr, fq * 8);
#define PG8_SA(b, h) (((b) * 2 + (h)) * HTB)
#define PG8_SB(b, h) ((4 + (b) * 2 + (h)) * HTB)
#define PG8_STAGE(bufoff, gbase, voff) do { _Pragma("unroll") for (int _i = 0; _i < 2; ++_i) \
        __builtin_amdgcn_global_load_lds((const unsigned*)((const char*)(gbase) + (voff)[_i]), (PG8_LAS unsigned*)(lds + (bufoff) + ldsw + _i * 8192), 16, 0, 0); } while (0)
#define PG8_LDA(dst, b, h) do { _Pragma("unroll") for (int m = 0; m < 4; ++m) _Pragma("unroll") for (int k = 0; k < 2; ++k) dst[m][k] = *(const PG8_LAS bf16x8*)(lds + PG8_SA(b, h) + aoff + m * 2048 + k * 1024); } while (0)
#define PG8_LDB(dst, b, h) do { _Pragma("unroll") for (int n = 0; n < 2; ++n) _Pragma("unroll") for (int k = 0; k < 2; ++k) dst[n][k] = *(const PG8_LAS bf16x8*)(lds + PG8_SB(b, h) + boff + n * 2048 + k * 1024); } while (0)
#define PG8_MMA(ai, bj, At, Bt) do { __builtin_amdgcn_s_setprio(1); _Pragma("unroll") for (int k = 0; k < 2; ++k) _Pragma("unroll") for (int m = 0; m < 4; ++m) _Pragma("unroll") for (int n = 0; n < 2; ++n) \
        asm volatile("v_mfma_f32_16x16x32_bf16 %0, %1, %2, %0" : "+v"(acc[ai][bj][m][n]) : "v"(Bt[n][k]), "v"(At[m][k])); __builtin_amdgcn_s_setprio(0); } while (0)
#define PG8_ACC_FENCE1(ai, bj) asm volatile("s_nop 15\n\ts_nop 15" : "+v"(acc[ai][bj][0][0]), "+v"(acc[ai][bj][0][1]), "+v"(acc[ai][bj][1][0]), "+v"(acc[ai][bj][1][1]), "+v"(acc[ai][bj][2][0]), "+v"(acc[ai][bj][2][1]), "+v"(acc[ai][bj][3][0]), "+v"(acc[ai][bj][3][1]))
#define PG8_ACC_FENCE() do { PG8_ACC_FENCE1(0, 0); PG8_ACC_FENCE1(0, 1); PG8_ACC_FENCE1(1, 0); PG8_ACC_FENCE1(1, 1); } while (0)
#define PG8_WAIT_V(n) asm volatile("s_waitcnt vmcnt(" #n ")" ::: "memory")
#define PG8_WAIT_L(n) asm volatile("s_waitcnt lgkmcnt(" #n ")" ::: "memory")
#define PG8_BAR __builtin_amdgcn_s_barrier()
#define PG8_SCHED __builtin_amdgcn_sched_barrier(0)
    Unit cur, nxt; int ui = 0;
    if (!S.next(0, cur)) return;
    f32x4 acc[2][2][4][2];
#pragma unroll
    for (int a = 0; a < 2; ++a)
#pragma unroll
        for (int b = 0; b < 2; ++b)
#pragma unroll
            for (int m = 0; m < 4; ++m)
#pragma unroll
                for (int n = 0; n < 2; ++n) acc[a][b][m][n] = (f32x4){0.f, 0.f, 0.f, 0.f};
    bf16x8 At[4][2], B0[2][2], B1[2][2];
    const size_t kslice = (size_t)g.KU * 2;
    const char* cA = (const char*)g.A + (size_t)cur.pm * tstep + cur.kh * kslice; const char* cB = (const char*)g.Bt + (size_t)cur.pn * tstep + cur.kh * kslice;
    S.a_ready(cur);
    PG8_STAGE(PG8_SB(0, 0), cB, voffB); PG8_STAGE(PG8_SA(0, 0), cA, voffA); PG8_STAGE(PG8_SB(0, 1), cB + hstep, voffB); PG8_STAGE(PG8_SA(0, 1), cA + hstep, voffA);
    if (wr == 1) PG8_BAR;
    PG8_WAIT_V(4); PG8_BAR;
    PG8_STAGE(PG8_SB(1, 0), cB + kstep, voffB); PG8_STAGE(PG8_SA(1, 0), cA + kstep, voffA); PG8_STAGE(PG8_SB(1, 1), cB + hstep + kstep, voffB);
    PG8_WAIT_V(6); PG8_BAR;
    PG8_STAMP();
    for (;;) {
        const bool has_next = S.next(ui + 1, nxt);
        const char* nA = has_next ? (const char*)g.A + (size_t)nxt.pm * tstep + nxt.kh * kslice : cA; const char* nB = has_next ? (const char*)g.Bt + (size_t)nxt.pn * tstep + nxt.kh * kslice : cB;
        const int unt = cur.nt ? cur.nt : nt;
        const bool pre = ui > 0;
        for (int t = 0; t < unt; t += 2) {
            const bool last = (t == unt - 2);
            const char* a1 = cA + (size_t)(t + 1) * kstep;
            const char* a2 = last ? nA : cA + (size_t)(t + 2) * kstep; const char* b2 = last ? nB : cB + (size_t)(t + 2) * kstep;
            const char* a3 = a2 + kstep; const char* b3 = b2 + kstep;
            if (last && has_next) S.a_ready(nxt);
            PG8_LDB(B0, 0, 0); PG8_SCHED; PG8_LDA(At, 0, 0); if (!(pre && t == 0)) PG8_STAGE(PG8_SA(1, 1), a1 + hstep, voffA);
            PG8_WAIT_L(8); PG8_BAR; PG8_WAIT_L(0); PG8_MMA(0, 0, At, B0); PG8_BAR; PG8_SCHED;
            PG8_LDB(B1, 0, 1); PG8_STAGE(PG8_SB(0, 0), b2, voffB);
            PG8_BAR; PG8_WAIT_L(0); PG8_MMA(0, 1, At, B1); PG8_BAR;
            PG8_LDA(At, 0, 1); PG8_STAGE(PG8_SA(0, 0), a2, voffA);
            PG8_BAR; PG8_WAIT_L(0); PG8_MMA(1, 0, At, B0); PG8_BAR; PG8_SCHED;
            PG8_STAGE(PG8_SB(0, 1), b2 + hstep, voffB);
            if (pre && t == 0) PG8_WAIT_V(22); else PG8_WAIT_V(6);
            PG8_BAR; PG8_MMA(1, 1, At, B1); PG8_BAR;
            PG8_LDB(B0, 1, 0); PG8_SCHED; PG8_LDA(At, 1, 0); PG8_STAGE(PG8_SA(0, 1), a2 + hstep, voffA);
            PG8_WAIT_L(8); PG8_BAR; PG8_WAIT_L(0); PG8_MMA(0, 0, At, B0); PG8_BAR; PG8_SCHED;
            PG8_LDB(B1, 1, 1); PG8_STAGE(PG8_SB(1, 0), b3, voffB);
            PG8_BAR; PG8_WAIT_L(0); PG8_MMA(0, 1, At, B1); PG8_BAR;
            PG8_LDA(At, 1, 1); PG8_STAGE(PG8_SA(1, 0), a3, voffA);
            PG8_BAR; PG8_WAIT_L(0); PG8_MMA(1, 0, At, B0); PG8_BAR; PG8_SCHED;
            PG8_STAGE(PG8_SB(1, 1), b3 + hstep, voffB);
            PG8_WAIT_V(6); PG8_BAR; PG8_MMA(1, 1, At, B1); PG8_BAR;
        }
        PG8_STAMP();
        if (has_next) { PG8_STAGE(PG8_SA(1, 1), nA + kstep + hstep, voffA); }
        asm volatile("" ::: "memory"); PG8_SCHED;
        PG8_ACC_FENCE();
        if constexpr (!Epi::AFTER_DRAIN) { E(acc, cur, wr, wc, fr, fq); S.done(cur); }
        PG8_STAMP();
        if (!has_next) break;
#pragma unroll
        for (int a = 0; a < 2; ++a)
#pragma unroll
            for (int b = 0; b < 2; ++b)
#pragma unroll
                for (int m = 0; m < 4; ++m)
#pragma unroll
                    for (int n = 0; n < 2; ++n) acc[a][b][m][n] = (f32x4){0.f, 0.f, 0.f, 0.f};
        cur = nxt; cA = nA; cB = nB; ++ui;
    }
    PG8_WAIT_V(0);
    if (wr == 0) PG8_BAR;
    PG8_BAR;
    if constexpr (Epi::AFTER_DRAIN) { E.fused(acc, cur, wr, wc, fr, fq, lds, wid, lane); S.done(cur); }
    PG8_STAMP();
    if (STAMP && wid == 0) { stamps[lane] = lane < nts ? (((unsigned long long)(unsigned)ts_hi << 32) | (unsigned)ts_lo) : 0ull;
        if (lane == 62) stamps[62] = rt_entry; if (lane == 63) stamps[63] = (unsigned long long)wall_clock64(); }
#undef PG8_STAMP
#undef PG8_SA
#undef PG8_SB
#undef PG8_STAGE
#undef PG8_LDA
#undef PG8_LDB
#undef PG8_MMA
#undef PG8_ACC_FENCE
#undef PG8_ACC_FENCE1
#undef PG8_WAIT_V
#undef PG8_WAIT_L
#undef PG8_BAR
#undef PG8_SCHED
}
}

#define XB_TMO      128
#define XB_XCNT(j)  (256  + 64 * (j))
#define XB_XSUB(j)  (1280 + 64 * (j))
#define XB_XGEN(j)  (2304 + 64 * (j))
#define XB_TOP      3328
#define XB_TOPGEN   3392
#define XCD_BAR_WORDS 3456
#define XB_SPIN_CAP (1u << 20)
#define LAS __attribute__((address_space(3)))

__device__ __forceinline__ unsigned xb_ld(unsigned* p)              { return __hip_atomic_load(p, __ATOMIC_RELAXED, __HIP_MEMORY_SCOPE_AGENT); }
__device__ __forceinline__ unsigned xb_add(unsigned* p, unsigned v) { return __hip_atomic_fetch_add(p, v, __ATOMIC_RELAXED, __HIP_MEMORY_SCOPE_AGENT); }
__device__ __forceinline__ unsigned xb_xcc_id() { return (unsigned)__builtin_amdgcn_s_getreg((3 << 11) | 20) & 0xFu; }
#define XB_SPIN(cond, bar) do { unsigned _sp = 0; while (cond) { __builtin_amdgcn_s_sleep(1); \
    if ((++_sp & 255u) == 0u) { if (xb_ld(&(bar)[XB_TMO])) break; if (_sp > XB_SPIN_CAP) { atomicAdd(&(bar)[XB_TMO], 1u); break; } } } } while (0)

struct XcdBarrier {
    unsigned* bar; unsigned x;
    volatile LAS unsigned* st;
};

__device__ __forceinline__ XcdBarrier xcd_barrier_post(unsigned* bar, volatile LAS unsigned* st) {
    XcdBarrier b; b.bar = bar; b.x = xb_xcc_id(); b.st = st;
    if (threadIdx.x == 0) (void)xb_add(&bar[XB_XCNT(b.x)], 1u);
    return b;
}
__device__ __forceinline__ void xcd_barrier_complete(unsigned* bar, unsigned x, unsigned& nloc, unsigned& nx) {
    const unsigned G = gridDim.x * gridDim.y * gridDim.z;
    unsigned sum, cnt, mine, sp = 0u;
    for (;;) {
        sum = 0u; cnt = 0u; mine = 0u;
#pragma unroll
        for (unsigned j = 0; j < 16; ++j) { const unsigned c = xb_ld(&bar[XB_XCNT(j)]); sum += c; cnt += (c > 0u) ? 1u : 0u; mine = (j == x) ? c : mine; }
        if (sum == G) break;
        __builtin_amdgcn_s_sleep(1);
        if ((++sp & 255u) == 0u) { if (xb_ld(&bar[XB_TMO])) break; if (sp > XB_SPIN_CAP) { atomicAdd(&bar[XB_TMO], 1u); break; } }
    }
    nloc = mine > 0u ? mine : 1u; nx = cnt > 0u ? cnt : 1u;
}

__device__ __forceinline__ void xcd_barrier(const XcdBarrier& b) {
    asm volatile("s_waitcnt vmcnt(0)" ::: "memory");
    __syncthreads();
    if (threadIdx.x == 0) {
        unsigned* bar = b.bar;
        __builtin_amdgcn_s_waitcnt(0);
        unsigned nloc = b.st[0], nx = b.st[1];
        if (nloc == 0u) { xcd_barrier_complete(bar, b.x, nloc, nx); b.st[0] = nloc; b.st[1] = nx; }
        const unsigned old = xb_add(&bar[XB_XSUB(b.x)], 1u);
        const unsigned gen = old / nloc;
        if (old + 1u == (gen + 1u) * nloc) {
            __builtin_amdgcn_fence(__ATOMIC_RELEASE, "agent");
            asm volatile("s_waitcnt vmcnt(0)" ::: "memory");
            const unsigned og = xb_add(&bar[XB_TOP], 1u);
            const unsigned tg = og / nx;
            if (og + 1u == (tg + 1u) * nx) xb_add(&bar[XB_TOPGEN], 1u);
            else XB_SPIN(xb_ld(&bar[XB_TOPGEN]) == tg, bar);
            __builtin_amdgcn_fence(__ATOMIC_ACQUIRE, "agent");
            xb_add(&bar[XB_XGEN(b.x)], 1u);
            asm volatile("s_waitcnt vmcnt(0)" ::: "memory");
        } else {
            XB_SPIN(xb_ld(&bar[XB_XGEN(b.x)]) == gen, bar);
            __builtin_amdgcn_fence(__ATOMIC_ACQUIRE, "agent");
            asm volatile("s_waitcnt vmcnt(0)" ::: "memory");
        }
    }
    __syncthreads();
}

typedef unsigned short bf16_t;
typedef short bf16x8 __attribute__((ext_vector_type(8)));
typedef short bf16x4 __attribute__((ext_vector_type(4)));
typedef float f32x2 __attribute__((ext_vector_type(2)));
typedef float f32x4 __attribute__((ext_vector_type(4)));
typedef float f32x16 __attribute__((ext_vector_type(16)));
typedef unsigned u32x4 __attribute__((ext_vector_type(4)));
typedef unsigned u32x2 __attribute__((ext_vector_type(2)));

constexpr int D = 2048, FF = 8192, MP = 4096, MS = 8192, MT = 12288;
constexpr int NPANEL = MT / 256;
constexpr size_t MiB = 1u << 20;
constexpr size_t WS_CTL = 0, WS_MOD = 1 * MiB, WS_ZERO_BYTES = 3 * MiB;
constexpr size_t WS_ROPE = 3 * MiB;
constexpr size_t WS_W1T = 4 * MiB, WS_W2T = 132 * MiB, WS_WQKVT = 260 * MiB, WS_WOT = 284 * MiB, WS_HYINT = 300 * MiB, WS_HYOUTT = 324 * MiB;
constexpr size_t WS_RWBT = 332 * MiB, WS_LORA2T = 359 * MiB, WS_RWOT = 364 * MiB, WS_KC = 372 * MiB, WS_VC = 380 * MiB, WS_FGS = 388 * MiB, WS_FGP = 397 * MiB;
constexpr size_t WS_X = 400 * MiB, WS_H = 496 * MiB, WS_ARENA = 544 * MiB, WS_INVSQ = 1186 * MiB, WS_END = 1188 * MiB;
constexpr size_t AR_U = 0;
constexpr size_t AR_Q = 0, AR_K = 48 * MiB, AR_V = 60 * MiB, AR_O = 72 * MiB;
constexpr size_t AR_P = 0, AR_X0 = 144 * MiB, AR_ZT = 192 * MiB, AR_YT = 240 * MiB, AR_HO = 288 * MiB;
constexpr size_t AR_XMIX = 0, AR_LD = 546 * MiB  , AR_LA = 96 * MiB, AR_G = 192 * MiB, AR_RO = 240 * MiB, AR_R = 288 * MiB, AR_KK = 336 * MiB, AR_VV = 384 * MiB, AR_A3 = 432 * MiB, AR_YB = 450 * MiB;
constexpr size_t OUT_Y = 0, OUT_NK = 25165824, OUT_NV = 29360128, OUT_ST = 33554432;
constexpr int FGS_ROW = 2112, FGP_ROW = 576;
constexpr size_t AR_FILT = 600 * MiB;
constexpr int LDS_BAR_OFF = 147456, LDS_BYTES = 147456 + 1024;

enum { I_XP = 0, I_XS, I_CK, I_CV, I_ST, I_C, I_CCTX, I_ADAW, I_ADAB, I_N1G, I_N2G, I_MW1, I_MW2, I_WQKV, I_WO, I_SINK, I_HYWIN, I_HYCW, I_HYCB, I_FW1, I_FB1, I_FW2, I_FB2, I_FW3, I_FB3,
       I_FREQ, I_FWOUT, I_HYBIAS, I_HYWOUT, I_MU, I_WR, I_WK, I_WV, I_RWO, I_W0, I_W1, I_W2, I_A0, I_A1, I_A2, I_G1, I_G2, I_KK, I_KA, I_RK, I_LNW, I_LNB, I_FNG, N_IN };

struct Params { const float* in[N_IN]; float* out; unsigned char* ws; int ph_lo, ph_hi; };

__device__ __forceinline__ unsigned cvt_pk(float lo, float hi) { unsigned r; asm("v_cvt_pk_bf16_f32 %0, %1, %2" : "=v"(r) : "v"(lo), "v"(hi)); return r; }
__device__ __forceinline__ float bflo(unsigned w) { return __uint_as_float(w << 16); }
__device__ __forceinline__ float bfhi(unsigned w) { return __uint_as_float(w & 0xffff0000u); }
__device__ __forceinline__ float bf2f(bf16_t b) { return __uint_as_float(((unsigned)b) << 16); }
__device__ __forceinline__ float dpp_f(float x, const int ctrl) { return x; }
#define DPP_ADD(x, ctrl) ((x) + __int_as_float(__builtin_amdgcn_update_dpp(0, __float_as_int(x), (ctrl), 0xF, 0xF, true)))
__device__ __forceinline__ float wave_sum(float v) {
    v = DPP_ADD(v, 0xB1); v = DPP_ADD(v, 0x4E); v = DPP_ADD(v, 0x141); v = DPP_ADD(v, 0x140);
    const int vi = __float_as_int(v);
    const float r0 = __int_as_float(__builtin_amdgcn_readlane(vi, 0)), r1 = __int_as_float(__builtin_amdgcn_readlane(vi, 16)),
                r2 = __int_as_float(__builtin_amdgcn_readlane(vi, 32)), r3 = __int_as_float(__builtin_amdgcn_readlane(vi, 48));
    return (r0 + r1) + (r2 + r3);
}
__device__ __forceinline__ float opaque_zero() { float z; asm volatile("v_mov_b32 %0, 0" : "=v"(z)); return z; }
__device__ __forceinline__ float fexp2(float x) { return __builtin_amdgcn_exp2f(x); }
__device__ __forceinline__ float fexp(float x) { return __builtin_amdgcn_exp2f(x * 1.4426950408889634f); }
__device__ __forceinline__ float flog(float x) { return __builtin_amdgcn_logf(x) * 0.6931471805599453f; }
__device__ __forceinline__ float frcp(float x) { return __builtin_amdgcn_rcpf(x); }
__device__ __forceinline__ float fsigmoid(float x) { return frcp(1.0f + fexp(-x)); }
__device__ __forceinline__ float ftanh(float x) { const float e = fexp(2.0f * x); return 1.0f - 2.0f * frcp(e + 1.0f); }
__device__ __forceinline__ float fsoftplus(float x) { return fmaxf(x, 0.0f) + flog(1.0f + fexp(-fabsf(x))); }
__device__ __forceinline__ float fsin_rev(float rev) { return __builtin_amdgcn_sinf(rev - rintf(rev)); }
__device__ __forceinline__ float fcos_rev(float rev) { return __builtin_amdgcn_cosf(rev - rintf(rev)); }
__device__ __forceinline__ float fsin(float x) { return fsin_rev(x * 0.15915494309189535f); }
__device__ __forceinline__ int cond_of_row(int m) { return m < MP ? 0 : 1 + ((m - MP) >> 10); }
__device__ __forceinline__ int cond_of_panel(int pm) { return pm < 16 ? 0 : 1 + ((pm - 16) >> 2); }

struct Ctx {
    LAS unsigned char* lds;
    int tid, lane, wave, G, bid;
    float* out;
    unsigned char* ws;
};
template <int IDX> __device__ __forceinline__ const float* karg() {
    unsigned long long v;
    asm volatile("s_load_dwordx2 %0, %1, %2\n\ts_waitcnt lgkmcnt(0)" : "=s"(v) : "s"(__builtin_amdgcn_kernarg_segment_ptr()), "n"(IDX * 8));
    return (const float*)v;
}
#define WSP(T, off) ((T*)(C.ws + (off)))
#define MODP(l, cond, which) (WSP(float, WS_MOD) + ((size_t)((l) * 9 + (cond)) * 6 + (which)) * D)

__device__ __forceinline__ void p0_transpose_item(const float* W, int K, int N, bf16_t* WT, LAS float* scr, int item, int lane) {
    const int nblk = N / 32, kb = item / nblk, nb = item % nblk, k0 = 64 * kb, n0 = 32 * nb;
    const int rsub = lane >> 3, c4 = (lane & 7) * 4;
    f32x4 v[8];
#pragma unroll
    for (int i = 0; i < 8; ++i) v[i] = *(const f32x4*)(W + (size_t)(k0 + 8 * i + rsub) * N + n0 + c4);
#pragma unroll
    for (int i = 0; i < 8; ++i) { LAS float* d = scr + (8 * i + rsub) * 33 + c4; d[0] = v[i].x; d[1] = v[i].y; d[2] = v[i].z; d[3] = v[i].w; }
    asm volatile("s_waitcnt lgkmcnt(0)" ::: "memory");
    const int c = lane & 7;
#pragma unroll
    for (int j = 0; j < 4; ++j) { const int n = (lane >> 3) + 8 * j; const LAS float* s = scr + (8 * c) * 33 + n;
        u32x4 o; o.x = cvt_pk(s[0 * 33], s[1 * 33]); o.y = cvt_pk(s[2 * 33], s[3 * 33]); o.z = cvt_pk(s[4 * 33], s[5 * 33]); o.w = cvt_pk(s[6 * 33], s[7 * 33]);
        *(u32x4*)(WT + (size_t)(n0 + n) * K + k0 + 8 * c) = o; }
    asm volatile("s_waitcnt lgkmcnt(0)" ::: "memory");
}

__device__ __forceinline__ void late_transposes(const Ctx& C, LAS float* scr, int wv, int nwv) {
    constexpr int I_M = 8192, I_QKV = 3072, I_O = 2048;
    constexpr int NIT = 4 * I_M + I_QKV + I_O;
    for (int it = wv; it < NIT; it += nwv) {
        int r = it;
        if (r < 2 * I_M) { const int l = 2 + r / I_M; p0_transpose_item(karg<I_MW1>() + (size_t)l * D * FF, D, FF, WSP(bf16_t, WS_W1T) + (size_t)l * D * FF, scr, r % I_M, C.lane); continue; } r -= 2 * I_M;
        if (r < 2 * I_M) { const int l = 2 + r / I_M; p0_transpose_item(karg<I_MW2>() + (size_t)l * D * FF, FF, D, WSP(bf16_t, WS_W2T) + (size_t)l * D * FF, scr, r % I_M, C.lane); continue; } r -= 2 * I_M;
        if (r < I_QKV) { p0_transpose_item(karg<I_WQKV>() + (size_t)D * 3072, D, 3072, WSP(bf16_t, WS_WQKVT) + (size_t)D * 3072, scr, r, C.lane); continue; } r -= I_QKV;
        p0_transpose_item(karg<I_WO>() + (size_t)D * D, D, D, WSP(bf16_t, WS_WOT) + (size_t)D * D, scr, r, C.lane);
    }
}
#ifndef MK_PRO_MASK
#define MK_PRO_MASK 127
#endif
__device__ __forceinline__ void phase_prologue(const Ctx& C) {
    const int gw = C.bid * 8 + C.wave, NGW = C.G * 8, lane = C.lane;
    const size_t gt = (size_t)C.bid * 512 + C.tid, NGT = (size_t)C.G * 512;
    LAS float* scr = (LAS float*)(C.lds + C.wave * 16384);
    if (MK_PRO_MASK & 1)
    {
        constexpr int I_M1 = 8192, I_M2 = 8192, I_QKV = 3072, I_O = 2048, I_HI = 6144, I_SQ = 2048;
        constexpr int NIT = 2 * I_M1 + 2 * I_M2 + I_QKV + I_O + I_HI + I_SQ + 4 * I_SQ;
        for (int it = gw; it < NIT; it += NGW) {
            int r = it;
            if (r < 2 * I_M1) { const int l = r / I_M1; p0_transpose_item(karg<I_MW1>() + (size_t)l * D * FF, D, FF, WSP(bf16_t, WS_W1T) + (size_t)l * D * FF, scr, r % I_M1, lane); continue; } r -= 2 * I_M1;
            if (r < 2 * I_M2) { const int l = r / I_M2; p0_transpose_item(karg<I_MW2>() + (size_t)l * D * FF, FF, D, WSP(bf16_t, WS_W2T) + (size_t)l * D * FF, scr, r % I_M2, lane); continue; } r -= 2 * I_M2;
            if (r < I_QKV) { p0_transpose_item(karg<I_WQKV>(), D, 3072, WSP(bf16_t, WS_WQKVT), scr, r, lane); continue; } r -= I_QKV;
            if (r < I_O) { p0_transpose_item(karg<I_WO>(), D, D, WSP(bf16_t, WS_WOT), scr, r, lane); continue; } r -= I_O;
            if (r < I_HI) { p0_transpose_item(karg<I_HYWIN>(), D, 6144, WSP(bf16_t, WS_HYINT), scr, r, lane); continue; } r -= I_HI;
            if (r < I_SQ) { p0_transpose_item(karg<I_HYWOUT>(), D, D, WSP(bf16_t, WS_HYOUTT), scr, r, lane); continue; } r -= I_SQ;
            if (r < I_SQ) { p0_transpose_item(karg<I_WR>(), D, D, WSP(bf16_t, WS_RWBT), scr, r, lane); continue; } r -= I_SQ;
            if (r < I_SQ) { p0_transpose_item(karg<I_WK>(), D, D, WSP(bf16_t, WS_RWBT) + (size_t)D * D, scr, r, lane); continue; } r -= I_SQ;
            if (r < I_SQ) { p0_transpose_item(karg<I_WV>(), D, D, WSP(bf16_t, WS_RWBT) + (size_t)2 * D * D, scr, r, lane); continue; } r -= I_SQ;
            p0_transpose_item(karg<I_RWO>(), D, D, WSP(bf16_t, WS_RWOT), scr, r, lane);
        }
    }
    if (MK_PRO_MASK & 2)
    {
        bf16_t* L1 = WSP(bf16_t, WS_RWBT) + (size_t)3 * D * D;
#pragma unroll
        for (int part = 0; part < 7; ++part) {
            const int row0 = part == 0 ? 0 : part == 1 ? 96 : part == 2 ? 192 : part == 3 ? 256 : part == 4 ? 352 : part == 5 ? 448 : 512;
            const int nrow = (part == 2 || part == 5) ? 64 : (part == 6 ? 256 : 96);
            const int ld = part == 6 ? 256 : 96;
            const float* src = part == 0 ? karg<I_W1>() : part == 1 ? karg<I_W1>() + (size_t)D * 96 : part == 3 ? karg<I_A1>() : part == 4 ? karg<I_A1>() + (size_t)D * 96 : karg<I_G1>();
            const bool zero = (part == 2 || part == 5);
            for (size_t i = gt; i < (size_t)nrow * 256; i += NGT) {
                const int rr = (int)(i / 256), k8 = (int)(i % 256);
                float v[8];
#pragma unroll
                for (int j = 0; j < 8; ++j) v[j] = zero ? 0.0f : src[(size_t)(8 * k8 + j) * ld + rr];
                u32x4 o; o.x = cvt_pk(v[0], v[1]); o.y = cvt_pk(v[2], v[3]); o.z = cvt_pk(v[4], v[5]); o.w = cvt_pk(v[6], v[7]);
                *(u32x4*)(L1 + (size_t)(row0 + rr) * D + 8 * k8) = o;
            }
        }
        bf16_t* L2 = WSP(bf16_t, WS_LORA2T);
#pragma unroll
        for (int mat = 0; mat < 5; ++mat) {
            const float* src = mat == 0 ? karg<I_W2>() : mat == 1 ? karg<I_W2>() + (size_t)96 * D : mat == 2 ? karg<I_A2>() : mat == 3 ? karg<I_A2>() + (size_t)96 * D : karg<I_G2>();
            const int kofs = (mat == 1 || mat == 3) ? 96 : 0, klen = mat == 4 ? 256 : 96;
            for (size_t i = gt; i < (size_t)2048 * 32; i += NGT) {
                const int n = (int)(i / 32), k8 = (int)(i % 32);
                float v[8];
#pragma unroll
                for (int j = 0; j < 8; ++j) { const int k = 8 * k8 + j - kofs; const int kc = k < 0 ? 0 : (k >= klen ? klen - 1 : k); const float x = src[(size_t)kc * D + n]; v[j] = (k >= 0 && k < klen) ? x : 0.0f; }
                u32x4 o; o.x = cvt_pk(v[0], v[1]); o.y = cvt_pk(v[2], v[3]); o.z = cvt_pk(v[4], v[5]); o.w = cvt_pk(v[6], v[7]);
                *(u32x4*)(L2 + ((size_t)mat * 2048 + n) * 256 + 8 * k8) = o;
            }
        }
    }
    if (MK_PRO_MASK & 4)
    for (size_t i = gt; i < 2048; i += NGT) {
        const int pos = (int)(i >> 5), fi = (int)(i & 31);
        const float inv = fexp2(-(float)(2 * fi) * (13.287712379549449f / 64.0f));
        const float rev = (float)pos * inv * 0.15915494309189535f;
        WSP(f32x2, WS_ROPE)[i] = (f32x2){fcos_rev(rev), fsin_rev(rev)};
    }
    for (size_t i = gt; i < (size_t)MT * 32 / 4; i += NGT) WSP(f32x4, WS_INVSQ)[i] = (f32x4){0.f, 0.f, 0.f, 0.f};
    if (MK_PRO_MASK & 8)
    { const float *ckp = karg<I_CK>(), *cvp = karg<I_CV>();
    for (size_t i = gt; i < (size_t)2 * 524288; i += NGT) {
        const bool isv = i >= 524288; const size_t e = (isv ? i - 524288 : i) * 8;
        const float* src = (isv ? cvp : ckp) + e;
        const f32x4 a = *(const f32x4*)src, b = *(const f32x4*)(src + 4);
        u32x4 o; o.x = cvt_pk(a.x, a.y); o.y = cvt_pk(a.z, a.w); o.z = cvt_pk(b.x, b.y); o.w = cvt_pk(b.z, b.w);
        *(u32x4*)(WSP(bf16_t, isv ? WS_VC : WS_KC) + e) = o;
    } }
    if (MK_PRO_MASK & 32)
    {
        __syncthreads();
        LAS float* tab = (LAS float*)C.lds;
        LAS float* red = (LAS float*)(C.lds + 73728);
        const float *cctx = karg<I_CCTX>(), *cc = karg<I_C>();
        for (int e = C.tid; e < 9 * D; e += 512) { const int j = e >> 11, k = e & (D - 1);
            const float cv = j == 0 ? cctx[k] : cc[(size_t)(j == 0 ? 0 : j - 1) * D + k]; tab[e] = cv * fsigmoid(cv); }
        __syncthreads();
        const float* adaw = karg<I_ADAW>(); const float* adab = karg<I_ADAB>();
        for (int it = C.bid; it < 4 * 192; it += C.G) {
            const int nb = it % 192, l = it / 192, w = C.wave;
            float acc[9];
#pragma unroll
            for (int j = 0; j < 9; ++j) acc[j] = 0.f;
            const float* wp = adaw + ((size_t)l * D + 256 * w) * (6 * D) + nb * 64 + lane;
#pragma unroll 4
            for (int k4 = 0; k4 < 256; k4 += 4) {
                const float w0 = wp[(size_t)(k4 + 0) * (6 * D)], w1 = wp[(size_t)(k4 + 1) * (6 * D)], w2 = wp[(size_t)(k4 + 2) * (6 * D)], w3 = wp[(size_t)(k4 + 3) * (6 * D)];
#pragma unroll
                for (int j = 0; j < 9; ++j) { const f32x4 sv = *(const LAS f32x4*)(tab + j * D + 256 * w + k4); acc[j] += (w0 * sv.x + w1 * sv.y) + (w2 * sv.z + w3 * sv.w); }
            }
#pragma unroll
            for (int j = 0; j < 9; ++j) red[(w * 9 + j) * 64 + lane] = acc[j];
            __syncthreads();
            for (int e = C.tid; e < 9 * 64; e += 512) { const int j = e >> 6, c = e & 63; float sum = adab[(size_t)l * 6 * D + nb * 64 + c];
#pragma unroll
                for (int ww = 0; ww < 8; ++ww) sum += red[(ww * 9 + j) * 64 + c];
                WSP(float, WS_MOD)[((size_t)l * 9 + j) * 6 * D + nb * 64 + c] = sum; }
            __syncthreads();
        }
    }
    if (MK_PRO_MASK & 64)
    {
        const float *fw1 = karg<I_FW1>(), *fw2 = karg<I_FW2>(), *fw3 = karg<I_FW3>(), *fwout = karg<I_FWOUT>(), *hbias = karg<I_HYBIAS>();
        const float fq = karg<I_FREQ>()[lane]; const float fb1 = karg<I_FB1>()[lane], fb2 = karg<I_FB2>()[lane], fb3 = karg<I_FB3>()[lane];
        for (int it = C.bid; it < 160; it += C.G) {
            const bool smp = it >= 32; const int nbase = (smp ? it - 32 : it) * 8; const int L = smp ? 1024 : 256; const int n = nbase + C.wave;
            float* FILT = WSP(float, WS_ARENA + AR_FILT) + (smp ? 0 : (size_t)1024 * 4096);
            __syncthreads();
            if (lane < 33) {
                float z;
                if (lane == 0) z = (float)n / (float)(L - 1);
                else { const int i = (lane - 1) & 15; const float fr = 1e-4f + (float)i * ((15.0f - 1e-4f) / 15.0f); const float rev = fr * (float)n / (float)L;
                       z = lane <= 16 ? fcos_rev(rev) : -fsin_rev(rev); }
                scr[lane] = z;
            }
            asm volatile("s_waitcnt lgkmcnt(0)" ::: "memory");
            float pre = fb1;
#pragma unroll 3
            for (int e = 0; e < 33; ++e) pre += scr[e] * fw1[e * 64 + lane];
            float hv = fsin(fq * pre);
            asm volatile("s_waitcnt lgkmcnt(0)" ::: "memory");
            scr[64 + lane] = hv;
            asm volatile("s_waitcnt lgkmcnt(0)" ::: "memory");
            pre = fb2;
#pragma unroll 4
            for (int e = 0; e < 64; ++e) pre += scr[64 + e] * fw2[e * 64 + lane];
            hv = fsin(fq * pre);
            asm volatile("s_waitcnt lgkmcnt(0)" ::: "memory");
            scr[128 + lane] = hv;
            asm volatile("s_waitcnt lgkmcnt(0)" ::: "memory");
            pre = fb3;
#pragma unroll 4
            for (int e = 0; e < 64; ++e) pre += scr[128 + e] * fw3[e * 64 + lane];
            hv = fsin(fq * pre);
            scr[1024 + lane] = hv;
            __syncthreads();
            float acc[8][8];
#pragma unroll
            for (int nn = 0; nn < 8; ++nn)
#pragma unroll
                for (int i = 0; i < 8; ++i) acc[nn][i] = 0.f;
            const float* wo = fwout + 512 * C.wave + lane;
#pragma unroll 2
            for (int e = 0; e < 64; ++e) {
                float wv[8];
#pragma unroll
                for (int i = 0; i < 8; ++i) wv[i] = wo[(size_t)e * 4096 + i * 64];
#pragma unroll
                for (int nn = 0; nn < 8; ++nn) { const float hh = ((const LAS float*)(C.lds + nn * 16384))[1024 + e];
#pragma unroll
                    for (int i = 0; i < 8; ++i) acc[nn][i] += hh * wv[i]; }
            }
#pragma unroll
            for (int nn = 0; nn < 8; ++nn) { const int n2 = nbase + nn; const float tn = (float)n2 / (float)(L - 1);
#pragma unroll
                for (int i = 0; i < 8; ++i) {
                    const int o = 512 * C.wave + i * 64 + lane, dir = o >> 11, c = o & 2047;
                    const float delta = -3.0701134573253944f + (float)c * ((-15.350567286626972f + 3.0701134573253944f) / 2047.0f);
                    float val = acc[nn][i] * fexp(-tn * fabsf(delta));
                    if (dir == 0 && n2 == 0) val += hbias[c];
                    FILT[(size_t)n2 * 4096 + o] = val;
                } }
        }
        __syncthreads();
    }
}

__device__ __forceinline__ void phase_fg_transpose(const Ctx& C) {
    const int tid = C.tid;
    LAS float* tl = (LAS float*)C.lds;
    for (int it = C.bid; it < 1280; it += C.G) {
        const bool smp = it < 1024; const int q = smp ? it : it - 1024;
        const int L = smp ? 1024 : 256, ROW = smp ? FGS_ROW : FGP_ROW;
        const int cbk = q & 31, nb = smp ? (q >> 5) & 15 : (q >> 5) & 3, dir = smp ? q >> 9 : q >> 7;
        const float* FILT = WSP(float, WS_ARENA + AR_FILT) + (smp ? 0 : (size_t)1024 * 4096);
        bf16_t* FG = WSP(bf16_t, smp ? WS_FGS : WS_FGP);
        const int n0 = nb * 64 + dir;
        __syncthreads();
        { const int nl = tid >> 3, c8 = tid & 7; const int n = n0 + nl;
          f32x4 a = (f32x4){0.f, 0.f, 0.f, 0.f}, b = a;
          const int nc = n < L ? n : L - 1;
          const float* src = FILT + (size_t)nc * 4096 + dir * 2048 + cbk * 64 + 8 * c8;
          a = *(const f32x4*)src; b = *(const f32x4*)(src + 4);
          if (n >= L) { a = (f32x4){0.f, 0.f, 0.f, 0.f}; b = a; }
          LAS float* d = tl + nl * 65 + 8 * c8;
          d[0] = a.x; d[1] = a.y; d[2] = a.z; d[3] = a.w; d[4] = b.x; d[5] = b.y; d[6] = b.z; d[7] = b.w; }
        __syncthreads();
        { const int cl = tid >> 3, i8 = tid & 7;
          float v[8];
#pragma unroll
          for (int j = 0; j < 8; ++j) { const int il = 8 * i8 + j; const int nl = dir ? il : 63 - il; v[j] = tl[nl * 65 + cl]; }
          const int idx0 = dir ? (L + nb * 64) : (L - 64 - nb * 64);
          u32x4 o; o.x = cvt_pk(v[0], v[1]); o.y = cvt_pk(v[2], v[3]); o.z = cvt_pk(v[4], v[5]); o.w = cvt_pk(v[6], v[7]);
          bf16_t* dst = FG + (size_t)(cbk * 64 + cl) * ROW;
          *(u32x4*)(dst + idx0 + 8 * i8) = o;
          if (dir && nb * 64 + 64 == L) *(u32x4*)(dst + 2 * L + 8 * i8) = (u32x4){0u, 0u, 0u, 0u}; }
    }
    __syncthreads();
}

__device__ __forceinline__ void phase_norm_mod(const Ctx& C, const float* Xp, const float* Xs, const float* g, int layer, int which_sh, bf16_t* H, const bf16_t* P1 = nullptr, float* Xw = nullptr) {
    const int gw = C.bid * 8 + C.wave, NGW = C.G * 8, lane = C.lane;
    for (int m = gw; m < MT; m += NGW) {
        const int cond = cond_of_row(m);
        const float* sh = MODP(layer, cond, which_sh); const float* sc = MODP(layer, cond, which_sh + 1);
        const f32x4* xr = (const f32x4*)(m < MP ? Xp + (size_t)m * D : Xs + (size_t)(m - MP) * D) + lane;
        f32x4 v[8]; float ss = 0.f;
#pragma unroll
        for (int j = 0; j < 8; ++j) { v[j] = xr[64 * j]; if (P1) { const u32x2 pw = ((const u32x2*)(P1 + (size_t)m * D) + lane)[64 * j]; v[j] += (f32x4){bflo(pw.x), bfhi(pw.x), bflo(pw.y), bfhi(pw.y)}; ((f32x4*)(Xw + (size_t)m * D) + lane)[64 * j] = v[j]; }
            ss += (v[j].x * v[j].x + v[j].y * v[j].y) + (v[j].z * v[j].z + v[j].w * v[j].w); }
        const float rstd = __builtin_amdgcn_rsqf(wave_sum(ss) * (1.0f / D) + 1e-6f);
        u32x2* o = (u32x2*)(H + (size_t)m * D) + lane;
#pragma unroll
        for (int j = 0; j < 8; ++j) {
            const f32x4 gv = ((const f32x4*)g)[lane + 64 * j], sv = ((const f32x4*)sh)[lane + 64 * j], cv = ((const f32x4*)sc)[lane + 64 * j];
            const f32x4 y = (v[j] * rstd * gv) * (cv + 1.0f) + sv;
            u32x2 w; w.x = cvt_pk(y.x, y.y); w.y = cvt_pk(y.z, y.w); o[64 * j] = w;
        }
    }
}
__device__ __forceinline__ void phase_norm_final(const Ctx& C, const float* X, const float* g, float* out, const bf16_t* P1 = nullptr) {
    const int gw = C.bid * 8 + C.wave, NGW = C.G * 8, lane = C.lane;
    for (int m = gw; m < MT; m += NGW) {
        const f32x4* xr = (const f32x4*)(X + (size_t)m * D) + lane;
        f32x4 v[8]; float ss = 0.f;
#pragma unroll
        for (int j = 0; j < 8; ++j) { v[j] = xr[64 * j]; if (P1) { const u32x2 pw = ((const u32x2*)(P1 + (size_t)m * D) + lane)[64 * j]; v[j] += (f32x4){bflo(pw.x), bfhi(pw.x), bflo(pw.y), bfhi(pw.y)}; } ss += (v[j].x * v[j].x + v[j].y * v[j].y) + (v[j].z * v[j].z + v[j].w * v[j].w); }
        const float rstd = __builtin_amdgcn_rsqf(wave_sum(ss) * (1.0f / D) + 1e-6f);
        f32x4* o = (f32x4*)(out + (size_t)m * D) + lane;
#pragma unroll
        for (int j = 0; j < 8; ++j) o[64 * j] = v[j] * rstd * ((const f32x4*)g)[lane + 64 * j];
    }
}

__device__ __forceinline__ void unpack8(const u32x4 w, float (&f)[8]) { f[0] = bflo(w.x); f[1] = bfhi(w.x); f[2] = bflo(w.y); f[3] = bfhi(w.y); f[4] = bflo(w.z); f[5] = bfhi(w.z); f[6] = bflo(w.w); f[7] = bfhi(w.w); }
__device__ __forceinline__ u32x4 pack8(const float (&f)[8]) { u32x4 o; o.x = cvt_pk(f[0], f[1]); o.y = cvt_pk(f[2], f[3]); o.z = cvt_pk(f[4], f[5]); o.w = cvt_pk(f[6], f[7]); return o; }
__device__ __forceinline__ void phase_norm_mod_b(const Ctx& C, const bf16_t* X, const float* g, int layer, int which_sh, bf16_t* H, const bf16_t* P1 = nullptr, bf16_t* Xw = nullptr, int p1_row0 = 0) {
    const int gw = C.bid * 8 + C.wave, NGW = C.G * 8, lane = C.lane;
    f32x4 gv[4][2];
#pragma unroll
    for (int j = 0; j < 4; ++j)
#pragma unroll
        for (int h = 0; h < 2; ++h) gv[j][h] = ((const f32x4*)g)[2 * (lane + 64 * j) + h];
    u32x4 xa[4], pa[4]; f32x4 sv[4][2], cv[4][2];
#define NM_LOAD(m_) do { const int cond_ = cond_of_row(m_); const f32x4* sh_ = (const f32x4*)MODP(layer, cond_, which_sh); const f32x4* sc_ = (const f32x4*)MODP(layer, cond_, which_sh + 1); \
        _Pragma("unroll") for (int j = 0; j < 4; ++j) { xa[j] = ((const u32x4*)(X + (size_t)(m_) * D) + lane)[64 * j]; if (P1 && (m_) >= p1_row0) pa[j] = ((const u32x4*)(P1 + (size_t)(m_) * D) + lane)[64 * j]; } \
        _Pragma("unroll") for (int j = 0; j < 4; ++j) { _Pragma("unroll") for (int h = 0; h < 2; ++h) { const int ci_ = 2 * (lane + 64 * j) + h; sv[j][h] = sh_[ci_]; cv[j][h] = sc_[ci_]; } } } while (0)
    int m = gw;
    if (m < MT) NM_LOAD(m);
    for (; m < MT; m += NGW) {
        const bool fold = P1 && m >= p1_row0;
        float v[4][8]; float ss = 0.f;
#pragma unroll
        for (int j = 0; j < 4; ++j) {
            unpack8(xa[j], v[j]);
            if (fold) { float p[8]; unpack8(pa[j], p);
#pragma unroll
                for (int e = 0; e < 8; ++e) v[j][e] += p[e]; }
#pragma unroll
            for (int e = 0; e < 8; ++e) ss += v[j][e] * v[j][e];
        }
        const float rstd = __builtin_amdgcn_rsqf(wave_sum(ss) * (1.0f / D) + 1e-6f);
        u32x4 xo[4], ho[4];
#pragma unroll
        for (int j = 0; j < 4; ++j) {
            if (fold) xo[j] = pack8(v[j]);
            float y[8];
#pragma unroll
            for (int h = 0; h < 2; ++h)
#pragma unroll
                for (int e = 0; e < 4; ++e) y[4 * h + e] = (v[j][4 * h + e] * rstd * gv[j][h][e]) * (cv[j][h][e] + 1.0f) + sv[j][h][e];
            ho[j] = pack8(y);
        }
        const int mn = m + NGW;
        if (mn < MT) NM_LOAD(mn);
        asm volatile("" ::: "memory");
#pragma unroll
        for (int j = 0; j < 4; ++j) { if (fold) ((u32x4*)(Xw + (size_t)m * D) + lane)[64 * j] = xo[j]; ((u32x4*)(H + (size_t)m * D) + lane)[64 * j] = ho[j]; }
    }
#undef NM_LOAD
}
__device__ __forceinline__ void phase_norm_final_b(const Ctx& C, const bf16_t* X, const float* g, float* out, const bf16_t* P1 = nullptr, int p1_row0 = 0) {
    const int gw = C.bid * 8 + C.wave, NGW = C.G * 8, lane = C.lane;
    for (int m = gw; m < MT; m += NGW) {
        const u32x4* xr = (const u32x4*)(X + (size_t)m * D) + lane;
        float v[4][8]; float ss = 0.f;
#pragma unroll
        for (int j = 0; j < 4; ++j) {
            unpack8(xr[64 * j], v[j]);
            if (P1 && m >= p1_row0) { float p[8]; unpack8(((const u32x4*)(P1 + (size_t)m * D) + lane)[64 * j], p);
#pragma unroll
                for (int e = 0; e < 8; ++e) v[j][e] += p[e]; }
#pragma unroll
            for (int e = 0; e < 8; ++e) ss += v[j][e] * v[j][e];
        }
        const float rstd = __builtin_amdgcn_rsqf(wave_sum(ss) * (1.0f / D) + 1e-6f);
        f32x4* o = (f32x4*)(out + (size_t)m * D);
#pragma unroll
        for (int j = 0; j < 4; ++j)
#pragma unroll
            for (int h = 0; h < 2; ++h) {
                const int ci = 2 * (lane + 64 * j) + h;
                const f32x4 gv = ((const f32x4*)g)[ci];
                f32x4 y;
#pragma unroll
                for (int e = 0; e < 4; ++e) y[e] = v[j][4 * h + e] * rstd * gv[e];
                o[ci] = y;
            }
    }
}

using pg8::Unit;
constexpr int HALF = 128;

struct EpiResidual {
    static constexpr bool PERM = false, AFTER_DRAIN = false;
    float* X; const float* gate_base;
    const float *Bp, *Bs;
    __device__ __forceinline__ void operator()(const f32x4 (&acc)[2][2][4][2], const Unit& u, int wr, int wc, int fr, int fq) const {
        const int row0 = u.pm * 256 + wr * 64 + fr, col0 = u.pn * 256 + wc * 32 + 4 * fq;
        const float* gp = gate_base + (size_t)cond_of_panel(u.pm) * 6 * D + col0;
        f32x4 gv[2][2];
#pragma unroll
        for (int bj = 0; bj < 2; ++bj)
#pragma unroll
            for (int n = 0; n < 2; ++n) gv[bj][n] = *(const f32x4*)(gp + bj * HALF + n * 16);
        const float* sbase = (u.pm < 16 ? Bp + (size_t)row0 * D : Bs + (size_t)(row0 - MP) * D) + col0;
#pragma unroll
        for (int ai = 0; ai < 2; ++ai) {
            f32x4 q[4][2][2];
#pragma unroll
            for (int m = 0; m < 4; ++m)
#pragma unroll
                for (int bj = 0; bj < 2; ++bj)
#pragma unroll
                    for (int n = 0; n < 2; ++n) if ((u.mask >> (ai * 2 + bj)) & 1) q[m][bj][n] = *(const f32x4*)(sbase + (size_t)(ai * HALF + m * 16) * D + bj * HALF + n * 16);
#pragma unroll
            for (int m = 0; m < 4; ++m) { float* rowp = X + (size_t)(row0 + ai * HALF + m * 16) * D + col0;
#pragma unroll
                for (int bj = 0; bj < 2; ++bj)
#pragma unroll
                    for (int n = 0; n < 2; ++n) if ((u.mask >> (ai * 2 + bj)) & 1) *(f32x4*)(rowp + bj * HALF + n * 16) = q[m][bj][n] + gv[bj][n] * acc[ai][bj][m][n]; }
            asm volatile("" ::: "memory");
        }
    }
};
template <int ACT> struct EpiBf16 {
    static constexpr bool PERM = true, AFTER_DRAIN = false;
    bf16_t* O; int ldc;
    __device__ __forceinline__ void operator()(const f32x4 (&acc)[2][2][4][2], const Unit& u, int wr, int wc, int fr, int fq) const {
        const int row0 = u.pm * 256 + wr * 64 + fr, col0 = u.pn * 256 + wc * 32 + 8 * fq;
#pragma unroll
        for (int ai = 0; ai < 2; ++ai)
#pragma unroll
            for (int m = 0; m < 4; ++m) { bf16_t* rowp = O + (size_t)(row0 + ai * HALF + m * 16) * ldc + col0;
#pragma unroll
                for (int bj = 0; bj < 2; ++bj) { if (!((u.mask >> (ai * 2 + bj)) & 1)) continue; f32x4 v0 = acc[ai][bj][m][0], v1 = acc[ai][bj][m][1];
                    if (ACT == 1) {
#pragma unroll
                        for (int j = 0; j < 4; ++j) { const float a = fmaxf(v0[j], 0.f), b = fmaxf(v1[j], 0.f); v0[j] = a * a; v1[j] = b * b; } }
                    u32x4 w; w.x = cvt_pk(v0[0], v0[1]); w.y = cvt_pk(v0[2], v0[3]); w.z = cvt_pk(v1[0], v1[1]); w.w = cvt_pk(v1[2], v1[3]);
                    *(u32x4*)(rowp + bj * HALF) = w; } }
    }
};
struct EpiQKV {
    static constexpr bool PERM = true, AFTER_DRAIN = false;
    bf16_t *Q, *K, *V; float *NK, *NV;
    __device__ __forceinline__ void operator()(const f32x4 (&acc)[2][2][4][2], const Unit& u, int wr, int wc, int fr, int fq) const {
        const int row0 = u.pm * 256 + wr * 64 + fr; const int cin = wc * 32 + 8 * fq;
        bf16_t* base; int ldc, colt; float* fo = nullptr;
        if (u.pn < 8) { base = Q; ldc = 2048; colt = u.pn * 256; }
        else if (u.pn < 10) { base = K; ldc = 512; colt = (u.pn - 8) * 256; if (u.pm < 16) fo = NK; }
        else { base = V; ldc = 512; colt = (u.pn - 10) * 256; if (u.pm < 16) fo = NV; }
#pragma unroll
        for (int ai = 0; ai < 2; ++ai)
#pragma unroll
            for (int m = 0; m < 4; ++m) { const int r = row0 + ai * HALF + m * 16; bf16_t* rowp = base + (size_t)r * ldc + colt + cin;
#pragma unroll
                for (int bj = 0; bj < 2; ++bj) { if (!((u.mask >> (ai * 2 + bj)) & 1)) continue; const f32x4 v0 = acc[ai][bj][m][0], v1 = acc[ai][bj][m][1];
                    u32x4 w; w.x = cvt_pk(v0[0], v0[1]); w.y = cvt_pk(v0[2], v0[3]); w.z = cvt_pk(v1[0], v1[1]); w.w = cvt_pk(v1[2], v1[3]);
                    *(u32x4*)(rowp + bj * HALF) = w;
                    if (fo) { float* fp = fo + ((size_t)(r >> 8) * 512 + (r & 255)) * 512 + colt + cin + bj * HALF; *(f32x4*)fp = v0; *(f32x4*)(fp + 4) = v1; } } }
    }
};
__device__ __forceinline__ size_t hm_index(int m, int c) { return ((size_t)(c >> 6) * MT + m) * 64 + (c & 63); }
struct EpiRw1 {
    static constexpr bool PERM = true, AFTER_DRAIN = false;
    bf16_t *R, *A3;
    const float* k_k; float* invsq;
    __device__ __forceinline__ void operator()(const f32x4 (&acc)[2][2][4][2], const Unit& u, int wr, int wc, int fr, int fq) const {
        const int ct = u.pn, panel = u.pm % NPANEL;
        const int row0 = panel * 256 + wr * 64 + fr; const int cin = wc * 32 + 8 * fq;
        bf16_t* base; int ldc, colt, act = 0;
        if (ct < 24) { base = R + (size_t)(ct >> 3) * MT * D; ldc = D; colt = (ct & 7) * 256; }
        else { base = A3 + (size_t)(ct - 24) * MT * 256; ldc = 256; colt = 0; act = ct - 23; }
#pragma unroll
        for (int ai = 0; ai < 2; ++ai)
#pragma unroll
            for (int m = 0; m < 4; ++m) { const int rrow = row0 + ai * HALF + m * 16; bf16_t* rowp = base + (size_t)rrow * ldc + colt + cin;
#pragma unroll
                for (int bj = 0; bj < 2; ++bj) { if (!((u.mask >> (ai * 2 + bj)) & 1)) continue; f32x4 v0 = acc[ai][bj][m][0], v1 = acc[ai][bj][m][1];
                    if (act == 1) {
#pragma unroll
                        for (int j = 0; j < 4; ++j) { v0[j] = ftanh(v0[j]); v1[j] = ftanh(v1[j]); } }
                    else if (act == 3) {
#pragma unroll
                        for (int j = 0; j < 4; ++j) { v0[j] = fsigmoid(v0[j]); v1[j] = fsigmoid(v1[j]); } }
                    u32x4 w; w.x = cvt_pk(v0[0], v0[1]); w.y = cvt_pk(v0[2], v0[3]); w.z = cvt_pk(v1[0], v1[1]); w.w = cvt_pk(v1[2], v1[3]);
                    if (ct < 24) *(u32x4*)(base + hm_index(rrow, colt + cin + bj * HALF)) = w; else *(u32x4*)(rowp + bj * HALF) = w;
} }
    }
};
struct EpiRw2 {
    static constexpr bool PERM = true, AFTER_DRAIN = false;
    bf16_t *LD, *LA, *Gt; const float *w0, *a0;
    __device__ __forceinline__ void operator()(const f32x4 (&acc)[2][2][4][2], const Unit& u, int wr, int wc, int fr, int fq) const {
        const int ct = u.pn, panel = u.pm % NPANEL, grp = ct >> 3;
        const int row0 = panel * 256 + wr * 64 + fr; const int col0 = (ct & 7) * 256 + wc * 32 + 8 * fq;
        bf16_t* base; const float* bias = nullptr;
        if (grp < 2) { base = LD + (size_t)grp * MT * D; bias = w0 + grp * D; }
        else if (grp < 4) { base = LA + (size_t)(grp - 2) * MT * D; bias = a0 + (grp - 2) * D; }
        else base = Gt;
        f32x4 bv[2][2];
#pragma unroll
        for (int bj = 0; bj < 2; ++bj)
#pragma unroll
            for (int n = 0; n < 2; ++n) bv[bj][n] = bias ? *(const f32x4*)(bias + col0 + bj * HALF + 4 * n) : (f32x4){0.f, 0.f, 0.f, 0.f};
#pragma unroll
        for (int ai = 0; ai < 2; ++ai)
#pragma unroll
            for (int m = 0; m < 4; ++m) { const int rrow = row0 + ai * HALF + m * 16; bf16_t* rowp = base + (size_t)rrow * D + col0;
#pragma unroll
                for (int bj = 0; bj < 2; ++bj) {
                    f32x4 v0 = acc[ai][bj][m][0] + bv[bj][0], v1 = acc[ai][bj][m][1] + bv[bj][1];
                    if (grp < 2) {
#pragma unroll
                        for (int j = 0; j < 4; ++j) { v0[j] = -fexp(-fsoftplus(-v0[j]) - 0.5f); v1[j] = -fexp(-fsoftplus(-v1[j]) - 0.5f); } }
                    u32x4 w; w.x = cvt_pk(v0[0], v0[1]); w.y = cvt_pk(v0[2], v0[3]); w.z = cvt_pk(v1[0], v1[1]); w.w = cvt_pk(v1[2], v1[3]);
                    if (grp < 4) *(u32x4*)(base + hm_index(rrow, col0 + bj * HALF)) = w; else *(u32x4*)(rowp + bj * HALF) = w; }
                asm volatile("" : "+v"(bv[0][0]), "+v"(bv[0][1]), "+v"(bv[1][0]), "+v"(bv[1][1]));
            }
    }
};
struct RwOrder1 {
    int G, c, lo, hi; bool xcd;
    __device__ __forceinline__ bool next(int i, Unit& u) const { const int L = lo + i * G + c; if (L >= hi) return false; u.mask = 15;
        int panel, ct;
        if (xcd) {
            if (L < 1280) {
                const int cc = L & 255, T = (((L >> 8) * 8 + (cc & 7)) << 5) + (cc >> 3);
                if (T < 1056) { const int blk = T >> 5, j = T & 31, pq = blk / 3, g = blk - 3 * pq; panel = pq * 4 + (j >> 3); ct = g * 8 + (j & 7); }
                else if (T < 1120) { const int blk = (T - 1056) >> 5, j = T & 31; panel = 44 + (j >> 3); ct = (1 + blk) * 8 + (j & 7); }
                else { const int U = T - 1120; if (U < 16) { panel = 44 + (U >> 3); ct = U & 7; } else { const int q = U - 16; panel = q / 3; ct = 24 + q - 3 * panel; } }
            } else { const int q = L - 1280; panel = 46 + (q >> 3); ct = q & 7; }
        } else { panel = L / 27; ct = L % 27; }
        const int ai = ct < 24 ? (ct >> 3) : ct - 21; u.pm = ai * NPANEL + panel; u.pn = ct; u.kh = 0; return true; }
    __device__ __forceinline__ void a_ready(const Unit&) const {}
    __device__ __forceinline__ void done(const Unit&) const {}
};
struct RwOrder2 {
    int G, c; unsigned* cnt; unsigned need;
    __device__ __forceinline__ bool next(int i, Unit& u) const { const int L = i * G + c; if (L >= 40 * NPANEL) return false; const int panel = L / 40, ct = L % 40; const int ai = ct < 16 ? 0 : (ct < 32 ? 1 : 2); u.pm = ai * NPANEL + panel; u.pn = ct; u.kh = 0; u.mask = 15; return true; }
    __device__ __forceinline__ void a_ready(const Unit& u) const {
        if (cnt && (u.pm % NPANEL) == NPANEL - 1) {
            unsigned sp = 0u;
            while (xb_ld(cnt) < need) { __builtin_amdgcn_s_sleep(2); if (++sp > (1u << 24)) break; }
            __builtin_amdgcn_fence(__ATOMIC_ACQUIRE, "agent");
            asm volatile("s_waitcnt vmcnt(0)" ::: "memory");
        }
    }
    __device__ __forceinline__ void done(const Unit&) const {}
};

struct SplitOrder {
    pg8::StaticOrder so; int G, c, ntiles;
    __device__ __forceinline__ void init(int N, int G_, int c_) { so.init(MT, N, G_, c_); G = G_; c = c_; ntiles = so.nwg; }
    __device__ __forceinline__ bool next(int i, Unit& u) const { const int L = i * G + c; if (L >= 2 * ntiles) return false; const int kh = L >= ntiles; so.map(kh ? L - ntiles : L, u); u.kh = kh; u.mask = 15; return true; }
    __device__ __forceinline__ void a_ready(const Unit&) const {}
    __device__ __forceinline__ void done(const Unit&) const {}
};
struct EpiResidualSplit {
    static constexpr bool PERM = false, AFTER_DRAIN = false;
    float* X; const float* gate_base; bf16_t* P1;
    __device__ __forceinline__ void operator()(const f32x4 (&acc)[2][2][4][2], const Unit& u, int wr, int wc, int fr, int fq) const {
        const int row0 = u.pm * 256 + wr * 64 + fr, col0 = u.pn * 256 + wc * 32 + 4 * fq;
        const float* gp = gate_base + (size_t)cond_of_panel(u.pm) * 6 * D + col0;
        f32x4 gv[2][2];
#pragma unroll
        for (int bj = 0; bj < 2; ++bj)
#pragma unroll
            for (int n = 0; n < 2; ++n) gv[bj][n] = *(const f32x4*)(gp + bj * HALF + n * 16);
        if (u.kh == 0) {
#pragma unroll
            for (int ai = 0; ai < 2; ++ai) {
                f32x4 q[4][2][2];
#pragma unroll
                for (int m = 0; m < 4; ++m)
#pragma unroll
                    for (int bj = 0; bj < 2; ++bj)
#pragma unroll
                        for (int n = 0; n < 2; ++n) q[m][bj][n] = *(const f32x4*)(X + (size_t)(row0 + ai * HALF + m * 16) * D + col0 + bj * HALF + n * 16);
#pragma unroll
                for (int m = 0; m < 4; ++m) { float* rowp = X + (size_t)(row0 + ai * HALF + m * 16) * D + col0;
#pragma unroll
                    for (int bj = 0; bj < 2; ++bj)
#pragma unroll
                        for (int n = 0; n < 2; ++n) *(f32x4*)(rowp + bj * HALF + n * 16) = q[m][bj][n] + gv[bj][n] * acc[ai][bj][m][n]; }
                asm volatile("" ::: "memory");
            }
        } else {
#pragma unroll
            for (int ai = 0; ai < 2; ++ai)
#pragma unroll
                for (int m = 0; m < 4; ++m) { bf16_t* rowp = P1 + (size_t)(row0 + ai * HALF + m * 16) * D + col0;
#pragma unroll
                    for (int bj = 0; bj < 2; ++bj)
#pragma unroll
                        for (int n = 0; n < 2; ++n) { const f32x4 v = gv[bj][n] * acc[ai][bj][m][n]; u32x2 w; w.x = cvt_pk(v.x, v.y); w.y = cvt_pk(v.z, v.w); *(u32x2*)(rowp + bj * HALF + n * 16) = w; } }
        }
    }
};

template <bool SRCF32> struct EpiResidualB {
    static constexpr bool PERM = true, AFTER_DRAIN = false;
    bf16_t* X; const float* gate_base; const float *Bp, *Bs;
    __device__ __forceinline__ void operator()(const f32x4 (&acc)[2][2][4][2], const Unit& u, int wr, int wc, int fr, int fq) const {
        const int row0 = u.pm * 256 + wr * 64 + fr, col0 = u.pn * 256 + wc * 32 + 8 * fq;
        const float* gp = gate_base + (size_t)cond_of_panel(u.pm) * 6 * D + col0;
        f32x4 gv[2][2];
#pragma unroll
        for (int bj = 0; bj < 2; ++bj)
#pragma unroll
            for (int n = 0; n < 2; ++n) gv[bj][n] = *(const f32x4*)(gp + bj * HALF + 4 * n);
#pragma unroll
        for (int ai = 0; ai < 2; ++ai) {
            if constexpr (SRCF32) {
                const float* sbase = (u.pm < 16 ? Bp + (size_t)row0 * D : Bs + (size_t)(row0 - MP) * D) + col0;
                f32x4 q[4][2][2];
#pragma unroll
                for (int m = 0; m < 4; ++m)
#pragma unroll
                    for (int bj = 0; bj < 2; ++bj)
#pragma unroll
                        for (int n = 0; n < 2; ++n) q[m][bj][n] = *(const f32x4*)(sbase + (size_t)(ai * HALF + m * 16) * D + bj * HALF + 4 * n);
#pragma unroll
                for (int m = 0; m < 4; ++m) { bf16_t* rowp = X + (size_t)(row0 + ai * HALF + m * 16) * D + col0;
#pragma unroll
                    for (int bj = 0; bj < 2; ++bj) { const f32x4 v0 = q[m][bj][0] + gv[bj][0] * acc[ai][bj][m][0], v1 = q[m][bj][1] + gv[bj][1] * acc[ai][bj][m][1];
                        u32x4 w; w.x = cvt_pk(v0.x, v0.y); w.y = cvt_pk(v0.z, v0.w); w.z = cvt_pk(v1.x, v1.y); w.w = cvt_pk(v1.z, v1.w); *(u32x4*)(rowp + bj * HALF) = w; } }
            } else {
                u32x4 q[4][2];
#pragma unroll
                for (int m = 0; m < 4; ++m)
#pragma unroll
                    for (int bj = 0; bj < 2; ++bj) q[m][bj] = *(const u32x4*)(X + (size_t)(row0 + ai * HALF + m * 16) * D + col0 + bj * HALF);
#pragma unroll
                for (int m = 0; m < 4; ++m) { bf16_t* rowp = X + (size_t)(row0 + ai * HALF + m * 16) * D + col0;
#pragma unroll
                    for (int bj = 0; bj < 2; ++bj) { const u32x4 o = q[m][bj];
                        const f32x4 v0 = (f32x4){bflo(o.x), bfhi(o.x), bflo(o.y), bfhi(o.y)} + gv[bj][0] * acc[ai][bj][m][0], v1 = (f32x4){bflo(o.z), bfhi(o.z), bflo(o.w), bfhi(o.w)} + gv[bj][1] * acc[ai][bj][m][1];
                        u32x4 w; w.x = cvt_pk(v0.x, v0.y); w.y = cvt_pk(v0.z, v0.w); w.z = cvt_pk(v1.x, v1.y); w.w = cvt_pk(v1.z, v1.w); *(u32x4*)(rowp + bj * HALF) = w; } }
            }
            asm volatile("" ::: "memory");
        }
    }
};
struct EpiResidualSplitB {
    static constexpr bool PERM = true, AFTER_DRAIN = false;
    bf16_t* X; const float* gate_base; bf16_t* P1;
    __device__ __forceinline__ void operator()(const f32x4 (&acc)[2][2][4][2], const Unit& u, int wr, int wc, int fr, int fq) const {
        const int row0 = u.pm * 256 + wr * 64 + fr, col0 = u.pn * 256 + wc * 32 + 8 * fq;
        const float* gp = gate_base + (size_t)cond_of_panel(u.pm) * 6 * D + col0;
        f32x4 gv[2][2];
#pragma unroll
        for (int bj = 0; bj < 2; ++bj)
#pragma unroll
            for (int n = 0; n < 2; ++n) gv[bj][n] = *(const f32x4*)(gp + bj * HALF + 4 * n);
        if (u.kh == 0) {
#pragma unroll
            for (int ai = 0; ai < 2; ++ai) {
                u32x4 q[4][2];
#pragma unroll
                for (int m = 0; m < 4; ++m)
#pragma unroll
                    for (int bj = 0; bj < 2; ++bj) q[m][bj] = *(const u32x4*)(X + (size_t)(row0 + ai * HALF + m * 16) * D + col0 + bj * HALF);
#pragma unroll
                for (int m = 0; m < 4; ++m) { bf16_t* rowp = X + (size_t)(row0 + ai * HALF + m * 16) * D + col0;
#pragma unroll
                    for (int bj = 0; bj < 2; ++bj) { const u32x4 o = q[m][bj];
                        const f32x4 v0 = (f32x4){bflo(o.x), bfhi(o.x), bflo(o.y), bfhi(o.y)} + gv[bj][0] * acc[ai][bj][m][0], v1 = (f32x4){bflo(o.z), bfhi(o.z), bflo(o.w), bfhi(o.w)} + gv[bj][1] * acc[ai][bj][m][1];
                        u32x4 w; w.x = cvt_pk(v0.x, v0.y); w.y = cvt_pk(v0.z, v0.w); w.z = cvt_pk(v1.x, v1.y); w.w = cvt_pk(v1.z, v1.w); *(u32x4*)(rowp + bj * HALF) = w; } }
                asm volatile("" ::: "memory");
            }
        } else {
#pragma unroll
            for (int ai = 0; ai < 2; ++ai)
#pragma unroll
                for (int m = 0; m < 4; ++m) { bf16_t* rowp = P1 + (size_t)(row0 + ai * HALF + m * 16) * D + col0;
#pragma unroll
                    for (int bj = 0; bj < 2; ++bj) { const f32x4 v0 = gv[bj][0] * acc[ai][bj][m][0], v1 = gv[bj][1] * acc[ai][bj][m][1];
                        u32x4 w; w.x = cvt_pk(v0.x, v0.y); w.y = cvt_pk(v0.z, v0.w); w.z = cvt_pk(v1.x, v1.y); w.w = cvt_pk(v1.z, v1.w); *(u32x4*)(rowp + bj * HALF) = w; } }
        }
    }
};
struct TailSplitOrder {
    pg8::StaticOrder sf, st; int G, c, ntf;
    __device__ __forceinline__ void init(int G_, int c_, int ntf_ = 32) { sf.init(8192, D, G_, c_); st.init(4096, D, G_, c_); G = G_; c = c_; ntf = ntf_; }
    __device__ __forceinline__ bool next(int i, Unit& u) const {
        const int L = i * G + c; if (L >= 512) return false;
        if (L < 256) { sf.map(L, u); u.kh = 0; u.nt = ntf; }
        else { const int h = L - 256, kh = h >= 128; st.map(kh ? h - 128 : h, u); u.pm += 32; u.kh = kh; u.nt = ntf >> 1; }
        u.mask = 15; return true; }
    __device__ __forceinline__ void a_ready(const Unit&) const {}
    __device__ __forceinline__ void done(const Unit&) const {}
};


typedef short s16x4 __attribute__((ext_vector_type(4)));
constexpr int KS_STRIDE = 136;
constexpr int VT_STRIDE = 72;
constexpr int ATT_KS_OFF = 0, ATT_VT_OFF = 64 * KS_STRIDE * 2, ATT_BUF_BYTES = 36864;

__device__ __forceinline__ void rope8(u32x4& a, u32x4& b, const f32x2* tab) {
    unsigned* pa = (unsigned*)&a; unsigned* pb = (unsigned*)&b;
#pragma unroll
    for (int w = 0; w < 4; ++w) {
        const f32x4 cs = *(const f32x4*)(tab + 2 * w);
        const float x1l = bflo(pa[w]), x1h = bfhi(pa[w]), x2l = bflo(pb[w]), x2h = bfhi(pb[w]);
        const float o1l = x1l * cs.x - x2l * cs.y, o2l = x1l * cs.y + x2l * cs.x;
        const float o1h = x1h * cs.z - x2h * cs.w, o2h = x1h * cs.w + x2h * cs.z;
        pa[w] = cvt_pk(o1l, o1h); pb[w] = cvt_pk(o2l, o2h);
    }
}

__device__ __forceinline__ void phase_attention(const Ctx& C, const bf16_t* Q, const bf16_t* Kb, const bf16_t* Vb, const bf16_t* KC, const bf16_t* VC, const float* sink, bf16_t* O) {
    const int tid = C.tid, lane = C.lane, w = C.wave, h = lane >> 5, lq = lane & 31;
    LAS bf16_t* Ks = (LAS bf16_t*)(C.lds + ATT_KS_OFF);
    LAS bf16_t* Vt = (LAS bf16_t*)(C.lds + ATT_VT_OFF);
    const f32x2* rope = WSP(f32x2, WS_ROPE);
    const float c2 = 0.08838834764831845f * 1.4426950408889634f;
    for (int it = C.bid; it < 768; it += C.G) {
        const bool smp = it < 512;
        int bb, kvh, qb, R0;
        if (smp) { bb = it >> 6; kvh = (it >> 4) & 3; qb = it & 15; R0 = MP + bb * 1024; }
        else { const int p = it - 512; bb = p >> 4; kvh = (p >> 2) & 3; qb = p & 3; R0 = bb * 256; }
        const int head = kvh * 4 + (w >> 1);
        const int t = qb * 64 + (w & 1) * 32 + lq;
        u32x4 qf[8];
        { const bf16_t* qp = Q + (size_t)(R0 + t) * D + head * 128 + 8 * h;
#pragma unroll
          for (int ks = 0; ks < 8; ++ks) qf[ks] = *(const u32x4*)(qp + 16 * ks); }
        if (smp) {
#pragma unroll
            for (int half = 0; half < 2; ++half) { const int pos = half ? (t & 63) : (t >> 6);
#pragma unroll
                for (int kk = 0; kk < 2; ++kk) rope8(qf[4 * half + kk], qf[4 * half + kk + 2], rope + pos * 32 + 16 * kk + 8 * h); }
        }
        f32x16 o[4];
#pragma unroll
        for (int db = 0; db < 4; ++db)
#pragma unroll
            for (int r = 0; r < 16; ++r) o[db][r] = 0.f;
        float mrun = -1e30f, lrun = 0.f;
        const int li0 = smp ? (qb >= 2 ? 0 : 2 - qb) : 0, li1 = smp ? (17 - qb < 4 ? 17 - qb : 4) : 0;
        const int ntot = smp ? 8 + (li1 - li0 + 1) : 4;
        const int key = tid >> 3, cc = tid & 7, c1 = (cc & 3) + (cc >> 2) * 8;
#define ATT_TILE(i, kp_, vp_, k0_, loc_) do { if (smp) { if ((i) < 8) { const size_t off_ = ((size_t)(bb * 2) * 512 + (i) * 64) * 512 + kvh * 128; kp_ = KC + off_; vp_ = VC + off_; k0_ = 0; loc_ = false; } \
            else { k0_ = qb * 64 - 128 + 64 * ((i) - 8 + li0); loc_ = true; const size_t off_ = (size_t)(R0 + k0_) * 512 + kvh * 128; kp_ = Kb + off_; vp_ = Vb + off_; } } \
          else { k0_ = (i) * 64; loc_ = false; const size_t off_ = (size_t)(R0 + k0_) * 512 + kvh * 128; kp_ = Kb + off_; vp_ = Vb + off_; } } while (0)
        u32x4 ka, kb2, va, vb2;
#define ATT_LOAD(i) do { const bf16_t *kp_, *vp_; int k0_; bool loc_; ATT_TILE(i, kp_, vp_, k0_, loc_); (void)k0_; (void)loc_; \
          ka = *(const u32x4*)(kp_ + (size_t)key * 512 + 8 * c1); kb2 = *(const u32x4*)(kp_ + (size_t)key * 512 + 8 * c1 + 32); \
          va = *(const u32x4*)(vp_ + (size_t)key * 512 + 8 * c1); vb2 = *(const u32x4*)(vp_ + (size_t)key * 512 + 8 * c1 + 32); } while (0)
#define ATT_STAGE(i, KsB, VtB) do { const bf16_t *kp_, *vp_; int k0_; bool loc_; ATT_TILE(i, kp_, vp_, k0_, loc_); (void)kp_; (void)vp_; \
          if (loc_) { const int kpos = k0_ + key; const int pos = (cc >> 2) ? (kpos & 63) : (kpos >> 6); rope8(ka, kb2, rope + pos * 32 + 8 * (cc & 3)); } \
          *(LAS u32x4*)((KsB) + key * KS_STRIDE + 8 * c1) = ka; *(LAS u32x4*)((KsB) + key * KS_STRIDE + 8 * c1 + 32) = kb2; \
          *(LAS u32x4*)((VtB) + key * KS_STRIDE + 8 * c1) = va; *(LAS u32x4*)((VtB) + key * KS_STRIDE + 8 * c1 + 32) = vb2; } while (0)
        ATT_LOAD(0); ATT_STAGE(0, Ks, Vt); if (ntot > 1) ATT_LOAD(1);
        __syncthreads();
        for (int ti = 0; ti < ntot; ++ti) {
            const bf16_t *kp, *vp; int k0; bool local; ATT_TILE(ti, kp, vp, k0, local); (void)kp; (void)vp;
            LAS bf16_t* Ks = (LAS bf16_t*)(C.lds + (ti & 1) * ATT_BUF_BYTES + ATT_KS_OFF);
            LAS bf16_t* Vt = (LAS bf16_t*)(C.lds + (ti & 1) * ATT_BUF_BYTES + ATT_VT_OFF);
            f32x16 s0, s1;
            { const float z0 = opaque_zero();
#pragma unroll
            for (int r = 0; r < 16; ++r) { s0[r] = z0; s1[r] = z0; } }
#pragma unroll
            for (int ks = 0; ks < 8; ++ks) {
                const bf16x8 a0 = *(const LAS bf16x8*)(Ks + lq * KS_STRIDE + 16 * ks + 8 * h);
                const bf16x8 a1 = *(const LAS bf16x8*)(Ks + (32 + lq) * KS_STRIDE + 16 * ks + 8 * h);
                const bf16x8 bq = __builtin_bit_cast(bf16x8, qf[ks]);
                s0 = __builtin_amdgcn_mfma_f32_32x32x16_bf16(a0, bq, s0, 0, 0, 0);
                s1 = __builtin_amdgcn_mfma_f32_32x32x16_bf16(a1, bq, s1, 0, 0, 0);
            }
            if (local) {
#pragma unroll
                for (int r = 0; r < 16; ++r) {
                    const int kl = (r & 3) + 8 * (r >> 2) + 4 * h;
                    const int d0 = k0 + kl - t, d1 = d0 + 32;
                    s0[r] = ((d0 <= 128) && (d0 >= -128)) ? s0[r] : -1e30f; s1[r] = ((d1 <= 128) && (d1 >= -128)) ? s1[r] : -1e30f;
                }
            }
            float mx = fmaxf(s0[0], s1[0]);
#pragma unroll
            for (int r = 1; r < 16; ++r) mx = fmaxf(mx, fmaxf(s0[r], s1[r]));
            mx = fmaxf(mx, __shfl_xor(mx, 32));
            const float mnew = fmaxf(mrun, mx * c2);
            const float alpha = fexp2(mrun - mnew);
            float ps = 0.f;
#pragma unroll
            for (int r = 0; r < 16; ++r) {
                const float p0 = fexp2(__builtin_fmaf(s0[r], c2, -mnew)), p1 = fexp2(__builtin_fmaf(s1[r], c2, -mnew));
                s0[r] = p0; s1[r] = p1; ps += p0 + p1;
            }
            lrun = lrun * alpha + ps; mrun = mnew;
            if (__any(alpha != 1.0f)) {
#pragma unroll
                for (int db = 0; db < 4; ++db)
#pragma unroll
                    for (int r = 0; r < 16; ++r) o[db][r] *= alpha;
            }
            u32x4 pf[4];
#pragma unroll
            for (int s = 0; s < 2; ++s) {
                pf[s].x = cvt_pk(s0[8 * s + 0], s0[8 * s + 1]); pf[s].y = cvt_pk(s0[8 * s + 2], s0[8 * s + 3]); pf[s].z = cvt_pk(s0[8 * s + 4], s0[8 * s + 5]); pf[s].w = cvt_pk(s0[8 * s + 6], s0[8 * s + 7]);
                pf[2 + s].x = cvt_pk(s1[8 * s + 0], s1[8 * s + 1]); pf[2 + s].y = cvt_pk(s1[8 * s + 2], s1[8 * s + 3]); pf[2 + s].z = cvt_pk(s1[8 * s + 4], s1[8 * s + 5]); pf[2 + s].w = cvt_pk(s1[8 * s + 6], s1[8 * s + 7]);
            }
#pragma unroll
            for (int db = 0; db < 4; ++db)
#pragma unroll
                for (int s2 = 0; s2 < 4; ++s2) {
                    const LAS bf16_t* vr = Vt + (16 * s2 + 4 * (lane >> 5) + ((lane & 15) >> 2)) * KS_STRIDE + 32 * db + 16 * ((lane >> 4) & 1) + 4 * (lane & 3);
                    const s16x4 lo = __builtin_amdgcn_ds_read_tr16_b64_v4i16((LAS s16x4*)vr), hi = __builtin_amdgcn_ds_read_tr16_b64_v4i16((LAS s16x4*)(vr + 8 * KS_STRIDE));
                    const u32x2 lo2 = __builtin_bit_cast(u32x2, lo), hi2 = __builtin_bit_cast(u32x2, hi);
                    u32x4 av; av.x = lo2.x; av.y = lo2.y; av.z = hi2.x; av.w = hi2.y;
                    o[db] = __builtin_amdgcn_mfma_f32_32x32x16_bf16(__builtin_bit_cast(bf16x8, av), __builtin_bit_cast(bf16x8, pf[s2]), o[db], 0, 0, 0);
                }
            if (ti + 1 < ntot) {
                LAS bf16_t* Ksn = (LAS bf16_t*)(C.lds + ((ti + 1) & 1) * ATT_BUF_BYTES + ATT_KS_OFF);
                LAS bf16_t* Vtn = (LAS bf16_t*)(C.lds + ((ti + 1) & 1) * ATT_BUF_BYTES + ATT_VT_OFF);
                ATT_STAGE(ti + 1, Ksn, Vtn);
                if (ti + 2 < ntot) ATT_LOAD(ti + 2);
            }
            __syncthreads();
        }
        {
            const float sk = sink[head] * 1.4426950408889634f;
            const float mnew = fmaxf(mrun, sk), alpha = fexp2(mrun - mnew);
            float l = lrun * alpha; l += __shfl_xor(l, 32); l += fexp2(sk - mnew);
            const float sc = alpha * frcp(l);
            bf16_t* op = O + (size_t)(R0 + t) * D + head * 128 + 4 * h;
#pragma unroll
            for (int db = 0; db < 4; ++db)
#pragma unroll
                for (int g4 = 0; g4 < 4; ++g4) {
                    u32x2 wv; wv.x = cvt_pk(o[db][4 * g4 + 0] * sc, o[db][4 * g4 + 1] * sc); wv.y = cvt_pk(o[db][4 * g4 + 2] * sc, o[db][4 * g4 + 3] * sc);
                    *(u32x2*)(op + 32 * db + 8 * g4) = wv;
                }
        }
    }
#undef ATT_TILE
#undef ATT_LOAD
#undef ATT_STAGE
    __syncthreads();
}

__device__ __forceinline__ void phase_hy_gate(const Ctx& C, const bf16_t* Pm, const float* cw, const float* cb, bf16_t* X0, bf16_t* ZTp, bf16_t* ZTs) {
    const int tid = C.tid;
    LAS bf16_t* zs = (LAS bf16_t*)C.lds;
    for (int it = C.bid; it < 6144; it += C.G) {
        const bool smp = it >= 2048; const int q = smp ? it - 2048 : it;
        const int cbk = q & 31, tb = smp ? (q >> 5) & 15 : (q >> 5) & 3, b = smp ? q >> 9 : q >> 7;
        const int L = smp ? 1024 : 256, R0 = smp ? MP + b * 1024 : b * 256, NB = smp ? 8 : 16;
        const int tl = tid >> 3, c8 = tid & 7, t = tb * 64 + tl, c0 = cbk * 64 + 8 * c8;
        float u[3][8];
#pragma unroll
        for (int g = 0; g < 3; ++g) {
            const int gc = g * D + c0;
            const bf16_t* pr = Pm + (size_t)(R0 + t) * 6144 + gc;
            u32x4 pm1 = *(const u32x4*)(pr - (t > 0 ? 6144 : 0)), pp1 = *(const u32x4*)(pr + (t < L - 1 ? 6144 : 0)); const u32x4 p0 = *(const u32x4*)pr;
            { const unsigned mk0 = t > 0 ? 0xffffffffu : 0u, mk1 = t < L - 1 ? 0xffffffffu : 0u; pm1.x &= mk0; pm1.y &= mk0; pm1.z &= mk0; pm1.w &= mk0; pp1.x &= mk1; pp1.y &= mk1; pp1.z &= mk1; pp1.w &= mk1; }
            const unsigned* a = (const unsigned*)&pm1; const unsigned* bq = (const unsigned*)&p0; const unsigned* cq = (const unsigned*)&pp1;
#pragma unroll
            for (int j = 0; j < 4; ++j) {
                const f32x2 w0 = *(const f32x2*)(cw + gc + 2 * j), w1 = *(const f32x2*)(cw + 6144 + gc + 2 * j), w2 = *(const f32x2*)(cw + 12288 + gc + 2 * j), bb = *(const f32x2*)(cb + gc + 2 * j);
#if defined(MK_GATE_VARIANT) && MK_GATE_VARIANT == 1
                u[g][2 * j] = bflo(bq[j]); u[g][2 * j + 1] = bfhi(bq[j]);
#elif defined(MK_GATE_VARIANT) && MK_GATE_VARIANT == 2
                u[g][2 * j] = bflo(bq[j]) * w1.x + bb.x; u[g][2 * j + 1] = bfhi(bq[j]) * w1.y + bb.y;
#elif defined(MK_GATE_VARIANT) && MK_GATE_VARIANT == 3
                u[g][2 * j] = bflo(a[j]) + bflo(bq[j]) + bflo(cq[j]); u[g][2 * j + 1] = bfhi(a[j]) + bfhi(bq[j]) + bfhi(cq[j]);
#else
                u[g][2 * j] = bflo(a[j]) * w0.x + bflo(bq[j]) * w1.x + bflo(cq[j]) * w2.x + bb.x;
                u[g][2 * j + 1] = bfhi(a[j]) * w0.y + bfhi(bq[j]) * w1.y + bfhi(cq[j]) * w2.y + bb.y;
#endif
            }
        }
        { u32x4 o; o.x = cvt_pk(u[0][0], u[0][1]); o.y = cvt_pk(u[0][2], u[0][3]); o.z = cvt_pk(u[0][4], u[0][5]); o.w = cvt_pk(u[0][6], u[0][7]);
          *(u32x4*)(X0 + (size_t)(R0 + t) * D + c0) = o; }
        __syncthreads();
#pragma unroll
        for (int j = 0; j < 8; ++j) zs[(8 * c8 + j) * 72 + tl] = (bf16_t)(cvt_pk(u[2][j] * u[1][j], 0.f) & 0xffffu);
        __syncthreads();
        { const int cl = tid >> 3, t8 = tid & 7;
          const u32x4 o = *(const LAS u32x4*)(zs + cl * 72 + 8 * t8);
          bf16_t* ZT = smp ? ZTs : ZTp;
          *(u32x4*)(ZT + ((size_t)(cbk * 64 + cl) * NB + b) * L + tb * 64 + 8 * t8) = o; }
    }
    __syncthreads();
}

template <int L, int NB>
__device__ __forceinline__ void phase_hy_conv(const Ctx& C, const bf16_t* FG, const bf16_t* ZT, bf16_t* YT) {
    constexpr int WPC = L / 256, CPB = 8 / WPC, NS = L / 32, ROW = 2 * L + 64, UNITS = L / 4, COPYB = UNITS * 16, CHB = 8 * COPYB;
    constexpr int NH = NS > 16 ? NS / 16 : 1, JH = NS / NH;
    const int lane = C.lane, w = C.wave, ch_local = w / WPC, w4 = w % WPC, r = lane & 15, q = lane >> 4;
    for (int it = C.bid; it < 2048 / CPB; it += C.G) {
        const int c = it * CPB + ch_local;
        __syncthreads();
        {
            const int tcid = w4 * 64 + lane;
            const bf16_t* frow = FG + (size_t)c * ROW;
            for (int x = tcid; x < UNITS; x += 64 * WPC) {
                const u32x4 d0 = *(const u32x4*)(frow + 8 * x), d1 = *(const u32x4*)(frow + 8 * x + 8);
                const unsigned dd[8] = {d0.x, d0.y, d0.z, d0.w, d1.x, d1.y, d1.z, d1.w};
#pragma unroll
                for (int k = 0; k < 8; ++k) {
                    u32x4 o;
                    if ((k & 1) == 0) { o.x = dd[k / 2]; o.y = dd[k / 2 + 1]; o.z = dd[k / 2 + 2]; o.w = dd[k / 2 + 3]; }
                    else { const int b0 = (k - 1) / 2;
                        o.x = (dd[b0] >> 16) | (dd[b0 + 1] << 16); o.y = (dd[b0 + 1] >> 16) | (dd[b0 + 2] << 16); o.z = (dd[b0 + 2] >> 16) | (dd[b0 + 3] << 16); o.w = (dd[b0 + 3] >> 16) | (dd[b0 + 4] << 16); }
                    *(LAS u32x4*)(C.lds + ch_local * CHB + k * COPYB + x * 16) = o;
                }
            }
        }
        __syncthreads();
        f32x4 acc[16];
        { const float z0 = opaque_zero();
#pragma unroll
        for (int i = 0; i < 16; ++i) acc[i] = (f32x4){z0, z0, z0, z0}; }
        const bf16_t* zrow = ZT + ((size_t)c * NB + (r % NB)) * L + 8 * q;
        const LAS unsigned char* abase = C.lds + ch_local * CHB + (7 - (r & 7)) * COPYB + ((L - 8) / 8 - (r >> 3) + q - 32 * w4) * 16;
#pragma unroll
        for (int hh = 0; hh < NH; ++hh) {
            bf16x8 bf[JH];
#pragma unroll
            for (int j = 0; j < JH; ++j) bf[j] = *(const bf16x8*)(zrow + 32 * (hh * JH + j));
#pragma unroll
            for (int e = -2 * (hh * JH + JH - 1); e <= 15 - 2 * (hh * JH); ++e) {
                const bf16x8 a = *(const LAS bf16x8*)(abase - 32 * e);
#pragma unroll
                for (int j = 0; j < JH; ++j) { const int il = e + 2 * (hh * JH + j);
                    if (il >= 0 && il < 16) asm volatile("v_mfma_f32_16x16x32_bf16 %0, %1, %2, %0" : "+v"(acc[il]) : "v"(a), "v"(bf[j])); }
                asm volatile("" :: "v"(a));
            }
#pragma unroll
            for (int j = 0; j < JH; ++j) asm volatile("" :: "v"(bf[j]));
        }
        asm volatile("s_nop 15\n\ts_nop 15" : "+v"(acc[0]), "+v"(acc[1]), "+v"(acc[2]), "+v"(acc[3]), "+v"(acc[4]), "+v"(acc[5]), "+v"(acc[6]), "+v"(acc[7]));
        asm volatile("" : "+v"(acc[8]), "+v"(acc[9]), "+v"(acc[10]), "+v"(acc[11]), "+v"(acc[12]), "+v"(acc[13]), "+v"(acc[14]), "+v"(acc[15]));
        if (r < NB) {
            bf16_t* yrow = YT + ((size_t)c * NB + r) * L + 256 * w4 + 4 * q;
#pragma unroll
            for (int i = 0; i < 16; ++i) { u32x2 o; o.x = cvt_pk(acc[i][0], acc[i][1]); o.y = cvt_pk(acc[i][2], acc[i][3]);
#if defined(MK_CONV_VARIANT) && MK_CONV_VARIANT == 1
                { const u32x4 zz = *(const u32x4*)(zrow + 32 * (i & 7)); o.x = zz.x; o.y = zz.y; }
#elif defined(MK_CONV_VARIANT) && MK_CONV_VARIANT == 2
                { const u32x4 aa = *(const LAS u32x4*)(abase - 32 * (i - 8)); o.x = aa.x; o.y = aa.w; }
#endif
                *(u32x2*)(yrow + 16 * i) = o; }
        }
    }
    __syncthreads();
}

__device__ __forceinline__ void phase_hy_out(const Ctx& C, const bf16_t* YTp, const bf16_t* YTs, const bf16_t* X0, bf16_t* Om) {
    const int tid = C.tid;
    LAS bf16_t* ys = (LAS bf16_t*)C.lds;
    for (int it = C.bid; it < 6144; it += C.G) {
        const bool smp = it >= 2048; const int q = smp ? it - 2048 : it;
        const int cbk = q & 31, tb = smp ? (q >> 5) & 15 : (q >> 5) & 3, b = smp ? q >> 9 : q >> 7;
        const int L = smp ? 1024 : 256, R0 = smp ? MP + b * 1024 : b * 256, NB = smp ? 8 : 16;
        __syncthreads();
        { const int cl = tid >> 3, t8 = tid & 7;
          const bf16_t* YT = smp ? YTs : YTp;
          const u32x4 v = *(const u32x4*)(YT + ((size_t)(cbk * 64 + cl) * NB + b) * L + tb * 64 + 8 * t8);
          const unsigned* pv = (const unsigned*)&v;
#pragma unroll
          for (int j = 0; j < 4; ++j) { ys[(8 * t8 + 2 * j) * 72 + cl] = (bf16_t)(pv[j] & 0xffffu); ys[(8 * t8 + 2 * j + 1) * 72 + cl] = (bf16_t)(pv[j] >> 16); } }
        __syncthreads();
        { const int tl = tid >> 3, c8 = tid & 7; const size_t off = (size_t)(R0 + tb * 64 + tl) * D + cbk * 64 + 8 * c8;
          const u32x4 yv = *(const LAS u32x4*)(ys + tl * 72 + 8 * c8), xv = *(const u32x4*)(X0 + off);
          const unsigned* py = (const unsigned*)&yv; const unsigned* px = (const unsigned*)&xv; u32x4 o; unsigned* po = (unsigned*)&o;
#pragma unroll
          for (int j = 0; j < 4; ++j) po[j] = cvt_pk(bflo(py[j]) * bflo(px[j]), bfhi(py[j]) * bfhi(px[j]));
          *(u32x4*)(Om + off) = o; }
    }
    __syncthreads();
}

__device__ __forceinline__ void phase_rw_mix(const Ctx& C, const bf16_t* H, const float* mu, bf16_t* XM) {
    const int gw = C.bid * 8 + C.wave, NGW = C.G * 8, lane = C.lane;
#pragma unroll 1
    for (int ch = 0; ch < 4; ++ch) {
        const int c0 = 8 * (lane + 64 * ch);
        f32x4 mv[6][2];
#pragma unroll
        for (int s = 0; s < 6; ++s) { const int mi = s == 0 ? 0 : s == 1 ? 2 : s == 2 ? 3 : s == 3 ? 1 : s; mv[s][0] = *(const f32x4*)(mu + mi * D + c0); mv[s][1] = *(const f32x4*)(mu + mi * D + c0 + 4); }
        u32x4 a, b, c;
#define MX_LOAD(m_) do { const int t_ = (m_) < MP ? ((m_) & 255) : (((m_) - MP) & 1023), L_ = (m_) < MP ? 256 : 1024; const bf16_t* hp_ = H + (size_t)(m_) * D + c0; \
            a = *(const u32x4*)(hp_ - (t_ > 0 ? D : 0)); c = *(const u32x4*)(hp_ + (t_ < L_ - 1 ? D : 0)); b = *(const u32x4*)hp_; } while (0)
        int m = gw;
        if (m < MT) MX_LOAD(m);
        for (; m < MT; m += NGW) {
            const int t = m < MP ? (m & 255) : ((m - MP) & 1023), L = m < MP ? 256 : 1024;
            const unsigned mk0 = t > 0 ? 0xffffffffu : 0u, mk1 = t < L - 1 ? 0xffffffffu : 0u;
            const unsigned pa[4] = {a.x & mk0, a.y & mk0, a.z & mk0, a.w & mk0}, pb[4] = {b.x, b.y, b.z, b.w}, pc[4] = {c.x & mk1, c.y & mk1, c.z & mk1, c.w & mk1};
            float hv[8], xx[8];
#pragma unroll
            for (int j = 0; j < 4; ++j) { hv[2 * j] = bflo(pb[j]); hv[2 * j + 1] = bfhi(pb[j]);
                xx[2 * j] = 0.5f * (bflo(pa[j]) + bflo(pc[j])) - hv[2 * j]; xx[2 * j + 1] = 0.5f * (bfhi(pa[j]) + bfhi(pc[j])) - hv[2 * j + 1]; }
            u32x4 o[6];
#pragma unroll
            for (int s = 0; s < 6; ++s) {
                const f32x4 m0 = mv[s][0], m1 = mv[s][1];
                o[s].x = cvt_pk(hv[0] + xx[0] * m0.x, hv[1] + xx[1] * m0.y); o[s].y = cvt_pk(hv[2] + xx[2] * m0.z, hv[3] + xx[3] * m0.w);
                o[s].z = cvt_pk(hv[4] + xx[4] * m1.x, hv[5] + xx[5] * m1.y); o[s].w = cvt_pk(hv[6] + xx[6] * m1.z, hv[7] + xx[7] * m1.w);
            }
            const int mn = m + NGW;
            if (mn < MT) MX_LOAD(mn);
            asm volatile("" ::: "memory");
#pragma unroll
            for (int s = 0; s < 6; ++s) *(u32x4*)(XM + ((size_t)s * MT + m) * D + c0) = o[s];
        }
#undef MX_LOAD
    }
}

__device__ __forceinline__ float dpp_xor1(float x) { return __int_as_float(__builtin_amdgcn_update_dpp(0, __float_as_int(x), 0xB1, 0xF, 0xF, true)); }
__device__ __forceinline__ float dpp_xor2(float x) { return __int_as_float(__builtin_amdgcn_update_dpp(0, __float_as_int(x), 0x4E, 0xF, 0xF, true)); }

constexpr int SC_STEP = 6 * 64;
template <int R, int SC_TS>
__device__ __forceinline__ void rw_scan_task(LAS float* buf, int lane, const bf16_t* Rm, const bf16_t* Km, const bf16_t* Vm, const bf16_t* LD, const bf16_t* LA,
                                             const float* k_k, const float* k_a, const float* invsq, const float* state_in, bf16_t* YB, float* state_out, bool smp, int b, int head, int dir, int half) {
    const int rg = lane >> 2, kq = lane & 3;
    const int L = smp ? 1024 : 256, R0 = smp ? MP + b * 1024 : b * 256;
    const int row0 = half * (16 * R) + R * rg;
    f32x2 S[R][8];
    if (smp) {
        const float* sp = state_in + ((size_t)(b * 2 + dir) * 32 + head) * 4096 + row0 * 64 + 16 * kq;
#pragma unroll
        for (int rr = 0; rr < R; ++rr)
#pragma unroll
            for (int j4 = 0; j4 < 4; ++j4) { const f32x4 v = *(const f32x4*)(sp + rr * 64 + 4 * j4); S[rr][2 * j4] = (f32x2){v.x, v.y}; S[rr][2 * j4 + 1] = (f32x2){v.z, v.w}; }
    } else {
#pragma unroll
        for (int rr = 0; rr < R; ++rr)
#pragma unroll
            for (int j = 0; j < 8; ++j) S[rr][j] = (f32x2){0.f, 0.f};
    }
    const int ch = head * 64 + lane; const size_t hbase = (size_t)head * MT * 64 + lane;
    const float kkc = k_k[ch], kac = k_a[ch];
    const bf16_t* ldp = LD + (size_t)dir * MT * D; const bf16_t* lap = LA + (size_t)dir * MT * D;
    bf16_t* yb = YB + (size_t)dir * MT * D;
    bf16_t pr[SC_TS], pk[SC_TS], pv[SC_TS], pl[SC_TS], pa[SC_TS], qr[SC_TS], qk[SC_TS], qv[SC_TS], ql[SC_TS], qa[SC_TS];
    const int tstart = dir ? L - 1 : 0, tstep = dir ? -1 : 1;
    const int NCH = L / SC_TS;
#define SC_PREFETCH(c) do { _Pragma("unroll") for (int s_ = 0; s_ < SC_TS; ++s_) { const size_t o_ = hbase + (size_t)(R0 + tstart + tstep * ((c) * SC_TS + s_)) * 64; pr[s_] = Rm[o_]; pk[s_] = Km[o_]; pv[s_] = Vm[o_]; pl[s_] = ldp[o_]; pa[s_] = lap[o_]; } } while (0)
#define SC_DERIVE(s_, bufp) do { const float r_ = bf2f(pr[s_]), k_ = bf2f(pk[s_]), v_ = bf2f(pv[s_]), ld_ = bf2f(pl[s_]), a_ = fsigmoid(bf2f(pa[s_])); \
        const float kr_ = k_ * kkc; const float kk_ = kr_ * __builtin_amdgcn_rsqf(wave_sum(kr_ * kr_) + 1e-12f); \
        const unsigned sa_ = (unsigned)(unsigned long)((bufp) + (s_) * SC_STEP) + 4u * (unsigned)lane;     \
        asm volatile("ds_write_b32 %0, %1" :: "v"(sa_), "v"(fexp(ld_))); asm volatile("ds_write_b32 %0, %1 offset:256" :: "v"(sa_), "v"(kk_ * a_)); \
        asm volatile("ds_write_b32 %0, %1 offset:512" :: "v"(sa_), "v"(k_ * (1.0f + (a_ - 1.0f) * kac))); asm volatile("ds_write_b32 %0, %1 offset:768" :: "v"(sa_), "v"(-kk_)); \
        asm volatile("ds_write_b32 %0, %1 offset:1024" :: "v"(sa_), "v"(r_)); asm volatile("ds_write_b32 %0, %1 offset:1280" :: "v"(sa_), "v"(v_)); } while (0)
#define SC_PREFETCH2(c) do { _Pragma("unroll") for (int s_ = 0; s_ < SC_TS; ++s_) { const size_t o_ = hbase + (size_t)(R0 + tstart + tstep * ((c) * SC_TS + s_)) * 64; qr[s_] = Rm[o_]; qk[s_] = Km[o_]; qv[s_] = Vm[o_]; ql[s_] = ldp[o_]; qa[s_] = lap[o_]; } } while (0)
    SC_PREFETCH(0);
#pragma unroll
    for (int s = 0; s < SC_TS; ++s) SC_DERIVE(s, buf);
    asm volatile("s_waitcnt lgkmcnt(0)" ::: "memory");
    SC_PREFETCH(1);
    SC_PREFETCH2(2);
#define SC_DERIVE_Q(s_, bufp) do { const float r_ = bf2f(qr[s_]), k_ = bf2f(qk[s_]), v_ = bf2f(qv[s_]), ld_ = bf2f(ql[s_]), a_ = fsigmoid(bf2f(qa[s_])); \
        const float kr_ = k_ * kkc; const float kk_ = kr_ * __builtin_amdgcn_rsqf(wave_sum(kr_ * kr_) + 1e-12f); \
        const unsigned sa_ = (unsigned)(unsigned long)((bufp) + (s_) * SC_STEP) + 4u * (unsigned)lane; \
        asm volatile("ds_write_b32 %0, %1" :: "v"(sa_), "v"(fexp(ld_))); asm volatile("ds_write_b32 %0, %1 offset:256" :: "v"(sa_), "v"(kk_ * a_)); \
        asm volatile("ds_write_b32 %0, %1 offset:512" :: "v"(sa_), "v"(k_ * (1.0f + (a_ - 1.0f) * kac))); asm volatile("ds_write_b32 %0, %1 offset:768" :: "v"(sa_), "v"(-kk_)); \
        asm volatile("ds_write_b32 %0, %1 offset:1024" :: "v"(sa_), "v"(r_)); asm volatile("ds_write_b32 %0, %1 offset:1280" :: "v"(sa_), "v"(v_)); } while (0)
    LAS float* const buf0 = buf; LAS float* const buf1 = buf + SC_TS * SC_STEP;
    for (int cix = 0; cix < NCH; cix += 2) {
#pragma unroll
        for (int s = 0; s < SC_TS; ++s) {
            SC_DERIVE(s, buf1);
            if (cix + 3 < NCH) { const size_t o_ = hbase + (size_t)(R0 + tstart + tstep * ((cix + 3) * SC_TS + s)) * 64; pr[s] = Rm[o_]; pk[s] = Km[o_]; pv[s] = Vm[o_]; pl[s] = ldp[o_]; pa[s] = lap[o_]; }
#define BC_ buf0
#define CX_ cix
            const LAS float* sb = BC_ + s * SC_STEP;
            f32x2 w2[8], b2[8], d2[8], n2[8], r2[8];
#pragma unroll
            for (int j4 = 0; j4 < 4; ++j4) { const f32x4 nv = *(const LAS f32x4*)(sb + 192 + 16 * kq + 4 * j4); n2[2 * j4] = (f32x2){nv.x, nv.y}; n2[2 * j4 + 1] = (f32x2){nv.z, nv.w}; }
#pragma unroll
            for (int j4 = 0; j4 < 4; ++j4) {
                const f32x4 bv = *(const LAS f32x4*)(sb + 64 + 16 * kq + 4 * j4), dv = *(const LAS f32x4*)(sb + 128 + 16 * kq + 4 * j4), wv = *(const LAS f32x4*)(sb + 16 * kq + 4 * j4), rv = *(const LAS f32x4*)(sb + 256 + 16 * kq + 4 * j4);
                w2[2 * j4] = (f32x2){wv.x, wv.y}; w2[2 * j4 + 1] = (f32x2){wv.z, wv.w}; b2[2 * j4] = (f32x2){bv.x, bv.y}; b2[2 * j4 + 1] = (f32x2){bv.z, bv.w};
                d2[2 * j4] = (f32x2){dv.x, dv.y}; d2[2 * j4 + 1] = (f32x2){dv.z, dv.w}; r2[2 * j4] = (f32x2){rv.x, rv.y}; r2[2 * j4 + 1] = (f32x2){rv.z, rv.w};
            }
            float vrow[R];
            if (R == 4) { const f32x4 vv = *(const LAS f32x4*)(sb + 320 + row0); vrow[0] = vv.x; vrow[R > 1 ? 1 : 0] = vv.y; vrow[R > 2 ? R - 2 : 0] = vv.z; vrow[R - 1] = vv.w; }
            else if (R == 2) { const f32x2 vv = *(const LAS f32x2*)(sb + 320 + row0); vrow[0] = vv.x; vrow[R - 1] = vv.y; }
            else vrow[0] = sb[320 + row0];
            float y[R];
#pragma unroll
            for (int rr = 0; rr < R; ++rr) {
                f32x2 a0 = S[rr][0] * n2[0], a1 = S[rr][1] * n2[1];
#pragma unroll
                for (int j = 2; j < 8; j += 2) { a0 = S[rr][j] * n2[j] + a0; a1 = S[rr][j + 1] * n2[j + 1] + a1; }
                a0 = a0 + a1;
                float sa = a0.x + a0.y; sa += dpp_xor1(sa); sa += dpp_xor2(sa);
                const f32x2 sa2 = (f32x2){sa, sa}, vr2 = (f32x2){vrow[rr], vrow[rr]};
                f32x2 y0 = (f32x2){0.f, 0.f}, y1 = (f32x2){0.f, 0.f};
#pragma unroll
                for (int j = 0; j < 8; j += 2) {
                    S[rr][j] = S[rr][j] * w2[j] + (sa2 * b2[j] + vr2 * d2[j]);
                    S[rr][j + 1] = S[rr][j + 1] * w2[j + 1] + (sa2 * b2[j + 1] + vr2 * d2[j + 1]);
                    y0 = S[rr][j] * r2[j] + y0; y1 = S[rr][j + 1] * r2[j + 1] + y1;
                }
                y0 = y0 + y1;
                float yy = y0.x + y0.y; yy += dpp_xor1(yy); yy += dpp_xor2(yy); y[rr] = yy;
            }
            {
                const int t = tstart + tstep * ((CX_) * SC_TS + s); bf16_t* yp = yb + (size_t)(R0 + t) * D + head * 64;
                if (R == 4) { const float ys = kq == 0 ? y[0] : kq == 1 ? y[R > 1 ? 1 : 0] : kq == 2 ? y[R > 2 ? R - 2 : 0] : y[R - 1]; yp[lane] = (bf16_t)cvt_pk(ys, ys); }
                else if (R == 2) { const float ys = (kq & 1) ? y[R - 1] : y[0]; yp[half * 32 + 2 * rg + (kq & 1)] = (bf16_t)cvt_pk(ys, ys); }
                else yp[row0] = (bf16_t)cvt_pk(y[0], y[0]);
            }
#undef BC_
#undef CX_
        }
        asm volatile("s_waitcnt lgkmcnt(0)" ::: "memory");
#pragma unroll
        for (int s = 0; s < SC_TS; ++s) {
            SC_DERIVE_Q(s, buf0);
            if (cix + 4 < NCH) { const size_t o_ = hbase + (size_t)(R0 + tstart + tstep * ((cix + 4) * SC_TS + s)) * 64; qr[s] = Rm[o_]; qk[s] = Km[o_]; qv[s] = Vm[o_]; ql[s] = ldp[o_]; qa[s] = lap[o_]; }
#define BC_ buf1
#define CX_ (cix + 1)
            const LAS float* sb = BC_ + s * SC_STEP;
            f32x2 w2[8], b2[8], d2[8], n2[8], r2[8];
#pragma unroll
            for (int j4 = 0; j4 < 4; ++j4) { const f32x4 nv = *(const LAS f32x4*)(sb + 192 + 16 * kq + 4 * j4); n2[2 * j4] = (f32x2){nv.x, nv.y}; n2[2 * j4 + 1] = (f32x2){nv.z, nv.w}; }
#pragma unroll
            for (int j4 = 0; j4 < 4; ++j4) {
                const f32x4 bv = *(const LAS f32x4*)(sb + 64 + 16 * kq + 4 * j4), dv = *(const LAS f32x4*)(sb + 128 + 16 * kq + 4 * j4), wv = *(const LAS f32x4*)(sb + 16 * kq + 4 * j4), rv = *(const LAS f32x4*)(sb + 256 + 16 * kq + 4 * j4);
                w2[2 * j4] = (f32x2){wv.x, wv.y}; w2[2 * j4 + 1] = (f32x2){wv.z, wv.w}; b2[2 * j4] = (f32x2){bv.x, bv.y}; b2[2 * j4 + 1] = (f32x2){bv.z, bv.w};
                d2[2 * j4] = (f32x2){dv.x, dv.y}; d2[2 * j4 + 1] = (f32x2){dv.z, dv.w}; r2[2 * j4] = (f32x2){rv.x, rv.y}; r2[2 * j4 + 1] = (f32x2){rv.z, rv.w};
            }
            float vrow[R];
            if (R == 4) { const f32x4 vv = *(const LAS f32x4*)(sb + 320 + row0); vrow[0] = vv.x; vrow[R > 1 ? 1 : 0] = vv.y; vrow[R > 2 ? R - 2 : 0] = vv.z; vrow[R - 1] = vv.w; }
            else if (R == 2) { const f32x2 vv = *(const LAS f32x2*)(sb + 320 + row0); vrow[0] = vv.x; vrow[R - 1] = vv.y; }
            else vrow[0] = sb[320 + row0];
            float y[R];
#pragma unroll
            for (int rr = 0; rr < R; ++rr) {
                f32x2 a0 = S[rr][0] * n2[0], a1 = S[rr][1] * n2[1];
#pragma unroll
                for (int j = 2; j < 8; j += 2) { a0 = S[rr][j] * n2[j] + a0; a1 = S[rr][j + 1] * n2[j + 1] + a1; }
                a0 = a0 + a1;
                float sa = a0.x + a0.y; sa += dpp_xor1(sa); sa += dpp_xor2(sa);
                const f32x2 sa2 = (f32x2){sa, sa}, vr2 = (f32x2){vrow[rr], vrow[rr]};
                f32x2 y0 = (f32x2){0.f, 0.f}, y1 = (f32x2){0.f, 0.f};
#pragma unroll
                for (int j = 0; j < 8; j += 2) {
                    S[rr][j] = S[rr][j] * w2[j] + (sa2 * b2[j] + vr2 * d2[j]);
                    S[rr][j + 1] = S[rr][j + 1] * w2[j + 1] + (sa2 * b2[j + 1] + vr2 * d2[j + 1]);
                    y0 = S[rr][j] * r2[j] + y0; y1 = S[rr][j + 1] * r2[j + 1] + y1;
                }
                y0 = y0 + y1;
                float yy = y0.x + y0.y; yy += dpp_xor1(yy); yy += dpp_xor2(yy); y[rr] = yy;
            }
            {
                const int t = tstart + tstep * ((CX_) * SC_TS + s); bf16_t* yp = yb + (size_t)(R0 + t) * D + head * 64;
                if (R == 4) { const float ys = kq == 0 ? y[0] : kq == 1 ? y[R > 1 ? 1 : 0] : kq == 2 ? y[R > 2 ? R - 2 : 0] : y[R - 1]; yp[lane] = (bf16_t)cvt_pk(ys, ys); }
                else if (R == 2) { const float ys = (kq & 1) ? y[R - 1] : y[0]; yp[half * 32 + 2 * rg + (kq & 1)] = (bf16_t)cvt_pk(ys, ys); }
                else yp[row0] = (bf16_t)cvt_pk(y[0], y[0]);
            }
#undef BC_
#undef CX_
        }
        asm volatile("s_waitcnt lgkmcnt(0)" ::: "memory");
    }
#undef SC_DERIVE_Q
#undef SC_PREFETCH
#undef SC_PREFETCH2
#undef SC_DERIVE
    if (!smp) {
        float* sp = state_out + ((size_t)(b * 2 + dir) * 32 + head) * 4096 + row0 * 64 + 16 * kq;
#pragma unroll
        for (int rr = 0; rr < R; ++rr)
#pragma unroll
            for (int j4 = 0; j4 < 4; ++j4) *(f32x4*)(sp + rr * 64 + 4 * j4) = (f32x4){S[rr][2 * j4].x, S[rr][2 * j4].y, S[rr][2 * j4 + 1].x, S[rr][2 * j4 + 1].y};
    }
}
__device__ __forceinline__ void phase_rw_scan(const Ctx& C, const bf16_t* Rm, const bf16_t* Km, const bf16_t* Vm, const bf16_t* LD, const bf16_t* LA,
                                              const float* k_k, const float* k_a, const float* invsq, const float* state_in, bf16_t* YB, float* state_out) {
    const int lane = C.lane, w = C.wave;
    LAS float* buf = (LAS float*)(C.lds + (w < 4 ? w * 24576 : 98304 + (w - 4) * 12288));
    if (w < 4) { for (int slot = C.bid * 4 + w; slot < 1024; slot += C.G * 4) { const int id = slot >> 1; rw_scan_task<2, 8>(buf, lane, Rm, Km, Vm, LD, LA, k_k, k_a, invsq, state_in, YB, state_out, true, id >> 6, (id >> 1) & 31, id & 1, slot & 1); } }
    else { for (int id = C.bid * 4 + (w - 4); id < 1024; id += C.G * 4) rw_scan_task<4, 4>(buf, lane, Rm, Km, Vm, LD, LA, k_k, k_a, invsq, state_in, YB, state_out, false, id >> 6, (id >> 1) & 31, id & 1, 0); }
    if (w >= 4) late_transposes(C, buf, C.bid * 4 + (w - 4), C.G * 4);
    __syncthreads();
}

__device__ __forceinline__ float head8_sum(float v) { v = DPP_ADD(v, 0xB1); v = DPP_ADD(v, 0x4E); v = DPP_ADD(v, 0x141); return v; }
__device__ __forceinline__ void phase_rw_post(const Ctx& C, const bf16_t* YB, const bf16_t* Rm, const bf16_t* Km, const bf16_t* Vm, const bf16_t* LA, const bf16_t* Gt,
                                              const float* k_a, const float* r_k, const float* ln_w, const float* ln_b, bf16_t* Om) {
    const int gw = C.bid * 8 + C.wave, NGW = C.G * 8, lane = C.lane;
#pragma unroll 1
    for (int ch = 0; ch < 4; ++ch) {
        const int c0 = 8 * (lane + 64 * ch);
        const f32x4 ka0 = *(const f32x4*)(k_a + c0), ka1 = *(const f32x4*)(k_a + c0 + 4), rk0 = *(const f32x4*)(r_k + c0), rk1 = *(const f32x4*)(r_k + c0 + 4);
        const f32x4 lw0 = *(const f32x4*)(ln_w + c0), lw1 = *(const f32x4*)(ln_w + c0 + 4), lb0 = *(const f32x4*)(ln_b + c0), lb1 = *(const f32x4*)(ln_b + c0 + 4);
        u32x4 yfw, ybw, rr, kk, vv, gg, l0, l1;
#define PO_LOAD(m_) do { const size_t o_ = (size_t)(m_) * D + c0; const size_t oh_ = hm_index((m_), c0); yfw = *(const u32x4*)(YB + o_); ybw = *(const u32x4*)(YB + (size_t)MT * D + o_); \
            rr = *(const u32x4*)(Rm + oh_); kk = *(const u32x4*)(Km + oh_); vv = *(const u32x4*)(Vm + oh_); gg = *(const u32x4*)(Gt + o_); l0 = *(const u32x4*)(LA + oh_); l1 = *(const u32x4*)(LA + (size_t)MT * D + oh_); } while (0)
        int m = gw;
        if (m < MT) PO_LOAD(m);
        for (; m < MT; m += NGW) {
            float y[8], r[8], k[8], v[8], g[8], a0[8], a1[8], ka[8], rk[8], lw[8], lb[8];
            const unsigned pyf[4] = {yfw.x, yfw.y, yfw.z, yfw.w}, pyb[4] = {ybw.x, ybw.y, ybw.z, ybw.w}, pr[4] = {rr.x, rr.y, rr.z, rr.w}, pk[4] = {kk.x, kk.y, kk.z, kk.w}, pv[4] = {vv.x, vv.y, vv.z, vv.w}, pg[4] = {gg.x, gg.y, gg.z, gg.w}, p0[4] = {l0.x, l0.y, l0.z, l0.w}, p1[4] = {l1.x, l1.y, l1.z, l1.w};
#pragma unroll
            for (int j = 0; j < 4; ++j) {
                y[2 * j] = bflo(pyf[j]) + bflo(pyb[j]); y[2 * j + 1] = bfhi(pyf[j]) + bfhi(pyb[j]); ka[j] = ka0[j]; ka[4 + j] = ka1[j]; rk[j] = rk0[j]; rk[4 + j] = rk1[j]; lw[j] = lw0[j]; lw[4 + j] = lw1[j]; lb[j] = lb0[j]; lb[4 + j] = lb1[j];
                r[2 * j] = bflo(pr[j]); r[2 * j + 1] = bfhi(pr[j]); k[2 * j] = bflo(pk[j]); k[2 * j + 1] = bfhi(pk[j]); v[2 * j] = bflo(pv[j]); v[2 * j + 1] = bfhi(pv[j]);
                g[2 * j] = bflo(pg[j]); g[2 * j + 1] = bfhi(pg[j]); a0[2 * j] = fsigmoid(bflo(p0[j])); a0[2 * j + 1] = fsigmoid(bfhi(p0[j])); a1[2 * j] = fsigmoid(bflo(p1[j])); a1[2 * j + 1] = fsigmoid(bfhi(p1[j]));
            }
            float s = 0.f, bon = 0.f;
#pragma unroll
            for (int j = 0; j < 8; ++j) { s += y[j]; bon += r[j] * (k[j] * (2.0f + (a0[j] + a1[j] - 2.0f) * ka[j])) * rk[j]; }
            const float mean = head8_sum(s) * (1.0f / 64.0f); bon = head8_sum(bon);
            float q = 0.f;
#pragma unroll
            for (int j = 0; j < 8; ++j) { y[j] -= mean; q += y[j] * y[j]; }
            const float rstd = __builtin_amdgcn_rsqf(head8_sum(q) * (1.0f / 64.0f) + 64e-5f);
            float ov[8];
#pragma unroll
            for (int j = 0; j < 8; ++j) ov[j] = (y[j] * rstd * lw[j] + lb[j] + bon * v[j]) * g[j];
            u32x4 w; w.x = cvt_pk(ov[0], ov[1]); w.y = cvt_pk(ov[2], ov[3]); w.z = cvt_pk(ov[4], ov[5]); w.w = cvt_pk(ov[6], ov[7]);
            const int mn = m + NGW;
            if (mn < MT) PO_LOAD(mn);
            asm volatile("" ::: "memory");
            *(u32x4*)(Om + (size_t)m * D + c0) = w;
        }
#undef PO_LOAD
    }
}

constexpr int NPH = 35;
#define IN(k) (lo <= (k) && (k) < hi)
#define SEAM(k) do { if (IN(k) && IN((k) + 1)) xcd_barrier(bar); } while (0)
#define LDSG ((PG8_LAS unsigned char*)C.lds)
#ifndef MK_REP_MASK
#define MK_REP_MASK 0ull
#endif
#define REPQ(k) (((MK_REP_MASK) >> (k)) & 1ull)

template <class Epi>
__device__ __forceinline__ void run_gemm(const Ctx& C, const bf16_t* A, const bf16_t* Bt, int N, int K, const Epi& E) {
    pg8::Gemm g{A, Bt, MT, N, K, K}; pg8::StaticOrder S; S.init(MT, N, C.G, C.bid);
    pg8::gemm_phase<Epi, pg8::StaticOrder, false>(LDSG, g, S, E, nullptr);
}

#ifndef MK_SPLIT_MASK
#define MK_SPLIT_MASK 15
#endif
#define PREVP1(L) (((L) > 0 && (((MK_SPLIT_MASK) >> ((L) - 1)) & 1)) ? (const bf16_t*)WSP(bf16_t, WS_ARENA + AR_SLAB) : (const bf16_t*)nullptr)
constexpr size_t AR_SLAB = 200 * MiB;
constexpr size_t CTL_SPLIT = 65536;
template <int SET>
__device__ __forceinline__ void run_gemm_split_res(const Ctx& C, const bf16_t* A, const bf16_t* Bt, int K, bf16_t* X, const float* gate_base) {
    pg8::Gemm g{A, Bt, MT, D, K, K / 2}; TailSplitOrder S; S.init(C.G, C.bid, K / 64);
    EpiResidualSplitB E{X, gate_base, WSP(bf16_t, WS_ARENA + AR_SLAB)};
    pg8::gemm_phase<EpiResidualSplitB, TailSplitOrder, false>(LDSG, g, S, E, nullptr);
}
template <int LAYER>
__device__ __forceinline__ void mlp_block(const Ctx& C, const XcdBarrier& bar, int lo, int hi, int b0) {
    bf16_t* X = WSP(bf16_t, WS_X); bf16_t* H = WSP(bf16_t, WS_H); bf16_t* U = WSP(bf16_t, WS_ARENA + AR_U);
    if (IN(b0)) { { phase_norm_mod_b(C, X, karg<I_N2G>() + LAYER * D, LAYER, 3, H); } if (REPQ(b0)) { phase_norm_mod_b(C, X, karg<I_N2G>() + LAYER * D, LAYER, 3, H); } }
    SEAM(b0);
    if (IN(b0 + 1)) { { EpiBf16<1> E{U, FF}; run_gemm(C, H, WSP(bf16_t, WS_W1T) + (size_t)LAYER * D * FF, FF, D, E); } if (REPQ(b0 + 1)) { EpiBf16<1> E{U, FF}; run_gemm(C, H, WSP(bf16_t, WS_W1T) + (size_t)LAYER * D * FF, FF, D, E); } }
    SEAM(b0 + 1);
    if (IN(b0 + 2)) { { if constexpr (((MK_SPLIT_MASK) >> LAYER) & 1) run_gemm_split_res<LAYER>(C, U, WSP(bf16_t, WS_W2T) + (size_t)LAYER * D * FF, FF, X, MODP(LAYER, 0, 5)); else { EpiResidualB<false> E{X, MODP(LAYER, 0, 5), nullptr, nullptr}; run_gemm(C, U, WSP(bf16_t, WS_W2T) + (size_t)LAYER * D * FF, D, FF, E); } } if (REPQ(b0 + 2)) { if constexpr (((MK_SPLIT_MASK) >> LAYER) & 1) run_gemm_split_res<LAYER>(C, U, WSP(bf16_t, WS_W2T) + (size_t)LAYER * D * FF, FF, X, MODP(LAYER, 0, 5)); else { EpiResidualB<false> E{X, MODP(LAYER, 0, 5), nullptr, nullptr}; run_gemm(C, U, WSP(bf16_t, WS_W2T) + (size_t)LAYER * D * FF, D, FF, E); } } }
    SEAM(b0 + 2);
}

template <int LAYER, int J>
__device__ __forceinline__ void attn_layer(const Ctx& C, const XcdBarrier& bar, int lo, int hi, int b0) {
    bf16_t* X = WSP(bf16_t, WS_X); bf16_t* H = WSP(bf16_t, WS_H);
    bf16_t *Q = WSP(bf16_t, WS_ARENA + AR_Q), *Kb = WSP(bf16_t, WS_ARENA + AR_K), *Vb = WSP(bf16_t, WS_ARENA + AR_V), *O = WSP(bf16_t, WS_ARENA + AR_O);
    if (IN(b0)) { { if (LAYER == 0) { phase_fg_transpose(C); phase_norm_mod(C, karg<I_XP>(), karg<I_XS>(), karg<I_N1G>() + LAYER * D, LAYER, 0, H); } else phase_norm_mod_b(C, X, karg<I_N1G>() + LAYER * D, LAYER, 0, H, PREVP1(LAYER), X, 8192); } if (REPQ(b0)) { if (LAYER == 0) { phase_fg_transpose(C); phase_norm_mod(C, karg<I_XP>(), karg<I_XS>(), karg<I_N1G>() + LAYER * D, LAYER, 0, H); } else phase_norm_mod_b(C, X, karg<I_N1G>() + LAYER * D, LAYER, 0, H, PREVP1(LAYER), X, 8192); } }
    SEAM(b0);
    if (IN(b0 + 1)) { { EpiQKV E{Q, Kb, Vb, C.out + OUT_NK + (size_t)J * 256 * 512, C.out + OUT_NV + (size_t)J * 256 * 512}; run_gemm(C, H, WSP(bf16_t, WS_WQKVT) + (size_t)J * D * 3072, 3072, D, E); } if (REPQ(b0 + 1)) { EpiQKV E{Q, Kb, Vb, C.out + OUT_NK + (size_t)J * 256 * 512, C.out + OUT_NV + (size_t)J * 256 * 512}; run_gemm(C, H, WSP(bf16_t, WS_WQKVT) + (size_t)J * D * 3072, 3072, D, E); } }
    SEAM(b0 + 1);
    if (IN(b0 + 2)) { { phase_attention(C, Q, Kb, Vb, WSP(bf16_t, WS_KC) + (size_t)J * 512 * 512, WSP(bf16_t, WS_VC) + (size_t)J * 512 * 512, karg<I_SINK>() + J * 16, O); } if (REPQ(b0 + 2)) { phase_attention(C, Q, Kb, Vb, WSP(bf16_t, WS_KC) + (size_t)J * 512 * 512, WSP(bf16_t, WS_VC) + (size_t)J * 512 * 512, karg<I_SINK>() + J * 16, O); } }
    SEAM(b0 + 2);
    if (IN(b0 + 3)) { { EpiResidualB<LAYER == 0> E{X, MODP(LAYER, 0, 2), LAYER == 0 ? karg<I_XP>() : nullptr, LAYER == 0 ? karg<I_XS>() : nullptr}; run_gemm(C, O, WSP(bf16_t, WS_WOT) + (size_t)J * D * D, D, D, E); } if (REPQ(b0 + 3)) { EpiResidualB<LAYER == 0> E{X, MODP(LAYER, 0, 2), LAYER == 0 ? karg<I_XP>() : nullptr, LAYER == 0 ? karg<I_XS>() : nullptr}; run_gemm(C, O, WSP(bf16_t, WS_WOT) + (size_t)J * D * D, D, D, E); } }
    SEAM(b0 + 3);
    mlp_block<LAYER>(C, bar, lo, hi, b0 + 4);
}

template <int LAYER>
__device__ __forceinline__ void hyena_layer(const Ctx& C, const XcdBarrier& bar, int lo, int hi, int b0) {
    bf16_t* X = WSP(bf16_t, WS_X); bf16_t* H = WSP(bf16_t, WS_H);
    bf16_t *Pm = WSP(bf16_t, WS_ARENA + AR_P), *X0 = WSP(bf16_t, WS_ARENA + AR_X0), *ZT = WSP(bf16_t, WS_ARENA + AR_ZT), *YT = WSP(bf16_t, WS_ARENA + AR_YT), *HO = WSP(bf16_t, WS_ARENA + AR_HO);
    bf16_t *ZTp = ZT, *ZTs = ZT + (size_t)MP * D, *YTp = YT, *YTs = YT + (size_t)MP * D;
    if (IN(b0)) { { phase_norm_mod_b(C, X, karg<I_N1G>() + LAYER * D, LAYER, 0, H, PREVP1(LAYER), X, 8192); } if (REPQ(b0)) { phase_norm_mod_b(C, X, karg<I_N1G>() + LAYER * D, LAYER, 0, H, PREVP1(LAYER), X, 8192); } }
    SEAM(b0);
    if (IN(b0 + 1)) { { EpiBf16<0> E{Pm, 6144}; run_gemm(C, H, WSP(bf16_t, WS_HYINT), 6144, D, E); } if (REPQ(b0 + 1)) { EpiBf16<0> E{Pm, 6144}; run_gemm(C, H, WSP(bf16_t, WS_HYINT), 6144, D, E); } }
    SEAM(b0 + 1);
    if (IN(b0 + 2)) { { phase_hy_gate(C, Pm, karg<I_HYCW>(), karg<I_HYCB>(), X0, ZTp, ZTs); } if (REPQ(b0 + 2)) { phase_hy_gate(C, Pm, karg<I_HYCW>(), karg<I_HYCB>(), X0, ZTp, ZTs); } }
    SEAM(b0 + 2);
    if (IN(b0 + 3)) { { phase_hy_conv<1024, 8>(C, WSP(bf16_t, WS_FGS), ZTs, YTs); phase_hy_conv<256, 16>(C, WSP(bf16_t, WS_FGP), ZTp, YTp); } if (REPQ(b0 + 3)) { phase_hy_conv<1024, 8>(C, WSP(bf16_t, WS_FGS), ZTs, YTs); phase_hy_conv<256, 16>(C, WSP(bf16_t, WS_FGP), ZTp, YTp); } }
    SEAM(b0 + 3);
    if (IN(b0 + 4)) { { phase_hy_out(C, YTp, YTs, X0, HO); } if (REPQ(b0 + 4)) { phase_hy_out(C, YTp, YTs, X0, HO); } }
    SEAM(b0 + 4);
    if (IN(b0 + 5)) { { EpiResidualB<false> E{X, MODP(LAYER, 0, 2), nullptr, nullptr}; run_gemm(C, HO, WSP(bf16_t, WS_HYOUTT), D, D, E); } if (REPQ(b0 + 5)) { EpiResidualB<false> E{X, MODP(LAYER, 0, 2), nullptr, nullptr}; run_gemm(C, HO, WSP(bf16_t, WS_HYOUTT), D, D, E); } }
    SEAM(b0 + 5);
    mlp_block<LAYER>(C, bar, lo, hi, b0 + 6);
}

__device__ __forceinline__ void rw_g2_phase(const Ctx& C, const bf16_t* XM, bf16_t* Rm, bf16_t* A3, bf16_t* LD, bf16_t* LA, bf16_t* Gt) {
    if (C.G == 256 && C.bid >= 240) { pg8::Gemm g{XM, WSP(bf16_t, WS_RWBT), 6 * MT, 27 * 256, D, D}; RwOrder1 S{16, C.bid - 240, 1280, 27 * NPANEL, true}; EpiRw1 E{Rm, A3, karg<I_KK>(), WSP(float, WS_INVSQ)}; pg8::gemm_phase<EpiRw1, RwOrder1, false>(LDSG, g, S, E, nullptr); }
    else { pg8::Gemm g{A3, WSP(bf16_t, WS_LORA2T), 3 * MT, 40 * 256, 256, 256}; RwOrder2 S{C.G == 256 ? 240 : C.G, C.bid, nullptr, 0u}; EpiRw2 E{LD, LA, Gt, karg<I_W0>(), karg<I_A0>()}; pg8::gemm_phase<EpiRw2, RwOrder2, false>(LDSG, g, S, E, nullptr); }
}
template <int LAYER>
__device__ __forceinline__ void rwkv_layer(const Ctx& C, const XcdBarrier& bar, int lo, int hi, int b0) {
    bf16_t* X = WSP(bf16_t, WS_X); bf16_t* H = WSP(bf16_t, WS_H);
    bf16_t *XM = WSP(bf16_t, WS_ARENA + AR_XMIX), *LD = WSP(bf16_t, WS_ARENA + AR_LD), *LA = WSP(bf16_t, WS_ARENA + AR_LA), *Gt = WSP(bf16_t, WS_ARENA + AR_G), *RO = WSP(bf16_t, WS_ARENA + AR_RO);
    bf16_t *Rm = WSP(bf16_t, WS_ARENA + AR_R), *Km = WSP(bf16_t, WS_ARENA + AR_KK), *Vm = WSP(bf16_t, WS_ARENA + AR_VV), *A3 = WSP(bf16_t, WS_ARENA + AR_A3);
    bf16_t* YB = WSP(bf16_t, WS_ARENA + AR_YB);
    if (IN(b0)) { { phase_norm_mod_b(C, X, karg<I_N1G>() + LAYER * D, LAYER, 0, H, PREVP1(LAYER), X, 8192); } if (REPQ(b0)) { phase_norm_mod_b(C, X, karg<I_N1G>() + LAYER * D, LAYER, 0, H, PREVP1(LAYER), X, 8192); } }
    SEAM(b0);
    if (IN(b0 + 1)) { { phase_rw_mix(C, H, karg<I_MU>(), XM); } if (REPQ(b0 + 1)) { phase_rw_mix(C, H, karg<I_MU>(), XM); } }
    SEAM(b0 + 1);
    if (IN(b0 + 2)) { { pg8::Gemm g{XM, WSP(bf16_t, WS_RWBT), 6 * MT, 27 * 256, D, D}; RwOrder1 S{C.G, C.bid, 0, C.G == 256 ? 1280 : 27 * NPANEL, C.G == 256}; EpiRw1 E{Rm, A3, karg<I_KK>(), WSP(float, WS_INVSQ)}; pg8::gemm_phase<EpiRw1, RwOrder1, false>(LDSG, g, S, E, nullptr); } if (REPQ(b0 + 2)) { pg8::Gemm g{XM, WSP(bf16_t, WS_RWBT), 6 * MT, 27 * 256, D, D}; RwOrder1 S{C.G, C.bid, 0, C.G == 256 ? 1280 : 27 * NPANEL, C.G == 256}; EpiRw1 E{Rm, A3, karg<I_KK>(), WSP(float, WS_INVSQ)}; pg8::gemm_phase<EpiRw1, RwOrder1, false>(LDSG, g, S, E, nullptr); } }
    SEAM(b0 + 2);
    if (IN(b0 + 3)) { { rw_g2_phase(C, XM, Rm, A3, LD, LA, Gt); } if (REPQ(b0 + 3)) { rw_g2_phase(C, XM, Rm, A3, LD, LA, Gt); } }
    SEAM(b0 + 3);
    if (IN(b0 + 4)) { { phase_rw_scan(C, Rm, Km, Vm, LD, LA, karg<I_KK>(), karg<I_KA>(), WSP(float, WS_INVSQ), karg<I_ST>(), YB, C.out + OUT_ST); } if (REPQ(b0 + 4)) { phase_rw_scan(C, Rm, Km, Vm, LD, LA, karg<I_KK>(), karg<I_KA>(), WSP(float, WS_INVSQ), karg<I_ST>(), YB, C.out + OUT_ST); } }
    SEAM(b0 + 4);
    if (IN(b0 + 5)) { { phase_rw_post(C, YB, Rm, Km, Vm, LA, Gt, karg<I_KA>(), karg<I_RK>(), karg<I_LNW>(), karg<I_LNB>(), RO); } if (REPQ(b0 + 5)) { phase_rw_post(C, YB, Rm, Km, Vm, LA, Gt, karg<I_KA>(), karg<I_RK>(), karg<I_LNW>(), karg<I_LNB>(), RO); } }
    SEAM(b0 + 5);
    if (IN(b0 + 6)) { { EpiResidualB<false> E{X, MODP(LAYER, 0, 2), nullptr, nullptr}; run_gemm(C, RO, WSP(bf16_t, WS_RWOT), D, D, E); } if (REPQ(b0 + 6)) { EpiResidualB<false> E{X, MODP(LAYER, 0, 2), nullptr, nullptr}; run_gemm(C, RO, WSP(bf16_t, WS_RWOT), D, D, E); } }
    SEAM(b0 + 6);
    mlp_block<LAYER>(C, bar, lo, hi, b0 + 7);
}

__global__ void __launch_bounds__(512, 2) fwd_kernel(Params prm) {
    extern __shared__ __attribute__((aligned(16))) unsigned char lds_raw[];
    Ctx C;
    C.lds = (LAS unsigned char*)lds_raw;
    C.tid = threadIdx.x; C.lane = C.tid & 63; C.wave = __builtin_amdgcn_readfirstlane(C.tid >> 6); C.G = gridDim.x; C.bid = blockIdx.x;
    C.out = prm.out; C.ws = prm.ws;
    const int lo = prm.ph_lo, hi = prm.ph_hi;
    volatile LAS unsigned* xbw = (volatile LAS unsigned*)(C.lds + LDS_BAR_OFF);
    if (C.tid < 4) xbw[C.tid] = 0u;
    __syncthreads();
    XcdBarrier bar; bar.bar = (unsigned*)(C.ws + WS_CTL) + 1024; bar.x = 0; bar.st = xbw;
    if (hi - lo > 1) bar = xcd_barrier_post((unsigned*)(C.ws + WS_CTL) + 1024, xbw);

#ifdef MK_SKIP_FROM
    if (IN(0)) { for (size_t i = (size_t)C.bid * 512 + C.tid; i < (size_t)3 * 4194304; i += (size_t)C.G * 512) prm.out[OUT_NK + i] = 0.f; }
#endif
    if (IN(0)) { { phase_prologue(C); } if (REPQ(0)) { phase_prologue(C); } }
    SEAM(0);
    attn_layer<0, 0>(C, bar, lo, hi, 1);
    hyena_layer<1>(C, bar, lo, hi, 8);
    rwkv_layer<2>(C, bar, lo, hi, 17);
    attn_layer<3, 1>(C, bar, lo, hi, 27);
#ifndef MK_DBG_N
#define MK_DBG_N ((size_t)MT * D)
#endif
#ifndef MK_DBG_SCALE
#define MK_DBG_SCALE 1.0f
#endif
#ifdef MK_DBG_OFF
    if (IN(34)) { for (size_t i = (size_t)C.bid * 512 + C.tid; i < (size_t)MT * D; i += (size_t)C.G * 512) prm.out[OUT_Y + i] = i < (size_t)(MK_DBG_N) ? MK_DBG_SCALE * (MK_DBG_BF16 ? bf2f(WSP(bf16_t, MK_DBG_OFF)[i]) : WSP(float, MK_DBG_OFF)[i]) : 0.f; }
#else
    if (IN(34)) { { phase_norm_final_b(C, WSP(bf16_t, WS_X), karg<I_FNG>(), prm.out + OUT_Y, PREVP1(4), 8192); } if (REPQ(34)) { phase_norm_final_b(C, WSP(bf16_t, WS_X), karg<I_FNG>(), prm.out + OUT_Y, PREVP1(4), 8192); } }
#endif
}

#ifdef MK_SEP_CONV
__global__ void __launch_bounds__(512, 2) k_hyconv(Params prm) {
    extern __shared__ __attribute__((aligned(16))) unsigned char lds_raw3[];
    Ctx C; C.lds = (LAS unsigned char*)lds_raw3; C.tid = threadIdx.x; C.lane = C.tid & 63; C.wave = __builtin_amdgcn_readfirstlane(C.tid >> 6); C.G = gridDim.x; C.bid = blockIdx.x; C.out = prm.out; C.ws = prm.ws;
    bf16_t *ZT = WSP(bf16_t, WS_ARENA + AR_ZT), *YT = WSP(bf16_t, WS_ARENA + AR_YT);
    phase_hy_conv<1024, 8>(C, WSP(bf16_t, WS_FGS), ZT + (size_t)MP * D, YT + (size_t)MP * D); phase_hy_conv<256, 16>(C, WSP(bf16_t, WS_FGP), ZT, YT);
}
#endif
#ifdef MK_SEP_GATE
__global__ void __launch_bounds__(512, 2) k_hygate(Params prm) {
    extern __shared__ __attribute__((aligned(16))) unsigned char lds_raw2[];
    Ctx C; C.lds = (LAS unsigned char*)lds_raw2; C.tid = threadIdx.x; C.lane = C.tid & 63; C.wave = __builtin_amdgcn_readfirstlane(C.tid >> 6); C.G = gridDim.x; C.bid = blockIdx.x; C.out = prm.out; C.ws = prm.ws;
    bf16_t* ZT = WSP(bf16_t, WS_ARENA + AR_ZT);
    phase_hy_gate(C, WSP(bf16_t, WS_ARENA + AR_P), karg<I_HYCW>(), karg<I_HYCB>(), WSP(bf16_t, WS_ARENA + AR_X0), ZT, ZT + (size_t)MP * D);
}
#endif
#ifndef MK_PER_PHASE
#define MK_PER_PHASE 0
#endif
extern "C" void kernel_launch(void* const* d_in, const int* in_sizes, int n_in, void* d_out, int out_size, void* d_ws, size_t ws_size, hipStream_t stream) {
    static int grid = 0;
    if (grid == 0) {
        if (n_in != N_IN || ws_size < WS_END || out_size != 37748736) { fprintf(stderr, "kernel_launch: unexpected shapes (n_in %d, ws %zu, out %d); nothing launched\n", n_in, ws_size, out_size); grid = -1; return; }
        int dev = 0, cus = 0, per_cu = 0;
        if (hipGetDevice(&dev) != hipSuccess || hipDeviceGetAttribute(&cus, hipDeviceAttributeMultiprocessorCount, dev) != hipSuccess) { grid = -1; return; }
        if (hipFuncSetAttribute((const void*)fwd_kernel, hipFuncAttributeMaxDynamicSharedMemorySize, LDS_BYTES) != hipSuccess) { fprintf(stderr, "kernel_launch: hipFuncSetAttribute failed\n"); grid = -1; return; }
        if (hipOccupancyMaxActiveBlocksPerMultiprocessor(&per_cu, (const void*)fwd_kernel, 512, LDS_BYTES) != hipSuccess || per_cu < 1) { fprintf(stderr, "kernel_launch: occupancy query says %d\n", per_cu); }
        (void)hipGetLastError();
        grid = cus;
    }
    if (grid < 0) return;
    (void)hipMemsetAsync((char*)d_ws, 0, WS_ZERO_BYTES, stream);
    Params p{};
    for (int i = 0; i < N_IN; ++i) p.in[i] = (const float*)d_in[i];
    p.out = (float*)d_out; p.ws = (unsigned char*)d_ws;
#ifndef MK_LASTP
#define MK_LASTP NPH
#endif
#ifndef MK_FIRSTP
#define MK_FIRSTP 0
#endif
#if MK_PER_PHASE
    for (int k = MK_FIRSTP; k < MK_LASTP; ++k) {
#ifdef MK_SKIP_FROM
        if (k >= MK_SKIP_FROM && k < NPH - 1) continue;
#endif
#ifdef MK_SEP_CONV
        if (k == 11) { static bool a3 = false; if (!a3) { (void)hipFuncSetAttribute((const void*)k_hyconv, hipFuncAttributeMaxDynamicSharedMemorySize, 70000); a3 = true; } hipLaunchKernelGGL(k_hyconv, dim3(grid), dim3(512), 70000, stream, p); continue; }
#endif
#ifdef MK_SEP_GATE
        if (k == 10) { hipLaunchKernelGGL(k_hygate, dim3(grid), dim3(512), 16384, stream, p); continue; }
#endif
#ifdef MK_REPEAT_PH
        if (k == MK_REPEAT_PH) { p.ph_lo = k; p.ph_hi = k + 1; hipLaunchKernelGGL(fwd_kernel, dim3(grid), dim3(512), LDS_BYTES, stream, p); }
#endif
 p.ph_lo = k; p.ph_hi = k + 1; hipLaunchKernelGGL(fwd_kernel, dim3(grid), dim3(512), LDS_BYTES, stream, p); }
#else
    p.ph_lo = 0; p.ph_hi = NPH; hipLaunchKernelGGL(fwd_kernel, dim3(grid), dim3(512), LDS_BYTES, stream, p);
#endif
}
```

```cpp
#include <hip/hip_runtime.h>
#include <cstdio>
#include <cstdint>
namespace pg8 {
#define PG8_LAS __attribute__((address_space(3)))
typedef unsigned short bf16_t;
typedef short bf16x8 __attribute__((ext_vector_type(8)));
typedef float f32x4 __attribute__((ext_vector_type(4)));
typedef unsigned u32x4 __attribute__((ext_vector_type(4)));
constexpr int BM = 256, BK = 64, HALF = 128, HTB = HALF * BK * 2  , STAGE_BYTES = 8 * HTB, NXCD = 8, WGM = 4;

__host__ __device__ __forceinline__ int lds_byte(int r, int c) { const int st = (r >> 4) * 2 + (c >> 5), rr = r & 15, cc = c & 31, ob = rr * 64 + cc * 2; return st * 1024 + (ob ^ (((ob >> 9) & 1) << 5)); }
__host__ __device__ __forceinline__ void stage_rc(int b, int& R, int& C) { const int st = b / 1024, sb = b % 1024, swz = sb ^ (((sb >> 9) & 1) << 5); R = (st >> 1) * 16 + swz / 64; C = (st & 1) * 32 + (swz % 64) / 2; }
__host__ __device__ __forceinline__ int perm32(int rho) { const int n = rho >> 4, i = rho & 15; return 8 * (i >> 2) + 4 * n + (i & 3); }

struct Unit { int pm, pn, kh, mask; int nt = 0; };
struct Gemm { const bf16_t* A; const bf16_t* Bt; int M, N, K, KU; };

__host__ __device__ __forceinline__ bool tail_deal(int nwg, int G, int i, int c, int& L, int& mask) {
    const int full = nwg / G, rem = nwg - full * G;
    if (i < full) { L = i * G + c; mask = 15; return true; }
    if (i > full || rem == 0) return false;
    const int parts = (4 * rem <= G) ? 4 : ((2 * rem <= G) ? 2 : 1);
    if (c >= parts * rem) return false;
    L = full * G + c / parts; const int sub = c % parts;
    mask = parts == 1 ? 15 : (parts == 2 ? (sub ? 0xA : 0x5) : (1 << sub));
    return true;
}
struct StaticOrder {
    int nM, nN, nwg, G, c;
    __host__ __device__ void init(int M, int N, int G_, int c_) { nM = M / BM; nN = N / BM; nwg = nM * nN; G = G_; c = c_; }
    __host__ __device__ bool next(int i, Unit& u) const { const long L = (long)i * G + c; if (L >= nwg) return false; map((int)L, u); u.kh = 0; u.mask = 15; return true; }
    __host__ __device__ bool map(int L, Unit& u) const {
        int wgid = (int)L; { const int q = nwg / NXCD, r = nwg % NXCD, xcd = wgid % NXCD, off = wgid / NXCD; wgid = (xcd < r ? xcd * (q + 1) : r * (q + 1) + (xcd - r) * q) + off; }
        const int nig = WGM * nN, gid = wgid / nig, fm = gid * WGM, gsz = (nM - fm) < WGM ? (nM - fm) : WGM;
        u.pm = fm + ((wgid % nig) % gsz); u.pn = (wgid % nig) / gsz; return true;
    }
    __device__ __forceinline__ void a_ready(const Unit&) const {}
    __device__ __forceinline__ void done(const Unit&) const {}
};

template <class Epi, class Sched, bool STAMP = false>
__device__ __forceinline__ void gemm_phase(PG8_LAS unsigned char* lds, const Gemm g, const Sched& S, const Epi& E, unsigned long long* stamps) {
    const int tid = threadIdx.x, wid = __builtin_amdgcn_readfirstlane(tid >> 6), lane = tid & 63, wr = wid >> 2, wc = wid & 3, fr = lane & 15, fq = lane >> 4;
    const int K = g.K, nt = g.KU / BK;
    int ts_lo = 0, ts_hi = 0, nts = 0; const unsigned long long rt_entry = STAMP ? (unsigned long long)wall_clock64() : 0ull;
#define PG8_STAMP() do { if (STAMP && wid == 0 && nts < 64) { const unsigned long long _c = (unsigned long long)clock64(); \
        ts_lo = (lane == nts) ? (int)(unsigned)_c : ts_lo; ts_hi = (lane == nts) ? (int)(unsigned)(_c >> 32) : ts_hi; ++nts; } } while (0)
    PG8_STAMP();
    unsigned voffA[2], voffB[2];
#pragma unroll
    for (int i = 0; i < 2; ++i) { int R, C; stage_rc(tid * 16 + i * 8192, R, C); const int Rb = Epi::PERM ? ((R & ~31) + perm32(R & 31)) : R;
        voffA[i] = (unsigned)(R * K + C) * 2u; voffB[i] = (unsigned)(Rb * K + C) * 2u; }
    const size_t kstep = (size_t)(BK * 2);
    const size_t hstep = (size_t)HALF * K * 2;
    const size_t tstep = 2 * hstep;
    const unsigned ldsw = (unsigned)wid * 1024u;
    const int aoff = lds_byte(wr * 64 + fr, fq * 8), boff = lds_byte(wc * 32 + fr, fq * 8);
#define PG8_SA(b, h) (((b) * 2 + (h)) * HTB)
#define PG8_SB(b, h) ((4 + (b) * 2 + (h)) * HTB)
#define PG8_STAGE(bufoff, gbase, voff) do { _Pragma("unroll") for (int _i = 0; _i < 2; ++_i) \
        __builtin_amdgcn_global_load_lds((const unsigned*)((const char*)(gbase) + (voff)[_i]), (PG8_LAS unsigned*)(lds + (bufoff) + ldsw + _i * 8192), 16, 0, 0); } while (0)
#define PG8_LDA(dst, b, h) do { _Pragma("unroll") for (int m = 0; m < 4; ++m) _Pragma("unroll") for (int k = 0; k < 2; ++k) dst[m][k] = *(const PG8_LAS bf16x8*)(lds + PG8_SA(b, h) + aoff + m * 2048 + k * 1024); } while (0)
#define PG8_LDB(dst, b, h) do { _Pragma("unroll") for (int n = 0; n < 2; ++n) _Pragma("unroll") for (int k = 0; k < 2; ++k) dst[n][k] = *(const PG8_LAS bf16x8*)(lds + PG8_SB(b, h) + boff + n * 2048 + k * 1024); } while (0)
#define PG8_MMA(ai, bj, At, Bt) do { __builtin_amdgcn_s_setprio(1); _Pragma("unroll") for (int k = 0; k < 2; ++k) _Pragma("unroll") for (int m = 0; m < 4; ++m) _Pragma("unroll") for (int n = 0; n < 2; ++n) \
        asm volatile("v_mfma_f32_16x16x32_bf16 %0, %1, %2, %0" : "+v"(acc[ai][bj][m][n]) : "v"(Bt[n][k]), "v"(At[m][k])); __builtin_amdgcn_s_setprio(0); } while (0)
#define PG8_ACC_FENCE1(ai, bj) asm volatile("s_nop 15\n\ts_nop 15" : "+v"(acc[ai][bj][0][0]), "+v"(acc[ai][bj][0][1]), "+v"(acc[ai][bj][1][0]), "+v"(acc[ai][bj][1][1]), "+v"(acc[ai][bj][2][0]), "+v"(acc[ai][bj][2][1]), "+v"(acc[ai][bj][3][0]), "+v"(acc[ai][bj][3][1]))
#define PG8_ACC_FENCE() do { PG8_ACC_FENCE1(0, 0); PG8_ACC_FENCE1(0, 1); PG8_ACC_FENCE1(1, 0); PG8_ACC_FENCE1(1, 1); } while (0)
#define PG8_WAIT_V(n) asm volatile("s_waitcnt vmcnt(" #n ")" ::: "memory")
#define PG8_WAIT_L(n) asm volatile("s_waitcnt lgkmcnt(" #n ")" ::: "memory")
#define PG8_BAR __builtin_amdgcn_s_barrier()
#define PG8_SCHED __builtin_amdgcn_sched_barrier(0)
    Unit cur, nxt; int ui = 0;
    if (!S.next(0, cur)) return;
    f32x4 acc[2][2][4][2];
#pragma unroll
    for (int a = 0; a < 2; ++a)
#pragma unroll
        for (int b = 0; b < 2; ++b)
#pragma unroll
            for (int m = 0; m < 4; ++m)
#pragma unroll
                for (int n = 0; n < 2; ++n) acc[a][b][m][n] = (f32x4){0.f, 0.f, 0.f, 0.f};
    bf16x8 At[4][2], B0[2][2], B1[2][2];
    const size_t kslice = (size_t)g.KU * 2;
    const char* cA = (const char*)g.A + (size_t)cur.pm * tstep + cur.kh * kslice; const char* cB = (const char*)g.Bt + (size_t)cur.pn * tstep + cur.kh * kslice;
    S.a_ready(cur);
    PG8_STAGE(PG8_SB(0, 0), cB, voffB); PG8_STAGE(PG8_SA(0, 0), cA, voffA); PG8_STAGE(PG8_SB(0, 1), cB + hstep, voffB); PG8_STAGE(PG8_SA(0, 1), cA + hstep, voffA);
    if (wr == 1) PG8_BAR;
    PG8_WAIT_V(4); PG8_BAR;
    PG8_STAGE(PG8_SB(1, 0), cB + kstep, voffB); PG8_STAGE(PG8_SA(1, 0), cA + kstep, voffA); PG8_STAGE(PG8_SB(1, 1), cB + hstep + kstep, voffB);
    PG8_WAIT_V(6); PG8_BAR;
    PG8_STAMP();
    for (;;) {
        const bool has_next = S.next(ui + 1, nxt);
        const char* nA = has_next ? (const char*)g.A + (size_t)nxt.pm * tstep + nxt.kh * kslice : cA; const char* nB = has_next ? (const char*)g.Bt + (size_t)nxt.pn * tstep + nxt.kh * kslice : cB;
        const int unt = cur.nt ? cur.nt : nt;
        const bool pre = ui > 0;
        for (int t = 0; t < unt; t += 2) {
            const bool last = (t == unt - 2);
            const char* a1 = cA + (size_t)(t + 1) * kstep;
            const char* a2 = last ? nA : cA + (size_t)(t + 2) * kstep; const char* b2 = last ? nB : cB + (size_t)(t + 2) * kstep;
            const char* a3 = a2 + kstep; const char* b3 = b2 + kstep;
            if (last && has_next) S.a_ready(nxt);
            PG8_LDB(B0, 0, 0); PG8_SCHED; PG8_LDA(At, 0, 0); if (!(pre && t == 0)) PG8_STAGE(PG8_SA(1, 1), a1 + hstep, voffA);
            PG8_WAIT_L(8); PG8_BAR; PG8_WAIT_L(0); PG8_MMA(0, 0, At, B0); PG8_BAR; PG8_SCHED;
            PG8_LDB(B1, 0, 1); PG8_STAGE(PG8_SB(0, 0), b2, voffB);
            PG8_BAR; PG8_WAIT_L(0); PG8_MMA(0, 1, At, B1); PG8_BAR;
            PG8_LDA(At, 0, 1); PG8_STAGE(PG8_SA(0, 0), a2, voffA);
            PG8_BAR; PG8_WAIT_L(0); PG8_MMA(1, 0, At, B0); PG8_BAR; PG8_SCHED;
            PG8_STAGE(PG8_SB(0, 1), b2 + hstep, voffB);
            if (pre && t == 0) PG8_WAIT_V(22); else PG8_WAIT_V(6);
            PG8_BAR; PG8_MMA(1, 1, At, B1); PG8_BAR;
            PG8_LDB(B0, 1, 0); PG8_SCHED; PG8_LDA(At, 1, 0); PG8_STAGE(PG8_SA(0, 1), a2 + hstep, voffA);
            PG8_WAIT_L(8); PG8_BAR; PG8_WAIT_L(0); PG8_MMA(0, 0, At, B0); PG8_BAR; PG8_SCHED;
            PG8_LDB(B1, 1, 1); PG8_STAGE(PG8_SB(1, 0), b3, voffB);
            PG8_BAR; PG8_WAIT_L(0); PG8_MMA(0, 1, At, B1); PG8_BAR;
            PG8_LDA(At, 1, 1); PG8_STAGE(PG8_SA(1, 0), a3, voffA);
            PG8_BAR; PG8_WAIT_L(0); PG8_MMA(1, 0, At, B0); PG8_BAR; PG8_SCHED;
            PG8_STAGE(PG8_SB(1, 1), b3 + hstep, voffB);
            PG8_WAIT_V(6); PG8_BAR; PG8_MMA(1, 1, At, B1); PG8_BAR;
        }
        PG8_STAMP();
        if (has_next) { PG8_STAGE(PG8_SA(1, 1), nA + kstep + hstep, voffA); }
        asm volatile("" ::: "memory"); PG8_SCHED;
        PG8_ACC_FENCE();
        if constexpr (!Epi::AFTER_DRAIN) { E(acc, cur, wr, wc, fr, fq); S.done(cur); }
        PG8_STAMP();
        if (!has_next) break;
#pragma unroll
        for (int a = 0; a < 2; ++a)
#pragma unroll
            for (int b = 0; b < 2; ++b)
#pragma unroll
                for (int m = 0; m < 4; ++m)
#pragma unroll
                    for (int n = 0; n < 2; ++n) acc[a][b][m][n] = (f32x4){0.f, 0.f, 0.f, 0.f};
        cur = nxt; cA = nA; cB = nB; ++ui;
    }
    PG8_WAIT_V(0);
    if (wr == 0) PG8_BAR;
    PG8_BAR;
    if constexpr (Epi::AFTER_DRAIN) { E.fused(acc, cur, wr, wc, fr, fq, lds, wid, lane); S.done(cur); }
    PG8_STAMP();
    if (STAMP && wid == 0) { stamps[lane] = lane < nts ? (((unsigned long long)(unsigned)ts_hi << 32) | (unsigned)ts_lo) : 0ull;
        if (lane == 62) stamps[62] = rt_entry; if (lane == 63) stamps[63] = (unsigned long long)wall_clock64(); }
#undef PG8_STAMP
#undef PG8_SA
#undef PG8_SB
#undef PG8_STAGE
#undef PG8_LDA
#undef PG8_LDB
#undef PG8_MMA
#undef PG8_ACC_FENCE
#undef PG8_ACC_FENCE1
#undef PG8_WAIT_V
#undef PG8_WAIT_L
#undef PG8_BAR
#undef PG8_SCHED
}
}

#define XB_TMO      128
#define XB_XCNT(j)  (256  + 64 * (j))
#define XB_XSUB(j)  (1280 + 64 * (j))
#define XB_XGEN(j)  (2304 + 64 * (j))
#define XB_TOP      3328
#define XB_TOPGEN   3392
#define XCD_BAR_WORDS 3456
#define XB_SPIN_CAP (1u << 20)
#define LAS __attribute__((address_space(3)))

__device__ __forceinline__ unsigned xb_ld(unsigned* p)              { return __hip_atomic_load(p, __ATOMIC_RELAXED, __HIP_MEMORY_SCOPE_AGENT); }
__device__ __forceinline__ unsigned xb_add(unsigned* p, unsigned v) { return __hip_atomic_fetch_add(p, v, __ATOMIC_RELAXED, __HIP_MEMORY_SCOPE_AGENT); }
__device__ __forceinline__ unsigned xb_xcc_id() { return (unsigned)__builtin_amdgcn_s_getreg((3 << 11) | 20) & 0xFu; }
#define XB_SPIN(cond, bar) do { unsigned _sp = 0; while (cond) { __builtin_amdgcn_s_sleep(1); \
    if ((++_sp & 255u) == 0u) { if (xb_ld(&(bar)[XB_TMO])) break; if (_sp > XB_SPIN_CAP) { atomicAdd(&(bar)[XB_TMO], 1u); break; } } } } while (0)

struct XcdBarrier {
    unsigned* bar; unsigned x;
    volatile LAS unsigned* st;
};

__device__ __forceinline__ XcdBarrier xcd_barrier_post(unsigned* bar, volatile LAS unsigned* st) {
    XcdBarrier b; b.bar = bar; b.x = xb_xcc_id(); b.st = st;
    if (threadIdx.x == 0) (void)xb_add(&bar[XB_XCNT(b.x)], 1u);
    return b;
}
__device__ __forceinline__ void xcd_barrier_complete(unsigned* bar, unsigned x, unsigned& nloc, unsigned& nx) {
    const unsigned G = gridDim.x * gridDim.y * gridDim.z;
    unsigned sum, cnt, mine, sp = 0u;
    for (;;) {
        sum = 0u; cnt = 0u; mine = 0u;
#pragma unroll
        for (unsigned j = 0; j < 16; ++j) { const unsigned c = xb_ld(&bar[XB_XCNT(j)]); sum += c; cnt += (c > 0u) ? 1u : 0u; mine = (j == x) ? c : mine; }
        if (sum == G) break;
        __builtin_amdgcn_s_sleep(1);
        if ((++sp & 255u) == 0u) { if (xb_ld(&bar[XB_TMO])) break; if (sp > XB_SPIN_CAP) { atomicAdd(&bar[XB_TMO], 1u); break; } }
    }
    nloc = mine > 0u ? mine : 1u; nx = cnt > 0u ? cnt : 1u;
}

__device__ __forceinline__ void xcd_barrier(const XcdBarrier& b) {
    asm volatile("s_waitcnt vmcnt(0)" ::: "memory");
    __syncthreads();
    if (threadIdx.x == 0) {
        unsigned* bar = b.bar;
        __builtin_amdgcn_s_waitcnt(0);
        unsigned nloc = b.st[0], nx = b.st[1];
        if (nloc == 0u) { xcd_barrier_complete(bar, b.x, nloc, nx); b.st[0] = nloc; b.st[1] = nx; }
        const unsigned old = xb_add(&bar[XB_XSUB(b.x)], 1u);
        const unsigned gen = old / nloc;
        if (old + 1u == (gen + 1u) * nloc) {
            __builtin_amdgcn_fence(__ATOMIC_RELEASE, "agent");
            asm volatile("s_waitcnt vmcnt(0)" ::: "memory");
            const unsigned og = xb_add(&bar[XB_TOP], 1u);
            const unsigned tg = og / nx;
            if (og + 1u == (tg + 1u) * nx) xb_add(&bar[XB_TOPGEN], 1u);
            else XB_SPIN(xb_ld(&bar[XB_TOPGEN]) == tg, bar);
            __builtin_amdgcn_fence(__ATOMIC_ACQUIRE, "agent");
            xb_add(&bar[XB_XGEN(b.x)], 1u);
            asm volatile("s_waitcnt vmcnt(0)" ::: "memory");
        } else {
            XB_SPIN(xb_ld(&bar[XB_XGEN(b.x)]) == gen, bar);
            __builtin_amdgcn_fence(__ATOMIC_ACQUIRE, "agent");
            asm volatile("s_waitcnt vmcnt(0)" ::: "memory");
        }
    }
    __syncthreads();
}

typedef unsigned short bf16_t;
typedef short bf16x8 __attribute__((ext_vector_type(8)));
typedef short bf16x4 __attribute__((ext_vector_type(4)));
typedef float f32x2 __attribute__((ext_vector_type(2)));
typedef float f32x4 __attribute__((ext_vector_type(4)));
typedef float f32x16 __attribute__((ext_vector_type(16)));
typedef unsigned u32x4 __attribute__((ext_vector_type(4)));
typedef unsigned u32x2 __attribute__((ext_vector_type(2)));

constexpr int D = 2048, FF = 8192, MP = 4096, MS = 8192, MT = 12288;
constexpr int NPANEL = MT / 256;
constexpr size_t MiB = 1u << 20;
constexpr size_t WS_CTL = 0, WS_MOD = 1 * MiB, WS_ZERO_BYTES = 3 * MiB;
constexpr size_t WS_ROPE = 3 * MiB;
constexpr size_t WS_W1T = 4 * MiB, WS_W2T = 132 * MiB, WS_WQKVT = 260 * MiB, WS_WOT = 284 * MiB, WS_HYINT = 300 * MiB, WS_HYOUTT = 324 * MiB;
constexpr size_t WS_RWBT = 332 * MiB, WS_LORA2T = 359 * MiB, WS_RWOT = 364 * MiB, WS_KC = 372 * MiB, WS_VC = 380 * MiB, WS_FGS = 388 * MiB, WS_FGP = 397 * MiB;
constexpr size_t WS_X = 400 * MiB, WS_H = 496 * MiB, WS_ARENA = 544 * MiB, WS_INVSQ = 1186 * MiB, WS_END = 1188 * MiB;
constexpr size_t AR_U = 0;
constexpr size_t AR_Q = 0, AR_K = 48 * MiB, AR_V = 60 * MiB, AR_O = 72 * MiB;
constexpr size_t AR_P = 0, AR_X0 = 144 * MiB, AR_ZT = 192 * MiB, AR_YT = 240 * MiB, AR_HO = 288 * MiB;
constexpr size_t AR_XMIX = 0, AR_LD = 546 * MiB  , AR_LA = 96 * MiB, AR_G = 192 * MiB, AR_RO = 240 * MiB, AR_R = 288 * MiB, AR_KK = 336 * MiB, AR_VV = 384 * MiB, AR_A3 = 432 * MiB, AR_YB = 450 * MiB;
constexpr size_t OUT_Y = 0, OUT_NK = 25165824, OUT_NV = 29360128, OUT_ST = 33554432;
constexpr int FGS_ROW = 2112, FGP_ROW = 576;
constexpr size_t AR_FILT = 600 * MiB;
constexpr int LDS_BAR_OFF = 147456, LDS_BYTES = 147456 + 1024;

enum { I_XP = 0, I_XS, I_CK, I_CV, I_ST, I_C, I_CCTX, I_ADAW, I_ADAB, I_N1G, I_N2G, I_MW1, I_MW2, I_WQKV, I_WO, I_SINK, I_HYWIN, I_HYCW, I_HYCB, I_FW1, I_FB1, I_FW2, I_FB2, I_FW3, I_FB3,
       I_FREQ, I_FWOUT, I_HYBIAS, I_HYWOUT, I_MU, I_WR, I_WK, I_WV, I_RWO, I_W0, I_W1, I_W2, I_A0, I_A1, I_A2, I_G1, I_G2, I_KK, I_KA, I_RK, I_LNW, I_LNB, I_FNG, N_IN };

struct Params { const float* in[N_IN]; float* out; unsigned char* ws; int ph_lo, ph_hi; };

__device__ __forceinline__ unsigned cvt_pk(float lo, float hi) { unsigned r; asm("v_cvt_pk_bf16_f32 %0, %1, %2" : "=v"(r) : "v"(lo), "v"(hi)); return r; }
__device__ __forceinline__ float bflo(unsigned w) { return __uint_as_float(w << 16); }
__device__ __forceinline__ float bfhi(unsigned w) { return __uint_as_float(w & 0xffff0000u); }
__device__ __forceinline__ float bf2f(bf16_t b) { return __uint_as_float(((unsigned)b) << 16); }
__device__ __forceinline__ float dpp_f(float x, const int ctrl) { return x; }
#define DPP_ADD(x, ctrl) ((x) + __int_as_float(__builtin_amdgcn_update_dpp(0, __float_as_int(x), (ctrl), 0xF, 0xF, true)))
__device__ __forceinline__ float wave_sum(float v) {
    v = DPP_ADD(v, 0xB1); v = DPP_ADD(v, 0x4E); v = DPP_ADD(v, 0x141); v = DPP_ADD(v, 0x140);
    const int vi = __float_as_int(v);
    const float r0 = __int_as_float(__builtin_amdgcn_readlane(vi, 0)), r1 = __int_as_float(__builtin_amdgcn_readlane(vi, 16)),
                r2 = __int_as_float(__builtin_amdgcn_readlane(vi, 32)), r3 = __int_as_float(__builtin_amdgcn_readlane(vi, 48));
    return (r0 + r1) + (r2 + r3);
}
__device__ __forceinline__ float opaque_zero() { float z; asm volatile("v_mov_b32 %0, 0" : "=v"(z)); return z; }
__device__ __forceinline__ float fexp2(float x) { return __builtin_amdgcn_exp2f(x); }
__device__ __forceinline__ float fexp(float x) { return __builtin_amdgcn_exp2f(x * 1.4426950408889634f); }
__device__ __forceinline__ float flog(float x) { return __builtin_amdgcn_logf(x) * 0.6931471805599453f; }
__device__ __forceinline__ float frcp(float x) { return __builtin_amdgcn_rcpf(x); }
__device__ __forceinline__ float fsigmoid(float x) { return frcp(1.0f + fexp(-x)); }
__device__ __forceinline__ float ftanh(float x) { const float e = fexp(2.0f * x); return 1.0f - 2.0f * frcp(e + 1.0f); }
__device__ __forceinline__ float fsoftplus(float x) { return fmaxf(x, 0.0f) + flog(1.0f + fexp(-fabsf(x))); }
__device__ __forceinline__ float fsin_rev(float rev) { return __builtin_amdgcn_sinf(rev - rintf(rev)); }
__device__ __forceinline__ float fcos_rev(float rev) { return __builtin_amdgcn_cosf(rev - rintf(rev)); }
__device__ __forceinline__ float fsin(float x) { return fsin_rev(x * 0.15915494309189535f); }
__device__ __forceinline__ int cond_of_row(int m) { return m < MP ? 0 : 1 + ((m - MP) >> 10); }
__device__ __forceinline__ int cond_of_panel(int pm) { return pm < 16 ? 0 : 1 + ((pm - 16) >> 2); }

struct Ctx {
    LAS unsigned char* lds;
    int tid, lane, wave, G, bid;
    float* out;
    unsigned char* ws;
};
template <int IDX> __device__ __forceinline__ const float* karg() {
    unsigned long long v;
    asm volatile("s_load_dwordx2 %0, %1, %2\n\ts_waitcnt lgkmcnt(0)" : "=s"(v) : "s"(__builtin_amdgcn_kernarg_segment_ptr()), "n"(IDX * 8));
    return (const float*)v;
}
#define WSP(T, off) ((T*)(C.ws + (off)))
#define MODP(l, cond, which) (WSP(float, WS_MOD) + ((size_t)((l) * 9 + (cond)) * 6 + (which)) * D)

__device__ __forceinline__ void p0_transpose_item(const float* W, int K, int N, bf16_t* WT, LAS float* scr, int item, int lane) {
    const int nblk = N / 32, kb = item / nblk, nb = item % nblk, k0 = 64 * kb, n0 = 32 * nb;
    const int rsub = lane >> 3, c4 = (lane & 7) * 4;
    f32x4 v[8];
#pragma unroll
    for (int i = 0; i < 8; ++i) v[i] = *(const f32x4*)(W + (size_t)(k0 + 8 * i + rsub) * N + n0 + c4);
#pragma unroll
    for (int i = 0; i < 8; ++i) { LAS float* d = scr + (8 * i + rsub) * 33 + c4; d[0] = v[i].x; d[1] = v[i].y; d[2] = v[i].z; d[3] = v[i].w; }
    asm volatile("s_waitcnt lgkmcnt(0)" ::: "memory");
    const int c = lane & 7;
#pragma unroll
    for (int j = 0; j < 4; ++j) { const int n = (lane >> 3) + 8 * j; const LAS float* s = scr + (8 * c) * 33 + n;
        u32x4 o; o.x = cvt_pk(s[0 * 33], s[1 * 33]); o.y = cvt_pk(s[2 * 33], s[3 * 33]); o.z = cvt_pk(s[4 * 33], s[5 * 33]); o.w = cvt_pk(s[6 * 33], s[7 * 33]);
        *(u32x4*)(WT + (size_t)(n0 + n) * K + k0 + 8 * c) = o; }
    asm volatile("s_waitcnt lgkmcnt(0)" ::: "memory");
}

__device__ __forceinline__ void late_transposes(const Ctx& C, LAS float* scr, int wv, int nwv) {
    constexpr int I_M = 8192, I_QKV = 3072, I_O = 2048;
    constexpr int NIT = 4 * I_M + I_QKV + I_O;
    for (int it = wv; it < NIT; it += nwv) {
        int r = it;
        if (r < 2 * I_M) { const int l = 2 + r / I_M; p0_transpose_item(karg<I_MW1>() + (size_t)l * D * FF, D, FF, WSP(bf16_t, WS_W1T) + (size_t)l * D * FF, scr, r % I_M, C.lane); continue; } r -= 2 * I_M;
        if (r < 2 * I_M) { const int l = 2 + r / I_M; p0_transpose_item(karg<I_MW2>() + (size_t)l * D * FF, FF, D, WSP(bf16_t, WS_W2T) + (size_t)l * D * FF, scr, r % I_M, C.lane); continue; } r -= 2 * I_M;
        if (r < I_QKV) { p0_transpose_item(karg<I_WQKV>() + (size_t)D * 3072, D, 3072, WSP(bf16_t, WS_WQKVT) + (size_t)D * 3072, scr, r, C.lane); continue; } r -= I_QKV;
        p0_transpose_item(karg<I_WO>() + (size_t)D * D, D, D, WSP(bf16_t, WS_WOT) + (size_t)D * D, scr, r, C.lane);
    }
}
#ifndef MK_PRO_MASK
#define MK_PRO_MASK 127
#endif
__device__ __forceinline__ void phase_prologue(const Ctx& C) {
    const int gw = C.bid * 8 + C.wave, NGW = C.G * 8, lane = C.lane;
    const size_t gt = (size_t)C.bid * 512 + C.tid, NGT = (size_t)C.G * 512;
    LAS float* scr = (LAS float*)(C.lds + C.wave * 16384);
    if (MK_PRO_MASK & 1)
    {
        constexpr int I_M1 = 8192, I_M2 = 8192, I_QKV = 3072, I_O = 2048, I_HI = 6144, I_SQ = 2048;
        constexpr int NIT = 2 * I_M1 + 2 * I_M2 + I_QKV + I_O + I_HI + I_SQ + 4 * I_SQ;
        for (int it = gw; it < NIT; it += NGW) {
            int r = it;
            if (r < 2 * I_M1) { const int l = r / I_M1; p0_transpose_item(karg<I_MW1>() + (size_t)l * D * FF, D, FF, WSP(bf16_t, WS_W1T) + (size_t)l * D * FF, scr, r % I_M1, lane); continue; } r -= 2 * I_M1;
            if (r < 2 * I_M2) { const int l = r / I_M2; p0_transpose_item(karg<I_MW2>() + (size_t)l * D * FF, FF, D, WSP(bf16_t, WS_W2T) + (size_t)l * D * FF, scr, r % I_M2, lane); continue; } r -= 2 * I_M2;
            if (r < I_QKV) { p0_transpose_item(karg<I_WQKV>(), D, 3072, WSP(bf16_t, WS_WQKVT), scr, r, lane); continue; } r -= I_QKV;
            if (r < I_O) { p0_transpose_item(karg<I_WO>(), D, D, WSP(bf16_t, WS_WOT), scr, r, lane); continue; } r -= I_O;
            if (r < I_HI) { p0_transpose_item(karg<I_HYWIN>(), D, 6144, WSP(bf16_t, WS_HYINT), scr, r, lane); continue; } r -= I_HI;
            if (r < I_SQ) { p0_transpose_item(karg<I_HYWOUT>(), D, D, WSP(bf16_t, WS_HYOUTT), scr, r, lane); continue; } r -= I_SQ;
            if (r < I_SQ) { p0_transpose_item(karg<I_WR>(), D, D, WSP(bf16_t, WS_RWBT), scr, r, lane); continue; } r -= I_SQ;
            if (r < I_SQ) { p0_transpose_item(karg<I_WK>(), D, D, WSP(bf16_t, WS_RWBT) + (size_t)D * D, scr, r, lane); continue; } r -= I_SQ;
            if (r < I_SQ) { p0_transpose_item(karg<I_WV>(), D, D, WSP(bf16_t, WS_RWBT) + (size_t)2 * D * D, scr, r, lane); continue; } r -= I_SQ;
            p0_transpose_item(karg<I_RWO>(), D, D, WSP(bf16_t, WS_RWOT), scr, r, lane);
        }
    }
    if (MK_PRO_MASK & 2)
    {
        bf16_t* L1 = WSP(bf16_t, WS_RWBT) + (size_t)3 * D * D;
#pragma unroll
        for (int part = 0; part < 7; ++part) {
            const int row0 = part == 0 ? 0 : part == 1 ? 96 : part == 2 ? 192 : part == 3 ? 256 : part == 4 ? 352 : part == 5 ? 448 : 512;
            const int nrow = (part == 2 || part == 5) ? 64 : (part == 6 ? 256 : 96);
            const int ld = part == 6 ? 256 : 96;
            const float* src = part == 0 ? karg<I_W1>() : part == 1 ? karg<I_W1>() + (size_t)D * 96 : part == 3 ? karg<I_A1>() : part == 4 ? karg<I_A1>() + (size_t)D * 96 : karg<I_G1>();
            const bool zero = (part == 2 || part == 5);
            for (size_t i = gt; i < (size_t)nrow * 256; i += NGT) {
                const int rr = (int)(i / 256), k8 = (int)(i % 256);
                float v[8];
#pragma unroll
                for (int j = 0; j < 8; ++j) v[j] = zero ? 0.0f : src[(size_t)(8 * k8 + j) * ld + rr];
                u32x4 o; o.x = cvt_pk(v[0], v[1]); o.y = cvt_pk(v[2], v[3]); o.z = cvt_pk(v[4], v[5]); o.w = cvt_pk(v[6], v[7]);
                *(u32x4*)(L1 + (size_t)(row0 + rr) * D + 8 * k8) = o;
            }
        }
        bf16_t* L2 = WSP(bf16_t, WS_LORA2T);
#pragma unroll
        for (int mat = 0; mat < 5; ++mat) {
            const float* src = mat == 0 ? karg<I_W2>() : mat == 1 ? karg<I_W2>() + (size_t)96 * D : mat == 2 ? karg<I_A2>() : mat == 3 ? karg<I_A2>() + (size_t)96 * D : karg<I_G2>();
            const int kofs = (mat == 1 || mat == 3) ? 96 : 0, klen = mat == 4 ? 256 : 96;
            for (size_t i = gt; i < (size_t)2048 * 32; i += NGT) {
                const int n = (int)(i / 32), k8 = (int)(i % 32);
                float v[8];
#pragma unroll
                for (int j = 0; j < 8; ++j) { const int k = 8 * k8 + j - kofs; const int kc = k < 0 ? 0 : (k >= klen ? klen - 1 : k); const float x = src[(size_t)kc * D + n]; v[j] = (k >= 0 && k < klen) ? x : 0.0f; }
                u32x4 o; o.x = cvt_pk(v[0], v[1]); o.y = cvt_pk(v[2], v[3]); o.z = cvt_pk(v[4], v[5]); o.w = cvt_pk(v[6], v[7]);
                *(u32x4*)(L2 + ((size_t)mat * 2048 + n) * 256 + 8 * k8) = o;
            }
        }
    }
    if (MK_PRO_MASK & 4)
    for (size_t i = gt; i < 2048; i += NGT) {
        const int pos = (int)(i >> 5), fi = (int)(i & 31);
        const float inv = fexp2(-(float)(2 * fi) * (13.287712379549449f / 64.0f));
        const float rev = (float)pos * inv * 0.15915494309189535f;
        WSP(f32x2, WS_ROPE)[i] = (f32x2){fcos_rev(rev), fsin_rev(rev)};
    }
    for (size_t i = gt; i < (size_t)MT * 32 / 4; i += NGT) WSP(f32x4, WS_INVSQ)[i] = (f32x4){0.f, 0.f, 0.f, 0.f};
    if (MK_PRO_MASK & 8)
    { const float *ckp = karg<I_CK>(), *cvp = karg<I_CV>();
    for (size_t i = gt; i < (size_t)2 * 524288; i += NGT) {
        const bool isv = i >= 524288; const size_t e = (isv ? i - 524288 : i) * 8;
        const float* src = (isv ? cvp : ckp) + e;
        const f32x4 a = *(const f32x4*)src, b = *(const f32x4*)(src + 4);
        u32x4 o; o.x = cvt_pk(a.x, a.y); o.y = cvt_pk(a.z, a.w); o.z = cvt_pk(b.x, b.y); o.w = cvt_pk(b.z, b.w);
        *(u32x4*)(WSP(bf16_t, isv ? WS_VC : WS_KC) + e) = o;
    } }
    if (MK_PRO_MASK & 32)
    {
        __syncthreads();
        LAS float* tab = (LAS float*)C.lds;
        LAS float* red = (LAS float*)(C.lds + 73728);
        const float *cctx = karg<I_CCTX>(), *cc = karg<I_C>();
        for (int e = C.tid; e < 9 * D; e += 512) { const int j = e >> 11, k = e & (D - 1);
            const float cv = j == 0 ? cctx[k] : cc[(size_t)(j == 0 ? 0 : j - 1) * D + k]; tab[e] = cv * fsigmoid(cv); }
        __syncthreads();
        const float* adaw = karg<I_ADAW>(); const float* adab = karg<I_ADAB>();
        for (int it = C.bid; it < 4 * 192; it += C.G) {
            const int nb = it % 192, l = it / 192, w = C.wave;
            float acc[9];
#pragma unroll
            for (int j = 0; j < 9; ++j) acc[j] = 0.f;
            const float* wp = adaw + ((size_t)l * D + 256 * w) * (6 * D) + nb * 64 + lane;
#pragma unroll 4
            for (int k4 = 0; k4 < 256; k4 += 4) {
                const float w0 = wp[(size_t)(k4 + 0) * (6 * D)], w1 = wp[(size_t)(k4 + 1) * (6 * D)], w2 = wp[(size_t)(k4 + 2) * (6 * D)], w3 = wp[(size_t)(k4 + 3) * (6 * D)];
#pragma unroll
                for (int j = 0; j < 9; ++j) { const f32x4 sv = *(const LAS f32x4*)(tab + j * D + 256 * w + k4); acc[j] += (w0 * sv.x + w1 * sv.y) + (w2 * sv.z + w3 * sv.w); }
            }
#pragma unroll
            for (int j = 0; j < 9; ++j) red[(w * 9 + j) * 64 + lane] = acc[j];
            __syncthreads();
            for (int e = C.tid; e < 9 * 64; e += 512) { const int j = e >> 6, c = e & 63; float sum = adab[(size_t)l * 6 * D + nb * 64 + c];
#pragma unroll
                for (int ww = 0; ww < 8; ++ww) sum += red[(ww * 9 + j) * 64 + c];
                WSP(float, WS_MOD)[((size_t)l * 9 + j) * 6 * D + nb * 64 + c] = sum; }
            __syncthreads();
        }
    }
    if (MK_PRO_MASK & 64)
    {
        const float *fw1 = karg<I_FW1>(), *fw2 = karg<I_FW2>(), *fw3 = karg<I_FW3>(), *fwout = karg<I_FWOUT>(), *hbias = karg<I_HYBIAS>();
        const float fq = karg<I_FREQ>()[lane]; const float fb1 = karg<I_FB1>()[lane], fb2 = karg<I_FB2>()[lane], fb3 = karg<I_FB3>()[lane];
        for (int it = C.bid; it < 160; it += C.G) {
            const bool smp = it >= 32; const int nbase = (smp ? it - 32 : it) * 8; const int L = smp ? 1024 : 256; const int n = nbase + C.wave;
            float* FILT = WSP(float, WS_ARENA + AR_FILT) + (smp ? 0 : (size_t)1024 * 4096);
            __syncthreads();
            if (lane < 33) {
                float z;
                if (lane == 0) z = (float)n / (float)(L - 1);
                else { const int i = (lane - 1) & 15; const float fr = 1e-4f + (float)i * ((15.0f - 1e-4f) / 15.0f); const float rev = fr * (float)n / (float)L;
                       z = lane <= 16 ? fcos_rev(rev) : -fsin_rev(rev); }
                scr[lane] = z;
            }
            asm volatile("s_waitcnt lgkmcnt(0)" ::: "memory");
            float pre = fb1;
#pragma unroll 3
            for (int e = 0; e < 33; ++e) pre += scr[e] * fw1[e * 64 + lane];
            float hv = fsin(fq * pre);
            asm volatile("s_waitcnt lgkmcnt(0)" ::: "memory");
            scr[64 + lane] = hv;
            asm volatile("s_waitcnt lgkmcnt(0)" ::: "memory");
            pre = fb2;
#pragma unroll 4
            for (int e = 0; e < 64; ++e) pre += scr[64 + e] * fw2[e * 64 + lane];
            hv = fsin(fq * pre);
            asm volatile("s_waitcnt lgkmcnt(0)" ::: "memory");
            scr[128 + lane] = hv;
            asm volatile("s_waitcnt lgkmcnt(0)" ::: "memory");
            pre = fb3;
#pragma unroll 4
            for (int e = 0; e < 64; ++e) pre += scr[128 + e] * fw3[e * 64 + lane];
            hv = fsin(fq * pre);
            scr[1024 + lane] = hv;
            __syncthreads();
            float acc[8][8];
#pragma unroll
            for (int nn = 0; nn < 8; ++nn)
#pragma unroll
                for (int i = 0; i < 8; ++i) acc[nn][i] = 0.f;
            const float* wo = fwout + 512 * C.wave + lane;
#pragma unroll 2
            for (int e = 0; e < 64; ++e) {
                float wv[8];
#pragma unroll
                for (int i = 0; i < 8; ++i) wv[i] = wo[(size_t)e * 4096 + i * 64];
#pragma unroll
                for (int nn = 0; nn < 8; ++nn) { const float hh = ((const LAS float*)(C.lds + nn * 16384))[1024 + e];
#pragma unroll
                    for (int i = 0; i < 8; ++i) acc[nn][i] += hh * wv[i]; }
            }
#pragma unroll
            for (int nn = 0; nn < 8; ++nn) { const int n2 = nbase + nn; const float tn = (float)n2 / (float)(L - 1);
#pragma unroll
                for (int i = 0; i < 8; ++i) {
                    const int o = 512 * C.wave + i * 64 + lane, dir = o >> 11, c = o & 2047;
                    const float delta = -3.0701134573253944f + (float)c * ((-15.350567286626972f + 3.0701134573253944f) / 2047.0f);
                    float val = acc[nn][i] * fexp(-tn * fabsf(delta));
                    if (dir == 0 && n2 == 0) val += hbias[c];
                    FILT[(size_t)n2 * 4096 + o] = val;
                } }
        }
        __syncthreads();
    }
}

__device__ __forceinline__ void phase_fg_transpose(const Ctx& C) {
    const int tid = C.tid;
    LAS float* tl = (LAS float*)C.lds;
    for (int it = C.bid; it < 1280; it += C.G) {
        const bool smp = it < 1024; const int q = smp ? it : it - 1024;
        const int L = smp ? 1024 : 256, ROW = smp ? FGS_ROW : FGP_ROW;
        const int cbk = q & 31, nb = smp ? (q >> 5) & 15 : (q >> 5) & 3, dir = smp ? q >> 9 : q >> 7;
        const float* FILT = WSP(float, WS_ARENA + AR_FILT) + (smp ? 0 : (size_t)1024 * 4096);
        bf16_t* FG = WSP(bf16_t, smp ? WS_FGS : WS_FGP);
        const int n0 = nb * 64 + dir;
        __syncthreads();
        { const int nl = tid >> 3, c8 = tid & 7; const int n = n0 + nl;
          f32x4 a = (f32x4){0.f, 0.f, 0.f, 0.f}, b = a;
          const int nc = n < L ? n : L - 1;
          const float* src = FILT + (size_t)nc * 4096 + dir * 2048 + cbk * 64 + 8 * c8;
          a = *(const f32x4*)src; b = *(const f32x4*)(src + 4);
          if (n >= L) { a = (f32x4){0.f, 0.f, 0.f, 0.f}; b = a; }
          LAS float* d = tl + nl * 65 + 8 * c8;
          d[0] = a.x; d[1] = a.y; d[2] = a.z; d[3] = a.w; d[4] = b.x; d[5] = b.y; d[6] = b.z; d[7] = b.w; }
        __syncthreads();
        { const int cl = tid >> 3, i8 = tid & 7;
          float v[8];
#pragma unroll
          for (int j = 0; j < 8; ++j) { const int il = 8 * i8 + j; const int nl = dir ? il : 63 - il; v[j] = tl[nl * 65 + cl]; }
          const int idx0 = dir ? (L + nb * 64) : (L - 64 - nb * 64);
          u32x4 o; o.x = cvt_pk(v[0], v[1]); o.y = cvt_pk(v[2], v[3]); o.z = cvt_pk(v[4], v[5]); o.w = cvt_pk(v[6], v[7]);
          bf16_t* dst = FG + (size_t)(cbk * 64 + cl) * ROW;
          *(u32x4*)(dst + idx0 + 8 * i8) = o;
          if (dir && nb * 64 + 64 == L) *(u32x4*)(dst + 2 * L + 8 * i8) = (u32x4){0u, 0u, 0u, 0u}; }
    }
    __syncthreads();
}

__device__ __forceinline__ void phase_norm_mod(const Ctx& C, const float* Xp, const float* Xs, const float* g, int layer, int which_sh, bf16_t* H, const bf16_t* P1 = nullptr, float* Xw = nullptr) {
    const int gw = C.bid * 8 + C.wave, NGW = C.G * 8, lane = C.lane;
    for (int m = gw; m < MT; m += NGW) {
        const int cond = cond_of_row(m);
        const float* sh = MODP(layer, cond, which_sh); const float* sc = MODP(layer, cond, which_sh + 1);
        const f32x4* xr = (const f32x4*)(m < MP ? Xp + (size_t)m * D : Xs + (size_t)(m - MP) * D) + lane;
        f32x4 v[8]; float ss = 0.f;
#pragma unroll
        for (int j = 0; j < 8; ++j) { v[j] = xr[64 * j]; if (P1) { const u32x2 pw = ((const u32x2*)(P1 + (size_t)m * D) + lane)[64 * j]; v[j] += (f32x4){bflo(pw.x), bfhi(pw.x), bflo(pw.y), bfhi(pw.y)}; ((f32x4*)(Xw + (size_t)m * D) + lane)[64 * j] = v[j]; }
            ss += (v[j].x * v[j].x + v[j].y * v[j].y) + (v[j].z * v[j].z + v[j].w * v[j].w); }
        const float rstd = __builtin_amdgcn_rsqf(wave_sum(ss) * (1.0f / D) + 1e-6f);
        u32x2* o = (u32x2*)(H + (size_t)m * D) + lane;
#pragma unroll
        for (int j = 0; j < 8; ++j) {
            const f32x4 gv = ((const f32x4*)g)[lane + 64 * j], sv = ((const f32x4*)sh)[lane + 64 * j], cv = ((const f32x4*)sc)[lane + 64 * j];
            const f32x4 y = (v[j] * rstd * gv) * (cv + 1.0f) + sv;
            u32x2 w; w.x = cvt_pk(y.x, y.y); w.y = cvt_pk(y.z, y.w); o[64 * j] = w;
        }
    }
}
__device__ __forceinline__ void phase_norm_final(const Ctx& C, const float* X, const float* g, float* out, const bf16_t* P1 = nullptr) {
    const int gw = C.bid * 8 + C.wave, NGW = C.G * 8, lane = C.lane;
    for (int m = gw; m < MT; m += NGW) {
        const f32x4* xr = (const f32x4*)(X + (size_t)m * D) + lane;
        f32x4 v[8]; float ss = 0.f;
#pragma unroll
        for (int j = 0; j < 8; ++j) { v[j] = xr[64 * j]; if (P1) { const u32x2 pw = ((const u32x2*)(P1 + (size_t)m * D) + lane)[64 * j]; v[j] += (f32x4){bflo(pw.x), bfhi(pw.x), bflo(pw.y), bfhi(pw.y)}; } ss += (v[j].x * v[j].x + v[j].y * v[j].y) + (v[j].z * v[j].z + v[j].w * v[j].w); }
        const float rstd = __builtin_amdgcn_rsqf(wave_sum(ss) * (1.0f / D) + 1e-6f);
        f32x4* o = (f32x4*)(out + (size_t)m * D) + lane;
#pragma unroll
        for (int j = 0; j < 8; ++j) o[64 * j] = v[j] * rstd * ((const f32x4*)g)[lane + 64 * j];
    }
}

__device__ __forceinline__ void unpack8(const u32x4 w, float (&f)[8]) { f[0] = bflo(w.x); f[1] = bfhi(w.x); f[2] = bflo(w.y); f[3] = bfhi(w.y); f[4] = bflo(w.z); f[5] = bfhi(w.z); f[6] = bflo(w.w); f[7] = bfhi(w.w); }
__device__ __forceinline__ u32x4 pack8(const float (&f)[8]) { u32x4 o; o.x = cvt_pk(f[0], f[1]); o.y = cvt_pk(f[2], f[3]); o.z = cvt_pk(f[4], f[5]); o.w = cvt_pk(f[6], f[7]); return o; }
__device__ __forceinline__ void phase_norm_mod_b(const Ctx& C, const bf16_t* X, const float* g, int layer, int which_sh, bf16_t* H, const bf16_t* P1 = nullptr, bf16_t* Xw = nullptr, int p1_row0 = 0) {
    const int gw = C.bid * 8 + C.wave, NGW = C.G * 8, lane = C.lane;
    f32x4 gv[4][2];
#pragma unroll
    for (int j = 0; j < 4; ++j)
#pragma unroll
        for (int h = 0; h < 2; ++h) gv[j][h] = ((const f32x4*)g)[2 * (lane + 64 * j) + h];
    u32x4 xa[4], pa[4]; f32x4 sv[4][2], cv[4][2];
#define NM_LOAD(m_) do { const int cond_ = cond_of_row(m_); const f32x4* sh_ = (const f32x4*)MODP(layer, cond_, which_sh); const f32x4* sc_ = (const f32x4*)MODP(layer, cond_, which_sh + 1); \
        _Pragma("unroll") for (int j = 0; j < 4; ++j) { xa[j] = ((const u32x4*)(X + (size_t)(m_) * D) + lane)[64 * j]; if (P1 && (m_) >= p1_row0) pa[j] = ((const u32x4*)(P1 + (size_t)(m_) * D) + lane)[64 * j]; } \
        _Pragma("unroll") for (int j = 0; j < 4; ++j) { _Pragma("unroll") for (int h = 0; h < 2; ++h) { const int ci_ = 2 * (lane + 64 * j) + h; sv[j][h] = sh_[ci_]; cv[j][h] = sc_[ci_]; } } } while (0)
    int m = gw;
    if (m < MT) NM_LOAD(m);
    for (; m < MT; m += NGW) {
        const bool fold = P1 && m >= p1_row0;
        float v[4][8]; float ss = 0.f;
#pragma unroll
        for (int j = 0; j < 4; ++j) {
            unpack8(xa[j], v[j]);
            if (fold) { float p[8]; unpack8(pa[j], p);
#pragma unroll
                for (int e = 0; e < 8; ++e) v[j][e] += p[e]; }
#pragma unroll
            for (int e = 0; e < 8; ++e) ss += v[j][e] * v[j][e];
        }
        const float rstd = __builtin_amdgcn_rsqf(wave_sum(ss) * (1.0f / D) + 1e-6f);
        u32x4 xo[4], ho[4];
#pragma unroll
        for (int j = 0; j < 4; ++j) {
            if (fold) xo[j] = pack8(v[j]);
            float y[8];
#pragma unroll
            for (int h = 0; h < 2; ++h)
#pragma unroll
                for (int e = 0; e < 4; ++e) y[4 * h + e] = (v[j][4 * h + e] * rstd * gv[j][h][e]) * (cv[j][h][e] + 1.0f) + sv[j][h][e];
            ho[j] = pack8(y);
        }
        const int mn = m + NGW;
        if (mn < MT) NM_LOAD(mn);
        asm volatile("" ::: "memory");
#pragma unroll
        for (int j = 0; j < 4; ++j) { if (fold) ((u32x4*)(Xw + (size_t)m * D) + lane)[64 * j] = xo[j]; ((u32x4*)(H + (size_t)m * D) + lane)[64 * j] = ho[j]; }
    }
#undef NM_LOAD
}
__device__ __forceinline__ void phase_norm_final_b(const Ctx& C, const bf16_t* X, const float* g, float* out, const bf16_t* P1 = nullptr, int p1_row0 = 0) {
    const int gw = C.bid * 8 + C.wave, NGW = C.G * 8, lane = C.lane;
    for (int m = gw; m < MT; m += NGW) {
        const u32x4* xr = (const u32x4*)(X + (size_t)m * D) + lane;
        float v[4][8]; float ss = 0.f;
#pragma unroll
        for (int j = 0; j < 4; ++j) {
            unpack8(xr[64 * j], v[j]);
            if (P1 && m >= p1_row0) { float p[8]; unpack8(((const u32x4*)(P1 + (size_t)m * D) + lane)[64 * j], p);
#pragma unroll
                for (int e = 0; e < 8; ++e) v[j][e] += p[e]; }
#pragma unroll
            for (int e = 0; e < 8; ++e) ss += v[j][e] * v[j][e];
        }
        const float rstd = __builtin_amdgcn_rsqf(wave_sum(ss) * (1.0f / D) + 1e-6f);
        f32x4* o = (f32x4*)(out + (size_t)m * D);
#pragma unroll
        for (int j = 0; j < 4; ++j)
#pragma unroll
            for (int h = 0; h < 2; ++h) {
                const int ci = 2 * (lane + 64 * j) + h;
                const f32x4 gv = ((const f32x4*)g)[ci];
                f32x4 y;
#pragma unroll
                for (int e = 0; e < 4; ++e) y[e] = v[j][4 * h + e] * rstd * gv[e];
                o[ci] = y;
            }
    }
}

using pg8::Unit;
constexpr int HALF = 128;

struct EpiResidual {
    static constexpr bool PERM = false, AFTER_DRAIN = false;
    float* X; const float* gate_base;
    const float *Bp, *Bs;
    __device__ __forceinline__ void operator()(const f32x4 (&acc)[2][2][4][2], const Unit& u, int wr, int wc, int fr, int fq) const {
        const int row0 = u.pm * 256 + wr * 64 + fr, col0 = u.pn * 256 + wc * 32 + 4 * fq;
        const float* gp = gate_base + (size_t)cond_of_panel(u.pm) * 6 * D + col0;
        f32x4 gv[2][2];
#pragma unroll
        for (int bj = 0; bj < 2; ++bj)
#pragma unroll
            for (int n = 0; n < 2; ++n) gv[bj][n] = *(const f32x4*)(gp + bj * HALF + n * 16);
        const float* sbase = (u.pm < 16 ? Bp + (size_t)row0 * D : Bs + (size_t)(row0 - MP) * D) + col0;
#pragma unroll
        for (int ai = 0; ai < 2; ++ai) {
            f32x4 q[4][2][2];
#pragma unroll
            for (int m = 0; m < 4; ++m)
#pragma unroll
                for (int bj = 0; bj < 2; ++bj)
#pragma unroll
                    for (int n = 0; n < 2; ++n) if ((u.mask >> (ai * 2 + bj)) & 1) q[m][bj][n] = *(const f32x4*)(sbase + (size_t)(ai * HALF + m * 16) * D + bj * HALF + n * 16);
#pragma unroll
            for (int m = 0; m < 4; ++m) { float* rowp = X + (size_t)(row0 + ai * HALF + m * 16) * D + col0;
#pragma unroll
                for (int bj = 0; bj < 2; ++bj)
#pragma unroll
                    for (int n = 0; n < 2; ++n) if ((u.mask >> (ai * 2 + bj)) & 1) *(f32x4*)(rowp + bj * HALF + n * 16) = q[m][bj][n] + gv[bj][n] * acc[ai][bj][m][n]; }
            asm volatile("" ::: "memory");
        }
    }
};
template <int ACT> struct EpiBf16 {
    static constexpr bool PERM = true, AFTER_DRAIN = false;
    bf16_t* O; int ldc;
    __device__ __forceinline__ void operator()(const f32x4 (&acc)[2][2][4][2], const Unit& u, int wr, int wc, int fr, int fq) const {
        const int row0 = u.pm * 256 + wr * 64 + fr, col0 = u.pn * 256 + wc * 32 + 8 * fq;
#pragma unroll
        for (int ai = 0; ai < 2; ++ai)
#pragma unroll
            for (int m = 0; m < 4; ++m) { bf16_t* rowp = O + (size_t)(row0 + ai * HALF + m * 16) * ldc + col0;
#pragma unroll
                for (int bj = 0; bj < 2; ++bj) { if (!((u.mask >> (ai * 2 + bj)) & 1)) continue; f32x4 v0 = acc[ai][bj][m][0], v1 = acc[ai][bj][m][1];
                    if (ACT == 1) {
#pragma unroll
                        for (int j = 0; j < 4; ++j) { const float a = fmaxf(v0[j], 0.f), b = fmaxf(v1[j], 0.f); v0[j] = a * a; v1[j] = b * b; } }
                    u32x4 w; w.x = cvt_pk(v0[0], v0[1]); w.y = cvt_pk(v0[2], v0[3]); w.z = cvt_pk(v1[0], v1[1]); w.w = cvt_pk(v1[2], v1[3]);
                    *(u32x4*)(rowp + bj * HALF) = w; } }
    }
};
struct EpiQKV {
    static constexpr bool PERM = true, AFTER_DRAIN = false;
    bf16_t *Q, *K, *V; float *NK, *NV;
    __device__ __forceinline__ void operator()(const f32x4 (&acc)[2][2][4][2], const Unit& u, int wr, int wc, int fr, int fq) const {
        const int row0 = u.pm * 256 + wr * 64 + fr; const int cin = wc * 32 + 8 * fq;
        bf16_t* base; int ldc, colt; float* fo = nullptr;
        if (u.pn < 8) { base = Q; ldc = 2048; colt = u.pn * 256; }
        else if (u.pn < 10) { base = K; ldc = 512; colt = (u.pn - 8) * 256; if (u.pm < 16) fo = NK; }
        else { base = V; ldc = 512; colt = (u.pn - 10) * 256; if (u.pm < 16) fo = NV; }
#pragma unroll
        for (int ai = 0; ai < 2; ++ai)
#pragma unroll
            for (int m = 0; m < 4; ++m) { const int r = row0 + ai * HALF + m * 16; bf16_t* rowp = base + (size_t)r * ldc + colt + cin;
#pragma unroll
                for (int bj = 0; bj < 2; ++bj) { if (!((u.mask >> (ai * 2 + bj)) & 1)) continue; const f32x4 v0 = acc[ai][bj][m][0], v1 = acc[ai][bj][m][1];
                    u32x4 w; w.x = cvt_pk(v0[0], v0[1]); w.y = cvt_pk(v0[2], v0[3]); w.z = cvt_pk(v1[0], v1[1]); w.w = cvt_pk(v1[2], v1[3]);
                    *(u32x4*)(rowp + bj * HALF) = w;
                    if (fo) { float* fp = fo + ((size_t)(r >> 8) * 512 + (r & 255)) * 512 + colt + cin + bj * HALF; *(f32x4*)fp = v0; *(f32x4*)(fp + 4) = v1; } } }
    }
};
__device__ __forceinline__ size_t hm_index(int m, int c) { return ((size_t)(c >> 6) * MT + m) * 64 + (c & 63); }
struct EpiRw1 {
    static constexpr bool PERM = true, AFTER_DRAIN = false;
    bf16_t *R, *A3;
    const float* k_k; float* invsq;
    __device__ __forceinline__ void operator()(const f32x4 (&acc)[2][2][4][2], const Unit& u, int wr, int wc, int fr, int fq) const {
        const int ct = u.pn, panel = u.pm % NPANEL;
        const int row0 = panel * 256 + wr * 64 + fr; const int cin = wc * 32 + 8 * fq;
        bf16_t* base; int ldc, colt, act = 0;
        if (ct < 24) { base = R + (size_t)(ct >> 3) * MT * D; ldc = D; colt = (ct & 7) * 256; }
        else { base = A3 + (size_t)(ct - 24) * MT * 256; ldc = 256; colt = 0; act = ct - 23; }
#pragma unroll
        for (int ai = 0; ai < 2; ++ai)
#pragma unroll
            for (int m = 0; m < 4; ++m) { const int rrow = row0 + ai * HALF + m * 16; bf16_t* rowp = base + (size_t)rrow * ldc + colt + cin;
#pragma unroll
                for (int bj = 0; bj < 2; ++bj) { if (!((u.mask >> (ai * 2 + bj)) & 1)) continue; f32x4 v0 = acc[ai][bj][m][0], v1 = acc[ai][bj][m][1];
                    if (act == 1) {
#pragma unroll
                        for (int j = 0; j < 4; ++j) { v0[j] = ftanh(v0[j]); v1[j] = ftanh(v1[j]); } }
                    else if (act == 3) {
#pragma unroll
                        for (int j = 0; j < 4; ++j) { v0[j] = fsigmoid(v0[j]); v1[j] = fsigmoid(v1[j]); } }
                    u32x4 w; w.x = cvt_pk(v0[0], v0[1]); w.y = cvt_pk(v0[2], v0[3]); w.z = cvt_pk(v1[0], v1[1]); w.w = cvt_pk(v1[2], v1[3]);
                    if (ct < 24) *(u32x4*)(base + hm_index(rrow, colt + cin + bj * HALF)) = w; else *(u32x4*)(rowp + bj * HALF) = w;
} }
    }
};
struct EpiRw2 {
    static constexpr bool PERM = true, AFTER_DRAIN = false;
    bf16_t *LD, *LA, *Gt; const float *w0, *a0;
    __device__ __forceinline__ void operator()(const f32x4 (&acc)[2][2][4][2], const Unit& u, int wr, int wc, int fr, int fq) const {
        const int ct = u.pn, panel = u.pm % NPANEL, grp = ct >> 3;
        const int row0 = panel * 256 + wr * 64 + fr; const int col0 = (ct & 7) * 256 + wc * 32 + 8 * fq;
        bf16_t* base; const float* bias = nullptr;
        if (grp < 2) { base = LD + (size_t)grp * MT * D; bias = w0 + grp * D; }
        else if (grp < 4) { base = LA + (size_t)(grp - 2) * MT * D; bias = a0 + (grp - 2) * D; }
        else base = Gt;
        f32x4 bv[2][2];
#pragma unroll
        for (int bj = 0; bj < 2; ++bj)
#pragma unroll
            for (int n = 0; n < 2; ++n) bv[bj][n] = bias ? *(const f32x4*)(bias + col0 + bj * HALF + 4 * n) : (f32x4){0.f, 0.f, 0.f, 0.f};
#pragma unroll
        for (int ai = 0; ai < 2; ++ai)
#pragma unroll
            for (int m = 0; m < 4; ++m) { const int rrow = row0 + ai * HALF + m * 16; bf16_t* rowp = base + (size_t)rrow * D + col0;
#pragma unroll
                for (int bj = 0; bj < 2; ++bj) {
                    f32x4 v0 = acc[ai][bj][m][0] + bv[bj][0], v1 = acc[ai][bj][m][1] + bv[bj][1];
                    if (grp < 2) {
#pragma unroll
                        for (int j = 0; j < 4; ++j) { v0[j] = -fexp(-fsoftplus(-v0[j]) - 0.5f); v1[j] = -fexp(-fsoftplus(-v1[j]) - 0.5f); } }
                    u32x4 w; w.x = cvt_pk(v0[0], v0[1]); w.y = cvt_pk(v0[2], v0[3]); w.z = cvt_pk(v1[0], v1[1]); w.w = cvt_pk(v1[2], v1[3]);
                    if (grp < 4) *(u32x4*)(base + hm_index(rrow, col0 + bj * HALF)) = w; else *(u32x4*)(rowp + bj * HALF) = w; }
                asm volatile("" : "+v"(bv[0][0]), "+v"(bv[0][1]), "+v"(bv[1][0]), "+v"(bv[1][1]));
            }
    }
};
struct RwOrder1 {
    int G, c, lo, hi; bool xcd;
    __device__ __forceinline__ bool next(int i, Unit& u) const { const int L = lo + i * G + c; if (L >= hi) return false; u.mask = 15;
        int panel, ct;
        if (xcd) {
            if (L < 1280) {
                const int cc = L & 255, T = (((L >> 8) * 8 + (cc & 7)) << 5) + (cc >> 3);
                if (T < 1056) { const int blk = T >> 5, j = T & 31, pq = blk / 3, g = blk - 3 * pq; panel = pq * 4 + (j >> 3); ct = g * 8 + (j & 7); }
                else if (T < 1120) { const int blk = (T - 1056) >> 5, j = T & 31; panel = 44 + (j >> 3); ct = (1 + blk) * 8 + (j & 7); }
                else { const int U = T - 1120; if (U < 16) { panel = 44 + (U >> 3); ct = U & 7; } else { const int q = U - 16; panel = q / 3; ct = 24 + q - 3 * panel; } }
            } else { const int q = L - 1280; panel = 46 + (q >> 3); ct = q & 7; }
        } else { panel = L / 27; ct = L % 27; }
        const int ai = ct < 24 ? (ct >> 3) : ct - 21; u.pm = ai * NPANEL + panel; u.pn = ct; u.kh = 0; return true; }
    __device__ __forceinline__ void a_ready(const Unit&) const {}
    __device__ __forceinline__ void done(const Unit&) const {}
};
struct RwOrder2 {
    int G, c; unsigned* cnt; unsigned need;
    __device__ __forceinline__ bool next(int i, Unit& u) const { const int L = i * G + c; if (L >= 40 * NPANEL) return false; const int panel = L / 40, ct = L % 40; const int ai = ct < 16 ? 0 : (ct < 32 ? 1 : 2); u.pm = ai * NPANEL + panel; u.pn = ct; u.kh = 0; u.mask = 15; return true; }
    __device__ __forceinline__ void a_ready(const Unit& u) const {
        if (cnt && (u.pm % NPANEL) == NPANEL - 1) {
            unsigned sp = 0u;
            while (xb_ld(cnt) < need) { __builtin_amdgcn_s_sleep(2); if (++sp > (1u << 24)) break; }
            __builtin_amdgcn_fence(__ATOMIC_ACQUIRE, "agent");
            asm volatile("s_waitcnt vmcnt(0)" ::: "memory");
        }
    }
    __device__ __forceinline__ void done(const Unit&) const {}
};

struct SplitOrder {
    pg8::StaticOrder so; int G, c, ntiles;
    __device__ __forceinline__ void init(int N, int G_, int c_) { so.init(MT, N, G_, c_); G = G_; c = c_; ntiles = so.nwg; }
    __device__ __forceinline__ bool next(int i, Unit& u) const { const int L = i * G + c; if (L >= 2 * ntiles) return false; const int kh = L >= ntiles; so.map(kh ? L - ntiles : L, u); u.kh = kh; u.mask = 15; return true; }
    __device__ __forceinline__ void a_ready(const Unit&) const {}
    __device__ __forceinline__ void done(const Unit&) const {}
};
struct EpiResidualSplit {
    static constexpr bool PERM = false, AFTER_DRAIN = false;
    float* X; const float* gate_base; bf16_t* P1;
    __device__ __forceinline__ void operator()(const f32x4 (&acc)[2][2][4][2], const Unit& u, int wr, int wc, int fr, int fq) const {
        const int row0 = u.pm * 256 + wr * 64 + fr, col0 = u.pn * 256 + wc * 32 + 4 * fq;
        const float* gp = gate_base + (size_t)cond_of_panel(u.pm) * 6 * D + col0;
        f32x4 gv[2][2];
#pragma unroll
        for (int bj = 0; bj < 2; ++bj)
#pragma unroll
            for (int n = 0; n < 2; ++n) gv[bj][n] = *(const f32x4*)(gp + bj * HALF + n * 16);
        if (u.kh == 0) {
#pragma unroll
            for (int ai = 0; ai < 2; ++ai) {
                f32x4 q[4][2][2];
#pragma unroll
                for (int m = 0; m < 4; ++m)
#pragma unroll
                    for (int bj = 0; bj < 2; ++bj)
#pragma unroll
                        for (int n = 0; n < 2; ++n) q[m][bj][n] = *(const f32x4*)(X + (size_t)(row0 + ai * HALF + m * 16) * D + col0 + bj * HALF + n * 16);
#pragma unroll
                for (int m = 0; m < 4; ++m) { float* rowp = X + (size_t)(row0 + ai * HALF + m * 16) * D + col0;
#pragma unroll
                    for (int bj = 0; bj < 2; ++bj)
#pragma unroll
                        for (int n = 0; n < 2; ++n) *(f32x4*)(rowp + bj * HALF + n * 16) = q[m][bj][n] + gv[bj][n] * acc[ai][bj][m][n]; }
                asm volatile("" ::: "memory");
            }
        } else {
#pragma unroll
            for (int ai = 0; ai < 2; ++ai)
#pragma unroll
                for (int m = 0; m < 4; ++m) { bf16_t* rowp = P1 + (size_t)(row0 + ai * HALF + m * 16) * D + col0;
#pragma unroll
                    for (int bj = 0; bj < 2; ++bj)
#pragma unroll
                        for (int n = 0; n < 2; ++n) { const f32x4 v = gv[bj][n] * acc[ai][bj][m][n]; u32x2 w; w.x = cvt_pk(v.x, v.y); w.y = cvt_pk(v.z, v.w); *(u32x2*)(rowp + bj * HALF + n * 16) = w; } }
        }
    }
};

template <bool SRCF32> struct EpiResidualB {
    static constexpr bool PERM = true, AFTER_DRAIN = false;
    bf16_t* X; const float* gate_base; const float *Bp, *Bs;
    __device__ __forceinline__ void operator()(const f32x4 (&acc)[2][2][4][2], const Unit& u, int wr, int wc, int fr, int fq) const {
        const int row0 = u.pm * 256 + wr * 64 + fr, col0 = u.pn * 256 + wc * 32 + 8 * fq;
        const float* gp = gate_base + (size_t)cond_of_panel(u.pm) * 6 * D + col0;
        f32x4 gv[2][2];
#pragma unroll
        for (int bj = 0; bj < 2; ++bj)
#pragma unroll
            for (int n = 0; n < 2; ++n) gv[bj][n] = *(const f32x4*)(gp + bj * HALF + 4 * n);
#pragma unroll
        for (int ai = 0; ai < 2; ++ai) {
            if constexpr (SRCF32) {
                const float* sbase = (u.pm < 16 ? Bp + (size_t)row0 * D : Bs + (size_t)(row0 - MP) * D) + col0;
                f32x4 q[4][2][2];
#pragma unroll
                for (int m = 0; m < 4; ++m)
#pragma unroll
                    for (int bj = 0; bj < 2; ++bj)
#pragma unroll
                        for (int n = 0; n < 2; ++n) q[m][bj][n] = *(const f32x4*)(sbase + (size_t)(ai * HALF + m * 16) * D + bj * HALF + 4 * n);
#pragma unroll
                for (int m = 0; m < 4; ++m) { bf16_t* rowp = X + (size_t)(row0 + ai * HALF + m * 16) * D + col0;
#pragma unroll
                    for (int bj = 0; bj < 2; ++bj) { const f32x4 v0 = q[m][bj][0] + gv[bj][0] * acc[ai][bj][m][0], v1 = q[m][bj][1] + gv[bj][1] * acc[ai][bj][m][1];
                        u32x4 w; w.x = cvt_pk(v0.x, v0.y); w.y = cvt_pk(v0.z, v0.w); w.z = cvt_pk(v1.x, v1.y); w.w = cvt_pk(v1.z, v1.w); *(u32x4*)(rowp + bj * HALF) = w; } }
            } else {
                u32x4 q[4][2];
#pragma unroll
                for (int m = 0; m < 4; ++m)
#pragma unroll
                    for (int bj = 0; bj < 2; ++bj) q[m][bj] = *(const u32x4*)(X + (size_t)(row0 + ai * HALF + m * 16) * D + col0 + bj * HALF);
#pragma unroll
                for (int m = 0; m < 4; ++m) { bf16_t* rowp = X + (size_t)(row0 + ai * HALF + m * 16) * D + col0;
#pragma unroll
                    for (int bj = 0; bj < 2; ++bj) { const u32x4 o = q[m][bj];
                        const f32x4 v0 = (f32x4){bflo(o.x), bfhi(o.x), bflo(o.y), bfhi(o.y)} + gv[bj][0] * acc[ai][bj][m][0], v1 = (f32x4){bflo(o.z), bfhi(o.z), bflo(o.w), bfhi(o.w)} + gv[bj][1] * acc[ai][bj][m][1];
                        u32x4 w; w.x = cvt_pk(v0.x, v0.y); w.y = cvt_pk(v0.z, v0.w); w.z = cvt_pk(v1.x, v1.y); w.w = cvt_pk(v1.z, v1.w); *(u32x4*)(rowp + bj * HALF) = w; } }
            }
            asm volatile("" ::: "memory");
        }
    }
};
struct EpiResidualSplitB {
    static constexpr bool PERM = true, AFTER_DRAIN = false;
    bf16_t* X; const float* gate_base; bf16_t* P1;
    __device__ __forceinline__ void operator()(const f32x4 (&acc)[2][2][4][2], const Unit& u, int wr, int wc, int fr, int fq) const {
        const int row0 = u.pm * 256 + wr * 64 + fr, col0 = u.pn * 256 + wc * 32 + 8 * fq;
        const float* gp = gate_base + (size_t)cond_of_panel(u.pm) * 6 * D + col0;
        f32x4 gv[2][2];
#pragma unroll
        for (int bj = 0; bj < 2; ++bj)
#pragma unroll
            for (int n = 0; n < 2; ++n) gv[bj][n] = *(const f32x4*)(gp + bj * HALF + 4 * n);
        if (u.kh == 0) {
#pragma unroll
            for (int ai = 0; ai < 2; ++ai) {
                u32x4 q[4][2];
#pragma unroll
                for (int m = 0; m < 4; ++m)
#pragma unroll
                    for (int bj = 0; bj < 2; ++bj) q[m][bj] = *(const u32x4*)(X + (size_t)(row0 + ai * HALF + m * 16) * D + col0 + bj * HALF);
#pragma unroll
                for (int m = 0; m < 4; ++m) { bf16_t* rowp = X + (size_t)(row0 + ai * HALF + m * 16) * D + col0;
#pragma unroll
                    for (int bj = 0; bj < 2; ++bj) { const u32x4 o = q[m][bj];
                        const f32x4 v0 = (f32x4){bflo(o.x), bfhi(o.x), bflo(o.y), bfhi(o.y)} + gv[bj][0] * acc[ai][bj][m][0], v1 = (f32x4){bflo(o.z), bfhi(o.z), bflo(o.w), bfhi(o.w)} + gv[bj][1] * acc[ai][bj][m][1];
                        u32x4 w; w.x = cvt_pk(v0.x, v0.y); w.y = cvt_pk(v0.z, v0.w); w.z = cvt_pk(v1.x, v1.y); w.w = cvt_pk(v1.z, v1.w); *(u32x4*)(rowp + bj * HALF) = w; } }
                asm volatile("" ::: "memory");
            }
        } else {
#pragma unroll
            for (int ai = 0; ai < 2; ++ai)
#pragma unroll
                for (int m = 0; m < 4; ++m) { bf16_t* rowp = P1 + (size_t)(row0 + ai * HALF + m * 16) * D + col0;
#pragma unroll
                    for (int bj = 0; bj < 2; ++bj) { const f32x4 v0 = gv[bj][0] * acc[ai][bj][m][0], v1 = gv[bj][1] * acc[ai][bj][m][1];
                        u32x4 w; w.x = cvt_pk(v0.x, v0.y); w.y = cvt_pk(v0.z, v0.w); w.z = cvt_pk(v1.x, v1.y); w.w = cvt_pk(v1.z, v1.w); *(u32x4*)(rowp + bj * HALF) = w; } }
        }
    }
};
struct TailSplitOrder {
    pg8::StaticOrder sf, st; int G, c, ntf;
    __device__ __forceinline__ void init(int G_, int c_, int ntf_ = 32) { sf.init(8192, D, G_, c_); st.init(4096, D, G_, c_); G = G_; c = c_; ntf = ntf_; }
    __device__ __forceinline__ bool next(int i, Unit& u) const {
        const int L = i * G + c; if (L >= 512) return false;
        if (L < 256) { sf.map(L, u); u.kh = 0; u.nt = ntf; }
        else { const int h = L - 256, kh = h >= 128; st.map(kh ? h - 128 : h, u); u.pm += 32; u.kh = kh; u.nt = ntf >> 1; }
        u.mask = 15; return true; }
    __device__ __forceinline__ void a_ready(const Unit&) const {}
    __device__ __forceinline__ void done(const Unit&) const {}
};


typedef short s16x4 __attribute__((ext_vector_type(4)));
constexpr int KS_STRIDE = 136;
constexpr int VT_STRIDE = 72;
constexpr int ATT_KS_OFF = 0, ATT_VT_OFF = 64 * KS_STRIDE * 2, ATT_BUF_BYTES = 36864;

__device__ __forceinline__ void rope8(u32x4& a, u32x4& b, const f32x2* tab) {
    unsigned* pa = (unsigned*)&a; unsigned* pb = (unsigned*)&b;
#pragma unroll
    for (int w = 0; w < 4; ++w) {
        const f32x4 cs = *(const f32x4*)(tab + 2 * w);
        const float x1l = bflo(pa[w]), x1h = bfhi(pa[w]), x2l = bflo(pb[w]), x2h = bfhi(pb[w]);
        const float o1l = x1l * cs.x - x2l * cs.y, o2l = x1l * cs.y + x2l * cs.x;
        const float o1h = x1h * cs.z - x2h * cs.w, o2h = x1h * cs.w + x2h * cs.z;
        pa[w] = cvt_pk(o1l, o1h); pb[w] = cvt_pk(o2l, o2h);
    }
}

__device__ __forceinline__ void phase_attention(const Ctx& C, const bf16_t* Q, const bf16_t* Kb, const bf16_t* Vb, const bf16_t* KC, const bf16_t* VC, const float* sink, bf16_t* O) {
    const int tid = C.tid, lane = C.lane, w = C.wave, h = lane >> 5, lq = lane & 31;
    LAS bf16_t* Ks = (LAS bf16_t*)(C.lds + ATT_KS_OFF);
    LAS bf16_t* Vt = (LAS bf16_t*)(C.lds + ATT_VT_OFF);
    const f32x2* rope = WSP(f32x2, WS_ROPE);
    const float c2 = 0.08838834764831845f * 1.4426950408889634f;
    for (int it = C.bid; it < 768; it += C.G) {
        const bool smp = it < 512;
        int bb, kvh, qb, R0;
        if (smp) { bb = it >> 6; kvh = (it >> 4) & 3; qb = it & 15; R0 = MP + bb * 1024; }
        else { const int p = it - 512; bb = p >> 4; kvh = (p >> 2) & 3; qb = p & 3; R0 = bb * 256; }
        const int head = kvh * 4 + (w >> 1);
        const int t = qb * 64 + (w & 1) * 32 + lq;
        u32x4 qf[8];
        { const bf16_t* qp = Q + (size_t)(R0 + t) * D + head * 128 + 8 * h;
#pragma unroll
          for (int ks = 0; ks < 8; ++ks) qf[ks] = *(const u32x4*)(qp + 16 * ks); }
        if (smp) {
#pragma unroll
            for (int half = 0; half < 2; ++half) { const int pos = half ? (t & 63) : (t >> 6);
#pragma unroll
                for (int kk = 0; kk < 2; ++kk) rope8(qf[4 * half + kk], qf[4 * half + kk + 2], rope + pos * 32 + 16 * kk + 8 * h); }
        }
        f32x16 o[4];
#pragma unroll
        for (int db = 0; db < 4; ++db)
#pragma unroll
            for (int r = 0; r < 16; ++r) o[db][r] = 0.f;
        float mrun = -1e30f, lrun = 0.f;
        const int li0 = smp ? (qb >= 2 ? 0 : 2 - qb) : 0, li1 = smp ? (17 - qb < 4 ? 17 - qb : 4) : 0;
        const int ntot = smp ? 8 + (li1 - li0 + 1) : 4;
        const int key = tid >> 3, cc = tid & 7, c1 = (cc & 3) + (cc >> 2) * 8;
#define ATT_TILE(i, kp_, vp_, k0_, loc_) do { if (smp) { if ((i) < 8) { const size_t off_ = ((size_t)(bb * 2) * 512 + (i) * 64) * 512 + kvh * 128; kp_ = KC + off_; vp_ = VC + off_; k0_ = 0; loc_ = false; } \
            else { k0_ = qb * 64 - 128 + 64 * ((i) - 8 + li0); loc_ = true; const size_t off_ = (size_t)(R0 + k0_) * 512 + kvh * 128; kp_ = Kb + off_; vp_ = Vb + off_; } } \
          else { k0_ = (i) * 64; loc_ = false; const size_t off_ = (size_t)(R0 + k0_) * 512 + kvh * 128; kp_ = Kb + off_; vp_ = Vb + off_; } } while (0)
        u32x4 ka, kb2, va, vb2;
#define ATT_LOAD(i) do { const bf16_t *kp_, *vp_; int k0_; bool loc_; ATT_TILE(i, kp_, vp_, k0_, loc_); (void)k0_; (void)loc_; \
          ka = *(const u32x4*)(kp_ + (size_t)key * 512 + 8 * c1); kb2 = *(const u32x4*)(kp_ + (size_t)key * 512 + 8 * c1 + 32); \
          va = *(const u32x4*)(vp_ + (size_t)key * 512 + 8 * c1); vb2 = *(const u32x4*)(vp_ + (size_t)key * 512 + 8 * c1 + 32); } while (0)
#define ATT_STAGE(i, KsB, VtB) do { const bf16_t *kp_, *vp_; int k0_; bool loc_; ATT_TILE(i, kp_, vp_, k0_, loc_); (void)kp_; (void)vp_; \
          if (loc_) { const int kpos = k0_ + key; const int pos = (cc >> 2) ? (kpos & 63) : (kpos >> 6); rope8(ka, kb2, rope + pos * 32 + 8 * (cc & 3)); } \
          *(LAS u32x4*)((KsB) + key * KS_STRIDE + 8 * c1) = ka; *(LAS u32x4*)((KsB) + key * KS_STRIDE + 8 * c1 + 32) = kb2; \
          *(LAS u32x4*)((VtB) + key * KS_STRIDE + 8 * c1) = va; *(LAS u32x4*)((VtB) + key * KS_STRIDE + 8 * c1 + 32) = vb2; } while (0)
        ATT_LOAD(0); ATT_STAGE(0, Ks, Vt); if (ntot > 1) ATT_LOAD(1);
        __syncthreads();
        for (int ti = 0; ti < ntot; ++ti) {
            const bf16_t *kp, *vp; int k0; bool local; ATT_TILE(ti, kp, vp, k0, local); (void)kp; (void)vp;
            LAS bf16_t* Ks = (LAS bf16_t*)(C.lds + (ti & 1) * ATT_BUF_BYTES + ATT_KS_OFF);
            LAS bf16_t* Vt = (LAS bf16_t*)(C.lds + (ti & 1) * ATT_BUF_BYTES + ATT_VT_OFF);
            f32x16 s0, s1;
            { const float z0 = opaque_zero();
#pragma unroll
            for (int r = 0; r < 16; ++r) { s0[r] = z0; s1[r] = z0; } }
#pragma unroll
            for (int ks = 0; ks < 8; ++ks) {
                const bf16x8 a0 = *(const LAS bf16x8*)(Ks + lq * KS_STRIDE + 16 * ks + 8 * h);
                const bf16x8 a1 = *(const LAS bf16x8*)(Ks + (32 + lq) * KS_STRIDE + 16 * ks + 8 * h);
                const bf16x8 bq = __builtin_bit_cast(bf16x8, qf[ks]);
                s0 = __builtin_amdgcn_mfma_f32_32x32x16_bf16(a0, bq, s0, 0, 0, 0);
                s1 = __builtin_amdgcn_mfma_f32_32x32x16_bf16(a1, bq, s1, 0, 0, 0);
            }
            if (local) {
#pragma unroll
                for (int r = 0; r < 16; ++r) {
                    const int kl = (r & 3) + 8 * (r >> 2) + 4 * h;
                    const int d0 = k0 + kl - t, d1 = d0 + 32;
                    s0[r] = ((d0 <= 128) && (d0 >= -128)) ? s0[r] : -1e30f; s1[r] = ((d1 <= 128) && (d1 >= -128)) ? s1[r] : -1e30f;
                }
            }
            float mx = fmaxf(s0[0], s1[0]);
#pragma unroll
            for (int r = 1; r < 16; ++r) mx = fmaxf(mx, fmaxf(s0[r], s1[r]));
            mx = fmaxf(mx, __shfl_xor(mx, 32));
            const float mnew = fmaxf(mrun, mx * c2);
            const float alpha = fexp2(mrun - mnew);
            float ps = 0.f;
#pragma unroll
            for (int r = 0; r < 16; ++r) {
                const float p0 = fexp2(__builtin_fmaf(s0[r], c2, -mnew)), p1 = fexp2(__builtin_fmaf(s1[r], c2, -mnew));
                s0[r] = p0; s1[r] = p1; ps += p0 + p1;
            }
            lrun = lrun * alpha + ps; mrun = mnew;
            if (__any(alpha != 1.0f)) {
#pragma unroll
                for (int db = 0; db < 4; ++db)
#pragma unroll
                    for (int r = 0; r < 16; ++r) o[db][r] *= alpha;
            }
            u32x4 pf[4];
#pragma unroll
            for (int s = 0; s < 2; ++s) {
                pf[s].x = cvt_pk(s0[8 * s + 0], s0[8 * s + 1]); pf[s].y = cvt_pk(s0[8 * s + 2], s0[8 * s + 3]); pf[s].z = cvt_pk(s0[8 * s + 4], s0[8 * s + 5]); pf[s].w = cvt_pk(s0[8 * s + 6], s0[8 * s + 7]);
                pf[2 + s].x = cvt_pk(s1[8 * s + 0], s1[8 * s + 1]); pf[2 + s].y = cvt_pk(s1[8 * s + 2], s1[8 * s + 3]); pf[2 + s].z = cvt_pk(s1[8 * s + 4], s1[8 * s + 5]); pf[2 + s].w = cvt_pk(s1[8 * s + 6], s1[8 * s + 7]);
            }
#pragma unroll
            for (int db = 0; db < 4; ++db)
#pragma unroll
                for (int s2 = 0; s2 < 4; ++s2) {
                    const LAS bf16_t* vr = Vt + (16 * s2 + 4 * (lane >> 5) + ((lane & 15) >> 2)) * KS_STRIDE + 32 * db + 16 * ((lane >> 4) & 1) + 4 * (lane & 3);
                    const s16x4 lo = __builtin_amdgcn_ds_read_tr16_b64_v4i16((LAS s16x4*)vr), hi = __builtin_amdgcn_ds_read_tr16_b64_v4i16((LAS s16x4*)(vr + 8 * KS_STRIDE));
                    const u32x2 lo2 = __builtin_bit_cast(u32x2, lo), hi2 = __builtin_bit_cast(u32x2, hi);
                    u32x4 av; av.x = lo2.x; av.y = lo2.y; av.z = hi2.x; av.w = hi2.y;
                    o[db] = __builtin_amdgcn_mfma_f32_32x32x16_bf16(__builtin_bit_cast(bf16x8, av), __builtin_bit_cast(bf16x8, pf[s2]), o[db], 0, 0, 0);
                }
            if (ti + 1 < ntot) {
                LAS bf16_t* Ksn = (LAS bf16_t*)(C.lds + ((ti + 1) & 1) * ATT_BUF_BYTES + ATT_KS_OFF);
                LAS bf16_t* Vtn = (LAS bf16_t*)(C.lds + ((ti + 1) & 1) * ATT_BUF_BYTES + ATT_VT_OFF);
                ATT_STAGE(ti + 1, Ksn, Vtn);
                if (ti + 2 < ntot) ATT_LOAD(ti + 2);
            }
            __syncthreads();
        }
        {
            const float sk = sink[head] * 1.4426950408889634f;
            const float mnew = fmaxf(mrun, sk), alpha = fexp2(mrun - mnew);
            float l = lrun * alpha; l += __shfl_xor(l, 32); l += fexp2(sk - mnew);
            const float sc = alpha * frcp(l);
            bf16_t* op = O + (size_t)(R0 + t) * D + head * 128 + 4 * h;
#pragma unroll
            for (int db = 0; db < 4; ++db)
#pragma unroll
                for (int g4 = 0; g4 < 4; ++g4) {
                    u32x2 wv; wv.x = cvt_pk(o[db][4 * g4 + 0] * sc, o[db][4 * g4 + 1] * sc); wv.y = cvt_pk(o[db][4 * g4 + 2] * sc, o[db][4 * g4 + 3] * sc);
                    *(u32x2*)(op + 32 * db + 8 * g4) = wv;
                }
        }
    }
#undef ATT_TILE
#undef ATT_LOAD
#undef ATT_STAGE
    __syncthreads();
}

__device__ __forceinline__ void phase_hy_gate(const Ctx& C, const bf16_t* Pm, const float* cw, const float* cb, bf16_t* X0, bf16_t* ZTp, bf16_t* ZTs) {
    const int tid = C.tid;
    LAS bf16_t* zs = (LAS bf16_t*)C.lds;
    u32x4 ld[3][3];
#define HG_LOAD(it_) do { const bool smp_ = (it_) >= 2048; const int q_ = smp_ ? (it_) - 2048 : (it_); const int cbk_ = q_ & 31, tb_ = smp_ ? (q_ >> 5) & 15 : (q_ >> 5) & 3, b_ = smp_ ? q_ >> 9 : q_ >> 7; \
        const int L_ = smp_ ? 1024 : 256, R0_ = smp_ ? MP + b_ * 1024 : b_ * 256; const int t_ = tb_ * 64 + (tid >> 3), c0_ = cbk_ * 64 + 8 * (tid & 7); \
        _Pragma("unroll") for (int g = 0; g < 3; ++g) { const bf16_t* pr_ = Pm + (size_t)(R0_ + t_) * 6144 + g * D + c0_; \
            ld[g][0] = *(const u32x4*)(pr_ - (t_ > 0 ? 6144 : 0)); ld[g][2] = *(const u32x4*)(pr_ + (t_ < L_ - 1 ? 6144 : 0)); ld[g][1] = *(const u32x4*)pr_; } } while (0)
    f32x2 tw[3][4][4];
    int cur_cbk = -1;
    int it = C.bid;
    if (it < 6144) HG_LOAD(it);
    for (; it < 6144; it += C.G) {
        const bool smp = it >= 2048; const int q = smp ? it - 2048 : it;
        const int cbk = q & 31, tb = smp ? (q >> 5) & 15 : (q >> 5) & 3, b = smp ? q >> 9 : q >> 7;
        const int L = smp ? 1024 : 256, R0 = smp ? MP + b * 1024 : b * 256, NB = smp ? 8 : 16;
        const int tl = tid >> 3, c8 = tid & 7, t = tb * 64 + tl, c0 = cbk * 64 + 8 * c8;
        if (cbk != cur_cbk) { cur_cbk = cbk;
#pragma unroll
            for (int g = 0; g < 3; ++g)
#pragma unroll
                for (int j = 0; j < 4; ++j) { const int gc = g * D + c0 + 2 * j; tw[g][j][0] = *(const f32x2*)(cw + gc); tw[g][j][1] = *(const f32x2*)(cw + 6144 + gc); tw[g][j][2] = *(const f32x2*)(cw + 12288 + gc); tw[g][j][3] = *(const f32x2*)(cb + gc); } }
        float u[3][8];
        { const unsigned mk0 = t > 0 ? 0xffffffffu : 0u, mk1 = t < L - 1 ? 0xffffffffu : 0u;
#pragma unroll
          for (int g = 0; g < 3; ++g) {
            const unsigned a[4] = {ld[g][0].x & mk0, ld[g][0].y & mk0, ld[g][0].z & mk0, ld[g][0].w & mk0}, bq[4] = {ld[g][1].x, ld[g][1].y, ld[g][1].z, ld[g][1].w}, cq[4] = {ld[g][2].x & mk1, ld[g][2].y & mk1, ld[g][2].z & mk1, ld[g][2].w & mk1};
#pragma unroll
            for (int j = 0; j < 4; ++j) {
                const f32x2 w0 = tw[g][j][0], w1 = tw[g][j][1], w2 = tw[g][j][2], bb = tw[g][j][3];
                u[g][2 * j] = bflo(a[j]) * w0.x + bflo(bq[j]) * w1.x + bflo(cq[j]) * w2.x + bb.x;
                u[g][2 * j + 1] = bfhi(a[j]) * w0.y + bfhi(bq[j]) * w1.y + bfhi(cq[j]) * w2.y + bb.y;
            }
          } }
        { const int itn = it + C.G; if (itn < 6144) HG_LOAD(itn); }
        asm volatile("" ::: "memory");
        { u32x4 o; o.x = cvt_pk(u[0][0], u[0][1]); o.y = cvt_pk(u[0][2], u[0][3]); o.z = cvt_pk(u[0][4], u[0][5]); o.w = cvt_pk(u[0][6], u[0][7]);
          *(u32x4*)(X0 + (size_t)(R0 + t) * D + c0) = o; }
        __syncthreads();
#pragma unroll
        for (int j = 0; j < 8; ++j) zs[(8 * c8 + j) * 72 + tl] = (bf16_t)(cvt_pk(u[2][j] * u[1][j], 0.f) & 0xffffu);
        __syncthreads();
        { const int cl = tid >> 3, t8 = tid & 7;
          const u32x4 o = *(const LAS u32x4*)(zs + cl * 72 + 8 * t8);
          bf16_t* ZT = smp ? ZTs : ZTp;
          *(u32x4*)(ZT + ((size_t)(cbk * 64 + cl) * NB + b) * L + tb * 64 + 8 * t8) = o; }
    }
#undef HG_LOAD
    __syncthreads();
}

template <int L, int NB>
__device__ __forceinline__ void phase_hy_conv(const Ctx& C, const bf16_t* FG, const bf16_t* ZT, bf16_t* YT) {
    constexpr int WPC = L / 256, CPB = 8 / WPC, NS = L / 32, ROW = 2 * L + 64, UNITS = L / 4, COPYB = UNITS * 16, CHB = 8 * COPYB;
    constexpr int NH = NS > 16 ? NS / 16 : 1, JH = NS / NH;
    const int lane = C.lane, w = C.wave, ch_local = w / WPC, w4 = w % WPC, r = lane & 15, q = lane >> 4;
    for (int it = C.bid; it < 2048 / CPB; it += C.G) {
        const int c = it * CPB + ch_local;
        __syncthreads();
        {
            const int tcid = w4 * 64 + lane;
            const bf16_t* frow = FG + (size_t)c * ROW;
            for (int x = tcid; x < UNITS; x += 64 * WPC) {
                const u32x4 d0 = *(const u32x4*)(frow + 8 * x), d1 = *(const u32x4*)(frow + 8 * x + 8);
                const unsigned dd[8] = {d0.x, d0.y, d0.z, d0.w, d1.x, d1.y, d1.z, d1.w};
#pragma unroll
                for (int k = 0; k < 8; ++k) {
                    u32x4 o;
                    if ((k & 1) == 0) { o.x = dd[k / 2]; o.y = dd[k / 2 + 1]; o.z = dd[k / 2 + 2]; o.w = dd[k / 2 + 3]; }
                    else { const int b0 = (k - 1) / 2;
                        o.x = (dd[b0] >> 16) | (dd[b0 + 1] << 16); o.y = (dd[b0 + 1] >> 16) | (dd[b0 + 2] << 16); o.z = (dd[b0 + 2] >> 16) | (dd[b0 + 3] << 16); o.w = (dd[b0 + 3] >> 16) | (dd[b0 + 4] << 16); }
                    *(LAS u32x4*)(C.lds + ch_local * CHB + k * COPYB + x * 16) = o;
                }
            }
        }
        __syncthreads();
        f32x4 acc[16];
        { const float z0 = opaque_zero();
#pragma unroll
        for (int i = 0; i < 16; ++i) acc[i] = (f32x4){z0, z0, z0, z0}; }
        const bf16_t* zrow = ZT + ((size_t)c * NB + (r % NB)) * L + 8 * q;
        const LAS unsigned char* abase = C.lds + ch_local * CHB + (7 - (r & 7)) * COPYB + ((L - 8) / 8 - (r >> 3) + q - 32 * w4) * 16;
#pragma unroll
        for (int hh = 0; hh < NH; ++hh) {
            bf16x8 bf[JH];
#pragma unroll
            for (int j = 0; j < JH; ++j) bf[j] = *(const bf16x8*)(zrow + 32 * (hh * JH + j));
#pragma unroll
            for (int e = -2 * (hh * JH + JH - 1); e <= 15 - 2 * (hh * JH); ++e) {
                const bf16x8 a = *(const LAS bf16x8*)(abase - 32 * e);
#pragma unroll
                for (int j = 0; j < JH; ++j) { const int il = e + 2 * (hh * JH + j);
                    if (il >= 0 && il < 16) asm volatile("v_mfma_f32_16x16x32_bf16 %0, %1, %2, %0" : "+v"(acc[il]) : "v"(a), "v"(bf[j])); }
                asm volatile("" :: "v"(a));
            }
#pragma unroll
            for (int j = 0; j < JH; ++j) asm volatile("" :: "v"(bf[j]));
        }
        asm volatile("s_nop 15\n\ts_nop 15" : "+v"(acc[0]), "+v"(acc[1]), "+v"(acc[2]), "+v"(acc[3]), "+v"(acc[4]), "+v"(acc[5]), "+v"(acc[6]), "+v"(acc[7]));
        asm volatile("" : "+v"(acc[8]), "+v"(acc[9]), "+v"(acc[10]), "+v"(acc[11]), "+v"(acc[12]), "+v"(acc[13]), "+v"(acc[14]), "+v"(acc[15]));
        if (r < NB) {
            bf16_t* yrow = YT + ((size_t)c * NB + r) * L + 256 * w4 + 4 * q;
#pragma unroll
            for (int i = 0; i < 16; ++i) { u32x2 o; o.x = cvt_pk(acc[i][0], acc[i][1]); o.y = cvt_pk(acc[i][2], acc[i][3]);
#if defined(MK_CONV_VARIANT) && MK_CONV_VARIANT == 1
                { const u32x4 zz = *(const u32x4*)(zrow + 32 * (i & 7)); o.x = zz.x; o.y = zz.y; }
#elif defined(MK_CONV_VARIANT) && MK_CONV_VARIANT == 2
                { const u32x4 aa = *(const LAS u32x4*)(abase - 32 * (i - 8)); o.x = aa.x; o.y = aa.w; }
#endif
                *(u32x2*)(yrow + 16 * i) = o; }
        }
    }
    __syncthreads();
}

__device__ __forceinline__ void phase_hy_out(const Ctx& C, const bf16_t* YTp, const bf16_t* YTs, const bf16_t* X0, bf16_t* Om) {
    const int tid = C.tid;
    LAS bf16_t* ys = (LAS bf16_t*)C.lds;
    u32x4 v, xv;
#define HO_LOAD(it_) do { const bool smp_ = (it_) >= 2048; const int q_ = smp_ ? (it_) - 2048 : (it_); const int cbk_ = q_ & 31, tb_ = smp_ ? (q_ >> 5) & 15 : (q_ >> 5) & 3, b_ = smp_ ? q_ >> 9 : q_ >> 7; \
        const int L_ = smp_ ? 1024 : 256, R0_ = smp_ ? MP + b_ * 1024 : b_ * 256, NB_ = smp_ ? 8 : 16; const bf16_t* YT_ = smp_ ? YTs : YTp; \
        v = *(const u32x4*)(YT_ + ((size_t)(cbk_ * 64 + (tid >> 3)) * NB_ + b_) * L_ + tb_ * 64 + 8 * (tid & 7)); \
        xv = *(const u32x4*)(X0 + (size_t)(R0_ + tb_ * 64 + (tid >> 3)) * D + cbk_ * 64 + 8 * (tid & 7)); } while (0)
    int it = C.bid;
    if (it < 6144) HO_LOAD(it);
    for (; it < 6144; it += C.G) {
        const bool smp = it >= 2048; const int q = smp ? it - 2048 : it;
        const int cbk = q & 31, tb = smp ? (q >> 5) & 15 : (q >> 5) & 3, b = smp ? q >> 9 : q >> 7;
        const int R0 = smp ? MP + b * 1024 : b * 256;
        __syncthreads();
        { const int cl = tid >> 3, t8 = tid & 7;
          const unsigned pv[4] = {v.x, v.y, v.z, v.w};
#pragma unroll
          for (int j = 0; j < 4; ++j) { ys[(8 * t8 + 2 * j) * 72 + cl] = (bf16_t)(pv[j] & 0xffffu); ys[(8 * t8 + 2 * j + 1) * 72 + cl] = (bf16_t)(pv[j] >> 16); } }
        __syncthreads();
        { const int tl = tid >> 3, c8 = tid & 7; const size_t off = (size_t)(R0 + tb * 64 + tl) * D + cbk * 64 + 8 * c8;
          const u32x4 yv = *(const LAS u32x4*)(ys + tl * 72 + 8 * c8);
          const unsigned py[4] = {yv.x, yv.y, yv.z, yv.w}, px[4] = {xv.x, xv.y, xv.z, xv.w}; u32x4 o;
          o.x = cvt_pk(bflo(py[0]) * bflo(px[0]), bfhi(py[0]) * bfhi(px[0])); o.y = cvt_pk(bflo(py[1]) * bflo(px[1]), bfhi(py[1]) * bfhi(px[1]));
          o.z = cvt_pk(bflo(py[2]) * bflo(px[2]), bfhi(py[2]) * bfhi(px[2])); o.w = cvt_pk(bflo(py[3]) * bflo(px[3]), bfhi(py[3]) * bfhi(px[3]));
          const int itn = it + C.G;
          if (itn < 6144) HO_LOAD(itn);
          asm volatile("" ::: "memory");
          *(u32x4*)(Om + off) = o; }
    }
#undef HO_LOAD
    __syncthreads();
}

__device__ __forceinline__ void phase_rw_mix(const Ctx& C, const bf16_t* H, const float* mu, bf16_t* XM) {
    const int gw = C.bid * 8 + C.wave, NGW = C.G * 8, lane = C.lane;
#pragma unroll 1
    for (int ch = 0; ch < 4; ++ch) {
        const int c0 = 8 * (lane + 64 * ch);
        f32x4 mv[6][2];
#pragma unroll
        for (int s = 0; s < 6; ++s) { const int mi = s == 0 ? 0 : s == 1 ? 2 : s == 2 ? 3 : s == 3 ? 1 : s; mv[s][0] = *(const f32x4*)(mu + mi * D + c0); mv[s][1] = *(const f32x4*)(mu + mi * D + c0 + 4); }
        u32x4 a, b, c;
#define MX_LOAD(m_) do { const int t_ = (m_) < MP ? ((m_) & 255) : (((m_) - MP) & 1023), L_ = (m_) < MP ? 256 : 1024; const bf16_t* hp_ = H + (size_t)(m_) * D + c0; \
            a = *(const u32x4*)(hp_ - (t_ > 0 ? D : 0)); c = *(const u32x4*)(hp_ + (t_ < L_ - 1 ? D : 0)); b = *(const u32x4*)hp_; } while (0)
        int m = gw;
        if (m < MT) MX_LOAD(m);
        for (; m < MT; m += NGW) {
            const int t = m < MP ? (m & 255) : ((m - MP) & 1023), L = m < MP ? 256 : 1024;
            const unsigned mk0 = t > 0 ? 0xffffffffu : 0u, mk1 = t < L - 1 ? 0xffffffffu : 0u;
            const unsigned pa[4] = {a.x & mk0, a.y & mk0, a.z & mk0, a.w & mk0}, pb[4] = {b.x, b.y, b.z, b.w}, pc[4] = {c.x & mk1, c.y & mk1, c.z & mk1, c.w & mk1};
            float hv[8], xx[8];
#pragma unroll
            for (int j = 0; j < 4; ++j) { hv[2 * j] = bflo(pb[j]); hv[2 * j + 1] = bfhi(pb[j]);
                xx[2 * j] = 0.5f * (bflo(pa[j]) + bflo(pc[j])) - hv[2 * j]; xx[2 * j + 1] = 0.5f * (bfhi(pa[j]) + bfhi(pc[j])) - hv[2 * j + 1]; }
            u32x4 o[6];
#pragma unroll
            for (int s = 0; s < 6; ++s) {
                const f32x4 m0 = mv[s][0], m1 = mv[s][1];
                o[s].x = cvt_pk(hv[0] + xx[0] * m0.x, hv[1] + xx[1] * m0.y); o[s].y = cvt_pk(hv[2] + xx[2] * m0.z, hv[3] + xx[3] * m0.w);
                o[s].z = cvt_pk(hv[4] + xx[4] * m1.x, hv[5] + xx[5] * m1.y); o[s].w = cvt_pk(hv[6] + xx[6] * m1.z, hv[7] + xx[7] * m1.w);
            }
            const int mn = m + NGW;
            if (mn < MT) MX_LOAD(mn);
            asm volatile("" ::: "memory");
#pragma unroll
            for (int s = 0; s < 6; ++s) *(u32x4*)(XM + ((size_t)s * MT + m) * D + c0) = o[s];
        }
#undef MX_LOAD
    }
}

__device__ __forceinline__ float dpp_xor1(float x) { return __int_as_float(__builtin_amdgcn_update_dpp(0, __float_as_int(x), 0xB1, 0xF, 0xF, true)); }
__device__ __forceinline__ float dpp_xor2(float x) { return __int_as_float(__builtin_amdgcn_update_dpp(0, __float_as_int(x), 0x4E, 0xF, 0xF, true)); }

constexpr int SC_STEP = 6 * 64;
template <int R, int SC_TS>
__device__ __forceinline__ void rw_scan_task(LAS float* buf, int lane, const bf16_t* Rm, const bf16_t* Km, const bf16_t* Vm, const bf16_t* LD, const bf16_t* LA,
                                             const float* k_k, const float* k_a, const float* invsq, const float* state_in, bf16_t* YB, float* state_out, bool smp, int b, int head, int dir, int half) {
    const int rg = lane >> 2, kq = lane & 3;
    const int L = smp ? 1024 : 256, R0 = smp ? MP + b * 1024 : b * 256;
    const int row0 = half * (16 * R) + R * rg;
    f32x2 S[R][8];
    if (smp) {
        const float* sp = state_in + ((size_t)(b * 2 + dir) * 32 + head) * 4096 + row0 * 64 + 16 * kq;
#pragma unroll
        for (int rr = 0; rr < R; ++rr)
#pragma unroll
            for (int j4 = 0; j4 < 4; ++j4) { const f32x4 v = *(const f32x4*)(sp + rr * 64 + 4 * j4); S[rr][2 * j4] = (f32x2){v.x, v.y}; S[rr][2 * j4 + 1] = (f32x2){v.z, v.w}; }
    } else {
#pragma unroll
        for (int rr = 0; rr < R; ++rr)
#pragma unroll
            for (int j = 0; j < 8; ++j) S[rr][j] = (f32x2){0.f, 0.f};
    }
    const int ch = head * 64 + lane; const size_t hbase = (size_t)head * MT * 64 + lane;
    const float kkc = k_k[ch], kac = k_a[ch];
    const bf16_t* ldp = LD + (size_t)dir * MT * D; const bf16_t* lap = LA + (size_t)dir * MT * D;
    bf16_t* yb = YB + (size_t)dir * MT * D;
    bf16_t pr[SC_TS], pk[SC_TS], pv[SC_TS], pl[SC_TS], pa[SC_TS], qr[SC_TS], qk[SC_TS], qv[SC_TS], ql[SC_TS], qa[SC_TS];
    const int tstart = dir ? L - 1 : 0, tstep = dir ? -1 : 1;
    const int NCH = L / SC_TS;
#define SC_PREFETCH(c) do { _Pragma("unroll") for (int s_ = 0; s_ < SC_TS; ++s_) { const size_t o_ = hbase + (size_t)(R0 + tstart + tstep * ((c) * SC_TS + s_)) * 64; pr[s_] = Rm[o_]; pk[s_] = Km[o_]; pv[s_] = Vm[o_]; pl[s_] = ldp[o_]; pa[s_] = lap[o_]; } } while (0)
#define SC_DERIVE(s_, bufp) do { const float r_ = bf2f(pr[s_]), k_ = bf2f(pk[s_]), v_ = bf2f(pv[s_]), ld_ = bf2f(pl[s_]), a_ = fsigmoid(bf2f(pa[s_])); \
        const float kr_ = k_ * kkc; const float kk_ = kr_ * __builtin_amdgcn_rsqf(wave_sum(kr_ * kr_) + 1e-12f); \
        const unsigned sa_ = (unsigned)(unsigned long)((bufp) + (s_) * SC_STEP) + 4u * (unsigned)lane;     \
        asm volatile("ds_write_b32 %0, %1" :: "v"(sa_), "v"(fexp(ld_))); asm volatile("ds_write_b32 %0, %1 offset:256" :: "v"(sa_), "v"(kk_ * a_)); \
        asm volatile("ds_write_b32 %0, %1 offset:512" :: "v"(sa_), "v"(k_ * (1.0f + (a_ - 1.0f) * kac))); asm volatile("ds_write_b32 %0, %1 offset:768" :: "v"(sa_), "v"(-kk_)); \
        asm volatile("ds_write_b32 %0, %1 offset:1024" :: "v"(sa_), "v"(r_)); asm volatile("ds_write_b32 %0, %1 offset:1280" :: "v"(sa_), "v"(v_)); } while (0)
#define SC_PREFETCH2(c) do { _Pragma("unroll") for (int s_ = 0; s_ < SC_TS; ++s_) { const size_t o_ = hbase + (size_t)(R0 + tstart + tstep * ((c) * SC_TS + s_)) * 64; qr[s_] = Rm[o_]; qk[s_] = Km[o_]; qv[s_] = Vm[o_]; ql[s_] = ldp[o_]; qa[s_] = lap[o_]; } } while (0)
    SC_PREFETCH(0);
#pragma unroll
    for (int s = 0; s < SC_TS; ++s) SC_DERIVE(s, buf);
    asm volatile("s_waitcnt lgkmcnt(0)" ::: "memory");
    SC_PREFETCH(1);
    SC_PREFETCH2(2);
#define SC_DERIVE_Q(s_, bufp) do { const float r_ = bf2f(qr[s_]), k_ = bf2f(qk[s_]), v_ = bf2f(qv[s_]), ld_ = bf2f(ql[s_]), a_ = fsigmoid(bf2f(qa[s_])); \
        const float kr_ = k_ * kkc; const float kk_ = kr_ * __builtin_amdgcn_rsqf(wave_sum(kr_ * kr_) + 1e-12f); \
        const unsigned sa_ = (unsigned)(unsigned long)((bufp) + (s_) * SC_STEP) + 4u * (unsigned)lane; \
        asm volatile("ds_write_b32 %0, %1" :: "v"(sa_), "v"(fexp(ld_))); asm volatile("ds_write_b32 %0, %1 offset:256" :: "v"(sa_), "v"(kk_ * a_)); \
        asm volatile("ds_write_b32 %0, %1 offset:512" :: "v"(sa_), "v"(k_ * (1.0f + (a_ - 1.0f) * kac))); asm volatile("ds_write_b32 %0, %1 offset:768" :: "v"(sa_), "v"(-kk_)); \
        asm volatile("ds_write_b32 %0, %1 offset:1024" :: "v"(sa_), "v"(r_)); asm volatile("ds_write_b32 %0, %1 offset:1280" :: "v"(sa_), "v"(v_)); } while (0)
    LAS float* const buf0 = buf; LAS float* const buf1 = buf + SC_TS * SC_STEP;
    for (int cix = 0; cix < NCH; cix += 2) {
#pragma unroll
        for (int s = 0; s < SC_TS; ++s) {
            SC_DERIVE(s, buf1);
            if (cix + 3 < NCH) { const size_t o_ = hbase + (size_t)(R0 + tstart + tstep * ((cix + 3) * SC_TS + s)) * 64; pr[s] = Rm[o_]; pk[s] = Km[o_]; pv[s] = Vm[o_]; pl[s] = ldp[o_]; pa[s] = lap[o_]; }
#define BC_ buf0
#define CX_ cix
            const LAS float* sb = BC_ + s * SC_STEP;
            f32x2 w2[8], b2[8], d2[8], n2[8], r2[8];
#pragma unroll
            for (int j4 = 0; j4 < 4; ++j4) { const f32x4 nv = *(const LAS f32x4*)(sb + 192 + 16 * kq + 4 * j4); n2[2 * j4] = (f32x2){nv.x, nv.y}; n2[2 * j4 + 1] = (f32x2){nv.z, nv.w}; }
#pragma unroll
            for (int j4 = 0; j4 < 4; ++j4) {
                const f32x4 bv = *(const LAS f32x4*)(sb + 64 + 16 * kq + 4 * j4), dv = *(const LAS f32x4*)(sb + 128 + 16 * kq + 4 * j4), wv = *(const LAS f32x4*)(sb + 16 * kq + 4 * j4), rv = *(const LAS f32x4*)(sb + 256 + 16 * kq + 4 * j4);
                w2[2 * j4] = (f32x2){wv.x, wv.y}; w2[2 * j4 + 1] = (f32x2){wv.z, wv.w}; b2[2 * j4] = (f32x2){bv.x, bv.y}; b2[2 * j4 + 1] = (f32x2){bv.z, bv.w};
                d2[2 * j4] = (f32x2){dv.x, dv.y}; d2[2 * j4 + 1] = (f32x2){dv.z, dv.w}; r2[2 * j4] = (f32x2){rv.x, rv.y}; r2[2 * j4 + 1] = (f32x2){rv.z, rv.w};
            }
            float vrow[R];
            if (R == 4) { const f32x4 vv = *(const LAS f32x4*)(sb + 320 + row0); vrow[0] = vv.x; vrow[R > 1 ? 1 : 0] = vv.y; vrow[R > 2 ? R - 2 : 0] = vv.z; vrow[R - 1] = vv.w; }
            else if (R == 2) { const f32x2 vv = *(const LAS f32x2*)(sb + 320 + row0); vrow[0] = vv.x; vrow[R - 1] = vv.y; }
            else vrow[0] = sb[320 + row0];
            float y[R];
#pragma unroll
            for (int rr = 0; rr < R; ++rr) {
                f32x2 a0 = S[rr][0] * n2[0], a1 = S[rr][1] * n2[1];
#pragma unroll
                for (int j = 2; j < 8; j += 2) { a0 = S[rr][j] * n2[j] + a0; a1 = S[rr][j + 1] * n2[j + 1] + a1; }
                a0 = a0 + a1;
                float sa = a0.x + a0.y; sa += dpp_xor1(sa); sa += dpp_xor2(sa);
                const f32x2 sa2 = (f32x2){sa, sa}, vr2 = (f32x2){vrow[rr], vrow[rr]};
                f32x2 y0 = (f32x2){0.f, 0.f}, y1 = (f32x2){0.f, 0.f};
#pragma unroll
                for (int j = 0; j < 8; j += 2) {
                    S[rr][j] = S[rr][j] * w2[j] + (sa2 * b2[j] + vr2 * d2[j]);
                    S[rr][j + 1] = S[rr][j + 1] * w2[j + 1] + (sa2 * b2[j + 1] + vr2 * d2[j + 1]);
                    y0 = S[rr][j] * r2[j] + y0; y1 = S[rr][j + 1] * r2[j + 1] + y1;
                }
                y0 = y0 + y1;
                float yy = y0.x + y0.y; yy += dpp_xor1(yy); yy += dpp_xor2(yy); y[rr] = yy;
            }
            {
                const int t = tstart + tstep * ((CX_) * SC_TS + s); bf16_t* yp = yb + (size_t)(R0 + t) * D + head * 64;
                if (R == 4) { const float ys = kq == 0 ? y[0] : kq == 1 ? y[R > 1 ? 1 : 0] : kq == 2 ? y[R > 2 ? R - 2 : 0] : y[R - 1]; yp[lane] = (bf16_t)cvt_pk(ys, ys); }
                else if (R == 2) { const float ys = (kq & 1) ? y[R - 1] : y[0]; yp[half * 32 + 2 * rg + (kq & 1)] = (bf16_t)cvt_pk(ys, ys); }
                else yp[row0] = (bf16_t)cvt_pk(y[0], y[0]);
            }
#undef BC_
#undef CX_
        }
        asm volatile("s_waitcnt lgkmcnt(0)" ::: "memory");
#pragma unroll
        for (int s = 0; s < SC_TS; ++s) {
            SC_DERIVE_Q(s, buf0);
            if (cix + 4 < NCH) { const size_t o_ = hbase + (size_t)(R0 + tstart + tstep * ((cix + 4) * SC_TS + s)) * 64; qr[s] = Rm[o_]; qk[s] = Km[o_]; qv[s] = Vm[o_]; ql[s] = ldp[o_]; qa[s] = lap[o_]; }
#define BC_ buf1
#define CX_ (cix + 1)
            const LAS float* sb = BC_ + s * SC_STEP;
            f32x2 w2[8], b2[8], d2[8], n2[8], r2[8];
#pragma unroll
            for (int j4 = 0; j4 < 4; ++j4) { const f32x4 nv = *(const LAS f32x4*)(sb + 192 + 16 * kq + 4 * j4); n2[2 * j4] = (f32x2){nv.x, nv.y}; n2[2 * j4 + 1] = (f32x2){nv.z, nv.w}; }
#pragma unroll
            for (int j4 = 0; j4 < 4; ++j4) {
                const f32x4 bv = *(const LAS f32x4*)(sb + 64 + 16 * kq + 4 * j4), dv = *(const LAS f32x4*)(sb + 128 + 16 * kq + 4 * j4), wv = *(const LAS f32x4*)(sb + 16 * kq + 4 * j4), rv = *(const LAS f32x4*)(sb + 256 + 16 * kq + 4 * j4);
                w2[2 * j4] = (f32x2){wv.x, wv.y}; w2[2 * j4 + 1] = (f32x2){wv.z, wv.w}; b2[2 * j4] = (f32x2){bv.x, bv.y}; b2[2 * j4 + 1] = (f32x2){bv.z, bv.w};
                d2[2 * j4] = (f32x2){dv.x, dv.y}; d2[2 * j4 + 1] = (f32x2){dv.z, dv.w}; r2[2 * j4] = (f32x2){rv.x, rv.y}; r2[2 * j4 + 1] = (f32x2){rv.z, rv.w};
            }
            float vrow[R];
            if (R == 4) { const f32x4 vv = *(const LAS f32x4*)(sb + 320 + row0); vrow[0] = vv.x; vrow[R > 1 ? 1 : 0] = vv.y; vrow[R > 2 ? R - 2 : 0] = vv.z; vrow[R - 1] = vv.w; }
            else if (R == 2) { const f32x2 vv = *(const LAS f32x2*)(sb + 320 + row0); vrow[0] = vv.x; vrow[R - 1] = vv.y; }
            else vrow[0] = sb[320 + row0];
            float y[R];
#pragma unroll
            for (int rr = 0; rr < R; ++rr) {
                f32x2 a0 = S[rr][0] * n2[0], a1 = S[rr][1] * n2[1];
#pragma unroll
                for (int j = 2; j < 8; j += 2) { a0 = S[rr][j] * n2[j] + a0; a1 = S[rr][j + 1] * n2[j + 1] + a1; }
                a0 = a0 + a1;
                float sa = a0.x + a0.y; sa += dpp_xor1(sa); sa += dpp_xor2(sa);
                const f32x2 sa2 = (f32x2){sa, sa}, vr2 = (f32x2){vrow[rr], vrow[rr]};
                f32x2 y0 = (f32x2){0.f, 0.f}, y1 = (f32x2){0.f, 0.f};
#pragma unroll
                for (int j = 0; j < 8; j += 2) {
                    S[rr][j] = S[rr][j] * w2[j] + (sa2 * b2[j] + vr2 * d2[j]);
                    S[rr][j + 1] = S[rr][j + 1] * w2[j + 1] + (sa2 * b2[j + 1] + vr2 * d2[j + 1]);
                    y0 = S[rr][j] * r2[j] + y0; y1 = S[rr][j + 1] * r2[j + 1] + y1;
                }
                y0 = y0 + y1;
                float yy = y0.x + y0.y; yy += dpp_xor1(yy); yy += dpp_xor2(yy); y[rr] = yy;
            }
            {
                const int t = tstart + tstep * ((CX_) * SC_TS + s); bf16_t* yp = yb + (size_t)(R0 + t) * D + head * 64;
                if (R == 4) { const float ys = kq == 0 ? y[0] : kq == 1 ? y[R > 1 ? 1 : 0] : kq == 2 ? y[R > 2 ? R - 2 : 0] : y[R - 1]; yp[lane] = (bf16_t)cvt_pk(ys, ys); }
                else if (R == 2) { const float ys = (kq & 1) ? y[R - 1] : y[0]; yp[half * 32 + 2 * rg + (kq & 1)] = (bf16_t)cvt_pk(ys, ys); }
                else yp[row0] = (bf16_t)cvt_pk(y[0], y[0]);
            }
#undef BC_
#undef CX_
        }
        asm volatile("s_waitcnt lgkmcnt(0)" ::: "memory");
    }
#undef SC_DERIVE_Q
#undef SC_PREFETCH
#undef SC_PREFETCH2
#undef SC_DERIVE
    if (!smp) {
        float* sp = state_out + ((size_t)(b * 2 + dir) * 32 + head) * 4096 + row0 * 64 + 16 * kq;
#pragma unroll
        for (int rr = 0; rr < R; ++rr)
#pragma unroll
            for (int j4 = 0; j4 < 4; ++j4) *(f32x4*)(sp + rr * 64 + 4 * j4) = (f32x4){S[rr][2 * j4].x, S[rr][2 * j4].y, S[rr][2 * j4 + 1].x, S[rr][2 * j4 + 1].y};
    }
}
__device__ __forceinline__ void phase_rw_scan(const Ctx& C, const bf16_t* Rm, const bf16_t* Km, const bf16_t* Vm, const bf16_t* LD, const bf16_t* LA,
                                              const float* k_k, const float* k_a, const float* invsq, const float* state_in, bf16_t* YB, float* state_out) {
    const int lane = C.lane, w = C.wave;
    LAS float* buf = (LAS float*)(C.lds + (w < 4 ? w * 24576 : 98304 + (w - 4) * 12288));
    if (w < 4) { for (int slot = C.bid * 4 + w; slot < 1024; slot += C.G * 4) { const int id = slot >> 1; rw_scan_task<2, 8>(buf, lane, Rm, Km, Vm, LD, LA, k_k, k_a, invsq, state_in, YB, state_out, true, id >> 6, (id >> 1) & 31, id & 1, slot & 1); } }
    else { for (int id = C.bid * 4 + (w - 4); id < 1024; id += C.G * 4) rw_scan_task<4, 4>(buf, lane, Rm, Km, Vm, LD, LA, k_k, k_a, invsq, state_in, YB, state_out, false, id >> 6, (id >> 1) & 31, id & 1, 0); }
    if (w >= 4) late_transposes(C, buf, C.bid * 4 + (w - 4), C.G * 4);
    __syncthreads();
}

__device__ __forceinline__ float head8_sum(float v) { v = DPP_ADD(v, 0xB1); v = DPP_ADD(v, 0x4E); v = DPP_ADD(v, 0x141); return v; }
__device__ __forceinline__ void phase_rw_post(const Ctx& C, const bf16_t* YB, const bf16_t* Rm, const bf16_t* Km, const bf16_t* Vm, const bf16_t* LA, const bf16_t* Gt,
                                              const float* k_a, const float* r_k, const float* ln_w, const float* ln_b, bf16_t* Om) {
    const int gw = C.bid * 8 + C.wave, NGW = C.G * 8, lane = C.lane;
#pragma unroll 1
    for (int ch = 0; ch < 4; ++ch) {
        const int c0 = 8 * (lane + 64 * ch);
        const f32x4 ka0 = *(const f32x4*)(k_a + c0), ka1 = *(const f32x4*)(k_a + c0 + 4), rk0 = *(const f32x4*)(r_k + c0), rk1 = *(const f32x4*)(r_k + c0 + 4);
        const f32x4 lw0 = *(const f32x4*)(ln_w + c0), lw1 = *(const f32x4*)(ln_w + c0 + 4), lb0 = *(const f32x4*)(ln_b + c0), lb1 = *(const f32x4*)(ln_b + c0 + 4);
        u32x4 yfw, ybw, rr, kk, vv, gg, l0, l1;
#define PO_LOAD(m_) do { const size_t o_ = (size_t)(m_) * D + c0; const size_t oh_ = hm_index((m_), c0); yfw = *(const u32x4*)(YB + o_); ybw = *(const u32x4*)(YB + (size_t)MT * D + o_); \
            rr = *(const u32x4*)(Rm + oh_); kk = *(const u32x4*)(Km + oh_); vv = *(const u32x4*)(Vm + oh_); gg = *(const u32x4*)(Gt + o_); l0 = *(const u32x4*)(LA + oh_); l1 = *(const u32x4*)(LA + (size_t)MT * D + oh_); } while (0)
        int m = gw;
        if (m < MT) PO_LOAD(m);
        for (; m < MT; m += NGW) {
            float y[8], r[8], k[8], v[8], g[8], a0[8], a1[8], ka[8], rk[8], lw[8], lb[8];
            const unsigned pyf[4] = {yfw.x, yfw.y, yfw.z, yfw.w}, pyb[4] = {ybw.x, ybw.y, ybw.z, ybw.w}, pr[4] = {rr.x, rr.y, rr.z, rr.w}, pk[4] = {kk.x, kk.y, kk.z, kk.w}, pv[4] = {vv.x, vv.y, vv.z, vv.w}, pg[4] = {gg.x, gg.y, gg.z, gg.w}, p0[4] = {l0.x, l0.y, l0.z, l0.w}, p1[4] = {l1.x, l1.y, l1.z, l1.w};
#pragma unroll
            for (int j = 0; j < 4; ++j) {
                y[2 * j] = bflo(pyf[j]) + bflo(pyb[j]); y[2 * j + 1] = bfhi(pyf[j]) + bfhi(pyb[j]); ka[j] = ka0[j]; ka[4 + j] = ka1[j]; rk[j] = rk0[j]; rk[4 + j] = rk1[j]; lw[j] = lw0[j]; lw[4 + j] = lw1[j]; lb[j] = lb0[j]; lb[4 + j] = lb1[j];
                r[2 * j] = bflo(pr[j]); r[2 * j + 1] = bfhi(pr[j]); k[2 * j] = bflo(pk[j]); k[2 * j + 1] = bfhi(pk[j]); v[2 * j] = bflo(pv[j]); v[2 * j + 1] = bfhi(pv[j]);
                g[2 * j] = bflo(pg[j]); g[2 * j + 1] = bfhi(pg[j]); a0[2 * j] = fsigmoid(bflo(p0[j])); a0[2 * j + 1] = fsigmoid(bfhi(p0[j])); a1[2 * j] = fsigmoid(bflo(p1[j])); a1[2 * j + 1] = fsigmoid(bfhi(p1[j]));
            }
            float s = 0.f, bon = 0.f;
#pragma unroll
            for (int j = 0; j < 8; ++j) { s += y[j]; bon += r[j] * (k[j] * (2.0f + (a0[j] + a1[j] - 2.0f) * ka[j])) * rk[j]; }
            const float mean = head8_sum(s) * (1.0f / 64.0f); bon = head8_sum(bon);
            float q = 0.f;
#pragma unroll
            for (int j = 0; j < 8; ++j) { y[j] -= mean; q += y[j] * y[j]; }
            const float rstd = __builtin_amdgcn_rsqf(head8_sum(q) * (1.0f / 64.0f) + 64e-5f);
            float ov[8];
#pragma unroll
            for (int j = 0; j < 8; ++j) ov[j] = (y[j] * rstd * lw[j] + lb[j] + bon * v[j]) * g[j];
            u32x4 w; w.x = cvt_pk(ov[0], ov[1]); w.y = cvt_pk(ov[2], ov[3]); w.z = cvt_pk(ov[4], ov[5]); w.w = cvt_pk(ov[6], ov[7]);
            const int mn = m + NGW;
            if (mn < MT) PO_LOAD(mn);
            asm volatile("" ::: "memory");
            *(u32x4*)(Om + (size_t)m * D + c0) = w;
        }
#undef PO_LOAD
    }
}

constexpr int NPH = 35;
#define IN(k) (lo <= (k) && (k) < hi)
#define SEAM(k) do { if (IN(k) && IN((k) + 1)) xcd_barrier(bar); } while (0)
#define LDSG ((PG8_LAS unsigned char*)C.lds)
#ifndef MK_REP_MASK
#define MK_REP_MASK 0ull
#endif
#define REPQ(k) (((MK_REP_MASK) >> (k)) & 1ull)

template <class Epi>
__device__ __forceinline__ void run_gemm(const Ctx& C, const bf16_t* A, const bf16_t* Bt, int N, int K, const Epi& E) {
    pg8::Gemm g{A, Bt, MT, N, K, K}; pg8::StaticOrder S; S.init(MT, N, C.G, C.bid);
    pg8::gemm_phase<Epi, pg8::StaticOrder, false>(LDSG, g, S, E, nullptr);
}

#ifndef MK_SPLIT_MASK
#define MK_SPLIT_MASK 15
#endif
#define PREVP1(L) (((L) > 0 && (((MK_SPLIT_MASK) >> ((L) - 1)) & 1)) ? (const bf16_t*)WSP(bf16_t, WS_ARENA + AR_SLAB) : (const bf16_t*)nullptr)
constexpr size_t AR_SLAB = 200 * MiB;
constexpr size_t CTL_SPLIT = 65536;
template <int SET>
__device__ __forceinline__ void run_gemm_split_res(const Ctx& C, const bf16_t* A, const bf16_t* Bt, int K, bf16_t* X, const float* gate_base) {
    pg8::Gemm g{A, Bt, MT, D, K, K / 2}; TailSplitOrder S; S.init(C.G, C.bid, K / 64);
    EpiResidualSplitB E{X, gate_base, WSP(bf16_t, WS_ARENA + AR_SLAB)};
    pg8::gemm_phase<EpiResidualSplitB, TailSplitOrder, false>(LDSG, g, S, E, nullptr);
}
template <int LAYER>
__device__ __forceinline__ void mlp_block(const Ctx& C, const XcdBarrier& bar, int lo, int hi, int b0) {
    bf16_t* X = WSP(bf16_t, WS_X); bf16_t* H = WSP(bf16_t, WS_H); bf16_t* U = WSP(bf16_t, WS_ARENA + AR_U);
    if (IN(b0)) { { phase_norm_mod_b(C, X, karg<I_N2G>() + LAYER * D, LAYER, 3, H); } if (REPQ(b0)) { phase_norm_mod_b(C, X, karg<I_N2G>() + LAYER * D, LAYER, 3, H); } }
    SEAM(b0);
    if (IN(b0 + 1)) { { EpiBf16<1> E{U, FF}; run_gemm(C, H, WSP(bf16_t, WS_W1T) + (size_t)LAYER * D * FF, FF, D, E); } if (REPQ(b0 + 1)) { EpiBf16<1> E{U, FF}; run_gemm(C, H, WSP(bf16_t, WS_W1T) + (size_t)LAYER * D * FF, FF, D, E); } }
    SEAM(b0 + 1);
    if (IN(b0 + 2)) { { if constexpr (((MK_SPLIT_MASK) >> LAYER) & 1) run_gemm_split_res<LAYER>(C, U, WSP(bf16_t, WS_W2T) + (size_t)LAYER * D * FF, FF, X, MODP(LAYER, 0, 5)); else { EpiResidualB<false> E{X, MODP(LAYER, 0, 5), nullptr, nullptr}; run_gemm(C, U, WSP(bf16_t, WS_W2T) + (size_t)LAYER * D * FF, D, FF, E); } } if (REPQ(b0 + 2)) { if constexpr (((MK_SPLIT_MASK) >> LAYER) & 1) run_gemm_split_res<LAYER>(C, U, WSP(bf16_t, WS_W2T) + (size_t)LAYER * D * FF, FF, X, MODP(LAYER, 0, 5)); else { EpiResidualB<false> E{X, MODP(LAYER, 0, 5), nullptr, nullptr}; run_gemm(C, U, WSP(bf16_t, WS_W2T) + (size_t)LAYER * D * FF, D, FF, E); } } }
    SEAM(b0 + 2);
}

template <int LAYER, int J>
__device__ __forceinline__ void attn_layer(const Ctx& C, const XcdBarrier& bar, int lo, int hi, int b0) {
    bf16_t* X = WSP(bf16_t, WS_X); bf16_t* H = WSP(bf16_t, WS_H);
    bf16_t *Q = WSP(bf16_t, WS_ARENA + AR_Q), *Kb = WSP(bf16_t, WS_ARENA + AR_K), *Vb = WSP(bf16_t, WS_ARENA + AR_V), *O = WSP(bf16_t, WS_ARENA + AR_O);
    if (IN(b0)) { { if (LAYER == 0) { phase_fg_transpose(C); phase_norm_mod(C, karg<I_XP>(), karg<I_XS>(), karg<I_N1G>() + LAYER * D, LAYER, 0, H); } else phase_norm_mod_b(C, X, karg<I_N1G>() + LAYER * D, LAYER, 0, H, PREVP1(LAYER), X, 8192); } if (REPQ(b0)) { if (LAYER == 0) { phase_fg_transpose(C); phase_norm_mod(C, karg<I_XP>(), karg<I_XS>(), karg<I_N1G>() + LAYER * D, LAYER, 0, H); } else phase_norm_mod_b(C, X, karg<I_N1G>() + LAYER * D, LAYER, 0, H, PREVP1(LAYER), X, 8192); } }
    SEAM(b0);
    if (IN(b0 + 1)) { { EpiQKV E{Q, Kb, Vb, C.out + OUT_NK + (size_t)J * 256 * 512, C.out + OUT_NV + (size_t)J * 256 * 512}; run_gemm(C, H, WSP(bf16_t, WS_WQKVT) + (size_t)J * D * 3072, 3072, D, E); } if (REPQ(b0 + 1)) { EpiQKV E{Q, Kb, Vb, C.out + OUT_NK + (size_t)J * 256 * 512, C.out + OUT_NV + (size_t)J * 256 * 512}; run_gemm(C, H, WSP(bf16_t, WS_WQKVT) + (size_t)J * D * 3072, 3072, D, E); } }
    SEAM(b0 + 1);
    if (IN(b0 + 2)) { { phase_attention(C, Q, Kb, Vb, WSP(bf16_t, WS_KC) + (size_t)J * 512 * 512, WSP(bf16_t, WS_VC) + (size_t)J * 512 * 512, karg<I_SINK>() + J * 16, O); } if (REPQ(b0 + 2)) { phase_attention(C, Q, Kb, Vb, WSP(bf16_t, WS_KC) + (size_t)J * 512 * 512, WSP(bf16_t, WS_VC) + (size_t)J * 512 * 512, karg<I_SINK>() + J * 16, O); } }
    SEAM(b0 + 2);
    if (IN(b0 + 3)) { { EpiResidualB<LAYER == 0> E{X, MODP(LAYER, 0, 2), LAYER == 0 ? karg<I_XP>() : nullptr, LAYER == 0 ? karg<I_XS>() : nullptr}; run_gemm(C, O, WSP(bf16_t, WS_WOT) + (size_t)J * D * D, D, D, E); } if (REPQ(b0 + 3)) { EpiResidualB<LAYER == 0> E{X, MODP(LAYER, 0, 2), LAYER == 0 ? karg<I_XP>() : nullptr, LAYER == 0 ? karg<I_XS>() : nullptr}; run_gemm(C, O, WSP(bf16_t, WS_WOT) + (size_t)J * D * D, D, D, E); } }
    SEAM(b0 + 3);
    mlp_block<LAYER>(C, bar, lo, hi, b0 + 4);
}

template <int LAYER>
__device__ __forceinline__ void hyena_layer(const Ctx& C, const XcdBarrier& bar, int lo, int hi, int b0) {
    bf16_t* X = WSP(bf16_t, WS_X); bf16_t* H = WSP(bf16_t, WS_H);
    bf16_t *Pm = WSP(bf16_t, WS_ARENA + AR_P), *X0 = WSP(bf16_t, WS_ARENA + AR_X0), *ZT = WSP(bf16_t, WS_ARENA + AR_ZT), *YT = WSP(bf16_t, WS_ARENA + AR_YT), *HO = WSP(bf16_t, WS_ARENA + AR_HO);
    bf16_t *ZTp = ZT, *ZTs = ZT + (size_t)MP * D, *YTp = YT, *YTs = YT + (size_t)MP * D;
    if (IN(b0)) { { phase_norm_mod_b(C, X, karg<I_N1G>() + LAYER * D, LAYER, 0, H, PREVP1(LAYER), X, 8192); } if (REPQ(b0)) { phase_norm_mod_b(C, X, karg<I_N1G>() + LAYER * D, LAYER, 0, H, PREVP1(LAYER), X, 8192); } }
    SEAM(b0);
    if (IN(b0 + 1)) { { EpiBf16<0> E{Pm, 6144}; run_gemm(C, H, WSP(bf16_t, WS_HYINT), 6144, D, E); } if (REPQ(b0 + 1)) { EpiBf16<0> E{Pm, 6144}; run_gemm(C, H, WSP(bf16_t, WS_HYINT), 6144, D, E); } }
    SEAM(b0 + 1);
    if (IN(b0 + 2)) { { phase_hy_gate(C, Pm, karg<I_HYCW>(), karg<I_HYCB>(), X0, ZTp, ZTs); } if (REPQ(b0 + 2)) { phase_hy_gate(C, Pm, karg<I_HYCW>(), karg<I_HYCB>(), X0, ZTp, ZTs); } }
    SEAM(b0 + 2);
    if (IN(b0 + 3)) { { phase_hy_conv<1024, 8>(C, WSP(bf16_t, WS_FGS), ZTs, YTs); phase_hy_conv<256, 16>(C, WSP(bf16_t, WS_FGP), ZTp, YTp); } if (REPQ(b0 + 3)) { phase_hy_conv<1024, 8>(C, WSP(bf16_t, WS_FGS), ZTs, YTs); phase_hy_conv<256, 16>(C, WSP(bf16_t, WS_FGP), ZTp, YTp); } }
    SEAM(b0 + 3);
    if (IN(b0 + 4)) { { phase_hy_out(C, YTp, YTs, X0, HO); } if (REPQ(b0 + 4)) { phase_hy_out(C, YTp, YTs, X0, HO); } }
    SEAM(b0 + 4);
    if (IN(b0 + 5)) { { EpiResidualB<false> E{X, MODP(LAYER, 0, 2), nullptr, nullptr}; run_gemm(C, HO, WSP(bf16_t, WS_HYOUTT), D, D, E); } if (REPQ(b0 + 5)) { EpiResidualB<false> E{X, MODP(LAYER, 0, 2), nullptr, nullptr}; run_gemm(C, HO, WSP(bf16_t, WS_HYOUTT), D, D, E); } }
    SEAM(b0 + 5);
    mlp_block<LAYER>(C, bar, lo, hi, b0 + 6);
}

__device__ __forceinline__ void rw_g2_phase(const Ctx& C, const bf16_t* XM, bf16_t* Rm, bf16_t* A3, bf16_t* LD, bf16_t* LA, bf16_t* Gt) {
    if (C.G == 256 && C.bid >= 240) { pg8::Gemm g{XM, WSP(bf16_t, WS_RWBT), 6 * MT, 27 * 256, D, D}; RwOrder1 S{16, C.bid - 240, 1280, 27 * NPANEL, true}; EpiRw1 E{Rm, A3, karg<I_KK>(), WSP(float, WS_INVSQ)}; pg8::gemm_phase<EpiRw1, RwOrder1, false>(LDSG, g, S, E, nullptr); }
    else { pg8::Gemm g{A3, WSP(bf16_t, WS_LORA2T), 3 * MT, 40 * 256, 256, 256}; RwOrder2 S{C.G == 256 ? 240 : C.G, C.bid, nullptr, 0u}; EpiRw2 E{LD, LA, Gt, karg<I_W0>(), karg<I_A0>()}; pg8::gemm_phase<EpiRw2, RwOrder2, false>(LDSG, g, S, E, nullptr); }
}
template <int LAYER>
__device__ __forceinline__ void rwkv_layer(const Ctx& C, const XcdBarrier& bar, int lo, int hi, int b0) {
    bf16_t* X = WSP(bf16_t, WS_X); bf16_t* H = WSP(bf16_t, WS_H);
    bf16_t *XM = WSP(bf16_t, WS_ARENA + AR_XMIX), *LD = WSP(bf16_t, WS_ARENA + AR_LD), *LA = WSP(bf16_t, WS_ARENA + AR_LA), *Gt = WSP(bf16_t, WS_ARENA + AR_G), *RO = WSP(bf16_t, WS_ARENA + AR_RO);
    bf16_t *Rm = WSP(bf16_t, WS_ARENA + AR_R), *Km = WSP(bf16_t, WS_ARENA + AR_KK), *Vm = WSP(bf16_t, WS_ARENA + AR_VV), *A3 = WSP(bf16_t, WS_ARENA + AR_A3);
    bf16_t* YB = WSP(bf16_t, WS_ARENA + AR_YB);
    if (IN(b0)) { { phase_norm_mod_b(C, X, karg<I_N1G>() + LAYER * D, LAYER, 0, H, PREVP1(LAYER), X, 8192); } if (REPQ(b0)) { phase_norm_mod_b(C, X, karg<I_N1G>() + LAYER * D, LAYER, 0, H, PREVP1(LAYER), X, 8192); } }
    SEAM(b0);
    if (IN(b0 + 1)) { { phase_rw_mix(C, H, karg<I_MU>(), XM); } if (REPQ(b0 + 1)) { phase_rw_mix(C, H, karg<I_MU>(), XM); } }
    SEAM(b0 + 1);
    if (IN(b0 + 2)) { { pg8::Gemm g{XM, WSP(bf16_t, WS_RWBT), 6 * MT, 27 * 256, D, D}; RwOrder1 S{C.G, C.bid, 0, C.G == 256 ? 1280 : 27 * NPANEL, C.G == 256}; EpiRw1 E{Rm, A3, karg<I_KK>(), WSP(float, WS_INVSQ)}; pg8::gemm_phase<EpiRw1, RwOrder1, false>(LDSG, g, S, E, nullptr); } if (REPQ(b0 + 2)) { pg8::Gemm g{XM, WSP(bf16_t, WS_RWBT), 6 * MT, 27 * 256, D, D}; RwOrder1 S{C.G, C.bid, 0, C.G == 256 ? 1280 : 27 * NPANEL, C.G == 256}; EpiRw1 E{Rm, A3, karg<I_KK>(), WSP(float, WS_INVSQ)}; pg8::gemm_phase<EpiRw1, RwOrder1, false>(LDSG, g, S, E, nullptr); } }
    SEAM(b0 + 2);
    if (IN(b0 + 3)) { { rw_g2_phase(C, XM, Rm, A3, LD, LA, Gt); } if (REPQ(b0 + 3)) { rw_g2_phase(C, XM, Rm, A3, LD, LA, Gt); } }
    SEAM(b0 + 3);
    if (IN(b0 + 4)) { { phase_rw_scan(C, Rm, Km, Vm, LD, LA, karg<I_KK>(), karg<I_KA>(), WSP(float, WS_INVSQ), karg<I_ST>(), YB, C.out + OUT_ST); } if (REPQ(b0 + 4)) { phase_rw_scan(C, Rm, Km, Vm, LD, LA, karg<I_KK>(), karg<I_KA>(), WSP(float, WS_INVSQ), karg<I_ST>(), YB, C.out + OUT_ST); } }
    SEAM(b0 + 4);
    if (IN(b0 + 5)) { { phase_rw_post(C, YB, Rm, Km, Vm, LA, Gt, karg<I_KA>(), karg<I_RK>(), karg<I_LNW>(), karg<I_LNB>(), RO); } if (REPQ(b0 + 5)) { phase_rw_post(C, YB, Rm, Km, Vm, LA, Gt, karg<I_KA>(), karg<I_RK>(), karg<I_LNW>(), karg<I_LNB>(), RO); } }
    SEAM(b0 + 5);
    if (IN(b0 + 6)) { { EpiResidualB<false> E{X, MODP(LAYER, 0, 2), nullptr, nullptr}; run_gemm(C, RO, WSP(bf16_t, WS_RWOT), D, D, E); } if (REPQ(b0 + 6)) { EpiResidualB<false> E{X, MODP(LAYER, 0, 2), nullptr, nullptr}; run_gemm(C, RO, WSP(bf16_t, WS_RWOT), D, D, E); } }
    SEAM(b0 + 6);
    mlp_block<LAYER>(C, bar, lo, hi, b0 + 7);
}

__global__ void __launch_bounds__(512, 2) fwd_kernel(Params prm) {
    extern __shared__ __attribute__((aligned(16))) unsigned char lds_raw[];
    Ctx C;
    C.lds = (LAS unsigned char*)lds_raw;
    C.tid = threadIdx.x; C.lane = C.tid & 63; C.wave = __builtin_amdgcn_readfirstlane(C.tid >> 6); C.G = gridDim.x; C.bid = blockIdx.x;
    C.out = prm.out; C.ws = prm.ws;
    const int lo = prm.ph_lo, hi = prm.ph_hi;
    volatile LAS unsigned* xbw = (volatile LAS unsigned*)(C.lds + LDS_BAR_OFF);
    if (C.tid < 4) xbw[C.tid] = 0u;
    __syncthreads();
    XcdBarrier bar; bar.bar = (unsigned*)(C.ws + WS_CTL) + 1024; bar.x = 0; bar.st = xbw;
    if (hi - lo > 1) bar = xcd_barrier_post((unsigned*)(C.ws + WS_CTL) + 1024, xbw);

#ifdef MK_SKIP_FROM
    if (IN(0)) { for (size_t i = (size_t)C.bid * 512 + C.tid; i < (size_t)3 * 4194304; i += (size_t)C.G * 512) prm.out[OUT_NK + i] = 0.f; }
#endif
    if (IN(0)) { { phase_prologue(C); } if (REPQ(0)) { phase_prologue(C); } }
    SEAM(0);
    attn_layer<0, 0>(C, bar, lo, hi, 1);
    hyena_layer<1>(C, bar, lo, hi, 8);
    rwkv_layer<2>(C, bar, lo, hi, 17);
    attn_layer<3, 1>(C, bar, lo, hi, 27);
#ifndef MK_DBG_N
#define MK_DBG_N ((size_t)MT * D)
#endif
#ifndef MK_DBG_SCALE
#define MK_DBG_SCALE 1.0f
#endif
#ifdef MK_DBG_OFF
    if (IN(34)) { for (size_t i = (size_t)C.bid * 512 + C.tid; i < (size_t)MT * D; i += (size_t)C.G * 512) prm.out[OUT_Y + i] = i < (size_t)(MK_DBG_N) ? MK_DBG_SCALE * (MK_DBG_BF16 ? bf2f(WSP(bf16_t, MK_DBG_OFF)[i]) : WSP(float, MK_DBG_OFF)[i]) : 0.f; }
#else
    if (IN(34)) { { phase_norm_final_b(C, WSP(bf16_t, WS_X), karg<I_FNG>(), prm.out + OUT_Y, PREVP1(4), 8192); } if (REPQ(34)) { phase_norm_final_b(C, WSP(bf16_t, WS_X), karg<I_FNG>(), prm.out + OUT_Y, PREVP1(4), 8192); } }
#endif
}

#ifdef MK_SEP_CONV
__global__ void __launch_bounds__(512, 2) k_hyconv(Params prm) {
    extern __shared__ __attribute__((aligned(16))) unsigned char lds_raw3[];
    Ctx C; C.lds = (LAS unsigned char*)lds_raw3; C.tid = threadIdx.x; C.lane = C.tid & 63; C.wave = __builtin_amdgcn_readfirstlane(C.tid >> 6); C.G = gridDim.x; C.bid = blockIdx.x; C.out = prm.out; C.ws = prm.ws;
    bf16_t *ZT = WSP(bf16_t, WS_ARENA + AR_ZT), *YT = WSP(bf16_t, WS_ARENA + AR_YT);
    phase_hy_conv<1024, 8>(C, WSP(bf16_t, WS_FGS), ZT + (size_t)MP * D, YT + (size_t)MP * D); phase_hy_conv<256, 16>(C, WSP(bf16_t, WS_FGP), ZT, YT);
}
#endif
#ifdef MK_SEP_GATE
__global__ void __launch_bounds__(512, 2) k_hygate(Params prm) {
    extern __shared__ __attribute__((aligned(16))) unsigned char lds_raw2[];
    Ctx C; C.lds = (LAS unsigned char*)lds_raw2; C.tid = threadIdx.x; C.lane = C.tid & 63; C.wave = __builtin_amdgcn_readfirstlane(C.tid >> 6); C.G = gridDim.x; C.bid = blockIdx.x; C.out = prm.out; C.ws = prm.ws;
    bf16_t* ZT = WSP(bf16_t, WS_ARENA + AR_ZT);
    phase_hy_gate(C, WSP(bf16_t, WS_ARENA + AR_P), karg<I_HYCW>(), karg<I_HYCB>(), WSP(bf16_t, WS_ARENA + AR_X0), ZT, ZT + (size_t)MP * D);
}
#endif
#ifndef MK_PER_PHASE
#define MK_PER_PHASE 0
#endif
extern "C" void kernel_launch(void* const* d_in, const int* in_sizes, int n_in, void* d_out, int out_size, void* d_ws, size_t ws_size, hipStream_t stream) {
    static int grid = 0;
    if (grid == 0) {
        if (n_in != N_IN || ws_size < WS_END || out_size != 37748736) { fprintf(stderr, "kernel_launch: unexpected shapes (n_in %d, ws %zu, out %d); nothing launched\n", n_in, ws_size, out_size); grid = -1; return; }
        int dev = 0, cus = 0, per_cu = 0;
        if (hipGetDevice(&dev) != hipSuccess || hipDeviceGetAttribute(&cus, hipDeviceAttributeMultiprocessorCount, dev) != hipSuccess) { grid = -1; return; }
        if (hipFuncSetAttribute((const void*)fwd_kernel, hipFuncAttributeMaxDynamicSharedMemorySize, LDS_BYTES) != hipSuccess) { fprintf(stderr, "kernel_launch: hipFuncSetAttribute failed\n"); grid = -1; return; }
        if (hipOccupancyMaxActiveBlocksPerMultiprocessor(&per_cu, (const void*)fwd_kernel, 512, LDS_BYTES) != hipSuccess || per_cu < 1) { fprintf(stderr, "kernel_launch: occupancy query says %d\n", per_cu); }
        (void)hipGetLastError();
        grid = cus;
    }
    if (grid < 0) return;
    (void)hipMemsetAsync((char*)d_ws, 0, WS_ZERO_BYTES, stream);
    Params p{};
    for (int i = 0; i < N_IN; ++i) p.in[i] = (const float*)d_in[i];
    p.out = (float*)d_out; p.ws = (unsigned char*)d_ws;
#ifndef MK_LASTP
#define MK_LASTP NPH
#endif
#ifndef MK_FIRSTP
#define MK_FIRSTP 0
#endif
#if MK_PER_PHASE
    for (int k = MK_FIRSTP; k < MK_LASTP; ++k) {
#ifdef MK_SKIP_FROM
        if (k >= MK_SKIP_FROM && k < NPH - 1) continue;
#endif
#ifdef MK_SEP_CONV
        if (k == 11) { static bool a3 = false; if (!a3) { (void)hipFuncSetAttribute((const void*)k_hyconv, hipFuncAttributeMaxDynamicSharedMemorySize, 70000); a3 = true; } hipLaunchKernelGGL(k_hyconv, dim3(grid), dim3(512), 70000, stream, p); continue; }
#endif
#ifdef MK_SEP_GATE
        if (k == 10) { hipLaunchKernelGGL(k_hygate, dim3(grid), dim3(512), 16384, stream, p); continue; }
#endif
#ifdef MK_REPEAT_PH
        if (k == MK_REPEAT_PH) { p.ph_lo = k; p.ph_hi = k + 1; hipLaunchKernelGGL(fwd_kernel, dim3(grid), dim3(512), LDS_BYTES, stream, p); }
#endif
 p.ph_lo = k; p.ph_hi = k + 1; hipLaunchKernelGGL(fwd_kernel, dim3(grid), dim3(512), LDS_BYTES, stream, p); }
#else
    p.ph_lo = 0; p.ph_hi = NPH; hipLaunchKernelGGL(fwd_kernel, dim3(grid), dim3(512), LDS_BYTES, stream, p);
#endif
}
```

```cpp
#include <hip/hip_runtime.h>
#include <cstdio>
#include <cstdint>
namespace pg8 {
#define PG8_LAS __attribute__((address_space(3)))
typedef unsigned short bf16_t;
typedef short bf16x8 __attribute__((ext_vector_type(8)));
typedef float f32x4 __attribute__((ext_vector_type(4)));
typedef unsigned u32x4 __attribute__((ext_vector_type(4)));
constexpr int BM = 256, BK = 64, HALF = 128, HTB = HALF * BK * 2  , STAGE_BYTES = 8 * HTB, NXCD = 8, WGM = 4;

__host__ __device__ __forceinline__ int lds_byte(int r, int c) { const int st = (r >> 4) * 2 + (c >> 5), rr = r & 15, cc = c & 31, ob = rr * 64 + cc * 2; return st * 1024 + (ob ^ (((ob >> 9) & 1) << 5)); }
__host__ __device__ __forceinline__ void stage_rc(int b, int& R, int& C) { const int st = b / 1024, sb = b % 1024, swz = sb ^ (((sb >> 9) & 1) << 5); R = (st >> 1) * 16 + swz / 64; C = (st & 1) * 32 + (swz % 64) / 2; }
__host__ __device__ __forceinline__ int perm32(int rho) { const int n = rho >> 4, i = rho & 15; return 8 * (i >> 2) + 4 * n + (i & 3); }

struct Unit { int pm, pn, kh, mask; int nt = 0; };
struct Gemm { const bf16_t* A; const bf16_t* Bt; int M, N, K, KU; };

__host__ __device__ __forceinline__ bool tail_deal(int nwg, int G, int i, int c, int& L, int& mask) {
    const int full = nwg / G, rem = nwg - full * G;
    if (i < full) { L = i * G + c; mask = 15; return true; }
    if (i > full || rem == 0) return false;
    const int parts = (4 * rem <= G) ? 4 : ((2 * rem <= G) ? 2 : 1);
    if (c >= parts * rem) return false;
    L = full * G + c / parts; const int sub = c % parts;
    mask = parts == 1 ? 15 : (parts == 2 ? (sub ? 0xA : 0x5) : (1 << sub));
    return true;
}
struct StaticOrder {
    int nM, nN, nwg, G, c;
    __host__ __device__ void init(int M, int N, int G_, int c_) { nM = M / BM; nN = N / BM; nwg = nM * nN; G = G_; c = c_; }
    __host__ __device__ bool next(int i, Unit& u) const { const long L = (long)i * G + c; if (L >= nwg) return false; map((int)L, u); u.kh = 0; u.mask = 15; return true; }
    __host__ __device__ bool map(int L, Unit& u) const {
        int wgid = (int)L; { const int q = nwg / NXCD, r = nwg % NXCD, xcd = wgid % NXCD, off = wgid / NXCD; wgid = (xcd < r ? xcd * (q + 1) : r * (q + 1) + (xcd - r) * q) + off; }
        const int nig = WGM * nN, gid = wgid / nig, fm = gid * WGM, gsz = (nM - fm) < WGM ? (nM - fm) : WGM;
        u.pm = fm + ((wgid % nig) % gsz); u.pn = (wgid % nig) / gsz; return true;
    }
    __device__ __forceinline__ void a_ready(const Unit&) const {}
    __device__ __forceinline__ void done(const Unit&) const {}
};

template <class Epi, class Sched, bool STAMP = false>
__device__ __forceinline__ void gemm_phase(PG8_LAS unsigned char* lds, const Gemm g, const Sched& S, const Epi& E, unsigned long long* stamps) {
    const int tid = threadIdx.x, wid = __builtin_amdgcn_readfirstlane(tid >> 6), lane = tid & 63, wr = wid >> 2, wc = wid & 3, fr = lane & 15, fq = lane >> 4;
    const int K = g.K, nt = g.KU / BK;
    int ts_lo = 0, ts_hi = 0, nts = 0; const unsigned long long rt_entry = STAMP ? (unsigned long long)wall_clock64() : 0ull;
#define PG8_STAMP() do { if (STAMP && wid == 0 && nts < 64) { const unsigned long long _c = (unsigned long long)clock64(); \
        ts_lo = (lane == nts) ? (int)(unsigned)_c : ts_lo; ts_hi = (lane == nts) ? (int)(unsigned)(_c >> 32) : ts_hi; ++nts; } } while (0)
    PG8_STAMP();
    unsigned voffA[2], voffB[2];
#pragma unroll
    for (int i = 0; i < 2; ++i) { int R, C; stage_rc(tid * 16 + i * 8192, R, C); const int Rb = Epi::PERM ? ((R & ~31) + perm32(R & 31)) : R;
        voffA[i] = (unsigned)(R * K + C) * 2u; voffB[i] = (unsigned)(Rb * K + C) * 2u; }
    const size_t kstep = (size_t)(BK * 2);
    const size_t hstep = (size_t)HALF * K * 2;
    const size_t tstep = 2 * hstep;
    const unsigned ldsw = (unsigned)wid * 1024u;
    const int aoff = lds_byte(wr * 64 + fr, fq * 8), boff = lds_byte(wc * 32 + fr, fq * 8);
#define PG8_SA(b, h) (((b) * 2 + (h)) * HTB)
#define PG8_SB(b, h) ((4 + (b) * 2 + (h)) * HTB)
#define PG8_STAGE(bufoff, gbase, voff) do { _Pragma("unroll") for (int _i = 0; _i < 2; ++_i) \
        __builtin_amdgcn_global_load_lds((const unsigned*)((const char*)(gbase) + (voff)[_i]), (PG8_LAS unsigned*)(lds + (bufoff) + ldsw + _i * 8192), 16, 0, 0); } while (0)
#define PG8_LDA(dst, b, h) do { _Pragma("unroll") for (int m = 0; m < 4; ++m) _Pragma("unroll") for (int k = 0; k < 2; ++k) dst[m][k] = *(const PG8_LAS bf16x8*)(lds + PG8_SA(b, h) + aoff + m * 2048 + k * 1024); } while (0)
#define PG8_LDB(dst, b, h) do { _Pragma("unroll") for (int n = 0; n < 2; ++n) _Pragma("unroll") for (int k = 0; k < 2; ++k) dst[n][k] = *(const PG8_LAS bf16x8*)(lds + PG8_SB(b, h) + boff + n * 2048 + k * 1024); } while (0)
#define PG8_MMA(ai, bj, At, Bt) do { __builtin_amdgcn_s_setprio(1); _Pragma("unroll") for (int k = 0; k < 2; ++k) _Pragma("unroll") for (int m = 0; m < 4; ++m) _Pragma("unroll") for (int n = 0; n < 2; ++n) \
        asm volatile("v_mfma_f32_16x16x32_bf16 %0, %1, %2, %0" : "+v"(acc[ai][bj][m][n]) : "v"(Bt[n][k]), "v"(At[m][k])); __builtin_amdgcn_s_setprio(0); } while (0)
#define PG8_ACC_FENCE1(ai, bj) asm volatile("s_nop 15\n\ts_nop 15" : "+v"(acc[ai][bj][0][0]), "+v"(acc[ai][bj][0][1]), "+v"(acc[ai][bj][1][0]), "+v"(acc[ai][bj][1][1]), "+v"(acc[ai][bj][2][0]), "+v"(acc[ai][bj][2][1]), "+v"(acc[ai][bj][3][0]), "+v"(acc[ai][bj][3][1]))
#define PG8_ACC_FENCE() do { PG8_ACC_FENCE1(0, 0); PG8_ACC_FENCE1(0, 1); PG8_ACC_FENCE1(1, 0); PG8_ACC_FENCE1(1, 1); } while (0)
#define PG8_WAIT_V(n) asm volatile("s_waitcnt vmcnt(" #n ")" ::: "memory")
#define PG8_WAIT_L(n) asm volatile("s_waitcnt lgkmcnt(" #n ")" ::: "memory")
#define PG8_BAR __builtin_amdgcn_s_barrier()
#define PG8_SCHED __builtin_amdgcn_sched_barrier(0)
    Unit cur, nxt; int ui = 0;
    if (!S.next(0, cur)) return;
    f32x4 acc[2][2][4][2];
#pragma unroll
    for (int a = 0; a < 2; ++a)
#pragma unroll
        for (int b = 0; b < 2; ++b)
#pragma unroll
            for (int m = 0; m < 4; ++m)
#pragma unroll
                for (int n = 0; n < 2; ++n) acc[a][b][m][n] = (f32x4){0.f, 0.f, 0.f, 0.f};
    bf16x8 At[4][2], B0[2][2], B1[2][2];
    const size_t kslice = (size_t)g.KU * 2;
    const char* cA = (const char*)g.A + (size_t)cur.pm * tstep + cur.kh * kslice; const char* cB = (const char*)g.Bt + (size_t)cur.pn * tstep + cur.kh * kslice;
    S.a_ready(cur);
    PG8_STAGE(PG8_SB(0, 0), cB, voffB); PG8_STAGE(PG8_SA(0, 0), cA, voffA); PG8_STAGE(PG8_SB(0, 1), cB + hstep, voffB); PG8_STAGE(PG8_SA(0, 1), cA + hstep, voffA);
    if (wr == 1) PG8_BAR;
    PG8_WAIT_V(4); PG8_BAR;
    PG8_STAGE(PG8_SB(1, 0), cB + kstep, voffB); PG8_STAGE(PG8_SA(1, 0), cA + kstep, voffA); PG8_STAGE(PG8_SB(1, 1), cB + hstep + kstep, voffB);
    PG8_WAIT_V(6); PG8_BAR;
    PG8_STAMP();
    for (;;) {
        const bool has_next = S.next(ui + 1, nxt);
        const char* nA = has_next ? (const char*)g.A + (size_t)nxt.pm * tstep + nxt.kh * kslice : cA; const char* nB = has_next ? (const char*)g.Bt + (size_t)nxt.pn * tstep + nxt.kh * kslice : cB;
        const int unt = cur.nt ? cur.nt : nt;
        const bool pre = ui > 0;
        for (int t = 0; t < unt; t += 2) {
            const bool last = (t == unt - 2);
            const char* a1 = cA + (size_t)(t + 1) * kstep;
            const char* a2 = last ? nA : cA + (size_t)(t + 2) * kstep; const char* b2 = last ? nB : cB + (size_t)(t + 2) * kstep;
            const char* a3 = a2 + kstep; const char* b3 = b2 + kstep;
            if (last && has_next) S.a_ready(nxt);
            PG8_LDB(B0, 0, 0); PG8_SCHED; PG8_LDA(At, 0, 0); if (!(pre && t == 0)) PG8_STAGE(PG8_SA(1, 1), a1 + hstep, voffA);
            PG8_WAIT_L(8); PG8_BAR; PG8_WAIT_L(0); PG8_MMA(0, 0, At, B0); PG8_BAR; PG8_SCHED;
            PG8_LDB(B1, 0, 1); PG8_STAGE(PG8_SB(0, 0), b2, voffB);
            PG8_BAR; PG8_WAIT_L(0); PG8_MMA(0, 1, At, B1); PG8_BAR;
            PG8_LDA(At, 0, 1); PG8_STAGE(PG8_SA(0, 0), a2, voffA);
            PG8_BAR; PG8_WAIT_L(0); PG8_MMA(1, 0, At, B0); PG8_BAR; PG8_SCHED;
            PG8_STAGE(PG8_SB(0, 1), b2 + hstep, voffB);
            if (pre && t == 0) PG8_WAIT_V(22); else PG8_WAIT_V(6);
            PG8_BAR; PG8_MMA(1, 1, At, B1); PG8_BAR;
            PG8_LDB(B0, 1, 0); PG8_SCHED; PG8_LDA(At, 1, 0); PG8_STAGE(PG8_SA(0, 1), a2 + hstep, voffA);
            PG8_WAIT_L(8); PG8_BAR; PG8_WAIT_L(0); PG8_MMA(0, 0, At, B0); PG8_BAR; PG8_SCHED;
            PG8_LDB(B1, 1, 1); PG8_STAGE(PG8_SB(1, 0), b3, voffB);
            PG8_BAR; PG8_WAIT_L(0); PG8_MMA(0, 1, At, B1); PG8_BAR;
            PG8_LDA(At, 1, 1); PG8_STAGE(PG8_SA(1, 0), a3, voffA);
            PG8_BAR; PG8_WAIT_L(0); PG8_MMA(1, 0, At, B0); PG8_BAR; PG8_SCHED;
            PG8_STAGE(PG8_SB(1, 1), b3 + hstep, voffB);
            PG8_WAIT_V(6); PG8_BAR; PG8_MMA(1, 1, At, B1); PG8_BAR;
        }
        PG8_STAMP();
        if (has_next) { PG8_STAGE(PG8_SA(1, 1), nA + kstep + hstep, voffA); }
        asm volatile("" ::: "memory"); PG8_SCHED;
        PG8_ACC_FENCE();
        if constexpr (!Epi::AFTER_DRAIN) { E(acc, cur, wr, wc, fr, fq); S.done(cur); }
        PG8_STAMP();
        if (!has_next) break;
#pragma unroll
        for (int a = 0; a < 2; ++a)
#pragma unroll
            for (int b = 0; b < 2; ++b)
#pragma unroll
                for (int m = 0; m < 4; ++m)
#pragma unroll
                    for (int n = 0; n < 2; ++n) acc[a][b][m][n] = (f32x4){0.f, 0.f, 0.f, 0.f};
        cur = nxt; cA = nA; cB = nB; ++ui;
    }
    PG8_WAIT_V(0);
    if (wr == 0) PG8_BAR;
    PG8_BAR;
    if constexpr (Epi::AFTER_DRAIN) { E.fused(acc, cur, wr, wc, fr, fq, lds, wid, lane); S.done(cur); }
    PG8_STAMP();
    if (STAMP && wid == 0) { stamps[lane] = lane < nts ? (((unsigned long long)(unsigned)ts_hi << 32) | (unsigned)ts_lo) : 0ull;
        if (lane == 62) stamps[62] = rt_entry; if (lane == 63) stamps[63] = (unsigned long long)wall_clock64(); }
#undef PG8_STAMP
#undef PG8_SA
#undef PG8_SB
#undef PG8_STAGE
#undef PG8_LDA
#undef PG8_LDB
#undef PG8_MMA
#undef PG8_ACC_FENCE
#undef PG8_ACC_FENCE1
#undef PG8_WAIT_V
#undef PG8_WAIT_L
#undef PG8_BAR
#undef PG8_SCHED
}
}

#define XB_TMO      128
#define XB_XCNT(j)  (256  + 64 * (j))
#define XB_XSUB(j)  (1280 + 64 * (j))
#define XB_XGEN(j)  (2304 + 64 * (j))
#define XB_TOP      3328
#define XB_TOPGEN   3392
#define XCD_BAR_WORDS 3456
#define XB_SPIN_CAP (1u << 20)
#define LAS __attribute__((address_space(3)))

__device__ __forceinline__ unsigned xb_ld(unsigned* p)              { return __hip_atomic_load(p, __ATOMIC_RELAXED, __HIP_MEMORY_SCOPE_AGENT); }
__device__ __forceinline__ unsigned xb_add(unsigned* p, unsigned v) { return __hip_atomic_fetch_add(p, v, __ATOMIC_RELAXED, __HIP_MEMORY_SCOPE_AGENT); }
__device__ __forceinline__ unsigned xb_xcc_id() { return (unsigned)__builtin_amdgcn_s_getreg((3 << 11) | 20) & 0xFu; }
#define XB_SPIN(cond, bar) do { unsigned _sp = 0; while (cond) { __builtin_amdgcn_s_sleep(1); \
    if ((++_sp & 255u) == 0u) { if (xb_ld(&(bar)[XB_TMO])) break; if (_sp > XB_SPIN_CAP) { atomicAdd(&(bar)[XB_TMO], 1u); break; } } } } while (0)

struct XcdBarrier {
    unsigned* bar; unsigned x;
    volatile LAS unsigned* st;
};

__device__ __forceinline__ XcdBarrier xcd_barrier_post(unsigned* bar, volatile LAS unsigned* st) {
    XcdBarrier b; b.bar = bar; b.x = xb_xcc_id(); b.st = st;
    if (threadIdx.x == 0) (void)xb_add(&bar[XB_XCNT(b.x)], 1u);
    return b;
}
__device__ __forceinline__ void xcd_barrier_complete(unsigned* bar, unsigned x, unsigned& nloc, unsigned& nx) {
    const unsigned G = gridDim.x * gridDim.y * gridDim.z;
    unsigned sum, cnt, mine, sp = 0u;
    for (;;) {
        sum = 0u; cnt = 0u; mine = 0u;
#pragma unroll
        for (unsigned j = 0; j < 16; ++j) { const unsigned c = xb_ld(&bar[XB_XCNT(j)]); sum += c; cnt += (c > 0u) ? 1u : 0u; mine = (j == x) ? c : mine; }
        if (sum == G) break;
        __builtin_amdgcn_s_sleep(1);
        if ((++sp & 255u) == 0u) { if (xb_ld(&bar[XB_TMO])) break; if (sp > XB_SPIN_CAP) { atomicAdd(&bar[XB_TMO], 1u); break; } }
    }
    nloc = mine > 0u ? mine : 1u; nx = cnt > 0u ? cnt : 1u;
}

__device__ __forceinline__ void xcd_barrier(const XcdBarrier& b) {
    asm volatile("s_waitcnt vmcnt(0)" ::: "memory");
    __syncthreads();
    if (threadIdx.x == 0) {
        unsigned* bar = b.bar;
        __builtin_amdgcn_s_waitcnt(0);
        unsigned nloc = b.st[0], nx = b.st[1];
        if (nloc == 0u) { xcd_barrier_complete(bar, b.x, nloc, nx); b.st[0] = nloc; b.st[1] = nx; }
        const unsigned old = xb_add(&bar[XB_XSUB(b.x)], 1u);
        const unsigned gen = old / nloc;
        if (old + 1u == (gen + 1u) * nloc) {
            __builtin_amdgcn_fence(__ATOMIC_RELEASE, "agent");
            asm volatile("s_waitcnt vmcnt(0)" ::: "memory");
            const unsigned og = xb_add(&bar[XB_TOP], 1u);
            const unsigned tg = og / nx;
            if (og + 1u == (tg + 1u) * nx) xb_add(&bar[XB_TOPGEN], 1u);
            else XB_SPIN(xb_ld(&bar[XB_TOPGEN]) == tg, bar);
            __builtin_amdgcn_fence(__ATOMIC_ACQUIRE, "agent");
            xb_add(&bar[XB_XGEN(b.x)], 1u);
            asm volatile("s_waitcnt vmcnt(0)" ::: "memory");
        } else {
            XB_SPIN(xb_ld(&bar[XB_XGEN(b.x)]) == gen, bar);
            __builtin_amdgcn_fence(__ATOMIC_ACQUIRE, "agent");
            asm volatile("s_waitcnt vmcnt(0)" ::: "memory");
        }
    }
    __syncthreads();
}

typedef unsigned short bf16_t;
typedef short bf16x8 __attribute__((ext_vector_type(8)));
typedef short bf16x4 __attribute__((ext_vector_type(4)));
typedef float f32x2 __attribute__((ext_vector_type(2)));
typedef float f32x4 __attribute__((ext_vector_type(4)));
typedef float f32x16 __attribute__((ext_vector_type(16)));
typedef unsigned u32x4 __attribute__((ext_vector_type(4)));
typedef unsigned u32x2 __attribute__((ext_vector_type(2)));

constexpr int D = 2048, FF = 8192, MP = 4096, MS = 8192, MT = 12288;
constexpr int NPANEL = MT / 256;
constexpr size_t MiB = 1u << 20;
constexpr size_t WS_CTL = 0, WS_MOD = 1 * MiB, WS_ZERO_BYTES = 3 * MiB;
constexpr size_t WS_ROPE = 3 * MiB;
constexpr size_t WS_W1T = 4 * MiB, WS_W2T = 132 * MiB, WS_WQKVT = 260 * MiB, WS_WOT = 284 * MiB, WS_HYINT = 300 * MiB, WS_HYOUTT = 324 * MiB;
constexpr size_t WS_RWBT = 332 * MiB, WS_LORA2T = 359 * MiB, WS_RWOT = 364 * MiB, WS_KC = 372 * MiB, WS_VC = 380 * MiB, WS_FGS = 388 * MiB, WS_FGP = 397 * MiB;
constexpr size_t WS_X = 400 * MiB, WS_H = 496 * MiB, WS_ARENA = 544 * MiB, WS_INVSQ = 1186 * MiB, WS_END = 1188 * MiB;
constexpr size_t AR_U = 0;
constexpr size_t AR_Q = 0, AR_K = 48 * MiB, AR_V = 60 * MiB, AR_O = 72 * MiB;
constexpr size_t AR_P = 0, AR_X0 = 144 * MiB, AR_ZT = 192 * MiB, AR_YT = 240 * MiB, AR_HO = 288 * MiB;
constexpr size_t AR_XMIX = 0, AR_LD = 546 * MiB  , AR_LA = 96 * MiB, AR_G = 192 * MiB, AR_RO = 240 * MiB, AR_R = 288 * MiB, AR_KK = 336 * MiB, AR_VV = 384 * MiB, AR_A3 = 432 * MiB, AR_YB = 450 * MiB;
constexpr size_t OUT_Y = 0, OUT_NK = 25165824, OUT_NV = 29360128, OUT_ST = 33554432;
constexpr int FGS_ROW = 2112, FGP_ROW = 576;
constexpr size_t AR_FILT = 600 * MiB;
constexpr int LDS_BAR_OFF = 147456, LDS_BYTES = 147456 + 1024;

enum { I_XP = 0, I_XS, I_CK, I_CV, I_ST, I_C, I_CCTX, I_ADAW, I_ADAB, I_N1G, I_N2G, I_MW1, I_MW2, I_WQKV, I_WO, I_SINK, I_HYWIN, I_HYCW, I_HYCB, I_FW1, I_FB1, I_FW2, I_FB2, I_FW3, I_FB3,
       I_FREQ, I_FWOUT, I_HYBIAS, I_HYWOUT, I_MU, I_WR, I_WK, I_WV, I_RWO, I_W0, I_W1, I_W2, I_A0, I_A1, I_A2, I_G1, I_G2, I_KK, I_KA, I_RK, I_LNW, I_LNB, I_FNG, N_IN };

struct Params { const float* in[N_IN]; float* out; unsigned char* ws; int ph_lo, ph_hi; };

__device__ __forceinline__ unsigned cvt_pk(float lo, float hi) { unsigned r; asm("v_cvt_pk_bf16_f32 %0, %1, %2" : "=v"(r) : "v"(lo), "v"(hi)); return r; }
__device__ __forceinline__ float bflo(unsigned w) { return __uint_as_float(w << 16); }
__device__ __forceinline__ float bfhi(unsigned w) { return __uint_as_float(w & 0xffff0000u); }
__device__ __forceinline__ float bf2f(bf16_t b) { return __uint_as_float(((unsigned)b) << 16); }
__device__ __forceinline__ float dpp_f(float x, const int ctrl) { return x; }
#define DPP_ADD(x, ctrl) ((x) + __int_as_float(__builtin_amdgcn_update_dpp(0, __float_as_int(x), (ctrl), 0xF, 0xF, true)))
__device__ __forceinline__ float wave_sum(float v) {
    v = DPP_ADD(v, 0xB1); v = DPP_ADD(v, 0x4E); v = DPP_ADD(v, 0x141); v = DPP_ADD(v, 0x140);
    const int vi = __float_as_int(v);
    const float r0 = __int_as_float(__builtin_amdgcn_readlane(vi, 0)), r1 = __int_as_float(__builtin_amdgcn_readlane(vi, 16)),
                r2 = __int_as_float(__builtin_amdgcn_readlane(vi, 32)), r3 = __int_as_float(__builtin_amdgcn_readlane(vi, 48));
    return (r0 + r1) + (r2 + r3);
}
__device__ __forceinline__ float opaque_zero() { float z; asm volatile("v_mov_b32 %0, 0" : "=v"(z)); return z; }
__device__ __forceinline__ float fexp2(float x) { return __builtin_amdgcn_exp2f(x); }
__device__ __forceinline__ float fexp(float x) { return __builtin_amdgcn_exp2f(x * 1.4426950408889634f); }
__device__ __forceinline__ float flog(float x) { return __builtin_amdgcn_logf(x) * 0.6931471805599453f; }
__device__ __forceinline__ float frcp(float x) { return __builtin_amdgcn_rcpf(x); }
__device__ __forceinline__ float fsigmoid(float x) { return frcp(1.0f + fexp(-x)); }
__device__ __forceinline__ float ftanh(float x) { const float e = fexp(2.0f * x); return 1.0f - 2.0f * frcp(e + 1.0f); }
__device__ __forceinline__ float fsoftplus(float x) { return fmaxf(x, 0.0f) + flog(1.0f + fexp(-fabsf(x))); }
__device__ __forceinline__ float fsin_rev(float rev) { return __builtin_amdgcn_sinf(rev - rintf(rev)); }
__device__ __forceinline__ float fcos_rev(float rev) { return __builtin_amdgcn_cosf(rev - rintf(rev)); }
__device__ __forceinline__ float fsin(float x) { return fsin_rev(x * 0.15915494309189535f); }
__device__ __forceinline__ int cond_of_row(int m) { return m < MP ? 0 : 1 + ((m - MP) >> 10); }
__device__ __forceinline__ int cond_of_panel(int pm) { return pm < 16 ? 0 : 1 + ((pm - 16) >> 2); }

struct Ctx {
    LAS unsigned char* lds;
    int tid, lane, wave, G, bid;
    float* out;
    unsigned char* ws;
};
template <int IDX> __device__ __forceinline__ const float* karg() {
    unsigned long long v;
    asm volatile("s_load_dwordx2 %0, %1, %2\n\ts_waitcnt lgkmcnt(0)" : "=s"(v) : "s"(__builtin_amdgcn_kernarg_segment_ptr()), "n"(IDX * 8));
    return (const float*)v;
}
#define WSP(T, off) ((T*)(C.ws + (off)))
#define MODP(l, cond, which) (WSP(float, WS_MOD) + ((size_t)((l) * 9 + (cond)) * 6 + (which)) * D)

__device__ __forceinline__ void p0_transpose_item(const float* W, int K, int N, bf16_t* WT, LAS float* scr, int item, int lane) {
    const int nblk = N / 32, kb = item / nblk, nb = item % nblk, k0 = 64 * kb, n0 = 32 * nb;
    const int rsub = lane >> 3, c4 = (lane & 7) * 4;
    f32x4 v[8];
#pragma unroll
    for (int i = 0; i < 8; ++i) v[i] = *(const f32x4*)(W + (size_t)(k0 + 8 * i + rsub) * N + n0 + c4);
#pragma unroll
    for (int i = 0; i < 8; ++i) { LAS float* d = scr + (8 * i + rsub) * 33 + c4; d[0] = v[i].x; d[1] = v[i].y; d[2] = v[i].z; d[3] = v[i].w; }
    asm volatile("s_waitcnt lgkmcnt(0)" ::: "memory");
    const int c = lane & 7;
#pragma unroll
    for (int j = 0; j < 4; ++j) { const int n = (lane >> 3) + 8 * j; const LAS float* s = scr + (8 * c) * 33 + n;
        u32x4 o; o.x = cvt_pk(s[0 * 33], s[1 * 33]); o.y = cvt_pk(s[2 * 33], s[3 * 33]); o.z = cvt_pk(s[4 * 33], s[5 * 33]); o.w = cvt_pk(s[6 * 33], s[7 * 33]);
        *(u32x4*)(WT + (size_t)(n0 + n) * K + k0 + 8 * c) = o; }
    asm volatile("s_waitcnt lgkmcnt(0)" ::: "memory");
}

__device__ __forceinline__ void late_transposes(const Ctx& C, LAS float* scr, int wv, int nwv) {
    constexpr int I_M = 8192, I_QKV = 3072, I_O = 2048;
    constexpr int NIT = 4 * I_M + I_QKV + I_O;
    for (int it = wv; it < NIT; it += nwv) {
        int r = it;
        if (r < 2 * I_M) { const int l = 2 + r / I_M; p0_transpose_item(karg<I_MW1>() + (size_t)l * D * FF, D, FF, WSP(bf16_t, WS_W1T) + (size_t)l * D * FF, scr, r % I_M, C.lane); continue; } r -= 2 * I_M;
        if (r < 2 * I_M) { const int l = 2 + r / I_M; p0_transpose_item(karg<I_MW2>() + (size_t)l * D * FF, FF, D, WSP(bf16_t, WS_W2T) + (size_t)l * D * FF, scr, r % I_M, C.lane); continue; } r -= 2 * I_M;
        if (r < I_QKV) { p0_transpose_item(karg<I_WQKV>() + (size_t)D * 3072, D, 3072, WSP(bf16_t, WS_WQKVT) + (size_t)D * 3072, scr, r, C.lane); continue; } r -= I_QKV;
        p0_transpose_item(karg<I_WO>() + (size_t)D * D, D, D, WSP(bf16_t, WS_WOT) + (size_t)D * D, scr, r, C.lane);
    }
}
#ifndef MK_PRO_MASK
#define MK_PRO_MASK 127
#endif
__device__ __forceinline__ void phase_prologue(const Ctx& C) {
    const int gw = C.bid * 8 + C.wave, NGW = C.G * 8, lane = C.lane;
    const size_t gt = (size_t)C.bid * 512 + C.tid, NGT = (size_t)C.G * 512;
    LAS float* scr = (LAS float*)(C.lds + C.wave * 16384);
    if (MK_PRO_MASK & 1)
    {
        constexpr int I_M1 = 8192, I_M2 = 8192, I_QKV = 3072, I_O = 2048, I_HI = 6144, I_SQ = 2048;
        constexpr int NIT = 2 * I_M1 + 2 * I_M2 + I_QKV + I_O + I_HI + I_SQ + 4 * I_SQ;
        for (int it = gw; it < NIT; it += NGW) {
            int r = it;
            if (r < 2 * I_M1) { const int l = r / I_M1; p0_transpose_item(karg<I_MW1>() + (size_t)l * D * FF, D, FF, WSP(bf16_t, WS_W1T) + (size_t)l * D * FF, scr, r % I_M1, lane); continue; } r -= 2 * I_M1;
            if (r < 2 * I_M2) { const int l = r / I_M2; p0_transpose_item(karg<I_MW2>() + (size_t)l * D * FF, FF, D, WSP(bf16_t, WS_W2T) + (size_t)l * D * FF, scr, r % I_M2, lane); continue; } r -= 2 * I_M2;
            if (r < I_QKV) { p0_transpose_item(karg<I_WQKV>(), D, 3072, WSP(bf16_t, WS_WQKVT), scr, r, lane); continue; } r -= I_QKV;
            if (r < I_O) { p0_transpose_item(karg<I_WO>(), D, D, WSP(bf16_t, WS_WOT), scr, r, lane); continue; } r -= I_O;
            if (r < I_HI) { p0_transpose_item(karg<I_HYWIN>(), D, 6144, WSP(bf16_t, WS_HYINT), scr, r, lane); continue; } r -= I_HI;
            if (r < I_SQ) { p0_transpose_item(karg<I_HYWOUT>(), D, D, WSP(bf16_t, WS_HYOUTT), scr, r, lane); continue; } r -= I_SQ;
            if (r < I_SQ) { p0_transpose_item(karg<I_WR>(), D, D, WSP(bf16_t, WS_RWBT), scr, r, lane); continue; } r -= I_SQ;
            if (r < I_SQ) { p0_transpose_item(karg<I_WK>(), D, D, WSP(bf16_t, WS_RWBT) + (size_t)D * D, scr, r, lane); continue; } r -= I_SQ;
            if (r < I_SQ) { p0_transpose_item(karg<I_WV>(), D, D, WSP(bf16_t, WS_RWBT) + (size_t)2 * D * D, scr, r, lane); continue; } r -= I_SQ;
            p0_transpose_item(karg<I_RWO>(), D, D, WSP(bf16_t, WS_RWOT), scr, r, lane);
        }
    }
    if (MK_PRO_MASK & 2)
    {
        bf16_t* L1 = WSP(bf16_t, WS_RWBT) + (size_t)3 * D * D;
#pragma unroll
        for (int part = 0; part < 7; ++part) {
            const int row0 = part == 0 ? 0 : part == 1 ? 96 : part == 2 ? 192 : part == 3 ? 256 : part == 4 ? 352 : part == 5 ? 448 : 512;
            const int nrow = (part == 2 || part == 5) ? 64 : (part == 6 ? 256 : 96);
            const int ld = part == 6 ? 256 : 96;
            const float* src = part == 0 ? karg<I_W1>() : part == 1 ? karg<I_W1>() + (size_t)D * 96 : part == 3 ? karg<I_A1>() : part == 4 ? karg<I_A1>() + (size_t)D * 96 : karg<I_G1>();
            const bool zero = (part == 2 || part == 5);
            for (size_t i = gt; i < (size_t)nrow * 256; i += NGT) {
                const int rr = (int)(i / 256), k8 = (int)(i % 256);
                float v[8];
#pragma unroll
                for (int j = 0; j < 8; ++j) v[j] = zero ? 0.0f : src[(size_t)(8 * k8 + j) * ld + rr];
                u32x4 o; o.x = cvt_pk(v[0], v[1]); o.y = cvt_pk(v[2], v[3]); o.z = cvt_pk(v[4], v[5]); o.w = cvt_pk(v[6], v[7]);
                *(u32x4*)(L1 + (size_t)(row0 + rr) * D + 8 * k8) = o;
            }
        }
        bf16_t* L2 = WSP(bf16_t, WS_LORA2T);
#pragma unroll
        for (int mat = 0; mat < 5; ++mat) {
            const float* src = mat == 0 ? karg<I_W2>() : mat == 1 ? karg<I_W2>() + (size_t)96 * D : mat == 2 ? karg<I_A2>() : mat == 3 ? karg<I_A2>() + (size_t)96 * D : karg<I_G2>();
            const int kofs = (mat == 1 || mat == 3) ? 96 : 0, klen = mat == 4 ? 256 : 96;
            for (size_t i = gt; i < (size_t)2048 * 32; i += NGT) {
                const int n = (int)(i / 32), k8 = (int)(i % 32);
                float v[8];
#pragma unroll
                for (int j = 0; j < 8; ++j) { const int k = 8 * k8 + j - kofs; const int kc = k < 0 ? 0 : (k >= klen ? klen - 1 : k); const float x = src[(size_t)kc * D + n]; v[j] = (k >= 0 && k < klen) ? x : 0.0f; }
                u32x4 o; o.x = cvt_pk(v[0], v[1]); o.y = cvt_pk(v[2], v[3]); o.z = cvt_pk(v[4], v[5]); o.w = cvt_pk(v[6], v[7]);
                *(u32x4*)(L2 + ((size_t)mat * 2048 + n) * 256 + 8 * k8) = o;
            }
        }
    }
    if (MK_PRO_MASK & 4)
    for (size_t i = gt; i < 2048; i += NGT) {
        const int pos = (int)(i >> 5), fi = (int)(i & 31);
        const float inv = fexp2(-(float)(2 * fi) * (13.287712379549449f / 64.0f));
        const float rev = (float)pos * inv * 0.15915494309189535f;
        WSP(f32x2, WS_ROPE)[i] = (f32x2){fcos_rev(rev), fsin_rev(rev)};
    }
    for (size_t i = gt; i < (size_t)MT * 32 / 4; i += NGT) WSP(f32x4, WS_INVSQ)[i] = (f32x4){0.f, 0.f, 0.f, 0.f};
    if (MK_PRO_MASK & 8)
    { const float *ckp = karg<I_CK>(), *cvp = karg<I_CV>();
    for (size_t i = gt; i < (size_t)2 * 524288; i += NGT) {
        const bool isv = i >= 524288; const size_t e = (isv ? i - 524288 : i) * 8;
        const float* src = (isv ? cvp : ckp) + e;
        const f32x4 a = *(const f32x4*)src, b = *(const f32x4*)(src + 4);
        u32x4 o; o.x = cvt_pk(a.x, a.y); o.y = cvt_pk(a.z, a.w); o.z = cvt_pk(b.x, b.y); o.w = cvt_pk(b.z, b.w);
        *(u32x4*)(WSP(bf16_t, isv ? WS_VC : WS_KC) + e) = o;
    } }
    if (MK_PRO_MASK & 32)
    {
        __syncthreads();
        LAS float* tab = (LAS float*)C.lds;
        LAS float* red = (LAS float*)(C.lds + 73728);
        const float *cctx = karg<I_CCTX>(), *cc = karg<I_C>();
        for (int e = C.tid; e < 9 * D; e += 512) { const int j = e >> 11, k = e & (D - 1);
            const float cv = j == 0 ? cctx[k] : cc[(size_t)(j == 0 ? 0 : j - 1) * D + k]; tab[e] = cv * fsigmoid(cv); }
        __syncthreads();
        const float* adaw = karg<I_ADAW>(); const float* adab = karg<I_ADAB>();
        for (int it = C.bid; it < 4 * 192; it += C.G) {
            const int nb = it % 192, l = it / 192, w = C.wave;
            float acc[9];
#pragma unroll
            for (int j = 0; j < 9; ++j) acc[j] = 0.f;
            const float* wp = adaw + ((size_t)l * D + 256 * w) * (6 * D) + nb * 64 + lane;
#pragma unroll 4
            for (int k4 = 0; k4 < 256; k4 += 4) {
                const float w0 = wp[(size_t)(k4 + 0) * (6 * D)], w1 = wp[(size_t)(k4 + 1) * (6 * D)], w2 = wp[(size_t)(k4 + 2) * (6 * D)], w3 = wp[(size_t)(k4 + 3) * (6 * D)];
#pragma unroll
                for (int j = 0; j < 9; ++j) { const f32x4 sv = *(const LAS f32x4*)(tab + j * D + 256 * w + k4); acc[j] += (w0 * sv.x + w1 * sv.y) + (w2 * sv.z + w3 * sv.w); }
            }
#pragma unroll
            for (int j = 0; j < 9; ++j) red[(w * 9 + j) * 64 + lane] = acc[j];
            __syncthreads();
            for (int e = C.tid; e < 9 * 64; e += 512) { const int j = e >> 6, c = e & 63; float sum = adab[(size_t)l * 6 * D + nb * 64 + c];
#pragma unroll
                for (int ww = 0; ww < 8; ++ww) sum += red[(ww * 9 + j) * 64 + c];
                WSP(float, WS_MOD)[((size_t)l * 9 + j) * 6 * D + nb * 64 + c] = sum; }
            __syncthreads();
        }
    }
    if (MK_PRO_MASK & 64)
    {
        const float *fw1 = karg<I_FW1>(), *fw2 = karg<I_FW2>(), *fw3 = karg<I_FW3>(), *fwout = karg<I_FWOUT>(), *hbias = karg<I_HYBIAS>();
        const float fq = karg<I_FREQ>()[lane]; const float fb1 = karg<I_FB1>()[lane], fb2 = karg<I_FB2>()[lane], fb3 = karg<I_FB3>()[lane];
        for (int it = C.bid; it < 160; it += C.G) {
            const bool smp = it >= 32; const int nbase = (smp ? it - 32 : it) * 8; const int L = smp ? 1024 : 256; const int n = nbase + C.wave;
            float* FILT = WSP(float, WS_ARENA + AR_FILT) + (smp ? 0 : (size_t)1024 * 4096);
            __syncthreads();
            if (lane < 33) {
                float z;
                if (lane == 0) z = (float)n / (float)(L - 1);
                else { const int i = (lane - 1) & 15; const float fr = 1e-4f + (float)i * ((15.0f - 1e-4f) / 15.0f); const float rev = fr * (float)n / (float)L;
                       z = lane <= 16 ? fcos_rev(rev) : -fsin_rev(rev); }
                scr[lane] = z;
            }
            asm volatile("s_waitcnt lgkmcnt(0)" ::: "memory");
            float pre = fb1;
#pragma unroll 3
            for (int e = 0; e < 33; ++e) pre += scr[e] * fw1[e * 64 + lane];
            float hv = fsin(fq * pre);
            asm volatile("s_waitcnt lgkmcnt(0)" ::: "memory");
            scr[64 + lane] = hv;
            asm volatile("s_waitcnt lgkmcnt(0)" ::: "memory");
            pre = fb2;
#pragma unroll 4
            for (int e = 0; e < 64; ++e) pre += scr[64 + e] * fw2[e * 64 + lane];
            hv = fsin(fq * pre);
            asm volatile("s_waitcnt lgkmcnt(0)" ::: "memory");
            scr[128 + lane] = hv;
            asm volatile("s_waitcnt lgkmcnt(0)" ::: "memory");
            pre = fb3;
#pragma unroll 4
            for (int e = 0; e < 64; ++e) pre += scr[128 + e] * fw3[e * 64 + lane];
            hv = fsin(fq * pre);
            scr[1024 + lane] = hv;
            __syncthreads();
            float acc[8][8];
#pragma unroll
            for (int nn = 0; nn < 8; ++nn)
#pragma unroll
                for (int i = 0; i < 8; ++i) acc[nn][i] = 0.f;
            const float* wo = fwout + 512 * C.wave + lane;
#pragma unroll 2
            for (int e = 0; e < 64; ++e) {
                float wv[8];
#pragma unroll
                for (int i = 0; i < 8; ++i) wv[i] = wo[(size_t)e * 4096 + i * 64];
#pragma unroll
                for (int nn = 0; nn < 8; ++nn) { const float hh = ((const LAS float*)(C.lds + nn * 16384))[1024 + e];
#pragma unroll
                    for (int i = 0; i < 8; ++i) acc[nn][i] += hh * wv[i]; }
            }
#pragma unroll
            for (int nn = 0; nn < 8; ++nn) { const int n2 = nbase + nn; const float tn = (float)n2 / (float)(L - 1);
#pragma unroll
                for (int i = 0; i < 8; ++i) {
                    const int o = 512 * C.wave + i * 64 + lane, dir = o >> 11, c = o & 2047;
                    const float delta = -3.0701134573253944f + (float)c * ((-15.350567286626972f + 3.0701134573253944f) / 2047.0f);
                    float val = acc[nn][i] * fexp(-tn * fabsf(delta));
                    if (dir == 0 && n2 == 0) val += hbias[c];
                    FILT[(size_t)n2 * 4096 + o] = val;
                } }
        }
        __syncthreads();
    }
}

__device__ __forceinline__ void phase_fg_transpose(const Ctx& C) {
    const int tid = C.tid;
    LAS float* tl = (LAS float*)C.lds;
    for (int it = C.bid; it < 1280; it += C.G) {
        const bool smp = it < 1024; const int q = smp ? it : it - 1024;
        const int L = smp ? 1024 : 256, ROW = smp ? FGS_ROW : FGP_ROW;
        const int cbk = q & 31, nb = smp ? (q >> 5) & 15 : (q >> 5) & 3, dir = smp ? q >> 9 : q >> 7;
        const float* FILT = WSP(float, WS_ARENA + AR_FILT) + (smp ? 0 : (size_t)1024 * 4096);
        bf16_t* FG = WSP(bf16_t, smp ? WS_FGS : WS_FGP);
        const int n0 = nb * 64 + dir;
        __syncthreads();
        { const int nl = tid >> 3, c8 = tid & 7; const int n = n0 + nl;
          f32x4 a = (f32x4){0.f, 0.f, 0.f, 0.f}, b = a;
          const int nc = n < L ? n : L - 1;
          const float* src = FILT + (size_t)nc * 4096 + dir * 2048 + cbk * 64 + 8 * c8;
          a = *(const f32x4*)src; b = *(const f32x4*)(src + 4);
          if (n >= L) { a = (f32x4){0.f, 0.f, 0.f, 0.f}; b = a; }
          LAS float* d = tl + nl * 65 + 8 * c8;
          d[0] = a.x; d[1] = a.y; d[2] = a.z; d[3] = a.w; d[4] = b.x; d[5] = b.y; d[6] = b.z; d[7] = b.w; }
        __syncthreads();
        { const int cl = tid >> 3, i8 = tid & 7;
          float v[8];
#pragma unroll
          for (int j = 0; j < 8; ++j) { const int il = 8 * i8 + j; const int nl = dir ? il : 63 - il; v[j] = tl[nl * 65 + cl]; }
          const int idx0 = dir ? (L + nb * 64) : (L - 64 - nb * 64);
          u32x4 o; o.x = cvt_pk(v[0], v[1]); o.y = cvt_pk(v[2], v[3]); o.z = cvt_pk(v[4], v[5]); o.w = cvt_pk(v[6], v[7]);
          bf16_t* dst = FG + (size_t)(cbk * 64 + cl) * ROW;
          *(u32x4*)(dst + idx0 + 8 * i8) = o;
          if (dir && nb * 64 + 64 == L) *(u32x4*)(dst + 2 * L + 8 * i8) = (u32x4){0u, 0u, 0u, 0u}; }
    }
    __syncthreads();
}

__device__ __forceinline__ void phase_norm_mod(const Ctx& C, const float* Xp, const float* Xs, const float* g, int layer, int which_sh, bf16_t* H, const bf16_t* P1 = nullptr, float* Xw = nullptr) {
    const int gw = C.bid * 8 + C.wave, NGW = C.G * 8, lane = C.lane;
    for (int m = gw; m < MT; m += NGW) {
        const int cond = cond_of_row(m);
        const float* sh = MODP(layer, cond, which_sh); const float* sc = MODP(layer, cond, which_sh + 1);
        const f32x4* xr = (const f32x4*)(m < MP ? Xp + (size_t)m * D : Xs + (size_t)(m - MP) * D) + lane;
        f32x4 v[8]; float ss = 0.f;
#pragma unroll
        for (int j = 0; j < 8; ++j) { v[j] = xr[64 * j]; if (P1) { const u32x2 pw = ((const u32x2*)(P1 + (size_t)m * D) + lane)[64 * j]; v[j] += (f32x4){bflo(pw.x), bfhi(pw.x), bflo(pw.y), bfhi(pw.y)}; ((f32x4*)(Xw + (size_t)m * D) + lane)[64 * j] = v[j]; }
            ss += (v[j].x * v[j].x + v[j].y * v[j].y) + (v[j].z * v[j].z + v[j].w * v[j].w); }
        const float rstd = __builtin_amdgcn_rsqf(wave_sum(ss) * (1.0f / D) + 1e-6f);
        u32x2* o = (u32x2*)(H + (size_t)m * D) + lane;
#pragma unroll
        for (int j = 0; j < 8; ++j) {
            const f32x4 gv = ((const f32x4*)g)[lane + 64 * j], sv = ((const f32x4*)sh)[lane + 64 * j], cv = ((const f32x4*)sc)[lane + 64 * j];
            const f32x4 y = (v[j] * rstd * gv) * (cv + 1.0f) + sv;
            u32x2 w; w.x = cvt_pk(y.x, y.y); w.y = cvt_pk(y.z, y.w); o[64 * j] = w;
        }
    }
}
__device__ __forceinline__ void phase_norm_final(const Ctx& C, const float* X, const float* g, float* out, const bf16_t* P1 = nullptr) {
    const int gw = C.bid * 8 + C.wave, NGW = C.G * 8, lane = C.lane;
    for (int m = gw; m < MT; m += NGW) {
        const f32x4* xr = (const f32x4*)(X + (size_t)m * D) + lane;
        f32x4 v[8]; float ss = 0.f;
#pragma unroll
        for (int j = 0; j < 8; ++j) { v[j] = xr[64 * j]; if (P1) { const u32x2 pw = ((const u32x2*)(P1 + (size_t)m * D) + lane)[64 * j]; v[j] += (f32x4){bflo(pw.x), bfhi(pw.x), bflo(pw.y), bfhi(pw.y)}; } ss += (v[j].x * v[j].x + v[j].y * v[j].y) + (v[j].z * v[j].z + v[j].w * v[j].w); }
        const float rstd = __builtin_amdgcn_rsqf(wave_sum(ss) * (1.0f / D) + 1e-6f);
        f32x4* o = (f32x4*)(out + (size_t)m * D) + lane;
#pragma unroll
        for (int j = 0; j < 8; ++j) o[64 * j] = v[j] * rstd * ((const f32x4*)g)[lane + 64 * j];
    }
}

__device__ __forceinline__ void unpack8(const u32x4 w, float (&f)[8]) { f[0] = bflo(w.x); f[1] = bfhi(w.x); f[2] = bflo(w.y); f[3] = bfhi(w.y); f[4] = bflo(w.z); f[5] = bfhi(w.z); f[6] = bflo(w.w); f[7] = bfhi(w.w); }
__device__ __forceinline__ u32x4 pack8(const float (&f)[8]) { u32x4 o; o.x = cvt_pk(f[0], f[1]); o.y = cvt_pk(f[2], f[3]); o.z = cvt_pk(f[4], f[5]); o.w = cvt_pk(f[6], f[7]); return o; }
__device__ __forceinline__ void phase_norm_mod_b(const Ctx& C, const bf16_t* X, const float* g, int layer, int which_sh, bf16_t* H, const bf16_t* P1 = nullptr, bf16_t* Xw = nullptr, int p1_row0 = 0) {
    const int gw = C.bid * 8 + C.wave, NGW = C.G * 8, lane = C.lane;
    f32x4 gv[4][2];
#pragma unroll
    for (int j = 0; j < 4; ++j)
#pragma unroll
        for (int h = 0; h < 2; ++h) gv[j][h] = ((const f32x4*)g)[2 * (lane + 64 * j) + h];
    u32x4 xa[4], pa[4]; f32x4 sv[4][2], cv[4][2];
#define NM_LOAD(m_) do { const int cond_ = cond_of_row(m_); const f32x4* sh_ = (const f32x4*)MODP(layer, cond_, which_sh); const f32x4* sc_ = (const f32x4*)MODP(layer, cond_, which_sh + 1); \
        _Pragma("unroll") for (int j = 0; j < 4; ++j) { xa[j] = ((const u32x4*)(X + (size_t)(m_) * D) + lane)[64 * j]; if (P1 && (m_) >= p1_row0) pa[j] = ((const u32x4*)(P1 + (size_t)(m_) * D) + lane)[64 * j]; } \
        _Pragma("unroll") for (int j = 0; j < 4; ++j) { _Pragma("unroll") for (int h = 0; h < 2; ++h) { const int ci_ = 2 * (lane + 64 * j) + h; sv[j][h] = sh_[ci_]; cv[j][h] = sc_[ci_]; } } } while (0)
    int m = gw;
    if (m < MT) NM_LOAD(m);
    for (; m < MT; m += NGW) {
        const bool fold = P1 && m >= p1_row0;
        float v[4][8]; float ss = 0.f;
#pragma unroll
        for (int j = 0; j < 4; ++j) {
            unpack8(xa[j], v[j]);
            if (fold) { float p[8]; unpack8(pa[j], p);
#pragma unroll
                for (int e = 0; e < 8; ++e) v[j][e] += p[e]; }
#pragma unroll
            for (int e = 0; e < 8; ++e) ss += v[j][e] * v[j][e];
        }
        const float rstd = __builtin_amdgcn_rsqf(wave_sum(ss) * (1.0f / D) + 1e-6f);
        u32x4 xo[4], ho[4];
#pragma unroll
        for (int j = 0; j < 4; ++j) {
            if (fold) xo[j] = pack8(v[j]);
            float y[8];
#pragma unroll
            for (int h = 0; h < 2; ++h)
#pragma unroll
                for (int e = 0; e < 4; ++e) y[4 * h + e] = (v[j][4 * h + e] * rstd * gv[j][h][e]) * (cv[j][h][e] + 1.0f) + sv[j][h][e];
            ho[j] = pack8(y);
        }
        const int mn = m + NGW;
        if (mn < MT) NM_LOAD(mn);
        asm volatile("" ::: "memory");
#pragma unroll
        for (int j = 0; j < 4; ++j) { if (fold) ((u32x4*)(Xw + (size_t)m * D) + lane)[64 * j] = xo[j]; ((u32x4*)(H + (size_t)m * D) + lane)[64 * j] = ho[j]; }
    }
#undef NM_LOAD
}
__device__ __forceinline__ void phase_norm_final_b(const Ctx& C, const bf16_t* X, const float* g, float* out, const bf16_t* P1 = nullptr, int p1_row0 = 0) {
    const int gw = C.bid * 8 + C.wave, NGW = C.G * 8, lane = C.lane;
    for (int m = gw; m < MT; m += NGW) {
        const u32x4* xr = (const u32x4*)(X + (size_t)m * D) + lane;
        float v[4][8]; float ss = 0.f;
#pragma unroll
        for (int j = 0; j < 4; ++j) {
            unpack8(xr[64 * j], v[j]);
            if (P1 && m >= p1_row0) { float p[8]; unpack8(((const u32x4*)(P1 + (size_t)m * D) + lane)[64 * j], p);
#pragma unroll
                for (int e = 0; e < 8; ++e) v[j][e] += p[e]; }
#pragma unroll
            for (int e = 0; e < 8; ++e) ss += v[j][e] * v[j][e];
        }
        const float rstd = __builtin_amdgcn_rsqf(wave_sum(ss) * (1.0f / D) + 1e-6f);
        f32x4* o = (f32x4*)(out + (size_t)m * D);
#pragma unroll
        for (int j = 0; j < 4; ++j)
#pragma unroll
            for (int h = 0; h < 2; ++h) {
                const int ci = 2 * (lane + 64 * j) + h;
                const f32x4 gv = ((const f32x4*)g)[ci];
                f32x4 y;
#pragma unroll
                for (int e = 0; e < 4; ++e) y[e] = v[j][4 * h + e] * rstd * gv[e];
                o[ci] = y;
            }
    }
}

using pg8::Unit;
constexpr int HALF = 128;

struct EpiResidual {
    static constexpr bool PERM = false, AFTER_DRAIN = false;
    float* X; const float* gate_base;
    const float *Bp, *Bs;
    __device__ __forceinline__ void operator()(const f32x4 (&acc)[2][2][4][2], const Unit& u, int wr, int wc, int fr, int fq) const {
        const int row0 = u.pm * 256 + wr * 64 + fr, col0 = u.pn * 256 + wc * 32 + 4 * fq;
        const float* gp = gate_base + (size_t)cond_of_panel(u.pm) * 6 * D + col0;
        f32x4 gv[2][2];
#pragma unroll
        for (int bj = 0; bj < 2; ++bj)
#pragma unroll
            for (int n = 0; n < 2; ++n) gv[bj][n] = *(const f32x4*)(gp + bj * HALF + n * 16);
        const float* sbase = (u.pm < 16 ? Bp + (size_t)row0 * D : Bs + (size_t)(row0 - MP) * D) + col0;
#pragma unroll
        for (int ai = 0; ai < 2; ++ai) {
            f32x4 q[4][2][2];
#pragma unroll
            for (int m = 0; m < 4; ++m)
#pragma unroll
                for (int bj = 0; bj < 2; ++bj)
#pragma unroll
                    for (int n = 0; n < 2; ++n) if ((u.mask >> (ai * 2 + bj)) & 1) q[m][bj][n] = *(const f32x4*)(sbase + (size_t)(ai * HALF + m * 16) * D + bj * HALF + n * 16);
#pragma unroll
            for (int m = 0; m < 4; ++m) { float* rowp = X + (size_t)(row0 + ai * HALF + m * 16) * D + col0;
#pragma unroll
                for (int bj = 0; bj < 2; ++bj)
#pragma unroll
                    for (int n = 0; n < 2; ++n) if ((u.mask >> (ai * 2 + bj)) & 1) *(f32x4*)(rowp + bj * HALF + n * 16) = q[m][bj][n] + gv[bj][n] * acc[ai][bj][m][n]; }
            asm volatile("" ::: "memory");
        }
    }
};
template <int ACT> struct EpiBf16 {
    static constexpr bool PERM = true, AFTER_DRAIN = false;
    bf16_t* O; int ldc;
    __device__ __forceinline__ void operator()(const f32x4 (&acc)[2][2][4][2], const Unit& u, int wr, int wc, int fr, int fq) const {
        const int row0 = u.pm * 256 + wr * 64 + fr, col0 = u.pn * 256 + wc * 32 + 8 * fq;
#pragma unroll
        for (int ai = 0; ai < 2; ++ai)
#pragma unroll
            for (int m = 0; m < 4; ++m) { bf16_t* rowp = O + (size_t)(row0 + ai * HALF + m * 16) * ldc + col0;
#pragma unroll
                for (int bj = 0; bj < 2; ++bj) { if (!((u.mask >> (ai * 2 + bj)) & 1)) continue; f32x4 v0 = acc[ai][bj][m][0], v1 = acc[ai][bj][m][1];
                    if (ACT == 1) {
#pragma unroll
                        for (int j = 0; j < 4; ++j) { const float a = fmaxf(v0[j], 0.f), b = fmaxf(v1[j], 0.f); v0[j] = a * a; v1[j] = b * b; } }
                    u32x4 w; w.x = cvt_pk(v0[0], v0[1]); w.y = cvt_pk(v0[2], v0[3]); w.z = cvt_pk(v1[0], v1[1]); w.w = cvt_pk(v1[2], v1[3]);
                    *(u32x4*)(rowp + bj * HALF) = w; } }
    }
};
struct EpiQKV {
    static constexpr bool PERM = true, AFTER_DRAIN = false;
    bf16_t *Q, *K, *V; float *NK, *NV;
    __device__ __forceinline__ void operator()(const f32x4 (&acc)[2][2][4][2], const Unit& u, int wr, int wc, int fr, int fq) const {
        const int row0 = u.pm * 256 + wr * 64 + fr; const int cin = wc * 32 + 8 * fq;
        bf16_t* base; int ldc, colt; float* fo = nullptr;
        if (u.pn < 8) { base = Q; ldc = 2048; colt = u.pn * 256; }
        else if (u.pn < 10) { base = K; ldc = 512; colt = (u.pn - 8) * 256; if (u.pm < 16) fo = NK; }
        else { base = V; ldc = 512; colt = (u.pn - 10) * 256; if (u.pm < 16) fo = NV; }
#pragma unroll
        for (int ai = 0; ai < 2; ++ai)
#pragma unroll
            for (int m = 0; m < 4; ++m) { const int r = row0 + ai * HALF + m * 16; bf16_t* rowp = base + (size_t)r * ldc + colt + cin;
#pragma unroll
                for (int bj = 0; bj < 2; ++bj) { if (!((u.mask >> (ai * 2 + bj)) & 1)) continue; const f32x4 v0 = acc[ai][bj][m][0], v1 = acc[ai][bj][m][1];
                    u32x4 w; w.x = cvt_pk(v0[0], v0[1]); w.y = cvt_pk(v0[2], v0[3]); w.z = cvt_pk(v1[0], v1[1]); w.w = cvt_pk(v1[2], v1[3]);
                    *(u32x4*)(rowp + bj * HALF) = w;
                    if (fo) { float* fp = fo + ((size_t)(r >> 8) * 512 + (r & 255)) * 512 + colt + cin + bj * HALF; *(f32x4*)fp = v0; *(f32x4*)(fp + 4) = v1; } } }
    }
};
__device__ __forceinline__ size_t hm_index(int m, int c) { return ((size_t)(c >> 6) * MT + m) * 64 + (c & 63); }
struct EpiRw1 {
    static constexpr bool PERM = true, AFTER_DRAIN = false;
    bf16_t *R, *A3;
    const float* k_k; float* invsq;
    __device__ __forceinline__ void operator()(const f32x4 (&acc)[2][2][4][2], const Unit& u, int wr, int wc, int fr, int fq) const {
        const int ct = u.pn, panel = u.pm % NPANEL;
        const int row0 = panel * 256 + wr * 64 + fr; const int cin = wc * 32 + 8 * fq;
        bf16_t* base; int ldc, colt, act = 0;
        if (ct < 24) { base = R + (size_t)(ct >> 3) * MT * D; ldc = D; colt = (ct & 7) * 256; }
        else { base = A3 + (size_t)(ct - 24) * MT * 256; ldc = 256; colt = 0; act = ct - 23; }
#pragma unroll
        for (int ai = 0; ai < 2; ++ai)
#pragma unroll
            for (int m = 0; m < 4; ++m) { const int rrow = row0 + ai * HALF + m * 16; bf16_t* rowp = base + (size_t)rrow * ldc + colt + cin;
#pragma unroll
                for (int bj = 0; bj < 2; ++bj) { if (!((u.mask >> (ai * 2 + bj)) & 1)) continue; f32x4 v0 = acc[ai][bj][m][0], v1 = acc[ai][bj][m][1];
                    if (act == 1) {
#pragma unroll
                        for (int j = 0; j < 4; ++j) { v0[j] = ftanh(v0[j]); v1[j] = ftanh(v1[j]); } }
                    else if (act == 3) {
#pragma unroll
                        for (int j = 0; j < 4; ++j) { v0[j] = fsigmoid(v0[j]); v1[j] = fsigmoid(v1[j]); } }
                    u32x4 w; w.x = cvt_pk(v0[0], v0[1]); w.y = cvt_pk(v0[2], v0[3]); w.z = cvt_pk(v1[0], v1[1]); w.w = cvt_pk(v1[2], v1[3]);
                    if (ct < 24) *(u32x4*)(base + hm_index(rrow, colt + cin + bj * HALF)) = w; else *(u32x4*)(rowp + bj * HALF) = w;
} }
    }
};
struct EpiRw2 {
    static constexpr bool PERM = true, AFTER_DRAIN = false;
    bf16_t *LD, *LA, *Gt; const float *w0, *a0;
    __device__ __forceinline__ void operator()(const f32x4 (&acc)[2][2][4][2], const Unit& u, int wr, int wc, int fr, int fq) const {
        const int ct = u.pn, panel = u.pm % NPANEL, grp = ct >> 3;
        const int row0 = panel * 256 + wr * 64 + fr; const int col0 = (ct & 7) * 256 + wc * 32 + 8 * fq;
        bf16_t* base; const float* bias = nullptr;
        if (grp < 2) { base = LD + (size_t)grp * MT * D; bias = w0 + grp * D; }
        else if (grp < 4) { base = LA + (size_t)(grp - 2) * MT * D; bias = a0 + (grp - 2) * D; }
        else base = Gt;
        f32x4 bv[2][2];
#pragma unroll
        for (int bj = 0; bj < 2; ++bj)
#pragma unroll
            for (int n = 0; n < 2; ++n) bv[bj][n] = bias ? *(const f32x4*)(bias + col0 + bj * HALF + 4 * n) : (f32x4){0.f, 0.f, 0.f, 0.f};
#pragma unroll
        for (int ai = 0; ai < 2; ++ai)
#pragma unroll
            for (int m = 0; m < 4; ++m) { const int rrow = row0 + ai * HALF + m * 16; bf16_t* rowp = base + (size_t)rrow * D + col0;
#pragma unroll
                for (int bj = 0; bj < 2; ++bj) {
                    f32x4 v0 = acc[ai][bj][m][0] + bv[bj][0], v1 = acc[ai][bj][m][1] + bv[bj][1];
                    if (grp < 2) {
#pragma unroll
                        for (int j = 0; j < 4; ++j) { v0[j] = -fexp(-fsoftplus(-v0[j]) - 0.5f); v1[j] = -fexp(-fsoftplus(-v1[j]) - 0.5f); } }
                    u32x4 w; w.x = cvt_pk(v0[0], v0[1]); w.y = cvt_pk(v0[2], v0[3]); w.z = cvt_pk(v1[0], v1[1]); w.w = cvt_pk(v1[2], v1[3]);
                    if (grp < 4) *(u32x4*)(base + hm_index(rrow, col0 + bj * HALF)) = w; else *(u32x4*)(rowp + bj * HALF) = w; }
                asm volatile("" : "+v"(bv[0][0]), "+v"(bv[0][1]), "+v"(bv[1][0]), "+v"(bv[1][1]));
            }
    }
};
struct RwOrder1 {
    int G, c, lo, hi; bool xcd;
    __device__ __forceinline__ bool next(int i, Unit& u) const { const int L = lo + i * G + c; if (L >= hi) return false; u.mask = 15;
        int panel, ct;
        if (xcd) {
            if (L < 1280) {
                const int cc = L & 255, T = (((L >> 8) * 8 + (cc & 7)) << 5) + (cc >> 3);
                if (T < 1056) { const int blk = T >> 5, j = T & 31, pq = blk / 3, g = blk - 3 * pq; panel = pq * 4 + (j >> 3); ct = g * 8 + (j & 7); }
                else if (T < 1120) { const int blk = (T - 1056) >> 5, j = T & 31; panel = 44 + (j >> 3); ct = (1 + blk) * 8 + (j & 7); }
                else { const int U = T - 1120; if (U < 16) { panel = 44 + (U >> 3); ct = U & 7; } else { const int q = U - 16; panel = q / 3; ct = 24 + q - 3 * panel; } }
            } else { const int q = L - 1280; panel = 46 + (q >> 3); ct = q & 7; }
        } else { panel = L / 27; ct = L % 27; }
        const int ai = ct < 24 ? (ct >> 3) : ct - 21; u.pm = ai * NPANEL + panel; u.pn = ct; u.kh = 0; return true; }
    __device__ __forceinline__ void a_ready(const Unit&) const {}
    __device__ __forceinline__ void done(const Unit&) const {}
};
struct RwOrder2 {
    int G, c; unsigned* cnt; unsigned need;
    __device__ __forceinline__ bool next(int i, Unit& u) const { const int L = i * G + c; if (L >= 40 * NPANEL) return false; const int panel = L / 40, ct = L % 40; const int ai = ct < 16 ? 0 : (ct < 32 ? 1 : 2); u.pm = ai * NPANEL + panel; u.pn = ct; u.kh = 0; u.mask = 15; return true; }
    __device__ __forceinline__ void a_ready(const Unit& u) const {
        if (cnt && (u.pm % NPANEL) == NPANEL - 1) {
            unsigned sp = 0u;
            while (xb_ld(cnt) < need) { __builtin_amdgcn_s_sleep(2); if (++sp > (1u << 24)) break; }
            __builtin_amdgcn_fence(__ATOMIC_ACQUIRE, "agent");
            asm volatile("s_waitcnt vmcnt(0)" ::: "memory");
        }
    }
    __device__ __forceinline__ void done(const Unit&) const {}
};

struct SplitOrder {
    pg8::StaticOrder so; int G, c, ntiles;
    __device__ __forceinline__ void init(int N, int G_, int c_) { so.init(MT, N, G_, c_); G = G_; c = c_; ntiles = so.nwg; }
    __device__ __forceinline__ bool next(int i, Unit& u) const { const int L = i * G + c; if (L >= 2 * ntiles) return false; const int kh = L >= ntiles; so.map(kh ? L - ntiles : L, u); u.kh = kh; u.mask = 15; return true; }
    __device__ __forceinline__ void a_ready(const Unit&) const {}
    __device__ __forceinline__ void done(const Unit&) const {}
};
struct EpiResidualSplit {
    static constexpr bool PERM = false, AFTER_DRAIN = false;
    float* X; const float* gate_base; bf16_t* P1;
    __device__ __forceinline__ void operator()(const f32x4 (&acc)[2][2][4][2], const Unit& u, int wr, int wc, int fr, int fq) const {
        const int row0 = u.pm * 256 + wr * 64 + fr, col0 = u.pn * 256 + wc * 32 + 4 * fq;
        const float* gp = gate_base + (size_t)cond_of_panel(u.pm) * 6 * D + col0;
        f32x4 gv[2][2];
#pragma unroll
        for (int bj = 0; bj < 2; ++bj)
#pragma unroll
            for (int n = 0; n < 2; ++n) gv[bj][n] = *(const f32x4*)(gp + bj * HALF + n * 16);
        if (u.kh == 0) {
#pragma unroll
            for (int ai = 0; ai < 2; ++ai) {
                f32x4 q[4][2][2];
#pragma unroll
                for (int m = 0; m < 4; ++m)
#pragma unroll
                    for (int bj = 0; bj < 2; ++bj)
#pragma unroll
                        for (int n = 0; n < 2; ++n) q[m][bj][n] = *(const f32x4*)(X + (size_t)(row0 + ai * HALF + m * 16) * D + col0 + bj * HALF + n * 16);
#pragma unroll
                for (int m = 0; m < 4; ++m) { float* rowp = X + (size_t)(row0 + ai * HALF + m * 16) * D + col0;
#pragma unroll
                    for (int bj = 0; bj < 2; ++bj)
#pragma unroll
                        for (int n = 0; n < 2; ++n) *(f32x4*)(rowp + bj * HALF + n * 16) = q[m][bj][n] + gv[bj][n] * acc[ai][bj][m][n]; }
                asm volatile("" ::: "memory");
            }
        } else {
#pragma unroll
            for (int ai = 0; ai < 2; ++ai)
#pragma unroll
                for (int m = 0; m < 4; ++m) { bf16_t* rowp = P1 + (size_t)(row0 + ai * HALF + m * 16) * D + col0;
#pragma unroll
                    for (int bj = 0; bj < 2; ++bj)
#pragma unroll
                        for (int n = 0; n < 2; ++n) { const f32x4 v = gv[bj][n] * acc[ai][bj][m][n]; u32x2 w; w.x = cvt_pk(v.x, v.y); w.y = cvt_pk(v.z, v.w); *(u32x2*)(rowp + bj * HALF + n * 16) = w; } }
        }
    }
};

template <bool SRCF32> struct EpiResidualB {
    static constexpr bool PERM = true, AFTER_DRAIN = false;
    bf16_t* X; const float* gate_base; const float *Bp, *Bs;
    __device__ __forceinline__ void operator()(const f32x4 (&acc)[2][2][4][2], const Unit& u, int wr, int wc, int fr, int fq) const {
        const int row0 = u.pm * 256 + wr * 64 + fr, col0 = u.pn * 256 + wc * 32 + 8 * fq;
        const float* gp = gate_base + (size_t)cond_of_panel(u.pm) * 6 * D + col0;
        f32x4 gv[2][2];
#pragma unroll
        for (int bj = 0; bj < 2; ++bj)
#pragma unroll
            for (int n = 0; n < 2; ++n) gv[bj][n] = *(const f32x4*)(gp + bj * HALF + 4 * n);
        u32x4 qa[2][4][2];
#pragma unroll
        for (int ai = 0; ai < 2; ++ai) {
            if constexpr (SRCF32) {
                const float* sbase = (u.pm < 16 ? Bp + (size_t)row0 * D : Bs + (size_t)(row0 - MP) * D) + col0;
                f32x4 q[4][2][2];
#pragma unroll
                for (int m = 0; m < 4; ++m)
#pragma unroll
                    for (int bj = 0; bj < 2; ++bj)
#pragma unroll
                        for (int n = 0; n < 2; ++n) q[m][bj][n] = *(const f32x4*)(sbase + (size_t)(ai * HALF + m * 16) * D + bj * HALF + 4 * n);
#pragma unroll
                for (int m = 0; m < 4; ++m) { bf16_t* rowp = X + (size_t)(row0 + ai * HALF + m * 16) * D + col0;
#pragma unroll
                    for (int bj = 0; bj < 2; ++bj) { const f32x4 v0 = q[m][bj][0] + gv[bj][0] * acc[ai][bj][m][0], v1 = q[m][bj][1] + gv[bj][1] * acc[ai][bj][m][1];
                        u32x4 w; w.x = cvt_pk(v0.x, v0.y); w.y = cvt_pk(v0.z, v0.w); w.z = cvt_pk(v1.x, v1.y); w.w = cvt_pk(v1.z, v1.w); *(u32x4*)(rowp + bj * HALF) = w; } }
            } else {
                if (ai == 0) {
#pragma unroll
                    for (int a2 = 0; a2 < 2; ++a2)
#pragma unroll
                        for (int m = 0; m < 4; ++m)
#pragma unroll
                            for (int bj = 0; bj < 2; ++bj) qa[a2][m][bj] = *(const u32x4*)(X + (size_t)(row0 + a2 * HALF + m * 16) * D + col0 + bj * HALF);
                }
#pragma unroll
                for (int m = 0; m < 4; ++m) { bf16_t* rowp = X + (size_t)(row0 + ai * HALF + m * 16) * D + col0;
#pragma unroll
                    for (int bj = 0; bj < 2; ++bj) { const u32x4 o = qa[ai][m][bj];
                        const f32x4 v0 = (f32x4){bflo(o.x), bfhi(o.x), bflo(o.y), bfhi(o.y)} + gv[bj][0] * acc[ai][bj][m][0], v1 = (f32x4){bflo(o.z), bfhi(o.z), bflo(o.w), bfhi(o.w)} + gv[bj][1] * acc[ai][bj][m][1];
                        u32x4 w; w.x = cvt_pk(v0.x, v0.y); w.y = cvt_pk(v0.z, v0.w); w.z = cvt_pk(v1.x, v1.y); w.w = cvt_pk(v1.z, v1.w); *(u32x4*)(rowp + bj * HALF) = w; } }
            }
            asm volatile("" ::: "memory");
        }
    }
};
struct EpiResidualSplitB {
    static constexpr bool PERM = true, AFTER_DRAIN = false;
    bf16_t* X; const float* gate_base; bf16_t* P1;
    __device__ __forceinline__ void operator()(const f32x4 (&acc)[2][2][4][2], const Unit& u, int wr, int wc, int fr, int fq) const {
        const int row0 = u.pm * 256 + wr * 64 + fr, col0 = u.pn * 256 + wc * 32 + 8 * fq;
        const float* gp = gate_base + (size_t)cond_of_panel(u.pm) * 6 * D + col0;
        f32x4 gv[2][2];
#pragma unroll
        for (int bj = 0; bj < 2; ++bj)
#pragma unroll
            for (int n = 0; n < 2; ++n) gv[bj][n] = *(const f32x4*)(gp + bj * HALF + 4 * n);
        if (u.kh == 0) {
            u32x4 qa[2][4][2];
#pragma unroll
            for (int a2 = 0; a2 < 2; ++a2)
#pragma unroll
                for (int m = 0; m < 4; ++m)
#pragma unroll
                    for (int bj = 0; bj < 2; ++bj) qa[a2][m][bj] = *(const u32x4*)(X + (size_t)(row0 + a2 * HALF + m * 16) * D + col0 + bj * HALF);
#pragma unroll
            for (int ai = 0; ai < 2; ++ai) {
#pragma unroll
                for (int m = 0; m < 4; ++m) { bf16_t* rowp = X + (size_t)(row0 + ai * HALF + m * 16) * D + col0;
#pragma unroll
                    for (int bj = 0; bj < 2; ++bj) { const u32x4 o = qa[ai][m][bj];
                        const f32x4 v0 = (f32x4){bflo(o.x), bfhi(o.x), bflo(o.y), bfhi(o.y)} + gv[bj][0] * acc[ai][bj][m][0], v1 = (f32x4){bflo(o.z), bfhi(o.z), bflo(o.w), bfhi(o.w)} + gv[bj][1] * acc[ai][bj][m][1];
                        u32x4 w; w.x = cvt_pk(v0.x, v0.y); w.y = cvt_pk(v0.z, v0.w); w.z = cvt_pk(v1.x, v1.y); w.w = cvt_pk(v1.z, v1.w); *(u32x4*)(rowp + bj * HALF) = w; } }
                asm volatile("" ::: "memory");
            }
        } else {
#pragma unroll
            for (int ai = 0; ai < 2; ++ai)
#pragma unroll
                for (int m = 0; m < 4; ++m) { bf16_t* rowp = P1 + (size_t)(row0 + ai * HALF + m * 16) * D + col0;
#pragma unroll
                    for (int bj = 0; bj < 2; ++bj) { const f32x4 v0 = gv[bj][0] * acc[ai][bj][m][0], v1 = gv[bj][1] * acc[ai][bj][m][1];
                        u32x4 w; w.x = cvt_pk(v0.x, v0.y); w.y = cvt_pk(v0.z, v0.w); w.z = cvt_pk(v1.x, v1.y); w.w = cvt_pk(v1.z, v1.w); *(u32x4*)(rowp + bj * HALF) = w; } }
        }
    }
};
struct TailSplitOrder {
    pg8::StaticOrder sf, st; int G, c, ntf;
    __device__ __forceinline__ void init(int G_, int c_, int ntf_ = 32) { sf.init(8192, D, G_, c_); st.init(4096, D, G_, c_); G = G_; c = c_; ntf = ntf_; }
    __device__ __forceinline__ bool next(int i, Unit& u) const {
        const int L = i * G + c; if (L >= 512) return false;
        if (L < 256) { sf.map(L, u); u.kh = 0; u.nt = ntf; }
        else { const int h = L - 256, kh = h >= 128; st.map(kh ? h - 128 : h, u); u.pm += 32; u.kh = kh; u.nt = ntf >> 1; }
        u.mask = 15; return true; }
    __device__ __forceinline__ void a_ready(const Unit&) const {}
    __device__ __forceinline__ void done(const Unit&) const {}
};


typedef short s16x4 __attribute__((ext_vector_type(4)));
constexpr int KS_STRIDE = 136;
constexpr int VT_STRIDE = 72;
constexpr int ATT_KS_OFF = 0, ATT_VT_OFF = 64 * KS_STRIDE * 2, ATT_BUF_BYTES = 36864;

__device__ __forceinline__ void rope8(u32x4& a, u32x4& b, const f32x2* tab) {
    unsigned* pa = (unsigned*)&a; unsigned* pb = (unsigned*)&b;
#pragma unroll
    for (int w = 0; w < 4; ++w) {
        const f32x4 cs = *(const f32x4*)(tab + 2 * w);
        const float x1l = bflo(pa[w]), x1h = bfhi(pa[w]), x2l = bflo(pb[w]), x2h = bfhi(pb[w]);
        const float o1l = x1l * cs.x - x2l * cs.y, o2l = x1l * cs.y + x2l * cs.x;
        const float o1h = x1h * cs.z - x2h * cs.w, o2h = x1h * cs.w + x2h * cs.z;
        pa[w] = cvt_pk(o1l, o1h); pb[w] = cvt_pk(o2l, o2h);
    }
}

__device__ __forceinline__ void phase_attention(const Ctx& C, const bf16_t* Q, const bf16_t* Kb, const bf16_t* Vb, const bf16_t* KC, const bf16_t* VC, const float* sink, bf16_t* O) {
    const int tid = C.tid, lane = C.lane, w = C.wave, h = lane >> 5, lq = lane & 31;
    LAS bf16_t* Ks = (LAS bf16_t*)(C.lds + ATT_KS_OFF);
    LAS bf16_t* Vt = (LAS bf16_t*)(C.lds + ATT_VT_OFF);
    const f32x2* rope = WSP(f32x2, WS_ROPE);
    const float c2 = 0.08838834764831845f * 1.4426950408889634f;
    for (int it = C.bid; it < 768; it += C.G) {
        const bool smp = it < 512;
        int bb, kvh, qb, R0;
        if (smp) { bb = it >> 6; kvh = (it >> 4) & 3; qb = it & 15; R0 = MP + bb * 1024; }
        else { const int p = it - 512; bb = p >> 4; kvh = (p >> 2) & 3; qb = p & 3; R0 = bb * 256; }
        const int head = kvh * 4 + (w >> 1);
        const int t = qb * 64 + (w & 1) * 32 + lq;
        u32x4 qf[8];
        { const bf16_t* qp = Q + (size_t)(R0 + t) * D + head * 128 + 8 * h;
#pragma unroll
          for (int ks = 0; ks < 8; ++ks) qf[ks] = *(const u32x4*)(qp + 16 * ks); }
        if (smp) {
#pragma unroll
            for (int half = 0; half < 2; ++half) { const int pos = half ? (t & 63) : (t >> 6);
#pragma unroll
                for (int kk = 0; kk < 2; ++kk) rope8(qf[4 * half + kk], qf[4 * half + kk + 2], rope + pos * 32 + 16 * kk + 8 * h); }
        }
        f32x16 o[4];
#pragma unroll
        for (int db = 0; db < 4; ++db)
#pragma unroll
            for (int r = 0; r < 16; ++r) o[db][r] = 0.f;
        float mrun = -1e30f, lrun = 0.f;
        const int li0 = smp ? (qb >= 2 ? 0 : 2 - qb) : 0, li1 = smp ? (17 - qb < 4 ? 17 - qb : 4) : 0;
        const int ntot = smp ? 8 + (li1 - li0 + 1) : 4;
        const int key = tid >> 3, cc = tid & 7, c1 = (cc & 3) + (cc >> 2) * 8;
#define ATT_TILE(i, kp_, vp_, k0_, loc_) do { if (smp) { if ((i) < 8) { const size_t off_ = ((size_t)(bb * 2) * 512 + (i) * 64) * 512 + kvh * 128; kp_ = KC + off_; vp_ = VC + off_; k0_ = 0; loc_ = false; } \
            else { k0_ = qb * 64 - 128 + 64 * ((i) - 8 + li0); loc_ = true; const size_t off_ = (size_t)(R0 + k0_) * 512 + kvh * 128; kp_ = Kb + off_; vp_ = Vb + off_; } } \
          else { k0_ = (i) * 64; loc_ = false; const size_t off_ = (size_t)(R0 + k0_) * 512 + kvh * 128; kp_ = Kb + off_; vp_ = Vb + off_; } } while (0)
        u32x4 ka, kb2, va, vb2;
#define ATT_LOAD(i) do { const bf16_t *kp_, *vp_; int k0_; bool loc_; ATT_TILE(i, kp_, vp_, k0_, loc_); (void)k0_; (void)loc_; \
          ka = *(const u32x4*)(kp_ + (size_t)key * 512 + 8 * c1); kb2 = *(const u32x4*)(kp_ + (size_t)key * 512 + 8 * c1 + 32); \
          va = *(const u32x4*)(vp_ + (size_t)key * 512 + 8 * c1); vb2 = *(const u32x4*)(vp_ + (size_t)key * 512 + 8 * c1 + 32); } while (0)
#define ATT_STAGE(i, KsB, VtB) do { const bf16_t *kp_, *vp_; int k0_; bool loc_; ATT_TILE(i, kp_, vp_, k0_, loc_); (void)kp_; (void)vp_; \
          if (loc_) { const int kpos = k0_ + key; const int pos = (cc >> 2) ? (kpos & 63) : (kpos >> 6); rope8(ka, kb2, rope + pos * 32 + 8 * (cc & 3)); } \
          *(LAS u32x4*)((KsB) + key * KS_STRIDE + 8 * c1) = ka; *(LAS u32x4*)((KsB) + key * KS_STRIDE + 8 * c1 + 32) = kb2; \
          *(LAS u32x4*)((VtB) + key * KS_STRIDE + 8 * c1) = va; *(LAS u32x4*)((VtB) + key * KS_STRIDE + 8 * c1 + 32) = vb2; } while (0)
        ATT_LOAD(0); ATT_STAGE(0, Ks, Vt); if (ntot > 1) ATT_LOAD(1);
        __syncthreads();
        for (int ti = 0; ti < ntot; ++ti) {
            const bf16_t *kp, *vp; int k0; bool local; ATT_TILE(ti, kp, vp, k0, local); (void)kp; (void)vp;
            LAS bf16_t* Ks = (LAS bf16_t*)(C.lds + (ti & 1) * ATT_BUF_BYTES + ATT_KS_OFF);
            LAS bf16_t* Vt = (LAS bf16_t*)(C.lds + (ti & 1) * ATT_BUF_BYTES + ATT_VT_OFF);
            f32x16 s0, s1;
            { const float z0 = opaque_zero();
#pragma unroll
            for (int r = 0; r < 16; ++r) { s0[r] = z0; s1[r] = z0; } }
#pragma unroll
            for (int ks = 0; ks < 8; ++ks) {
                const bf16x8 a0 = *(const LAS bf16x8*)(Ks + lq * KS_STRIDE + 16 * ks + 8 * h);
                const bf16x8 a1 = *(const LAS bf16x8*)(Ks + (32 + lq) * KS_STRIDE + 16 * ks + 8 * h);
                const bf16x8 bq = __builtin_bit_cast(bf16x8, qf[ks]);
                s0 = __builtin_amdgcn_mfma_f32_32x32x16_bf16(a0, bq, s0, 0, 0, 0);
                s1 = __builtin_amdgcn_mfma_f32_32x32x16_bf16(a1, bq, s1, 0, 0, 0);
            }
            if (local) {
#pragma unroll
                for (int r = 0; r < 16; ++r) {
                    const int kl = (r & 3) + 8 * (r >> 2) + 4 * h;
                    const int d0 = k0 + kl - t, d1 = d0 + 32;
                    s0[r] = ((d0 <= 128) && (d0 >= -128)) ? s0[r] : -1e30f; s1[r] = ((d1 <= 128) && (d1 >= -128)) ? s1[r] : -1e30f;
                }
            }
            float mx = fmaxf(s0[0], s1[0]);
#pragma unroll
            for (int r = 1; r < 16; ++r) mx = fmaxf(mx, fmaxf(s0[r], s1[r]));
            mx = fmaxf(mx, __shfl_xor(mx, 32));
            const float mnew = fmaxf(mrun, mx * c2);
            const float alpha = fexp2(mrun - mnew);
            float ps = 0.f;
#pragma unroll
            for (int r = 0; r < 16; ++r) {
                const float p0 = fexp2(__builtin_fmaf(s0[r], c2, -mnew)), p1 = fexp2(__builtin_fmaf(s1[r], c2, -mnew));
                s0[r] = p0; s1[r] = p1; ps += p0 + p1;
            }
            lrun = lrun * alpha + ps; mrun = mnew;
            if (__any(alpha != 1.0f)) {
#pragma unroll
                for (int db = 0; db < 4; ++db)
#pragma unroll
                    for (int r = 0; r < 16; ++r) o[db][r] *= alpha;
            }
            u32x4 pf[4];
#pragma unroll
            for (int s = 0; s < 2; ++s) {
                pf[s].x = cvt_pk(s0[8 * s + 0], s0[8 * s + 1]); pf[s].y = cvt_pk(s0[8 * s + 2], s0[8 * s + 3]); pf[s].z = cvt_pk(s0[8 * s + 4], s0[8 * s + 5]); pf[s].w = cvt_pk(s0[8 * s + 6], s0[8 * s + 7]);
                pf[2 + s].x = cvt_pk(s1[8 * s + 0], s1[8 * s + 1]); pf[2 + s].y = cvt_pk(s1[8 * s + 2], s1[8 * s + 3]); pf[2 + s].z = cvt_pk(s1[8 * s + 4], s1[8 * s + 5]); pf[2 + s].w = cvt_pk(s1[8 * s + 6], s1[8 * s + 7]);
            }
#pragma unroll
            for (int db = 0; db < 4; ++db)
#pragma unroll
                for (int s2 = 0; s2 < 4; ++s2) {
                    const LAS bf16_t* vr = Vt + (16 * s2 + 4 * (lane >> 5) + ((lane & 15) >> 2)) * KS_STRIDE + 32 * db + 16 * ((lane >> 4) & 1) + 4 * (lane & 3);
                    const s16x4 lo = __builtin_amdgcn_ds_read_tr16_b64_v4i16((LAS s16x4*)vr), hi = __builtin_amdgcn_ds_read_tr16_b64_v4i16((LAS s16x4*)(vr + 8 * KS_STRIDE));
                    const u32x2 lo2 = __builtin_bit_cast(u32x2, lo), hi2 = __builtin_bit_cast(u32x2, hi);
                    u32x4 av; av.x = lo2.x; av.y = lo2.y; av.z = hi2.x; av.w = hi2.y;
                    o[db] = __builtin_amdgcn_mfma_f32_32x32x16_bf16(__builtin_bit_cast(bf16x8, av), __builtin_bit_cast(bf16x8, pf[s2]), o[db], 0, 0, 0);
                }
            if (ti + 1 < ntot) {
                LAS bf16_t* Ksn = (LAS bf16_t*)(C.lds + ((ti + 1) & 1) * ATT_BUF_BYTES + ATT_KS_OFF);
                LAS bf16_t* Vtn = (LAS bf16_t*)(C.lds + ((ti + 1) & 1) * ATT_BUF_BYTES + ATT_VT_OFF);
                ATT_STAGE(ti + 1, Ksn, Vtn);
                if (ti + 2 < ntot) ATT_LOAD(ti + 2);
            }
            __syncthreads();
        }
        {
            const float sk = sink[head] * 1.4426950408889634f;
            const float mnew = fmaxf(mrun, sk), alpha = fexp2(mrun - mnew);
            float l = lrun * alpha; l += __shfl_xor(l, 32); l += fexp2(sk - mnew);
            const float sc = alpha * frcp(l);
            bf16_t* op = O + (size_t)(R0 + t) * D + head * 128 + 4 * h;
#pragma unroll
            for (int db = 0; db < 4; ++db)
#pragma unroll
                for (int g4 = 0; g4 < 4; ++g4) {
                    u32x2 wv; wv.x = cvt_pk(o[db][4 * g4 + 0] * sc, o[db][4 * g4 + 1] * sc); wv.y = cvt_pk(o[db][4 * g4 + 2] * sc, o[db][4 * g4 + 3] * sc);
                    *(u32x2*)(op + 32 * db + 8 * g4) = wv;
                }
        }
    }
#undef ATT_TILE
#undef ATT_LOAD
#undef ATT_STAGE
    __syncthreads();
}

__device__ __forceinline__ void phase_hy_gate(const Ctx& C, const bf16_t* Pm, const float* cw, const float* cb, bf16_t* X0, bf16_t* ZTp, bf16_t* ZTs) {
    const int tid = C.tid;
    LAS bf16_t* zs = (LAS bf16_t*)C.lds;
    u32x4 ld[3][3];
#define HG_LOAD(it_) do { const bool smp_ = (it_) >= 2048; const int q_ = smp_ ? (it_) - 2048 : (it_); const int cbk_ = q_ & 31, tb_ = smp_ ? (q_ >> 5) & 15 : (q_ >> 5) & 3, b_ = smp_ ? q_ >> 9 : q_ >> 7; \
        const int L_ = smp_ ? 1024 : 256, R0_ = smp_ ? MP + b_ * 1024 : b_ * 256; const int t_ = tb_ * 64 + (tid >> 3), c0_ = cbk_ * 64 + 8 * (tid & 7); \
        _Pragma("unroll") for (int g = 0; g < 3; ++g) { const bf16_t* pr_ = Pm + (size_t)(R0_ + t_) * 6144 + g * D + c0_; \
            ld[g][0] = *(const u32x4*)(pr_ - (t_ > 0 ? 6144 : 0)); ld[g][2] = *(const u32x4*)(pr_ + (t_ < L_ - 1 ? 6144 : 0)); ld[g][1] = *(const u32x4*)pr_; } } while (0)
    f32x2 tw[3][4][4];
    int cur_cbk = -1;
    int it = C.bid;
    if (it < 6144) HG_LOAD(it);
    for (; it < 6144; it += C.G) {
        const bool smp = it >= 2048; const int q = smp ? it - 2048 : it;
        const int cbk = q & 31, tb = smp ? (q >> 5) & 15 : (q >> 5) & 3, b = smp ? q >> 9 : q >> 7;
        const int L = smp ? 1024 : 256, R0 = smp ? MP + b * 1024 : b * 256, NB = smp ? 8 : 16;
        const int tl = tid >> 3, c8 = tid & 7, t = tb * 64 + tl, c0 = cbk * 64 + 8 * c8;
        if (cbk != cur_cbk) { cur_cbk = cbk;
#pragma unroll
            for (int g = 0; g < 3; ++g)
#pragma unroll
                for (int j = 0; j < 4; ++j) { const int gc = g * D + c0 + 2 * j; tw[g][j][0] = *(const f32x2*)(cw + gc); tw[g][j][1] = *(const f32x2*)(cw + 6144 + gc); tw[g][j][2] = *(const f32x2*)(cw + 12288 + gc); tw[g][j][3] = *(const f32x2*)(cb + gc); } }
        float u[3][8];
        { const unsigned mk0 = t > 0 ? 0xffffffffu : 0u, mk1 = t < L - 1 ? 0xffffffffu : 0u;
#pragma unroll
          for (int g = 0; g < 3; ++g) {
            const unsigned a[4] = {ld[g][0].x & mk0, ld[g][0].y & mk0, ld[g][0].z & mk0, ld[g][0].w & mk0}, bq[4] = {ld[g][1].x, ld[g][1].y, ld[g][1].z, ld[g][1].w}, cq[4] = {ld[g][2].x & mk1, ld[g][2].y & mk1, ld[g][2].z & mk1, ld[g][2].w & mk1};
#pragma unroll
            for (int j = 0; j < 4; ++j) {
                const f32x2 w0 = tw[g][j][0], w1 = tw[g][j][1], w2 = tw[g][j][2], bb = tw[g][j][3];
                u[g][2 * j] = bflo(a[j]) * w0.x + bflo(bq[j]) * w1.x + bflo(cq[j]) * w2.x + bb.x;
                u[g][2 * j + 1] = bfhi(a[j]) * w0.y + bfhi(bq[j]) * w1.y + bfhi(cq[j]) * w2.y + bb.y;
            }
          } }
        { const int itn = it + C.G; if (itn < 6144) HG_LOAD(itn); }
        asm volatile("" ::: "memory");
        { u32x4 o; o.x = cvt_pk(u[0][0], u[0][1]); o.y = cvt_pk(u[0][2], u[0][3]); o.z = cvt_pk(u[0][4], u[0][5]); o.w = cvt_pk(u[0][6], u[0][7]);
          *(u32x4*)(X0 + (size_t)(R0 + t) * D + c0) = o; }
        __syncthreads();
#pragma unroll
        for (int j = 0; j < 8; ++j) zs[(8 * c8 + j) * 72 + tl] = (bf16_t)(cvt_pk(u[2][j] * u[1][j], 0.f) & 0xffffu);
        __syncthreads();
        { const int cl = tid >> 3, t8 = tid & 7;
          const u32x4 o = *(const LAS u32x4*)(zs + cl * 72 + 8 * t8);
          bf16_t* ZT = smp ? ZTs : ZTp;
          *(u32x4*)(ZT + ((size_t)(cbk * 64 + cl) * NB + b) * L + tb * 64 + 8 * t8) = o; }
    }
#undef HG_LOAD
    __syncthreads();
}

template <int L, int NB>
__device__ __forceinline__ void phase_hy_conv(const Ctx& C, const bf16_t* FG, const bf16_t* ZT, bf16_t* YT) {
    constexpr int WPC = L / 256, CPB = 8 / WPC, NS = L / 32, ROW = 2 * L + 64, UNITS = L / 4, COPYB = UNITS * 16, CHB = 8 * COPYB;
    constexpr int NH = NS > 16 ? NS / 16 : 1, JH = NS / NH;
    const int lane = C.lane, w = C.wave, ch_local = w / WPC, w4 = w % WPC, r = lane & 15, q = lane >> 4;
    for (int it = C.bid; it < 2048 / CPB; it += C.G) {
        const int c = it * CPB + ch_local;
        __syncthreads();
        {
            const int tcid = w4 * 64 + lane;
            const bf16_t* frow = FG + (size_t)c * ROW;
            for (int x = tcid; x < UNITS; x += 64 * WPC) {
                const u32x4 d0 = *(const u32x4*)(frow + 8 * x), d1 = *(const u32x4*)(frow + 8 * x + 8);
                const unsigned dd[8] = {d0.x, d0.y, d0.z, d0.w, d1.x, d1.y, d1.z, d1.w};
#pragma unroll
                for (int k = 0; k < 8; ++k) {
                    u32x4 o;
                    if ((k & 1) == 0) { o.x = dd[k / 2]; o.y = dd[k / 2 + 1]; o.z = dd[k / 2 + 2]; o.w = dd[k / 2 + 3]; }
                    else { const int b0 = (k - 1) / 2;
                        o.x = (dd[b0] >> 16) | (dd[b0 + 1] << 16); o.y = (dd[b0 + 1] >> 16) | (dd[b0 + 2] << 16); o.z = (dd[b0 + 2] >> 16) | (dd[b0 + 3] << 16); o.w = (dd[b0 + 3] >> 16) | (dd[b0 + 4] << 16); }
                    *(LAS u32x4*)(C.lds + ch_local * CHB + k * COPYB + x * 16) = o;
                }
            }
        }
        __syncthreads();
        f32x4 acc[16];
        { const float z0 = opaque_zero();
#pragma unroll
        for (int i = 0; i < 16; ++i) acc[i] = (f32x4){z0, z0, z0, z0}; }
        const bf16_t* zrow = ZT + ((size_t)c * NB + (r % NB)) * L + 8 * q;
        const LAS unsigned char* abase = C.lds + ch_local * CHB + (7 - (r & 7)) * COPYB + ((L - 8) / 8 - (r >> 3) + q - 32 * w4) * 16;
#pragma unroll
        for (int hh = 0; hh < NH; ++hh) {
            bf16x8 bf[JH];
#pragma unroll
            for (int j = 0; j < JH; ++j) bf[j] = *(const bf16x8*)(zrow + 32 * (hh * JH + j));
#pragma unroll
            for (int e = -2 * (hh * JH + JH - 1); e <= 15 - 2 * (hh * JH); ++e) {
                const bf16x8 a = *(const LAS bf16x8*)(abase - 32 * e);
#pragma unroll
                for (int j = 0; j < JH; ++j) { const int il = e + 2 * (hh * JH + j);
                    if (il >= 0 && il < 16) asm volatile("v_mfma_f32_16x16x32_bf16 %0, %1, %2, %0" : "+v"(acc[il]) : "v"(a), "v"(bf[j])); }
                asm volatile("" :: "v"(a));
            }
#pragma unroll
            for (int j = 0; j < JH; ++j) asm volatile("" :: "v"(bf[j]));
        }
        asm volatile("s_nop 15\n\ts_nop 15" : "+v"(acc[0]), "+v"(acc[1]), "+v"(acc[2]), "+v"(acc[3]), "+v"(acc[4]), "+v"(acc[5]), "+v"(acc[6]), "+v"(acc[7]));
        asm volatile("" : "+v"(acc[8]), "+v"(acc[9]), "+v"(acc[10]), "+v"(acc[11]), "+v"(acc[12]), "+v"(acc[13]), "+v"(acc[14]), "+v"(acc[15]));
        if (r < NB) {
            bf16_t* yrow = YT + ((size_t)c * NB + r) * L + 256 * w4 + 4 * q;
#pragma unroll
            for (int i = 0; i < 16; ++i) { u32x2 o; o.x = cvt_pk(acc[i][0], acc[i][1]); o.y = cvt_pk(acc[i][2], acc[i][3]);
#if defined(MK_CONV_VARIANT) && MK_CONV_VARIANT == 1
                { const u32x4 zz = *(const u32x4*)(zrow + 32 * (i & 7)); o.x = zz.x; o.y = zz.y; }
#elif defined(MK_CONV_VARIANT) && MK_CONV_VARIANT == 2
                { const u32x4 aa = *(const LAS u32x4*)(abase - 32 * (i - 8)); o.x = aa.x; o.y = aa.w; }
#endif
                *(u32x2*)(yrow + 16 * i) = o; }
        }
    }
    __syncthreads();
}

__device__ __forceinline__ void phase_hy_out(const Ctx& C, const bf16_t* YTp, const bf16_t* YTs, const bf16_t* X0, bf16_t* Om) {
    const int tid = C.tid;
    LAS bf16_t* ys = (LAS bf16_t*)C.lds;
    u32x4 v, xv;
#define HO_LOAD(it_) do { const bool smp_ = (it_) >= 2048; const int q_ = smp_ ? (it_) - 2048 : (it_); const int cbk_ = q_ & 31, tb_ = smp_ ? (q_ >> 5) & 15 : (q_ >> 5) & 3, b_ = smp_ ? q_ >> 9 : q_ >> 7; \
        const int L_ = smp_ ? 1024 : 256, R0_ = smp_ ? MP + b_ * 1024 : b_ * 256, NB_ = smp_ ? 8 : 16; const bf16_t* YT_ = smp_ ? YTs : YTp; \
        v = *(const u32x4*)(YT_ + ((size_t)(cbk_ * 64 + (tid >> 3)) * NB_ + b_) * L_ + tb_ * 64 + 8 * (tid & 7)); \
        xv = *(const u32x4*)(X0 + (size_t)(R0_ + tb_ * 64 + (tid >> 3)) * D + cbk_ * 64 + 8 * (tid & 7)); } while (0)
    int it = C.bid;
    if (it < 6144) HO_LOAD(it);
    for (; it < 6144; it += C.G) {
        const bool smp = it >= 2048; const int q = smp ? it - 2048 : it;
        const int cbk = q & 31, tb = smp ? (q >> 5) & 15 : (q >> 5) & 3, b = smp ? q >> 9 : q >> 7;
        const int R0 = smp ? MP + b * 1024 : b * 256;
        __syncthreads();
        { const int cl = tid >> 3, t8 = tid & 7;
          const unsigned pv[4] = {v.x, v.y, v.z, v.w};
#pragma unroll
          for (int j = 0; j < 4; ++j) { ys[(8 * t8 + 2 * j) * 72 + cl] = (bf16_t)(pv[j] & 0xffffu); ys[(8 * t8 + 2 * j + 1) * 72 + cl] = (bf16_t)(pv[j] >> 16); } }
        __syncthreads();
        { const int tl = tid >> 3, c8 = tid & 7; const size_t off = (size_t)(R0 + tb * 64 + tl) * D + cbk * 64 + 8 * c8;
          const u32x4 yv = *(const LAS u32x4*)(ys + tl * 72 + 8 * c8);
          const unsigned py[4] = {yv.x, yv.y, yv.z, yv.w}, px[4] = {xv.x, xv.y, xv.z, xv.w}; u32x4 o;
          o.x = cvt_pk(bflo(py[0]) * bflo(px[0]), bfhi(py[0]) * bfhi(px[0])); o.y = cvt_pk(bflo(py[1]) * bflo(px[1]), bfhi(py[1]) * bfhi(px[1]));
          o.z = cvt_pk(bflo(py[2]) * bflo(px[2]), bfhi(py[2]) * bfhi(px[2])); o.w = cvt_pk(bflo(py[3]) * bflo(px[3]), bfhi(py[3]) * bfhi(px[3]));
          const int itn = it + C.G;
          if (itn < 6144) HO_LOAD(itn);
          asm volatile("" ::: "memory");
          *(u32x4*)(Om + off) = o; }
    }
#undef HO_LOAD
    __syncthreads();
}

__device__ __forceinline__ void phase_rw_mix(const Ctx& C, const bf16_t* H, const float* mu, bf16_t* XM) {
    const int gw = C.bid * 8 + C.wave, NGW = C.G * 8, lane = C.lane;
#pragma unroll 1
    for (int ch = 0; ch < 4; ++ch) {
        const int c0 = 8 * (lane + 64 * ch);
        f32x4 mv[6][2];
#pragma unroll
        for (int s = 0; s < 6; ++s) { const int mi = s == 0 ? 0 : s == 1 ? 2 : s == 2 ? 3 : s == 3 ? 1 : s; mv[s][0] = *(const f32x4*)(mu + mi * D + c0); mv[s][1] = *(const f32x4*)(mu + mi * D + c0 + 4); }
        u32x4 a, b, c;
#define MX_LOAD(m_) do { const int t_ = (m_) < MP ? ((m_) & 255) : (((m_) - MP) & 1023), L_ = (m_) < MP ? 256 : 1024; const bf16_t* hp_ = H + (size_t)(m_) * D + c0; \
            a = *(const u32x4*)(hp_ - (t_ > 0 ? D : 0)); c = *(const u32x4*)(hp_ + (t_ < L_ - 1 ? D : 0)); b = *(const u32x4*)hp_; } while (0)
        int m = gw;
        if (m < MT) MX_LOAD(m);
        for (; m < MT; m += NGW) {
            const int t = m < MP ? (m & 255) : ((m - MP) & 1023), L = m < MP ? 256 : 1024;
            const unsigned mk0 = t > 0 ? 0xffffffffu : 0u, mk1 = t < L - 1 ? 0xffffffffu : 0u;
            const unsigned pa[4] = {a.x & mk0, a.y & mk0, a.z & mk0, a.w & mk0}, pb[4] = {b.x, b.y, b.z, b.w}, pc[4] = {c.x & mk1, c.y & mk1, c.z & mk1, c.w & mk1};
            float hv[8], xx[8];
#pragma unroll
            for (int j = 0; j < 4; ++j) { hv[2 * j] = bflo(pb[j]); hv[2 * j + 1] = bfhi(pb[j]);
                xx[2 * j] = 0.5f * (bflo(pa[j]) + bflo(pc[j])) - hv[2 * j]; xx[2 * j + 1] = 0.5f * (bfhi(pa[j]) + bfhi(pc[j])) - hv[2 * j + 1]; }
            u32x4 o[6];
#pragma unroll
            for (int s = 0; s < 6; ++s) {
                const f32x4 m0 = mv[s][0], m1 = mv[s][1];
                o[s].x = cvt_pk(hv[0] + xx[0] * m0.x, hv[1] + xx[1] * m0.y); o[s].y = cvt_pk(hv[2] + xx[2] * m0.z, hv[3] + xx[3] * m0.w);
                o[s].z = cvt_pk(hv[4] + xx[4] * m1.x, hv[5] + xx[5] * m1.y); o[s].w = cvt_pk(hv[6] + xx[6] * m1.z, hv[7] + xx[7] * m1.w);
            }
            const int mn = m + NGW;
            if (mn < MT) MX_LOAD(mn);
            asm volatile("" ::: "memory");
#pragma unroll
            for (int s = 0; s < 6; ++s) *(u32x4*)(XM + ((size_t)s * MT + m) * D + c0) = o[s];
        }
#undef MX_LOAD
    }
}

__device__ __forceinline__ float dpp_xor1(float x) { return __int_as_float(__builtin_amdgcn_update_dpp(0, __float_as_int(x), 0xB1, 0xF, 0xF, true)); }
__device__ __forceinline__ float dpp_xor2(float x) { return __int_as_float(__builtin_amdgcn_update_dpp(0, __float_as_int(x), 0x4E, 0xF, 0xF, true)); }

constexpr int SC_STEP = 6 * 64;
template <int R, int SC_TS>
__device__ __forceinline__ void rw_scan_task(LAS float* buf, int lane, const bf16_t* Rm, const bf16_t* Km, const bf16_t* Vm, const bf16_t* LD, const bf16_t* LA,
                                             const float* k_k, const float* k_a, const float* invsq, const float* state_in, bf16_t* YB, float* state_out, bool smp, int b, int head, int dir, int half) {
    const int rg = lane >> 2, kq = lane & 3;
    const int L = smp ? 1024 : 256, R0 = smp ? MP + b * 1024 : b * 256;
    const int row0 = half * (16 * R) + R * rg;
    f32x2 S[R][8];
    if (smp) {
        const float* sp = state_in + ((size_t)(b * 2 + dir) * 32 + head) * 4096 + row0 * 64 + 16 * kq;
#pragma unroll
        for (int rr = 0; rr < R; ++rr)
#pragma unroll
            for (int j4 = 0; j4 < 4; ++j4) { const f32x4 v = *(const f32x4*)(sp + rr * 64 + 4 * j4); S[rr][2 * j4] = (f32x2){v.x, v.y}; S[rr][2 * j4 + 1] = (f32x2){v.z, v.w}; }
    } else {
#pragma unroll
        for (int rr = 0; rr < R; ++rr)
#pragma unroll
            for (int j = 0; j < 8; ++j) S[rr][j] = (f32x2){0.f, 0.f};
    }
    const int ch = head * 64 + lane; const size_t hbase = (size_t)head * MT * 64 + lane;
    const float kkc = k_k[ch], kac = k_a[ch];
    const bf16_t* ldp = LD + (size_t)dir * MT * D; const bf16_t* lap = LA + (size_t)dir * MT * D;
    bf16_t* yb = YB + (size_t)dir * MT * D;
    bf16_t pr[SC_TS], pk[SC_TS], pv[SC_TS], pl[SC_TS], pa[SC_TS], qr[SC_TS], qk[SC_TS], qv[SC_TS], ql[SC_TS], qa[SC_TS];
    const int tstart = dir ? L - 1 : 0, tstep = dir ? -1 : 1;
    const int NCH = L / SC_TS;
#define SC_PREFETCH(c) do { _Pragma("unroll") for (int s_ = 0; s_ < SC_TS; ++s_) { const size_t o_ = hbase + (size_t)(R0 + tstart + tstep * ((c) * SC_TS + s_)) * 64; pr[s_] = Rm[o_]; pk[s_] = Km[o_]; pv[s_] = Vm[o_]; pl[s_] = ldp[o_]; pa[s_] = lap[o_]; } } while (0)
#define SC_DERIVE(s_, bufp) do { const float r_ = bf2f(pr[s_]), k_ = bf2f(pk[s_]), v_ = bf2f(pv[s_]), ld_ = bf2f(pl[s_]), a_ = fsigmoid(bf2f(pa[s_])); \
        const float kr_ = k_ * kkc; const float kk_ = kr_ * __builtin_amdgcn_rsqf(wave_sum(kr_ * kr_) + 1e-12f); \
        const unsigned sa_ = (unsigned)(unsigned long)((bufp) + (s_) * SC_STEP) + 4u * (unsigned)lane;     \
        asm volatile("ds_write_b32 %0, %1" :: "v"(sa_), "v"(fexp(ld_))); asm volatile("ds_write_b32 %0, %1 offset:256" :: "v"(sa_), "v"(kk_ * a_)); \
        asm volatile("ds_write_b32 %0, %1 offset:512" :: "v"(sa_), "v"(k_ * (1.0f + (a_ - 1.0f) * kac))); asm volatile("ds_write_b32 %0, %1 offset:768" :: "v"(sa_), "v"(-kk_)); \
        asm volatile("ds_write_b32 %0, %1 offset:1024" :: "v"(sa_), "v"(r_)); asm volatile("ds_write_b32 %0, %1 offset:1280" :: "v"(sa_), "v"(v_)); } while (0)
#define SC_PREFETCH2(c) do { _Pragma("unroll") for (int s_ = 0; s_ < SC_TS; ++s_) { const size_t o_ = hbase + (size_t)(R0 + tstart + tstep * ((c) * SC_TS + s_)) * 64; qr[s_] = Rm[o_]; qk[s_] = Km[o_]; qv[s_] = Vm[o_]; ql[s_] = ldp[o_]; qa[s_] = lap[o_]; } } while (0)
    SC_PREFETCH(0);
#pragma unroll
    for (int s = 0; s < SC_TS; ++s) SC_DERIVE(s, buf);
    asm volatile("s_waitcnt lgkmcnt(0)" ::: "memory");
    SC_PREFETCH(1);
    SC_PREFETCH2(2);
#define SC_DERIVE_Q(s_, bufp) do { const float r_ = bf2f(qr[s_]), k_ = bf2f(qk[s_]), v_ = bf2f(qv[s_]), ld_ = bf2f(ql[s_]), a_ = fsigmoid(bf2f(qa[s_])); \
        const float kr_ = k_ * kkc; const float kk_ = kr_ * __builtin_amdgcn_rsqf(wave_sum(kr_ * kr_) + 1e-12f); \
        const unsigned sa_ = (unsigned)(unsigned long)((bufp) + (s_) * SC_STEP) + 4u * (unsigned)lane; \
        asm volatile("ds_write_b32 %0, %1" :: "v"(sa_), "v"(fexp(ld_))); asm volatile("ds_write_b32 %0, %1 offset:256" :: "v"(sa_), "v"(kk_ * a_)); \
        asm volatile("ds_write_b32 %0, %1 offset:512" :: "v"(sa_), "v"(k_ * (1.0f + (a_ - 1.0f) * kac))); asm volatile("ds_write_b32 %0, %1 offset:768" :: "v"(sa_), "v"(-kk_)); \
        asm volatile("ds_write_b32 %0, %1 offset:1024" :: "v"(sa_), "v"(r_)); asm volatile("ds_write_b32 %0, %1 offset:1280" :: "v"(sa_), "v"(v_)); } while (0)
    LAS float* const buf0 = buf; LAS float* const buf1 = buf + SC_TS * SC_STEP;
    for (int cix = 0; cix < NCH; cix += 2) {
#pragma unroll
        for (int s = 0; s < SC_TS; ++s) {
            SC_DERIVE(s, buf1);
            if (cix + 3 < NCH) { const size_t o_ = hbase + (size_t)(R0 + tstart + tstep * ((cix + 3) * SC_TS + s)) * 64; pr[s] = Rm[o_]; pk[s] = Km[o_]; pv[s] = Vm[o_]; pl[s] = ldp[o_]; pa[s] = lap[o_]; }
#define BC_ buf0
#define CX_ cix
            const LAS float* sb = BC_ + s * SC_STEP;
            f32x2 w2[8], b2[8], d2[8], n2[8], r2[8];
#pragma unroll
            for (int j4 = 0; j4 < 4; ++j4) { const f32x4 nv = *(const LAS f32x4*)(sb + 192 + 16 * kq + 4 * j4); n2[2 * j4] = (f32x2){nv.x, nv.y}; n2[2 * j4 + 1] = (f32x2){nv.z, nv.w}; }
#pragma unroll
            for (int j4 = 0; j4 < 4; ++j4) {
                const f32x4 bv = *(const LAS f32x4*)(sb + 64 + 16 * kq + 4 * j4), dv = *(const LAS f32x4*)(sb + 128 + 16 * kq + 4 * j4), wv = *(const LAS f32x4*)(sb + 16 * kq + 4 * j4), rv = *(const LAS f32x4*)(sb + 256 + 16 * kq + 4 * j4);
                w2[2 * j4] = (f32x2){wv.x, wv.y}; w2[2 * j4 + 1] = (f32x2){wv.z, wv.w}; b2[2 * j4] = (f32x2){bv.x, bv.y}; b2[2 * j4 + 1] = (f32x2){bv.z, bv.w};
                d2[2 * j4] = (f32x2){dv.x, dv.y}; d2[2 * j4 + 1] = (f32x2){dv.z, dv.w}; r2[2 * j4] = (f32x2){rv.x, rv.y}; r2[2 * j4 + 1] = (f32x2){rv.z, rv.w};
            }
            float vrow[R];
            if (R == 4) { const f32x4 vv = *(const LAS f32x4*)(sb + 320 + row0); vrow[0] = vv.x; vrow[R > 1 ? 1 : 0] = vv.y; vrow[R > 2 ? R - 2 : 0] = vv.z; vrow[R - 1] = vv.w; }
            else if (R == 2) { const f32x2 vv = *(const LAS f32x2*)(sb + 320 + row0); vrow[0] = vv.x; vrow[R - 1] = vv.y; }
            else vrow[0] = sb[320 + row0];
            float y[R];
#pragma unroll
            for (int rr = 0; rr < R; ++rr) {
                f32x2 a0 = S[rr][0] * n2[0], a1 = S[rr][1] * n2[1];
#pragma unroll
                for (int j = 2; j < 8; j += 2) { a0 = S[rr][j] * n2[j] + a0; a1 = S[rr][j + 1] * n2[j + 1] + a1; }
                a0 = a0 + a1;
                float sa = a0.x + a0.y; sa += dpp_xor1(sa); sa += dpp_xor2(sa);
                const f32x2 sa2 = (f32x2){sa, sa}, vr2 = (f32x2){vrow[rr], vrow[rr]};
                f32x2 y0 = (f32x2){0.f, 0.f}, y1 = (f32x2){0.f, 0.f};
#pragma unroll
                for (int j = 0; j < 8; j += 2) {
                    S[rr][j] = S[rr][j] * w2[j] + (sa2 * b2[j] + vr2 * d2[j]);
                    S[rr][j + 1] = S[rr][j + 1] * w2[j + 1] + (sa2 * b2[j + 1] + vr2 * d2[j + 1]);
                    y0 = S[rr][j] * r2[j] + y0; y1 = S[rr][j + 1] * r2[j + 1] + y1;
                }
                y0 = y0 + y1;
                float yy = y0.x + y0.y; yy += dpp_xor1(yy); yy += dpp_xor2(yy); y[rr] = yy;
            }
            {
                const int t = tstart + tstep * ((CX_) * SC_TS + s); bf16_t* yp = yb + (size_t)(R0 + t) * D + head * 64;
                if (R == 4) { const float ys = kq == 0 ? y[0] : kq == 1 ? y[R > 1 ? 1 : 0] : kq == 2 ? y[R > 2 ? R - 2 : 0] : y[R - 1]; yp[lane] = (bf16_t)cvt_pk(ys, ys); }
                else if (R == 2) { const float ys = (kq & 1) ? y[R - 1] : y[0]; yp[half * 32 + 2 * rg + (kq & 1)] = (bf16_t)cvt_pk(ys, ys); }
                else yp[row0] = (bf16_t)cvt_pk(y[0], y[0]);
            }
#undef BC_
#undef CX_
        }
        asm volatile("s_waitcnt lgkmcnt(0)" ::: "memory");
#pragma unroll
        for (int s = 0; s < SC_TS; ++s) {
            SC_DERIVE_Q(s, buf0);
            if (cix + 4 < NCH) { const size_t o_ = hbase + (size_t)(R0 + tstart + tstep * ((cix + 4) * SC_TS + s)) * 64; qr[s] = Rm[o_]; qk[s] = Km[o_]; qv[s] = Vm[o_]; ql[s] = ldp[o_]; qa[s] = lap[o_]; }
#define BC_ buf1
#define CX_ (cix + 1)
            const LAS float* sb = BC_ + s * SC_STEP;
            f32x2 w2[8], b2[8], d2[8], n2[8], r2[8];
#pragma unroll
            for (int j4 = 0; j4 < 4; ++j4) { const f32x4 nv = *(const LAS f32x4*)(sb + 192 + 16 * kq + 4 * j4); n2[2 * j4] = (f32x2){nv.x, nv.y}; n2[2 * j4 + 1] = (f32x2){nv.z, nv.w}; }
#pragma unroll
            for (int j4 = 0; j4 < 4; ++j4) {
                const f32x4 bv = *(const LAS f32x4*)(sb + 64 + 16 * kq + 4 * j4), dv = *(const LAS f32x4*)(sb + 128 + 16 * kq + 4 * j4), wv = *(const LAS f32x4*)(sb + 16 * kq + 4 * j4), rv = *(const LAS f32x4*)(sb + 256 + 16 * kq + 4 * j4);
                w2[2 * j4] = (f32x2){wv.x, wv.y}; w2[2 * j4 + 1] = (f32x2){wv.z, wv.w}; b2[2 * j4] = (f32x2){bv.x, bv.y}; b2[2 * j4 + 1] = (f32x2){bv.z, bv.w};
                d2[2 * j4] = (f32x2){dv.x, dv.y}; d2[2 * j4 + 1] = (f32x2){dv.z, dv.w}; r2[2 * j4] = (f32x2){rv.x, rv.y}; r2[2 * j4 + 1] = (f32x2){rv.z, rv.w};
            }
            float vrow[R];
            if (R == 4) { const f32x4 vv = *(const LAS f32x4*)(sb + 320 + row0); vrow[0] = vv.x; vrow[R > 1 ? 1 : 0] = vv.y; vrow[R > 2 ? R - 2 : 0] = vv.z; vrow[R - 1] = vv.w; }
            else if (R == 2) { const f32x2 vv = *(const LAS f32x2*)(sb + 320 + row0); vrow[0] = vv.x; vrow[R - 1] = vv.y; }
            else vrow[0] = sb[320 + row0];
            float y[R];
#pragma unroll
            for (int rr = 0; rr < R; ++rr) {
                f32x2 a0 = S[rr][0] * n2[0], a1 = S[rr][1] * n2[1];
#pragma unroll
                for (int j = 2; j < 8; j += 2) { a0 = S[rr][j] * n2[j] + a0; a1 = S[rr][j + 1] * n2[j + 1] + a1; }
                a0 = a0 + a1;
                float sa = a0.x + a0.y; sa += dpp_xor1(sa); sa += dpp_xor2(sa);
                const f32x2 sa2 = (f32x2){sa, sa}, vr2 = (f32x2){vrow[rr], vrow[rr]};
                f32x2 y0 = (f32x2){0.f, 0.f}, y1 = (f32x2){0.f, 0.f};
#pragma unroll
                for (int j = 0; j < 8; j += 2) {
                    S[rr][j] = S[rr][j] * w2[j] + (sa2 * b2[j] + vr2 * d2[j]);
                    S[rr][j + 1] = S[rr][j + 1] * w2[j + 1] + (sa2 * b2[j + 1] + vr2 * d2[j + 1]);
                    y0 = S[rr][j] * r2[j] + y0; y1 = S[rr][j + 1] * r2[j + 1] + y1;
                }
                y0 = y0 + y1;
                float yy = y0.x + y0.y; yy += dpp_xor1(yy); yy += dpp_xor2(yy); y[rr] = yy;
            }
            {
                const int t = tstart + tstep * ((CX_) * SC_TS + s); bf16_t* yp = yb + (size_t)(R0 + t) * D + head * 64;
                if (R == 4) { const float ys = kq == 0 ? y[0] : kq == 1 ? y[R > 1 ? 1 : 0] : kq == 2 ? y[R > 2 ? R - 2 : 0] : y[R - 1]; yp[lane] = (bf16_t)cvt_pk(ys, ys); }
                else if (R == 2) { const float ys = (kq & 1) ? y[R - 1] : y[0]; yp[half * 32 + 2 * rg + (kq & 1)] = (bf16_t)cvt_pk(ys, ys); }
                else yp[row0] = (bf16_t)cvt_pk(y[0], y[0]);
            }
#undef BC_
#undef CX_
        }
        asm volatile("s_waitcnt lgkmcnt(0)" ::: "memory");
    }
#undef SC_DERIVE_Q
#undef SC_PREFETCH
#undef SC_PREFETCH2
#undef SC_DERIVE
    if (!smp) {
        float* sp = state_out + ((size_t)(b * 2 + dir) * 32 + head) * 4096 + row0 * 64 + 16 * kq;
#pragma unroll
        for (int rr = 0; rr < R; ++rr)
#pragma unroll
            for (int j4 = 0; j4 < 4; ++j4) *(f32x4*)(sp + rr * 64 + 4 * j4) = (f32x4){S[rr][2 * j4].x, S[rr][2 * j4].y, S[rr][2 * j4 + 1].x, S[rr][2 * j4 + 1].y};
    }
}
__device__ __forceinline__ void phase_rw_scan(const Ctx& C, const bf16_t* Rm, const bf16_t* Km, const bf16_t* Vm, const bf16_t* LD, const bf16_t* LA,
                                              const float* k_k, const float* k_a, const float* invsq, const float* state_in, bf16_t* YB, float* state_out) {
    const int lane = C.lane, w = C.wave;
    LAS float* buf = (LAS float*)(C.lds + (w < 4 ? w * 24576 : 98304 + (w - 4) * 12288));
    if (w < 4) { for (int slot = C.bid * 4 + w; slot < 1024; slot += C.G * 4) { const int id = slot >> 1; rw_scan_task<2, 8>(buf, lane, Rm, Km, Vm, LD, LA, k_k, k_a, invsq, state_in, YB, state_out, true, id >> 6, (id >> 1) & 31, id & 1, slot & 1); } }
    else { for (int id = C.bid * 4 + (w - 4); id < 1024; id += C.G * 4) rw_scan_task<4, 4>(buf, lane, Rm, Km, Vm, LD, LA, k_k, k_a, invsq, state_in, YB, state_out, false, id >> 6, (id >> 1) & 31, id & 1, 0); }
    if (w >= 4) late_transposes(C, buf, C.bid * 4 + (w - 4), C.G * 4);
    __syncthreads();
}

__device__ __forceinline__ float head8_sum(float v) { v = DPP_ADD(v, 0xB1); v = DPP_ADD(v, 0x4E); v = DPP_ADD(v, 0x141); return v; }
__device__ __forceinline__ void phase_rw_post(const Ctx& C, const bf16_t* YB, const bf16_t* Rm, const bf16_t* Km, const bf16_t* Vm, const bf16_t* LA, const bf16_t* Gt,
                                              const float* k_a, const float* r_k, const float* ln_w, const float* ln_b, bf16_t* Om) {
    const int gw = C.bid * 8 + C.wave, NGW = C.G * 8, lane = C.lane;
#pragma unroll 1
    for (int ch = 0; ch < 4; ++ch) {
        const int c0 = 8 * (lane + 64 * ch);
        const f32x4 ka0 = *(const f32x4*)(k_a + c0), ka1 = *(const f32x4*)(k_a + c0 + 4), rk0 = *(const f32x4*)(r_k + c0), rk1 = *(const f32x4*)(r_k + c0 + 4);
        const f32x4 lw0 = *(const f32x4*)(ln_w + c0), lw1 = *(const f32x4*)(ln_w + c0 + 4), lb0 = *(const f32x4*)(ln_b + c0), lb1 = *(const f32x4*)(ln_b + c0 + 4);
        u32x4 yfw, ybw, rr, kk, vv, gg, l0, l1;
#define PO_LOAD(m_) do { const size_t o_ = (size_t)(m_) * D + c0; const size_t oh_ = hm_index((m_), c0); yfw = *(const u32x4*)(YB + o_); ybw = *(const u32x4*)(YB + (size_t)MT * D + o_); \
            rr = *(const u32x4*)(Rm + oh_); kk = *(const u32x4*)(Km + oh_); vv = *(const u32x4*)(Vm + oh_); gg = *(const u32x4*)(Gt + o_); l0 = *(const u32x4*)(LA + oh_); l1 = *(const u32x4*)(LA + (size_t)MT * D + oh_); } while (0)
        int m = gw;
        if (m < MT) PO_LOAD(m);
        for (; m < MT; m += NGW) {
            float y[8], r[8], k[8], v[8], g[8], a0[8], a1[8], ka[8], rk[8], lw[8], lb[8];
            const unsigned pyf[4] = {yfw.x, yfw.y, yfw.z, yfw.w}, pyb[4] = {ybw.x, ybw.y, ybw.z, ybw.w}, pr[4] = {rr.x, rr.y, rr.z, rr.w}, pk[4] = {kk.x, kk.y, kk.z, kk.w}, pv[4] = {vv.x, vv.y, vv.z, vv.w}, pg[4] = {gg.x, gg.y, gg.z, gg.w}, p0[4] = {l0.x, l0.y, l0.z, l0.w}, p1[4] = {l1.x, l1.y, l1.z, l1.w};
#pragma unroll
            for (int j = 0; j < 4; ++j) {
                y[2 * j] = bflo(pyf[j]) + bflo(pyb[j]); y[2 * j + 1] = bfhi(pyf[j]) + bfhi(pyb[j]); ka[j] = ka0[j]; ka[4 + j] = ka1[j]; rk[j] = rk0[j]; rk[4 + j] = rk1[j]; lw[j] = lw0[j]; lw[4 + j] = lw1[j]; lb[j] = lb0[j]; lb[4 + j] = lb1[j];
                r[2 * j] = bflo(pr[j]); r[2 * j + 1] = bfhi(pr[j]); k[2 * j] = bflo(pk[j]); k[2 * j + 1] = bfhi(pk[j]); v[2 * j] = bflo(pv[j]); v[2 * j + 1] = bfhi(pv[j]);
                g[2 * j] = bflo(pg[j]); g[2 * j + 1] = bfhi(pg[j]); a0[2 * j] = fsigmoid(bflo(p0[j])); a0[2 * j + 1] = fsigmoid(bfhi(p0[j])); a1[2 * j] = fsigmoid(bflo(p1[j])); a1[2 * j + 1] = fsigmoid(bfhi(p1[j]));
            }
            float s = 0.f, bon = 0.f;
#pragma unroll
            for (int j = 0; j < 8; ++j) { s += y[j]; bon += r[j] * (k[j] * (2.0f + (a0[j] + a1[j] - 2.0f) * ka[j])) * rk[j]; }
            const float mean = head8_sum(s) * (1.0f / 64.0f); bon = head8_sum(bon);
            float q = 0.f;
#pragma unroll
            for (int j = 0; j < 8; ++j) { y[j] -= mean; q += y[j] * y[j]; }
            const float rstd = __builtin_amdgcn_rsqf(head8_sum(q) * (1.0f / 64.0f) + 64e-5f);
            float ov[8];
#pragma unroll
            for (int j = 0; j < 8; ++j) ov[j] = (y[j] * rstd * lw[j] + lb[j] + bon * v[j]) * g[j];
            u32x4 w; w.x = cvt_pk(ov[0], ov[1]); w.y = cvt_pk(ov[2], ov[3]); w.z = cvt_pk(ov[4], ov[5]); w.w = cvt_pk(ov[6], ov[7]);
            const int mn = m + NGW;
            if (mn < MT) PO_LOAD(mn);
            asm volatile("" ::: "memory");
            *(u32x4*)(Om + (size_t)m * D + c0) = w;
        }
#undef PO_LOAD
    }
}

constexpr int NPH = 35;
#define IN(k) (lo <= (k) && (k) < hi)
#define SEAM(k) do { if (IN(k) && IN((k) + 1)) xcd_barrier(bar); } while (0)
#define LDSG ((PG8_LAS unsigned char*)C.lds)
#ifndef MK_REP_MASK
#define MK_REP_MASK 0ull
#endif
#define REPQ(k) (((MK_REP_MASK) >> (k)) & 1ull)

template <class Epi>
__device__ __forceinline__ void run_gemm(const Ctx& C, const bf16_t* A, const bf16_t* Bt, int N, int K, const Epi& E) {
    pg8::Gemm g{A, Bt, MT, N, K, K}; pg8::StaticOrder S; S.init(MT, N, C.G, C.bid);
    pg8::gemm_phase<Epi, pg8::StaticOrder, false>(LDSG, g, S, E, nullptr);
}

#ifndef MK_SPLIT_MASK
#define MK_SPLIT_MASK 15
#endif
#define PREVP1(L) (((L) > 0 && (((MK_SPLIT_MASK) >> ((L) - 1)) & 1)) ? (const bf16_t*)WSP(bf16_t, WS_ARENA + AR_SLAB) : (const bf16_t*)nullptr)
constexpr size_t AR_SLAB = 200 * MiB;
constexpr size_t CTL_SPLIT = 65536;
template <int SET>
__device__ __forceinline__ void run_gemm_split_res(const Ctx& C, const bf16_t* A, const bf16_t* Bt, int K, bf16_t* X, const float* gate_base) {
    pg8::Gemm g{A, Bt, MT, D, K, K / 2}; TailSplitOrder S; S.init(C.G, C.bid, K / 64);
    EpiResidualSplitB E{X, gate_base, WSP(bf16_t, WS_ARENA + AR_SLAB)};
    pg8::gemm_phase<EpiResidualSplitB, TailSplitOrder, false>(LDSG, g, S, E, nullptr);
}
template <int LAYER>
__device__ __forceinline__ void mlp_block(const Ctx& C, const XcdBarrier& bar, int lo, int hi, int b0) {
    bf16_t* X = WSP(bf16_t, WS_X); bf16_t* H = WSP(bf16_t, WS_H); bf16_t* U = WSP(bf16_t, WS_ARENA + AR_U);
    if (IN(b0)) { { phase_norm_mod_b(C, X, karg<I_N2G>() + LAYER * D, LAYER, 3, H); } if (REPQ(b0)) { phase_norm_mod_b(C, X, karg<I_N2G>() + LAYER * D, LAYER, 3, H); } }
    SEAM(b0);
    if (IN(b0 + 1)) { { EpiBf16<1> E{U, FF}; run_gemm(C, H, WSP(bf16_t, WS_W1T) + (size_t)LAYER * D * FF, FF, D, E); } if (REPQ(b0 + 1)) { EpiBf16<1> E{U, FF}; run_gemm(C, H, WSP(bf16_t, WS_W1T) + (size_t)LAYER * D * FF, FF, D, E); } }
    SEAM(b0 + 1);
    if (IN(b0 + 2)) { { if constexpr (((MK_SPLIT_MASK) >> LAYER) & 1) run_gemm_split_res<LAYER>(C, U, WSP(bf16_t, WS_W2T) + (size_t)LAYER * D * FF, FF, X, MODP(LAYER, 0, 5)); else { EpiResidualB<false> E{X, MODP(LAYER, 0, 5), nullptr, nullptr}; run_gemm(C, U, WSP(bf16_t, WS_W2T) + (size_t)LAYER * D * FF, D, FF, E); } } if (REPQ(b0 + 2)) { if constexpr (((MK_SPLIT_MASK) >> LAYER) & 1) run_gemm_split_res<LAYER>(C, U, WSP(bf16_t, WS_W2T) + (size_t)LAYER * D * FF, FF, X, MODP(LAYER, 0, 5)); else { EpiResidualB<false> E{X, MODP(LAYER, 0, 5), nullptr, nullptr}; run_gemm(C, U, WSP(bf16_t, WS_W2T) + (size_t)LAYER * D * FF, D, FF, E); } } }
    SEAM(b0 + 2);
}

template <int LAYER, int J>
__device__ __forceinline__ void attn_layer(const Ctx& C, const XcdBarrier& bar, int lo, int hi, int b0) {
    bf16_t* X = WSP(bf16_t, WS_X); bf16_t* H = WSP(bf16_t, WS_H);
    bf16_t *Q = WSP(bf16_t, WS_ARENA + AR_Q), *Kb = WSP(bf16_t, WS_ARENA + AR_K), *Vb = WSP(bf16_t, WS_ARENA + AR_V), *O = WSP(bf16_t, WS_ARENA + AR_O);
    if (IN(b0)) { { if (LAYER == 0) { phase_fg_transpose(C); phase_norm_mod(C, karg<I_XP>(), karg<I_XS>(), karg<I_N1G>() + LAYER * D, LAYER, 0, H); } else phase_norm_mod_b(C, X, karg<I_N1G>() + LAYER * D, LAYER, 0, H, PREVP1(LAYER), X, 8192); } if (REPQ(b0)) { if (LAYER == 0) { phase_fg_transpose(C); phase_norm_mod(C, karg<I_XP>(), karg<I_XS>(), karg<I_N1G>() + LAYER * D, LAYER, 0, H); } else phase_norm_mod_b(C, X, karg<I_N1G>() + LAYER * D, LAYER, 0, H, PREVP1(LAYER), X, 8192); } }
    SEAM(b0);
    if (IN(b0 + 1)) { { EpiQKV E{Q, Kb, Vb, C.out + OUT_NK + (size_t)J * 256 * 512, C.out + OUT_NV + (size_t)J * 256 * 512}; run_gemm(C, H, WSP(bf16_t, WS_WQKVT) + (size_t)J * D * 3072, 3072, D, E); } if (REPQ(b0 + 1)) { EpiQKV E{Q, Kb, Vb, C.out + OUT_NK + (size_t)J * 256 * 512, C.out + OUT_NV + (size_t)J * 256 * 512}; run_gemm(C, H, WSP(bf16_t, WS_WQKVT) + (size_t)J * D * 3072, 3072, D, E); } }
    SEAM(b0 + 1);
    if (IN(b0 + 2)) { { phase_attention(C, Q, Kb, Vb, WSP(bf16_t, WS_KC) + (size_t)J * 512 * 512, WSP(bf16_t, WS_VC) + (size_t)J * 512 * 512, karg<I_SINK>() + J * 16, O); } if (REPQ(b0 + 2)) { phase_attention(C, Q, Kb, Vb, WSP(bf16_t, WS_KC) + (size_t)J * 512 * 512, WSP(bf16_t, WS_VC) + (size_t)J * 512 * 512, karg<I_SINK>() + J * 16, O); } }
    SEAM(b0 + 2);
    if (IN(b0 + 3)) { { EpiResidualB<LAYER == 0> E{X, MODP(LAYER, 0, 2), LAYER == 0 ? karg<I_XP>() : nullptr, LAYER == 0 ? karg<I_XS>() : nullptr}; run_gemm(C, O, WSP(bf16_t, WS_WOT) + (size_t)J * D * D, D, D, E); } if (REPQ(b0 + 3)) { EpiResidualB<LAYER == 0> E{X, MODP(LAYER, 0, 2), LAYER == 0 ? karg<I_XP>() : nullptr, LAYER == 0 ? karg<I_XS>() : nullptr}; run_gemm(C, O, WSP(bf16_t, WS_WOT) + (size_t)J * D * D, D, D, E); } }
    SEAM(b0 + 3);
    mlp_block<LAYER>(C, bar, lo, hi, b0 + 4);
}

template <int LAYER>
__device__ __forceinline__ void hyena_layer(const Ctx& C, const XcdBarrier& bar, int lo, int hi, int b0) {
    bf16_t* X = WSP(bf16_t, WS_X); bf16_t* H = WSP(bf16_t, WS_H);
    bf16_t *Pm = WSP(bf16_t, WS_ARENA + AR_P), *X0 = WSP(bf16_t, WS_ARENA + AR_X0), *ZT = WSP(bf16_t, WS_ARENA + AR_ZT), *YT = WSP(bf16_t, WS_ARENA + AR_YT), *HO = WSP(bf16_t, WS_ARENA + AR_HO);
    bf16_t *ZTp = ZT, *ZTs = ZT + (size_t)MP * D, *YTp = YT, *YTs = YT + (size_t)MP * D;
    if (IN(b0)) { { phase_norm_mod_b(C, X, karg<I_N1G>() + LAYER * D, LAYER, 0, H, PREVP1(LAYER), X, 8192); } if (REPQ(b0)) { phase_norm_mod_b(C, X, karg<I_N1G>() + LAYER * D, LAYER, 0, H, PREVP1(LAYER), X, 8192); } }
    SEAM(b0);
    if (IN(b0 + 1)) { { EpiBf16<0> E{Pm, 6144}; run_gemm(C, H, WSP(bf16_t, WS_HYINT), 6144, D, E); } if (REPQ(b0 + 1)) { EpiBf16<0> E{Pm, 6144}; run_gemm(C, H, WSP(bf16_t, WS_HYINT), 6144, D, E); } }
    SEAM(b0 + 1);
    if (IN(b0 + 2)) { { phase_hy_gate(C, Pm, karg<I_HYCW>(), karg<I_HYCB>(), X0, ZTp, ZTs); } if (REPQ(b0 + 2)) { phase_hy_gate(C, Pm, karg<I_HYCW>(), karg<I_HYCB>(), X0, ZTp, ZTs); } }
    SEAM(b0 + 2);
    if (IN(b0 + 3)) { { phase_hy_conv<1024, 8>(C, WSP(bf16_t, WS_FGS), ZTs, YTs); phase_hy_conv<256, 16>(C, WSP(bf16_t, WS_FGP), ZTp, YTp); } if (REPQ(b0 + 3)) { phase_hy_conv<1024, 8>(C, WSP(bf16_t, WS_FGS), ZTs, YTs); phase_hy_conv<256, 16>(C, WSP(bf16_t, WS_FGP), ZTp, YTp); } }
    SEAM(b0 + 3);
    if (IN(b0 + 4)) { { phase_hy_out(C, YTp, YTs, X0, HO); } if (REPQ(b0 + 4)) { phase_hy_out(C, YTp, YTs, X0, HO); } }
    SEAM(b0 + 4);
    if (IN(b0 + 5)) { { EpiResidualB<false> E{X, MODP(LAYER, 0, 2), nullptr, nullptr}; run_gemm(C, HO, WSP(bf16_t, WS_HYOUTT), D, D, E); } if (REPQ(b0 + 5)) { EpiResidualB<false> E{X, MODP(LAYER, 0, 2), nullptr, nullptr}; run_gemm(C, HO, WSP(bf16_t, WS_HYOUTT), D, D, E); } }
    SEAM(b0 + 5);
    mlp_block<LAYER>(C, bar, lo, hi, b0 + 6);
}

__device__ __forceinline__ void rw_g2_phase(const Ctx& C, const bf16_t* XM, bf16_t* Rm, bf16_t* A3, bf16_t* LD, bf16_t* LA, bf16_t* Gt) {
    if (C.G == 256 && C.bid >= 240) { pg8::Gemm g{XM, WSP(bf16_t, WS_RWBT), 6 * MT, 27 * 256, D, D}; RwOrder1 S{16, C.bid - 240, 1280, 27 * NPANEL, true}; EpiRw1 E{Rm, A3, karg<I_KK>(), WSP(float, WS_INVSQ)}; pg8::gemm_phase<EpiRw1, RwOrder1, false>(LDSG, g, S, E, nullptr); }
    else { pg8::Gemm g{A3, WSP(bf16_t, WS_LORA2T), 3 * MT, 40 * 256, 256, 256}; RwOrder2 S{C.G == 256 ? 240 : C.G, C.bid, nullptr, 0u}; EpiRw2 E{LD, LA, Gt, karg<I_W0>(), karg<I_A0>()}; pg8::gemm_phase<EpiRw2, RwOrder2, false>(LDSG, g, S, E, nullptr); }
}
template <int LAYER>
__device__ __forceinline__ void rwkv_layer(const Ctx& C, const XcdBarrier& bar, int lo, int hi, int b0) {
    bf16_t* X = WSP(bf16_t, WS_X); bf16_t* H = WSP(bf16_t, WS_H);
    bf16_t *XM = WSP(bf16_t, WS_ARENA + AR_XMIX), *LD = WSP(bf16_t, WS_ARENA + AR_LD), *LA = WSP(bf16_t, WS_ARENA + AR_LA), *Gt = WSP(bf16_t, WS_ARENA + AR_G), *RO = WSP(bf16_t, WS_ARENA + AR_RO);
    bf16_t *Rm = WSP(bf16_t, WS_ARENA + AR_R), *Km = WSP(bf16_t, WS_ARENA + AR_KK), *Vm = WSP(bf16_t, WS_ARENA + AR_VV), *A3 = WSP(bf16_t, WS_ARENA + AR_A3);
    bf16_t* YB = WSP(bf16_t, WS_ARENA + AR_YB);
    if (IN(b0)) { { phase_norm_mod_b(C, X, karg<I_N1G>() + LAYER * D, LAYER, 0, H, PREVP1(LAYER), X, 8192); } if (REPQ(b0)) { phase_norm_mod_b(C, X, karg<I_N1G>() + LAYER * D, LAYER, 0, H, PREVP1(LAYER), X, 8192); } }
    SEAM(b0);
    if (IN(b0 + 1)) { { phase_rw_mix(C, H, karg<I_MU>(), XM); } if (REPQ(b0 + 1)) { phase_rw_mix(C, H, karg<I_MU>(), XM); } }
    SEAM(b0 + 1);
    if (IN(b0 + 2)) { { pg8::Gemm g{XM, WSP(bf16_t, WS_RWBT), 6 * MT, 27 * 256, D, D}; RwOrder1 S{C.G, C.bid, 0, C.G == 256 ? 1280 : 27 * NPANEL, C.G == 256}; EpiRw1 E{Rm, A3, karg<I_KK>(), WSP(float, WS_INVSQ)}; pg8::gemm_phase<EpiRw1, RwOrder1, false>(LDSG, g, S, E, nullptr); } if (REPQ(b0 + 2)) { pg8::Gemm g{XM, WSP(bf16_t, WS_RWBT), 6 * MT, 27 * 256, D, D}; RwOrder1 S{C.G, C.bid, 0, C.G == 256 ? 1280 : 27 * NPANEL, C.G == 256}; EpiRw1 E{Rm, A3, karg<I_KK>(), WSP(float, WS_INVSQ)}; pg8::gemm_phase<EpiRw1, RwOrder1, false>(LDSG, g, S, E, nullptr); } }
    SEAM(b0 + 2);
    if (IN(b0 + 3)) { { rw_g2_phase(C, XM, Rm, A3, LD, LA, Gt); } if (REPQ(b0 + 3)) { rw_g2_phase(C, XM, Rm, A3, LD, LA, Gt); } }
    SEAM(b0 + 3);
    if (IN(b0 + 4)) { { phase_rw_scan(C, Rm, Km, Vm, LD, LA, karg<I_KK>(), karg<I_KA>(), WSP(float, WS_INVSQ), karg<I_ST>(), YB, C.out + OUT_ST); } if (REPQ(b0 + 4)) { phase_rw_scan(C, Rm, Km, Vm, LD, LA, karg<I_KK>(), karg<I_KA>(), WSP(float, WS_INVSQ), karg<I_ST>(), YB, C.out + OUT_ST); } }
    SEAM(b0 + 4);
    if (IN(b0 + 5)) { { phase_rw_post(C, YB, Rm, Km, Vm, LA, Gt, karg<I_KA>(), karg<I_RK>(), karg<I_LNW>(), karg<I_LNB>(), RO); } if (REPQ(b0 + 5)) { phase_rw_post(C, YB, Rm, Km, Vm, LA, Gt, karg<I_KA>(), karg<I_RK>(), karg<I_LNW>(), karg<I_LNB>(), RO); } }
    SEAM(b0 + 5);
    if (IN(b0 + 6)) { { EpiResidualB<false> E{X, MODP(LAYER, 0, 2), nullptr, nullptr}; run_gemm(C, RO, WSP(bf16_t, WS_RWOT), D, D, E); } if (REPQ(b0 + 6)) { EpiResidualB<false> E{X, MODP(LAYER, 0, 2), nullptr, nullptr}; run_gemm(C, RO, WSP(bf16_t, WS_RWOT), D, D, E); } }
    SEAM(b0 + 6);
    mlp_block<LAYER>(C, bar, lo, hi, b0 + 7);
}

__global__ void __launch_bounds__(512, 2) fwd_kernel(Params prm) {
    extern __shared__ __attribute__((aligned(16))) unsigned char lds_raw[];
    Ctx C;
    C.lds = (LAS unsigned char*)lds_raw;
    C.tid = threadIdx.x; C.lane = C.tid & 63; C.wave = __builtin_amdgcn_readfirstlane(C.tid >> 6); C.G = gridDim.x; C.bid = blockIdx.x;
    C.out = prm.out; C.ws = prm.ws;
    const int lo = prm.ph_lo, hi = prm.ph_hi;
    volatile LAS unsigned* xbw = (volatile LAS unsigned*)(C.lds + LDS_BAR_OFF);
    if (C.tid < 4) xbw[C.tid] = 0u;
    __syncthreads();
    XcdBarrier bar; bar.bar = (unsigned*)(C.ws + WS_CTL) + 1024; bar.x = 0; bar.st = xbw;
    if (hi - lo > 1) bar = xcd_barrier_post((unsigned*)(C.ws + WS_CTL) + 1024, xbw);

#ifdef MK_SKIP_FROM
    if (IN(0)) { for (size_t i = (size_t)C.bid * 512 + C.tid; i < (size_t)3 * 4194304; i += (size_t)C.G * 512) prm.out[OUT_NK + i] = 0.f; }
#endif
    if (IN(0)) { { phase_prologue(C); } if (REPQ(0)) { phase_prologue(C); } }
    SEAM(0);
    attn_layer<0, 0>(C, bar, lo, hi, 1);
    hyena_layer<1>(C, bar, lo, hi, 8);
    rwkv_layer<2>(C, bar, lo, hi, 17);
    attn_layer<3, 1>(C, bar, lo, hi, 27);
#ifndef MK_DBG_N
#define MK_DBG_N ((size_t)MT * D)
#endif
#ifndef MK_DBG_SCALE
#define MK_DBG_SCALE 1.0f
#endif
#ifdef MK_DBG_OFF
    if (IN(34)) { for (size_t i = (size_t)C.bid * 512 + C.tid; i < (size_t)MT * D; i += (size_t)C.G * 512) prm.out[OUT_Y + i] = i < (size_t)(MK_DBG_N) ? MK_DBG_SCALE * (MK_DBG_BF16 ? bf2f(WSP(bf16_t, MK_DBG_OFF)[i]) : WSP(float, MK_DBG_OFF)[i]) : 0.f; }
#else
    if (IN(34)) { { phase_norm_final_b(C, WSP(bf16_t, WS_X), karg<I_FNG>(), prm.out + OUT_Y, PREVP1(4), 8192); } if (REPQ(34)) { phase_norm_final_b(C, WSP(bf16_t, WS_X), karg<I_FNG>(), prm.out + OUT_Y, PREVP1(4), 8192); } }
#endif
}

#ifdef MK_SEP_CONV
__global__ void __launch_bounds__(512, 2) k_hyconv(Params prm) {
    extern __shared__ __attribute__((aligned(16))) unsigned char lds_raw3[];
    Ctx C; C.lds = (LAS unsigned char*)lds_raw3; C.tid = threadIdx.x; C.lane = C.tid & 63; C.wave = __builtin_amdgcn_readfirstlane(C.tid >> 6); C.G = gridDim.x; C.bid = blockIdx.x; C.out = prm.out; C.ws = prm.ws;
    bf16_t *ZT = WSP(bf16_t, WS_ARENA + AR_ZT), *YT = WSP(bf16_t, WS_ARENA + AR_YT);
    phase_hy_conv<1024, 8>(C, WSP(bf16_t, WS_FGS), ZT + (size_t)MP * D, YT + (size_t)MP * D); phase_hy_conv<256, 16>(C, WSP(bf16_t, WS_FGP), ZT, YT);
}
#endif
#ifdef MK_SEP_GATE
__global__ void __launch_bounds__(512, 2) k_hygate(Params prm) {
    extern __shared__ __attribute__((aligned(16))) unsigned char lds_raw2[];
    Ctx C; C.lds = (LAS unsigned char*)lds_raw2; C.tid = threadIdx.x; C.lane = C.tid & 63; C.wave = __builtin_amdgcn_readfirstlane(C.tid >> 6); C.G = gridDim.x; C.bid = blockIdx.x; C.out = prm.out; C.ws = prm.ws;
    bf16_t* ZT = WSP(bf16_t, WS_ARENA + AR_ZT);
    phase_hy_gate(C, WSP(bf16_t, WS_ARENA + AR_P), karg<I_HYCW>(), karg<I_HYCB>(), WSP(bf16_t, WS_ARENA + AR_X0), ZT, ZT + (size_t)MP * D);
}
#endif
#ifndef MK_PER_PHASE
#define MK_PER_PHASE 0
#endif
extern "C" void kernel_launch(void* const* d_in, const int* in_sizes, int n_in, void* d_out, int out_size, void* d_ws, size_t ws_size, hipStream_t stream) {
    static int grid = 0;
    if (grid == 0) {
        if (n_in != N_IN || ws_size < WS_END || out_size != 37748736) { fprintf(stderr, "kernel_launch: unexpected shapes (n_in %d, ws %zu, out %d); nothing launched\n", n_in, ws_size, out_size); grid = -1; return; }
        int dev = 0, cus = 0, per_cu = 0;
        if (hipGetDevice(&dev) != hipSuccess || hipDeviceGetAttribute(&cus, hipDeviceAttributeMultiprocessorCount, dev) != hipSuccess) { grid = -1; return; }
        if (hipFuncSetAttribute((const void*)fwd_kernel, hipFuncAttributeMaxDynamicSharedMemorySize, LDS_BYTES) != hipSuccess) { fprintf(stderr, "kernel_launch: hipFuncSetAttribute failed\n"); grid = -1; return; }
        if (hipOccupancyMaxActiveBlocksPerMultiprocessor(&per_cu, (const void*)fwd_kernel, 512, LDS_BYTES) != hipSuccess || per_cu < 1) { fprintf(stderr, "kernel_launch: occupancy query says %d\n", per_cu); }
        (void)hipGetLastError();
        grid = cus;
    }
    if (grid < 0) return;
    (void)hipMemsetAsync((char*)d_ws, 0, WS_ZERO_BYTES, stream);
    Params p{};
    for (int i = 0; i < N_IN; ++i) p.in[i] = (const float*)d_in[i];
    p.out = (float*)d_out; p.ws = (unsigned char*)d_ws;
#ifndef MK_LASTP
#define MK_LASTP NPH
#endif
#ifndef MK_FIRSTP
#define MK_FIRSTP 0
#endif
#if MK_PER_PHASE
    for (int k = MK_FIRSTP; k < MK_LASTP; ++k) {
#ifdef MK_SKIP_FROM
        if (k >= MK_SKIP_FROM && k < NPH - 1) continue;
#endif
#ifdef MK_SEP_CONV
        if (k == 11) { static bool a3 = false; if (!a3) { (void)hipFuncSetAttribute((const void*)k_hyconv, hipFuncAttributeMaxDynamicSharedMemorySize, 70000); a3 = true; } hipLaunchKernelGGL(k_hyconv, dim3(grid), dim3(512), 70000, stream, p); continue; }
#endif
#ifdef MK_SEP_GATE
        if (k == 10) { hipLaunchKernelGGL(k_hygate, dim3(grid), dim3(512), 16384, stream, p); continue; }
#endif
#ifdef MK_REPEAT_PH
        if (k == MK_REPEAT_PH) { p.ph_lo = k; p.ph_hi = k + 1; hipLaunchKernelGGL(fwd_kernel, dim3(grid), dim3(512), LDS_BYTES, stream, p); }
#endif
 p.ph_lo = k; p.ph_hi = k + 1; hipLaunchKernelGGL(fwd_kernel, dim3(grid), dim3(512), LDS_BYTES, stream, p); }
#else
    p.ph_lo = 0; p.ph_hi = NPH; hipLaunchKernelGGL(fwd_kernel, dim3(grid), dim3(512), LDS_BYTES, stream, p);
#endif
}
```

```cpp
#include <hip/hip_runtime.h>
#include <cstdio>
#include <cstdint>
namespace pg8 {
#define PG8_LAS __attribute__((address_space(3)))
typedef unsigned short bf16_t;
typedef short bf16x8 __attribute__((ext_vector_type(8)));
typedef float f32x4 __attribute__((ext_vector_type(4)));
typedef unsigned u32x4 __attribute__((ext_vector_type(4)));
constexpr int BM = 256, BK = 64, HALF = 128, HTB = HALF * BK * 2  , STAGE_BYTES = 8 * HTB, NXCD = 8, WGM = 4;

__host__ __device__ __forceinline__ int lds_byte(int r, int c) { const int st = (r >> 4) * 2 + (c >> 5), rr = r & 15, cc = c & 31, ob = rr * 64 + cc * 2; return st * 1024 + (ob ^ (((ob >> 9) & 1) << 5)); }
__host__ __device__ __forceinline__ void stage_rc(int b, int& R, int& C) { const int st = b / 1024, sb = b % 1024, swz = sb ^ (((sb >> 9) & 1) << 5); R = (st >> 1) * 16 + swz / 64; C = (st & 1) * 32 + (swz % 64) / 2; }
__host__ __device__ __forceinline__ int perm32(int rho) { const int n = rho >> 4, i = rho & 15; return 8 * (i >> 2) + 4 * n + (i & 3); }

struct Unit { int pm, pn, kh, mask; int nt = 0; };
struct Gemm { const bf16_t* A; const bf16_t* Bt; int M, N, K, KU; };

__host__ __device__ __forceinline__ bool tail_deal(int nwg, int G, int i, int c, int& L, int& mask) {
    const int full = nwg / G, rem = nwg - full * G;
    if (i < full) { L = i * G + c; mask = 15; return true; }
    if (i > full || rem == 0) return false;
    const int parts = (4 * rem <= G) ? 4 : ((2 * rem <= G) ? 2 : 1);
    if (c >= parts * rem) return false;
    L = full * G + c / parts; const int sub = c % parts;
    mask = parts == 1 ? 15 : (parts == 2 ? (sub ? 0xA : 0x5) : (1 << sub));
    return true;
}
struct StaticOrder {
    int nM, nN, nwg, G, c;
    __host__ __device__ void init(int M, int N, int G_, int c_) { nM = M / BM; nN = N / BM; nwg = nM * nN; G = G_; c = c_; }
    __host__ __device__ bool next(int i, Unit& u) const { const long L = (long)i * G + c; if (L >= nwg) return false; map((int)L, u); u.kh = 0; u.mask = 15; return true; }
    __host__ __device__ bool map(int L, Unit& u) const {
        int wgid = (int)L; { const int q = nwg / NXCD, r = nwg % NXCD, xcd = wgid % NXCD, off = wgid / NXCD; wgid = (xcd < r ? xcd * (q + 1) : r * (q + 1) + (xcd - r) * q) + off; }
        const int nig = WGM * nN, gid = wgid / nig, fm = gid * WGM, gsz = (nM - fm) < WGM ? (nM - fm) : WGM;
        u.pm = fm + ((wgid % nig) % gsz); u.pn = (wgid % nig) / gsz; return true;
    }
    __device__ __forceinline__ void a_ready(const Unit&) const {}
    __device__ __forceinline__ void done(const Unit&) const {}
};

template <class Epi, class Sched, bool STAMP = false>
__device__ __forceinline__ void gemm_phase(PG8_LAS unsigned char* lds, const Gemm g, const Sched& S, const Epi& E, unsigned long long* stamps) {
    const int tid = threadIdx.x, wid = __builtin_amdgcn_readfirstlane(tid >> 6), lane = tid & 63, wr = wid >> 2, wc = wid & 3, fr = lane & 15, fq = lane >> 4;
    const int K = g.K, nt = g.KU / BK;
    int ts_lo = 0, ts_hi = 0, nts = 0; const unsigned long long rt_entry = STAMP ? (unsigned long long)wall_clock64() : 0ull;
#define PG8_STAMP() do { if (STAMP && wid == 0 && nts < 64) { const unsigned long long _c = (unsigned long long)clock64(); \
        ts_lo = (lane == nts) ? (int)(unsigned)_c : ts_lo; ts_hi = (lane == nts) ? (int)(unsigned)(_c >> 32) : ts_hi; ++nts; } } while (0)
    PG8_STAMP();
    unsigned voffA[2], voffB[2];
#pragma unroll
    for (int i = 0; i < 2; ++i) { int R, C; stage_rc(tid * 16 + i * 8192, R, C); const int Rb = Epi::PERM ? ((R & ~31) + perm32(R & 31)) : R;
        voffA[i] = (unsigned)(R * K + C) * 2u; voffB[i] = (unsigned)(Rb * K + C) * 2u; }
    const size_t kstep = (size_t)(BK * 2);
    const size_t hstep = (size_t)HALF * K * 2;
    const size_t tstep = 2 * hstep;
    const unsigned ldsw = (unsigned)wid * 1024u;
    const int aoff = lds_byte(wr * 64 + fr, fq * 8), boff = lds_byte(wc * 32 + fr, fq * 8);
#define PG8_SA(b, h) (((b) * 2 + (h)) * HTB)
#define PG8_SB(b, h) ((4 + (b) * 2 + (h)) * HTB)
#define PG8_STAGE(bufoff, gbase, voff) do { _Pragma("unroll") for (int _i = 0; _i < 2; ++_i) \
        __builtin_amdgcn_global_load_lds((const unsigned*)((const char*)(gbase) + (voff)[_i]), (PG8_LAS unsigned*)(lds + (bufoff) + ldsw + _i * 8192), 16, 0, 0); } while (0)
#define PG8_LDA(dst, b, h) do { _Pragma("unroll") for (int m = 0; m < 4; ++m) _Pragma("unroll") for (int k = 0; k < 2; ++k) dst[m][k] = *(const PG8_LAS bf16x8*)(lds + PG8_SA(b, h) + aoff + m * 2048 + k * 1024); } while (0)
#define PG8_LDB(dst, b, h) do { _Pragma("unroll") for (int n = 0; n < 2; ++n) _Pragma("unroll") for (int k = 0; k < 2; ++k) dst[n][k] = *(const PG8_LAS bf16x8*)(lds + PG8_SB(b, h) + boff + n * 2048 + k * 1024); } while (0)
#define PG8_MMA(ai, bj, At, Bt) do { __builtin_amdgcn_s_setprio(1); _Pragma("unroll") for (int k = 0; k < 2; ++k) _Pragma("unroll") for (int m = 0; m < 4; ++m) _Pragma("unroll") for (int n = 0; n < 2; ++n) \
        asm volatile("v_mfma_f32_16x16x32_bf16 %0, %1, %2, %0" : "+v"(acc[ai][bj][m][n]) : "v"(Bt[n][k]), "v"(At[m][k])); __builtin_amdgcn_s_setprio(0); } while (0)
#define PG8_ACC_FENCE1(ai, bj) asm volatile("s_nop 15\n\ts_nop 15" : "+v"(acc[ai][bj][0][0]), "+v"(acc[ai][bj][0][1]), "+v"(acc[ai][bj][1][0]), "+v"(acc[ai][bj][1][1]), "+v"(acc[ai][bj][2][0]), "+v"(acc[ai][bj][2][1]), "+v"(acc[ai][bj][3][0]), "+v"(acc[ai][bj][3][1]))
#define PG8_ACC_FENCE() do { PG8_ACC_FENCE1(0, 0); PG8_ACC_FENCE1(0, 1); PG8_ACC_FENCE1(1, 0); PG8_ACC_FENCE1(1, 1); } while (0)
#define PG8_WAIT_V(n) asm volatile("s_waitcnt vmcnt(" #n ")" ::: "memory")
#define PG8_WAIT_L(n) asm volatile("s_waitcnt lgkmcnt(" #n ")" ::: "memory")
#define PG8_BAR __builtin_amdgcn_s_barrier()
#define PG8_SCHED __builtin_amdgcn_sched_barrier(0)
    Unit cur, nxt; int ui = 0;
    if (!S.next(0, cur)) return;
    f32x4 acc[2][2][4][2];
#pragma unroll
    for (int a = 0; a < 2; ++a)
#pragma unroll
        for (int b = 0; b < 2; ++b)
#pragma unroll
            for (int m = 0; m < 4; ++m)
#pragma unroll
                for (int n = 0; n < 2; ++n) acc[a][b][m][n] = (f32x4){0.f, 0.f, 0.f, 0.f};
    bf16x8 At[4][2], B0[2][2], B1[2][2];
    const size_t kslice = (size_t)g.KU * 2;
    const char* cA = (const char*)g.A + (size_t)cur.pm * tstep + cur.kh * kslice; const char* cB = (const char*)g.Bt + (size_t)cur.pn * tstep + cur.kh * kslice;
    S.a_ready(cur);
    PG8_STAGE(PG8_SB(0, 0), cB, voffB); PG8_STAGE(PG8_SA(0, 0), cA, voffA); PG8_STAGE(PG8_SB(0, 1), cB + hstep, voffB); PG8_STAGE(PG8_SA(0, 1), cA + hstep, voffA);
    if (wr == 1) PG8_BAR;
    PG8_WAIT_V(4); PG8_BAR;
    PG8_STAGE(PG8_SB(1, 0), cB + kstep, voffB); PG8_STAGE(PG8_SA(1, 0), cA + kstep, voffA); PG8_STAGE(PG8_SB(1, 1), cB + hstep + kstep, voffB);
    PG8_WAIT_V(6); PG8_BAR;
    PG8_STAMP();
    for (;;) {
        const bool has_next = S.next(ui + 1, nxt);
        const char* nA = has_next ? (const char*)g.A + (size_t)nxt.pm * tstep + nxt.kh * kslice : cA; const char* nB = has_next ? (const char*)g.Bt + (size_t)nxt.pn * tstep + nxt.kh * kslice : cB;
        const int unt = cur.nt ? cur.nt : nt;
        const bool pre = ui > 0;
        for (int t = 0; t < unt; t += 2) {
            const bool last = (t == unt - 2);
            const char* a1 = cA + (size_t)(t + 1) * kstep;
            const char* a2 = last ? nA : cA + (size_t)(t + 2) * kstep; const char* b2 = last ? nB : cB + (size_t)(t + 2) * kstep;
            const char* a3 = a2 + kstep; const char* b3 = b2 + kstep;
            if (last && has_next) S.a_ready(nxt);
            PG8_LDB(B0, 0, 0); PG8_SCHED; PG8_LDA(At, 0, 0); if (!(pre && t == 0)) PG8_STAGE(PG8_SA(1, 1), a1 + hstep, voffA);
            PG8_WAIT_L(8); PG8_BAR; PG8_WAIT_L(0); PG8_MMA(0, 0, At, B0); PG8_BAR; PG8_SCHED;
            PG8_LDB(B1, 0, 1); PG8_STAGE(PG8_SB(0, 0), b2, voffB);
            PG8_BAR; PG8_WAIT_L(0); PG8_MMA(0, 1, At, B1); PG8_BAR;
            PG8_LDA(At, 0, 1); PG8_STAGE(PG8_SA(0, 0), a2, voffA);
            PG8_BAR; PG8_WAIT_L(0); PG8_MMA(1, 0, At, B0); PG8_BAR; PG8_SCHED;
            PG8_STAGE(PG8_SB(0, 1), b2 + hstep, voffB);
            if (pre && t == 0) PG8_WAIT_V(22); else PG8_WAIT_V(6);
            PG8_BAR; PG8_MMA(1, 1, At, B1); PG8_BAR;
            PG8_LDB(B0, 1, 0); PG8_SCHED; PG8_LDA(At, 1, 0); PG8_STAGE(PG8_SA(0, 1), a2 + hstep, voffA);
            PG8_WAIT_L(8); PG8_BAR; PG8_WAIT_L(0); PG8_MMA(0, 0, At, B0); PG8_BAR; PG8_SCHED;
            PG8_LDB(B1, 1, 1); PG8_STAGE(PG8_SB(1, 0), b3, voffB);
            PG8_BAR; PG8_WAIT_L(0); PG8_MMA(0, 1, At, B1); PG8_BAR;
            PG8_LDA(At, 1, 1); PG8_STAGE(PG8_SA(1, 0), a3, voffA);
            PG8_BAR; PG8_WAIT_L(0); PG8_MMA(1, 0, At, B0); PG8_BAR; PG8_SCHED;
            PG8_STAGE(PG8_SB(1, 1), b3 + hstep, voffB);
            PG8_WAIT_V(6); PG8_BAR; PG8_MMA(1, 1, At, B1); PG8_BAR;
        }
        PG8_STAMP();
        if (has_next) { PG8_STAGE(PG8_SA(1, 1), nA + kstep + hstep, voffA); }
        asm volatile("" ::: "memory"); PG8_SCHED;
        PG8_ACC_FENCE();
        if constexpr (!Epi::AFTER_DRAIN) { E(acc, cur, wr, wc, fr, fq); S.done(cur); }
        PG8_STAMP();
        if (!has_next) break;
#pragma unroll
        for (int a = 0; a < 2; ++a)
#pragma unroll
            for (int b = 0; b < 2; ++b)
#pragma unroll
                for (int m = 0; m < 4; ++m)
#pragma unroll
                    for (int n = 0; n < 2; ++n) acc[a][b][m][n] = (f32x4){0.f, 0.f, 0.f, 0.f};
        cur = nxt; cA = nA; cB = nB; ++ui;
    }
    PG8_WAIT_V(0);
    if (wr == 0) PG8_BAR;
    PG8_BAR;
    if constexpr (Epi::AFTER_DRAIN) { E.fused(acc, cur, wr, wc, fr, fq, lds, wid, lane); S.done(cur); }
    PG8_STAMP();
    if (STAMP && wid == 0) { stamps[lane] = lane < nts ? (((unsigned long long)(unsigned)ts_hi << 32) | (unsigned)ts_lo) : 0ull;
        if (lane == 62) stamps[62] = rt_entry; if (lane == 63) stamps[63] = (unsigned long long)wall_clock64(); }
#undef PG8_STAMP
#undef PG8_SA
#undef PG8_SB
#undef PG8_STAGE
#undef PG8_LDA
#undef PG8_LDB
#undef PG8_MMA
#undef PG8_ACC_FENCE
#undef PG8_ACC_FENCE1
#undef PG8_WAIT_V
#undef PG8_WAIT_L
#undef PG8_BAR
#undef PG8_SCHED
}
}

#define XB_TMO      128
#define XB_XCNT(j)  (256  + 64 * (j))
#define XB_XSUB(j)  (1280 + 64 * (j))
#define XB_XGEN(j)  (2304 + 64 * (j))
#define XB_TOP      3328
#define XB_TOPGEN   3392
#define XCD_BAR_WORDS 3456
#define XB_SPIN_CAP (1u << 20)
#define LAS __attribute__((address_space(3)))

__device__ __forceinline__ unsigned xb_ld(unsigned* p)              { return __hip_atomic_load(p, __ATOMIC_RELAXED, __HIP_MEMORY_SCOPE_AGENT); }
__device__ __forceinline__ unsigned xb_add(unsigned* p, unsigned v) { return __hip_atomic_fetch_add(p, v, __ATOMIC_RELAXED, __HIP_MEMORY_SCOPE_AGENT); }
__device__ __forceinline__ unsigned xb_xcc_id() { return (unsigned)__builtin_amdgcn_s_getreg((3 << 11) | 20) & 0xFu; }
#define XB_SPIN(cond, bar) do { unsigned _sp = 0; while (cond) { __builtin_amdgcn_s_sleep(1); \
    if ((++_sp & 255u) == 0u) { if (xb_ld(&(bar)[XB_TMO])) break; if (_sp > XB_SPIN_CAP) { atomicAdd(&(bar)[XB_TMO], 1u); break; } } } } while (0)

struct XcdBarrier {
    unsigned* bar; unsigned x;
    volatile LAS unsigned* st;
};

__device__ __forceinline__ XcdBarrier xcd_barrier_post(unsigned* bar, volatile LAS unsigned* st) {
    XcdBarrier b; b.bar = bar; b.x = xb_xcc_id(); b.st = st;
    if (threadIdx.x == 0) (void)xb_add(&bar[XB_XCNT(b.x)], 1u);
    return b;
}
__device__ __forceinline__ void xcd_barrier_complete(unsigned* bar, unsigned x, unsigned& nloc, unsigned& nx) {
    const unsigned G = gridDim.x * gridDim.y * gridDim.z;
    unsigned sum, cnt, mine, sp = 0u;
    for (;;) {
        sum = 0u; cnt = 0u; mine = 0u;
#pragma unroll
        for (unsigned j = 0; j < 16; ++j) { const unsigned c = xb_ld(&bar[XB_XCNT(j)]); sum += c; cnt += (c > 0u) ? 1u : 0u; mine = (j == x) ? c : mine; }
        if (sum == G) break;
        __builtin_amdgcn_s_sleep(1);
        if ((++sp & 255u) == 0u) { if (xb_ld(&bar[XB_TMO])) break; if (sp > XB_SPIN_CAP) { atomicAdd(&bar[XB_TMO], 1u); break; } }
    }
    nloc = mine > 0u ? mine : 1u; nx = cnt > 0u ? cnt : 1u;
}

__device__ __forceinline__ void xcd_barrier(const XcdBarrier& b) {
    asm volatile("s_waitcnt vmcnt(0)" ::: "memory");
    __syncthreads();
    if (threadIdx.x == 0) {
        unsigned* bar = b.bar;
        __builtin_amdgcn_s_waitcnt(0);
        unsigned nloc = b.st[0], nx = b.st[1];
        if (nloc == 0u) { xcd_barrier_complete(bar, b.x, nloc, nx); b.st[0] = nloc; b.st[1] = nx; }
        const unsigned old = xb_add(&bar[XB_XSUB(b.x)], 1u);
        const unsigned gen = old / nloc;
        if (old + 1u == (gen + 1u) * nloc) {
            __builtin_amdgcn_fence(__ATOMIC_RELEASE, "agent");
            asm volatile("s_waitcnt vmcnt(0)" ::: "memory");
            const unsigned og = xb_add(&bar[XB_TOP], 1u);
            const unsigned tg = og / nx;
            if (og + 1u == (tg + 1u) * nx) xb_add(&bar[XB_TOPGEN], 1u);
            else XB_SPIN(xb_ld(&bar[XB_TOPGEN]) == tg, bar);
            __builtin_amdgcn_fence(__ATOMIC_ACQUIRE, "agent");
            xb_add(&bar[XB_XGEN(b.x)], 1u);
            asm volatile("s_waitcnt vmcnt(0)" ::: "memory");
        } else {
            XB_SPIN(xb_ld(&bar[XB_XGEN(b.x)]) == gen, bar);
            __builtin_amdgcn_fence(__ATOMIC_ACQUIRE, "agent");
            asm volatile("s_waitcnt vmcnt(0)" ::: "memory");
        }
    }
    __syncthreads();
}

typedef unsigned short bf16_t;
typedef short bf16x8 __attribute__((ext_vector_type(8)));
typedef short bf16x4 __attribute__((ext_vector_type(4)));
typedef float f32x2 __attribute__((ext_vector_type(2)));
typedef float f32x4 __attribute__((ext_vector_type(4)));
typedef float f32x16 __attribute__((ext_vector_type(16)));
typedef unsigned u32x4 __attribute__((ext_vector_type(4)));
typedef unsigned u32x2 __attribute__((ext_vector_type(2)));

constexpr int D = 2048, FF = 8192, MP = 4096, MS = 8192, MT = 12288;
constexpr int NPANEL = MT / 256;
constexpr size_t MiB = 1u << 20;
constexpr size_t WS_CTL = 0, WS_MOD = 1 * MiB, WS_ZERO_BYTES = 3 * MiB;
constexpr size_t WS_ROPE = 3 * MiB;
constexpr size_t WS_W1T = 4 * MiB, WS_W2T = 132 * MiB, WS_WQKVT = 260 * MiB, WS_WOT = 284 * MiB, WS_HYINT = 300 * MiB, WS_HYOUTT = 324 * MiB;
constexpr size_t WS_RWBT = 332 * MiB, WS_LORA2T = 359 * MiB, WS_RWOT = 364 * MiB, WS_KC = 372 * MiB, WS_VC = 380 * MiB, WS_FGS = 388 * MiB, WS_FGP = 397 * MiB;
constexpr size_t WS_X = 400 * MiB, WS_H = 496 * MiB, WS_ARENA = 544 * MiB, WS_INVSQ = 1186 * MiB, WS_END = 1188 * MiB;
constexpr size_t AR_U = 0;
constexpr size_t AR_Q = 0, AR_K = 48 * MiB, AR_V = 60 * MiB, AR_O = 72 * MiB;
constexpr size_t AR_P = 0, AR_X0 = 144 * MiB, AR_ZT = 192 * MiB, AR_YT = 240 * MiB, AR_HO = 288 * MiB;
constexpr size_t AR_XMIX = 0, AR_LD = 546 * MiB  , AR_LA = 96 * MiB, AR_G = 192 * MiB, AR_RO = 240 * MiB, AR_R = 288 * MiB, AR_KK = 336 * MiB, AR_VV = 384 * MiB, AR_A3 = 432 * MiB, AR_YB = 450 * MiB;
constexpr size_t OUT_Y = 0, OUT_NK = 25165824, OUT_NV = 29360128, OUT_ST = 33554432;
constexpr int FGS_ROW = 2112, FGP_ROW = 576;
constexpr size_t AR_FILT = 600 * MiB;
constexpr int LDS_BAR_OFF = 147456, LDS_BYTES = 147456 + 1024;

enum { I_XP = 0, I_XS, I_CK, I_CV, I_ST, I_C, I_CCTX, I_ADAW, I_ADAB, I_N1G, I_N2G, I_MW1, I_MW2, I_WQKV, I_WO, I_SINK, I_HYWIN, I_HYCW, I_HYCB, I_FW1, I_FB1, I_FW2, I_FB2, I_FW3, I_FB3,
       I_FREQ, I_FWOUT, I_HYBIAS, I_HYWOUT, I_MU, I_WR, I_WK, I_WV, I_RWO, I_W0, I_W1, I_W2, I_A0, I_A1, I_A2, I_G1, I_G2, I_KK, I_KA, I_RK, I_LNW, I_LNB, I_FNG, N_IN };

struct Params { const float* in[N_IN]; float* out; unsigned char* ws; int ph_lo, ph_hi; };

__device__ __forceinline__ unsigned cvt_pk(float lo, float hi) { unsigned r; asm("v_cvt_pk_bf16_f32 %0, %1, %2" : "=v"(r) : "v"(lo), "v"(hi)); return r; }
__device__ __forceinline__ float bflo(unsigned w) { return __uint_as_float(w << 16); }
__device__ __forceinline__ float bfhi(unsigned w) { return __uint_as_float(w & 0xffff0000u); }
__device__ __forceinline__ float bf2f(bf16_t b) { return __uint_as_float(((unsigned)b) << 16); }
__device__ __forceinline__ float dpp_f(float x, const int ctrl) { return x; }
#define DPP_ADD(x, ctrl) ((x) + __int_as_float(__builtin_amdgcn_update_dpp(0, __float_as_int(x), (ctrl), 0xF, 0xF, true)))
__device__ __forceinline__ float wave_sum(float v) {
    v = DPP_ADD(v, 0xB1); v = DPP_ADD(v, 0x4E); v = DPP_ADD(v, 0x141); v = DPP_ADD(v, 0x140);
    const int vi = __float_as_int(v);
    const float r0 = __int_as_float(__builtin_amdgcn_readlane(vi, 0)), r1 = __int_as_float(__builtin_amdgcn_readlane(vi, 16)),
                r2 = __int_as_float(__builtin_amdgcn_readlane(vi, 32)), r3 = __int_as_float(__builtin_amdgcn_readlane(vi, 48));
    return (r0 + r1) + (r2 + r3);
}
__device__ __forceinline__ float opaque_zero() { float z; asm volatile("v_mov_b32 %0, 0" : "=v"(z)); return z; }
__device__ __forceinline__ float fexp2(float x) { return __builtin_amdgcn_exp2f(x); }
__device__ __forceinline__ float fexp(float x) { return __builtin_amdgcn_exp2f(x * 1.4426950408889634f); }
__device__ __forceinline__ float flog(float x) { return __builtin_amdgcn_logf(x) * 0.6931471805599453f; }
__device__ __forceinline__ float frcp(float x) { return __builtin_amdgcn_rcpf(x); }
__device__ __forceinline__ float fsigmoid(float x) { return frcp(1.0f + fexp(-x)); }
__device__ __forceinline__ float ftanh(float x) { const float e = fexp(2.0f * x); return 1.0f - 2.0f * frcp(e + 1.0f); }
__device__ __forceinline__ float fsoftplus(float x) { return fmaxf(x, 0.0f) + flog(1.0f + fexp(-fabsf(x))); }
__device__ __forceinline__ float fsin_rev(float rev) { return __builtin_amdgcn_sinf(rev - rintf(rev)); }
__device__ __forceinline__ float fcos_rev(float rev) { return __builtin_amdgcn_cosf(rev - rintf(rev)); }
__device__ __forceinline__ float fsin(float x) { return fsin_rev(x * 0.15915494309189535f); }
__device__ __forceinline__ int cond_of_row(int m) { return m < MP ? 0 : 1 + ((m - MP) >> 10); }
__device__ __forceinline__ int cond_of_panel(int pm) { return pm < 16 ? 0 : 1 + ((pm - 16) >> 2); }

struct Ctx {
    LAS unsigned char* lds;
    int tid, lane, wave, G, bid;
    float* out;
    unsigned char* ws;
};
template <int IDX> __device__ __forceinline__ const float* karg() {
    unsigned long long v;
    asm volatile("s_load_dwordx2 %0, %1, %2\n\ts_waitcnt lgkmcnt(0)" : "=s"(v) : "s"(__builtin_amdgcn_kernarg_segment_ptr()), "n"(IDX * 8));
    return (const float*)v;
}
#define WSP(T, off) ((T*)(C.ws + (off)))
#define MODP(l, cond, which) (WSP(float, WS_MOD) + ((size_t)((l) * 9 + (cond)) * 6 + (which)) * D)

__device__ __forceinline__ void p0_transpose_item(const float* W, int K, int N, bf16_t* WT, LAS float* scr, int item, int lane) {
    const int nblk = N / 32, kb = item / nblk, nb = item % nblk, k0 = 64 * kb, n0 = 32 * nb;
    const int rsub = lane >> 3, c4 = (lane & 7) * 4;
    f32x4 v[8];
#pragma unroll
    for (int i = 0; i < 8; ++i) v[i] = *(const f32x4*)(W + (size_t)(k0 + 8 * i + rsub) * N + n0 + c4);
#pragma unroll
    for (int i = 0; i < 8; ++i) { LAS float* d = scr + (8 * i + rsub) * 33 + c4; d[0] = v[i].x; d[1] = v[i].y; d[2] = v[i].z; d[3] = v[i].w; }
    asm volatile("s_waitcnt lgkmcnt(0)" ::: "memory");
    const int c = lane & 7;
#pragma unroll
    for (int j = 0; j < 4; ++j) { const int n = (lane >> 3) + 8 * j; const LAS float* s = scr + (8 * c) * 33 + n;
        u32x4 o; o.x = cvt_pk(s[0 * 33], s[1 * 33]); o.y = cvt_pk(s[2 * 33], s[3 * 33]); o.z = cvt_pk(s[4 * 33], s[5 * 33]); o.w = cvt_pk(s[6 * 33], s[7 * 33]);
        *(u32x4*)(WT + (size_t)(n0 + n) * K + k0 + 8 * c) = o; }
    asm volatile("s_waitcnt lgkmcnt(0)" ::: "memory");
}

__device__ __forceinline__ void late_transposes(const Ctx& C, LAS float* scr, int wv, int nwv) {
    constexpr int I_M = 8192, I_QKV = 3072, I_O = 2048;
    constexpr int NIT = 4 * I_M + I_QKV + I_O;
    for (int it = wv; it < NIT; it += nwv) {
        int r = it;
        if (r < 2 * I_M) { const int l = 2 + r / I_M; p0_transpose_item(karg<I_MW1>() + (size_t)l * D * FF, D, FF, WSP(bf16_t, WS_W1T) + (size_t)l * D * FF, scr, r % I_M, C.lane); continue; } r -= 2 * I_M;
        if (r < 2 * I_M) { const int l = 2 + r / I_M; p0_transpose_item(karg<I_MW2>() + (size_t)l * D * FF, FF, D, WSP(bf16_t, WS_W2T) + (size_t)l * D * FF, scr, r % I_M, C.lane); continue; } r -= 2 * I_M;
        if (r < I_QKV) { p0_transpose_item(karg<I_WQKV>() + (size_t)D * 3072, D, 3072, WSP(bf16_t, WS_WQKVT) + (size_t)D * 3072, scr, r, C.lane); continue; } r -= I_QKV;
        p0_transpose_item(karg<I_WO>() + (size_t)D * D, D, D, WSP(bf16_t, WS_WOT) + (size_t)D * D, scr, r, C.lane);
    }
}
#ifndef MK_PRO_MASK
#define MK_PRO_MASK 127
#endif
__device__ __forceinline__ void phase_prologue(const Ctx& C) {
    const int gw = C.bid * 8 + C.wave, NGW = C.G * 8, lane = C.lane;
    const size_t gt = (size_t)C.bid * 512 + C.tid, NGT = (size_t)C.G * 512;
    LAS float* scr = (LAS float*)(C.lds + C.wave * 16384);
    if (MK_PRO_MASK & 1)
    {
        constexpr int I_M1 = 8192, I_M2 = 8192, I_QKV = 3072, I_O = 2048, I_HI = 6144, I_SQ = 2048;
        constexpr int NIT = 2 * I_M1 + 2 * I_M2 + I_QKV + I_O + I_HI + I_SQ + 4 * I_SQ;
        for (int it = gw; it < NIT; it += NGW) {
            int r = it;
            if (r < 2 * I_M1) { const int l = r / I_M1; p0_transpose_item(karg<I_MW1>() + (size_t)l * D * FF, D, FF, WSP(bf16_t, WS_W1T) + (size_t)l * D * FF, scr, r % I_M1, lane); continue; } r -= 2 * I_M1;
            if (r < 2 * I_M2) { const int l = r / I_M2; p0_transpose_item(karg<I_MW2>() + (size_t)l * D * FF, FF, D, WSP(bf16_t, WS_W2T) + (size_t)l * D * FF, scr, r % I_M2, lane); continue; } r -= 2 * I_M2;
            if (r < I_QKV) { p0_transpose_item(karg<I_WQKV>(), D, 3072, WSP(bf16_t, WS_WQKVT), scr, r, lane); continue; } r -= I_QKV;
            if (r < I_O) { p0_transpose_item(karg<I_WO>(), D, D, WSP(bf16_t, WS_WOT), scr, r, lane); continue; } r -= I_O;
            if (r < I_HI) { p0_transpose_item(karg<I_HYWIN>(), D, 6144, WSP(bf16_t, WS_HYINT), scr, r, lane); continue; } r -= I_HI;
            if (r < I_SQ) { p0_transpose_item(karg<I_HYWOUT>(), D, D, WSP(bf16_t, WS_HYOUTT), scr, r, lane); continue; } r -= I_SQ;
            if (r < I_SQ) { p0_transpose_item(karg<I_WR>(), D, D, WSP(bf16_t, WS_RWBT), scr, r, lane); continue; } r -= I_SQ;
            if (r < I_SQ) { p0_transpose_item(karg<I_WK>(), D, D, WSP(bf16_t, WS_RWBT) + (size_t)D * D, scr, r, lane); continue; } r -= I_SQ;
            if (r < I_SQ) { p0_transpose_item(karg<I_WV>(), D, D, WSP(bf16_t, WS_RWBT) + (size_t)2 * D * D, scr, r, lane); continue; } r -= I_SQ;
            p0_transpose_item(karg<I_RWO>(), D, D, WSP(bf16_t, WS_RWOT), scr, r, lane);
        }
    }
    if (MK_PRO_MASK & 2)
    {
        bf16_t* L1 = WSP(bf16_t, WS_RWBT) + (size_t)3 * D * D;
#pragma unroll
        for (int part = 0; part < 7; ++part) {
            const int row0 = part == 0 ? 0 : part == 1 ? 96 : part == 2 ? 192 : part == 3 ? 256 : part == 4 ? 352 : part == 5 ? 448 : 512;
            const int nrow = (part == 2 || part == 5) ? 64 : (part == 6 ? 256 : 96);
            const int ld = part == 6 ? 256 : 96;
            const float* src = part == 0 ? karg<I_W1>() : part == 1 ? karg<I_W1>() + (size_t)D * 96 : part == 3 ? karg<I_A1>() : part == 4 ? karg<I_A1>() + (size_t)D * 96 : karg<I_G1>();
            const bool zero = (part == 2 || part == 5);
            for (size_t i = gt; i < (size_t)nrow * 256; i += NGT) {
                const int rr = (int)(i / 256), k8 = (int)(i % 256);
                float v[8];
#pragma unroll
                for (int j = 0; j < 8; ++j) v[j] = zero ? 0.0f : src[(size_t)(8 * k8 + j) * ld + rr];
                u32x4 o; o.x = cvt_pk(v[0], v[1]); o.y = cvt_pk(v[2], v[3]); o.z = cvt_pk(v[4], v[5]); o.w = cvt_pk(v[6], v[7]);
                *(u32x4*)(L1 + (size_t)(row0 + rr) * D + 8 * k8) = o;
            }
        }
        bf16_t* L2 = WSP(bf16_t, WS_LORA2T);
#pragma unroll
        for (int mat = 0; mat < 5; ++mat) {
            const float* src = mat == 0 ? karg<I_W2>() : mat == 1 ? karg<I_W2>() + (size_t)96 * D : mat == 2 ? karg<I_A2>() : mat == 3 ? karg<I_A2>() + (size_t)96 * D : karg<I_G2>();
            const int kofs = (mat == 1 || mat == 3) ? 96 : 0, klen = mat == 4 ? 256 : 96;
            for (size_t i = gt; i < (size_t)2048 * 32; i += NGT) {
                const int n = (int)(i / 32), k8 = (int)(i % 32);
                float v[8];
#pragma unroll
                for (int j = 0; j < 8; ++j) { const int k = 8 * k8 + j - kofs; const int kc = k < 0 ? 0 : (k >= klen ? klen - 1 : k); const float x = src[(size_t)kc * D + n]; v[j] = (k >= 0 && k < klen) ? x : 0.0f; }
                u32x4 o; o.x = cvt_pk(v[0], v[1]); o.y = cvt_pk(v[2], v[3]); o.z = cvt_pk(v[4], v[5]); o.w = cvt_pk(v[6], v[7]);
                *(u32x4*)(L2 + ((size_t)mat * 2048 + n) * 256 + 8 * k8) = o;
            }
        }
    }
    if (MK_PRO_MASK & 4)
    for (size_t i = gt; i < 2048; i += NGT) {
        const int pos = (int)(i >> 5), fi = (int)(i & 31);
        const float inv = fexp2(-(float)(2 * fi) * (13.287712379549449f / 64.0f));
        const float rev = (float)pos * inv * 0.15915494309189535f;
        WSP(f32x2, WS_ROPE)[i] = (f32x2){fcos_rev(rev), fsin_rev(rev)};
    }
    for (size_t i = gt; i < (size_t)MT * 32 / 4; i += NGT) WSP(f32x4, WS_INVSQ)[i] = (f32x4){0.f, 0.f, 0.f, 0.f};
    if (MK_PRO_MASK & 8)
    { const float *ckp = karg<I_CK>(), *cvp = karg<I_CV>();
    for (size_t i = gt; i < (size_t)2 * 524288; i += NGT) {
        const bool isv = i >= 524288; const size_t e = (isv ? i - 524288 : i) * 8;
        const float* src = (isv ? cvp : ckp) + e;
        const f32x4 a = *(const f32x4*)src, b = *(const f32x4*)(src + 4);
        u32x4 o; o.x = cvt_pk(a.x, a.y); o.y = cvt_pk(a.z, a.w); o.z = cvt_pk(b.x, b.y); o.w = cvt_pk(b.z, b.w);
        *(u32x4*)(WSP(bf16_t, isv ? WS_VC : WS_KC) + e) = o;
    } }
    if (MK_PRO_MASK & 32)
    {
        __syncthreads();
        LAS float* tab = (LAS float*)C.lds;
        LAS float* red = (LAS float*)(C.lds + 73728);
        const float *cctx = karg<I_CCTX>(), *cc = karg<I_C>();
        for (int e = C.tid; e < 9 * D; e += 512) { const int j = e >> 11, k = e & (D - 1);
            const float cv = j == 0 ? cctx[k] : cc[(size_t)(j == 0 ? 0 : j - 1) * D + k]; tab[e] = cv * fsigmoid(cv); }
        __syncthreads();
        const float* adaw = karg<I_ADAW>(); const float* adab = karg<I_ADAB>();
        for (int it = C.bid; it < 4 * 192; it += C.G) {
            const int nb = it % 192, l = it / 192, w = C.wave;
            float acc[9];
#pragma unroll
            for (int j = 0; j < 9; ++j) acc[j] = 0.f;
            const float* wp = adaw + ((size_t)l * D + 256 * w) * (6 * D) + nb * 64 + lane;
#pragma unroll 4
            for (int k4 = 0; k4 < 256; k4 += 4) {
                const float w0 = wp[(size_t)(k4 + 0) * (6 * D)], w1 = wp[(size_t)(k4 + 1) * (6 * D)], w2 = wp[(size_t)(k4 + 2) * (6 * D)], w3 = wp[(size_t)(k4 + 3) * (6 * D)];
#pragma unroll
                for (int j = 0; j < 9; ++j) { const f32x4 sv = *(const LAS f32x4*)(tab + j * D + 256 * w + k4); acc[j] += (w0 * sv.x + w1 * sv.y) + (w2 * sv.z + w3 * sv.w); }
            }
#pragma unroll
            for (int j = 0; j < 9; ++j) red[(w * 9 + j) * 64 + lane] = acc[j];
            __syncthreads();
            for (int e = C.tid; e < 9 * 64; e += 512) { const int j = e >> 6, c = e & 63; float sum = adab[(size_t)l * 6 * D + nb * 64 + c];
#pragma unroll
                for (int ww = 0; ww < 8; ++ww) sum += red[(ww * 9 + j) * 64 + c];
                WSP(float, WS_MOD)[((size_t)l * 9 + j) * 6 * D + nb * 64 + c] = sum; }
            __syncthreads();
        }
    }
    if (MK_PRO_MASK & 64)
    {
        const float *fw1 = karg<I_FW1>(), *fw2 = karg<I_FW2>(), *fw3 = karg<I_FW3>(), *fwout = karg<I_FWOUT>(), *hbias = karg<I_HYBIAS>();
        const float fq = karg<I_FREQ>()[lane]; const float fb1 = karg<I_FB1>()[lane], fb2 = karg<I_FB2>()[lane], fb3 = karg<I_FB3>()[lane];
        for (int it = C.bid; it < 160; it += C.G) {
            const bool smp = it >= 32; const int nbase = (smp ? it - 32 : it) * 8; const int L = smp ? 1024 : 256; const int n = nbase + C.wave;
            float* FILT = WSP(float, WS_ARENA + AR_FILT) + (smp ? 0 : (size_t)1024 * 4096);
            __syncthreads();
            if (lane < 33) {
                float z;
                if (lane == 0) z = (float)n / (float)(L - 1);
                else { const int i = (lane - 1) & 15; const float fr = 1e-4f + (float)i * ((15.0f - 1e-4f) / 15.0f); const float rev = fr * (float)n / (float)L;
                       z = lane <= 16 ? fcos_rev(rev) : -fsin_rev(rev); }
                scr[lane] = z;
            }
            asm volatile("s_waitcnt lgkmcnt(0)" ::: "memory");
            float pre = fb1;
#pragma unroll 3
            for (int e = 0; e < 33; ++e) pre += scr[e] * fw1[e * 64 + lane];
            float hv = fsin(fq * pre);
            asm volatile("s_waitcnt lgkmcnt(0)" ::: "memory");
            scr[64 + lane] = hv;
            asm volatile("s_waitcnt lgkmcnt(0)" ::: "memory");
            pre = fb2;
#pragma unroll 4
            for (int e = 0; e < 64; ++e) pre += scr[64 + e] * fw2[e * 64 + lane];
            hv = fsin(fq * pre);
            asm volatile("s_waitcnt lgkmcnt(0)" ::: "memory");
            scr[128 + lane] = hv;
            asm volatile("s_waitcnt lgkmcnt(0)" ::: "memory");
            pre = fb3;
#pragma unroll 4
            for (int e = 0; e < 64; ++e) pre += scr[128 + e] * fw3[e * 64 + lane];
            hv = fsin(fq * pre);
            scr[1024 + lane] = hv;
            __syncthreads();
            float acc[8][8];
#pragma unroll
            for (int nn = 0; nn < 8; ++nn)
#pragma unroll
                for (int i = 0; i < 8; ++i) acc[nn][i] = 0.f;
            const float* wo = fwout + 512 * C.wave + lane;
#pragma unroll 2
            for (int e = 0; e < 64; ++e) {
                float wv[8];
#pragma unroll
                for (int i = 0; i < 8; ++i) wv[i] = wo[(size_t)e * 4096 + i * 64];
#pragma unroll
                for (int nn = 0; nn < 8; ++nn) { const float hh = ((const LAS float*)(C.lds + nn * 16384))[1024 + e];
#pragma unroll
                    for (int i = 0; i < 8; ++i) acc[nn][i] += hh * wv[i]; }
            }
#pragma unroll
            for (int nn = 0; nn < 8; ++nn) { const int n2 = nbase + nn; const float tn = (float)n2 / (float)(L - 1);
#pragma unroll
                for (int i = 0; i < 8; ++i) {
                    const int o = 512 * C.wave + i * 64 + lane, dir = o >> 11, c = o & 2047;
                    const float delta = -3.0701134573253944f + (float)c * ((-15.350567286626972f + 3.0701134573253944f) / 2047.0f);
                    float val = acc[nn][i] * fexp(-tn * fabsf(delta));
                    if (dir == 0 && n2 == 0) val += hbias[c];
                    FILT[(size_t)n2 * 4096 + o] = val;
                } }
        }
        __syncthreads();
    }
}

__device__ __forceinline__ void phase_fg_transpose(const Ctx& C) {
    const int tid = C.tid;
    LAS float* tl = (LAS float*)C.lds;
    for (int it = C.bid; it < 1280; it += C.G) {
        const bool smp = it < 1024; const int q = smp ? it : it - 1024;
        const int L = smp ? 1024 : 256, ROW = smp ? FGS_ROW : FGP_ROW;
        const int cbk = q & 31, nb = smp ? (q >> 5) & 15 : (q >> 5) & 3, dir = smp ? q >> 9 : q >> 7;
        const float* FILT = WSP(float, WS_ARENA + AR_FILT) + (smp ? 0 : (size_t)1024 * 4096);
        bf16_t* FG = WSP(bf16_t, smp ? WS_FGS : WS_FGP);
        const int n0 = nb * 64 + dir;
        __syncthreads();
        { const int nl = tid >> 3, c8 = tid & 7; const int n = n0 + nl;
          f32x4 a = (f32x4){0.f, 0.f, 0.f, 0.f}, b = a;
          const int nc = n < L ? n : L - 1;
          const float* src = FILT + (size_t)nc * 4096 + dir * 2048 + cbk * 64 + 8 * c8;
          a = *(const f32x4*)src; b = *(const f32x4*)(src + 4);
          if (n >= L) { a = (f32x4){0.f, 0.f, 0.f, 0.f}; b = a; }
          LAS float* d = tl + nl * 65 + 8 * c8;
          d[0] = a.x; d[1] = a.y; d[2] = a.z; d[3] = a.w; d[4] = b.x; d[5] = b.y; d[6] = b.z; d[7] = b.w; }
        __syncthreads();
        { const int cl = tid >> 3, i8 = tid & 7;
          float v[8];
#pragma unroll
          for (int j = 0; j < 8; ++j) { const int il = 8 * i8 + j; const int nl = dir ? il : 63 - il; v[j] = tl[nl * 65 + cl]; }
          const int idx0 = dir ? (L + nb * 64) : (L - 64 - nb * 64);
          u32x4 o; o.x = cvt_pk(v[0], v[1]); o.y = cvt_pk(v[2], v[3]); o.z = cvt_pk(v[4], v[5]); o.w = cvt_pk(v[6], v[7]);
          bf16_t* dst = FG + (size_t)(cbk * 64 + cl) * ROW;
          *(u32x4*)(dst + idx0 + 8 * i8) = o;
          if (dir && nb * 64 + 64 == L) *(u32x4*)(dst + 2 * L + 8 * i8) = (u32x4){0u, 0u, 0u, 0u}; }
    }
    __syncthreads();
}

__device__ __forceinline__ void phase_norm_mod(const Ctx& C, const float* Xp, const float* Xs, const float* g, int layer, int which_sh, bf16_t* H, const bf16_t* P1 = nullptr, float* Xw = nullptr) {
    const int gw = C.bid * 8 + C.wave, NGW = C.G * 8, lane = C.lane;
    for (int m = gw; m < MT; m += NGW) {
        const int cond = cond_of_row(m);
        const float* sh = MODP(layer, cond, which_sh); const float* sc = MODP(layer, cond, which_sh + 1);
        const f32x4* xr = (const f32x4*)(m < MP ? Xp + (size_t)m * D : Xs + (size_t)(m - MP) * D) + lane;
        f32x4 v[8]; float ss = 0.f;
#pragma unroll
        for (int j = 0; j < 8; ++j) { v[j] = xr[64 * j]; if (P1) { const u32x2 pw = ((const u32x2*)(P1 + (size_t)m * D) + lane)[64 * j]; v[j] += (f32x4){bflo(pw.x), bfhi(pw.x), bflo(pw.y), bfhi(pw.y)}; ((f32x4*)(Xw + (size_t)m * D) + lane)[64 * j] = v[j]; }
            ss += (v[j].x * v[j].x + v[j].y * v[j].y) + (v[j].z * v[j].z + v[j].w * v[j].w); }
        const float rstd = __builtin_amdgcn_rsqf(wave_sum(ss) * (1.0f / D) + 1e-6f);
        u32x2* o = (u32x2*)(H + (size_t)m * D) + lane;
#pragma unroll
        for (int j = 0; j < 8; ++j) {
            const f32x4 gv = ((const f32x4*)g)[lane + 64 * j], sv = ((const f32x4*)sh)[lane + 64 * j], cv = ((const f32x4*)sc)[lane + 64 * j];
            const f32x4 y = (v[j] * rstd * gv) * (cv + 1.0f) + sv;
            u32x2 w; w.x = cvt_pk(y.x, y.y); w.y = cvt_pk(y.z, y.w); o[64 * j] = w;
        }
    }
}
__device__ __forceinline__ void phase_norm_final(const Ctx& C, const float* X, const float* g, float* out, const bf16_t* P1 = nullptr) {
    const int gw = C.bid * 8 + C.wave, NGW = C.G * 8, lane = C.lane;
    for (int m = gw; m < MT; m += NGW) {
        const f32x4* xr = (const f32x4*)(X + (size_t)m * D) + lane;
        f32x4 v[8]; float ss = 0.f;
#pragma unroll
        for (int j = 0; j < 8; ++j) { v[j] = xr[64 * j]; if (P1) { const u32x2 pw = ((const u32x2*)(P1 + (size_t)m * D) + lane)[64 * j]; v[j] += (f32x4){bflo(pw.x), bfhi(pw.x), bflo(pw.y), bfhi(pw.y)}; } ss += (v[j].x * v[j].x + v[j].y * v[j].y) + (v[j].z * v[j].z + v[j].w * v[j].w); }
        const float rstd = __builtin_amdgcn_rsqf(wave_sum(ss) * (1.0f / D) + 1e-6f);
        f32x4* o = (f32x4*)(out + (size_t)m * D) + lane;
#pragma unroll
        for (int j = 0; j < 8; ++j) o[64 * j] = v[j] * rstd * ((const f32x4*)g)[lane + 64 * j];
    }
}

__device__ __forceinline__ void unpack8(const u32x4 w, float (&f)[8]) { f[0] = bflo(w.x); f[1] = bfhi(w.x); f[2] = bflo(w.y); f[3] = bfhi(w.y); f[4] = bflo(w.z); f[5] = bfhi(w.z); f[6] = bflo(w.w); f[7] = bfhi(w.w); }
__device__ __forceinline__ u32x4 pack8(const float (&f)[8]) { u32x4 o; o.x = cvt_pk(f[0], f[1]); o.y = cvt_pk(f[2], f[3]); o.z = cvt_pk(f[4], f[5]); o.w = cvt_pk(f[6], f[7]); return o; }
__device__ __forceinline__ void phase_norm_mod_b(const Ctx& C, const bf16_t* X, const float* g, int layer, int which_sh, bf16_t* H, const bf16_t* P1 = nullptr, bf16_t* Xw = nullptr, int p1_row0 = 0) {
    const int gw = C.bid * 8 + C.wave, NGW = C.G * 8, lane = C.lane;
    f32x4 gv[4][2];
#pragma unroll
    for (int j = 0; j < 4; ++j)
#pragma unroll
        for (int h = 0; h < 2; ++h) gv[j][h] = ((const f32x4*)g)[2 * (lane + 64 * j) + h];
    u32x4 xa[4], pa[4]; f32x4 sv[4][2], cv[4][2];
#define NM_LOAD(m_) do { const int cond_ = cond_of_row(m_); const f32x4* sh_ = (const f32x4*)MODP(layer, cond_, which_sh); const f32x4* sc_ = (const f32x4*)MODP(layer, cond_, which_sh + 1); \
        _Pragma("unroll") for (int j = 0; j < 4; ++j) { xa[j] = ((const u32x4*)(X + (size_t)(m_) * D) + lane)[64 * j]; if (P1 && (m_) >= p1_row0) pa[j] = ((const u32x4*)(P1 + (size_t)(m_) * D) + lane)[64 * j]; } \
        _Pragma("unroll") for (int j = 0; j < 4; ++j) { _Pragma("unroll") for (int h = 0; h < 2; ++h) { const int ci_ = 2 * (lane + 64 * j) + h; sv[j][h] = sh_[ci_]; cv[j][h] = sc_[ci_]; } } } while (0)
    int m = gw;
    if (m < MT) NM_LOAD(m);
    for (; m < MT; m += NGW) {
        const bool fold = P1 && m >= p1_row0;
        float v[4][8]; float ss = 0.f;
#pragma unroll
        for (int j = 0; j < 4; ++j) {
            unpack8(xa[j], v[j]);
            if (fold) { float p[8]; unpack8(pa[j], p);
#pragma unroll
                for (int e = 0; e < 8; ++e) v[j][e] += p[e]; }
#pragma unroll
            for (int e = 0; e < 8; ++e) ss += v[j][e] * v[j][e];
        }
        const float rstd = __builtin_amdgcn_rsqf(wave_sum(ss) * (1.0f / D) + 1e-6f);
        u32x4 xo[4], ho[4];
#pragma unroll
        for (int j = 0; j < 4; ++j) {
            if (fold) xo[j] = pack8(v[j]);
            float y[8];
#pragma unroll
            for (int h = 0; h < 2; ++h)
#pragma unroll
                for (int e = 0; e < 4; ++e) y[4 * h + e] = (v[j][4 * h + e] * rstd * gv[j][h][e]) * (cv[j][h][e] + 1.0f) + sv[j][h][e];
            ho[j] = pack8(y);
        }
        const int mn = m + NGW;
        if (mn < MT) NM_LOAD(mn);
        asm volatile("" ::: "memory");
#pragma unroll
        for (int j = 0; j < 4; ++j) { if (fold) ((u32x4*)(Xw + (size_t)m * D) + lane)[64 * j] = xo[j]; ((u32x4*)(H + (size_t)m * D) + lane)[64 * j] = ho[j]; }
    }
#undef NM_LOAD
}
__device__ __forceinline__ void phase_norm_final_b(const Ctx& C, const bf16_t* X, const float* g, float* out, const bf16_t* P1 = nullptr, int p1_row0 = 0) {
    const int gw = C.bid * 8 + C.wave, NGW = C.G * 8, lane = C.lane;
    for (int m = gw; m < MT; m += NGW) {
        const u32x4* xr = (const u32x4*)(X + (size_t)m * D) + lane;
        float v[4][8]; float ss = 0.f;
#pragma unroll
        for (int j = 0; j < 4; ++j) {
            unpack8(xr[64 * j], v[j]);
            if (P1 && m >= p1_row0) { float p[8]; unpack8(((const u32x4*)(P1 + (size_t)m * D) + lane)[64 * j], p);
#pragma unroll
                for (int e = 0; e < 8; ++e) v[j][e] += p[e]; }
#pragma unroll
            for (int e = 0; e < 8; ++e) ss += v[j][e] * v[j][e];
        }
        const float rstd = __builtin_amdgcn_rsqf(wave_sum(ss) * (1.0f / D) + 1e-6f);
        f32x4* o = (f32x4*)(out + (size_t)m * D);
#pragma unroll
        for (int j = 0; j < 4; ++j)
#pragma unroll
            for (int h = 0; h < 2; ++h) {
                const int ci = 2 * (lane + 64 * j) + h;
                const f32x4 gv = ((const f32x4*)g)[ci];
                f32x4 y;
#pragma unroll
                for (int e = 0; e < 4; ++e) y[e] = v[j][4 * h + e] * rstd * gv[e];
                o[ci] = y;
            }
    }
}

using pg8::Unit;
constexpr int HALF = 128;

struct EpiResidual {
    static constexpr bool PERM = false, AFTER_DRAIN = false;
    float* X; const float* gate_base;
    const float *Bp, *Bs;
    __device__ __forceinline__ void operator()(const f32x4 (&acc)[2][2][4][2], const Unit& u, int wr, int wc, int fr, int fq) const {
        const int row0 = u.pm * 256 + wr * 64 + fr, col0 = u.pn * 256 + wc * 32 + 4 * fq;
        const float* gp = gate_base + (size_t)cond_of_panel(u.pm) * 6 * D + col0;
        f32x4 gv[2][2];
#pragma unroll
        for (int bj = 0; bj < 2; ++bj)
#pragma unroll
            for (int n = 0; n < 2; ++n) gv[bj][n] = *(const f32x4*)(gp + bj * HALF + n * 16);
        const float* sbase = (u.pm < 16 ? Bp + (size_t)row0 * D : Bs + (size_t)(row0 - MP) * D) + col0;
#pragma unroll
        for (int ai = 0; ai < 2; ++ai) {
            f32x4 q[4][2][2];
#pragma unroll
            for (int m = 0; m < 4; ++m)
#pragma unroll
                for (int bj = 0; bj < 2; ++bj)
#pragma unroll
                    for (int n = 0; n < 2; ++n) if ((u.mask >> (ai * 2 + bj)) & 1) q[m][bj][n] = *(const f32x4*)(sbase + (size_t)(ai * HALF + m * 16) * D + bj * HALF + n * 16);
#pragma unroll
            for (int m = 0; m < 4; ++m) { float* rowp = X + (size_t)(row0 + ai * HALF + m * 16) * D + col0;
#pragma unroll
                for (int bj = 0; bj < 2; ++bj)
#pragma unroll
                    for (int n = 0; n < 2; ++n) if ((u.mask >> (ai * 2 + bj)) & 1) *(f32x4*)(rowp + bj * HALF + n * 16) = q[m][bj][n] + gv[bj][n] * acc[ai][bj][m][n]; }
            asm volatile("" ::: "memory");
        }
    }
};
template <int ACT> struct EpiBf16 {
    static constexpr bool PERM = true, AFTER_DRAIN = false;
    bf16_t* O; int ldc;
    __device__ __forceinline__ void operator()(const f32x4 (&acc)[2][2][4][2], const Unit& u, int wr, int wc, int fr, int fq) const {
        const int row0 = u.pm * 256 + wr * 64 + fr, col0 = u.pn * 256 + wc * 32 + 8 * fq;
#pragma unroll
        for (int ai = 0; ai < 2; ++ai)
#pragma unroll
            for (int m = 0; m < 4; ++m) { bf16_t* rowp = O + (size_t)(row0 + ai * HALF + m * 16) * ldc + col0;
#pragma unroll
                for (int bj = 0; bj < 2; ++bj) { if (!((u.mask >> (ai * 2 + bj)) & 1)) continue; f32x4 v0 = acc[ai][bj][m][0], v1 = acc[ai][bj][m][1];
                    if (ACT == 1) {
#pragma unroll
                        for (int j = 0; j < 4; ++j) { const float a = fmaxf(v0[j], 0.f), b = fmaxf(v1[j], 0.f); v0[j] = a * a; v1[j] = b * b; } }
                    u32x4 w; w.x = cvt_pk(v0[0], v0[1]); w.y = cvt_pk(v0[2], v0[3]); w.z = cvt_pk(v1[0], v1[1]); w.w = cvt_pk(v1[2], v1[3]);
                    *(u32x4*)(rowp + bj * HALF) = w; } }
    }
};
struct EpiQKV {
    static constexpr bool PERM = true, AFTER_DRAIN = false;
    bf16_t *Q, *K, *V; float *NK, *NV;
    __device__ __forceinline__ void operator()(const f32x4 (&acc)[2][2][4][2], const Unit& u, int wr, int wc, int fr, int fq) const {
        const int row0 = u.pm * 256 + wr * 64 + fr; const int cin = wc * 32 + 8 * fq;
        bf16_t* base; int ldc, colt; float* fo = nullptr;
        if (u.pn < 8) { base = Q; ldc = 2048; colt = u.pn * 256; }
        else if (u.pn < 10) { base = K; ldc = 512; colt = (u.pn - 8) * 256; if (u.pm < 16) fo = NK; }
        else { base = V; ldc = 512; colt = (u.pn - 10) * 256; if (u.pm < 16) fo = NV; }
#pragma unroll
        for (int ai = 0; ai < 2; ++ai)
#pragma unroll
            for (int m = 0; m < 4; ++m) { const int r = row0 + ai * HALF + m * 16; bf16_t* rowp = base + (size_t)r * ldc + colt + cin;
#pragma unroll
                for (int bj = 0; bj < 2; ++bj) { if (!((u.mask >> (ai * 2 + bj)) & 1)) continue; const f32x4 v0 = acc[ai][bj][m][0], v1 = acc[ai][bj][m][1];
                    u32x4 w; w.x = cvt_pk(v0[0], v0[1]); w.y = cvt_pk(v0[2], v0[3]); w.z = cvt_pk(v1[0], v1[1]); w.w = cvt_pk(v1[2], v1[3]);
                    *(u32x4*)(rowp + bj * HALF) = w;
                    if (fo) { float* fp = fo + ((size_t)(r >> 8) * 512 + (r & 255)) * 512 + colt + cin + bj * HALF; *(f32x4*)fp = v0; *(f32x4*)(fp + 4) = v1; } } }
    }
};
__device__ __forceinline__ size_t hm_index(int m, int c) { return ((size_t)(c >> 6) * MT + m) * 64 + (c & 63); }
struct EpiRw1 {
    static constexpr bool PERM = true, AFTER_DRAIN = false;
    bf16_t *R, *A3;
    const float* k_k; float* invsq;
    __device__ __forceinline__ void operator()(const f32x4 (&acc)[2][2][4][2], const Unit& u, int wr, int wc, int fr, int fq) const {
        const int ct = u.pn, panel = u.pm % NPANEL;
        const int row0 = panel * 256 + wr * 64 + fr; const int cin = wc * 32 + 8 * fq;
        bf16_t* base; int ldc, colt, act = 0;
        if (ct < 24) { base = R + (size_t)(ct >> 3) * MT * D; ldc = D; colt = (ct & 7) * 256; }
        else { base = A3 + (size_t)(ct - 24) * MT * 256; ldc = 256; colt = 0; act = ct - 23; }
#pragma unroll
        for (int ai = 0; ai < 2; ++ai)
#pragma unroll
            for (int m = 0; m < 4; ++m) { const int rrow = row0 + ai * HALF + m * 16; bf16_t* rowp = base + (size_t)rrow * ldc + colt + cin;
#pragma unroll
                for (int bj = 0; bj < 2; ++bj) { if (!((u.mask >> (ai * 2 + bj)) & 1)) continue; f32x4 v0 = acc[ai][bj][m][0], v1 = acc[ai][bj][m][1];
                    if (act == 1) {
#pragma unroll
                        for (int j = 0; j < 4; ++j) { v0[j] = ftanh(v0[j]); v1[j] = ftanh(v1[j]); } }
                    else if (act == 3) {
#pragma unroll
                        for (int j = 0; j < 4; ++j) { v0[j] = fsigmoid(v0[j]); v1[j] = fsigmoid(v1[j]); } }
                    u32x4 w; w.x = cvt_pk(v0[0], v0[1]); w.y = cvt_pk(v0[2], v0[3]); w.z = cvt_pk(v1[0], v1[1]); w.w = cvt_pk(v1[2], v1[3]);
                    if (ct < 24) *(u32x4*)(base + hm_index(rrow, colt + cin + bj * HALF)) = w; else *(u32x4*)(rowp + bj * HALF) = w;
} }
    }
};
struct EpiRw2 {
    static constexpr bool PERM = true, AFTER_DRAIN = false;
    bf16_t *LD, *LA, *Gt; const float *w0, *a0;
    __device__ __forceinline__ void operator()(const f32x4 (&acc)[2][2][4][2], const Unit& u, int wr, int wc, int fr, int fq) const {
        const int ct = u.pn, panel = u.pm % NPANEL, grp = ct >> 3;
        const int row0 = panel * 256 + wr * 64 + fr; const int col0 = (ct & 7) * 256 + wc * 32 + 8 * fq;
        bf16_t* base; const float* bias = nullptr;
        if (grp < 2) { base = LD + (size_t)grp * MT * D; bias = w0 + grp * D; }
        else if (grp < 4) { base = LA + (size_t)(grp - 2) * MT * D; bias = a0 + (grp - 2) * D; }
        else base = Gt;
        f32x4 bv[2][2];
#pragma unroll
        for (int bj = 0; bj < 2; ++bj)
#pragma unroll
            for (int n = 0; n < 2; ++n) bv[bj][n] = bias ? *(const f32x4*)(bias + col0 + bj * HALF + 4 * n) : (f32x4){0.f, 0.f, 0.f, 0.f};
#pragma unroll
        for (int ai = 0; ai < 2; ++ai)
#pragma unroll
            for (int m = 0; m < 4; ++m) { const int rrow = row0 + ai * HALF + m * 16; bf16_t* rowp = base + (size_t)rrow * D + col0;
#pragma unroll
                for (int bj = 0; bj < 2; ++bj) {
                    f32x4 v0 = acc[ai][bj][m][0] + bv[bj][0], v1 = acc[ai][bj][m][1] + bv[bj][1];
                    if (grp < 2) {
#pragma unroll
                        for (int j = 0; j < 4; ++j) { v0[j] = -fexp(-fsoftplus(-v0[j]) - 0.5f); v1[j] = -fexp(-fsoftplus(-v1[j]) - 0.5f); } }
                    u32x4 w; w.x = cvt_pk(v0[0], v0[1]); w.y = cvt_pk(v0[2], v0[3]); w.z = cvt_pk(v1[0], v1[1]); w.w = cvt_pk(v1[2], v1[3]);
                    if (grp < 4) *(u32x4*)(base + hm_index(rrow, col0 + bj * HALF)) = w; else *(u32x4*)(rowp + bj * HALF) = w; }
                asm volatile("" : "+v"(bv[0][0]), "+v"(bv[0][1]), "+v"(bv[1][0]), "+v"(bv[1][1]));
            }
    }
};
struct RwOrder1 {
    int G, c, lo, hi; bool xcd;
    __device__ __forceinline__ bool next(int i, Unit& u) const { const int L = lo + i * G + c; if (L >= hi) return false; u.mask = 15;
        int panel, ct;
        if (xcd) {
            if (L < 1280) {
                const int cc = L & 255, T = (((L >> 8) * 8 + (cc & 7)) << 5) + (cc >> 3);
                if (T < 1056) { const int blk = T >> 5, j = T & 31, pq = blk / 3, g = blk - 3 * pq; panel = pq * 4 + (j >> 3); ct = g * 8 + (j & 7); }
                else if (T < 1120) { const int blk = (T - 1056) >> 5, j = T & 31; panel = 44 + (j >> 3); ct = (1 + blk) * 8 + (j & 7); }
                else { const int U = T - 1120; if (U < 16) { panel = 44 + (U >> 3); ct = U & 7; } else { const int q = U - 16; panel = q / 3; ct = 24 + q - 3 * panel; } }
            } else { const int q = L - 1280; panel = 46 + (q >> 3); ct = q & 7; }
        } else { panel = L / 27; ct = L % 27; }
        const int ai = ct < 24 ? (ct >> 3) : ct - 21; u.pm = ai * NPANEL + panel; u.pn = ct; u.kh = 0; return true; }
    __device__ __forceinline__ void a_ready(const Unit&) const {}
    __device__ __forceinline__ void done(const Unit&) const {}
};
struct RwOrder2 {
    int G, c; unsigned* cnt; unsigned need;
    __device__ __forceinline__ bool next(int i, Unit& u) const {
        int panel, ct;
        if (G == 240) {
            if (i >= 8) return false; const int x = c & 7, j = c >> 3; panel = 6 * i + j / 5; ct = 5 * x + j % 5;
        } else { const int L = i * G + c; if (L >= 40 * NPANEL) return false; panel = L / 40; ct = L % 40; }
        const int ai = ct < 16 ? 0 : (ct < 32 ? 1 : 2); u.pm = ai * NPANEL + panel; u.pn = ct; u.kh = 0; u.mask = 15; return true; }
    __device__ __forceinline__ void a_ready(const Unit& u) const {
        if (cnt && (u.pm % NPANEL) == NPANEL - 1) {
            unsigned sp = 0u;
            while (xb_ld(cnt) < need) { __builtin_amdgcn_s_sleep(2); if (++sp > (1u << 24)) break; }
            __builtin_amdgcn_fence(__ATOMIC_ACQUIRE, "agent");
            asm volatile("s_waitcnt vmcnt(0)" ::: "memory");
        }
    }
    __device__ __forceinline__ void done(const Unit&) const {}
};

struct SplitOrder {
    pg8::StaticOrder so; int G, c, ntiles;
    __device__ __forceinline__ void init(int N, int G_, int c_) { so.init(MT, N, G_, c_); G = G_; c = c_; ntiles = so.nwg; }
    __device__ __forceinline__ bool next(int i, Unit& u) const { const int L = i * G + c; if (L >= 2 * ntiles) return false; const int kh = L >= ntiles; so.map(kh ? L - ntiles : L, u); u.kh = kh; u.mask = 15; return true; }
    __device__ __forceinline__ void a_ready(const Unit&) const {}
    __device__ __forceinline__ void done(const Unit&) const {}
};
struct EpiResidualSplit {
    static constexpr bool PERM = false, AFTER_DRAIN = false;
    float* X; const float* gate_base; bf16_t* P1;
    __device__ __forceinline__ void operator()(const f32x4 (&acc)[2][2][4][2], const Unit& u, int wr, int wc, int fr, int fq) const {
        const int row0 = u.pm * 256 + wr * 64 + fr, col0 = u.pn * 256 + wc * 32 + 4 * fq;
        const float* gp = gate_base + (size_t)cond_of_panel(u.pm) * 6 * D + col0;
        f32x4 gv[2][2];
#pragma unroll
        for (int bj = 0; bj < 2; ++bj)
#pragma unroll
            for (int n = 0; n < 2; ++n) gv[bj][n] = *(const f32x4*)(gp + bj * HALF + n * 16);
        if (u.kh == 0) {
#pragma unroll
            for (int ai = 0; ai < 2; ++ai) {
                f32x4 q[4][2][2];
#pragma unroll
                for (int m = 0; m < 4; ++m)
#pragma unroll
                    for (int bj = 0; bj < 2; ++bj)
#pragma unroll
                        for (int n = 0; n < 2; ++n) q[m][bj][n] = *(const f32x4*)(X + (size_t)(row0 + ai * HALF + m * 16) * D + col0 + bj * HALF + n * 16);
#pragma unroll
                for (int m = 0; m < 4; ++m) { float* rowp = X + (size_t)(row0 + ai * HALF + m * 16) * D + col0;
#pragma unroll
                    for (int bj = 0; bj < 2; ++bj)
#pragma unroll
                        for (int n = 0; n < 2; ++n) *(f32x4*)(rowp + bj * HALF + n * 16) = q[m][bj][n] + gv[bj][n] * acc[ai][bj][m][n]; }
                asm volatile("" ::: "memory");
            }
        } else {
#pragma unroll
            for (int ai = 0; ai < 2; ++ai)
#pragma unroll
                for (int m = 0; m < 4; ++m) { bf16_t* rowp = P1 + (size_t)(row0 + ai * HALF + m * 16) * D + col0;
#pragma unroll
                    for (int bj = 0; bj < 2; ++bj)
#pragma unroll
                        for (int n = 0; n < 2; ++n) { const f32x4 v = gv[bj][n] * acc[ai][bj][m][n]; u32x2 w; w.x = cvt_pk(v.x, v.y); w.y = cvt_pk(v.z, v.w); *(u32x2*)(rowp + bj * HALF + n * 16) = w; } }
        }
    }
};

template <bool SRCF32> struct EpiResidualB {
    static constexpr bool PERM = true, AFTER_DRAIN = false;
    bf16_t* X; const float* gate_base; const float *Bp, *Bs;
    __device__ __forceinline__ void operator()(const f32x4 (&acc)[2][2][4][2], const Unit& u, int wr, int wc, int fr, int fq) const {
        const int row0 = u.pm * 256 + wr * 64 + fr, col0 = u.pn * 256 + wc * 32 + 8 * fq;
        const float* gp = gate_base + (size_t)cond_of_panel(u.pm) * 6 * D + col0;
        f32x4 gv[2][2];
#pragma unroll
        for (int bj = 0; bj < 2; ++bj)
#pragma unroll
            for (int n = 0; n < 2; ++n) gv[bj][n] = *(const f32x4*)(gp + bj * HALF + 4 * n);
#pragma unroll
        for (int ai = 0; ai < 2; ++ai) {
            if constexpr (SRCF32) {
                const float* sbase = (u.pm < 16 ? Bp + (size_t)row0 * D : Bs + (size_t)(row0 - MP) * D) + col0;
                f32x4 q[4][2][2];
#pragma unroll
                for (int m = 0; m < 4; ++m)
#pragma unroll
                    for (int bj = 0; bj < 2; ++bj)
#pragma unroll
                        for (int n = 0; n < 2; ++n) q[m][bj][n] = *(const f32x4*)(sbase + (size_t)(ai * HALF + m * 16) * D + bj * HALF + 4 * n);
#pragma unroll
                for (int m = 0; m < 4; ++m) { bf16_t* rowp = X + (size_t)(row0 + ai * HALF + m * 16) * D + col0;
#pragma unroll
                    for (int bj = 0; bj < 2; ++bj) { const f32x4 v0 = q[m][bj][0] + gv[bj][0] * acc[ai][bj][m][0], v1 = q[m][bj][1] + gv[bj][1] * acc[ai][bj][m][1];
                        u32x4 w; w.x = cvt_pk(v0.x, v0.y); w.y = cvt_pk(v0.z, v0.w); w.z = cvt_pk(v1.x, v1.y); w.w = cvt_pk(v1.z, v1.w); *(u32x4*)(rowp + bj * HALF) = w; } }
            } else {
                u32x4 q[4][2];
#pragma unroll
                for (int m = 0; m < 4; ++m)
#pragma unroll
                    for (int bj = 0; bj < 2; ++bj) q[m][bj] = *(const u32x4*)(X + (size_t)(row0 + ai * HALF + m * 16) * D + col0 + bj * HALF);
#pragma unroll
                for (int m = 0; m < 4; ++m) { bf16_t* rowp = X + (size_t)(row0 + ai * HALF + m * 16) * D + col0;
#pragma unroll
                    for (int bj = 0; bj < 2; ++bj) { const u32x4 o = q[m][bj];
                        const f32x4 v0 = (f32x4){bflo(o.x), bfhi(o.x), bflo(o.y), bfhi(o.y)} + gv[bj][0] * acc[ai][bj][m][0], v1 = (f32x4){bflo(o.z), bfhi(o.z), bflo(o.w), bfhi(o.w)} + gv[bj][1] * acc[ai][bj][m][1];
                        u32x4 w; w.x = cvt_pk(v0.x, v0.y); w.y = cvt_pk(v0.z, v0.w); w.z = cvt_pk(v1.x, v1.y); w.w = cvt_pk(v1.z, v1.w); *(u32x4*)(rowp + bj * HALF) = w; } }
            }
            asm volatile("" ::: "memory");
        }
    }
};
struct EpiResidualSplitB {
    static constexpr bool PERM = true, AFTER_DRAIN = false;
    bf16_t* X; const float* gate_base; bf16_t* P1;
    __device__ __forceinline__ void operator()(const f32x4 (&acc)[2][2][4][2], const Unit& u, int wr, int wc, int fr, int fq) const {
        const int row0 = u.pm * 256 + wr * 64 + fr, col0 = u.pn * 256 + wc * 32 + 8 * fq;
        const float* gp = gate_base + (size_t)cond_of_panel(u.pm) * 6 * D + col0;
        f32x4 gv[2][2];
#pragma unroll
        for (int bj = 0; bj < 2; ++bj)
#pragma unroll
            for (int n = 0; n < 2; ++n) gv[bj][n] = *(const f32x4*)(gp + bj * HALF + 4 * n);
        if (u.kh == 0) {
#pragma unroll
            for (int ai = 0; ai < 2; ++ai) {
                u32x4 q[4][2];
#pragma unroll
                for (int m = 0; m < 4; ++m)
#pragma unroll
                    for (int bj = 0; bj < 2; ++bj) q[m][bj] = *(const u32x4*)(X + (size_t)(row0 + ai * HALF + m * 16) * D + col0 + bj * HALF);
#pragma unroll
                for (int m = 0; m < 4; ++m) { bf16_t* rowp = X + (size_t)(row0 + ai * HALF + m * 16) * D + col0;
#pragma unroll
                    for (int bj = 0; bj < 2; ++bj) { const u32x4 o = q[m][bj];
                        const f32x4 v0 = (f32x4){bflo(o.x), bfhi(o.x), bflo(o.y), bfhi(o.y)} + gv[bj][0] * acc[ai][bj][m][0], v1 = (f32x4){bflo(o.z), bfhi(o.z), bflo(o.w), bfhi(o.w)} + gv[bj][1] * acc[ai][bj][m][1];
                        u32x4 w; w.x = cvt_pk(v0.x, v0.y); w.y = cvt_pk(v0.z, v0.w); w.z = cvt_pk(v1.x, v1.y); w.w = cvt_pk(v1.z, v1.w); *(u32x4*)(rowp + bj * HALF) = w; } }
                asm volatile("" ::: "memory");
            }
        } else {
#pragma unroll
            for (int ai = 0; ai < 2; ++ai)
#pragma unroll
                for (int m = 0; m < 4; ++m) { bf16_t* rowp = P1 + (size_t)(row0 + ai * HALF + m * 16) * D + col0;
#pragma unroll
                    for (int bj = 0; bj < 2; ++bj) { const f32x4 v0 = gv[bj][0] * acc[ai][bj][m][0], v1 = gv[bj][1] * acc[ai][bj][m][1];
                        u32x4 w; w.x = cvt_pk(v0.x, v0.y); w.y = cvt_pk(v0.z, v0.w); w.z = cvt_pk(v1.x, v1.y); w.w = cvt_pk(v1.z, v1.w); *(u32x4*)(rowp + bj * HALF) = w; } }
        }
    }
};
struct TailSplitOrder {
    pg8::StaticOrder sf, st; int G, c, ntf;
    __device__ __forceinline__ void init(int G_, int c_, int ntf_ = 32) { sf.init(8192, D, G_, c_); st.init(4096, D, G_, c_); G = G_; c = c_; ntf = ntf_; }
    __device__ __forceinline__ bool next(int i, Unit& u) const {
        const int L = i * G + c; if (L >= 512) return false;
        if (L < 256) { sf.map(L, u); u.kh = 0; u.nt = ntf; }
        else { const int h = L - 256, kh = h >= 128; st.map(kh ? h - 128 : h, u); u.pm += 32; u.kh = kh; u.nt = ntf >> 1; }
        u.mask = 15; return true; }
    __device__ __forceinline__ void a_ready(const Unit&) const {}
    __device__ __forceinline__ void done(const Unit&) const {}
};


typedef short s16x4 __attribute__((ext_vector_type(4)));
constexpr int KS_STRIDE = 136;
constexpr int VT_STRIDE = 72;
constexpr int ATT_KS_OFF = 0, ATT_VT_OFF = 64 * KS_STRIDE * 2, ATT_BUF_BYTES = 36864;

__device__ __forceinline__ void rope8(u32x4& a, u32x4& b, const f32x2* tab) {
    unsigned* pa = (unsigned*)&a; unsigned* pb = (unsigned*)&b;
#pragma unroll
    for (int w = 0; w < 4; ++w) {
        const f32x4 cs = *(const f32x4*)(tab + 2 * w);
        const float x1l = bflo(pa[w]), x1h = bfhi(pa[w]), x2l = bflo(pb[w]), x2h = bfhi(pb[w]);
        const float o1l = x1l * cs.x - x2l * cs.y, o2l = x1l * cs.y + x2l * cs.x;
        const float o1h = x1h * cs.z - x2h * cs.w, o2h = x1h * cs.w + x2h * cs.z;
        pa[w] = cvt_pk(o1l, o1h); pb[w] = cvt_pk(o2l, o2h);
    }
}

__device__ __forceinline__ void phase_attention(const Ctx& C, const bf16_t* Q, const bf16_t* Kb, const bf16_t* Vb, const bf16_t* KC, const bf16_t* VC, const float* sink, bf16_t* O) {
    const int tid = C.tid, lane = C.lane, w = C.wave, h = lane >> 5, lq = lane & 31;
    LAS bf16_t* Ks = (LAS bf16_t*)(C.lds + ATT_KS_OFF);
    LAS bf16_t* Vt = (LAS bf16_t*)(C.lds + ATT_VT_OFF);
    const f32x2* rope = WSP(f32x2, WS_ROPE);
    const float c2 = 0.08838834764831845f * 1.4426950408889634f;
    for (int it = C.bid; it < 768; it += C.G) {
        const bool smp = it < 512;
        int bb, kvh, qb, R0;
        if (smp) { bb = it >> 6; kvh = (it >> 4) & 3; qb = it & 15; R0 = MP + bb * 1024; }
        else { const int p = it - 512; bb = p >> 4; kvh = (p >> 2) & 3; qb = p & 3; R0 = bb * 256; }
        const int head = kvh * 4 + (w >> 1);
        const int t = qb * 64 + (w & 1) * 32 + lq;
        u32x4 qf[8];
        { const bf16_t* qp = Q + (size_t)(R0 + t) * D + head * 128 + 8 * h;
#pragma unroll
          for (int ks = 0; ks < 8; ++ks) qf[ks] = *(const u32x4*)(qp + 16 * ks); }
        if (smp) {
#pragma unroll
            for (int half = 0; half < 2; ++half) { const int pos = half ? (t & 63) : (t >> 6);
#pragma unroll
                for (int kk = 0; kk < 2; ++kk) rope8(qf[4 * half + kk], qf[4 * half + kk + 2], rope + pos * 32 + 16 * kk + 8 * h); }
        }
        f32x16 o[4];
#pragma unroll
        for (int db = 0; db < 4; ++db)
#pragma unroll
            for (int r = 0; r < 16; ++r) o[db][r] = 0.f;
        float mrun = -1e30f, lrun = 0.f;
        const int li0 = smp ? (qb >= 2 ? 0 : 2 - qb) : 0, li1 = smp ? (17 - qb < 4 ? 17 - qb : 4) : 0;
        const int ntot = smp ? 8 + (li1 - li0 + 1) : 4;
        const int key = tid >> 3, cc = tid & 7, c1 = (cc & 3) + (cc >> 2) * 8;
#define ATT_TILE(i, kp_, vp_, k0_, loc_) do { if (smp) { if ((i) < 8) { const size_t off_ = ((size_t)(bb * 2) * 512 + (i) * 64) * 512 + kvh * 128; kp_ = KC + off_; vp_ = VC + off_; k0_ = 0; loc_ = false; } \
            else { k0_ = qb * 64 - 128 + 64 * ((i) - 8 + li0); loc_ = true; const size_t off_ = (size_t)(R0 + k0_) * 512 + kvh * 128; kp_ = Kb + off_; vp_ = Vb + off_; } } \
          else { k0_ = (i) * 64; loc_ = false; const size_t off_ = (size_t)(R0 + k0_) * 512 + kvh * 128; kp_ = Kb + off_; vp_ = Vb + off_; } } while (0)
        u32x4 ka, kb2, va, vb2;
#define ATT_LOAD(i) do { const bf16_t *kp_, *vp_; int k0_; bool loc_; ATT_TILE(i, kp_, vp_, k0_, loc_); (void)k0_; (void)loc_; \
          ka = *(const u32x4*)(kp_ + (size_t)key * 512 + 8 * c1); kb2 = *(const u32x4*)(kp_ + (size_t)key * 512 + 8 * c1 + 32); \
          va = *(const u32x4*)(vp_ + (size_t)key * 512 + 8 * c1); vb2 = *(const u32x4*)(vp_ + (size_t)key * 512 + 8 * c1 + 32); } while (0)
#define ATT_STAGE(i, KsB, VtB) do { const bf16_t *kp_, *vp_; int k0_; bool loc_; ATT_TILE(i, kp_, vp_, k0_, loc_); (void)kp_; (void)vp_; \
          if (loc_) { const int kpos = k0_ + key; const int pos = (cc >> 2) ? (kpos & 63) : (kpos >> 6); rope8(ka, kb2, rope + pos * 32 + 8 * (cc & 3)); } \
          *(LAS u32x4*)((KsB) + key * KS_STRIDE + 8 * c1) = ka; *(LAS u32x4*)((KsB) + key * KS_STRIDE + 8 * c1 + 32) = kb2; \
          *(LAS u32x4*)((VtB) + key * KS_STRIDE + 8 * c1) = va; *(LAS u32x4*)((VtB) + key * KS_STRIDE + 8 * c1 + 32) = vb2; } while (0)
        ATT_LOAD(0); ATT_STAGE(0, Ks, Vt); if (ntot > 1) ATT_LOAD(1);
        __syncthreads();
        for (int ti = 0; ti < ntot; ++ti) {
            const bf16_t *kp, *vp; int k0; bool local; ATT_TILE(ti, kp, vp, k0, local); (void)kp; (void)vp;
            LAS bf16_t* Ks = (LAS bf16_t*)(C.lds + (ti & 1) * ATT_BUF_BYTES + ATT_KS_OFF);
            LAS bf16_t* Vt = (LAS bf16_t*)(C.lds + (ti & 1) * ATT_BUF_BYTES + ATT_VT_OFF);
            f32x16 s0, s1;
            { const float z0 = opaque_zero();
#pragma unroll
            for (int r = 0; r < 16; ++r) { s0[r] = z0; s1[r] = z0; } }
#pragma unroll
            for (int ks = 0; ks < 8; ++ks) {
                const bf16x8 a0 = *(const LAS bf16x8*)(Ks + lq * KS_STRIDE + 16 * ks + 8 * h);
                const bf16x8 a1 = *(const LAS bf16x8*)(Ks + (32 + lq) * KS_STRIDE + 16 * ks + 8 * h);
                const bf16x8 bq = __builtin_bit_cast(bf16x8, qf[ks]);
                s0 = __builtin_amdgcn_mfma_f32_32x32x16_bf16(a0, bq, s0, 0, 0, 0);
                s1 = __builtin_amdgcn_mfma_f32_32x32x16_bf16(a1, bq, s1, 0, 0, 0);
            }
            if (local) {
#pragma unroll
                for (int r = 0; r < 16; ++r) {
                    const int kl = (r & 3) + 8 * (r >> 2) + 4 * h;
                    const int d0 = k0 + kl - t, d1 = d0 + 32;
                    s0[r] = ((d0 <= 128) && (d0 >= -128)) ? s0[r] : -1e30f; s1[r] = ((d1 <= 128) && (d1 >= -128)) ? s1[r] : -1e30f;
                }
            }
            float mx = fmaxf(s0[0], s1[0]);
#pragma unroll
            for (int r = 1; r < 16; ++r) mx = fmaxf(mx, fmaxf(s0[r], s1[r]));
            mx = fmaxf(mx, __shfl_xor(mx, 32));
            const float mnew = fmaxf(mrun, mx * c2);
            const float alpha = fexp2(mrun - mnew);
            float ps = 0.f;
#pragma unroll
            for (int r = 0; r < 16; ++r) {
                const float p0 = fexp2(__builtin_fmaf(s0[r], c2, -mnew)), p1 = fexp2(__builtin_fmaf(s1[r], c2, -mnew));
                s0[r] = p0; s1[r] = p1; ps += p0 + p1;
            }
            lrun = lrun * alpha + ps; mrun = mnew;
            if (__any(alpha != 1.0f)) {
#pragma unroll
                for (int db = 0; db < 4; ++db)
#pragma unroll
                    for (int r = 0; r < 16; ++r) o[db][r] *= alpha;
            }
            u32x4 pf[4];
#pragma unroll
            for (int s = 0; s < 2; ++s) {
                pf[s].x = cvt_pk(s0[8 * s + 0], s0[8 * s + 1]); pf[s].y = cvt_pk(s0[8 * s + 2], s0[8 * s + 3]); pf[s].z = cvt_pk(s0[8 * s + 4], s0[8 * s + 5]); pf[s].w = cvt_pk(s0[8 * s + 6], s0[8 * s + 7]);
                pf[2 + s].x = cvt_pk(s1[8 * s + 0], s1[8 * s + 1]); pf[2 + s].y = cvt_pk(s1[8 * s + 2], s1[8 * s + 3]); pf[2 + s].z = cvt_pk(s1[8 * s + 4], s1[8 * s + 5]); pf[2 + s].w = cvt_pk(s1[8 * s + 6], s1[8 * s + 7]);
            }
#pragma unroll
            for (int db = 0; db < 4; ++db)
#pragma unroll
                for (int s2 = 0; s2 < 4; ++s2) {
                    const LAS bf16_t* vr = Vt + (16 * s2 + 4 * (lane >> 5) + ((lane & 15) >> 2)) * KS_STRIDE + 32 * db + 16 * ((lane >> 4) & 1) + 4 * (lane & 3);
                    const s16x4 lo = __builtin_amdgcn_ds_read_tr16_b64_v4i16((LAS s16x4*)vr), hi = __builtin_amdgcn_ds_read_tr16_b64_v4i16((LAS s16x4*)(vr + 8 * KS_STRIDE));
                    const u32x2 lo2 = __builtin_bit_cast(u32x2, lo), hi2 = __builtin_bit_cast(u32x2, hi);
                    u32x4 av; av.x = lo2.x; av.y = lo2.y; av.z = hi2.x; av.w = hi2.y;
                    o[db] = __builtin_amdgcn_mfma_f32_32x32x16_bf16(__builtin_bit_cast(bf16x8, av), __builtin_bit_cast(bf16x8, pf[s2]), o[db], 0, 0, 0);
                }
            if (ti + 1 < ntot) {
                LAS bf16_t* Ksn = (LAS bf16_t*)(C.lds + ((ti + 1) & 1) * ATT_BUF_BYTES + ATT_KS_OFF);
                LAS bf16_t* Vtn = (LAS bf16_t*)(C.lds + ((ti + 1) & 1) * ATT_BUF_BYTES + ATT_VT_OFF);
                ATT_STAGE(ti + 1, Ksn, Vtn);
                if (ti + 2 < ntot) ATT_LOAD(ti + 2);
            }
            __syncthreads();
        }
        {
            const float sk = sink[head] * 1.4426950408889634f;
            const float mnew = fmaxf(mrun, sk), alpha = fexp2(mrun - mnew);
            float l = lrun * alpha; l += __shfl_xor(l, 32); l += fexp2(sk - mnew);
            const float sc = alpha * frcp(l);
            bf16_t* op = O + (size_t)(R0 + t) * D + head * 128 + 4 * h;
#pragma unroll
            for (int db = 0; db < 4; ++db)
#pragma unroll
                for (int g4 = 0; g4 < 4; ++g4) {
                    u32x2 wv; wv.x = cvt_pk(o[db][4 * g4 + 0] * sc, o[db][4 * g4 + 1] * sc); wv.y = cvt_pk(o[db][4 * g4 + 2] * sc, o[db][4 * g4 + 3] * sc);
                    *(u32x2*)(op + 32 * db + 8 * g4) = wv;
                }
        }
    }
#undef ATT_TILE
#undef ATT_LOAD
#undef ATT_STAGE
    __syncthreads();
}

__device__ __forceinline__ void phase_hy_gate(const Ctx& C, const bf16_t* Pm, const float* cw, const float* cb, bf16_t* X0, bf16_t* ZTp, bf16_t* ZTs) {
    const int tid = C.tid;
    LAS bf16_t* zs = (LAS bf16_t*)C.lds;
    u32x4 ld[3][3];
#define HG_LOAD(it_) do { const bool smp_ = (it_) >= 2048; const int q_ = smp_ ? (it_) - 2048 : (it_); const int cbk_ = q_ & 31, tb_ = smp_ ? (q_ >> 5) & 15 : (q_ >> 5) & 3, b_ = smp_ ? q_ >> 9 : q_ >> 7; \
        const int L_ = smp_ ? 1024 : 256, R0_ = smp_ ? MP + b_ * 1024 : b_ * 256; const int t_ = tb_ * 64 + (tid >> 3), c0_ = cbk_ * 64 + 8 * (tid & 7); \
        _Pragma("unroll") for (int g = 0; g < 3; ++g) { const bf16_t* pr_ = Pm + (size_t)(R0_ + t_) * 6144 + g * D + c0_; \
            ld[g][0] = *(const u32x4*)(pr_ - (t_ > 0 ? 6144 : 0)); ld[g][2] = *(const u32x4*)(pr_ + (t_ < L_ - 1 ? 6144 : 0)); ld[g][1] = *(const u32x4*)pr_; } } while (0)
    f32x2 tw[3][4][4];
    int cur_cbk = -1;
    int it = C.bid;
    if (it < 6144) HG_LOAD(it);
    for (; it < 6144; it += C.G) {
        const bool smp = it >= 2048; const int q = smp ? it - 2048 : it;
        const int cbk = q & 31, tb = smp ? (q >> 5) & 15 : (q >> 5) & 3, b = smp ? q >> 9 : q >> 7;
        const int L = smp ? 1024 : 256, R0 = smp ? MP + b * 1024 : b * 256, NB = smp ? 8 : 16;
        const int tl = tid >> 3, c8 = tid & 7, t = tb * 64 + tl, c0 = cbk * 64 + 8 * c8;
        if (cbk != cur_cbk) { cur_cbk = cbk;
#pragma unroll
            for (int g = 0; g < 3; ++g)
#pragma unroll
                for (int j = 0; j < 4; ++j) { const int gc = g * D + c0 + 2 * j; tw[g][j][0] = *(const f32x2*)(cw + gc); tw[g][j][1] = *(const f32x2*)(cw + 6144 + gc); tw[g][j][2] = *(const f32x2*)(cw + 12288 + gc); tw[g][j][3] = *(const f32x2*)(cb + gc); } }
        float u[3][8];
        { const unsigned mk0 = t > 0 ? 0xffffffffu : 0u, mk1 = t < L - 1 ? 0xffffffffu : 0u;
#pragma unroll
          for (int g = 0; g < 3; ++g) {
            const unsigned a[4] = {ld[g][0].x & mk0, ld[g][0].y & mk0, ld[g][0].z & mk0, ld[g][0].w & mk0}, bq[4] = {ld[g][1].x, ld[g][1].y, ld[g][1].z, ld[g][1].w}, cq[4] = {ld[g][2].x & mk1, ld[g][2].y & mk1, ld[g][2].z & mk1, ld[g][2].w & mk1};
#pragma unroll
            for (int j = 0; j < 4; ++j) {
                const f32x2 w0 = tw[g][j][0], w1 = tw[g][j][1], w2 = tw[g][j][2], bb = tw[g][j][3];
                u[g][2 * j] = bflo(a[j]) * w0.x + bflo(bq[j]) * w1.x + bflo(cq[j]) * w2.x + bb.x;
                u[g][2 * j + 1] = bfhi(a[j]) * w0.y + bfhi(bq[j]) * w1.y + bfhi(cq[j]) * w2.y + bb.y;
            }
          } }
        { const int itn = it + C.G; if (itn < 6144) HG_LOAD(itn); }
        asm volatile("" ::: "memory");
        { u32x4 o; o.x = cvt_pk(u[0][0], u[0][1]); o.y = cvt_pk(u[0][2], u[0][3]); o.z = cvt_pk(u[0][4], u[0][5]); o.w = cvt_pk(u[0][6], u[0][7]);
          *(u32x4*)(X0 + (size_t)(R0 + t) * D + c0) = o; }
        __syncthreads();
#pragma unroll
        for (int j = 0; j < 8; ++j) zs[(8 * c8 + j) * 72 + tl] = (bf16_t)(cvt_pk(u[2][j] * u[1][j], 0.f) & 0xffffu);
        __syncthreads();
        { const int cl = tid >> 3, t8 = tid & 7;
          const u32x4 o = *(const LAS u32x4*)(zs + cl * 72 + 8 * t8);
          bf16_t* ZT = smp ? ZTs : ZTp;
          *(u32x4*)(ZT + ((size_t)(cbk * 64 + cl) * NB + b) * L + tb * 64 + 8 * t8) = o; }
    }
#undef HG_LOAD
    __syncthreads();
}

template <int L, int NB>
__device__ __forceinline__ void phase_hy_conv(const Ctx& C, const bf16_t* FG, const bf16_t* ZT, bf16_t* YT) {
    constexpr int WPC = L / 256, CPB = 8 / WPC, NS = L / 32, ROW = 2 * L + 64, UNITS = L / 4, COPYB = UNITS * 16, CHB = 8 * COPYB;
    constexpr int NH = NS > 16 ? NS / 16 : 1, JH = NS / NH;
    const int lane = C.lane, w = C.wave, ch_local = w / WPC, w4 = w % WPC, r = lane & 15, q = lane >> 4;
    for (int it = C.bid; it < 2048 / CPB; it += C.G) {
        const int c = it * CPB + ch_local;
        __syncthreads();
        {
            const int tcid = w4 * 64 + lane;
            const bf16_t* frow = FG + (size_t)c * ROW;
            for (int x = tcid; x < UNITS; x += 64 * WPC) {
                const u32x4 d0 = *(const u32x4*)(frow + 8 * x), d1 = *(const u32x4*)(frow + 8 * x + 8);
                const unsigned dd[8] = {d0.x, d0.y, d0.z, d0.w, d1.x, d1.y, d1.z, d1.w};
#pragma unroll
                for (int k = 0; k < 8; ++k) {
                    u32x4 o;
                    if ((k & 1) == 0) { o.x = dd[k / 2]; o.y = dd[k / 2 + 1]; o.z = dd[k / 2 + 2]; o.w = dd[k / 2 + 3]; }
                    else { const int b0 = (k - 1) / 2;
                        o.x = (dd[b0] >> 16) | (dd[b0 + 1] << 16); o.y = (dd[b0 + 1] >> 16) | (dd[b0 + 2] << 16); o.z = (dd[b0 + 2] >> 16) | (dd[b0 + 3] << 16); o.w = (dd[b0 + 3] >> 16) | (dd[b0 + 4] << 16); }
                    *(LAS u32x4*)(C.lds + ch_local * CHB + k * COPYB + x * 16) = o;
                }
            }
        }
        __syncthreads();
        f32x4 acc[16];
        { const float z0 = opaque_zero();
#pragma unroll
        for (int i = 0; i < 16; ++i) acc[i] = (f32x4){z0, z0, z0, z0}; }
        const bf16_t* zrow = ZT + ((size_t)c * NB + (r % NB)) * L + 8 * q;
        const LAS unsigned char* abase = C.lds + ch_local * CHB + (7 - (r & 7)) * COPYB + ((L - 8) / 8 - (r >> 3) + q - 32 * w4) * 16;
#pragma unroll
        for (int hh = 0; hh < NH; ++hh) {
            bf16x8 bf[JH];
#pragma unroll
            for (int j = 0; j < JH; ++j) bf[j] = *(const bf16x8*)(zrow + 32 * (hh * JH + j));
#pragma unroll
            for (int e = -2 * (hh * JH + JH - 1); e <= 15 - 2 * (hh * JH); ++e) {
                const bf16x8 a = *(const LAS bf16x8*)(abase - 32 * e);
#pragma unroll
                for (int j = 0; j < JH; ++j) { const int il = e + 2 * (hh * JH + j);
                    if (il >= 0 && il < 16) asm volatile("v_mfma_f32_16x16x32_bf16 %0, %1, %2, %0" : "+v"(acc[il]) : "v"(a), "v"(bf[j])); }
                asm volatile("" :: "v"(a));
            }
#pragma unroll
            for (int j = 0; j < JH; ++j) asm volatile("" :: "v"(bf[j]));
        }
        asm volatile("s_nop 15\n\ts_nop 15" : "+v"(acc[0]), "+v"(acc[1]), "+v"(acc[2]), "+v"(acc[3]), "+v"(acc[4]), "+v"(acc[5]), "+v"(acc[6]), "+v"(acc[7]));
        asm volatile("" : "+v"(acc[8]), "+v"(acc[9]), "+v"(acc[10]), "+v"(acc[11]), "+v"(acc[12]), "+v"(acc[13]), "+v"(acc[14]), "+v"(acc[15]));
        if (r < NB) {
            bf16_t* yrow = YT + ((size_t)c * NB + r) * L + 256 * w4 + 4 * q;
#pragma unroll
            for (int i = 0; i < 16; ++i) { u32x2 o; o.x = cvt_pk(acc[i][0], acc[i][1]); o.y = cvt_pk(acc[i][2], acc[i][3]);
#if defined(MK_CONV_VARIANT) && MK_CONV_VARIANT == 1
                { const u32x4 zz = *(const u32x4*)(zrow + 32 * (i & 7)); o.x = zz.x; o.y = zz.y; }
#elif defined(MK_CONV_VARIANT) && MK_CONV_VARIANT == 2
                { const u32x4 aa = *(const LAS u32x4*)(abase - 32 * (i - 8)); o.x = aa.x; o.y = aa.w; }
#endif
                *(u32x2*)(yrow + 16 * i) = o; }
        }
    }
    __syncthreads();
}

__device__ __forceinline__ void phase_hy_out(const Ctx& C, const bf16_t* YTp, const bf16_t* YTs, const bf16_t* X0, bf16_t* Om) {
    const int tid = C.tid;
    LAS bf16_t* ys = (LAS bf16_t*)C.lds;
    u32x4 v, xv;
#define HO_LOAD(it_) do { const bool smp_ = (it_) >= 2048; const int q_ = smp_ ? (it_) - 2048 : (it_); const int cbk_ = q_ & 31, tb_ = smp_ ? (q_ >> 5) & 15 : (q_ >> 5) & 3, b_ = smp_ ? q_ >> 9 : q_ >> 7; \
        const int L_ = smp_ ? 1024 : 256, R0_ = smp_ ? MP + b_ * 1024 : b_ * 256, NB_ = smp_ ? 8 : 16; const bf16_t* YT_ = smp_ ? YTs : YTp; \
        v = *(const u32x4*)(YT_ + ((size_t)(cbk_ * 64 + (tid >> 3)) * NB_ + b_) * L_ + tb_ * 64 + 8 * (tid & 7)); \
        xv = *(const u32x4*)(X0 + (size_t)(R0_ + tb_ * 64 + (tid >> 3)) * D + cbk_ * 64 + 8 * (tid & 7)); } while (0)
    int it = C.bid;
    if (it < 6144) HO_LOAD(it);
    for (; it < 6144; it += C.G) {
        const bool smp = it >= 2048; const int q = smp ? it - 2048 : it;
        const int cbk = q & 31, tb = smp ? (q >> 5) & 15 : (q >> 5) & 3, b = smp ? q >> 9 : q >> 7;
        const int R0 = smp ? MP + b * 1024 : b * 256;
        __syncthreads();
        { const int cl = tid >> 3, t8 = tid & 7;
          const unsigned pv[4] = {v.x, v.y, v.z, v.w};
#pragma unroll
          for (int j = 0; j < 4; ++j) { ys[(8 * t8 + 2 * j) * 72 + cl] = (bf16_t)(pv[j] & 0xffffu); ys[(8 * t8 + 2 * j + 1) * 72 + cl] = (bf16_t)(pv[j] >> 16); } }
        __syncthreads();
        { const int tl = tid >> 3, c8 = tid & 7; const size_t off = (size_t)(R0 + tb * 64 + tl) * D + cbk * 64 + 8 * c8;
          const u32x4 yv = *(const LAS u32x4*)(ys + tl * 72 + 8 * c8);
          const unsigned py[4] = {yv.x, yv.y, yv.z, yv.w}, px[4] = {xv.x, xv.y, xv.z, xv.w}; u32x4 o;
          o.x = cvt_pk(bflo(py[0]) * bflo(px[0]), bfhi(py[0]) * bfhi(px[0])); o.y = cvt_pk(bflo(py[1]) * bflo(px[1]), bfhi(py[1]) * bfhi(px[1]));
          o.z = cvt_pk(bflo(py[2]) * bflo(px[2]), bfhi(py[2]) * bfhi(px[2])); o.w = cvt_pk(bflo(py[3]) * bflo(px[3]), bfhi(py[3]) * bfhi(px[3]));
          const int itn = it + C.G;
          if (itn < 6144) HO_LOAD(itn);
          asm volatile("" ::: "memory");
          *(u32x4*)(Om + off) = o; }
    }
#undef HO_LOAD
    __syncthreads();
}

__device__ __forceinline__ void phase_rw_mix(const Ctx& C, const bf16_t* H, const float* mu, bf16_t* XM) {
    const int gw = C.bid * 8 + C.wave, NGW = C.G * 8, lane = C.lane;
#pragma unroll 1
    for (int ch = 0; ch < 4; ++ch) {
        const int c0 = 8 * (lane + 64 * ch);
        f32x4 mv[6][2];
#pragma unroll
        for (int s = 0; s < 6; ++s) { const int mi = s == 0 ? 0 : s == 1 ? 2 : s == 2 ? 3 : s == 3 ? 1 : s; mv[s][0] = *(const f32x4*)(mu + mi * D + c0); mv[s][1] = *(const f32x4*)(mu + mi * D + c0 + 4); }
        u32x4 a, b, c;
#define MX_LOAD(m_) do { const int t_ = (m_) < MP ? ((m_) & 255) : (((m_) - MP) & 1023), L_ = (m_) < MP ? 256 : 1024; const bf16_t* hp_ = H + (size_t)(m_) * D + c0; \
            a = *(const u32x4*)(hp_ - (t_ > 0 ? D : 0)); c = *(const u32x4*)(hp_ + (t_ < L_ - 1 ? D : 0)); b = *(const u32x4*)hp_; } while (0)
        int m = gw;
        if (m < MT) MX_LOAD(m);
        for (; m < MT; m += NGW) {
            const int t = m < MP ? (m & 255) : ((m - MP) & 1023), L = m < MP ? 256 : 1024;
            const unsigned mk0 = t > 0 ? 0xffffffffu : 0u, mk1 = t < L - 1 ? 0xffffffffu : 0u;
            const unsigned pa[4] = {a.x & mk0, a.y & mk0, a.z & mk0, a.w & mk0}, pb[4] = {b.x, b.y, b.z, b.w}, pc[4] = {c.x & mk1, c.y & mk1, c.z & mk1, c.w & mk1};
            float hv[8], xx[8];
#pragma unroll
            for (int j = 0; j < 4; ++j) { hv[2 * j] = bflo(pb[j]); hv[2 * j + 1] = bfhi(pb[j]);
                xx[2 * j] = 0.5f * (bflo(pa[j]) + bflo(pc[j])) - hv[2 * j]; xx[2 * j + 1] = 0.5f * (bfhi(pa[j]) + bfhi(pc[j])) - hv[2 * j + 1]; }
            u32x4 o[6];
#pragma unroll
            for (int s = 0; s < 6; ++s) {
                const f32x4 m0 = mv[s][0], m1 = mv[s][1];
                o[s].x = cvt_pk(hv[0] + xx[0] * m0.x, hv[1] + xx[1] * m0.y); o[s].y = cvt_pk(hv[2] + xx[2] * m0.z, hv[3] + xx[3] * m0.w);
                o[s].z = cvt_pk(hv[4] + xx[4] * m1.x, hv[5] + xx[5] * m1.y); o[s].w = cvt_pk(hv[6] + xx[6] * m1.z, hv[7] + xx[7] * m1.w);
            }
            const int mn = m + NGW;
            if (mn < MT) MX_LOAD(mn);
            asm volatile("" ::: "memory");
#pragma unroll
            for (int s = 0; s < 6; ++s) *(u32x4*)(XM + ((size_t)s * MT + m) * D + c0) = o[s];
        }
#undef MX_LOAD
    }
}

__device__ __forceinline__ float dpp_xor1(float x) { return __int_as_float(__builtin_amdgcn_update_dpp(0, __float_as_int(x), 0xB1, 0xF, 0xF, true)); }
__device__ __forceinline__ float dpp_xor2(float x) { return __int_as_float(__builtin_amdgcn_update_dpp(0, __float_as_int(x), 0x4E, 0xF, 0xF, true)); }

constexpr int SC_STEP = 6 * 64;
template <int R, int SC_TS>
__device__ __forceinline__ void rw_scan_task(LAS float* buf, int lane, const bf16_t* Rm, const bf16_t* Km, const bf16_t* Vm, const bf16_t* LD, const bf16_t* LA,
                                             const float* k_k, const float* k_a, const float* invsq, const float* state_in, bf16_t* YB, float* state_out, bool smp, int b, int head, int dir, int half) {
    const int rg = lane >> 2, kq = lane & 3;
    const int L = smp ? 1024 : 256, R0 = smp ? MP + b * 1024 : b * 256;
    const int row0 = half * (16 * R) + R * rg;
    f32x2 S[R][8];
    if (smp) {
        const float* sp = state_in + ((size_t)(b * 2 + dir) * 32 + head) * 4096 + row0 * 64 + 16 * kq;
#pragma unroll
        for (int rr = 0; rr < R; ++rr)
#pragma unroll
            for (int j4 = 0; j4 < 4; ++j4) { const f32x4 v = *(const f32x4*)(sp + rr * 64 + 4 * j4); S[rr][2 * j4] = (f32x2){v.x, v.y}; S[rr][2 * j4 + 1] = (f32x2){v.z, v.w}; }
    } else {
#pragma unroll
        for (int rr = 0; rr < R; ++rr)
#pragma unroll
            for (int j = 0; j < 8; ++j) S[rr][j] = (f32x2){0.f, 0.f};
    }
    const int ch = head * 64 + lane; const size_t hbase = (size_t)head * MT * 64 + lane;
    const float kkc = k_k[ch], kac = k_a[ch];
    const bf16_t* ldp = LD + (size_t)dir * MT * D; const bf16_t* lap = LA + (size_t)dir * MT * D;
    bf16_t* yb = YB + (size_t)dir * MT * D;
    bf16_t pr[SC_TS], pk[SC_TS], pv[SC_TS], pl[SC_TS], pa[SC_TS], qr[SC_TS], qk[SC_TS], qv[SC_TS], ql[SC_TS], qa[SC_TS];
    const int tstart = dir ? L - 1 : 0, tstep = dir ? -1 : 1;
    const int NCH = L / SC_TS;
#define SC_PREFETCH(c) do { _Pragma("unroll") for (int s_ = 0; s_ < SC_TS; ++s_) { const size_t o_ = hbase + (size_t)(R0 + tstart + tstep * ((c) * SC_TS + s_)) * 64; pr[s_] = Rm[o_]; pk[s_] = Km[o_]; pv[s_] = Vm[o_]; pl[s_] = ldp[o_]; pa[s_] = lap[o_]; } } while (0)
#define SC_DERIVE(s_, bufp) do { const float r_ = bf2f(pr[s_]), k_ = bf2f(pk[s_]), v_ = bf2f(pv[s_]), ld_ = bf2f(pl[s_]), a_ = fsigmoid(bf2f(pa[s_])); \
        const float kr_ = k_ * kkc; const float kk_ = kr_ * __builtin_amdgcn_rsqf(wave_sum(kr_ * kr_) + 1e-12f); \
        const unsigned sa_ = (unsigned)(unsigned long)((bufp) + (s_) * SC_STEP) + 4u * (unsigned)lane;     \
        asm volatile("ds_write_b32 %0, %1" :: "v"(sa_), "v"(fexp(ld_))); asm volatile("ds_write_b32 %0, %1 offset:256" :: "v"(sa_), "v"(kk_ * a_)); \
        asm volatile("ds_write_b32 %0, %1 offset:512" :: "v"(sa_), "v"(k_ * (1.0f + (a_ - 1.0f) * kac))); asm volatile("ds_write_b32 %0, %1 offset:768" :: "v"(sa_), "v"(-kk_)); \
        asm volatile("ds_write_b32 %0, %1 offset:1024" :: "v"(sa_), "v"(r_)); asm volatile("ds_write_b32 %0, %1 offset:1280" :: "v"(sa_), "v"(v_)); } while (0)
#define SC_PREFETCH2(c) do { _Pragma("unroll") for (int s_ = 0; s_ < SC_TS; ++s_) { const size_t o_ = hbase + (size_t)(R0 + tstart + tstep * ((c) * SC_TS + s_)) * 64; qr[s_] = Rm[o_]; qk[s_] = Km[o_]; qv[s_] = Vm[o_]; ql[s_] = ldp[o_]; qa[s_] = lap[o_]; } } while (0)
    SC_PREFETCH(0);
#pragma unroll
    for (int s = 0; s < SC_TS; ++s) SC_DERIVE(s, buf);
    asm volatile("s_waitcnt lgkmcnt(0)" ::: "memory");
    SC_PREFETCH(1);
    SC_PREFETCH2(2);
#define SC_DERIVE_Q(s_, bufp) do { const float r_ = bf2f(qr[s_]), k_ = bf2f(qk[s_]), v_ = bf2f(qv[s_]), ld_ = bf2f(ql[s_]), a_ = fsigmoid(bf2f(qa[s_])); \
        const float kr_ = k_ * kkc; const float kk_ = kr_ * __builtin_amdgcn_rsqf(wave_sum(kr_ * kr_) + 1e-12f); \
        const unsigned sa_ = (unsigned)(unsigned long)((bufp) + (s_) * SC_STEP) + 4u * (unsigned)lane; \
        asm volatile("ds_write_b32 %0, %1" :: "v"(sa_), "v"(fexp(ld_))); asm volatile("ds_write_b32 %0, %1 offset:256" :: "v"(sa_), "v"(kk_ * a_)); \
        asm volatile("ds_write_b32 %0, %1 offset:512" :: "v"(sa_), "v"(k_ * (1.0f + (a_ - 1.0f) * kac))); asm volatile("ds_write_b32 %0, %1 offset:768" :: "v"(sa_), "v"(-kk_)); \
        asm volatile("ds_write_b32 %0, %1 offset:1024" :: "v"(sa_), "v"(r_)); asm volatile("ds_write_b32 %0, %1 offset:1280" :: "v"(sa_), "v"(v_)); } while (0)
    LAS float* const buf0 = buf; LAS float* const buf1 = buf + SC_TS * SC_STEP;
    for (int cix = 0; cix < NCH; cix += 2) {
#pragma unroll
        for (int s = 0; s < SC_TS; ++s) {
            SC_DERIVE(s, buf1);
            if (cix + 3 < NCH) { const size_t o_ = hbase + (size_t)(R0 + tstart + tstep * ((cix + 3) * SC_TS + s)) * 64; pr[s] = Rm[o_]; pk[s] = Km[o_]; pv[s] = Vm[o_]; pl[s] = ldp[o_]; pa[s] = lap[o_]; }
#define BC_ buf0
#define CX_ cix
            const LAS float* sb = BC_ + s * SC_STEP;
            f32x2 w2[8], b2[8], d2[8], n2[8], r2[8];
#pragma unroll
            for (int j4 = 0; j4 < 4; ++j4) { const f32x4 nv = *(const LAS f32x4*)(sb + 192 + 16 * kq + 4 * j4); n2[2 * j4] = (f32x2){nv.x, nv.y}; n2[2 * j4 + 1] = (f32x2){nv.z, nv.w}; }
#pragma unroll
            for (int j4 = 0; j4 < 4; ++j4) {
                const f32x4 bv = *(const LAS f32x4*)(sb + 64 + 16 * kq + 4 * j4), dv = *(const LAS f32x4*)(sb + 128 + 16 * kq + 4 * j4), wv = *(const LAS f32x4*)(sb + 16 * kq + 4 * j4), rv = *(const LAS f32x4*)(sb + 256 + 16 * kq + 4 * j4);
                w2[2 * j4] = (f32x2){wv.x, wv.y}; w2[2 * j4 + 1] = (f32x2){wv.z, wv.w}; b2[2 * j4] = (f32x2){bv.x, bv.y}; b2[2 * j4 + 1] = (f32x2){bv.z, bv.w};
                d2[2 * j4] = (f32x2){dv.x, dv.y}; d2[2 * j4 + 1] = (f32x2){dv.z, dv.w}; r2[2 * j4] = (f32x2){rv.x, rv.y}; r2[2 * j4 + 1] = (f32x2){rv.z, rv.w};
            }
            float vrow[R];
            if (R == 4) { const f32x4 vv = *(const LAS f32x4*)(sb + 320 + row0); vrow[0] = vv.x; vrow[R > 1 ? 1 : 0] = vv.y; vrow[R > 2 ? R - 2 : 0] = vv.z; vrow[R - 1] = vv.w; }
            else if (R == 2) { const f32x2 vv = *(const LAS f32x2*)(sb + 320 + row0); vrow[0] = vv.x; vrow[R - 1] = vv.y; }
            else vrow[0] = sb[320 + row0];
            float y[R];
#pragma unroll
            for (int rr = 0; rr < R; ++rr) {
                f32x2 a0 = S[rr][0] * n2[0], a1 = S[rr][1] * n2[1];
#pragma unroll
                for (int j = 2; j < 8; j += 2) { a0 = S[rr][j] * n2[j] + a0; a1 = S[rr][j + 1] * n2[j + 1] + a1; }
                a0 = a0 + a1;
                float sa = a0.x + a0.y; sa += dpp_xor1(sa); sa += dpp_xor2(sa);
                const f32x2 sa2 = (f32x2){sa, sa}, vr2 = (f32x2){vrow[rr], vrow[rr]};
                f32x2 y0 = (f32x2){0.f, 0.f}, y1 = (f32x2){0.f, 0.f};
#pragma unroll
                for (int j = 0; j < 8; j += 2) {
                    S[rr][j] = S[rr][j] * w2[j] + (sa2 * b2[j] + vr2 * d2[j]);
                    S[rr][j + 1] = S[rr][j + 1] * w2[j + 1] + (sa2 * b2[j + 1] + vr2 * d2[j + 1]);
                    y0 = S[rr][j] * r2[j] + y0; y1 = S[rr][j + 1] * r2[j + 1] + y1;
                }
                y0 = y0 + y1;
                float yy = y0.x + y0.y; yy += dpp_xor1(yy); yy += dpp_xor2(yy); y[rr] = yy;
            }
            {
                const int t = tstart + tstep * ((CX_) * SC_TS + s); bf16_t* yp = yb + (size_t)(R0 + t) * D + head * 64;
                if (R == 4) { const float ys = kq == 0 ? y[0] : kq == 1 ? y[R > 1 ? 1 : 0] : kq == 2 ? y[R > 2 ? R - 2 : 0] : y[R - 1]; yp[lane] = (bf16_t)cvt_pk(ys, ys); }
                else if (R == 2) { const float ys = (kq & 1) ? y[R - 1] : y[0]; yp[half * 32 + 2 * rg + (kq & 1)] = (bf16_t)cvt_pk(ys, ys); }
                else yp[row0] = (bf16_t)cvt_pk(y[0], y[0]);
            }
#undef BC_
#undef CX_
        }
        asm volatile("s_waitcnt lgkmcnt(0)" ::: "memory");
#pragma unroll
        for (int s = 0; s < SC_TS; ++s) {
            SC_DERIVE_Q(s, buf0);
            if (cix + 4 < NCH) { const size_t o_ = hbase + (size_t)(R0 + tstart + tstep * ((cix + 4) * SC_TS + s)) * 64; qr[s] = Rm[o_]; qk[s] = Km[o_]; qv[s] = Vm[o_]; ql[s] = ldp[o_]; qa[s] = lap[o_]; }
#define BC_ buf1
#define CX_ (cix + 1)
            const LAS float* sb = BC_ + s * SC_STEP;
            f32x2 w2[8], b2[8], d2[8], n2[8], r2[8];
#pragma unroll
            for (int j4 = 0; j4 < 4; ++j4) { const f32x4 nv = *(const LAS f32x4*)(sb + 192 + 16 * kq + 4 * j4); n2[2 * j4] = (f32x2){nv.x, nv.y}; n2[2 * j4 + 1] = (f32x2){nv.z, nv.w}; }
#pragma unroll
            for (int j4 = 0; j4 < 4; ++j4) {
                const f32x4 bv = *(const LAS f32x4*)(sb + 64 + 16 * kq + 4 * j4), dv = *(const LAS f32x4*)(sb + 128 + 16 * kq + 4 * j4), wv = *(const LAS f32x4*)(sb + 16 * kq + 4 * j4), rv = *(const LAS f32x4*)(sb + 256 + 16 * kq + 4 * j4);
                w2[2 * j4] = (f32x2){wv.x, wv.y}; w2[2 * j4 + 1] = (f32x2){wv.z, wv.w}; b2[2 * j4] = (f32x2){bv.x, bv.y}; b2[2 * j4 + 1] = (f32x2){bv.z, bv.w};
                d2[2 * j4] = (f32x2){dv.x, dv.y}; d2[2 * j4 + 1] = (f32x2){dv.z, dv.w}; r2[2 * j4] = (f32x2){rv.x, rv.y}; r2[2 * j4 + 1] = (f32x2){rv.z, rv.w};
            }
            float vrow[R];
            if (R == 4) { const f32x4 vv = *(const LAS f32x4*)(sb + 320 + row0); vrow[0] = vv.x; vrow[R > 1 ? 1 : 0] = vv.y; vrow[R > 2 ? R - 2 : 0] = vv.z; vrow[R - 1] = vv.w; }
            else if (R == 2) { const f32x2 vv = *(const LAS f32x2*)(sb + 320 + row0); vrow[0] = vv.x; vrow[R - 1] = vv.y; }
            else vrow[0] = sb[320 + row0];
            float y[R];
#pragma unroll
            for (int rr = 0; rr < R; ++rr) {
                f32x2 a0 = S[rr][0] * n2[0], a1 = S[rr][1] * n2[1];
#pragma unroll
                for (int j = 2; j < 8; j += 2) { a0 = S[rr][j] * n2[j] + a0; a1 = S[rr][j + 1] * n2[j + 1] + a1; }
                a0 = a0 + a1;
                float sa = a0.x + a0.y; sa += dpp_xor1(sa); sa += dpp_xor2(sa);
                const f32x2 sa2 = (f32x2){sa, sa}, vr2 = (f32x2){vrow[rr], vrow[rr]};
                f32x2 y0 = (f32x2){0.f, 0.f}, y1 = (f32x2){0.f, 0.f};
#pragma unroll
                for (int j = 0; j < 8; j += 2) {
                    S[rr][j] = S[rr][j] * w2[j] + (sa2 * b2[j] + vr2 * d2[j]);
                    S[rr][j + 1] = S[rr][j + 1] * w2[j + 1] + (sa2 * b2[j + 1] + vr2 * d2[j + 1]);
                    y0 = S[rr][j] * r2[j] + y0; y1 = S[rr][j + 1] * r2[j + 1] + y1;
                }
                y0 = y0 + y1;
                float yy = y0.x + y0.y; yy += dpp_xor1(yy); yy += dpp_xor2(yy); y[rr] = yy;
            }
            {
                const int t = tstart + tstep * ((CX_) * SC_TS + s); bf16_t* yp = yb + (size_t)(R0 + t) * D + head * 64;
                if (R == 4) { const float ys = kq == 0 ? y[0] : kq == 1 ? y[R > 1 ? 1 : 0] : kq == 2 ? y[R > 2 ? R - 2 : 0] : y[R - 1]; yp[lane] = (bf16_t)cvt_pk(ys, ys); }
                else if (R == 2) { const float ys = (kq & 1) ? y[R - 1] : y[0]; yp[half * 32 + 2 * rg + (kq & 1)] = (bf16_t)cvt_pk(ys, ys); }
                else yp[row0] = (bf16_t)cvt_pk(y[0], y[0]);
            }
#undef BC_
#undef CX_
        }
        asm volatile("s_waitcnt lgkmcnt(0)" ::: "memory");
    }
#undef SC_DERIVE_Q
#undef SC_PREFETCH
#undef SC_PREFETCH2
#undef SC_DERIVE
    if (!smp) {
        float* sp = state_out + ((size_t)(b * 2 + dir) * 32 + head) * 4096 + row0 * 64 + 16 * kq;
#pragma unroll
        for (int rr = 0; rr < R; ++rr)
#pragma unroll
            for (int j4 = 0; j4 < 4; ++j4) *(f32x4*)(sp + rr * 64 + 4 * j4) = (f32x4){S[rr][2 * j4].x, S[rr][2 * j4].y, S[rr][2 * j4 + 1].x, S[rr][2 * j4 + 1].y};
    }
}
__device__ __forceinline__ void phase_rw_scan(const Ctx& C, const bf16_t* Rm, const bf16_t* Km, const bf16_t* Vm, const bf16_t* LD, const bf16_t* LA,
                                              const float* k_k, const float* k_a, const float* invsq, const float* state_in, bf16_t* YB, float* state_out) {
    const int lane = C.lane, w = C.wave;
    LAS float* buf = (LAS float*)(C.lds + (w < 4 ? w * 24576 : 98304 + (w - 4) * 12288));
    if (w < 4) { for (int slot = C.bid * 4 + w; slot < 1024; slot += C.G * 4) { const int id = slot >> 1; rw_scan_task<2, 8>(buf, lane, Rm, Km, Vm, LD, LA, k_k, k_a, invsq, state_in, YB, state_out, true, id >> 6, (id >> 1) & 31, id & 1, slot & 1); } }
    else { for (int id = C.bid * 4 + (w - 4); id < 1024; id += C.G * 4) rw_scan_task<4, 4>(buf, lane, Rm, Km, Vm, LD, LA, k_k, k_a, invsq, state_in, YB, state_out, false, id >> 6, (id >> 1) & 31, id & 1, 0); }
    if (w >= 4) late_transposes(C, buf, C.bid * 4 + (w - 4), C.G * 4);
    __syncthreads();
}

__device__ __forceinline__ float head8_sum(float v) { v = DPP_ADD(v, 0xB1); v = DPP_ADD(v, 0x4E); v = DPP_ADD(v, 0x141); return v; }
__device__ __forceinline__ void phase_rw_post(const Ctx& C, const bf16_t* YB, const bf16_t* Rm, const bf16_t* Km, const bf16_t* Vm, const bf16_t* LA, const bf16_t* Gt,
                                              const float* k_a, const float* r_k, const float* ln_w, const float* ln_b, bf16_t* Om) {
    const int gw = C.bid * 8 + C.wave, NGW = C.G * 8, lane = C.lane;
#pragma unroll 1
    for (int ch = 0; ch < 4; ++ch) {
        const int c0 = 8 * (lane + 64 * ch);
        const f32x4 ka0 = *(const f32x4*)(k_a + c0), ka1 = *(const f32x4*)(k_a + c0 + 4), rk0 = *(const f32x4*)(r_k + c0), rk1 = *(const f32x4*)(r_k + c0 + 4);
        const f32x4 lw0 = *(const f32x4*)(ln_w + c0), lw1 = *(const f32x4*)(ln_w + c0 + 4), lb0 = *(const f32x4*)(ln_b + c0), lb1 = *(const f32x4*)(ln_b + c0 + 4);
        u32x4 yfw, ybw, rr, kk, vv, gg, l0, l1;
#define PO_LOAD(m_) do { const size_t o_ = (size_t)(m_) * D + c0; const size_t oh_ = hm_index((m_), c0); yfw = *(const u32x4*)(YB + o_); ybw = *(const u32x4*)(YB + (size_t)MT * D + o_); \
            rr = *(const u32x4*)(Rm + oh_); kk = *(const u32x4*)(Km + oh_); vv = *(const u32x4*)(Vm + oh_); gg = *(const u32x4*)(Gt + o_); l0 = *(const u32x4*)(LA + oh_); l1 = *(const u32x4*)(LA + (size_t)MT * D + oh_); } while (0)
        int m = gw;
        if (m < MT) PO_LOAD(m);
        for (; m < MT; m += NGW) {
            float y[8], r[8], k[8], v[8], g[8], a0[8], a1[8], ka[8], rk[8], lw[8], lb[8];
            const unsigned pyf[4] = {yfw.x, yfw.y, yfw.z, yfw.w}, pyb[4] = {ybw.x, ybw.y, ybw.z, ybw.w}, pr[4] = {rr.x, rr.y, rr.z, rr.w}, pk[4] = {kk.x, kk.y, kk.z, kk.w}, pv[4] = {vv.x, vv.y, vv.z, vv.w}, pg[4] = {gg.x, gg.y, gg.z, gg.w}, p0[4] = {l0.x, l0.y, l0.z, l0.w}, p1[4] = {l1.x, l1.y, l1.z, l1.w};
#pragma unroll
            for (int j = 0; j < 4; ++j) {
                y[2 * j] = bflo(pyf[j]) + bflo(pyb[j]); y[2 * j + 1] = bfhi(pyf[j]) + bfhi(pyb[j]); ka[j] = ka0[j]; ka[4 + j] = ka1[j]; rk[j] = rk0[j]; rk[4 + j] = rk1[j]; lw[j] = lw0[j]; lw[4 + j] = lw1[j]; lb[j] = lb0[j]; lb[4 + j] = lb1[j];
                r[2 * j] = bflo(pr[j]); r[2 * j + 1] = bfhi(pr[j]); k[2 * j] = bflo(pk[j]); k[2 * j + 1] = bfhi(pk[j]); v[2 * j] = bflo(pv[j]); v[2 * j + 1] = bfhi(pv[j]);
                g[2 * j] = bflo(pg[j]); g[2 * j + 1] = bfhi(pg[j]); a0[2 * j] = fsigmoid(bflo(p0[j])); a0[2 * j + 1] = fsigmoid(bfhi(p0[j])); a1[2 * j] = fsigmoid(bflo(p1[j])); a1[2 * j + 1] = fsigmoid(bfhi(p1[j]));
            }
            float s = 0.f, bon = 0.f;
#pragma unroll
            for (int j = 0; j < 8; ++j) { s += y[j]; bon += r[j] * (k[j] * (2.0f + (a0[j] + a1[j] - 2.0f) * ka[j])) * rk[j]; }
            const float mean = head8_sum(s) * (1.0f / 64.0f); bon = head8_sum(bon);
            float q = 0.f;
#pragma unroll
            for (int j = 0; j < 8; ++j) { y[j] -= mean; q += y[j] * y[j]; }
            const float rstd = __builtin_amdgcn_rsqf(head8_sum(q) * (1.0f / 64.0f) + 64e-5f);
            float ov[8];
#pragma unroll
            for (int j = 0; j < 8; ++j) ov[j] = (y[j] * rstd * lw[j] + lb[j] + bon * v[j]) * g[j];
            u32x4 w; w.x = cvt_pk(ov[0], ov[1]); w.y = cvt_pk(ov[2], ov[3]); w.z = cvt_pk(ov[4], ov[5]); w.w = cvt_pk(ov[6], ov[7]);
            const int mn = m + NGW;
            if (mn < MT) PO_LOAD(mn);
            asm volatile("" ::: "memory");
            *(u32x4*)(Om + (size_t)m * D + c0) = w;
        }
#undef PO_LOAD
    }
}

constexpr int NPH = 35;
#define IN(k) (lo <= (k) && (k) < hi)
#define SEAM(k) do { if (IN(k) && IN((k) + 1)) xcd_barrier(bar); } while (0)
#define LDSG ((PG8_LAS unsigned char*)C.lds)
#ifndef MK_REP_MASK
#define MK_REP_MASK 0ull
#endif
#define REPQ(k) (((MK_REP_MASK) >> (k)) & 1ull)

template <class Epi>
__device__ __forceinline__ void run_gemm(const Ctx& C, const bf16_t* A, const bf16_t* Bt, int N, int K, const Epi& E) {
    pg8::Gemm g{A, Bt, MT, N, K, K}; pg8::StaticOrder S; S.init(MT, N, C.G, C.bid);
    pg8::gemm_phase<Epi, pg8::StaticOrder, false>(LDSG, g, S, E, nullptr);
}

#ifndef MK_SPLIT_MASK
#define MK_SPLIT_MASK 15
#endif
#define PREVP1(L) (((L) > 0 && (((MK_SPLIT_MASK) >> ((L) - 1)) & 1)) ? (const bf16_t*)WSP(bf16_t, WS_ARENA + AR_SLAB) : (const bf16_t*)nullptr)
constexpr size_t AR_SLAB = 200 * MiB;
constexpr size_t CTL_SPLIT = 65536;
template <int SET>
__device__ __forceinline__ void run_gemm_split_res(const Ctx& C, const bf16_t* A, const bf16_t* Bt, int K, bf16_t* X, const float* gate_base) {
    pg8::Gemm g{A, Bt, MT, D, K, K / 2}; TailSplitOrder S; S.init(C.G, C.bid, K / 64);
    EpiResidualSplitB E{X, gate_base, WSP(bf16_t, WS_ARENA + AR_SLAB)};
    pg8::gemm_phase<EpiResidualSplitB, TailSplitOrder, false>(LDSG, g, S, E, nullptr);
}
template <int LAYER>
__device__ __forceinline__ void mlp_block(const Ctx& C, const XcdBarrier& bar, int lo, int hi, int b0) {
    bf16_t* X = WSP(bf16_t, WS_X); bf16_t* H = WSP(bf16_t, WS_H); bf16_t* U = WSP(bf16_t, WS_ARENA + AR_U);
    if (IN(b0)) { { phase_norm_mod_b(C, X, karg<I_N2G>() + LAYER * D, LAYER, 3, H); } if (REPQ(b0)) { phase_norm_mod_b(C, X, karg<I_N2G>() + LAYER * D, LAYER, 3, H); } }
    SEAM(b0);
    if (IN(b0 + 1)) { { EpiBf16<1> E{U, FF}; run_gemm(C, H, WSP(bf16_t, WS_W1T) + (size_t)LAYER * D * FF, FF, D, E); } if (REPQ(b0 + 1)) { EpiBf16<1> E{U, FF}; run_gemm(C, H, WSP(bf16_t, WS_W1T) + (size_t)LAYER * D * FF, FF, D, E); } }
    SEAM(b0 + 1);
    if (IN(b0 + 2)) { { if constexpr (((MK_SPLIT_MASK) >> LAYER) & 1) run_gemm_split_res<LAYER>(C, U, WSP(bf16_t, WS_W2T) + (size_t)LAYER * D * FF, FF, X, MODP(LAYER, 0, 5)); else { EpiResidualB<false> E{X, MODP(LAYER, 0, 5), nullptr, nullptr}; run_gemm(C, U, WSP(bf16_t, WS_W2T) + (size_t)LAYER * D * FF, D, FF, E); } } if (REPQ(b0 + 2)) { if constexpr (((MK_SPLIT_MASK) >> LAYER) & 1) run_gemm_split_res<LAYER>(C, U, WSP(bf16_t, WS_W2T) + (size_t)LAYER * D * FF, FF, X, MODP(LAYER, 0, 5)); else { EpiResidualB<false> E{X, MODP(LAYER, 0, 5), nullptr, nullptr}; run_gemm(C, U, WSP(bf16_t, WS_W2T) + (size_t)LAYER * D * FF, D, FF, E); } } }
    SEAM(b0 + 2);
}

template <int LAYER, int J>
__device__ __forceinline__ void attn_layer(const Ctx& C, const XcdBarrier& bar, int lo, int hi, int b0) {
    bf16_t* X = WSP(bf16_t, WS_X); bf16_t* H = WSP(bf16_t, WS_H);
    bf16_t *Q = WSP(bf16_t, WS_ARENA + AR_Q), *Kb = WSP(bf16_t, WS_ARENA + AR_K), *Vb = WSP(bf16_t, WS_ARENA + AR_V), *O = WSP(bf16_t, WS_ARENA + AR_O);
    if (IN(b0)) { { if (LAYER == 0) { phase_fg_transpose(C); phase_norm_mod(C, karg<I_XP>(), karg<I_XS>(), karg<I_N1G>() + LAYER * D, LAYER, 0, H); } else phase_norm_mod_b(C, X, karg<I_N1G>() + LAYER * D, LAYER, 0, H, PREVP1(LAYER), X, 8192); } if (REPQ(b0)) { if (LAYER == 0) { phase_fg_transpose(C); phase_norm_mod(C, karg<I_XP>(), karg<I_XS>(), karg<I_N1G>() + LAYER * D, LAYER, 0, H); } else phase_norm_mod_b(C, X, karg<I_N1G>() + LAYER * D, LAYER, 0, H, PREVP1(LAYER), X, 8192); } }
    SEAM(b0);
    if (IN(b0 + 1)) { { EpiQKV E{Q, Kb, Vb, C.out + OUT_NK + (size_t)J * 256 * 512, C.out + OUT_NV + (size_t)J * 256 * 512}; run_gemm(C, H, WSP(bf16_t, WS_WQKVT) + (size_t)J * D * 3072, 3072, D, E); } if (REPQ(b0 + 1)) { EpiQKV E{Q, Kb, Vb, C.out + OUT_NK + (size_t)J * 256 * 512, C.out + OUT_NV + (size_t)J * 256 * 512}; run_gemm(C, H, WSP(bf16_t, WS_WQKVT) + (size_t)J * D * 3072, 3072, D, E); } }
    SEAM(b0 + 1);
    if (IN(b0 + 2)) { { phase_attention(C, Q, Kb, Vb, WSP(bf16_t, WS_KC) + (size_t)J * 512 * 512, WSP(bf16_t, WS_VC) + (size_t)J * 512 * 512, karg<I_SINK>() + J * 16, O); } if (REPQ(b0 + 2)) { phase_attention(C, Q, Kb, Vb, WSP(bf16_t, WS_KC) + (size_t)J * 512 * 512, WSP(bf16_t, WS_VC) + (size_t)J * 512 * 512, karg<I_SINK>() + J * 16, O); } }
    SEAM(b0 + 2);
    if (IN(b0 + 3)) { { EpiResidualB<LAYER == 0> E{X, MODP(LAYER, 0, 2), LAYER == 0 ? karg<I_XP>() : nullptr, LAYER == 0 ? karg<I_XS>() : nullptr}; run_gemm(C, O, WSP(bf16_t, WS_WOT) + (size_t)J * D * D, D, D, E); } if (REPQ(b0 + 3)) { EpiResidualB<LAYER == 0> E{X, MODP(LAYER, 0, 2), LAYER == 0 ? karg<I_XP>() : nullptr, LAYER == 0 ? karg<I_XS>() : nullptr}; run_gemm(C, O, WSP(bf16_t, WS_WOT) + (size_t)J * D * D, D, D, E); } }
    SEAM(b0 + 3);
    mlp_block<LAYER>(C, bar, lo, hi, b0 + 4);
}

template <int LAYER>
__device__ __forceinline__ void hyena_layer(const Ctx& C, const XcdBarrier& bar, int lo, int hi, int b0) {
    bf16_t* X = WSP(bf16_t, WS_X); bf16_t* H = WSP(bf16_t, WS_H);
    bf16_t *Pm = WSP(bf16_t, WS_ARENA + AR_P), *X0 = WSP(bf16_t, WS_ARENA + AR_X0), *ZT = WSP(bf16_t, WS_ARENA + AR_ZT), *YT = WSP(bf16_t, WS_ARENA + AR_YT), *HO = WSP(bf16_t, WS_ARENA + AR_HO);
    bf16_t *ZTp = ZT, *ZTs = ZT + (size_t)MP * D, *YTp = YT, *YTs = YT + (size_t)MP * D;
    if (IN(b0)) { { phase_norm_mod_b(C, X, karg<I_N1G>() + LAYER * D, LAYER, 0, H, PREVP1(LAYER), X, 8192); } if (REPQ(b0)) { phase_norm_mod_b(C, X, karg<I_N1G>() + LAYER * D, LAYER, 0, H, PREVP1(LAYER), X, 8192); } }
    SEAM(b0);
    if (IN(b0 + 1)) { { EpiBf16<0> E{Pm, 6144}; run_gemm(C, H, WSP(bf16_t, WS_HYINT), 6144, D, E); } if (REPQ(b0 + 1)) { EpiBf16<0> E{Pm, 6144}; run_gemm(C, H, WSP(bf16_t, WS_HYINT), 6144, D, E); } }
    SEAM(b0 + 1);
    if (IN(b0 + 2)) { { phase_hy_gate(C, Pm, karg<I_HYCW>(), karg<I_HYCB>(), X0, ZTp, ZTs); } if (REPQ(b0 + 2)) { phase_hy_gate(C, Pm, karg<I_HYCW>(), karg<I_HYCB>(), X0, ZTp, ZTs); } }
    SEAM(b0 + 2);
    if (IN(b0 + 3)) { { phase_hy_conv<1024, 8>(C, WSP(bf16_t, WS_FGS), ZTs, YTs); phase_hy_conv<256, 16>(C, WSP(bf16_t, WS_FGP), ZTp, YTp); } if (REPQ(b0 + 3)) { phase_hy_conv<1024, 8>(C, WSP(bf16_t, WS_FGS), ZTs, YTs); phase_hy_conv<256, 16>(C, WSP(bf16_t, WS_FGP), ZTp, YTp); } }
    SEAM(b0 + 3);
    if (IN(b0 + 4)) { { phase_hy_out(C, YTp, YTs, X0, HO); } if (REPQ(b0 + 4)) { phase_hy_out(C, YTp, YTs, X0, HO); } }
    SEAM(b0 + 4);
    if (IN(b0 + 5)) { { EpiResidualB<false> E{X, MODP(LAYER, 0, 2), nullptr, nullptr}; run_gemm(C, HO, WSP(bf16_t, WS_HYOUTT), D, D, E); } if (REPQ(b0 + 5)) { EpiResidualB<false> E{X, MODP(LAYER, 0, 2), nullptr, nullptr}; run_gemm(C, HO, WSP(bf16_t, WS_HYOUTT), D, D, E); } }
    SEAM(b0 + 5);
    mlp_block<LAYER>(C, bar, lo, hi, b0 + 6);
}

__device__ __forceinline__ void rw_g2_phase(const Ctx& C, const bf16_t* XM, bf16_t* Rm, bf16_t* A3, bf16_t* LD, bf16_t* LA, bf16_t* Gt) {
    if (C.G == 256 && C.bid >= 240) { pg8::Gemm g{XM, WSP(bf16_t, WS_RWBT), 6 * MT, 27 * 256, D, D}; RwOrder1 S{16, C.bid - 240, 1280, 27 * NPANEL, true}; EpiRw1 E{Rm, A3, karg<I_KK>(), WSP(float, WS_INVSQ)}; pg8::gemm_phase<EpiRw1, RwOrder1, false>(LDSG, g, S, E, nullptr); }
    else { pg8::Gemm g{A3, WSP(bf16_t, WS_LORA2T), 3 * MT, 40 * 256, 256, 256}; RwOrder2 S{C.G == 256 ? 240 : C.G, C.bid, nullptr, 0u}; EpiRw2 E{LD, LA, Gt, karg<I_W0>(), karg<I_A0>()}; pg8::gemm_phase<EpiRw2, RwOrder2, false>(LDSG, g, S, E, nullptr); }
}
template <int LAYER>
__device__ __forceinline__ void rwkv_layer(const Ctx& C, const XcdBarrier& bar, int lo, int hi, int b0) {
    bf16_t* X = WSP(bf16_t, WS_X); bf16_t* H = WSP(bf16_t, WS_H);
    bf16_t *XM = WSP(bf16_t, WS_ARENA + AR_XMIX), *LD = WSP(bf16_t, WS_ARENA + AR_LD), *LA = WSP(bf16_t, WS_ARENA + AR_LA), *Gt = WSP(bf16_t, WS_ARENA + AR_G), *RO = WSP(bf16_t, WS_ARENA + AR_RO);
    bf16_t *Rm = WSP(bf16_t, WS_ARENA + AR_R), *Km = WSP(bf16_t, WS_ARENA + AR_KK), *Vm = WSP(bf16_t, WS_ARENA + AR_VV), *A3 = WSP(bf16_t, WS_ARENA + AR_A3);
    bf16_t* YB = WSP(bf16_t, WS_ARENA + AR_YB);
    if (IN(b0)) { { phase_norm_mod_b(C, X, karg<I_N1G>() + LAYER * D, LAYER, 0, H, PREVP1(LAYER), X, 8192); } if (REPQ(b0)) { phase_norm_mod_b(C, X, karg<I_N1G>() + LAYER * D, LAYER, 0, H, PREVP1(LAYER), X, 8192); } }
    SEAM(b0);
    if (IN(b0 + 1)) { { phase_rw_mix(C, H, karg<I_MU>(), XM); } if (REPQ(b0 + 1)) { phase_rw_mix(C, H, karg<I_MU>(), XM); } }
    SEAM(b0 + 1);
    if (IN(b0 + 2)) { { pg8::Gemm g{XM, WSP(bf16_t, WS_RWBT), 6 * MT, 27 * 256, D, D}; RwOrder1 S{C.G, C.bid, 0, C.G == 256 ? 1280 : 27 * NPANEL, C.G == 256}; EpiRw1 E{Rm, A3, karg<I_KK>(), WSP(float, WS_INVSQ)}; pg8::gemm_phase<EpiRw1, RwOrder1, false>(LDSG, g, S, E, nullptr); } if (REPQ(b0 + 2)) { pg8::Gemm g{XM, WSP(bf16_t, WS_RWBT), 6 * MT, 27 * 256, D, D}; RwOrder1 S{C.G, C.bid, 0, C.G == 256 ? 1280 : 27 * NPANEL, C.G == 256}; EpiRw1 E{Rm, A3, karg<I_KK>(), WSP(float, WS_INVSQ)}; pg8::gemm_phase<EpiRw1, RwOrder1, false>(LDSG, g, S, E, nullptr); } }
    SEAM(b0 + 2);
    if (IN(b0 + 3)) { { rw_g2_phase(C, XM, Rm, A3, LD, LA, Gt); } if (REPQ(b0 + 3)) { rw_g2_phase(C, XM, Rm, A3, LD, LA, Gt); } }
    SEAM(b0 + 3);
    if (IN(b0 + 4)) { { phase_rw_scan(C, Rm, Km, Vm, LD, LA, karg<I_KK>(), karg<I_KA>(), WSP(float, WS_INVSQ), karg<I_ST>(), YB, C.out + OUT_ST); } if (REPQ(b0 + 4)) { phase_rw_scan(C, Rm, Km, Vm, LD, LA, karg<I_KK>(), karg<I_KA>(), WSP(float, WS_INVSQ), karg<I_ST>(), YB, C.out + OUT_ST); } }
    SEAM(b0 + 4);
    if (IN(b0 + 5)) { { phase_rw_post(C, YB, Rm, Km, Vm, LA, Gt, karg<I_KA>(), karg<I_RK>(), karg<I_LNW>(), karg<I_LNB>(), RO); } if (REPQ(b0 + 5)) { phase_rw_post(C, YB, Rm, Km, Vm, LA, Gt, karg<I_KA>(), karg<I_RK>(), karg<I_LNW>(), karg<I_LNB>(), RO); } }
    SEAM(b0 + 5);
    if (IN(b0 + 6)) { { EpiResidualB<false> E{X, MODP(LAYER, 0, 2), nullptr, nullptr}; run_gemm(C, RO, WSP(bf16_t, WS_RWOT), D, D, E); } if (REPQ(b0 + 6)) { EpiResidualB<false> E{X, MODP(LAYER, 0, 2), nullptr, nullptr}; run_gemm(C, RO, WSP(bf16_t, WS_RWOT), D, D, E); } }
    SEAM(b0 + 6);
    mlp_block<LAYER>(C, bar, lo, hi, b0 + 7);
}

__global__ void __launch_bounds__(512, 2) fwd_kernel(Params prm) {
    extern __shared__ __attribute__((aligned(16))) unsigned char lds_raw[];
    Ctx C;
    C.lds = (LAS unsigned char*)lds_raw;
    C.tid = threadIdx.x; C.lane = C.tid & 63; C.wave = __builtin_amdgcn_readfirstlane(C.tid >> 6); C.G = gridDim.x; C.bid = blockIdx.x;
    C.out = prm.out; C.ws = prm.ws;
    const int lo = prm.ph_lo, hi = prm.ph_hi;
    volatile LAS unsigned* xbw = (volatile LAS unsigned*)(C.lds + LDS_BAR_OFF);
    if (C.tid < 4) xbw[C.tid] = 0u;
    __syncthreads();
    XcdBarrier bar; bar.bar = (unsigned*)(C.ws + WS_CTL) + 1024; bar.x = 0; bar.st = xbw;
    if (hi - lo > 1) bar = xcd_barrier_post((unsigned*)(C.ws + WS_CTL) + 1024, xbw);

#ifdef MK_SKIP_FROM
    if (IN(0)) { for (size_t i = (size_t)C.bid * 512 + C.tid; i < (size_t)3 * 4194304; i += (size_t)C.G * 512) prm.out[OUT_NK + i] = 0.f; }
#endif
    if (IN(0)) { { phase_prologue(C); } if (REPQ(0)) { phase_prologue(C); } }
    SEAM(0);
    attn_layer<0, 0>(C, bar, lo, hi, 1);
    hyena_layer<1>(C, bar, lo, hi, 8);
    rwkv_layer<2>(C, bar, lo, hi, 17);
    attn_layer<3, 1>(C, bar, lo, hi, 27);
#ifndef MK_DBG_N
#define MK_DBG_N ((size_t)MT * D)
#endif
#ifndef MK_DBG_SCALE
#define MK_DBG_SCALE 1.0f
#endif
#ifdef MK_DBG_OFF
    if (IN(34)) { for (size_t i = (size_t)C.bid * 512 + C.tid; i < (size_t)MT * D; i += (size_t)C.G * 512) prm.out[OUT_Y + i] = i < (size_t)(MK_DBG_N) ? MK_DBG_SCALE * (MK_DBG_BF16 ? bf2f(WSP(bf16_t, MK_DBG_OFF)[i]) : WSP(float, MK_DBG_OFF)[i]) : 0.f; }
#else
    if (IN(34)) { { phase_norm_final_b(C, WSP(bf16_t, WS_X), karg<I_FNG>(), prm.out + OUT_Y, PREVP1(4), 8192); } if (REPQ(34)) { phase_norm_final_b(C, WSP(bf16_t, WS_X), karg<I_FNG>(), prm.out + OUT_Y, PREVP1(4), 8192); } }
#endif
}

#ifdef MK_SEP_CONV
__global__ void __launch_bounds__(512, 2) k_hyconv(Params prm) {
    extern __shared__ __attribute__((aligned(16))) unsigned char lds_raw3[];
    Ctx C; C.lds = (LAS unsigned char*)lds_raw3; C.tid = threadIdx.x; C.lane = C.tid & 63; C.wave = __builtin_amdgcn_readfirstlane(C.tid >> 6); C.G = gridDim.x; C.bid = blockIdx.x; C.out = prm.out; C.ws = prm.ws;
    bf16_t *ZT = WSP(bf16_t, WS_ARENA + AR_ZT), *YT = WSP(bf16_t, WS_ARENA + AR_YT);
    phase_hy_conv<1024, 8>(C, WSP(bf16_t, WS_FGS), ZT + (size_t)MP * D, YT + (size_t)MP * D); phase_hy_conv<256, 16>(C, WSP(bf16_t, WS_FGP), ZT, YT);
}
#endif
#ifdef MK_SEP_GATE
__global__ void __launch_bounds__(512, 2) k_hygate(Params prm) {
    extern __shared__ __attribute__((aligned(16))) unsigned char lds_raw2[];
    Ctx C; C.lds = (LAS unsigned char*)lds_raw2; C.tid = threadIdx.x; C.lane = C.tid & 63; C.wave = __builtin_amdgcn_readfirstlane(C.tid >> 6); C.G = gridDim.x; C.bid = blockIdx.x; C.out = prm.out; C.ws = prm.ws;
    bf16_t* ZT = WSP(bf16_t, WS_ARENA + AR_ZT);
    phase_hy_gate(C, WSP(bf16_t, WS_ARENA + AR_P), karg<I_HYCW>(), karg<I_HYCB>(), WSP(bf16_t, WS_ARENA + AR_X0), ZT, ZT + (size_t)MP * D);
}
#endif
#ifndef MK_PER_PHASE
#define MK_PER_PHASE 0
#endif
extern "C" void kernel_launch(void* const* d_in, const int* in_sizes, int n_in, void* d_out, int out_size, void* d_ws, size_t ws_size, hipStream_t stream) {
    static int grid = 0;
    if (grid == 0) {
        if (n_in != N_IN || ws_size < WS_END || out_size != 37748736) { fprintf(stderr, "kernel_launch: unexpected shapes (n_in %d, ws %zu, out %d); nothing launched\n", n_in, ws_size, out_size); grid = -1; return; }
        int dev = 0, cus = 0, per_cu = 0;
        if (hipGetDevice(&dev) != hipSuccess || hipDeviceGetAttribute(&cus, hipDeviceAttributeMultiprocessorCount, dev) != hipSuccess) { grid = -1; return; }
        if (hipFuncSetAttribute((const void*)fwd_kernel, hipFuncAttributeMaxDynamicSharedMemorySize, LDS_BYTES) != hipSuccess) { fprintf(stderr, "kernel_launch: hipFuncSetAttribute failed\n"); grid = -1; return; }
        if (hipOccupancyMaxActiveBlocksPerMultiprocessor(&per_cu, (const void*)fwd_kernel, 512, LDS_BYTES) != hipSuccess || per_cu < 1) { fprintf(stderr, "kernel_launch: occupancy query says %d\n", per_cu); }
        (void)hipGetLastError();
        grid = cus;
    }
    if (grid < 0) return;
    (void)hipMemsetAsync((char*)d_ws, 0, WS_ZERO_BYTES, stream);
    Params p{};
    for (int i = 0; i < N_IN; ++i) p.in[i] = (const float*)d_in[i];
    p.out = (float*)d_out; p.ws = (unsigned char*)d_ws;
#ifndef MK_LASTP
#define MK_LASTP NPH
#endif
#ifndef MK_FIRSTP
#define MK_FIRSTP 0
#endif
#if MK_PER_PHASE
    for (int k = MK_FIRSTP; k < MK_LASTP; ++k) {
#ifdef MK_SKIP_FROM
        if (k >= MK_SKIP_FROM && k < NPH - 1) continue;
#endif
#ifdef MK_SEP_CONV
        if (k == 11) { static bool a3 = false; if (!a3) { (void)hipFuncSetAttribute((const void*)k_hyconv, hipFuncAttributeMaxDynamicSharedMemorySize, 70000); a3 = true; } hipLaunchKernelGGL(k_hyconv, dim3(grid), dim3(512), 70000, stream, p); continue; }
#endif
#ifdef MK_SEP_GATE
        if (k == 10) { hipLaunchKernelGGL(k_hygate, dim3(grid), dim3(512), 16384, stream, p); continue; }
#endif
#ifdef MK_REPEAT_PH
        if (k == MK_REPEAT_PH) { p.ph_lo = k; p.ph_hi = k + 1; hipLaunchKernelGGL(fwd_kernel, dim3(grid), dim3(512), LDS_BYTES, stream, p); }
#endif
 p.ph_lo = k; p.ph_hi = k + 1; hipLaunchKernelGGL(fwd_kernel, dim3(grid), dim3(512), LDS_BYTES, stream, p); }
#else
    p.ph_lo = 0; p.ph_hi = NPH; hipLaunchKernelGGL(fwd_kernel, dim3(grid), dim3(512), LDS_BYTES, stream, p);
#endif
}
```
